# Optimizing an MI355X kernel written in HIP

```python
import math
import jax, jax.numpy as jnp
from jax import lax
import numpy as np

D_MODEL = 1024
BATCH = 8
SEQ = 4096
DEPTH = 1

MIX_WIDTH = D_MODEL
DIFF_WIDTH = MIX_WIDTH // 2
GMLP_WIDTH = MIX_WIDTH - DIFF_WIDTH
DIFF_HEADS = 4
DIFF_HEAD_DIM = DIFF_WIDTH // (2 * DIFF_HEADS)
QK_WIDTH = DIFF_HEADS * DIFF_HEAD_DIM
GMLP_GROUPS = 8
GMLP_GROUP_DIM = GMLP_WIDTH // GMLP_GROUPS
CHUNK = 128
Q_BLOCK = 128
IN_WIDTH = 4 * QK_WIDTH + DIFF_WIDTH + 2 * GMLP_WIDTH
N_EXPERTS = 32
TOP_K = 4
D_FF = D_MODEL
SWIGLU_LIMIT = 7.0
SWIGLU_ALPHA = 1.702
EXPERT_BLOCK = 128
LN_EPS = 1e-5
DEEPNORM_ALPHA = (2.0 * DEPTH) ** 0.25
DEEPNORM_BETA = (8.0 * DEPTH) ** -0.25

kernel_name = "hybrid_diffattn_gmlp_moe_deepnorm"


def layer_norm(x, g, b):
    xf = x.astype(jnp.float32)
    mu = jnp.mean(xf, axis=-1, keepdims=True)
    var = jnp.mean(jnp.square(xf - mu), axis=-1, keepdims=True)
    return ((xf - mu) * lax.rsqrt(var + LN_EPS)).astype(x.dtype) * g + b


def rms_norm(x, g):
    xf = x.astype(jnp.float32)
    ms = jnp.mean(jnp.square(xf), axis=-1, keepdims=True)
    return (xf * lax.rsqrt(ms + LN_EPS)).astype(x.dtype) * g


def diff_attention(q1, q2, k1, k2, v, lam):
    B, S, H, Dh = q1.shape
    nb = S // Q_BLOCK
    scale = Dh ** -0.5
    kpos = jnp.arange(S)
    lam32 = lam.astype(jnp.float32)

    def to_blocks(q):
        return q.reshape(B, nb, Q_BLOCK, H, Dh).transpose(1, 0, 2, 3, 4)

    def one_block(args):
        q1b, q2b, bi = args
        qpos = bi * Q_BLOCK + jnp.arange(Q_BLOCK)
        causal = kpos[None, :] <= qpos[:, None]

        def probs(qb, k):
            s = jnp.einsum('bqhd,bkhd->bhqk', qb, k).astype(jnp.float32) * scale
            return jax.nn.softmax(jnp.where(causal, s, -jnp.inf), axis=-1)

        a = probs(q1b, k1) - lam32 * probs(q2b, k2)
        return jnp.einsum('bhqk,bkhe->bqhe', a.astype(v.dtype), v)

    out = lax.map(one_block, (to_blocks(q1), to_blocks(q2), jnp.arange(nb)))
    return out.transpose(1, 0, 2, 3, 4).reshape(B, S, H, v.shape[-1])


def spatial_gating(gu, gv, ln_g, ln_b, w_s, b_s):
    B, S, _ = gu.shape
    u = jax.nn.gelu(gu, approximate=False)
    v = layer_norm(jax.nn.gelu(gv, approximate=False), ln_g, ln_b)
    vc = v.reshape(B, S // CHUNK, CHUNK, GMLP_GROUPS, GMLP_GROUP_DIM)
    causal = jnp.tril(jnp.ones((CHUNK, CHUNK), dtype=bool))
    w = jnp.where(causal[None], w_s, jnp.zeros_like(w_s))
    z = jnp.einsum('gts,bcsgd->bctgd', w, vc) + b_s.T[None, None, :, :, None]
    return u * z.reshape(B, S, GMLP_WIDTH)


def token_mixer(x, w_in, lq1, lk1, lq2, lk2, subln_g, gln_g, gln_b, w_s, b_s, w_o, lambda_init):
    B, S, _ = x.shape
    proj = x @ w_in
    cuts = [QK_WIDTH, 2 * QK_WIDTH, 3 * QK_WIDTH, 4 * QK_WIDTH,
            4 * QK_WIDTH + DIFF_WIDTH, 4 * QK_WIDTH + DIFF_WIDTH + GMLP_WIDTH]
    q1, q2, k1, k2, v, gu, gv = jnp.split(proj, cuts, axis=-1)
    heads = lambda t: t.reshape(B, S, DIFF_HEADS, -1)
    lam = jnp.exp(jnp.sum(lq1 * lk1)) - jnp.exp(jnp.sum(lq2 * lk2)) + lambda_init
    attn = diff_attention(heads(q1), heads(q2), heads(k1), heads(k2), heads(v), lam)
    attn = (rms_norm(attn, subln_g) * (1.0 - lambda_init)).reshape(B, S, DIFF_WIDTH)
    gated = spatial_gating(gu, gv, gln_g, gln_b, w_s, b_s)
    return jnp.concatenate([attn, gated], axis=-1) @ w_o


def moe_ffn(x, w_router, b_router, w_up, b_up, w_down, b_down):
    B, S, D = x.shape
    N = B * S
    A = N * TOP_K
    P = A + N_EXPERTS * EXPERT_BLOCK
    nblk = P // EXPERT_BLOCK
    xt = x.reshape(N, D)
    logits = xt @ w_router + b_router
    topv, topi = lax.top_k(logits, TOP_K)
    gates = jax.nn.softmax(topv.astype(jnp.float32), axis=-1).astype(x.dtype)

    flat_e = topi.reshape(A)
    flat_tok = jnp.repeat(jnp.arange(N, dtype=jnp.int32), TOP_K)
    flat_g = gates.reshape(A)
    order = jnp.argsort(flat_e, stable=True)
    sorted_e = flat_e[order]
    sorted_tok = flat_tok[order]
    sorted_g = flat_g[order]

    counts = jnp.bincount(flat_e, length=N_EXPERTS)
    padded = ((counts + EXPERT_BLOCK - 1) // EXPERT_BLOCK) * EXPERT_BLOCK
    start_sorted = jnp.cumsum(counts) - counts
    end_padded = jnp.cumsum(padded)
    start_padded = end_padded - padded
    rank = jnp.arange(A) - start_sorted[sorted_e]
    dest = start_padded[sorted_e] + rank

    tok_pad = jnp.zeros((P,), jnp.int32).at[dest].set(sorted_tok)
    x_blocks = xt[tok_pad].reshape(nblk, EXPERT_BLOCK, D)
    blk_start = jnp.arange(nblk) * EXPERT_BLOCK
    blk_expert = jnp.clip(jnp.searchsorted(end_padded, blk_start, side='right'), 0, N_EXPERTS - 1)

    def expert_block(args):
        xb, e = args
        h = xb @ w_up[e] + b_up[e]
        gate, lin = h[:, :D_FF], h[:, D_FF:]
        gate = jnp.minimum(gate, SWIGLU_LIMIT)
        lin = jnp.clip(lin, -SWIGLU_LIMIT, SWIGLU_LIMIT)
        act = (lin + 1.0) * gate * jax.nn.sigmoid(SWIGLU_ALPHA * gate)
        return act @ w_down[e] + b_down[e]

    y_pad = lax.map(expert_block, (x_blocks, blk_expert)).reshape(P, D)
    y_assign = y_pad[dest] * sorted_g[:, None]
    out = jax.ops.segment_sum(y_assign, sorted_tok, num_segments=N)
    return out.reshape(B, S, D)


def setup_inputs(seed: int = 0) -> dict:
    key = jax.random.key(seed)
    ks = jax.random.split(key, 24)
    L = DEPTH
    nrm = lambda k, shape, s: jax.random.normal(k, shape, jnp.float32) * s
    tril = jnp.tril(jnp.ones((CHUNK, CHUNK), jnp.float32))
    return {
        "x": nrm(ks[0], (BATCH, SEQ, D_MODEL), 1.0),
        "w_in": nrm(ks[1], (L, D_MODEL, IN_WIDTH), D_MODEL ** -0.5),
        "lambda_q1": nrm(ks[2], (L, DIFF_HEAD_DIM), 0.1),
        "lambda_k1": nrm(ks[3], (L, DIFF_HEAD_DIM), 0.1),
        "lambda_q2": nrm(ks[4], (L, DIFF_HEAD_DIM), 0.1),
        "lambda_k2": nrm(ks[5], (L, DIFF_HEAD_DIM), 0.1),
        "subln_g": 1.0 + nrm(ks[6], (L, 2 * DIFF_HEAD_DIM), 0.01),
        "gmlp_ln_g": 1.0 + nrm(ks[7], (L, GMLP_WIDTH), 0.01),
        "gmlp_ln_b": nrm(ks[8], (L, GMLP_WIDTH), 0.01),
        "w_spatial": nrm(ks[9], (L, GMLP_GROUPS, CHUNK, CHUNK), CHUNK ** -0.5) * tril,
        "b_spatial": 1.0 + nrm(ks[10], (L, GMLP_GROUPS, CHUNK), 0.01),
        "w_o": nrm(ks[11], (L, MIX_WIDTH, D_MODEL), MIX_WIDTH ** -0.5 * DEEPNORM_BETA),
        "ln1_g": 1.0 + nrm(ks[12], (L, D_MODEL), 0.01),
        "ln1_b": nrm(ks[13], (L, D_MODEL), 0.01),
        "w_router": nrm(ks[14], (L, D_MODEL, N_EXPERTS), D_MODEL ** -0.5),
        "b_router": nrm(ks[15], (L, N_EXPERTS), 0.01),
        "w_up": nrm(ks[16], (L, N_EXPERTS, D_MODEL, 2 * D_FF), D_MODEL ** -0.5),
        "b_up": nrm(ks[17], (L, N_EXPERTS, 2 * D_FF), 0.01),
        "w_down": nrm(ks[18], (L, N_EXPERTS, D_FF, D_MODEL), D_FF ** -0.5 * DEEPNORM_BETA),
        "b_down": nrm(ks[19], (L, N_EXPERTS, D_MODEL), 0.01),
        "ln2_g": 1.0 + nrm(ks[20], (L, D_MODEL), 0.01),
        "ln2_b": nrm(ks[21], (L, D_MODEL), 0.01),
    }


def reference(x, w_in, lambda_q1, lambda_k1, lambda_q2, lambda_k2, subln_g, gmlp_ln_g, gmlp_ln_b,
              w_spatial, b_spatial, w_o, ln1_g, ln1_b, w_router, b_router, w_up, b_up,
              w_down, b_down, ln2_g, ln2_b):
    for l in range(DEPTH):
        lambda_init = 0.8 - 0.6 * math.exp(-0.3 * l)
        mixed = token_mixer(x, w_in[l], lambda_q1[l], lambda_k1[l], lambda_q2[l], lambda_k2[l],
                            subln_g[l], gmlp_ln_g[l], gmlp_ln_b[l], w_spatial[l], b_spatial[l],
                            w_o[l], lambda_init)
        x = layer_norm(DEEPNORM_ALPHA * x + mixed, ln1_g[l], ln1_b[l])
        ffn = moe_ffn(x, w_router[l], b_router[l], w_up[l], b_up[l], w_down[l], b_down[l])
        x = layer_norm(DEEPNORM_ALPHA * x + ffn, ln2_g[l], ln2_b[l])
    return x
```

```cpp
#include <hip/hip_runtime.h>
#include <cstdint>
#include <cstdio>

namespace cfg {
constexpr int BATCH = 8, SEQ = 4096, NTOK = BATCH * SEQ, DM = 1024;
constexpr int INW = 2560, NH = 4, DH = 64, DV = 128;
constexpr int C_Q = 0, C_K = 512, C_V = 1024, C_GU = 1536, C_GV = 2048;
constexpr int GW = 512, NG = 8, GD = 64, CHUNK = 128;
constexpr int NE = 32, TOPK = 4, DFF = 1024;
constexpr int PADROWS = 139264;
constexpr float LN_EPS = 1e-5f;
constexpr float ALPHA = 1.189207115002721f;
constexpr float LAMBDA_INIT = 0.2f;
constexpr float QSCALE = 0.125f * 1.4426950408889634f;
constexpr size_t MiB = 1u << 20;
constexpr size_t WS_CTL = 0, CTL_BYTES = 1 * MiB;
constexpr size_t WS_LIST = 1 * MiB;
constexpr size_t WS_RE = 5 * MiB, WS_RR = 5 * MiB + 512 * 1024, WS_RG = 6 * MiB;
constexpr size_t WS_XB = 208 * MiB;
constexpr size_t WS_PROJ = 272 * MiB;
constexpr size_t WS_MIX = 432 * MiB;
constexpr size_t WS_Y = 272 * MiB;
constexpr size_t WS_H1 = 560 * MiB;
constexpr size_t WS_ACT = 688 * MiB;
constexpr size_t WS_END = 960 * MiB;
constexpr int CW_CNT = 0;
constexpr int CW_PSTART = 64;
}
using namespace cfg;
typedef uint16_t bf16_t;

__device__ __forceinline__ float bf2f(bf16_t b) { return __uint_as_float((uint32_t)b << 16); }
__device__ __forceinline__ bf16_t f2bf(float f) { uint32_t u = __float_as_uint(f); u += 0x7fffu + ((u >> 16) & 1u); return (bf16_t)(u >> 16); }
__device__ __forceinline__ float wave_sum(float v) {
#pragma unroll
    for (int o = 1; o < 64; o <<= 1) v += __shfl_xor(v, o);
    return v;
}
__device__ __forceinline__ float wave_max(float v) {
#pragma unroll
    for (int o = 1; o < 64; o <<= 1) v = fmaxf(v, __shfl_xor(v, o));
    return v;
}
__device__ __forceinline__ float gelu_exact(float x) { return 0.5f * x * (1.0f + erff(x * 0.70710678118654752f)); }

struct NArgs {
    const float* x; const float* B; const float* bias; const float* bias2;
    const bf16_t* Ab; bf16_t* Ob; float* Of; const int* ctl; const int* list;
};
template <int MODE> __global__ void __launch_bounds__(256) ngemm(NArgs a) {
    constexpr int K = 1024;
    constexpr int LDB = (MODE == 0) ? INW : (MODE == 2 ? 2048 : 1024);
    constexpr bool DUAL = (MODE == 2);
    __shared__ float As[16][68];
    __shared__ float Bs[16][64];
    __shared__ float Bs2[DUAL ? 16 : 1][64];
    const int tid = threadIdx.x, ty = tid >> 4, tx = tid & 15;
    const int row0 = blockIdx.y * 64, col0 = blockIdx.x * 64;
    const float* B = a.B; int e = 0, pst = 0, cnt = 0;
    if (MODE >= 2) {
        const int* ps = a.ctl + CW_PSTART;
        while (e < NE && row0 >= ps[e + 1]) ++e;
        if (e >= NE) return;
        pst = ps[e]; cnt = a.ctl[CW_CNT + e];
        B += (size_t)e * K * LDB;
    }
    const int ar = tid >> 2, ak = (tid & 3) * 4;
    const float* arow_f = nullptr; const bf16_t* arow_b = nullptr;
    if (MODE == 0) arow_f = a.x + (size_t)(row0 + ar) * K;
    else if (MODE == 1 || MODE == 3) arow_b = a.Ab + (size_t)(row0 + ar) * K;
    else { const int r = row0 + ar - pst; const int tok = (r < cnt) ? a.list[e * NTOK + r] : 0; arow_b = a.Ab + (size_t)tok * K; }
    const int bk = tid >> 4, bn = (tid & 15) * 4;
    float acc[4][4], acc2[4][4];
#pragma unroll
    for (int i = 0; i < 4; ++i)
#pragma unroll
        for (int j = 0; j < 4; ++j) { acc[i][j] = 0.f; acc2[i][j] = 0.f; }
    for (int k0 = 0; k0 < K; k0 += 16) {
        float av[4];
        if (MODE == 0) { const float4 t = *(const float4*)(arow_f + k0 + ak); av[0] = t.x; av[1] = t.y; av[2] = t.z; av[3] = t.w; }
        else { const uint2 t = *(const uint2*)(arow_b + k0 + ak); av[0] = bf2f((bf16_t)(t.x & 0xffff)); av[1] = bf2f((bf16_t)(t.x >> 16)); av[2] = bf2f((bf16_t)(t.y & 0xffff)); av[3] = bf2f((bf16_t)(t.y >> 16)); }
        const float4 bv = *(const float4*)(B + (size_t)(k0 + bk) * LDB + col0 + bn);
        float4 bv2 = bv;
        if (DUAL) bv2 = *(const float4*)(B + (size_t)(k0 + bk) * LDB + 1024 + col0 + bn);
        __syncthreads();
#pragma unroll
        for (int c = 0; c < 4; ++c) As[ak + c][ar] = av[c];
        *(float4*)&Bs[bk][bn] = bv;
        if (DUAL) *(float4*)&Bs2[bk][bn] = bv2;
        __syncthreads();
#pragma unroll
        for (int k = 0; k < 16; ++k) {
            const float4 a4 = *(const float4*)&As[k][ty * 4];
            const float4 b4 = *(const float4*)&Bs[k][tx * 4];
            const float aa[4] = {a4.x, a4.y, a4.z, a4.w}, bb[4] = {b4.x, b4.y, b4.z, b4.w};
#pragma unroll
            for (int i = 0; i < 4; ++i)
#pragma unroll
                for (int j = 0; j < 4; ++j) acc[i][j] = fmaf(aa[i], bb[j], acc[i][j]);
            if (DUAL) {
                const float4 c4 = *(const float4*)&Bs2[k][tx * 4];
                const float cc[4] = {c4.x, c4.y, c4.z, c4.w};
#pragma unroll
                for (int i = 0; i < 4; ++i)
#pragma unroll
                    for (int j = 0; j < 4; ++j) acc2[i][j] = fmaf(aa[i], cc[j], acc2[i][j]);
            }
        }
    }
#pragma unroll
    for (int i = 0; i < 4; ++i) {
        const int row = row0 + ty * 4 + i;
#pragma unroll
        for (int j = 0; j < 4; ++j) {
            const int col = col0 + tx * 4 + j;
            if (MODE == 0) { float v = acc[i][j]; if (col < C_K) v *= QSCALE; a.Ob[(size_t)row * INW + col] = f2bf(v); }
            else if (MODE == 1) { a.Of[(size_t)row * DM + col] = ALPHA * a.x[(size_t)row * DM + col] + acc[i][j]; }
            else if (MODE == 2) {
                float g = acc[i][j] + a.bias[e * 2048 + col], l = acc2[i][j] + a.bias[e * 2048 + 1024 + col];
                g = fminf(g, 7.0f); l = fminf(fmaxf(l, -7.0f), 7.0f);
                const float act = (l + 1.0f) * g * (1.0f / (1.0f + expf(-1.702f * g)));
                a.Ob[(size_t)row * DFF + col] = f2bf(act);
            } else { a.Ob[(size_t)row * DM + col] = f2bf(acc[i][j] + a.bias[e * DM + col]); }
        }
    }
}

__global__ void __launch_bounds__(128) nattn(const bf16_t* __restrict__ proj, bf16_t* __restrict__ mix, const float* lq1, const float* lk1, const float* lq2, const float* lk2, const float* subg) {
    __shared__ float sc[2][SEQ];
    const int w = threadIdx.x >> 6, lane = threadIdx.x & 63;
    const int task = blockIdx.x * 2 + w, t = task >> 2, h = task & 3, b = t / SEQ, qpos = t % SEQ;
    const float lam = expf(wave_sum(lq1[lane] * lk1[lane])) - expf(wave_sum(lq2[lane] * lk2[lane])) + LAMBDA_INIT;
    const bf16_t* pb = proj + (size_t)b * SEQ * INW;
    float o[2][2];
    for (int s = 0; s < 2; ++s) {
        float q[DH];
        const bf16_t* qp = proj + (size_t)t * INW + C_Q + s * 256 + h * DH;
#pragma unroll
        for (int d = 0; d < DH; ++d) q[d] = bf2f(qp[d]);
        float m = -INFINITY;
        for (int j = lane; j <= qpos; j += 64) {
            const uint4* kp = (const uint4*)(pb + (size_t)j * INW + C_K + s * 256 + h * DH);
            float acc = 0.f;
#pragma unroll
            for (int c = 0; c < 8; ++c) {
                const uint4 kk = kp[c];
                const uint32_t ww[4] = {kk.x, kk.y, kk.z, kk.w};
#pragma unroll
                for (int z = 0; z < 4; ++z) { acc = fmaf(q[c * 8 + 2 * z], bf2f((bf16_t)(ww[z] & 0xffff)), acc); acc = fmaf(q[c * 8 + 2 * z + 1], bf2f((bf16_t)(ww[z] >> 16)), acc); }
            }
            sc[w][j] = acc; m = fmaxf(m, acc);
        }
        m = wave_max(m);
        float l = 0.f;
        for (int j = lane; j <= qpos; j += 64) { const float p = exp2f(sc[w][j] - m); sc[w][j] = p; l += p; }
        l = wave_sum(l);
        __syncthreads();
        float o0 = 0.f, o1 = 0.f;
        const bf16_t* vp = pb + C_V + h * DV + lane * 2;
        for (int j = 0; j <= qpos; ++j) {
            const float p = sc[w][j];
            const uint32_t vv = *(const uint32_t*)(vp + (size_t)j * INW);
            o0 = fmaf(p, bf2f((bf16_t)(vv & 0xffff)), o0); o1 = fmaf(p, bf2f((bf16_t)(vv >> 16)), o1);
        }
        o[s][0] = o0 / l; o[s][1] = o1 / l;
        __syncthreads();
    }
    const float d0 = o[0][0] - lam * o[1][0], d1 = o[0][1] - lam * o[1][1];
    const float ss = wave_sum(d0 * d0 + d1 * d1);
    const float r = rsqrtf(ss * (1.0f / DV) + LN_EPS) * (1.0f - LAMBDA_INIT);
    const uint32_t pk = (uint32_t)f2bf(d0 * r * subg[lane * 2]) | ((uint32_t)f2bf(d1 * r * subg[lane * 2 + 1]) << 16);
    *(uint32_t*)(mix + (size_t)t * DM + h * DV + lane * 2) = pk;
}

__global__ void __launch_bounds__(256) ngmlp(const bf16_t* __restrict__ proj, bf16_t* __restrict__ mix, const float* lng, const float* lnb, const float* wsp, const float* bsp) {
    __shared__ float mu[CHUNK], rs[CHUNK];
    __shared__ float vn[CHUNK][GD];
    const int c = blockIdx.x, g = blockIdx.y, tid = threadIdx.x, w = tid >> 6, lane = tid & 63;
    const size_t row0 = (size_t)c * CHUNK;
    for (int s = w; s < CHUNK; s += 4) {
        const bf16_t* p = proj + (row0 + s) * INW + C_GV;
        float v[8]; float sum = 0.f;
#pragma unroll
        for (int i = 0; i < 8; ++i) { v[i] = gelu_exact(bf2f(p[lane + 64 * i])); sum += v[i]; }
        const float mean = wave_sum(sum) * (1.0f / GW); float q = 0.f;
#pragma unroll
        for (int i = 0; i < 8; ++i) { const float d = v[i] - mean; q += d * d; }
        const float var = wave_sum(q) * (1.0f / GW);
        if (lane == 0) { mu[s] = mean; rs[s] = rsqrtf(var + LN_EPS); }
    }
    __syncthreads();
    for (int i = tid; i < CHUNK * GD; i += 256) {
        const int s = i >> 6, d = i & 63, col = g * GD + d;
        const float v = gelu_exact(bf2f(proj[(row0 + s) * INW + C_GV + col]));
        vn[s][d] = (v - mu[s]) * rs[s] * lng[col] + lnb[col];
    }
    __syncthreads();
    const int t = tid >> 1, dh = (tid & 1) * 32;
    float z[32];
#pragma unroll
    for (int d = 0; d < 32; ++d) z[d] = 0.f;
    const float* wr = wsp + ((size_t)g * CHUNK + t) * CHUNK;
    for (int s = 0; s <= t; ++s) {
        const float wv = wr[s];
#pragma unroll
        for (int d = 0; d < 32; ++d) z[d] = fmaf(wv, vn[s][dh + d], z[d]);
    }
    const float bb = bsp[g * CHUNK + t];
#pragma unroll
    for (int d = 0; d < 32; ++d) {
        const int col = g * GD + dh + d;
        const float u = gelu_exact(bf2f(proj[(row0 + t) * INW + C_GU + col]));
        mix[(row0 + t) * DM + GW + col] = f2bf(u * (z[d] + bb));
    }
}

__global__ void __launch_bounds__(256) nroute(float* __restrict__ h1, bf16_t* __restrict__ xb, const float* g1, const float* b1, const float* wr, const float* br, int* ctl, int* list, int* re, int* rr, float* rg) {
    const int w = threadIdx.x >> 6, lane = threadIdx.x & 63, t = blockIdx.x * 4 + w;
    float* row = h1 + (size_t)t * DM;
    float v[16]; float s = 0.f;
#pragma unroll
    for (int j = 0; j < 4; ++j) { const float4 q = *(const float4*)(row + j * 256 + lane * 4); v[4 * j] = q.x; v[4 * j + 1] = q.y; v[4 * j + 2] = q.z; v[4 * j + 3] = q.w; s += (q.x + q.y) + (q.z + q.w); }
    const float mean = wave_sum(s) * (1.0f / DM); float q2 = 0.f;
#pragma unroll
    for (int i = 0; i < 16; ++i) { v[i] -= mean; q2 += v[i] * v[i]; }
    const float rstd = rsqrtf(wave_sum(q2) * (1.0f / DM) + LN_EPS);
#pragma unroll
    for (int j = 0; j < 4; ++j) {
        const int col = j * 256 + lane * 4;
#pragma unroll
        for (int c = 0; c < 4; ++c) v[4 * j + c] = v[4 * j + c] * rstd * g1[col + c] + b1[col + c];
        *(float4*)(row + col) = make_float4(v[4 * j], v[4 * j + 1], v[4 * j + 2], v[4 * j + 3]);
        uint2 pk; pk.x = (uint32_t)f2bf(v[4 * j]) | ((uint32_t)f2bf(v[4 * j + 1]) << 16); pk.y = (uint32_t)f2bf(v[4 * j + 2]) | ((uint32_t)f2bf(v[4 * j + 3]) << 16);
        *(uint2*)(xb + (size_t)t * DM + col) = pk;
    }
    float lg[NE];
#pragma unroll
    for (int e = 0; e < NE; ++e) lg[e] = 0.f;
#pragma unroll
    for (int j = 0; j < 4; ++j)
#pragma unroll
        for (int c = 0; c < 4; ++c) {
            const float xv = v[4 * j + c]; const float4* wp = (const float4*)(wr + (size_t)(j * 256 + lane * 4 + c) * NE);
#pragma unroll
            for (int e4 = 0; e4 < 8; ++e4) { const float4 ww = wp[e4]; lg[4 * e4] = fmaf(xv, ww.x, lg[4 * e4]); lg[4 * e4 + 1] = fmaf(xv, ww.y, lg[4 * e4 + 1]); lg[4 * e4 + 2] = fmaf(xv, ww.z, lg[4 * e4 + 2]); lg[4 * e4 + 3] = fmaf(xv, ww.w, lg[4 * e4 + 3]); }
        }
#pragma unroll
    for (int e = 0; e < NE; ++e) lg[e] = wave_sum(lg[e]) + br[e];
    int idx[4]; float val[4]; unsigned taken = 0u;
#pragma unroll
    for (int k = 0; k < 4; ++k) {
        float best = -INFINITY; int bi = 0;
#pragma unroll
        for (int e = 0; e < NE; ++e) { const bool ok = !((taken >> e) & 1u) && lg[e] > best; best = ok ? lg[e] : best; bi = ok ? e : bi; }
        idx[k] = bi; val[k] = best; taken |= 1u << bi;
    }
    float ex[4], se = 0.f;
#pragma unroll
    for (int k = 0; k < 4; ++k) { ex[k] = expf(val[k] - val[0]); se += ex[k]; }
    if (lane == 0) {
#pragma unroll
        for (int k = 0; k < 4; ++k) {
            const int r = atomicAdd(ctl + CW_CNT + idx[k], 1);
            list[idx[k] * NTOK + r] = t;
            re[t * 4 + k] = idx[k]; rr[t * 4 + k] = r; rg[t * 4 + k] = ex[k] / se;
        }
    }
}
__global__ void npstart(int* ctl) {
    if (threadIdx.x == 0 && blockIdx.x == 0) { int p = 0; for (int e = 0; e < NE; ++e) { ctl[CW_PSTART + e] = p; p += ((ctl[CW_CNT + e] + 255) / 256) * 256; } ctl[CW_PSTART + NE] = p; }
}
__global__ void __launch_bounds__(256) ncombine(const float* __restrict__ x1, const bf16_t* __restrict__ y, const int* ctl, const int* re, const int* rr, const float* rg, const float* g2, const float* b2, float* __restrict__ out) {
    const int w = threadIdx.x >> 6, lane = threadIdx.x & 63, t = blockIdx.x * 4 + w;
    float v[16];
#pragma unroll
    for (int j = 0; j < 4; ++j) { const float4 q = *(const float4*)(x1 + (size_t)t * DM + j * 256 + lane * 4); v[4 * j] = ALPHA * q.x; v[4 * j + 1] = ALPHA * q.y; v[4 * j + 2] = ALPHA * q.z; v[4 * j + 3] = ALPHA * q.w; }
#pragma unroll
    for (int k = 0; k < 4; ++k) {
        const int e = re[t * 4 + k], slot = ctl[CW_PSTART + e] + rr[t * 4 + k]; const float g = rg[t * 4 + k];
        const bf16_t* yr = y + (size_t)slot * DM;
#pragma unroll
        for (int j = 0; j < 4; ++j) { const uint2 pk = *(const uint2*)(yr + j * 256 + lane * 4);
            v[4 * j] = fmaf(g, bf2f((bf16_t)(pk.x & 0xffff)), v[4 * j]); v[4 * j + 1] = fmaf(g, bf2f((bf16_t)(pk.x >> 16)), v[4 * j + 1]);
            v[4 * j + 2] = fmaf(g, bf2f((bf16_t)(pk.y & 0xffff)), v[4 * j + 2]); v[4 * j + 3] = fmaf(g, bf2f((bf16_t)(pk.y >> 16)), v[4 * j + 3]); }
    }
    float s = 0.f;
#pragma unroll
    for (int i = 0; i < 16; ++i) s += v[i];
    const float mean = wave_sum(s) * (1.0f / DM); float q2 = 0.f;
#pragma unroll
    for (int i = 0; i < 16; ++i) { v[i] -= mean; q2 += v[i] * v[i]; }
    const float rstd = rsqrtf(wave_sum(q2) * (1.0f / DM) + LN_EPS);
#pragma unroll
    for (int j = 0; j < 4; ++j) { const int col = j * 256 + lane * 4;
        *(float4*)(out + (size_t)t * DM + col) = make_float4(v[4 * j] * rstd * g2[col] + b2[col], v[4 * j + 1] * rstd * g2[col + 1] + b2[col + 1], v[4 * j + 2] * rstd * g2[col + 2] + b2[col + 2], v[4 * j + 3] * rstd * g2[col + 3] + b2[col + 3]); }
}

extern "C" void kernel_launch(void* const* d_in, const int* in_sizes, int n_in, void* d_out, int out_size, void* d_ws, size_t ws_size, hipStream_t stream) {
    if (n_in != 22 || in_sizes[0] != NTOK * DM || out_size != NTOK * DM || ws_size < WS_END) { fprintf(stderr, "kernel_launch: unexpected shapes (n_in %d, in0 %d, out %d, ws %zu)\n", n_in, n_in > 0 ? in_sizes[0] : -1, out_size, ws_size); return; }
    const float* x = (const float*)d_in[0]; const float* w_in = (const float*)d_in[1];
    const float *lq1 = (const float*)d_in[2], *lk1 = (const float*)d_in[3], *lq2 = (const float*)d_in[4], *lk2 = (const float*)d_in[5];
    const float *subg = (const float*)d_in[6], *glng = (const float*)d_in[7], *glnb = (const float*)d_in[8], *wsp = (const float*)d_in[9], *bsp = (const float*)d_in[10];
    const float *w_o = (const float*)d_in[11], *ln1g = (const float*)d_in[12], *ln1b = (const float*)d_in[13], *w_r = (const float*)d_in[14], *b_r = (const float*)d_in[15];
    const float *w_up = (const float*)d_in[16], *b_up = (const float*)d_in[17], *w_dn = (const float*)d_in[18], *b_dn = (const float*)d_in[19], *ln2g = (const float*)d_in[20], *ln2b = (const float*)d_in[21];
    unsigned char* ws = (unsigned char*)d_ws;
    int* ctl = (int*)(ws + WS_CTL); int* list = (int*)(ws + WS_LIST); int* re = (int*)(ws + WS_RE); int* rr = (int*)(ws + WS_RR); float* rg = (float*)(ws + WS_RG);
    bf16_t* xb = (bf16_t*)(ws + WS_XB); bf16_t* proj = (bf16_t*)(ws + WS_PROJ); bf16_t* mix = (bf16_t*)(ws + WS_MIX); bf16_t* yb = (bf16_t*)(ws + WS_Y);
    float* h1 = (float*)(ws + WS_H1); bf16_t* act = (bf16_t*)(ws + WS_ACT);
    (void)hipMemsetAsync(ws + WS_CTL, 0, CTL_BYTES, stream);
    { NArgs a{}; a.x = x; a.B = w_in; a.Ob = proj; ngemm<0><<<dim3(INW / 64, NTOK / 64), 256, 0, stream>>>(a); }
    nattn<<<NTOK * NH / 2, 128, 0, stream>>>(proj, mix, lq1, lk1, lq2, lk2, subg);
    ngmlp<<<dim3(NTOK / CHUNK, NG), 256, 0, stream>>>(proj, mix, glng, glnb, wsp, bsp);
    { NArgs a{}; a.x = x; a.B = w_o; a.Ab = mix; a.Of = h1; ngemm<1><<<dim3(DM / 64, NTOK / 64), 256, 0, stream>>>(a); }
    nroute<<<NTOK / 4, 256, 0, stream>>>(h1, xb, ln1g, ln1b, w_r, b_r, ctl, list, re, rr, rg);
    npstart<<<1, 64, 0, stream>>>(ctl);
    { NArgs a{}; a.B = w_up; a.bias = b_up; a.Ab = xb; a.Ob = act; a.ctl = ctl; a.list = list; ngemm<2><<<dim3(DFF / 64, PADROWS / 64), 256, 0, stream>>>(a); }
    { NArgs a{}; a.B = w_dn; a.bias = b_dn; a.Ab = act; a.Ob = yb; a.ctl = ctl; a.list = list; ngemm<3><<<dim3(DM / 64, PADROWS / 64), 256, 0, stream>>>(a); }
    ncombine<<<NTOK / 4, 256, 0, stream>>>(h1, yb, ctl, re, rr, rg, ln2g, ln2b, (float*)d_out);
}
```

```cpp
#include <hip/hip_runtime.h>
#include <hip/hip_bf16.h>
#include <cstdint>
#include <cstdio>
#include <cmath>

namespace cfg {
constexpr int BATCH = 8, SEQ = 4096, NTOK = BATCH * SEQ, DM = 1024;
constexpr int INW = 2560, NH = 4, DH = 64, DV = 128;
constexpr int C_Q = 0, C_K = 512, C_V = 1024, C_GU = 1536, C_GV = 2048;
constexpr int GW = 512, NG = 8, GD = 64, CHUNK = 128;
constexpr int NE = 32, TOPK = 4, DFF = 1024;
constexpr int PADROWS = 139264;
constexpr float LN_EPS = 1e-5f;
constexpr float ALPHA = 1.189207115002721f;
constexpr float LAMBDA_INIT = 0.2f;
constexpr float QSCALE = 0.125f * 1.4426950408889634f;
constexpr size_t MiB = 1u << 20;
constexpr size_t WS_CTL = 0, CTL_BYTES = 1 * MiB;
constexpr size_t WS_LIST = 1 * MiB;
constexpr size_t WS_RE = 5 * MiB, WS_RR = 5 * MiB + 512 * 1024, WS_RG = 6 * MiB;
constexpr size_t WS_WIN = 8 * MiB;
constexpr size_t WS_WO = 13 * MiB;
constexpr size_t WS_WUP = 16 * MiB;
constexpr size_t WS_WDN = 144 * MiB;
constexpr size_t WS_XB = 208 * MiB;
constexpr size_t WS_PROJ = 272 * MiB;
constexpr size_t WS_MIX = 432 * MiB;
constexpr size_t WS_ATTO = 496 * MiB;
constexpr size_t WS_Y = 272 * MiB;
constexpr size_t WS_H1 = 560 * MiB;
constexpr size_t WS_ACT = 688 * MiB;
constexpr size_t WS_END = 960 * MiB;
constexpr int CW_CNT = 0;
constexpr int CW_PSTART = 64;
constexpr int CW_BAR = 4096;
}
using namespace cfg;
typedef uint16_t bf16_t;

__device__ __forceinline__ float bf2f(bf16_t b) { return __uint_as_float((uint32_t)b << 16); }
__device__ __forceinline__ bf16_t f2bf(float f) { uint32_t u = __float_as_uint(f); u += 0x7fffu + ((u >> 16) & 1u); return (bf16_t)(u >> 16); }
__device__ __forceinline__ uint32_t pk2(float lo, float hi) { return (uint32_t)f2bf(lo) | ((uint32_t)f2bf(hi) << 16); }
__device__ __forceinline__ float wave_sum(float v) {
#pragma unroll
    for (int o = 1; o < 64; o <<= 1) v += __shfl_xor(v, o);
    return v;
}
__device__ __forceinline__ float wave_max(float v) {
#pragma unroll
    for (int o = 1; o < 64; o <<= 1) v = fmaxf(v, __shfl_xor(v, o));
    return v;
}
__device__ __forceinline__ float gelu_exact(float x) { return 0.5f * x * (1.0f + erff(x * 0.70710678118654752f)); }

#define OPT_MASK 0x1FF
#define FUSED 1
namespace pg8 {
#define PG8_LAS __attribute__((address_space(3)))
typedef short bf16x8 __attribute__((ext_vector_type(8)));
typedef float f32x4 __attribute__((ext_vector_type(4)));
typedef float f32x2 __attribute__((ext_vector_type(2)));
typedef unsigned u32x4 __attribute__((ext_vector_type(4)));
constexpr int BM = 256, BK = 64, HALF = 128, HTB = HALF * BK * 2  , STAGE_BYTES = 8 * HTB, NXCD = 8, WGM = 8;

__host__ __device__ __forceinline__ int lds_byte(int r, int c) { const int st = (r >> 4) * 2 + (c >> 5), rr = r & 15, cc = c & 31, ob = rr * 64 + cc * 2; return st * 1024 + (ob ^ (((ob >> 9) & 1) << 5)); }
__host__ __device__ __forceinline__ void stage_rc(int b, int& R, int& C) { const int st = b / 1024, sb = b % 1024, swz = sb ^ (((sb >> 9) & 1) << 5); R = (st >> 1) * 16 + swz / 64; C = (st & 1) * 32 + (swz % 64) / 2; }
__host__ __device__ __forceinline__ int perm32(int rho) { const int n = rho >> 4, i = rho & 15; return 8 * (i >> 2) + 4 * n + (i & 3); }

struct Unit { int pm, pn, e; };
struct Gemm { const bf16_t* A; const bf16_t* Bt; int M, N, K; size_t strideB; };

struct StaticOrder {
    int nM, nN, nwg, G, c;
    __host__ __device__ void init(int M, int N, int G_, int c_) { nM = M / BM; nN = N / BM; nwg = nM * nN; G = G_; c = c_; }
    __host__ __device__ bool next(int i, Unit& u) const {
        const long L = (long)i * G + c; if (L >= nwg) return false;
        int wgid = (int)L; { const int q = nwg / NXCD, r = nwg % NXCD, xcd = wgid % NXCD, off = wgid / NXCD; wgid = (xcd < r ? xcd * (q + 1) : r * (q + 1) + (xcd - r) * q) + off; }
        const int nig = WGM * nN, gid = wgid / nig, fm = gid * WGM, gsz = (nM - fm) < WGM ? (nM - fm) : WGM;
        u.pm = fm + ((wgid % nig) % gsz); u.pn = (wgid % nig) / gsz; u.e = 0; return true;
    }
    __device__ __forceinline__ void gather(const Unit&, const int (&)[2], const int (&)[2], unsigned (&)[2][2]) const {}
};
struct MoeOrder {
    const PG8_LAS int* tab; const int* list; int NC, RG, chunk0, nrt, j0;
    __device__ __forceinline__ void init(const PG8_LAS int* tab_, const int* list_, int NC_, int bid) {
        tab = tab_; list = list_; NC = NC_; RG = 32 / NC_; const int x = bid & 7; j0 = bid >> 3;
        const int T = __builtin_amdgcn_readfirstlane(tab_[32]); chunk0 = (T * x) / 8; nrt = (T * (x + 1)) / 8 - chunk0;
    }
    __device__ __forceinline__ bool next(int i, Unit& u) const {
        const int pml = i * RG + (j0 % RG); if (pml >= nrt) return false;
        u.pm = chunk0 + pml; u.pn = j0 / RG; int e = 0;
        while (e < NE - 1 && u.pm >= __builtin_amdgcn_readfirstlane(tab[e + 1])) ++e;
        u.e = e; return true;
    }
    __device__ __forceinline__ void gather(const Unit& u, const int (&RA)[2], const int (&CA2)[2], unsigned (&go)[2][2]) const {
        const int r0 = (u.pm - __builtin_amdgcn_readfirstlane(tab[u.e])) * BM, cnt = __builtin_amdgcn_readfirstlane(tab[40 + u.e]);
#pragma unroll
        for (int h = 0; h < 2; ++h)
#pragma unroll
            for (int i = 0; i < 2; ++i) { const int r = r0 + h * HALF + RA[i]; const int tok = (r < cnt) ? list[u.e * NTOK + r] : 0; go[h][i] = (unsigned)tok * (unsigned)(DM * 2) + (unsigned)CA2[i]; }
    }
};

__device__ __forceinline__ unsigned cvt_pk_bf16(float lo, float hi) { unsigned r; asm volatile("v_cvt_pk_bf16_f32 %0, %1, %2" : "=v"(r) : "v"(lo), "v"(hi)); return r; }
__device__ __forceinline__ f32x2 gelu_pk(f32x2 v) {
    const f32x2 av = __builtin_elementwise_abs(v), d = av * 0.2316418882f + 1.0f;
    f32x2 t; t.x = __builtin_amdgcn_rcpf(d.x); t.y = __builtin_amdgcn_rcpf(d.y);
    f32x2 q = t * 0.5307027145f + (-0.7265760135f); q = q * t + 0.7107068705f; q = q * t + (-0.142248368f); q = q * t + 0.127414796f; q = q * t;
    const f32x2 s = (v * v) * (-0.72134752044f);
    f32x2 e; e.x = __builtin_amdgcn_exp2f(s.x); e.y = __builtin_amdgcn_exp2f(s.y);
    const f32x2 m = v * (q * e), r = v - m;
    f32x2 o; o.x = v.x < 0.f ? m.x : r.x; o.y = v.y < 0.f ? m.y : r.y; return o;
}
__device__ __forceinline__ float gelu1(float v) { return gelu_pk((f32x2){v, v}).x; }

struct EpiProj {
    static constexpr bool PERM = true;
    bf16_t* O;
    __device__ __forceinline__ void operator()(const f32x4 (&acc)[2][2][4][2], const Unit& u, int wr, int wc, int fr, int fq) const {
        const int row0 = u.pm * BM + wr * 64 + fr, col0 = u.pn * BM + wc * 32 + 8 * fq; const float sc = (u.pn < 2) ? QSCALE : 1.0f;
#pragma unroll
        for (int ai = 0; ai < 2; ++ai)
#pragma unroll
            for (int m = 0; m < 4; ++m) { bf16_t* rowp = O + (size_t)(row0 + ai * HALF + m * 16) * INW + col0;
#pragma unroll
                for (int bj = 0; bj < 2; ++bj) { const f32x4 v0 = acc[ai][bj][m][0] * sc, v1 = acc[ai][bj][m][1] * sc;
                    u32x4 w; w.x = cvt_pk_bf16(v0[0], v0[1]); w.y = cvt_pk_bf16(v0[2], v0[3]); w.z = cvt_pk_bf16(v1[0], v1[1]); w.w = cvt_pk_bf16(v1[2], v1[3]);
                    *(u32x4*)(rowp + bj * HALF) = w; } }
    }
};
struct EpiH1 {
    static constexpr bool PERM = false;
    const float* X; float* C;
    __device__ __forceinline__ void operator()(const f32x4 (&acc)[2][2][4][2], const Unit& u, int wr, int wc, int fr, int fq) const {
        const int row0 = u.pm * BM + wr * 64 + fr, col0 = u.pn * BM + wc * 32 + 4 * fq;
#pragma unroll
        for (int ai = 0; ai < 2; ++ai)
#pragma unroll
            for (int m = 0; m < 4; ++m) { const size_t off = (size_t)(row0 + ai * HALF + m * 16) * DM + col0;
#pragma unroll
                for (int bj = 0; bj < 2; ++bj)
#pragma unroll
                    for (int n = 0; n < 2; ++n) { const f32x4 xv = *(const f32x4*)(X + off + bj * HALF + n * 16); *(f32x4*)(C + off + bj * HALF + n * 16) = xv * ALPHA + acc[ai][bj][m][n]; } }
    }
};
struct EpiSwiglu {
    static constexpr bool PERM = true;
    bf16_t* O; const float* bias;
    __device__ __forceinline__ void operator()(const f32x4 (&acc)[2][2][4][2], const Unit& u, int wr, int wc, int fr, int fq) const {
        const int row0 = u.pm * BM + wr * 64 + fr, col0 = u.pn * HALF + wc * 32 + 8 * fq;
        const float* bp = bias + (size_t)u.e * (2 * DFF) + col0;
        f32x4 bg[2], bl[2];
#pragma unroll
        for (int n = 0; n < 2; ++n) { bg[n] = *(const f32x4*)(bp + 4 * n); bl[n] = *(const f32x4*)(bp + DFF + 4 * n); }
#pragma unroll
        for (int ai = 0; ai < 2; ++ai)
#pragma unroll
            for (int m = 0; m < 4; ++m) { float a8[8];
#pragma unroll
                for (int n = 0; n < 2; ++n) { const f32x4 g4 = acc[ai][0][m][n] + bg[n], l4 = acc[ai][1][m][n] + bl[n];
#pragma unroll
                    for (int j = 0; j < 4; ++j) { const float g = fminf(g4[j], 7.0f), l = fminf(fmaxf(l4[j], -7.0f), 7.0f);
                        const float sg = __builtin_amdgcn_rcpf(1.0f + __builtin_amdgcn_exp2f(g * (-1.702f * 1.4426950408889634f)));
                        a8[4 * n + j] = (l + 1.0f) * g * sg; } }
                u32x4 w; w.x = cvt_pk_bf16(a8[0], a8[1]); w.y = cvt_pk_bf16(a8[2], a8[3]); w.z = cvt_pk_bf16(a8[4], a8[5]); w.w = cvt_pk_bf16(a8[6], a8[7]);
                *(u32x4*)(O + (size_t)(row0 + ai * HALF + m * 16) * DFF + col0) = w; }
    }
};
struct EpiDown {
    static constexpr bool PERM = true;
    bf16_t* O; const float* bias;
    __device__ __forceinline__ void operator()(const f32x4 (&acc)[2][2][4][2], const Unit& u, int wr, int wc, int fr, int fq) const {
        const int row0 = u.pm * BM + wr * 64 + fr, col0 = u.pn * BM + wc * 32 + 8 * fq;
        const float* bp = bias + (size_t)u.e * DM + col0;
        f32x4 bv[2][2];
#pragma unroll
        for (int bj = 0; bj < 2; ++bj)
#pragma unroll
            for (int n = 0; n < 2; ++n) bv[bj][n] = *(const f32x4*)(bp + bj * HALF + 4 * n);
#pragma unroll
        for (int ai = 0; ai < 2; ++ai)
#pragma unroll
            for (int m = 0; m < 4; ++m) { bf16_t* rowp = O + (size_t)(row0 + ai * HALF + m * 16) * DM + col0;
#pragma unroll
                for (int bj = 0; bj < 2; ++bj) { const f32x4 v0 = acc[ai][bj][m][0] + bv[bj][0], v1 = acc[ai][bj][m][1] + bv[bj][1];
                    u32x4 w; w.x = cvt_pk_bf16(v0[0], v0[1]); w.y = cvt_pk_bf16(v0[2], v0[3]); w.z = cvt_pk_bf16(v1[0], v1[1]); w.w = cvt_pk_bf16(v1[2], v1[3]);
                    *(u32x4*)(rowp + bj * HALF) = w; } }
    }
};

template <class Epi, class Sched, bool GATHER>
__device__ __forceinline__ void gemm_phase(PG8_LAS unsigned char* lds, const Gemm g, const Sched& S, const Epi& E) {
    int tid_ = threadIdx.x; asm volatile("" : "+v"(tid_));
    const int tid = tid_, wid = __builtin_amdgcn_readfirstlane(tid >> 6), lane = tid & 63, wr = wid >> 2, wc = wid & 3, fr = lane & 15, fq = lane >> 4;
    const int K = g.K, nt = K / BK;
    unsigned voffB[2]; int RA[2], CA2[2]; unsigned voffA[2];
#pragma unroll
    for (int i = 0; i < 2; ++i) { int R, C; stage_rc(tid * 16 + i * 8192, R, C); const int Rb = Epi::PERM ? ((R & ~31) + perm32(R & 31)) : R;
        voffA[i] = (unsigned)(R * K + C) * 2u; voffB[i] = (unsigned)(Rb * K + C) * 2u; RA[i] = R; CA2[i] = C * 2; }
    const size_t kstep = (size_t)(BK * 2);
    const size_t hstep = (size_t)HALF * K * 2;
    const size_t tstep = 2 * hstep;
    const unsigned ldsw = (unsigned)wid * 1024u;
    const int aoff = lds_byte(wr * 64 + fr, fq * 8), boff = lds_byte(wc * 32 + fr, fq * 8);
#define PG8_SA(b, h) (((b) * 2 + (h)) * HTB)
#define PG8_SB(b, h) ((4 + (b) * 2 + (h)) * HTB)
#define PG8_GLDS(gptr, ldsoff) __builtin_amdgcn_global_load_lds((const unsigned*)(gptr), (PG8_LAS unsigned*)(lds + (ldsoff)), 16, 0, 0)
#define PG8_STAGE_B(bufoff, gbase) do { PG8_GLDS((const char*)(gbase) + voffB[0], (bufoff) + ldsw); PG8_GLDS((const char*)(gbase) + voffB[1], (bufoff) + ldsw + 8192); } while (0)
#define PG8_STAGE_A(bufoff, gbase, o0, o1) do { PG8_GLDS((const char*)(gbase) + (o0), (bufoff) + ldsw); PG8_GLDS((const char*)(gbase) + (o1), (bufoff) + ldsw + 8192); } while (0)
#define PG8_LDA(dst, b, h) do { _Pragma("unroll") for (int m = 0; m < 4; ++m) _Pragma("unroll") for (int k = 0; k < 2; ++k) dst[m][k] = *(const PG8_LAS bf16x8*)(lds + PG8_SA(b, h) + aoff + m * 2048 + k * 1024); } while (0)
#define PG8_LDB(dst, b, h) do { _Pragma("unroll") for (int n = 0; n < 2; ++n) _Pragma("unroll") for (int k = 0; k < 2; ++k) dst[n][k] = *(const PG8_LAS bf16x8*)(lds + PG8_SB(b, h) + boff + n * 2048 + k * 1024); } while (0)
#define PG8_MMA(ai, bj, At, Bt) do { __builtin_amdgcn_s_setprio(1); _Pragma("unroll") for (int m = 0; m < 4; ++m) _Pragma("unroll") for (int n = 0; n < 2; ++n) _Pragma("unroll") for (int k = 0; k < 2; ++k) \
        acc[ai][bj][m][n] = __builtin_amdgcn_mfma_f32_16x16x32_bf16(Bt[n][k], At[m][k], acc[ai][bj][m][n], 0, 0, 0); __builtin_amdgcn_s_setprio(0); } while (0)
#define PG8_WAIT_V(n) asm volatile("s_waitcnt vmcnt(" #n ")" ::: "memory")
#define PG8_WAIT_L(n) asm volatile("s_waitcnt lgkmcnt(" #n ")" ::: "memory")
#define PG8_BAR __builtin_amdgcn_s_barrier()
#define PG8_SCHED __builtin_amdgcn_sched_barrier(0)
    Unit cur, nxt; int ui = 0;
    if (!S.next(0, cur)) return;
    f32x4 acc[2][2][4][2];
#pragma unroll
    for (int a = 0; a < 2; ++a)
#pragma unroll
        for (int b = 0; b < 2; ++b)
#pragma unroll
            for (int m = 0; m < 4; ++m)
#pragma unroll
                for (int n = 0; n < 2; ++n) acc[a][b][m][n] = (f32x4){0.f, 0.f, 0.f, 0.f};
    bf16x8 At[4][2], B0[2][2], B1[2][2];
    const char* cA = GATHER ? (const char*)g.A : (const char*)g.A + (size_t)cur.pm * tstep;
    const char* cB = (const char*)g.Bt + ((size_t)cur.e * g.strideB) * 2 + (size_t)cur.pn * tstep;
    unsigned gc[2][2], gn[2][2];
    if constexpr (GATHER) { S.gather(cur, RA, CA2, gc); }
    else {
#pragma unroll
        for (int h = 0; h < 2; ++h)
#pragma unroll
            for (int i = 0; i < 2; ++i) gc[h][i] = (unsigned)(h * hstep) + voffA[i]; }
#pragma unroll
    for (int h = 0; h < 2; ++h)
#pragma unroll
        for (int i = 0; i < 2; ++i) gn[h][i] = gc[h][i];
    PG8_STAGE_B(PG8_SB(0, 0), cB); PG8_STAGE_B(PG8_SB(0, 1), cB + hstep); PG8_STAGE_A(PG8_SA(0, 0), cA, gc[0][0], gc[0][1]); PG8_STAGE_A(PG8_SA(0, 1), cA, gc[1][0], gc[1][1]);
    if (wr == 1) PG8_BAR;
    PG8_WAIT_V(2); PG8_BAR;
    PG8_STAGE_B(PG8_SB(1, 0), cB + kstep); PG8_STAGE_A(PG8_SA(1, 0), cA + kstep, gc[0][0], gc[0][1]); PG8_STAGE_B(PG8_SB(1, 1), cB + hstep + kstep);
    PG8_WAIT_V(6); PG8_BAR;
    for (;;) {
        const bool has_next = S.next(ui + 1, nxt);
        const char* nA = GATHER ? cA : (has_next ? (const char*)g.A + (size_t)nxt.pm * tstep : cA);
        const char* nB = has_next ? (const char*)g.Bt + ((size_t)nxt.e * g.strideB) * 2 + (size_t)nxt.pn * tstep : cB;
        if constexpr (GATHER) { if (has_next) S.gather(nxt, RA, CA2, gn); }
        for (int t = 0; t < nt; t += 2) {
            const bool last = (t == nt - 2);
            const char* a1 = cA + (size_t)(t + 1) * kstep;
            const char* a2 = last ? nA : cA + (size_t)(t + 2) * kstep; const char* b2 = last ? nB : cB + (size_t)(t + 2) * kstep;
            const char* a3 = a2 + kstep; const char* b3 = b2 + kstep;
            unsigned o00 = gc[0][0], o01 = gc[0][1], o10 = gc[1][0], o11 = gc[1][1];
            if constexpr (GATHER) { if (last) { o00 = gn[0][0]; o01 = gn[0][1]; o10 = gn[1][0]; o11 = gn[1][1]; } }
            PG8_LDB(B0, 0, 0); PG8_LDB(B1, 0, 1); PG8_SCHED; PG8_LDA(At, 0, 0); PG8_STAGE_A(PG8_SA(1, 1), a1, gc[1][0], gc[1][1]);
            PG8_WAIT_V(8); PG8_WAIT_L(0); PG8_BAR; PG8_MMA(0, 0, At, B0); PG8_MMA(0, 1, At, B1); PG8_BAR; PG8_SCHED;
            PG8_LDA(At, 0, 1); PG8_STAGE_B(PG8_SB(0, 0), b2); PG8_STAGE_B(PG8_SB(0, 1), b2 + hstep); PG8_STAGE_A(PG8_SA(0, 0), a2, o00, o01);
            PG8_WAIT_V(8); PG8_WAIT_L(0); PG8_BAR; PG8_MMA(1, 0, At, B0); PG8_MMA(1, 1, At, B1); PG8_BAR; PG8_SCHED;
            PG8_LDB(B0, 1, 0); PG8_LDB(B1, 1, 1); PG8_SCHED; PG8_LDA(At, 1, 0); PG8_STAGE_A(PG8_SA(0, 1), a2, o10, o11);
            PG8_WAIT_V(8); PG8_WAIT_L(0); PG8_BAR; PG8_MMA(0, 0, At, B0); PG8_MMA(0, 1, At, B1); PG8_BAR; PG8_SCHED;
            PG8_LDA(At, 1, 1); PG8_STAGE_B(PG8_SB(1, 0), b3); PG8_STAGE_B(PG8_SB(1, 1), b3 + hstep); PG8_STAGE_A(PG8_SA(1, 0), a3, o00, o01);
            PG8_WAIT_V(8); PG8_WAIT_L(0); PG8_BAR; PG8_MMA(1, 0, At, B0); PG8_MMA(1, 1, At, B1); PG8_BAR; PG8_SCHED;
        }
        if (wr == 0) PG8_BAR;
        E(acc, cur, wr, wc, fr, fq);
        if (!has_next) break;
#pragma unroll
        for (int a = 0; a < 2; ++a)
#pragma unroll
            for (int b = 0; b < 2; ++b)
#pragma unroll
                for (int m = 0; m < 4; ++m)
#pragma unroll
                    for (int n = 0; n < 2; ++n) acc[a][b][m][n] = (f32x4){0.f, 0.f, 0.f, 0.f};
        cur = nxt; cA = nA; cB = nB; ++ui;
#pragma unroll
        for (int h = 0; h < 2; ++h)
#pragma unroll
            for (int i = 0; i < 2; ++i) gc[h][i] = gn[h][i];
        if (wr == 1) PG8_BAR;
    }
    PG8_WAIT_V(0);
    PG8_BAR;
#undef PG8_SA
#undef PG8_SB
#undef PG8_GLDS
#undef PG8_STAGE_A
#undef PG8_STAGE_B
#undef PG8_LDA
#undef PG8_LDB
#undef PG8_MMA
#undef PG8_WAIT_V
#undef PG8_WAIT_L
#undef PG8_BAR
#undef PG8_SCHED
}
}

namespace attn_body {
using bf16=__hip_bfloat16;
using bf16x8=__attribute__((ext_vector_type(8)))short;
using s16x4=__attribute__((ext_vector_type(4)))short;
using f32x16=__attribute__((ext_vector_type(16)))float;
using u32x4=__attribute__((ext_vector_type(4)))unsigned;
constexpr int D=64,PQ=INW,PO=DM;
constexpr int NW=8,QBLK=32,QB=QBLK*NW,KVBLK=64,NQB=SEQ/QB;
constexpr int ATTN_UNIT_ROWS=QB;
__device__ __forceinline__ int crow(int r,int hi){return (r&3)+8*(r>>2)+4*hi;}
#define SBAR() __builtin_amdgcn_sched_barrier(0)
__device__ __forceinline__ void cmask(f32x16&p0,f32x16&p1,int jb,int qrel,int hi){
  const float NEG=-INFINITY; int kb=64*jb+4*hi;
  #pragma unroll
  for(int r=0;r<16;++r){int kv=kb+(r&3)+8*(r>>2); if(kv>qrel)p0[r]=NEG; if(kv+32>qrel)p1[r]=NEG;}
}

constexpr int NSLOT=3, SLOTB=8192;
constexpr int LDS_K=0, LDS_V=NSLOT*SLOTB, LDS_WS=2*NSLOT*SLOTB, LDS_OST=LDS_WS+NW*64*4, LDS_BYTES=LDS_OST+NW*4096;
constexpr float C2=0.125f*1.4426950408889634f;
__device__ __forceinline__ void glds16(const void*gsrc,unsigned lds_dst){unsigned keep;
  asm volatile("s_mov_b32 %0, m0\n\ts_mov_b32 m0, %2\n\ts_nop 0\n\tglobal_load_lds_dwordx4 %1, off\n\ts_mov_b32 m0, %0":"=&s"(keep):"v"(gsrc),"s"(lds_dst):"memory");}
__device__ __forceinline__ float max3f(float a,float b,float c){float r;asm("v_max3_f32 %0, %1, %2, %3":"=v"(r):"v"(a),"v"(b),"v"(c));return r;}
__device__ __forceinline__ float max2f(float a,float b){float r;asm("v_max_f32_e32 %0, %1, %2":"=v"(r):"v"(a),"v"(b));return r;}
__device__ __forceinline__ float fadd_s(float a,float b){float r;asm("v_add_f32_e32 %0, %1, %2":"=v"(r):"v"(a),"v"(b));return r;}
__device__ __forceinline__ float fsub_s(float a,float b){float r;asm("v_sub_f32_e32 %0, %1, %2":"=v"(r):"v"(a),"v"(b));return r;}
typedef float f32x2_t __attribute__((ext_vector_type(2))); typedef __bf16 bf16x2_t __attribute__((ext_vector_type(2)));
__device__ __forceinline__ unsigned cvtpk_s(float lo,float hi){f32x2_t v={lo,hi};bf16x2_t b=__builtin_convertvector(v,bf16x2_t);return __builtin_bit_cast(unsigned,b);}
#define WAIT_BAR(N) asm volatile("s_waitcnt vmcnt(" #N ") lgkmcnt(0)\n\ts_barrier":::"memory")

__device__ __forceinline__ void qkt(f32x16&p0,f32x16&p1,const char*Kslot,const bf16x8*qr,const f32x16&negm,int r32,int hi){
  const char*kb=Kslot+hi*1024+r32*16;
  #pragma unroll
  for(int d0=0;d0<4;++d0){
    const bf16x8 b0=*reinterpret_cast<const bf16x8*>(kb+d0*2048);
    const bf16x8 b1=*reinterpret_cast<const bf16x8*>(kb+d0*2048+512);
    if(d0==0){p0=__builtin_amdgcn_mfma_f32_32x32x16_bf16(b0,qr[0],negm,0,0,0);p1=__builtin_amdgcn_mfma_f32_32x32x16_bf16(b1,qr[0],negm,0,0,0);}
    else{p0=__builtin_amdgcn_mfma_f32_32x32x16_bf16(b0,qr[d0],p0,0,0,0);p1=__builtin_amdgcn_mfma_f32_32x32x16_bf16(b1,qr[d0],p1,0,0,0);}}
}
typedef __attribute__((address_space(3))) const char* lds_cptr;
typedef short v4i16_t __attribute__((ext_vector_type(4)));
__device__ __forceinline__ void kload8(bf16x8*kf,lds_cptr kp){
  kf[0]=*(const __attribute__((address_space(3))) bf16x8*)(kp);      kf[1]=*(const __attribute__((address_space(3))) bf16x8*)(kp+512);
  kf[2]=*(const __attribute__((address_space(3))) bf16x8*)(kp+2048); kf[3]=*(const __attribute__((address_space(3))) bf16x8*)(kp+2560);
  kf[4]=*(const __attribute__((address_space(3))) bf16x8*)(kp+4096); kf[5]=*(const __attribute__((address_space(3))) bf16x8*)(kp+4608);
  kf[6]=*(const __attribute__((address_space(3))) bf16x8*)(kp+6144); kf[7]=*(const __attribute__((address_space(3))) bf16x8*)(kp+6656);
}
__device__ __forceinline__ void kload2(bf16x8*kf,lds_cptr kp,int j){ kf[2*j]=*(const __attribute__((address_space(3))) bf16x8*)(kp+j*2048); kf[2*j+1]=*(const __attribute__((address_space(3))) bf16x8*)(kp+j*2048+512); }
__device__ __forceinline__ s16x4 vtr(lds_cptr p){ return __builtin_bit_cast(s16x4,__builtin_amdgcn_ds_read_tr16_b64_v4i16((__attribute__((address_space(3))) v4i16_t*)p)); }
__device__ __forceinline__ float rowmax(const f32x16&p0,const f32x16&p1){
  float a=max3f(p0[0],p0[1],p1[0]),b=max3f(p0[2],p0[3],p1[1]);a=max3f(a,p1[2],p1[3]);
  #pragma unroll
  for(int r=4;r<16;r+=4){a=max3f(a,p0[r],p0[r+1]);b=max3f(b,p0[r+2],p0[r+3]);a=max3f(a,p1[r],p1[r+1]);b=max3f(b,p1[r+2],p1[r+3]);}
  const float m=max2f(a,b);
  auto rr=__builtin_amdgcn_permlane32_swap(__float_as_uint(m),__float_as_uint(m),false,false);
  return max2f(__uint_as_float(rr[0]),__uint_as_float(rr[1]));
}
__device__ __forceinline__ void pv(f32x16*o,int vb,bf16x8 pa0,bf16x8 pa1,bf16x8 pa2,bf16x8 pa3){
  #pragma unroll
  for(int d0=0;d0<2;++d0){s16x4 lo[4],hi[4];
    #pragma unroll
    for(int ks=0;ks<4;++ks){
      asm volatile("ds_read_b64_tr_b16 %0,%1 offset:%c2":"=&v"(lo[ks]):"v"(vb),"i"(d0*4096+ks*1024):"memory");
      asm volatile("ds_read_b64_tr_b16 %0,%1 offset:%c2":"=&v"(hi[ks]):"v"(vb),"i"(d0*4096+ks*1024+512):"memory");}
    asm volatile("s_waitcnt lgkmcnt(0)":::"memory");SBAR();
    #define PK(k) (bf16x8){lo[k][0],lo[k][1],lo[k][2],lo[k][3],hi[k][0],hi[k][1],hi[k][2],hi[k][3]}
    o[d0]=__builtin_amdgcn_mfma_f32_32x32x16_bf16(pa0,PK(0),o[d0],0,0,0);
    o[d0]=__builtin_amdgcn_mfma_f32_32x32x16_bf16(pa1,PK(1),o[d0],0,0,0);
    o[d0]=__builtin_amdgcn_mfma_f32_32x32x16_bf16(pa2,PK(2),o[d0],0,0,0);
    o[d0]=__builtin_amdgcn_mfma_f32_32x32x16_bf16(pa3,PK(3),o[d0],0,0,0);
    #undef PK
  }
}

#ifndef ATTN_STORE16
#define ATTN_STORE16(p,v) (*(u32x4*)(p)=(v))
#endif
template<int THRL> __device__ __forceinline__ void attn_unit(int qb,const bf16*Qb,const bf16*__restrict__ Kb,const bf16*__restrict__ Vb,bf16*Ob,char*shm){
  int tid_=threadIdx.x; asm volatile("":"+v"(tid_));
  const int tid=tid_,lane=tid&63,r32=lane&31,hi=lane>>5; const int wid=__builtin_amdgcn_readfirstlane(tid>>6);
  const int q0=qb*QB;
  const bf16*Qw=Qb+(long)(q0+wid*QBLK)*PQ;
  const bf16*Kh=Kb,*Vh=Vb;
  const unsigned lds0=(unsigned)(uintptr_t)shm;
  float*wsf=(float*)(shm+LDS_WS)+wid*64;
  const bf16*ksrc=Kh+(long)lane*PQ+wid*8;
  const bf16*vsrc=Vh+(long)(16*(wid&3)+(lane>>2))*PQ+(wid>>2)*32+(lane&3)*8;
  const unsigned kdst=lds0+LDS_K+wid*1024, vdst=lds0+LDS_V+wid*1024;
  #define DMA_K(t,slot) glds16(ksrc+(long)(t)*KVBLK*PQ,(unsigned)__builtin_amdgcn_readfirstlane(kdst+(slot)))
  #define DMA_V(t,slot) glds16(vsrc+(long)(t)*KVBLK*PQ,(unsigned)__builtin_amdgcn_readfirstlane(vdst+(slot)))
  const int vb0=(int)(lds0+LDS_V)+((lane>>4)&1)*32+(lane&3)*8+(4*hi+((lane&15)>>2))*64;
  const char*Kbase=shm+LDS_K; bf16x8 kf[8];
  const lds_cptr shm3=(lds_cptr)shm; const lds_cptr kp0=shm3+LDS_K+hi*1024+r32*16; const lds_cptr vp0=shm3+LDS_V+((lane>>4)&1)*32+(lane&3)*8+(4*hi+((lane&15)>>2))*64;
  const int NT=(q0+QB)/KVBLK;
  DMA_K(0,0);DMA_V(0,0);DMA_K(1,SLOTB);
  bf16x8 qr[4];
  #pragma unroll
  for(int d0=0;d0<4;++d0)qr[d0]=*reinterpret_cast<const bf16x8*>(&Qw[(long)r32*PQ+d0*16+hi*8]);
  float mhat=0.f,l_reg=0.f;f32x16 o[2];o[0]=f32x16{};o[1]=f32x16{};f32x16 negm=f32x16{};asm volatile("":"+v"(negm));
  const int qrel=wid*QBLK+r32;
  #define CMASK(P0,P1,t) do{int jb_=(t)-(NT-4); if(jb_>=0)cmask(P0,P1,jb_,qrel,hi);}while(0)
  bool resc=false;
  #define START(P0,P1) do{ const float rm=rowmax(P0,P1); resc=false; \
    { const float dl=rm; mhat=fadd_s(mhat,dl); \
      _Pragma("unroll") for(int r=0;r<16;++r){P0[r]=fsub_s(P0[r],dl);P1[r]=fsub_s(P1[r],dl);} \
      _Pragma("unroll") for(int r=0;r<16;++r)negm[r]=-mhat; asm volatile("":"+v"(negm)); } \
    _Pragma("unroll") for(int r=0;r<16;++r)P0[r]=__builtin_amdgcn_exp2f(P0[r]); }while(0)
  #define RESC() do{ if(resc){ asm volatile("s_waitcnt lgkmcnt(0)":::"memory"); \
      _Pragma("unroll") for(int d_=0;d_<2;++d_) _Pragma("unroll") for(int r=0;r<16;++r)o[d_][r]*=wsf[crow(r,hi)]; } }while(0)
  f32x16 pA0,pA1,pB0,pB1;
  int sl_prev=0,sl_cur=0,sl_next=SLOTB;
  #define ROT() do{sl_prev=sl_cur;sl_cur=sl_next;sl_next=(sl_next==(NSLOT-1)*SLOTB)?0:sl_next+SLOTB;}while(0)
  DMA_K(2,2*SLOTB);
  WAIT_BAR(3);
  qkt(pA0,pA1,Kbase,qr,negm,r32,hi);asm volatile("s_nop 15\n\ts_nop 7":"+v"(pA0),"+v"(pA1));CMASK(pA0,pA1,0);
  START(pA0,pA1);
  _Pragma("unroll") for(int r=0;r<16;++r)pA1[r]=__builtin_amdgcn_exp2f(pA1[r]);
  WAIT_BAR(0);
  DMA_K(3,0);DMA_V(1,SLOTB);
  ROT();
  kload8(kf,kp0+sl_cur);
  WAIT_BAR(2);
  s16x4 vlo[8],vhi[8]; u32x4 pw0,pw1,pw2,pw3;
  #define PKW(P,B) cvtpk_s(P[B],P[B+1])
  #define PAF(k) __builtin_bit_cast(bf16x8,pw##k)
  #define VFR(i) (bf16x8){vlo[i][0],vlo[i][1],vlo[i][2],vlo[i][3],vhi[i][0],vhi[i][1],vhi[i][2],vhi[i][3]}
  #define PIN(x) asm volatile("":"+v"(x))
  #define MX3(a,b,c) __builtin_fmaxf(__builtin_fmaxf((a),(b)),(c))
  #define GAPA(MF,A0,A1,A2,A3,W0,W1,PW) do{ MF; sacc+=A0; sacc+=A1; sacc+=A2; sacc+=A3; PIN(sacc); W0; W1; PIN(PW); SBAR(); }while(0)
  #define EX(v) __builtin_amdgcn_exp2f(v)
  #define GAPB(MF,X,B) do{ MF; X[B]=EX(X[B]); X[B+1]=EX(X[B+1]); X[B+2]=EX(X[B+2]); X[B+3]=EX(X[B+3]); PIN(X); SBAR(); }while(0)
  #define VRD(i) do{ vlo[i]=vtr(vp_+(((i)>>2)*4096+((i)&3)*1024)); vhi[i]=vtr(vp_+(((i)>>2)*4096+((i)&3)*1024+512)); }while(0)
  #define KRD(G,j) do{ if(G){ kload2(kf,kp0+sl_next,j); SBAR(); } }while(0)
  #define STEP(C0,C1,P0,P1,t,GK,GV,GL) do{ SBAR(); \
    const lds_cptr vp_=vp0+sl_prev; \
    VRD(0); SBAR(); float sacc=(P0[0]+P0[1]); \
    GAPA(C0=__builtin_amdgcn_mfma_f32_32x32x16_bf16(kf[0],qr[0],negm,0,0,0), P0[2],P0[3],P0[4],P0[5],     pw0[0]=PKW(P0,0), pw0[1]=PKW(P0,2), pw0); \
    VRD(4); SBAR(); GAPA(C1=__builtin_amdgcn_mfma_f32_32x32x16_bf16(kf[1],qr[0],negm,0,0,0), P0[6],P0[7],P0[8],P0[9],     pw0[2]=PKW(P0,4), pw0[3]=PKW(P0,6), pw0); \
    VRD(1); SBAR(); GAPA(C0=__builtin_amdgcn_mfma_f32_32x32x16_bf16(kf[2],qr[1],C0,0,0,0),   P0[10],P0[11],P0[12],P0[13], pw1[0]=PKW(P0,8), pw1[1]=PKW(P0,10), pw1); \
    VRD(5); SBAR(); GAPA(C1=__builtin_amdgcn_mfma_f32_32x32x16_bf16(kf[3],qr[1],C1,0,0,0),   P0[14],P0[15],P1[0],P1[1],   pw1[2]=PKW(P0,12),pw1[3]=PKW(P0,14), pw1); \
    VRD(2); SBAR(); GAPA(C0=__builtin_amdgcn_mfma_f32_32x32x16_bf16(kf[4],qr[2],C0,0,0,0),   P1[2],P1[3],P1[4],P1[5],     pw2[0]=PKW(P1,0), pw2[1]=PKW(P1,2), pw2); \
    VRD(6); SBAR(); GAPA(C1=__builtin_amdgcn_mfma_f32_32x32x16_bf16(kf[5],qr[2],C1,0,0,0),   P1[6],P1[7],P1[8],P1[9],     pw2[2]=PKW(P1,4), pw2[3]=PKW(P1,6), pw2); \
    VRD(3); SBAR(); GAPA(C0=__builtin_amdgcn_mfma_f32_32x32x16_bf16(kf[6],qr[3],C0,0,0,0),   P1[10],P1[11],P1[12],P1[13], pw3[0]=PKW(P1,8), pw3[1]=PKW(P1,10), pw3); \
    VRD(7); SBAR(); GAPA(C1=__builtin_amdgcn_mfma_f32_32x32x16_bf16(kf[7],qr[3],C1,0,0,0),   P1[14],P1[15],0.f,0.f,       pw3[2]=PKW(P1,12),pw3[3]=PKW(P1,14), pw3); \
    l_reg+=sacc; \
    if(GK){DMA_K((t)+3,sl_cur);} if(GV){DMA_V((t)+1,sl_next);} \
    CMASK(C0,C1,t); \
    { float a=MX3(C0[0],C0[1],C1[0]),b=MX3(C0[2],C0[3],C1[1]); a=MX3(a,C1[2],C1[3]); \
      _Pragma("unroll") for(int r=4;r<16;r+=4){a=MX3(a,C0[r],C0[r+1]);b=MX3(b,C0[r+2],C0[r+3]);a=MX3(a,C1[r],C1[r+1]);b=MX3(b,C1[r+2],C1[r+3]);} \
      float rm=__builtin_fmaxf(a,b); { auto rr=__builtin_amdgcn_permlane32_swap(__float_as_uint(rm),__float_as_uint(rm),false,false); rm=__builtin_fmaxf(__uint_as_float(rr[0]),__uint_as_float(rr[1])); } \
      resc=false; \
      if(__builtin_expect(__any(rm>(float)THRL),0)){ const float dl=__builtin_fmaxf(rm,0.f); mhat+=dl; \
        _Pragma("unroll") for(int r=0;r<16;++r){C0[r]-=dl;C1[r]-=dl;} \
        _Pragma("unroll") for(int r=0;r<16;++r)negm[r]=-mhat; asm volatile("":"+v"(negm)); \
        const float f=__builtin_amdgcn_exp2f(-dl); l_reg*=f; if(hi==0)wsf[r32]=f; resc=true; } } \
    SBAR(); \
    GAPB(o[0]=__builtin_amdgcn_mfma_f32_32x32x16_bf16(PAF(0),VFR(0),o[0],0,0,0), C0,0); \
    GAPB(o[1]=__builtin_amdgcn_mfma_f32_32x32x16_bf16(PAF(0),VFR(4),o[1],0,0,0), C0,4); \
    KRD(GL,0); GAPB(o[0]=__builtin_amdgcn_mfma_f32_32x32x16_bf16(PAF(1),VFR(1),o[0],0,0,0), C0,8); \
    KRD(GL,1); GAPB(o[1]=__builtin_amdgcn_mfma_f32_32x32x16_bf16(PAF(1),VFR(5),o[1],0,0,0), C0,12); \
    KRD(GL,2); GAPB(o[0]=__builtin_amdgcn_mfma_f32_32x32x16_bf16(PAF(2),VFR(2),o[0],0,0,0), C1,0); \
    KRD(GL,3); GAPB(o[1]=__builtin_amdgcn_mfma_f32_32x32x16_bf16(PAF(2),VFR(6),o[1],0,0,0), C1,4); \
    GAPB(o[0]=__builtin_amdgcn_mfma_f32_32x32x16_bf16(PAF(3),VFR(3),o[0],0,0,0), C1,8); \
    GAPB(o[1]=__builtin_amdgcn_mfma_f32_32x32x16_bf16(PAF(3),VFR(7),o[1],0,0,0), C1,12); \
    }while(0)
  int t=1;
  #undef CMASK
  #define CMASK(P0,P1,t) do{}while(0)
  for(;t+5<NT;t+=2){
    STEP(pB0,pB1,pA0,pA1,t,true,true,true);     WAIT_BAR(2); RESC(); ROT();
    STEP(pA0,pA1,pB0,pB1,t+1,true,true,true);   WAIT_BAR(2); RESC(); ROT();
  }
  #undef CMASK
  #define CMASK(P0,P1,t) do{int jb_=(t)-(NT-4); if(jb_>=0)cmask(P0,P1,jb_,qrel,hi);}while(0)
  #define ENDW(tt) do{ if((tt)+3<NT){WAIT_BAR(2);} else if((tt)+2<NT){WAIT_BAR(1);} else {WAIT_BAR(0);} }while(0)
  for(;t+1<NT;t+=2){
    STEP(pB0,pB1,pA0,pA1,t,(t+3<NT),(t+1<NT),(t+1<NT));       ENDW(t);   RESC(); ROT();
    STEP(pA0,pA1,pB0,pB1,t+1,(t+4<NT),(t+2<NT),(t+2<NT));     ENDW(t+1); RESC(); ROT();
  }
  STEP(pB0,pB1,pA0,pA1,NT-1,false,false,false); RESC();
  { float sacc=pB0[0]+pB0[1]; _Pragma("unroll") for(int r=2;r<16;++r)sacc+=pB0[r]; _Pragma("unroll") for(int r=0;r<16;++r)sacc+=pB1[r]; l_reg+=sacc;
    pw0=(u32x4){PKW(pB0,0),PKW(pB0,2),PKW(pB0,4),PKW(pB0,6)};pw1=(u32x4){PKW(pB0,8),PKW(pB0,10),PKW(pB0,12),PKW(pB0,14)};pw2=(u32x4){PKW(pB1,0),PKW(pB1,2),PKW(pB1,4),PKW(pB1,6)};pw3=(u32x4){PKW(pB1,8),PKW(pB1,10),PKW(pB1,12),PKW(pB1,14)};
    SBAR(); pv(o,vb0+sl_cur,PAF(0),PAF(1),PAF(2),PAF(3)); }
  #undef PKW
  #undef PAF
  #undef VFR
  #undef PIN
  #undef MX3
  #undef GAPA
  #undef GAPB
  #undef EX
  #undef VRD
  #undef KRD
  #undef STEP
  #undef ENDW
  {auto rr=__builtin_amdgcn_permlane32_swap(__float_as_uint(l_reg),__float_as_uint(l_reg),false,false);l_reg=__uint_as_float(rr[0])+__uint_as_float(rr[1]);}
  if(hi==0)wsf[32+r32]=l_reg;asm volatile("s_waitcnt lgkmcnt(0)":::"memory");
  float rli[16];
  #pragma unroll
  for(int r=0;r<16;++r)rli[r]=__builtin_amdgcn_rcpf(wsf[32+crow(r,hi)]);
  bf16*Ow=Ob+(long)(q0+wid*QBLK)*PO;
  { bf16*stg=(bf16*)(shm+LDS_OST)+wid*2048;
    #pragma unroll
    for(int r=0;r<16;++r){const int orow=crow(r,hi);
      #pragma unroll
      for(int d0=0;d0<2;++d0)stg[orow*64+d0*32+r32]=__float2bfloat16(o[d0][r]*rli[r]);}
    asm volatile("s_waitcnt lgkmcnt(0)":::"memory");
    #pragma unroll
    for(int i=0;i<4;++i){const int row=i*8+(lane>>3),ch=lane&7; const u32x4 v=*(const u32x4*)(stg+row*64+ch*8); ATTN_STORE16(Ow+(long)row*PO+ch*8,v);} }
  asm volatile("s_waitcnt lgkmcnt(0)\n\ts_barrier":::"memory");
  #undef DMA_K
  #undef DMA_V
  #undef CMASK
  #undef START
  #undef RESC
  #undef ROT
}
constexpr int ATTN_LDS_BYTES=LDS_BYTES;
template<int THRL=8> __device__ __forceinline__ void attn_phase(char*lds,const bf16_t*proj,bf16_t*atto,int vcu){
  const int bh=vcu>>3,s8=vcu&7,b=bh>>2,h=bh&3;
  const bf16*P0=(const bf16*)proj+(long)b*SEQ*PQ; bf16*O0=(bf16*)atto+(long)b*SEQ*PO;
  for(int i=0;i<8;++i){ const int qb=(i<4)?(15-s8):s8, sub=i&3, st=sub>>1, vh=sub&1;
    attn_unit<THRL>(qb,P0+C_Q+st*256+h*64,P0+C_K+st*256+h*64,P0+C_V+h*128+vh*64,O0+h*256+st*128+vh*64,lds); }
}
#undef SBAR
#undef WAIT_BAR
}

constexpr int NWAVES = 8;
constexpr int RING_OFF = 0, RING_BYTES = 131072;
constexpr int LDSCTL_OFF = RING_BYTES, MISC_OFF = LDSCTL_OFF + 320;
constexpr int TAB_OFF = LDSCTL_OFF + 1024;
constexpr int REC_OFF = LDSCTL_OFF + 2048;
constexpr int LDS_BYTES = 147456;
static_assert(REC_OFF + (64 + 512) * 4 <= LDS_BYTES, "LDS map");

#define GAS __attribute__((address_space(1)))
#define LAS __attribute__((address_space(3)))
typedef unsigned v4u __attribute__((ext_vector_type(4)));
typedef unsigned v2u __attribute__((ext_vector_type(2)));
typedef float f32x4 __attribute__((ext_vector_type(4)));
typedef float f32x2 __attribute__((ext_vector_type(2)));
typedef short bf16x8 __attribute__((ext_vector_type(8)));
typedef GAS unsigned gu32;
#define RLX_AGENT __ATOMIC_RELAXED, __HIP_MEMORY_SCOPE_AGENT
#define LDS_WAIT() asm volatile("s_waitcnt lgkmcnt(0)" ::: "memory")
#define VM_WAIT() asm volatile("s_waitcnt vmcnt(0)" ::: "memory")

#define XB_TMO      128
#define XB_XCNT(j)  (256  + 64 * (j))
#define XB_XSUB(j)  (1280 + 64 * (j))
#define XB_XGEN(j)  (2304 + 64 * (j))
#define XB_TOP      3328
#define XB_TOPGEN   3392
#define XCD_BAR_WORDS 3456
#define XB_SPIN_CAP (1u << 18)
__device__ __forceinline__ unsigned xb_ld(unsigned* p)              { return __hip_atomic_load(p, __ATOMIC_RELAXED, __HIP_MEMORY_SCOPE_AGENT); }
__device__ __forceinline__ unsigned xb_add(unsigned* p, unsigned v) { return __hip_atomic_fetch_add(p, v, __ATOMIC_RELAXED, __HIP_MEMORY_SCOPE_AGENT); }
__device__ __forceinline__ unsigned xb_xcc_id() { return (unsigned)__builtin_amdgcn_s_getreg((3 << 11) | 20) & 0xFu; }
#define XB_SPIN(cond, bar) do { unsigned _sp = 0; while (cond) { __builtin_amdgcn_s_sleep(1); \
    if ((++_sp & 255u) == 0u) { if (xb_ld(&(bar)[XB_TMO])) break; if (_sp > XB_SPIN_CAP) { atomicAdd(&(bar)[XB_TMO], 1u); break; } } } } while (0)
struct XcdBarrier { unsigned* bar; unsigned x; volatile LAS unsigned* st; };
__device__ __forceinline__ XcdBarrier xcd_barrier_post(unsigned* bar, volatile LAS unsigned* st) {
    XcdBarrier b; b.bar = bar; b.x = xb_xcc_id(); b.st = st;
    if (threadIdx.x == 0) (void)xb_add(&bar[XB_XCNT(b.x)], 1u);
    return b;
}
__device__ __forceinline__ void xcd_barrier_complete(unsigned* bar, unsigned x, unsigned& nloc, unsigned& nx) {
    const unsigned G = gridDim.x * gridDim.y * gridDim.z;
    unsigned sum, cnt, mine, sp = 0u;
    for (;;) {
        sum = 0u; cnt = 0u; mine = 0u;
#pragma unroll
        for (unsigned j = 0; j < 16; ++j) { const unsigned c = xb_ld(&bar[XB_XCNT(j)]); sum += c; cnt += (c > 0u) ? 1u : 0u; mine = (j == x) ? c : mine; }
        if (sum == G) break;
        __builtin_amdgcn_s_sleep(1);
        if ((++sp & 255u) == 0u) { if (xb_ld(&bar[XB_TMO])) break; if (sp > XB_SPIN_CAP) { atomicAdd(&bar[XB_TMO], 1u); break; } }
    }
    nloc = mine > 0u ? mine : 1u; nx = cnt > 0u ? cnt : 1u;
}
__device__ __forceinline__ void xcd_barrier(const XcdBarrier& b) {
    asm volatile("s_waitcnt vmcnt(0)" ::: "memory");
    __syncthreads();
    if (threadIdx.x == 0) {
        unsigned* bar = b.bar;
        __builtin_amdgcn_s_waitcnt(0);
        unsigned nloc = b.st[0], nx = b.st[1];
        if (nloc == 0u) { xcd_barrier_complete(bar, b.x, nloc, nx); b.st[0] = nloc; b.st[1] = nx; }
        const unsigned old = xb_add(&bar[XB_XSUB(b.x)], 1u);
        const unsigned gen = old / nloc;
        if (old + 1u == (gen + 1u) * nloc) {
            __builtin_amdgcn_fence(__ATOMIC_RELEASE, "agent");
            asm volatile("s_waitcnt vmcnt(0)" ::: "memory");
            const unsigned og = xb_add(&bar[XB_TOP], 1u);
            const unsigned tg = og / nx;
            if (og + 1u == (tg + 1u) * nx) xb_add(&bar[XB_TOPGEN], 1u);
            else XB_SPIN(xb_ld(&bar[XB_TOPGEN]) == tg, bar);
            __builtin_amdgcn_fence(__ATOMIC_ACQUIRE, "agent");
            xb_add(&bar[XB_XGEN(b.x)], 1u);
            asm volatile("s_waitcnt vmcnt(0)" ::: "memory");
        } else {
            XB_SPIN(xb_ld(&bar[XB_XGEN(b.x)]) == gen, bar);
            __builtin_amdgcn_fence(__ATOMIC_ACQUIRE, "agent");
            asm volatile("s_waitcnt vmcnt(0)" ::: "memory");
        }
    }
    __syncthreads();
}

struct Args { const float* in[22]; float* out; unsigned char* ws; int ph_lo, ph_hi, pad0, pad1; };
struct Frame {
    LAS unsigned char* lds; volatile LAS unsigned* MISC; gu32* ctl;
    int tid, lane, wave, vcu, G;
};

typedef const __attribute__((address_space(4))) Args* kargs_t;
__device__ __forceinline__ Args fetch_args() {
    kargs_t kp = (kargs_t)__builtin_amdgcn_kernarg_segment_ptr();
    asm volatile("" : "+s"(kp));
    Args a;
#pragma unroll
    for (int i = 0; i < 22; ++i) a.in[i] = kp->in[i];
    a.out = kp->out; a.ws = kp->ws; a.ph_lo = kp->ph_lo; a.ph_hi = kp->ph_hi; a.pad0 = kp->pad0; a.pad1 = kp->pad1;
    return a;
}
__device__ __forceinline__ void refresh_frame(Frame& F) { int t = threadIdx.x; asm volatile("" : "+v"(t)); F.tid = t; F.lane = t & 63; F.wave = __builtin_amdgcn_readfirstlane(t >> 6); }

__device__ __forceinline__ void p0_transpose_item(const float* W, int K, int N, bf16_t* WT, long row_off, LAS float* scr, int item, int lane) {
    const int nblk = N / 32, kb = item / nblk, nb = item % nblk, k0 = 64 * kb, n0 = 32 * nb;
#pragma unroll 8
    for (int i = 0; i < 32; ++i) { const int kk = 2 * i + (lane >> 5); scr[kk * 33 + (lane & 31)] = W[(size_t)(k0 + kk) * N + n0 + (lane & 31)]; }
    LDS_WAIT(); asm volatile("" ::: "memory");
    const int c = lane & 7;
#pragma unroll
    for (int j = 0; j < 4; ++j) { const int n = (lane >> 3) + 8 * j; const LAS float* s = scr + (8 * c) * 33 + n;
        v4u o; o.x = pk2(s[0 * 33], s[1 * 33]); o.y = pk2(s[2 * 33], s[3 * 33]); o.z = pk2(s[4 * 33], s[5 * 33]); o.w = pk2(s[6 * 33], s[7 * 33]);
        *(GAS v4u*)(WT + (size_t)(row_off + n0 + n) * K + k0 + 8 * c) = o; }
    LDS_WAIT(); asm volatile("" ::: "memory");
}
__device__ __forceinline__ void p0_prologue(Frame& F, const Args& a) {
    LAS float* scr = (LAS float*)(F.lds + RING_OFF + F.wave * 16384);
    const int gw = F.vcu * NWAVES + F.wave, NGW = F.G * NWAVES;
    unsigned char* ws = a.ws;
    constexpr int I_IN = (DM / 64) * (INW / 32), I_O = (DM / 64) * (DM / 32), I_UP1 = (DM / 64) * (2 * DFF / 32), I_DN1 = (DFF / 64) * (DM / 32);
    constexpr int NITEMS = I_IN + I_O + NE * I_UP1 + NE * I_DN1;
    for (int it = gw; it < NITEMS; it += NGW) {
        int r = it;
        if (r < I_IN) { p0_transpose_item(a.in[1], DM, INW, (bf16_t*)(ws + WS_WIN), 0, scr, r, F.lane); continue; } r -= I_IN;
        if (r < I_O) { p0_transpose_item(a.in[11], DM, DM, (bf16_t*)(ws + WS_WO), 0, scr, r, F.lane); continue; } r -= I_O;
        if (r < NE * I_UP1) { const int e = r / I_UP1, ii = r % I_UP1; const int n0 = 32 * (ii % (2 * DFF / 32));
            const int bj = n0 / DFF, f = n0 % DFF, rho0 = 256 * (f / 128) + 128 * bj + (f % 128);
            p0_transpose_item(a.in[16] + (size_t)e * DM * 2 * DFF, DM, 2 * DFF, (bf16_t*)(ws + WS_WUP) + (size_t)e * 2 * DFF * DM, (long)rho0 - n0, scr, ii, F.lane); continue; } r -= NE * I_UP1;
        { const int e = r / I_DN1, ii = r % I_DN1;
            p0_transpose_item(a.in[18] + (size_t)e * DFF * DM, DFF, DM, (bf16_t*)(ws + WS_WDN) + (size_t)e * DM * DFF, 0, scr, ii, F.lane); }
    }
    const float* x = a.in[0]; bf16_t* xb = (bf16_t*)(ws + WS_XB);
    for (int m = gw; m < NTOK; m += NGW) {
        const GAS f32x4* xr = (const GAS f32x4*)(x + (size_t)m * DM) + F.lane; GAS v2u* o8 = (GAS v2u*)(xb + (size_t)m * DM) + F.lane;
        f32x4 v[4];
#pragma unroll
        for (int j = 0; j < 4; ++j) v[j] = xr[64 * j];
#pragma unroll
        for (int j = 0; j < 4; ++j) { v2u o; o.x = pk2(v[j].x, v[j].y); o.y = pk2(v[j].z, v[j].w); o8[64 * j] = o; }
    }
}

__device__ __forceinline__ void gmlp_phase(Frame& F, const Args& a) {
    const bf16_t* proj = (const bf16_t*)(a.ws + WS_PROJ); bf16_t* mix = (bf16_t*)(a.ws + WS_MIX);
    const float *lng = a.in[7], *lnb = a.in[8], *wsp = a.in[9], *bsp = a.in[10];
    LAS f32x2* st = (LAS f32x2*)(F.lds + RING_OFF);
    LAS bf16_t* Vg = (LAS bf16_t*)(F.lds + RING_OFF + 1024);
    LAS bf16_t* Wg = (LAS bf16_t*)(F.lds + RING_OFF + 19456);
    LAS float* Zg = (LAS float*)(F.lds + RING_OFF + 54272);
    const int tid = F.tid, lane = F.lane, w = F.wave;
    for (int c = blockIdx.x; c < NTOK / CHUNK; c += F.G) {
        const size_t row0 = (size_t)c * CHUNK;
        for (int s = 16 * w; s < 16 * w + 16; ++s) {
            const v4u raw = *(const GAS v4u*)(proj + (row0 + s) * INW + C_GV + lane * 8);
            const unsigned rw[4] = {raw.x, raw.y, raw.z, raw.w}; float v[8]; float sum = 0.f;
#pragma unroll
            for (int i = 0; i < 4; ++i) { const f32x2 gg = pg8::gelu_pk((f32x2){bf2f((bf16_t)(rw[i] & 0xffff)), bf2f((bf16_t)(rw[i] >> 16))}); v[2 * i] = gg.x; v[2 * i + 1] = gg.y; sum += gg.x + gg.y; }
            const float mean = wave_sum(sum) * (1.0f / GW); float q = 0.f;
#pragma unroll
            for (int i = 0; i < 8; ++i) { const float d = v[i] - mean; q += d * d; }
            const float var = wave_sum(q) * (1.0f / GW);
            if (lane == 0) st[s] = (f32x2){mean, rsqrtf(var + LN_EPS)};
        }
        __syncthreads();
        for (int g = 0; g < NG; ++g) {
            {
                const int row = tid >> 2, cq = (tid & 3) * 16, col = g * GD + cq; const f32x2 ms = st[row];
                const GAS v4u* src = (const GAS v4u*)(proj + (row0 + row) * INW + C_GV + col);
                unsigned ow[8];
#pragma unroll
                for (int hh = 0; hh < 2; ++hh) { const v4u raw = src[hh]; const unsigned rw[4] = {raw.x, raw.y, raw.z, raw.w};
#pragma unroll
                    for (int i = 0; i < 4; ++i) { const f32x2 gg = pg8::gelu_pk((f32x2){bf2f((bf16_t)(rw[i] & 0xffff)), bf2f((bf16_t)(rw[i] >> 16))});
                        const int cc = col + hh * 8 + 2 * i;
                        ow[hh * 4 + i] = pk2((gg.x - ms.x) * ms.y * lng[cc] + lnb[cc], (gg.y - ms.x) * ms.y * lng[cc + 1] + lnb[cc + 1]); } }
                *(LAS v4u*)(Vg + row * 72 + cq) = (v4u){ow[0], ow[1], ow[2], ow[3]};
                *(LAS v4u*)(Vg + row * 72 + cq + 8) = (v4u){ow[4], ow[5], ow[6], ow[7]};
#pragma unroll
                for (int k = 0; k < 8; ++k) { const int i = tid + 512 * k, t = i >> 5, s4 = (i & 31) * 4;
                    const f32x4 wv = *(const GAS f32x4*)(wsp + ((size_t)g * CHUNK + t) * CHUNK + s4);
                    v2u o; o.x = pk2(s4 <= t ? wv.x : 0.f, s4 + 1 <= t ? wv.y : 0.f); o.y = pk2(s4 + 2 <= t ? wv.z : 0.f, s4 + 3 <= t ? wv.w : 0.f);
                    *(LAS v2u*)(Wg + t * 136 + s4) = o; }
            }
            __syncthreads();
            {
                f32x4 acc[4];
#pragma unroll
                for (int n = 0; n < 4; ++n) acc[n] = (f32x4){0.f, 0.f, 0.f, 0.f};
                const int t0 = 16 * w, fr = lane & 15, fq = lane >> 4;
                for (int ks = 0; ks * 32 <= t0 + 15; ++ks) {
                    const bf16x8 af = *(const LAS bf16x8*)(Wg + (t0 + fr) * 136 + ks * 32 + fq * 8);
#pragma unroll
                    for (int n = 0; n < 4; ++n) { bf16x8 bfv;
#pragma unroll
                        for (int j = 0; j < 8; ++j) bfv[j] = (short)Vg[(ks * 32 + fq * 8 + j) * 72 + n * 16 + fr];
                        acc[n] = __builtin_amdgcn_mfma_f32_16x16x32_bf16(af, bfv, acc[n], 0, 0, 0); }
                }
#pragma unroll
                for (int n = 0; n < 4; ++n)
#pragma unroll
                    for (int r = 0; r < 4; ++r) Zg[(t0 + fq * 4 + r) * 68 + n * 16 + fr] = acc[n][r];
            }
            __syncthreads();
            {
                const int row = tid >> 2, cq = (tid & 3) * 16, col = g * GD + cq; const float bb = bsp[g * CHUNK + row];
                const GAS v4u* src = (const GAS v4u*)(proj + (row0 + row) * INW + C_GU + col);
                unsigned ow[8];
#pragma unroll
                for (int hh = 0; hh < 2; ++hh) { const v4u raw = src[hh]; const unsigned rw[4] = {raw.x, raw.y, raw.z, raw.w};
#pragma unroll
                    for (int i = 0; i < 4; ++i) { const f32x2 uu = pg8::gelu_pk((f32x2){bf2f((bf16_t)(rw[i] & 0xffff)), bf2f((bf16_t)(rw[i] >> 16))});
                        const f32x2 zz = *(const LAS f32x2*)(Zg + row * 68 + cq + hh * 8 + 2 * i);
                        ow[hh * 4 + i] = pk2(uu.x * (zz.x + bb), uu.y * (zz.y + bb)); } }
                GAS v4u* dst = (GAS v4u*)(mix + (row0 + row) * DM + GW + col);
                dst[0] = (v4u){ow[0], ow[1], ow[2], ow[3]}; dst[1] = (v4u){ow[4], ow[5], ow[6], ow[7]};
            }
            __syncthreads();
        }
    }
}

__device__ __forceinline__ void attn_combine_phase(Frame& F, const Args& a) {
    const bf16_t* atto = (const bf16_t*)(a.ws + WS_ATTO); bf16_t* mix = (bf16_t*)(a.ws + WS_MIX);
    const int lane = F.lane, gw = F.vcu * NWAVES + F.wave, NGW = F.G * NWAVES;
    const float lam = expf(wave_sum(a.in[2][lane] * a.in[3][lane])) - expf(wave_sum(a.in[4][lane] * a.in[5][lane])) + LAMBDA_INIT;
    const int h = lane >> 4, e0 = (lane & 15) * 8;
    float sg[8];
#pragma unroll
    for (int i = 0; i < 8; ++i) sg[i] = a.in[6][e0 + i] * (1.0f - LAMBDA_INIT);
    for (int t = gw; t < NTOK; t += NGW) {
        const v4u r1 = *(const GAS v4u*)(atto + (size_t)t * DM + h * 256 + e0), r2 = *(const GAS v4u*)(atto + (size_t)t * DM + h * 256 + 128 + e0);
        const unsigned w1[4] = {r1.x, r1.y, r1.z, r1.w}, w2[4] = {r2.x, r2.y, r2.z, r2.w};
        float d[8]; float ss = 0.f;
#pragma unroll
        for (int i = 0; i < 4; ++i) { d[2 * i] = bf2f((bf16_t)(w1[i] & 0xffff)) - lam * bf2f((bf16_t)(w2[i] & 0xffff)); d[2 * i + 1] = bf2f((bf16_t)(w1[i] >> 16)) - lam * bf2f((bf16_t)(w2[i] >> 16)); ss += d[2 * i] * d[2 * i] + d[2 * i + 1] * d[2 * i + 1]; }
        ss += __shfl_xor(ss, 1); ss += __shfl_xor(ss, 2); ss += __shfl_xor(ss, 4); ss += __shfl_xor(ss, 8);
        const float r = rsqrtf(ss * (1.0f / DV) + LN_EPS);
        v4u o; o.x = pk2(d[0] * r * sg[0], d[1] * r * sg[1]); o.y = pk2(d[2] * r * sg[2], d[3] * r * sg[3]); o.z = pk2(d[4] * r * sg[4], d[5] * r * sg[5]); o.w = pk2(d[6] * r * sg[6], d[7] * r * sg[7]);
        *(GAS v4u*)(mix + (size_t)t * DM + h * DV + e0) = o;
    }
}

__device__ __forceinline__ void route_phase(Frame& F, const Args& a) {
    float* h1 = (float*)(a.ws + WS_H1); bf16_t* xb = (bf16_t*)(a.ws + WS_XB);
    int* list = (int*)(a.ws + WS_LIST); int* re = (int*)(a.ws + WS_RE); int* rr = (int*)(a.ws + WS_RR); float* rg = (float*)(a.ws + WS_RG);
    const float *g1 = a.in[12], *b1 = a.in[13], *wr = a.in[14], *br = a.in[15];
    constexpr int XS = 1028;
    LAS float* XT = (LAS float*)(F.lds + RING_OFF);
    LAS float* PT = (LAS float*)(F.lds + RING_OFF + 16 * XS * 4);
    LAS int* lcnt = (LAS int*)(F.lds + REC_OFF); LAS int* lbase = lcnt + 32; LAS int* rec = lcnt + 64;
    const int tid = F.tid, lane = F.lane, w = F.wave, fr = lane & 15, fq = lane >> 4;
    if (tid < 32) lcnt[tid] = 0;
    float bw[32][2];
#pragma unroll
    for (int s = 0; s < 32; ++s)
#pragma unroll
        for (int n = 0; n < 2; ++n) bw[s][n] = wr[(size_t)(128 * w + 4 * s + fq) * NE + 16 * n + fr];
    const float mybr = br[lane & 31];
    constexpr int RPB = NTOK / 256;
    for (int ch = 0; ch < 8; ++ch) {
        const int t0 = blockIdx.x * RPB + ch * 16;
#pragma unroll
        for (int q = 0; q < 2; ++q) {
            const int rl = 2 * w + q, t = t0 + rl;
            float* row = h1 + (size_t)t * DM;
            float v[16]; float s = 0.f;
#pragma unroll
            for (int j = 0; j < 4; ++j) { const f32x4 qv = *(const GAS f32x4*)(row + j * 256 + lane * 4); v[4 * j] = qv.x; v[4 * j + 1] = qv.y; v[4 * j + 2] = qv.z; v[4 * j + 3] = qv.w; s += (qv.x + qv.y) + (qv.z + qv.w); }
            const float mean = wave_sum(s) * (1.0f / DM); float q2 = 0.f;
#pragma unroll
            for (int i = 0; i < 16; ++i) { v[i] -= mean; q2 += v[i] * v[i]; }
            const float rstd = rsqrtf(wave_sum(q2) * (1.0f / DM) + LN_EPS);
#pragma unroll
            for (int j = 0; j < 4; ++j) {
                const int col = j * 256 + lane * 4;
                const f32x4 gq = *(const GAS f32x4*)(g1 + col), bq = *(const GAS f32x4*)(b1 + col);
                const f32x4 o = (f32x4){v[4 * j] * rstd * gq.x + bq.x, v[4 * j + 1] * rstd * gq.y + bq.y, v[4 * j + 2] * rstd * gq.z + bq.z, v[4 * j + 3] * rstd * gq.w + bq.w};
                *(GAS f32x4*)(row + col) = o;
                *(LAS f32x4*)(XT + rl * XS + col) = o;
                v2u pk; pk.x = pk2(o.x, o.y); pk.y = pk2(o.z, o.w);
                *(GAS v2u*)(xb + (size_t)t * DM + col) = pk;
            }
        }
        __syncthreads();
        {
            f32x4 acc0 = (f32x4){0.f, 0.f, 0.f, 0.f}, acc1 = (f32x4){0.f, 0.f, 0.f, 0.f};
            const LAS float* xp = XT + fr * XS + 128 * w + fq;
#pragma unroll
            for (int s = 0; s < 32; ++s) { const float av = xp[4 * s];
                acc0 = __builtin_amdgcn_mfma_f32_16x16x4f32(av, bw[s][0], acc0, 0, 0, 0);
                acc1 = __builtin_amdgcn_mfma_f32_16x16x4f32(av, bw[s][1], acc1, 0, 0, 0); }
#pragma unroll
            for (int r = 0; r < 4; ++r) { PT[(w * 16 + fq * 4 + r) * 32 + fr] = acc0[r]; PT[(w * 16 + fq * 4 + r) * 32 + 16 + fr] = acc1[r]; }
        }
        __syncthreads();
#pragma unroll
        for (int q = 0; q < 2; ++q) {
            const int rl = 2 * w + q, t = t0 + rl, myexp = lane & 31;
            float cur = mybr;
#pragma unroll
            for (int ww = 0; ww < 8; ++ww) cur += PT[(ww * 16 + rl) * 32 + myexp];
            int idx[4]; float val[4];
#pragma unroll
            for (int k = 0; k < 4; ++k) {
                const float m = wave_max(cur);
                int cand = (cur == m) ? myexp : 99;
#pragma unroll
                for (int o = 1; o < 64; o <<= 1) cand = min(cand, __shfl_xor(cand, o));
                idx[k] = cand; val[k] = m; if (myexp == cand) cur = -INFINITY;
            }
            float ex[4], se = 0.f;
#pragma unroll
            for (int k = 0; k < 4; ++k) { ex[k] = expf(val[k] - val[0]); se += ex[k]; }
            if (lane < 4) {
                int e_ = idx[0]; float g_ = ex[0];
                if (lane == 1) { e_ = idx[1]; g_ = ex[1]; } else if (lane == 2) { e_ = idx[2]; g_ = ex[2]; } else if (lane == 3) { e_ = idx[3]; g_ = ex[3]; }
                const int lr = __hip_atomic_fetch_add(lcnt + e_, 1, __ATOMIC_RELAXED, __HIP_MEMORY_SCOPE_WORKGROUP);
                rec[(ch * 16 + rl) * 4 + lane] = e_ | (lr << 8);
                re[t * 4 + lane] = e_; rg[t * 4 + lane] = g_ / se;
            }
        }
    }
    __syncthreads();
    if (tid < 32) lbase[tid] = (int)__hip_atomic_fetch_add((unsigned*)(F.ctl + CW_CNT + tid), (unsigned)lcnt[tid], RLX_AGENT);
    __syncthreads();
    { const int rw = tid >> 2, k = tid & 3; const int t = blockIdx.x * RPB + rw; const int rc = rec[tid]; const int e_ = rc & 255, r_ = lbase[e_] + (rc >> 8);
      rr[t * 4 + k] = r_; list[e_ * NTOK + r_] = t; }
}
__device__ __forceinline__ void build_tab(Frame& F) {
    LAS int* tab = (LAS int*)(F.lds + TAB_OFF);
    if (F.tid < 32) tab[40 + F.tid] = (int)__hip_atomic_load(F.ctl + CW_CNT + F.tid, RLX_AGENT);
    __syncthreads();
    if (F.tid == 0) { int p = 0; for (int e = 0; e < NE; ++e) { tab[e] = p; p += (tab[40 + e] + 255) >> 8; } tab[NE] = p; }
    __syncthreads();
}
__device__ __forceinline__ void combine_phase(Frame& F, const Args& a) {
    const float* x1 = (const float*)(a.ws + WS_H1); const bf16_t* y = (const bf16_t*)(a.ws + WS_Y);
    const int* re = (const int*)(a.ws + WS_RE); const int* rr = (const int*)(a.ws + WS_RR); const float* rg = (const float*)(a.ws + WS_RG);
    const float *g2 = a.in[20], *b2 = a.in[21]; float* out = a.out;
    const LAS int* tab = (const LAS int*)(F.lds + TAB_OFF);
    const int lane = F.lane, gw = F.vcu * NWAVES + F.wave, NGW = F.G * NWAVES;
    for (int t = gw; t < NTOK; t += NGW) {
        float v[16];
#pragma unroll
        for (int j = 0; j < 4; ++j) { const f32x4 q = *(const GAS f32x4*)(x1 + (size_t)t * DM + j * 256 + lane * 4); v[4 * j] = ALPHA * q.x; v[4 * j + 1] = ALPHA * q.y; v[4 * j + 2] = ALPHA * q.z; v[4 * j + 3] = ALPHA * q.w; }
#pragma unroll
        for (int k = 0; k < 4; ++k) {
            const int e = re[t * 4 + k], slot = tab[e] * 256 + rr[t * 4 + k]; const float g = rg[t * 4 + k];
            const bf16_t* yr = y + (size_t)slot * DM;
#pragma unroll
            for (int j = 0; j < 4; ++j) { const v2u pk = *(const GAS v2u*)(yr + j * 256 + lane * 4);
                v[4 * j] = fmaf(g, bf2f((bf16_t)(pk.x & 0xffff)), v[4 * j]); v[4 * j + 1] = fmaf(g, bf2f((bf16_t)(pk.x >> 16)), v[4 * j + 1]);
                v[4 * j + 2] = fmaf(g, bf2f((bf16_t)(pk.y & 0xffff)), v[4 * j + 2]); v[4 * j + 3] = fmaf(g, bf2f((bf16_t)(pk.y >> 16)), v[4 * j + 3]); }
        }
        float s = 0.f;
#pragma unroll
        for (int i = 0; i < 16; ++i) s += v[i];
        const float mean = wave_sum(s) * (1.0f / DM); float q2 = 0.f;
#pragma unroll
        for (int i = 0; i < 16; ++i) { v[i] -= mean; q2 += v[i] * v[i]; }
        const float rstd = rsqrtf(wave_sum(q2) * (1.0f / DM) + LN_EPS);
#pragma unroll
        for (int j = 0; j < 4; ++j) { const int col = j * 256 + lane * 4; const f32x4 gg = *(const GAS f32x4*)(g2 + col), bb = *(const GAS f32x4*)(b2 + col);
            *(GAS f32x4*)(out + (size_t)t * DM + col) = (f32x4){v[4 * j] * rstd * gg.x + bb.x, v[4 * j + 1] * rstd * gg.y + bb.y, v[4 * j + 2] * rstd * gg.z + bb.z, v[4 * j + 3] * rstd * gg.w + bb.w}; }
    }
}

constexpr int N_PHASES = 9;
__global__ void __launch_bounds__(NWAVES * 64, 2) mega_fwd(Args args) {
    extern __shared__ __attribute__((aligned(16))) unsigned char lds[];
    Frame F;
    F.lds = (LAS unsigned char*)lds;
    F.MISC = (volatile LAS unsigned*)(F.lds + MISC_OFF);
    F.tid = threadIdx.x; F.lane = F.tid & 63; F.wave = __builtin_amdgcn_readfirstlane(F.tid >> 6);
    F.G = gridDim.x; { const int bx = blockIdx.x; F.vcu = (F.G % 8 == 0) ? (bx % 8) * (F.G / 8) + bx / 8 : bx; }
    F.ctl = (gu32*)(args.ws + WS_CTL);
    for (int u = F.tid; u < (LDS_BYTES - LDSCTL_OFF) / 4; u += NWAVES * 64) ((LAS unsigned*)(F.lds + LDSCTL_OFF))[u] = 0u;
    __syncthreads();
    const int lo = args.ph_lo, hi = args.ph_hi;
    const bool multi = (hi - lo) > 1;
    XcdBarrier bar; bar.bar = (unsigned*)(F.ctl + CW_BAR); bar.x = 0; bar.st = nullptr;
    if (multi) bar = xcd_barrier_post((unsigned*)(F.ctl + CW_BAR), F.MISC + 8);
#ifndef PH_MASK
#define PH_MASK 0x1FF
#endif
#define IN(k) ((((PH_MASK) >> (k)) & 1) && lo <= (k) && (k) < hi)
#define SEAM(k) do { if (IN(k) && IN((k) + 1)) xcd_barrier(bar); } while (0)
    if (IN(0)) { refresh_frame(F); const Args A = fetch_args(); p0_prologue(F, A); SEAM(0); }
    if (IN(1)) {
        refresh_frame(F); const Args A = fetch_args(); unsigned char* ws = A.ws;
        pg8::Gemm g{(const bf16_t*)(ws + WS_XB), (const bf16_t*)(ws + WS_WIN), NTOK, INW, DM, 0}; pg8::StaticOrder S; S.init(NTOK, INW, F.G, (int)blockIdx.x);
        pg8::EpiProj E{(bf16_t*)(ws + WS_PROJ)};
        pg8::gemm_phase<pg8::EpiProj, pg8::StaticOrder, false>(F.lds + RING_OFF, g, S, E);
        SEAM(1);
    }
    if (IN(2)) {
        refresh_frame(F); const Args A = fetch_args(); unsigned char* ws = A.ws;
        if (A.pad0 & 1) attn_body::attn_phase<8>((char*)lds + RING_OFF, (const bf16_t*)(ws + WS_PROJ), (bf16_t*)(ws + WS_ATTO), F.vcu);
        if (A.pad0 & 2) gmlp_phase(F, A);
        SEAM(2);
    }
    if (IN(3)) { refresh_frame(F); const Args A = fetch_args(); attn_combine_phase(F, A); SEAM(3); }
    if (IN(4)) {
        refresh_frame(F); const Args A = fetch_args(); unsigned char* ws = A.ws;
        pg8::Gemm g{(const bf16_t*)(ws + WS_MIX), (const bf16_t*)(ws + WS_WO), NTOK, DM, DM, 0}; pg8::StaticOrder S; S.init(NTOK, DM, F.G, (int)blockIdx.x);
        pg8::EpiH1 E{A.in[0], (float*)(ws + WS_H1)};
        pg8::gemm_phase<pg8::EpiH1, pg8::StaticOrder, false>(F.lds + RING_OFF, g, S, E);
        SEAM(4);
    }
    if (IN(5)) { refresh_frame(F); const Args A = fetch_args(); route_phase(F, A); SEAM(5); }
    if (IN(6)) {
        refresh_frame(F); const Args A = fetch_args(); unsigned char* ws = A.ws;
        build_tab(F);
        pg8::Gemm g{(const bf16_t*)(ws + WS_XB), (const bf16_t*)(ws + WS_WUP), PADROWS, 2 * DFF, DM, (size_t)2 * DFF * DM};
        pg8::MoeOrder S; S.init((const LAS int*)(F.lds + TAB_OFF), (const int*)(ws + WS_LIST), 8, (int)blockIdx.x);
        pg8::EpiSwiglu E{(bf16_t*)(ws + WS_ACT), A.in[17]};
        pg8::gemm_phase<pg8::EpiSwiglu, pg8::MoeOrder, true>(F.lds + RING_OFF, g, S, E);
        SEAM(6);
    }
    if (IN(7)) {
        refresh_frame(F); const Args A = fetch_args(); unsigned char* ws = A.ws;
        build_tab(F);
        pg8::Gemm g{(const bf16_t*)(ws + WS_ACT), (const bf16_t*)(ws + WS_WDN), PADROWS, DM, DFF, (size_t)DM * DFF};
        pg8::MoeOrder S; S.init((const LAS int*)(F.lds + TAB_OFF), (const int*)(ws + WS_LIST), 4, (int)blockIdx.x);
        pg8::EpiDown E{(bf16_t*)(ws + WS_Y), A.in[19]};
        pg8::gemm_phase<pg8::EpiDown, pg8::MoeOrder, false>(F.lds + RING_OFF, g, S, E);
        SEAM(7);
    }
    if (IN(8)) { refresh_frame(F); const Args A = fetch_args(); build_tab(F); combine_phase(F, A); }
#undef IN
#undef SEAM
}

struct NArgs {
    const float* x; const float* B; const float* bias; const float* bias2;
    const bf16_t* Ab; bf16_t* Ob; float* Of; const int* ctl; const int* list;
};
template <int MODE> __global__ void __launch_bounds__(256) ngemm(NArgs a) {
    constexpr int K = 1024;
    constexpr int LDB = (MODE == 0) ? INW : (MODE == 2 ? 2048 : 1024);
    constexpr bool DUAL = (MODE == 2);
    __shared__ float As[16][68];
    __shared__ float Bs[16][64];
    __shared__ float Bs2[DUAL ? 16 : 1][64];
    const int tid = threadIdx.x, ty = tid >> 4, tx = tid & 15;
    const int row0 = blockIdx.y * 64, col0 = blockIdx.x * 64;
    const float* B = a.B; int e = 0, pst = 0, cnt = 0;
    if (MODE >= 2) {
        const int* ps = a.ctl + CW_PSTART;
        while (e < NE && row0 >= ps[e + 1]) ++e;
        if (e >= NE) return;
        pst = ps[e]; cnt = a.ctl[CW_CNT + e];
        B += (size_t)e * K * LDB;
    }
    const int ar = tid >> 2, ak = (tid & 3) * 4;
    const float* arow_f = nullptr; const bf16_t* arow_b = nullptr;
    if (MODE == 0) arow_f = a.x + (size_t)(row0 + ar) * K;
    else if (MODE == 1 || MODE == 3) arow_b = a.Ab + (size_t)(row0 + ar) * K;
    else { const int r = row0 + ar - pst; const int tok = (r < cnt) ? a.list[e * NTOK + r] : 0; arow_b = a.Ab + (size_t)tok * K; }
    const int bk = tid >> 4, bn = (tid & 15) * 4;
    float acc[4][4], acc2[4][4];
#pragma unroll
    for (int i = 0; i < 4; ++i)
#pragma unroll
        for (int j = 0; j < 4; ++j) { acc[i][j] = 0.f; acc2[i][j] = 0.f; }
    for (int k0 = 0; k0 < K; k0 += 16) {
        float av[4];
        if (MODE == 0) { const float4 t = *(const float4*)(arow_f + k0 + ak); av[0] = t.x; av[1] = t.y; av[2] = t.z; av[3] = t.w; }
        else { const uint2 t = *(const uint2*)(arow_b + k0 + ak); av[0] = bf2f((bf16_t)(t.x & 0xffff)); av[1] = bf2f((bf16_t)(t.x >> 16)); av[2] = bf2f((bf16_t)(t.y & 0xffff)); av[3] = bf2f((bf16_t)(t.y >> 16)); }
        const float4 bv = *(const float4*)(B + (size_t)(k0 + bk) * LDB + col0 + bn);
        float4 bv2 = bv;
        if (DUAL) bv2 = *(const float4*)(B + (size_t)(k0 + bk) * LDB + 1024 + col0 + bn);
        __syncthreads();
#pragma unroll
        for (int c = 0; c < 4; ++c) As[ak + c][ar] = av[c];
        *(float4*)&Bs[bk][bn] = bv;
        if (DUAL) *(float4*)&Bs2[bk][bn] = bv2;
        __syncthreads();
#pragma unroll
        for (int k = 0; k < 16; ++k) {
            const float4 a4 = *(const float4*)&As[k][ty * 4];
            const float4 b4 = *(const float4*)&Bs[k][tx * 4];
            const float aa[4] = {a4.x, a4.y, a4.z, a4.w}, bb[4] = {b4.x, b4.y, b4.z, b4.w};
#pragma unroll
            for (int i = 0; i < 4; ++i)
#pragma unroll
                for (int j = 0; j < 4; ++j) acc[i][j] = fmaf(aa[i], bb[j], acc[i][j]);
            if (DUAL) {
                const float4 c4 = *(const float4*)&Bs2[k][tx * 4];
                const float cc[4] = {c4.x, c4.y, c4.z, c4.w};
#pragma unroll
                for (int i = 0; i < 4; ++i)
#pragma unroll
                    for (int j = 0; j < 4; ++j) acc2[i][j] = fmaf(aa[i], cc[j], acc2[i][j]);
            }
        }
    }
#pragma unroll
    for (int i = 0; i < 4; ++i) {
        const int row = row0 + ty * 4 + i;
#pragma unroll
        for (int j = 0; j < 4; ++j) {
            const int col = col0 + tx * 4 + j;
            if (MODE == 0) { float v = acc[i][j]; if (col < C_K) v *= QSCALE; a.Ob[(size_t)row * INW + col] = f2bf(v); }
            else if (MODE == 1) { a.Of[(size_t)row * DM + col] = ALPHA * a.x[(size_t)row * DM + col] + acc[i][j]; }
            else if (MODE == 2) {
                float g = acc[i][j] + a.bias[e * 2048 + col], l = acc2[i][j] + a.bias[e * 2048 + 1024 + col];
                g = fminf(g, 7.0f); l = fminf(fmaxf(l, -7.0f), 7.0f);
                const float act = (l + 1.0f) * g * (1.0f / (1.0f + expf(-1.702f * g)));
                a.Ob[(size_t)row * DFF + col] = f2bf(act);
            } else { a.Ob[(size_t)row * DM + col] = f2bf(acc[i][j] + a.bias[e * DM + col]); }
        }
    }
}

__global__ void __launch_bounds__(128) nattn(const bf16_t* __restrict__ proj, bf16_t* __restrict__ mix, const float* lq1, const float* lk1, const float* lq2, const float* lk2, const float* subg) {
    __shared__ float sc[2][SEQ];
    const int w = threadIdx.x >> 6, lane = threadIdx.x & 63;
    const int task = blockIdx.x * 2 + w, t = task >> 2, h = task & 3, b = t / SEQ, qpos = t % SEQ;
    const float lam = expf(wave_sum(lq1[lane] * lk1[lane])) - expf(wave_sum(lq2[lane] * lk2[lane])) + LAMBDA_INIT;
    const bf16_t* pb = proj + (size_t)b * SEQ * INW;
    float o[2][2];
    for (int s = 0; s < 2; ++s) {
        float q[DH];
        const bf16_t* qp = proj + (size_t)t * INW + C_Q + s * 256 + h * DH;
#pragma unroll
        for (int d = 0; d < DH; ++d) q[d] = bf2f(qp[d]);
        float m = -INFINITY;
        for (int j = lane; j <= qpos; j += 64) {
            const uint4* kp = (const uint4*)(pb + (size_t)j * INW + C_K + s * 256 + h * DH);
            float acc = 0.f;
#pragma unroll
            for (int c = 0; c < 8; ++c) {
                const uint4 kk = kp[c];
                const uint32_t ww[4] = {kk.x, kk.y, kk.z, kk.w};
#pragma unroll
                for (int z = 0; z < 4; ++z) { acc = fmaf(q[c * 8 + 2 * z], bf2f((bf16_t)(ww[z] & 0xffff)), acc); acc = fmaf(q[c * 8 + 2 * z + 1], bf2f((bf16_t)(ww[z] >> 16)), acc); }
            }
            sc[w][j] = acc; m = fmaxf(m, acc);
        }
        m = wave_max(m);
        float l = 0.f;
        for (int j = lane; j <= qpos; j += 64) { const float p = exp2f(sc[w][j] - m); sc[w][j] = p; l += p; }
        l = wave_sum(l);
        __syncthreads();
        float o0 = 0.f, o1 = 0.f;
        const bf16_t* vp = pb + C_V + h * DV + lane * 2;
        for (int j = 0; j <= qpos; ++j) {
            const float p = sc[w][j];
            const uint32_t vv = *(const uint32_t*)(vp + (size_t)j * INW);
            o0 = fmaf(p, bf2f((bf16_t)(vv & 0xffff)), o0); o1 = fmaf(p, bf2f((bf16_t)(vv >> 16)), o1);
        }
        o[s][0] = o0 / l; o[s][1] = o1 / l;
        __syncthreads();
    }
    const float d0 = o[0][0] - lam * o[1][0], d1 = o[0][1] - lam * o[1][1];
    const float ss = wave_sum(d0 * d0 + d1 * d1);
    const float r = rsqrtf(ss * (1.0f / DV) + LN_EPS) * (1.0f - LAMBDA_INIT);
    const uint32_t pk = (uint32_t)f2bf(d0 * r * subg[lane * 2]) | ((uint32_t)f2bf(d1 * r * subg[lane * 2 + 1]) << 16);
    *(uint32_t*)(mix + (size_t)t * DM + h * DV + lane * 2) = pk;
}

__global__ void __launch_bounds__(256) ngmlp(const bf16_t* __restrict__ proj, bf16_t* __restrict__ mix, const float* lng, const float* lnb, const float* wsp, const float* bsp) {
    __shared__ float mu[CHUNK], rs[CHUNK];
    __shared__ float vn[CHUNK][GD];
    const int c = blockIdx.x, g = blockIdx.y, tid = threadIdx.x, w = tid >> 6, lane = tid & 63;
    const size_t row0 = (size_t)c * CHUNK;
    for (int s = w; s < CHUNK; s += 4) {
        const bf16_t* p = proj + (row0 + s) * INW + C_GV;
        float v[8]; float sum = 0.f;
#pragma unroll
        for (int i = 0; i < 8; ++i) { v[i] = gelu_exact(bf2f(p[lane + 64 * i])); sum += v[i]; }
        const float mean = wave_sum(sum) * (1.0f / GW); float q = 0.f;
#pragma unroll
        for (int i = 0; i < 8; ++i) { const float d = v[i] - mean; q += d * d; }
        const float var = wave_sum(q) * (1.0f / GW);
        if (lane == 0) { mu[s] = mean; rs[s] = rsqrtf(var + LN_EPS); }
    }
    __syncthreads();
    for (int i = tid; i < CHUNK * GD; i += 256) {
        const int s = i >> 6, d = i & 63, col = g * GD + d;
        const float v = gelu_exact(bf2f(proj[(row0 + s) * INW + C_GV + col]));
        vn[s][d] = (v - mu[s]) * rs[s] * lng[col] + lnb[col];
    }
    __syncthreads();
    const int t = tid >> 1, dh = (tid & 1) * 32;
    float z[32];
#pragma unroll
    for (int d = 0; d < 32; ++d) z[d] = 0.f;
    const float* wr = wsp + ((size_t)g * CHUNK + t) * CHUNK;
    for (int s = 0; s <= t; ++s) {
        const float wv = wr[s];
#pragma unroll
        for (int d = 0; d < 32; ++d) z[d] = fmaf(wv, vn[s][dh + d], z[d]);
    }
    const float bb = bsp[g * CHUNK + t];
#pragma unroll
    for (int d = 0; d < 32; ++d) {
        const int col = g * GD + dh + d;
        const float u = gelu_exact(bf2f(proj[(row0 + t) * INW + C_GU + col]));
        mix[(row0 + t) * DM + GW + col] = f2bf(u * (z[d] + bb));
    }
}

__global__ void __launch_bounds__(256) nroute(float* __restrict__ h1, bf16_t* __restrict__ xb, const float* g1, const float* b1, const float* wr, const float* br, int* ctl, int* list, int* re, int* rr, float* rg) {
    const int w = threadIdx.x >> 6, lane = threadIdx.x & 63, t = blockIdx.x * 4 + w;
    float* row = h1 + (size_t)t * DM;
    float v[16]; float s = 0.f;
#pragma unroll
    for (int j = 0; j < 4; ++j) { const float4 q = *(const float4*)(row + j * 256 + lane * 4); v[4 * j] = q.x; v[4 * j + 1] = q.y; v[4 * j + 2] = q.z; v[4 * j + 3] = q.w; s += (q.x + q.y) + (q.z + q.w); }
    const float mean = wave_sum(s) * (1.0f / DM); float q2 = 0.f;
#pragma unroll
    for (int i = 0; i < 16; ++i) { v[i] -= mean; q2 += v[i] * v[i]; }
    const float rstd = rsqrtf(wave_sum(q2) * (1.0f / DM) + LN_EPS);
#pragma unroll
    for (int j = 0; j < 4; ++j) {
        const int col = j * 256 + lane * 4;
#pragma unroll
        for (int c = 0; c < 4; ++c) v[4 * j + c] = v[4 * j + c] * rstd * g1[col + c] + b1[col + c];
        *(float4*)(row + col) = make_float4(v[4 * j], v[4 * j + 1], v[4 * j + 2], v[4 * j + 3]);
        uint2 pk; pk.x = (uint32_t)f2bf(v[4 * j]) | ((uint32_t)f2bf(v[4 * j + 1]) << 16); pk.y = (uint32_t)f2bf(v[4 * j + 2]) | ((uint32_t)f2bf(v[4 * j + 3]) << 16);
        *(uint2*)(xb + (size_t)t * DM + col) = pk;
    }
    float lg[NE];
#pragma unroll
    for (int e = 0; e < NE; ++e) lg[e] = 0.f;
#pragma unroll
    for (int j = 0; j < 4; ++j)
#pragma unroll
        for (int c = 0; c < 4; ++c) {
            const float xv = v[4 * j + c]; const float4* wp = (const float4*)(wr + (size_t)(j * 256 + lane * 4 + c) * NE);
#pragma unroll
            for (int e4 = 0; e4 < 8; ++e4) { const float4 ww = wp[e4]; lg[4 * e4] = fmaf(xv, ww.x, lg[4 * e4]); lg[4 * e4 + 1] = fmaf(xv, ww.y, lg[4 * e4 + 1]); lg[4 * e4 + 2] = fmaf(xv, ww.z, lg[4 * e4 + 2]); lg[4 * e4 + 3] = fmaf(xv, ww.w, lg[4 * e4 + 3]); }
        }
#pragma unroll
    for (int e = 0; e < NE; ++e) lg[e] = wave_sum(lg[e]) + br[e];
    int idx[4]; float val[4]; unsigned taken = 0u;
#pragma unroll
    for (int k = 0; k < 4; ++k) {
        float best = -INFINITY; int bi = 0;
#pragma unroll
        for (int e = 0; e < NE; ++e) { const bool ok = !((taken >> e) & 1u) && lg[e] > best; best = ok ? lg[e] : best; bi = ok ? e : bi; }
        idx[k] = bi; val[k] = best; taken |= 1u << bi;
    }
    float ex[4], se = 0.f;
#pragma unroll
    for (int k = 0; k < 4; ++k) { ex[k] = expf(val[k] - val[0]); se += ex[k]; }
    if (lane == 0) {
#pragma unroll
        for (int k = 0; k < 4; ++k) {
            const int r = atomicAdd(ctl + CW_CNT + idx[k], 1);
            list[idx[k] * NTOK + r] = t;
            re[t * 4 + k] = idx[k]; rr[t * 4 + k] = r; rg[t * 4 + k] = ex[k] / se;
        }
    }
}
__global__ void npstart(int* ctl) {
    if (threadIdx.x == 0 && blockIdx.x == 0) { int p = 0; for (int e = 0; e < NE; ++e) { ctl[CW_PSTART + e] = p; p += ((ctl[CW_CNT + e] + 255) / 256) * 256; } ctl[CW_PSTART + NE] = p; }
}
__global__ void __launch_bounds__(256) ncombine(const float* __restrict__ x1, const bf16_t* __restrict__ y, const int* ctl, const int* re, const int* rr, const float* rg, const float* g2, const float* b2, float* __restrict__ out) {
    const int w = threadIdx.x >> 6, lane = threadIdx.x & 63, t = blockIdx.x * 4 + w;
    float v[16];
#pragma unroll
    for (int j = 0; j < 4; ++j) { const float4 q = *(const float4*)(x1 + (size_t)t * DM + j * 256 + lane * 4); v[4 * j] = ALPHA * q.x; v[4 * j + 1] = ALPHA * q.y; v[4 * j + 2] = ALPHA * q.z; v[4 * j + 3] = ALPHA * q.w; }
#pragma unroll
    for (int k = 0; k < 4; ++k) {
        const int e = re[t * 4 + k], slot = ctl[CW_PSTART + e] + rr[t * 4 + k]; const float g = rg[t * 4 + k];
        const bf16_t* yr = y + (size_t)slot * DM;
#pragma unroll
        for (int j = 0; j < 4; ++j) { const uint2 pk = *(const uint2*)(yr + j * 256 + lane * 4);
            v[4 * j] = fmaf(g, bf2f((bf16_t)(pk.x & 0xffff)), v[4 * j]); v[4 * j + 1] = fmaf(g, bf2f((bf16_t)(pk.x >> 16)), v[4 * j + 1]);
            v[4 * j + 2] = fmaf(g, bf2f((bf16_t)(pk.y & 0xffff)), v[4 * j + 2]); v[4 * j + 3] = fmaf(g, bf2f((bf16_t)(pk.y >> 16)), v[4 * j + 3]); }
    }
    float s = 0.f;
#pragma unroll
    for (int i = 0; i < 16; ++i) s += v[i];
    const float mean = wave_sum(s) * (1.0f / DM); float q2 = 0.f;
#pragma unroll
    for (int i = 0; i < 16; ++i) { v[i] -= mean; q2 += v[i] * v[i]; }
    const float rstd = rsqrtf(wave_sum(q2) * (1.0f / DM) + LN_EPS);
#pragma unroll
    for (int j = 0; j < 4; ++j) { const int col = j * 256 + lane * 4;
        *(float4*)(out + (size_t)t * DM + col) = make_float4(v[4 * j] * rstd * g2[col] + b2[col], v[4 * j + 1] * rstd * g2[col + 1] + b2[col + 1], v[4 * j + 2] * rstd * g2[col + 2] + b2[col + 2], v[4 * j + 3] * rstd * g2[col + 3] + b2[col + 3]); }
}

#ifndef OPT_MASK
#define OPT_MASK 0x1FF
#endif
#ifndef FUSED
#define FUSED 0
#endif
static void launch_mega(const Args& base, int lo, int hi, int sub, hipStream_t stream) {
    Args a = base; a.ph_lo = lo; a.ph_hi = hi; a.pad0 = sub; a.pad1 = 0;
    hipLaunchKernelGGL(mega_fwd, dim3(256), dim3(NWAVES * 64), LDS_BYTES, stream, a);
}
extern "C" void kernel_launch(void* const* d_in, const int* in_sizes, int n_in, void* d_out, int out_size, void* d_ws, size_t ws_size, hipStream_t stream) {
    static int ready = 0;
    if (ready == 0) {
        if (n_in != 22 || in_sizes[0] != NTOK * DM || out_size != NTOK * DM || ws_size < WS_END) { fprintf(stderr, "kernel_launch: unexpected shapes (n_in %d, in0 %d, out %d, ws %zu)\n", n_in, n_in > 0 ? in_sizes[0] : -1, out_size, ws_size); ready = -1; return; }
        if (hipFuncSetAttribute((const void*)mega_fwd, hipFuncAttributeMaxDynamicSharedMemorySize, LDS_BYTES) != hipSuccess) { fprintf(stderr, "kernel_launch: hipFuncSetAttribute failed\n"); ready = -1; return; }
        ready = 1;
    }
    if (ready < 0) return;
    const float* x = (const float*)d_in[0]; const float* w_in = (const float*)d_in[1];
    const float *lq1 = (const float*)d_in[2], *lk1 = (const float*)d_in[3], *lq2 = (const float*)d_in[4], *lk2 = (const float*)d_in[5];
    const float *subg = (const float*)d_in[6], *glng = (const float*)d_in[7], *glnb = (const float*)d_in[8], *wsp = (const float*)d_in[9], *bsp = (const float*)d_in[10];
    const float *w_o = (const float*)d_in[11], *ln1g = (const float*)d_in[12], *ln1b = (const float*)d_in[13], *w_r = (const float*)d_in[14], *b_r = (const float*)d_in[15];
    const float *w_up = (const float*)d_in[16], *b_up = (const float*)d_in[17], *w_dn = (const float*)d_in[18], *b_dn = (const float*)d_in[19], *ln2g = (const float*)d_in[20], *ln2b = (const float*)d_in[21];
    unsigned char* ws = (unsigned char*)d_ws;
    int* ctl = (int*)(ws + WS_CTL); int* list = (int*)(ws + WS_LIST); int* re = (int*)(ws + WS_RE); int* rr = (int*)(ws + WS_RR); float* rg = (float*)(ws + WS_RG);
    bf16_t* xb = (bf16_t*)(ws + WS_XB); bf16_t* proj = (bf16_t*)(ws + WS_PROJ); bf16_t* mix = (bf16_t*)(ws + WS_MIX); bf16_t* yb = (bf16_t*)(ws + WS_Y);
    float* h1 = (float*)(ws + WS_H1); bf16_t* act = (bf16_t*)(ws + WS_ACT);
    (void)hipMemsetAsync(ws + WS_CTL, 0, CTL_BYTES, stream);
    Args base{};
    for (int i = 0; i < 22; ++i) base.in[i] = (const float*)d_in[i];
    base.out = (float*)d_out; base.ws = ws;
    constexpr unsigned OM = OPT_MASK;
#if FUSED
    static_assert(OM == 0x1FFu, "FUSED needs every stage in the persistent kernel");
    launch_mega(base, 0, N_PHASES, 3, stream);
#else
    if (OM & 0xD3u) launch_mega(base, 0, 1, 0, stream);
    if (OM & 2u) launch_mega(base, 1, 2, 0, stream);
    else { NArgs a{}; a.x = x; a.B = w_in; a.Ob = proj; ngemm<0><<<dim3(INW / 64, NTOK / 64), 256, 0, stream>>>(a); }
    if ((OM & 4u) || (OM & 8u)) launch_mega(base, 2, 3, ((OM & 4u) ? 1 : 0) | ((OM & 8u) ? 2 : 0), stream);
    if (OM & 4u) launch_mega(base, 3, 4, 0, stream);
    else nattn<<<NTOK * NH / 2, 128, 0, stream>>>(proj, mix, lq1, lk1, lq2, lk2, subg);
    if (!(OM & 8u)) ngmlp<<<dim3(NTOK / CHUNK, NG), 256, 0, stream>>>(proj, mix, glng, glnb, wsp, bsp);
    if (OM & 16u) launch_mega(base, 4, 5, 0, stream);
    else { NArgs a{}; a.x = x; a.B = w_o; a.Ab = mix; a.Of = h1; ngemm<1><<<dim3(DM / 64, NTOK / 64), 256, 0, stream>>>(a); }
    if (OM & 32u) launch_mega(base, 5, 6, 0, stream);
    else nroute<<<NTOK / 4, 256, 0, stream>>>(h1, xb, ln1g, ln1b, w_r, b_r, ctl, list, re, rr, rg);
    if ((OM & 0x1C0u) != 0x1C0u) npstart<<<1, 64, 0, stream>>>(ctl);
    if (OM & 64u) launch_mega(base, 6, 7, 0, stream);
    else { NArgs a{}; a.B = w_up; a.bias = b_up; a.Ab = xb; a.Ob = act; a.ctl = ctl; a.list = list; ngemm<2><<<dim3(DFF / 64, PADROWS / 64), 256, 0, stream>>>(a); }
    if (OM & 128u) launch_mega(base, 7, 8, 0, stream);
    else { NArgs a{}; a.B = w_dn; a.bias = b_dn; a.Ab = act; a.Ob = yb; a.ctl = ctl; a.list = list; ngemm<3><<<dim3(DM / 64, PADROWS / 64), 256, 0, stream>>>(a); }
    if (OM & 256u) launch_mega(base, 8, 9, 0, stream);
    else ncombine<<<NTOK / 4, 256, 0, stream>>>(h1, yb, ctl, re, rr, rg, ln2g, ln2b, (float*)d_out);
#endif
}
```

```cpp
#include <hip/hip_runtime.h>
#include <hip/hip_bf16.h>
#include <cstdint>
#include <cstdio>
#include <cmath>

#ifndef MOE_FP8
#define MOE_FP8 1
#endif
namespace cfg {
constexpr int BATCH = 8, SEQ = 4096, NTOK = BATCH * SEQ, DM = 1024;
constexpr int INW = 2560, NH = 4, DH = 64, DV = 128;
constexpr int C_Q = 0, C_K = 512, C_V = 1024, C_GU = 1536, C_GV = 2048;
constexpr int GW = 512, NG = 8, GD = 64, CHUNK = 128;
constexpr int NE = 32, TOPK = 4, DFF = 1024;
constexpr int PADROWS = 139264;
constexpr float LN_EPS = 1e-5f;
constexpr float ALPHA = 1.189207115002721f;
constexpr float LAMBDA_INIT = 0.2f;
constexpr float QSCALE = 0.125f * 1.4426950408889634f;
constexpr size_t MiB = 1u << 20;
constexpr size_t WS_CTL = 0, CTL_BYTES = 1 * MiB;
constexpr size_t WS_LIST = 1 * MiB;
constexpr size_t WS_RE = 5 * MiB, WS_RR = 5 * MiB + 512 * 1024, WS_RG = 6 * MiB;
constexpr size_t WS_WIN = 8 * MiB;
constexpr size_t WS_WO = 13 * MiB;
constexpr size_t WS_WUP = 16 * MiB;
constexpr size_t WS_WDN = 144 * MiB;
constexpr size_t WS_XB = 208 * MiB;
constexpr size_t WS_PROJ = 272 * MiB;
constexpr size_t WS_MIX = 432 * MiB;
constexpr size_t WS_ATTO = 496 * MiB;
constexpr size_t WS_Y = 272 * MiB;
constexpr size_t WS_H1 = 560 * MiB;
constexpr size_t WS_ACT = 688 * MiB;
constexpr size_t WS_END = 960 * MiB;
constexpr int CW_CNT = 0;
constexpr int CW_PSTART = 64;
constexpr int CW_BAR = 4096;
}
using namespace cfg;
typedef uint16_t bf16_t;

__device__ __forceinline__ float bf2f(bf16_t b) { return __uint_as_float((uint32_t)b << 16); }
__device__ __forceinline__ bf16_t f2bf(float f) { uint32_t u = __float_as_uint(f); u += 0x7fffu + ((u >> 16) & 1u); return (bf16_t)(u >> 16); }
__device__ __forceinline__ uint32_t pk2(float lo, float hi) { return (uint32_t)f2bf(lo) | ((uint32_t)f2bf(hi) << 16); }
__device__ __forceinline__ float wave_sum(float v) {
#pragma unroll
    for (int o = 1; o < 64; o <<= 1) v += __shfl_xor(v, o);
    return v;
}
__device__ __forceinline__ float wave_max(float v) {
#pragma unroll
    for (int o = 1; o < 64; o <<= 1) v = fmaxf(v, __shfl_xor(v, o));
    return v;
}
__device__ __forceinline__ float gelu_exact(float x) { return 0.5f * x * (1.0f + erff(x * 0.70710678118654752f)); }

#define OPT_MASK 0x1FF
#define FUSED 1
#define DOUBLE_MASK 0
namespace pg8 {
#define PG8_LAS __attribute__((address_space(3)))
typedef short bf16x8 __attribute__((ext_vector_type(8)));
typedef float f32x4 __attribute__((ext_vector_type(4)));
typedef float f32x2 __attribute__((ext_vector_type(2)));
typedef unsigned u32x4 __attribute__((ext_vector_type(4)));
typedef int v4i_t __attribute__((ext_vector_type(4)));
typedef int v8i_t __attribute__((ext_vector_type(8)));
constexpr int WSHIFT = 6;
constexpr int WSCALE_E8M0 = (127 - WSHIFT) * 0x01010101;
constexpr int BM = 256, BK = 64, HALF = 128, HTB = HALF * BK * 2  , STAGE_BYTES = 8 * HTB, NXCD = 8, WGM = 8;

__host__ __device__ __forceinline__ int lds_byte(int r, int c) { const int st = (r >> 4) * 2 + (c >> 5), rr = r & 15, cc = c & 31, ob = rr * 64 + cc * 2; return st * 1024 + (ob ^ (((ob >> 9) & 1) << 5)); }
__host__ __device__ __forceinline__ void stage_rc(int b, int& R, int& C) { const int st = b / 1024, sb = b % 1024, swz = sb ^ (((sb >> 9) & 1) << 5); R = (st >> 1) * 16 + swz / 64; C = (st & 1) * 32 + (swz % 64) / 2; }
__host__ __device__ __forceinline__ int perm32(int rho) { const int n = rho >> 4, i = rho & 15; return 8 * (i >> 2) + 4 * n + (i & 3); }

struct Unit { int pm, pn, e; };
struct Gemm { const bf16_t* A; const bf16_t* Bt; int M, N, K; size_t strideB; };

struct StaticOrder {
    int nM, nN, nwg, G, c;
    __host__ __device__ void init(int M, int N, int G_, int c_) { nM = M / BM; nN = N / BM; nwg = nM * nN; G = G_; c = c_; }
    __host__ __device__ bool next(int i, Unit& u) const {
        const long L = (long)i * G + c; if (L >= nwg) return false;
        int wgid = (int)L; { const int q = nwg / NXCD, r = nwg % NXCD, xcd = wgid % NXCD, off = wgid / NXCD; wgid = (xcd < r ? xcd * (q + 1) : r * (q + 1) + (xcd - r) * q) + off; }
        const int nig = WGM * nN, gid = wgid / nig, fm = gid * WGM, gsz = (nM - fm) < WGM ? (nM - fm) : WGM;
        u.pm = fm + ((wgid % nig) % gsz); u.pn = (wgid % nig) / gsz; u.e = 0; return true;
    }
    __device__ __forceinline__ void gather(const Unit&, const int (&)[2], const int (&)[2], unsigned (&)[2][2], unsigned) const {}
};
struct MoeOrder {
    const PG8_LAS int* tab; const int* list; int NC, RG, chunk0, nrt, j0;
    __device__ __forceinline__ void init(const PG8_LAS int* tab_, const int* list_, int NC_, int bid) {
        tab = tab_; list = list_; NC = NC_; RG = 32 / NC_; const int x = bid & 7; j0 = bid >> 3;
        const int T = __builtin_amdgcn_readfirstlane(tab_[32]); chunk0 = (T * x) / 8; nrt = (T * (x + 1)) / 8 - chunk0;
    }
    __device__ __forceinline__ bool next(int i, Unit& u) const {
        const int pml = i * RG + (j0 % RG); if (pml >= nrt) return false;
        u.pm = chunk0 + pml; u.pn = j0 / RG; int e = 0;
        while (e < NE - 1 && u.pm >= __builtin_amdgcn_readfirstlane(tab[e + 1])) ++e;
        u.e = e; return true;
    }
    __device__ __forceinline__ void gather(const Unit& u, const int (&RA)[2], const int (&CA2)[2], unsigned (&go)[2][2], unsigned rowbytes) const {
        const int r0 = (u.pm - __builtin_amdgcn_readfirstlane(tab[u.e])) * BM, cnt = __builtin_amdgcn_readfirstlane(tab[40 + u.e]);
#pragma unroll
        for (int h = 0; h < 2; ++h)
#pragma unroll
            for (int i = 0; i < 2; ++i) { const int r = r0 + h * HALF + RA[i]; const int tok = (r < cnt) ? list[u.e * NTOK + r] : 0; go[h][i] = (unsigned)tok * rowbytes + (unsigned)CA2[i]; }
    }
};

__device__ __forceinline__ unsigned cvt_pk_bf16(float lo, float hi) { unsigned r; asm volatile("v_cvt_pk_bf16_f32 %0, %1, %2" : "=v"(r) : "v"(lo), "v"(hi)); return r; }
__device__ __forceinline__ f32x2 gelu_pk(f32x2 v) {
    const f32x2 av = __builtin_elementwise_abs(v), d = av * 0.2316418882f + 1.0f;
    f32x2 t; t.x = __builtin_amdgcn_rcpf(d.x); t.y = __builtin_amdgcn_rcpf(d.y);
    f32x2 q = t * 0.5307027145f + (-0.7265760135f); q = q * t + 0.7107068705f; q = q * t + (-0.142248368f); q = q * t + 0.127414796f; q = q * t;
    const f32x2 s = (v * v) * (-0.72134752044f);
    f32x2 e; e.x = __builtin_amdgcn_exp2f(s.x); e.y = __builtin_amdgcn_exp2f(s.y);
    const f32x2 m = v * (q * e), r = v - m;
    f32x2 o; o.x = v.x < 0.f ? m.x : r.x; o.y = v.y < 0.f ? m.y : r.y; return o;
}
__device__ __forceinline__ float gelu1(float v) { return gelu_pk((f32x2){v, v}).x; }

struct EpiProj {
    static constexpr bool PERM = true;
    bf16_t* O;
    __device__ __forceinline__ void operator()(const f32x4 (&acc)[2][2][4][2], const Unit& u, int wr, int wc, int fr, int fq) const {
        const int row0 = u.pm * BM + wr * 64 + fr, col0 = u.pn * BM + wc * 32 + 8 * fq; const float sc = (u.pn < 2) ? QSCALE : 1.0f;
#pragma unroll
        for (int ai = 0; ai < 2; ++ai)
#pragma unroll
            for (int m = 0; m < 4; ++m) { bf16_t* rowp = O + (size_t)(row0 + ai * HALF + m * 16) * INW + col0;
#pragma unroll
                for (int bj = 0; bj < 2; ++bj) { const f32x4 v0 = acc[ai][bj][m][0] * sc, v1 = acc[ai][bj][m][1] * sc;
                    u32x4 w; w.x = cvt_pk_bf16(v0[0], v0[1]); w.y = cvt_pk_bf16(v0[2], v0[3]); w.z = cvt_pk_bf16(v1[0], v1[1]); w.w = cvt_pk_bf16(v1[2], v1[3]);
                    *(u32x4*)(rowp + bj * HALF) = w; } }
    }
};
struct EpiH1 {
    static constexpr bool PERM = false;
    const float* X; float* C;
    __device__ __forceinline__ void operator()(const f32x4 (&acc)[2][2][4][2], const Unit& u, int wr, int wc, int fr, int fq) const {
        const int row0 = u.pm * BM + wr * 64 + fr, col0 = u.pn * BM + wc * 32 + 4 * fq;
#pragma unroll
        for (int ai = 0; ai < 2; ++ai)
#pragma unroll
            for (int m = 0; m < 4; ++m) { const size_t off = (size_t)(row0 + ai * HALF + m * 16) * DM + col0;
#pragma unroll
                for (int bj = 0; bj < 2; ++bj)
#pragma unroll
                    for (int n = 0; n < 2; ++n) { const f32x4 xv = *(const f32x4*)(X + off + bj * HALF + n * 16); *(f32x4*)(C + off + bj * HALF + n * 16) = xv * ALPHA + acc[ai][bj][m][n]; } }
    }
};
struct EpiSwiglu {
    static constexpr bool PERM = true;
    bf16_t* O; const float* bias;
    __device__ __forceinline__ void operator()(const f32x4 (&acc)[2][2][4][2], const Unit& u, int wr, int wc, int fr, int fq) const {
        const int row0 = u.pm * BM + wr * 64 + fr, col0 = u.pn * HALF + wc * 32 + 8 * fq;
        const float* bp = bias + (size_t)u.e * (2 * DFF) + col0;
        f32x4 bg[2], bl[2];
#pragma unroll
        for (int n = 0; n < 2; ++n) { bg[n] = *(const f32x4*)(bp + 4 * n); bl[n] = *(const f32x4*)(bp + DFF + 4 * n); }
#pragma unroll
        for (int ai = 0; ai < 2; ++ai)
#pragma unroll
            for (int m = 0; m < 4; ++m) { float a8[8];
#pragma unroll
                for (int n = 0; n < 2; ++n) { const f32x4 g4 = acc[ai][0][m][n] + bg[n], l4 = acc[ai][1][m][n] + bl[n];
#pragma unroll
                    for (int j = 0; j < 4; ++j) { const float g = fminf(g4[j], 7.0f), l = fminf(fmaxf(l4[j], -7.0f), 7.0f);
                        const float sg = __builtin_amdgcn_rcpf(1.0f + __builtin_amdgcn_exp2f(g * (-1.702f * 1.4426950408889634f)));
                        a8[4 * n + j] = (l + 1.0f) * g * sg; } }
                u32x4 w; w.x = cvt_pk_bf16(a8[0], a8[1]); w.y = cvt_pk_bf16(a8[2], a8[3]); w.z = cvt_pk_bf16(a8[4], a8[5]); w.w = cvt_pk_bf16(a8[6], a8[7]);
                *(u32x4*)(O + (size_t)(row0 + ai * HALF + m * 16) * DFF + col0) = w; }
    }
};
struct EpiDown {
    static constexpr bool PERM = true;
    bf16_t* O; const float* bias;
    __device__ __forceinline__ void operator()(const f32x4 (&acc)[2][2][4][2], const Unit& u, int wr, int wc, int fr, int fq) const {
        const int row0 = u.pm * BM + wr * 64 + fr, col0 = u.pn * BM + wc * 32 + 8 * fq;
        const float* bp = bias + (size_t)u.e * DM + col0;
        f32x4 bv[2][2];
#pragma unroll
        for (int bj = 0; bj < 2; ++bj)
#pragma unroll
            for (int n = 0; n < 2; ++n) bv[bj][n] = *(const f32x4*)(bp + bj * HALF + 4 * n);
#pragma unroll
        for (int ai = 0; ai < 2; ++ai)
#pragma unroll
            for (int m = 0; m < 4; ++m) { bf16_t* rowp = O + (size_t)(row0 + ai * HALF + m * 16) * DM + col0;
#pragma unroll
                for (int bj = 0; bj < 2; ++bj) { const f32x4 v0 = acc[ai][bj][m][0] + bv[bj][0], v1 = acc[ai][bj][m][1] + bv[bj][1];
                    u32x4 w; w.x = cvt_pk_bf16(v0[0], v0[1]); w.y = cvt_pk_bf16(v0[2], v0[3]); w.z = cvt_pk_bf16(v1[0], v1[1]); w.w = cvt_pk_bf16(v1[2], v1[3]);
                    *(u32x4*)(rowp + bj * HALF) = w; } }
    }
};

__device__ __forceinline__ unsigned pk4_fp8(float a, float b, float c, float d) { int w = 0; w = __builtin_amdgcn_cvt_pk_fp8_f32(a, b, w, false); w = __builtin_amdgcn_cvt_pk_fp8_f32(c, d, w, true); return (unsigned)w; }
typedef unsigned u32x2 __attribute__((ext_vector_type(2)));
struct EpiSwiglu8 {
    static constexpr bool PERM = true;
    unsigned char* O; const float* bias;
    __device__ __forceinline__ void operator()(const f32x4 (&acc)[2][2][4][2], const Unit& u, int wr, int wc, int fr, int fq) const {
        const int row0 = u.pm * BM + wr * 64 + fr, col0 = u.pn * HALF + wc * 32 + 8 * fq;
        const float* bp = bias + (size_t)u.e * (2 * DFF) + col0;
        f32x4 bg[2], bl[2];
#pragma unroll
        for (int n = 0; n < 2; ++n) { bg[n] = *(const f32x4*)(bp + 4 * n); bl[n] = *(const f32x4*)(bp + DFF + 4 * n); }
#pragma unroll
        for (int ai = 0; ai < 2; ++ai)
#pragma unroll
            for (int m = 0; m < 4; ++m) { float a8[8];
#pragma unroll
                for (int n = 0; n < 2; ++n) { const f32x4 g4 = acc[ai][0][m][n] + bg[n], l4 = acc[ai][1][m][n] + bl[n];
#pragma unroll
                    for (int j = 0; j < 4; ++j) { const float g = fminf(g4[j], 7.0f), l = fminf(fmaxf(l4[j], -7.0f), 7.0f);
                        const float sg = __builtin_amdgcn_rcpf(1.0f + __builtin_amdgcn_exp2f(g * (-1.702f * 1.4426950408889634f)));
                        a8[4 * n + j] = (l + 1.0f) * g * sg; } }
                u32x2 w; w.x = pk4_fp8(a8[0], a8[1], a8[2], a8[3]); w.y = pk4_fp8(a8[4], a8[5], a8[6], a8[7]);
                *(u32x2*)(O + (size_t)(row0 + ai * HALF + m * 16) * DFF + col0) = w; }
    }
};

template <class Epi, class Sched, bool GATHER, bool FP8 = false>
__device__ __forceinline__ void gemm_phase(PG8_LAS unsigned char* lds, const Gemm g, const Sched& S, const Epi& E) {
    int tid_ = threadIdx.x; asm volatile("" : "+v"(tid_));
    const int tid = tid_, wid = __builtin_amdgcn_readfirstlane(tid >> 6), lane = tid & 63, wr = wid >> 2, wc = wid & 3, fr = lane & 15, fq = lane >> 4;
    const int K = FP8 ? g.K / 2 : g.K, nt = K / BK;
    unsigned voffB[2]; int RA[2], CA2[2]; unsigned voffA[2];
#pragma unroll
    for (int i = 0; i < 2; ++i) { int R, C; stage_rc(tid * 16 + i * 8192, R, C); const int Rb = Epi::PERM ? ((R & ~31) + perm32(R & 31)) : R;
        voffA[i] = (unsigned)(R * K + C) * 2u; voffB[i] = (unsigned)(Rb * K + C) * 2u; RA[i] = R; CA2[i] = C * 2; }
    const size_t kstep = (size_t)(BK * 2);
    const size_t hstep = (size_t)HALF * K * 2;
    const size_t tstep = 2 * hstep;
    const unsigned ldsw = (unsigned)wid * 1024u;
    const int aoff = lds_byte(wr * 64 + fr, fq * 8), boff = lds_byte(wc * 32 + fr, fq * 8);
    const unsigned lds0 = (unsigned)(uintptr_t)lds;
#define PG8_SA(b, h) (((b) * 2 + (h)) * HTB)
#define PG8_SB(b, h) ((4 + (b) * 2 + (h)) * HTB)
#define PG8_GLDS(sbase, voff, ldsoff) do { unsigned keep_; asm volatile("s_mov_b32 %0, m0\n\ts_mov_b32 m0, %3\n\ts_nop 0\n\tglobal_load_lds_dwordx4 %1, %2\n\ts_mov_b32 m0, %0" \
        : "=&s"(keep_) : "v"(voff), "s"(sbase), "s"((unsigned)__builtin_amdgcn_readfirstlane((int)(lds0 + (unsigned)(ldsoff)))) : "memory"); } while (0)
#define PG8_STAGE_B(bufoff, gbase) do { PG8_GLDS((const char*)(gbase), voffB[0], (bufoff) + ldsw); PG8_GLDS((const char*)(gbase), voffB[1], (bufoff) + ldsw + 8192); } while (0)
#define PG8_STAGE_A(bufoff, gbase, o0, o1) do { PG8_GLDS((const char*)(gbase), (o0), (bufoff) + ldsw); PG8_GLDS((const char*)(gbase), (o1), (bufoff) + ldsw + 8192); } while (0)
#define PG8_LDA(dst, b, h) do { _Pragma("unroll") for (int m = 0; m < 4; ++m) _Pragma("unroll") for (int k = 0; k < 2; ++k) dst[m][k] = *(const PG8_LAS bf16x8*)(lds + PG8_SA(b, h) + aoff + m * 2048 + k * 1024); } while (0)
#define PG8_LDB(dst, b, h) do { _Pragma("unroll") for (int n = 0; n < 2; ++n) _Pragma("unroll") for (int k = 0; k < 2; ++k) dst[n][k] = *(const PG8_LAS bf16x8*)(lds + PG8_SB(b, h) + boff + n * 2048 + k * 1024); } while (0)
#define PG8_LD8(p) __builtin_shufflevector(*(const PG8_LAS v4i_t*)(p), *(const PG8_LAS v4i_t*)((p) + 1024), 0, 1, 2, 3, 4, 5, 6, 7)
#define PG8_LDA8(dst, b, h) do { _Pragma("unroll") for (int m = 0; m < 4; ++m) dst[m] = PG8_LD8(lds + PG8_SA(b, h) + aoff + m * 2048); } while (0)
#define PG8_LDB8(dst, b, h) do { _Pragma("unroll") for (int n = 0; n < 2; ++n) dst[n] = PG8_LD8(lds + PG8_SB(b, h) + boff + n * 2048); } while (0)
#define PG8_MMA(ai, bj, At, Bt) do { __builtin_amdgcn_s_setprio(1); \
        if constexpr (FP8) { _Pragma("unroll") for (int m = 0; m < 4; ++m) _Pragma("unroll") for (int n = 0; n < 2; ++n) \
            acc[ai][bj][m][n] = __builtin_amdgcn_mfma_scale_f32_16x16x128_f8f6f4(Bt##8[n], At##8[m], acc[ai][bj][m][n], 0, 0, 0, WSCALE_E8M0, 0, 0x7f7f7f7f); \
              \
            _Pragma("unroll") for (int m = 0; m < 4; ++m) _Pragma("unroll") for (int n = 0; n < 2; ++n) asm volatile("" : "+v"(acc[ai][bj][m][n])); } \
        else { _Pragma("unroll") for (int m = 0; m < 4; ++m) _Pragma("unroll") for (int n = 0; n < 2; ++n) _Pragma("unroll") for (int k = 0; k < 2; ++k) \
            acc[ai][bj][m][n] = __builtin_amdgcn_mfma_f32_16x16x32_bf16(Bt[n][k], At[m][k], acc[ai][bj][m][n], 0, 0, 0); } \
        __builtin_amdgcn_s_setprio(0); } while (0)
#define PG8_XLDA(dst, b, h) do { if constexpr (FP8) PG8_LDA8(dst##8, b, h); else PG8_LDA(dst, b, h); } while (0)
#define PG8_XLDB(dst, b, h) do { if constexpr (FP8) PG8_LDB8(dst##8, b, h); else PG8_LDB(dst, b, h); } while (0)
#define PG8_WAIT_V(n) asm volatile("s_waitcnt vmcnt(" #n ")" ::: "memory")
#define PG8_WAIT_L(n) asm volatile("s_waitcnt lgkmcnt(" #n ")" ::: "memory")
#define PG8_BAR __builtin_amdgcn_s_barrier()
#define PG8_SCHED __builtin_amdgcn_sched_barrier(0)
    Unit cur, nxt; int ui = 0;
    if (!S.next(0, cur)) return;
    f32x4 acc[2][2][4][2];
#pragma unroll
    for (int a = 0; a < 2; ++a)
#pragma unroll
        for (int b = 0; b < 2; ++b)
#pragma unroll
            for (int m = 0; m < 4; ++m)
#pragma unroll
                for (int n = 0; n < 2; ++n) acc[a][b][m][n] = (f32x4){0.f, 0.f, 0.f, 0.f};
    bf16x8 At[4][2], B0[2][2], B1[2][2]; v8i_t At8[4], B08[2], B18[2];
    const char* cA = GATHER ? (const char*)g.A : (const char*)g.A + (size_t)cur.pm * tstep;
    const char* cB = (const char*)g.Bt + ((size_t)cur.e * g.strideB) * 2 + (size_t)cur.pn * tstep;
    unsigned gc[2][2], gn[2][2];
    if constexpr (GATHER) { S.gather(cur, RA, CA2, gc, (unsigned)(K * 2)); }
    else {
#pragma unroll
        for (int h = 0; h < 2; ++h)
#pragma unroll
            for (int i = 0; i < 2; ++i) gc[h][i] = (unsigned)(h * hstep) + voffA[i]; }
#pragma unroll
    for (int h = 0; h < 2; ++h)
#pragma unroll
        for (int i = 0; i < 2; ++i) gn[h][i] = gc[h][i];
    PG8_STAGE_B(PG8_SB(0, 0), cB); PG8_STAGE_B(PG8_SB(0, 1), cB + hstep); PG8_STAGE_A(PG8_SA(0, 0), cA, gc[0][0], gc[0][1]); PG8_STAGE_A(PG8_SA(0, 1), cA, gc[1][0], gc[1][1]);
    if (wr == 1) PG8_BAR;
    PG8_WAIT_V(2); PG8_BAR;
    PG8_STAGE_B(PG8_SB(1, 0), cB + kstep); PG8_STAGE_A(PG8_SA(1, 0), cA + kstep, gc[0][0], gc[0][1]); PG8_STAGE_B(PG8_SB(1, 1), cB + hstep + kstep);
    PG8_WAIT_V(6); PG8_BAR;
    for (;;) {
        const bool has_next = S.next(ui + 1, nxt);
        const char* nA = GATHER ? cA : (has_next ? (const char*)g.A + (size_t)nxt.pm * tstep : cA);
        const char* nB = has_next ? (const char*)g.Bt + ((size_t)nxt.e * g.strideB) * 2 + (size_t)nxt.pn * tstep : cB;
        if constexpr (GATHER) { if (has_next) S.gather(nxt, RA, CA2, gn, (unsigned)(K * 2)); }
        for (int t = 0; t < nt; t += 2) {
            const bool last = (t == nt - 2);
            const char* a1 = cA + (size_t)(t + 1) * kstep;
            const char* a2 = last ? nA : cA + (size_t)(t + 2) * kstep; const char* b2 = last ? nB : cB + (size_t)(t + 2) * kstep;
            const char* a3 = a2 + kstep; const char* b3 = b2 + kstep;
            unsigned o00 = gc[0][0], o01 = gc[0][1], o10 = gc[1][0], o11 = gc[1][1];
            if constexpr (GATHER) { if (last) { o00 = gn[0][0]; o01 = gn[0][1]; o10 = gn[1][0]; o11 = gn[1][1]; } }
            PG8_XLDB(B0, 0, 0); PG8_XLDB(B1, 0, 1); PG8_SCHED; PG8_XLDA(At, 0, 0); PG8_STAGE_A(PG8_SA(1, 1), a1, gc[1][0], gc[1][1]);
            PG8_WAIT_V(8); PG8_WAIT_L(0); PG8_BAR; PG8_MMA(0, 0, At, B0); PG8_MMA(0, 1, At, B1); PG8_BAR; PG8_SCHED;
            PG8_XLDA(At, 0, 1); PG8_STAGE_B(PG8_SB(0, 0), b2); PG8_STAGE_B(PG8_SB(0, 1), b2 + hstep); PG8_STAGE_A(PG8_SA(0, 0), a2, o00, o01);
            PG8_WAIT_V(8); PG8_WAIT_L(0); PG8_BAR; PG8_MMA(1, 0, At, B0); PG8_MMA(1, 1, At, B1); PG8_BAR; PG8_SCHED;
            PG8_XLDB(B0, 1, 0); PG8_XLDB(B1, 1, 1); PG8_SCHED; PG8_XLDA(At, 1, 0); PG8_STAGE_A(PG8_SA(0, 1), a2, o10, o11);
            PG8_WAIT_V(8); PG8_WAIT_L(0); PG8_BAR; PG8_MMA(0, 0, At, B0); PG8_MMA(0, 1, At, B1); PG8_BAR; PG8_SCHED;
            PG8_XLDA(At, 1, 1); PG8_STAGE_B(PG8_SB(1, 0), b3); PG8_STAGE_B(PG8_SB(1, 1), b3 + hstep); PG8_STAGE_A(PG8_SA(1, 0), a3, o00, o01);
            PG8_WAIT_V(8); PG8_WAIT_L(0); PG8_BAR; PG8_MMA(1, 0, At, B0); PG8_MMA(1, 1, At, B1); PG8_BAR; PG8_SCHED;
        }
        if (wr == 0) PG8_BAR;
        { int fr_ = fr, fq_ = fq; asm volatile("" : "+v"(fr_), "+v"(fq_));
          E(acc, cur, wr, wc, fr_, fq_); }
        if (!has_next) break;
#pragma unroll
        for (int a = 0; a < 2; ++a)
#pragma unroll
            for (int b = 0; b < 2; ++b)
#pragma unroll
                for (int m = 0; m < 4; ++m)
#pragma unroll
                    for (int n = 0; n < 2; ++n) acc[a][b][m][n] = (f32x4){0.f, 0.f, 0.f, 0.f};
        cur = nxt; cA = nA; cB = nB; ++ui;
#pragma unroll
        for (int h = 0; h < 2; ++h)
#pragma unroll
            for (int i = 0; i < 2; ++i) gc[h][i] = gn[h][i];
        if (wr == 1) PG8_BAR;
    }
    PG8_WAIT_V(0);
    PG8_BAR;
#undef PG8_SA
#undef PG8_SB
#undef PG8_GLDS
#undef PG8_STAGE_A
#undef PG8_STAGE_B
#undef PG8_LDA
#undef PG8_LDB
#undef PG8_MMA
#undef PG8_LD8
#undef PG8_LDA8
#undef PG8_LDB8
#undef PG8_XLDA
#undef PG8_XLDB
#undef PG8_WAIT_V
#undef PG8_WAIT_L
#undef PG8_BAR
#undef PG8_SCHED
}
}

namespace attn_body {
using bf16=__hip_bfloat16;
using bf16x8=__attribute__((ext_vector_type(8)))short;
using s16x4=__attribute__((ext_vector_type(4)))short;
using f32x16=__attribute__((ext_vector_type(16)))float;
using u32x4=__attribute__((ext_vector_type(4)))unsigned;
constexpr int D=64,PQ=INW,PO=DM;
constexpr int NW=8,QBLK=32,QB=QBLK*NW,KVBLK=64,NQB=SEQ/QB;
constexpr int ATTN_UNIT_ROWS=QB;
__device__ __forceinline__ int crow(int r,int hi){return (r&3)+8*(r>>2)+4*hi;}
#define SBAR() __builtin_amdgcn_sched_barrier(0)
__device__ __forceinline__ void cmask(f32x16&p0,f32x16&p1,int jb,int qrel,int hi){
  const float NEG=-INFINITY; int kb=64*jb+4*hi;
  #pragma unroll
  for(int r=0;r<16;++r){int kv=kb+(r&3)+8*(r>>2); if(kv>qrel)p0[r]=NEG; if(kv+32>qrel)p1[r]=NEG;}
}

constexpr int NSLOT=3, SLOTB=8192;
constexpr int LDS_K=0, LDS_V=NSLOT*SLOTB, LDS_WS=2*NSLOT*SLOTB, LDS_OST=LDS_WS+NW*64*4, LDS_BYTES=LDS_OST+NW*4096;
constexpr float C2=0.125f*1.4426950408889634f;
__device__ __forceinline__ void glds16(const void*gsrc,unsigned lds_dst){unsigned keep;
  asm volatile("s_mov_b32 %0, m0\n\ts_mov_b32 m0, %2\n\ts_nop 0\n\tglobal_load_lds_dwordx4 %1, off\n\ts_mov_b32 m0, %0":"=&s"(keep):"v"(gsrc),"s"(lds_dst):"memory");}
__device__ __forceinline__ float max3f(float a,float b,float c){float r;asm("v_max3_f32 %0, %1, %2, %3":"=v"(r):"v"(a),"v"(b),"v"(c));return r;}
__device__ __forceinline__ float max2f(float a,float b){float r;asm("v_max_f32_e32 %0, %1, %2":"=v"(r):"v"(a),"v"(b));return r;}
__device__ __forceinline__ float fadd_s(float a,float b){float r;asm("v_add_f32_e32 %0, %1, %2":"=v"(r):"v"(a),"v"(b));return r;}
__device__ __forceinline__ float fsub_s(float a,float b){float r;asm("v_sub_f32_e32 %0, %1, %2":"=v"(r):"v"(a),"v"(b));return r;}
typedef float f32x2_t __attribute__((ext_vector_type(2))); typedef __bf16 bf16x2_t __attribute__((ext_vector_type(2)));
__device__ __forceinline__ unsigned cvtpk_s(float lo,float hi){f32x2_t v={lo,hi};bf16x2_t b=__builtin_convertvector(v,bf16x2_t);return __builtin_bit_cast(unsigned,b);}
#define WAIT_BAR(N) asm volatile("s_waitcnt vmcnt(" #N ") lgkmcnt(0)\n\ts_barrier":::"memory")

__device__ __forceinline__ void qkt(f32x16&p0,f32x16&p1,const char*Kslot,const bf16x8*qr,const f32x16&negm,int r32,int hi){
  const char*kb=Kslot+hi*1024+r32*16;
  #pragma unroll
  for(int d0=0;d0<4;++d0){
    const bf16x8 b0=*reinterpret_cast<const bf16x8*>(kb+d0*2048);
    const bf16x8 b1=*reinterpret_cast<const bf16x8*>(kb+d0*2048+512);
    if(d0==0){p0=__builtin_amdgcn_mfma_f32_32x32x16_bf16(b0,qr[0],negm,0,0,0);p1=__builtin_amdgcn_mfma_f32_32x32x16_bf16(b1,qr[0],negm,0,0,0);}
    else{p0=__builtin_amdgcn_mfma_f32_32x32x16_bf16(b0,qr[d0],p0,0,0,0);p1=__builtin_amdgcn_mfma_f32_32x32x16_bf16(b1,qr[d0],p1,0,0,0);}}
}
typedef __attribute__((address_space(3))) const char* lds_cptr;
typedef short v4i16_t __attribute__((ext_vector_type(4)));
__device__ __forceinline__ void kload8(bf16x8*kf,lds_cptr kp){
  kf[0]=*(const __attribute__((address_space(3))) bf16x8*)(kp);      kf[1]=*(const __attribute__((address_space(3))) bf16x8*)(kp+512);
  kf[2]=*(const __attribute__((address_space(3))) bf16x8*)(kp+2048); kf[3]=*(const __attribute__((address_space(3))) bf16x8*)(kp+2560);
  kf[4]=*(const __attribute__((address_space(3))) bf16x8*)(kp+4096); kf[5]=*(const __attribute__((address_space(3))) bf16x8*)(kp+4608);
  kf[6]=*(const __attribute__((address_space(3))) bf16x8*)(kp+6144); kf[7]=*(const __attribute__((address_space(3))) bf16x8*)(kp+6656);
}
__device__ __forceinline__ void kload2(bf16x8*kf,lds_cptr kp,int j){ kf[2*j]=*(const __attribute__((address_space(3))) bf16x8*)(kp+j*2048); kf[2*j+1]=*(const __attribute__((address_space(3))) bf16x8*)(kp+j*2048+512); }
__device__ __forceinline__ s16x4 vtr(lds_cptr p){ return __builtin_bit_cast(s16x4,__builtin_amdgcn_ds_read_tr16_b64_v4i16((__attribute__((address_space(3))) v4i16_t*)p)); }
__device__ __forceinline__ float rowmax(const f32x16&p0,const f32x16&p1){
  float a=max3f(p0[0],p0[1],p1[0]),b=max3f(p0[2],p0[3],p1[1]);a=max3f(a,p1[2],p1[3]);
  #pragma unroll
  for(int r=4;r<16;r+=4){a=max3f(a,p0[r],p0[r+1]);b=max3f(b,p0[r+2],p0[r+3]);a=max3f(a,p1[r],p1[r+1]);b=max3f(b,p1[r+2],p1[r+3]);}
  const float m=max2f(a,b);
  auto rr=__builtin_amdgcn_permlane32_swap(__float_as_uint(m),__float_as_uint(m),false,false);
  return max2f(__uint_as_float(rr[0]),__uint_as_float(rr[1]));
}
__device__ __forceinline__ void pv(f32x16*o,int vb,bf16x8 pa0,bf16x8 pa1,bf16x8 pa2,bf16x8 pa3){
  #pragma unroll
  for(int d0=0;d0<2;++d0){s16x4 lo[4],hi[4];
    #pragma unroll
    for(int ks=0;ks<4;++ks){
      asm volatile("ds_read_b64_tr_b16 %0,%1 offset:%c2":"=&v"(lo[ks]):"v"(vb),"i"(d0*4096+ks*1024):"memory");
      asm volatile("ds_read_b64_tr_b16 %0,%1 offset:%c2":"=&v"(hi[ks]):"v"(vb),"i"(d0*4096+ks*1024+512):"memory");}
    asm volatile("s_waitcnt lgkmcnt(0)":::"memory");SBAR();
    #define PK(k) (bf16x8){lo[k][0],lo[k][1],lo[k][2],lo[k][3],hi[k][0],hi[k][1],hi[k][2],hi[k][3]}
    o[d0]=__builtin_amdgcn_mfma_f32_32x32x16_bf16(pa0,PK(0),o[d0],0,0,0);
    o[d0]=__builtin_amdgcn_mfma_f32_32x32x16_bf16(pa1,PK(1),o[d0],0,0,0);
    o[d0]=__builtin_amdgcn_mfma_f32_32x32x16_bf16(pa2,PK(2),o[d0],0,0,0);
    o[d0]=__builtin_amdgcn_mfma_f32_32x32x16_bf16(pa3,PK(3),o[d0],0,0,0);
    #undef PK
  }
}

#ifndef ATTN_STORE16
#define ATTN_STORE16(p,v) (*(u32x4*)(p)=(v))
#endif
template<int THRL> __device__ __forceinline__ void attn_unit(int qb,const bf16*Qb,const bf16*__restrict__ Kb,const bf16*__restrict__ Vb,bf16*Ob,char*shm){
  int tid_=threadIdx.x; asm volatile("":"+v"(tid_));
  const int tid=tid_,lane=tid&63,r32=lane&31,hi=lane>>5; const int wid=__builtin_amdgcn_readfirstlane(tid>>6);
  const int q0=qb*QB;
  const bf16*Qw=Qb+(long)(q0+wid*QBLK)*PQ;
  const bf16*Kh=Kb,*Vh=Vb;
  const unsigned lds0=(unsigned)(uintptr_t)shm;
  float*wsf=(float*)(shm+LDS_WS)+wid*64;
  const bf16*ksrc=Kh+(long)lane*PQ+wid*8;
  const bf16*vsrc=Vh+(long)(16*(wid&3)+(lane>>2))*PQ+(wid>>2)*32+(lane&3)*8;
  const unsigned kdst=lds0+LDS_K+wid*1024, vdst=lds0+LDS_V+wid*1024;
  #define DMA_K(t,slot) glds16(ksrc+(long)(t)*KVBLK*PQ,(unsigned)__builtin_amdgcn_readfirstlane(kdst+(slot)))
  #define DMA_V(t,slot) glds16(vsrc+(long)(t)*KVBLK*PQ,(unsigned)__builtin_amdgcn_readfirstlane(vdst+(slot)))
  const int vb0=(int)(lds0+LDS_V)+((lane>>4)&1)*32+(lane&3)*8+(4*hi+((lane&15)>>2))*64;
  const char*Kbase=shm+LDS_K; bf16x8 kf[8];
  const lds_cptr shm3=(lds_cptr)shm; const lds_cptr kp0=shm3+LDS_K+hi*1024+r32*16; const lds_cptr vp0=shm3+LDS_V+((lane>>4)&1)*32+(lane&3)*8+(4*hi+((lane&15)>>2))*64;
  const int NT=(q0+QB)/KVBLK;
  DMA_K(0,0);DMA_V(0,0);DMA_K(1,SLOTB);
  bf16x8 qr[4];
  #pragma unroll
  for(int d0=0;d0<4;++d0)qr[d0]=*reinterpret_cast<const bf16x8*>(&Qw[(long)r32*PQ+d0*16+hi*8]);
  float mhat=0.f,l_reg=0.f;f32x16 o[2];o[0]=f32x16{};o[1]=f32x16{};f32x16 negm=f32x16{};asm volatile("":"+v"(negm));
  const int qrel=wid*QBLK+r32;
  #define CMASK(P0,P1,t) do{int jb_=(t)-(NT-4); if(jb_>=0)cmask(P0,P1,jb_,qrel,hi);}while(0)
  bool resc=false;
  #define START(P0,P1) do{ const float rm=rowmax(P0,P1); resc=false; \
    { const float dl=rm; mhat=fadd_s(mhat,dl); \
      _Pragma("unroll") for(int r=0;r<16;++r){P0[r]=fsub_s(P0[r],dl);P1[r]=fsub_s(P1[r],dl);} \
      _Pragma("unroll") for(int r=0;r<16;++r)negm[r]=-mhat; asm volatile("":"+v"(negm)); } \
    _Pragma("unroll") for(int r=0;r<16;++r)P0[r]=__builtin_amdgcn_exp2f(P0[r]); }while(0)
  #define RESC() do{ if(resc){ asm volatile("s_waitcnt lgkmcnt(0)":::"memory"); \
      _Pragma("unroll") for(int d_=0;d_<2;++d_) _Pragma("unroll") for(int r=0;r<16;++r)o[d_][r]*=wsf[crow(r,hi)]; } }while(0)
  f32x16 pA0,pA1,pB0,pB1;
  int sl_prev=0,sl_cur=0,sl_next=SLOTB;
  #define ROT() do{sl_prev=sl_cur;sl_cur=sl_next;sl_next=(sl_next==(NSLOT-1)*SLOTB)?0:sl_next+SLOTB;}while(0)
  DMA_K(2,2*SLOTB);
  WAIT_BAR(3);
  qkt(pA0,pA1,Kbase,qr,negm,r32,hi);asm volatile("s_nop 15\n\ts_nop 7":"+v"(pA0),"+v"(pA1));CMASK(pA0,pA1,0);
  START(pA0,pA1);
  _Pragma("unroll") for(int r=0;r<16;++r)pA1[r]=__builtin_amdgcn_exp2f(pA1[r]);
  WAIT_BAR(0);
  DMA_K(3,0);DMA_V(1,SLOTB);
  ROT();
  kload8(kf,kp0+sl_cur);
  WAIT_BAR(2);
  s16x4 vlo[8],vhi[8]; u32x4 pw0,pw1,pw2,pw3;
  #define PKW(P,B) cvtpk_s(P[B],P[B+1])
  #define PAF(k) __builtin_bit_cast(bf16x8,pw##k)
  #define VFR(i) (bf16x8){vlo[i][0],vlo[i][1],vlo[i][2],vlo[i][3],vhi[i][0],vhi[i][1],vhi[i][2],vhi[i][3]}
  #define PIN(x) asm volatile("":"+v"(x))
  #define MX3(a,b,c) __builtin_fmaxf(__builtin_fmaxf((a),(b)),(c))
  #define GAPA(MF,A0,A1,A2,A3,W0,W1,PW) do{ MF; sacc+=A0; sacc+=A1; sacc+=A2; sacc+=A3; PIN(sacc); W0; W1; PIN(PW); SBAR(); }while(0)
  #define EX(v) __builtin_amdgcn_exp2f(v)
  #define GAPB(MF,X,B) do{ MF; X[B]=EX(X[B]); X[B+1]=EX(X[B+1]); X[B+2]=EX(X[B+2]); X[B+3]=EX(X[B+3]); PIN(X); SBAR(); }while(0)
  #define VRD(i) do{ vlo[i]=vtr(vp_+(((i)>>2)*4096+((i)&3)*1024)); vhi[i]=vtr(vp_+(((i)>>2)*4096+((i)&3)*1024+512)); }while(0)
  #define KRD(G,j) do{ if(G){ kload2(kf,kp0+sl_next,j); SBAR(); } }while(0)
  #define STEP(C0,C1,P0,P1,t,GK,GV,GL) do{ SBAR(); \
    const lds_cptr vp_=vp0+sl_prev; \
    VRD(0); SBAR(); float sacc=(P0[0]+P0[1]); \
    GAPA(C0=__builtin_amdgcn_mfma_f32_32x32x16_bf16(kf[0],qr[0],negm,0,0,0), P0[2],P0[3],P0[4],P0[5],     pw0[0]=PKW(P0,0), pw0[1]=PKW(P0,2), pw0); \
    VRD(4); SBAR(); GAPA(C1=__builtin_amdgcn_mfma_f32_32x32x16_bf16(kf[1],qr[0],negm,0,0,0), P0[6],P0[7],P0[8],P0[9],     pw0[2]=PKW(P0,4), pw0[3]=PKW(P0,6), pw0); \
    VRD(1); SBAR(); GAPA(C0=__builtin_amdgcn_mfma_f32_32x32x16_bf16(kf[2],qr[1],C0,0,0,0),   P0[10],P0[11],P0[12],P0[13], pw1[0]=PKW(P0,8), pw1[1]=PKW(P0,10), pw1); \
    VRD(5); SBAR(); GAPA(C1=__builtin_amdgcn_mfma_f32_32x32x16_bf16(kf[3],qr[1],C1,0,0,0),   P0[14],P0[15],P1[0],P1[1],   pw1[2]=PKW(P0,12),pw1[3]=PKW(P0,14), pw1); \
    VRD(2); SBAR(); GAPA(C0=__builtin_amdgcn_mfma_f32_32x32x16_bf16(kf[4],qr[2],C0,0,0,0),   P1[2],P1[3],P1[4],P1[5],     pw2[0]=PKW(P1,0), pw2[1]=PKW(P1,2), pw2); \
    VRD(6); SBAR(); GAPA(C1=__builtin_amdgcn_mfma_f32_32x32x16_bf16(kf[5],qr[2],C1,0,0,0),   P1[6],P1[7],P1[8],P1[9],     pw2[2]=PKW(P1,4), pw2[3]=PKW(P1,6), pw2); \
    VRD(3); SBAR(); GAPA(C0=__builtin_amdgcn_mfma_f32_32x32x16_bf16(kf[6],qr[3],C0,0,0,0),   P1[10],P1[11],P1[12],P1[13], pw3[0]=PKW(P1,8), pw3[1]=PKW(P1,10), pw3); \
    VRD(7); SBAR(); GAPA(C1=__builtin_amdgcn_mfma_f32_32x32x16_bf16(kf[7],qr[3],C1,0,0,0),   P1[14],P1[15],0.f,0.f,       pw3[2]=PKW(P1,12),pw3[3]=PKW(P1,14), pw3); \
    l_reg+=sacc; \
    if(GK){DMA_K((t)+3,sl_cur);} if(GV){DMA_V((t)+1,sl_next);} \
    CMASK(C0,C1,t); \
    { float a=MX3(C0[0],C0[1],C1[0]),b=MX3(C0[2],C0[3],C1[1]); a=MX3(a,C1[2],C1[3]); \
      _Pragma("unroll") for(int r=4;r<16;r+=4){a=MX3(a,C0[r],C0[r+1]);b=MX3(b,C0[r+2],C0[r+3]);a=MX3(a,C1[r],C1[r+1]);b=MX3(b,C1[r+2],C1[r+3]);} \
      float rm=__builtin_fmaxf(a,b); { auto rr=__builtin_amdgcn_permlane32_swap(__float_as_uint(rm),__float_as_uint(rm),false,false); rm=__builtin_fmaxf(__uint_as_float(rr[0]),__uint_as_float(rr[1])); } \
      resc=false; \
      if(__builtin_expect(__any(rm>(float)THRL),0)){ const float dl=__builtin_fmaxf(rm,0.f); mhat+=dl; \
        _Pragma("unroll") for(int r=0;r<16;++r){C0[r]-=dl;C1[r]-=dl;} \
        _Pragma("unroll") for(int r=0;r<16;++r)negm[r]=-mhat; asm volatile("":"+v"(negm)); \
        const float f=__builtin_amdgcn_exp2f(-dl); l_reg*=f; if(hi==0)wsf[r32]=f; resc=true; } } \
    SBAR(); \
    GAPB(o[0]=__builtin_amdgcn_mfma_f32_32x32x16_bf16(PAF(0),VFR(0),o[0],0,0,0), C0,0); \
    GAPB(o[1]=__builtin_amdgcn_mfma_f32_32x32x16_bf16(PAF(0),VFR(4),o[1],0,0,0), C0,4); \
    KRD(GL,0); GAPB(o[0]=__builtin_amdgcn_mfma_f32_32x32x16_bf16(PAF(1),VFR(1),o[0],0,0,0), C0,8); \
    KRD(GL,1); GAPB(o[1]=__builtin_amdgcn_mfma_f32_32x32x16_bf16(PAF(1),VFR(5),o[1],0,0,0), C0,12); \
    KRD(GL,2); GAPB(o[0]=__builtin_amdgcn_mfma_f32_32x32x16_bf16(PAF(2),VFR(2),o[0],0,0,0), C1,0); \
    KRD(GL,3); GAPB(o[1]=__builtin_amdgcn_mfma_f32_32x32x16_bf16(PAF(2),VFR(6),o[1],0,0,0), C1,4); \
    GAPB(o[0]=__builtin_amdgcn_mfma_f32_32x32x16_bf16(PAF(3),VFR(3),o[0],0,0,0), C1,8); \
    GAPB(o[1]=__builtin_amdgcn_mfma_f32_32x32x16_bf16(PAF(3),VFR(7),o[1],0,0,0), C1,12); \
    }while(0)
  int t=1;
  #undef CMASK
  #define CMASK(P0,P1,t) do{}while(0)
  for(;t+5<NT;t+=2){
    STEP(pB0,pB1,pA0,pA1,t,true,true,true);     WAIT_BAR(2); RESC(); ROT();
    STEP(pA0,pA1,pB0,pB1,t+1,true,true,true);   WAIT_BAR(2); RESC(); ROT();
  }
  #undef CMASK
  #define CMASK(P0,P1,t) do{int jb_=(t)-(NT-4); if(jb_>=0)cmask(P0,P1,jb_,qrel,hi);}while(0)
  #define ENDW(tt) do{ if((tt)+3<NT){WAIT_BAR(2);} else if((tt)+2<NT){WAIT_BAR(1);} else {WAIT_BAR(0);} }while(0)
  for(;t+1<NT;t+=2){
    STEP(pB0,pB1,pA0,pA1,t,(t+3<NT),(t+1<NT),(t+1<NT));       ENDW(t);   RESC(); ROT();
    STEP(pA0,pA1,pB0,pB1,t+1,(t+4<NT),(t+2<NT),(t+2<NT));     ENDW(t+1); RESC(); ROT();
  }
  STEP(pB0,pB1,pA0,pA1,NT-1,false,false,false); RESC();
  { float sacc=pB0[0]+pB0[1]; _Pragma("unroll") for(int r=2;r<16;++r)sacc+=pB0[r]; _Pragma("unroll") for(int r=0;r<16;++r)sacc+=pB1[r]; l_reg+=sacc;
    pw0=(u32x4){PKW(pB0,0),PKW(pB0,2),PKW(pB0,4),PKW(pB0,6)};pw1=(u32x4){PKW(pB0,8),PKW(pB0,10),PKW(pB0,12),PKW(pB0,14)};pw2=(u32x4){PKW(pB1,0),PKW(pB1,2),PKW(pB1,4),PKW(pB1,6)};pw3=(u32x4){PKW(pB1,8),PKW(pB1,10),PKW(pB1,12),PKW(pB1,14)};
    SBAR(); pv(o,vb0+sl_cur,PAF(0),PAF(1),PAF(2),PAF(3)); }
  #undef PKW
  #undef PAF
  #undef VFR
  #undef PIN
  #undef MX3
  #undef GAPA
  #undef GAPB
  #undef EX
  #undef VRD
  #undef KRD
  #undef STEP
  #undef ENDW
  {auto rr=__builtin_amdgcn_permlane32_swap(__float_as_uint(l_reg),__float_as_uint(l_reg),false,false);l_reg=__uint_as_float(rr[0])+__uint_as_float(rr[1]);}
  if(hi==0)wsf[32+r32]=l_reg;asm volatile("s_waitcnt lgkmcnt(0)":::"memory");
  float rli[16];
  #pragma unroll
  for(int r=0;r<16;++r)rli[r]=__builtin_amdgcn_rcpf(wsf[32+crow(r,hi)]);
  bf16*Ow=Ob+(long)(q0+wid*QBLK)*PO;
  { bf16*stg=(bf16*)(shm+LDS_OST)+wid*2048;
    #pragma unroll
    for(int r=0;r<16;++r){const int orow=crow(r,hi);
      #pragma unroll
      for(int d0=0;d0<2;++d0)stg[orow*64+d0*32+r32]=__float2bfloat16(o[d0][r]*rli[r]);}
    asm volatile("s_waitcnt lgkmcnt(0)":::"memory");
    #pragma unroll
    for(int i=0;i<4;++i){const int row=i*8+(lane>>3),ch=lane&7; const u32x4 v=*(const u32x4*)(stg+row*64+ch*8); ATTN_STORE16(Ow+(long)row*PO+ch*8,v);} }
  asm volatile("s_waitcnt lgkmcnt(0)\n\ts_barrier":::"memory");
  #undef DMA_K
  #undef DMA_V
  #undef CMASK
  #undef START
  #undef RESC
  #undef ROT
}
constexpr int ATTN_LDS_BYTES=LDS_BYTES;
template<int THRL=8> __device__ __forceinline__ void attn_phase(char*lds,const bf16_t*proj,bf16_t*atto,int vcu){
  const int bh=vcu>>3,s8=vcu&7,b=bh>>2,h=bh&3;
  const bf16*P0=(const bf16*)proj+(long)b*SEQ*PQ; bf16*O0=(bf16*)atto+(long)b*SEQ*PO;
  for(int i=0;i<8;++i){ const int qb=(i<4)?(15-s8):s8, sub=i&3, st=sub>>1, vh=sub&1;
    attn_unit<THRL>(qb,P0+C_Q+st*256+h*64,P0+C_K+st*256+h*64,P0+C_V+h*128+vh*64,O0+h*256+st*128+vh*64,lds); }
}
#undef SBAR
#undef WAIT_BAR
}

constexpr int NWAVES = 8;
constexpr int RING_OFF = 0, RING_BYTES = 131072;
constexpr int LDSCTL_OFF = RING_BYTES, MISC_OFF = LDSCTL_OFF + 320;
constexpr int TAB_OFF = LDSCTL_OFF + 1024;
constexpr int REC_OFF = LDSCTL_OFF + 2048;
constexpr int LDS_BYTES = 147456;
static_assert(REC_OFF + (64 + 512) * 4 <= LDS_BYTES, "LDS map");

#define GAS __attribute__((address_space(1)))
#define LAS __attribute__((address_space(3)))
typedef unsigned v4u __attribute__((ext_vector_type(4)));
typedef unsigned v2u __attribute__((ext_vector_type(2)));
typedef float f32x4 __attribute__((ext_vector_type(4)));
typedef float f32x2 __attribute__((ext_vector_type(2)));
typedef short bf16x8 __attribute__((ext_vector_type(8)));
typedef GAS unsigned gu32;
#define RLX_AGENT __ATOMIC_RELAXED, __HIP_MEMORY_SCOPE_AGENT
#define LDS_WAIT() asm volatile("s_waitcnt lgkmcnt(0)" ::: "memory")
#define VM_WAIT() asm volatile("s_waitcnt vmcnt(0)" ::: "memory")

#define XB_TMO      128
#define XB_XCNT(j)  (256  + 64 * (j))
#define XB_XSUB(j)  (1280 + 64 * (j))
#define XB_XGEN(j)  (2304 + 64 * (j))
#define XB_TOP      3328
#define XB_TOPGEN   3392
#define XCD_BAR_WORDS 3456
#define XB_SPIN_CAP (1u << 18)
__device__ __forceinline__ unsigned xb_ld(unsigned* p)              { return __hip_atomic_load(p, __ATOMIC_RELAXED, __HIP_MEMORY_SCOPE_AGENT); }
__device__ __forceinline__ unsigned xb_add(unsigned* p, unsigned v) { return __hip_atomic_fetch_add(p, v, __ATOMIC_RELAXED, __HIP_MEMORY_SCOPE_AGENT); }
__device__ __forceinline__ unsigned xb_xcc_id() { return (unsigned)__builtin_amdgcn_s_getreg((3 << 11) | 20) & 0xFu; }
#define XB_SPIN(cond, bar) do { unsigned _sp = 0; while (cond) { __builtin_amdgcn_s_sleep(1); \
    if ((++_sp & 255u) == 0u) { if (xb_ld(&(bar)[XB_TMO])) break; if (_sp > XB_SPIN_CAP) { atomicAdd(&(bar)[XB_TMO], 1u); break; } } } } while (0)
struct XcdBarrier { unsigned* bar; unsigned x; volatile LAS unsigned* st; };
__device__ __forceinline__ XcdBarrier xcd_barrier_post(unsigned* bar, volatile LAS unsigned* st) {
    XcdBarrier b; b.bar = bar; b.x = xb_xcc_id(); b.st = st;
    if (threadIdx.x == 0) (void)xb_add(&bar[XB_XCNT(b.x)], 1u);
    return b;
}
__device__ __forceinline__ void xcd_barrier_complete(unsigned* bar, unsigned x, unsigned& nloc, unsigned& nx) {
    const unsigned G = gridDim.x * gridDim.y * gridDim.z;
    unsigned sum, cnt, mine, sp = 0u;
    for (;;) {
        sum = 0u; cnt = 0u; mine = 0u;
#pragma unroll
        for (unsigned j = 0; j < 16; ++j) { const unsigned c = xb_ld(&bar[XB_XCNT(j)]); sum += c; cnt += (c > 0u) ? 1u : 0u; mine = (j == x) ? c : mine; }
        if (sum == G) break;
        __builtin_amdgcn_s_sleep(1);
        if ((++sp & 255u) == 0u) { if (xb_ld(&bar[XB_TMO])) break; if (sp > XB_SPIN_CAP) { atomicAdd(&bar[XB_TMO], 1u); break; } }
    }
    nloc = mine > 0u ? mine : 1u; nx = cnt > 0u ? cnt : 1u;
}
__device__ __forceinline__ void xcd_barrier(const XcdBarrier& b) {
    asm volatile("s_waitcnt vmcnt(0)" ::: "memory");
    __syncthreads();
    if (threadIdx.x == 0) {
        unsigned* bar = b.bar;
        __builtin_amdgcn_s_waitcnt(0);
        unsigned nloc = b.st[0], nx = b.st[1];
        if (nloc == 0u) { xcd_barrier_complete(bar, b.x, nloc, nx); b.st[0] = nloc; b.st[1] = nx; }
        const unsigned old = xb_add(&bar[XB_XSUB(b.x)], 1u);
        const unsigned gen = old / nloc;
        if (old + 1u == (gen + 1u) * nloc) {
            __builtin_amdgcn_fence(__ATOMIC_RELEASE, "agent");
            asm volatile("s_waitcnt vmcnt(0)" ::: "memory");
            const unsigned og = xb_add(&bar[XB_TOP], 1u);
            const unsigned tg = og / nx;
            if (og + 1u == (tg + 1u) * nx) xb_add(&bar[XB_TOPGEN], 1u);
            else XB_SPIN(xb_ld(&bar[XB_TOPGEN]) == tg, bar);
            __builtin_amdgcn_fence(__ATOMIC_ACQUIRE, "agent");
            xb_add(&bar[XB_XGEN(b.x)], 1u);
            asm volatile("s_waitcnt vmcnt(0)" ::: "memory");
        } else {
            XB_SPIN(xb_ld(&bar[XB_XGEN(b.x)]) == gen, bar);
            __builtin_amdgcn_fence(__ATOMIC_ACQUIRE, "agent");
            asm volatile("s_waitcnt vmcnt(0)" ::: "memory");
        }
    }
    __syncthreads();
}

struct Args { const float* in[22]; float* out; unsigned char* ws; int ph_lo, ph_hi, pad0, pad1; };
struct Frame {
    LAS unsigned char* lds; volatile LAS unsigned* MISC; gu32* ctl;
    int tid, lane, wave, vcu, G;
};

typedef const __attribute__((address_space(4))) Args* kargs_t;
__device__ __forceinline__ Args fetch_args() {
    kargs_t kp = (kargs_t)__builtin_amdgcn_kernarg_segment_ptr();
    asm volatile("" : "+s"(kp));
    Args a;
#pragma unroll
    for (int i = 0; i < 22; ++i) a.in[i] = kp->in[i];
    a.out = kp->out; a.ws = kp->ws; a.ph_lo = kp->ph_lo; a.ph_hi = kp->ph_hi; a.pad0 = kp->pad0; a.pad1 = kp->pad1;
    return a;
}
__device__ __forceinline__ void refresh_frame(Frame& F) { int t = threadIdx.x; asm volatile("" : "+v"(t)); F.tid = t; F.lane = t & 63; F.wave = __builtin_amdgcn_readfirstlane(t >> 6); }

__device__ __forceinline__ void p0_transpose_item(const float* W, int K, int N, bf16_t* WT, long row_off, LAS float* scr, int item, int lane) {
    const int nblk = N / 32, kb = item / nblk, nb = item % nblk, k0 = 64 * kb, n0 = 32 * nb;
#pragma unroll 8
    for (int i = 0; i < 32; ++i) { const int kk = 2 * i + (lane >> 5); scr[kk * 33 + (lane & 31)] = W[(size_t)(k0 + kk) * N + n0 + (lane & 31)]; }
    LDS_WAIT(); asm volatile("" ::: "memory");
    const int c = lane & 7;
#pragma unroll
    for (int j = 0; j < 4; ++j) { const int n = (lane >> 3) + 8 * j; const LAS float* s = scr + (8 * c) * 33 + n;
        v4u o; o.x = pk2(s[0 * 33], s[1 * 33]); o.y = pk2(s[2 * 33], s[3 * 33]); o.z = pk2(s[4 * 33], s[5 * 33]); o.w = pk2(s[6 * 33], s[7 * 33]);
        *(GAS v4u*)(WT + (size_t)(row_off + n0 + n) * K + k0 + 8 * c) = o; }
    LDS_WAIT(); asm volatile("" ::: "memory");
}
__device__ __forceinline__ void p0_transpose_item8(const float* W, int K, int N, unsigned char* WT, long row_off, LAS float* scr, int item, int lane) {
    const int nblk = N / 32, kb = item / nblk, nb = item % nblk, k0 = 64 * kb, n0 = 32 * nb;
#pragma unroll 8
    for (int i = 0; i < 32; ++i) { const int kk = 2 * i + (lane >> 5); scr[kk * 33 + (lane & 31)] = W[(size_t)(k0 + kk) * N + n0 + (lane & 31)]; }
    LDS_WAIT(); asm volatile("" ::: "memory");
    const int c = lane & 3; constexpr float SC = (float)(1 << pg8::WSHIFT);
#pragma unroll
    for (int j = 0; j < 2; ++j) { const int n = (lane >> 2) + 16 * j; const LAS float* s = scr + (16 * c) * 33 + n;
        v4u o; o.x = pg8::pk4_fp8(s[0 * 33] * SC, s[1 * 33] * SC, s[2 * 33] * SC, s[3 * 33] * SC); o.y = pg8::pk4_fp8(s[4 * 33] * SC, s[5 * 33] * SC, s[6 * 33] * SC, s[7 * 33] * SC);
        o.z = pg8::pk4_fp8(s[8 * 33] * SC, s[9 * 33] * SC, s[10 * 33] * SC, s[11 * 33] * SC); o.w = pg8::pk4_fp8(s[12 * 33] * SC, s[13 * 33] * SC, s[14 * 33] * SC, s[15 * 33] * SC);
        *(GAS v4u*)(WT + (size_t)(row_off + n0 + n) * K + k0 + 16 * c) = o; }
    LDS_WAIT(); asm volatile("" ::: "memory");
}
__device__ __forceinline__ void p0_prologue(Frame& F, const Args& a) {
    LAS float* scr = (LAS float*)(F.lds + RING_OFF + F.wave * 16384);
    const int gw = F.vcu * NWAVES + F.wave, NGW = F.G * NWAVES;
    unsigned char* ws = a.ws;
    constexpr int I_IN = (DM / 64) * (INW / 32), I_O = (DM / 64) * (DM / 32), I_UP1 = (DM / 64) * (2 * DFF / 32), I_DN1 = (DFF / 64) * (DM / 32);
    constexpr int NITEMS = I_IN + I_O + NE * I_UP1 + NE * I_DN1;
    for (int it = gw; it < NITEMS; it += NGW) {
        int r = it;
        if (r < I_IN) { p0_transpose_item(a.in[1], DM, INW, (bf16_t*)(ws + WS_WIN), 0, scr, r, F.lane); continue; } r -= I_IN;
        if (r < I_O) { p0_transpose_item(a.in[11], DM, DM, (bf16_t*)(ws + WS_WO), 0, scr, r, F.lane); continue; } r -= I_O;
        if (r < NE * I_UP1) { const int e = r / I_UP1, ii = r % I_UP1; const int n0 = 32 * (ii % (2 * DFF / 32));
            const int bj = n0 / DFF, f = n0 % DFF, rho0 = 256 * (f / 128) + 128 * bj + (f % 128);
#if MOE_FP8
            p0_transpose_item8(a.in[16] + (size_t)e * DM * 2 * DFF, DM, 2 * DFF, (unsigned char*)(ws + WS_WUP) + (size_t)e * 2 * DFF * DM, (long)rho0 - n0, scr, ii, F.lane); continue; }
#else
            p0_transpose_item(a.in[16] + (size_t)e * DM * 2 * DFF, DM, 2 * DFF, (bf16_t*)(ws + WS_WUP) + (size_t)e * 2 * DFF * DM, (long)rho0 - n0, scr, ii, F.lane); continue; }
#endif
        r -= NE * I_UP1;
        { const int e = r / I_DN1, ii = r % I_DN1;
#if MOE_FP8
            p0_transpose_item8(a.in[18] + (size_t)e * DFF * DM, DFF, DM, (unsigned char*)(ws + WS_WDN) + (size_t)e * DM * DFF, 0, scr, ii, F.lane); }
#else
            p0_transpose_item(a.in[18] + (size_t)e * DFF * DM, DFF, DM, (bf16_t*)(ws + WS_WDN) + (size_t)e * DM * DFF, 0, scr, ii, F.lane); }
#endif
    }
    const float* x = a.in[0]; bf16_t* xb = (bf16_t*)(ws + WS_XB);
    for (int m = gw; m < NTOK; m += NGW) {
        const GAS f32x4* xr = (const GAS f32x4*)(x + (size_t)m * DM) + F.lane; GAS v2u* o8 = (GAS v2u*)(xb + (size_t)m * DM) + F.lane;
        f32x4 v[4];
#pragma unroll
        for (int j = 0; j < 4; ++j) v[j] = xr[64 * j];
#pragma unroll
        for (int j = 0; j < 4; ++j) { v2u o; o.x = pk2(v[j].x, v[j].y); o.y = pk2(v[j].z, v[j].w); o8[64 * j] = o; }
    }
}

__device__ __forceinline__ void gmlp_phase(Frame& F, const Args& a) {
    const bf16_t* proj = (const bf16_t*)(a.ws + WS_PROJ); bf16_t* mix = (bf16_t*)(a.ws + WS_MIX);
    const float *lng = a.in[7], *lnb = a.in[8], *wsp = a.in[9], *bsp = a.in[10];
    LAS f32x2* st = (LAS f32x2*)(F.lds + RING_OFF);
    LAS bf16_t* Vg = (LAS bf16_t*)(F.lds + RING_OFF + 1024);
    LAS bf16_t* Wg = (LAS bf16_t*)(F.lds + RING_OFF + 19456);
    LAS float* Zg = (LAS float*)(F.lds + RING_OFF + 54272);
    const int tid = F.tid, lane = F.lane, w = F.wave;
    for (int c = blockIdx.x; c < NTOK / CHUNK; c += F.G) {
        const size_t row0 = (size_t)c * CHUNK;
        for (int s = 16 * w; s < 16 * w + 16; ++s) {
            const v4u raw = *(const GAS v4u*)(proj + (row0 + s) * INW + C_GV + lane * 8);
            const unsigned rw[4] = {raw.x, raw.y, raw.z, raw.w}; float v[8]; float sum = 0.f;
#pragma unroll
            for (int i = 0; i < 4; ++i) { const f32x2 gg = pg8::gelu_pk((f32x2){bf2f((bf16_t)(rw[i] & 0xffff)), bf2f((bf16_t)(rw[i] >> 16))}); v[2 * i] = gg.x; v[2 * i + 1] = gg.y; sum += gg.x + gg.y; }
            const float mean = wave_sum(sum) * (1.0f / GW); float q = 0.f;
#pragma unroll
            for (int i = 0; i < 8; ++i) { const float d = v[i] - mean; q += d * d; }
            const float var = wave_sum(q) * (1.0f / GW);
            if (lane == 0) st[s] = (f32x2){mean, rsqrtf(var + LN_EPS)};
        }
        __syncthreads();
        for (int g = 0; g < NG; ++g) {
            {
                const int row = tid >> 2, cq = (tid & 3) * 16, col = g * GD + cq; const f32x2 ms = st[row];
                const GAS v4u* src = (const GAS v4u*)(proj + (row0 + row) * INW + C_GV + col);
                unsigned ow[8];
#pragma unroll
                for (int hh = 0; hh < 2; ++hh) { const v4u raw = src[hh]; const unsigned rw[4] = {raw.x, raw.y, raw.z, raw.w};
#pragma unroll
                    for (int i = 0; i < 4; ++i) { const f32x2 gg = pg8::gelu_pk((f32x2){bf2f((bf16_t)(rw[i] & 0xffff)), bf2f((bf16_t)(rw[i] >> 16))});
                        const int cc = col + hh * 8 + 2 * i;
                        ow[hh * 4 + i] = pk2((gg.x - ms.x) * ms.y * lng[cc] + lnb[cc], (gg.y - ms.x) * ms.y * lng[cc + 1] + lnb[cc + 1]); } }
                *(LAS v4u*)(Vg + row * 72 + cq) = (v4u){ow[0], ow[1], ow[2], ow[3]};
                *(LAS v4u*)(Vg + row * 72 + cq + 8) = (v4u){ow[4], ow[5], ow[6], ow[7]};
#pragma unroll
                for (int k = 0; k < 8; ++k) { const int i = tid + 512 * k, t = i >> 5, s4 = (i & 31) * 4;
                    const f32x4 wv = *(const GAS f32x4*)(wsp + ((size_t)g * CHUNK + t) * CHUNK + s4);
                    v2u o; o.x = pk2(s4 <= t ? wv.x : 0.f, s4 + 1 <= t ? wv.y : 0.f); o.y = pk2(s4 + 2 <= t ? wv.z : 0.f, s4 + 3 <= t ? wv.w : 0.f);
                    *(LAS v2u*)(Wg + t * 136 + s4) = o; }
            }
            __syncthreads();
            {
                f32x4 acc[4];
#pragma unroll
                for (int n = 0; n < 4; ++n) acc[n] = (f32x4){0.f, 0.f, 0.f, 0.f};
                const int t0 = 16 * w, fr = lane & 15, fq = lane >> 4;
                for (int ks = 0; ks * 32 <= t0 + 15; ++ks) {
                    const bf16x8 af = *(const LAS bf16x8*)(Wg + (t0 + fr) * 136 + ks * 32 + fq * 8);
#pragma unroll
                    for (int n = 0; n < 4; ++n) { bf16x8 bfv;
#pragma unroll
                        for (int j = 0; j < 8; ++j) bfv[j] = (short)Vg[(ks * 32 + fq * 8 + j) * 72 + n * 16 + fr];
                        acc[n] = __builtin_amdgcn_mfma_f32_16x16x32_bf16(af, bfv, acc[n], 0, 0, 0); }
                }
#pragma unroll
                for (int n = 0; n < 4; ++n)
#pragma unroll
                    for (int r = 0; r < 4; ++r) Zg[(t0 + fq * 4 + r) * 68 + n * 16 + fr] = acc[n][r];
            }
            __syncthreads();
            {
                const int row = tid >> 2, cq = (tid & 3) * 16, col = g * GD + cq; const float bb = bsp[g * CHUNK + row];
                const GAS v4u* src = (const GAS v4u*)(proj + (row0 + row) * INW + C_GU + col);
                unsigned ow[8];
#pragma unroll
                for (int hh = 0; hh < 2; ++hh) { const v4u raw = src[hh]; const unsigned rw[4] = {raw.x, raw.y, raw.z, raw.w};
#pragma unroll
                    for (int i = 0; i < 4; ++i) { const f32x2 uu = pg8::gelu_pk((f32x2){bf2f((bf16_t)(rw[i] & 0xffff)), bf2f((bf16_t)(rw[i] >> 16))});
                        const f32x2 zz = *(const LAS f32x2*)(Zg + row * 68 + cq + hh * 8 + 2 * i);
                        ow[hh * 4 + i] = pk2(uu.x * (zz.x + bb), uu.y * (zz.y + bb)); } }
                GAS v4u* dst = (GAS v4u*)(mix + (row0 + row) * DM + GW + col);
                dst[0] = (v4u){ow[0], ow[1], ow[2], ow[3]}; dst[1] = (v4u){ow[4], ow[5], ow[6], ow[7]};
            }
            __syncthreads();
        }
    }
}

__device__ __forceinline__ void attn_combine_phase(Frame& F, const Args& a) {
    const bf16_t* atto = (const bf16_t*)(a.ws + WS_ATTO); bf16_t* mix = (bf16_t*)(a.ws + WS_MIX);
    const int lane = F.lane, gw = F.vcu * NWAVES + F.wave, NGW = F.G * NWAVES;
    const float lam = expf(wave_sum(a.in[2][lane] * a.in[3][lane])) - expf(wave_sum(a.in[4][lane] * a.in[5][lane])) + LAMBDA_INIT;
    const int h = lane >> 4, e0 = (lane & 15) * 8;
    float sg[8];
#pragma unroll
    for (int i = 0; i < 8; ++i) sg[i] = a.in[6][e0 + i] * (1.0f - LAMBDA_INIT);
    for (int t = gw; t < NTOK; t += NGW) {
        const v4u r1 = *(const GAS v4u*)(atto + (size_t)t * DM + h * 256 + e0), r2 = *(const GAS v4u*)(atto + (size_t)t * DM + h * 256 + 128 + e0);
        const unsigned w1[4] = {r1.x, r1.y, r1.z, r1.w}, w2[4] = {r2.x, r2.y, r2.z, r2.w};
        float d[8]; float ss = 0.f;
#pragma unroll
        for (int i = 0; i < 4; ++i) { d[2 * i] = bf2f((bf16_t)(w1[i] & 0xffff)) - lam * bf2f((bf16_t)(w2[i] & 0xffff)); d[2 * i + 1] = bf2f((bf16_t)(w1[i] >> 16)) - lam * bf2f((bf16_t)(w2[i] >> 16)); ss += d[2 * i] * d[2 * i] + d[2 * i + 1] * d[2 * i + 1]; }
        ss += __shfl_xor(ss, 1); ss += __shfl_xor(ss, 2); ss += __shfl_xor(ss, 4); ss += __shfl_xor(ss, 8);
        const float r = rsqrtf(ss * (1.0f / DV) + LN_EPS);
        v4u o; o.x = pk2(d[0] * r * sg[0], d[1] * r * sg[1]); o.y = pk2(d[2] * r * sg[2], d[3] * r * sg[3]); o.z = pk2(d[4] * r * sg[4], d[5] * r * sg[5]); o.w = pk2(d[6] * r * sg[6], d[7] * r * sg[7]);
        *(GAS v4u*)(mix + (size_t)t * DM + h * DV + e0) = o;
    }
}

__device__ __forceinline__ void route_phase(Frame& F, const Args& a) {
    float* h1 = (float*)(a.ws + WS_H1); bf16_t* xb = (bf16_t*)(a.ws + WS_XB);
    int* list = (int*)(a.ws + WS_LIST); int* re = (int*)(a.ws + WS_RE); int* rr = (int*)(a.ws + WS_RR); float* rg = (float*)(a.ws + WS_RG);
    const float *g1 = a.in[12], *b1 = a.in[13], *wr = a.in[14], *br = a.in[15];
    constexpr int XS = 1028;
    LAS float* XT = (LAS float*)(F.lds + RING_OFF);
    LAS float* PT = (LAS float*)(F.lds + RING_OFF + 16 * XS * 4);
    LAS int* lcnt = (LAS int*)(F.lds + REC_OFF); LAS int* lbase = lcnt + 32; LAS int* rec = lcnt + 64;
    const int tid = F.tid, lane = F.lane, w = F.wave, fr = lane & 15, fq = lane >> 4;
    if (tid < 32) lcnt[tid] = 0;
    float bw[32][2];
#pragma unroll
    for (int s = 0; s < 32; ++s)
#pragma unroll
        for (int n = 0; n < 2; ++n) bw[s][n] = wr[(size_t)(128 * w + 4 * s + fq) * NE + 16 * n + fr];
    const float mybr = br[lane & 31];
    constexpr int RPB = NTOK / 256;
    for (int ch = 0; ch < 8; ++ch) {
        const int t0 = blockIdx.x * RPB + ch * 16;
#pragma unroll
        for (int q = 0; q < 2; ++q) {
            const int rl = 2 * w + q, t = t0 + rl;
            float* row = h1 + (size_t)t * DM;
            float v[16]; float s = 0.f;
#pragma unroll
            for (int j = 0; j < 4; ++j) { const f32x4 qv = *(const GAS f32x4*)(row + j * 256 + lane * 4); v[4 * j] = qv.x; v[4 * j + 1] = qv.y; v[4 * j + 2] = qv.z; v[4 * j + 3] = qv.w; s += (qv.x + qv.y) + (qv.z + qv.w); }
            const float mean = wave_sum(s) * (1.0f / DM); float q2 = 0.f;
#pragma unroll
            for (int i = 0; i < 16; ++i) { v[i] -= mean; q2 += v[i] * v[i]; }
            const float rstd = rsqrtf(wave_sum(q2) * (1.0f / DM) + LN_EPS);
#pragma unroll
            for (int j = 0; j < 4; ++j) {
                const int col = j * 256 + lane * 4;
                const f32x4 gq = *(const GAS f32x4*)(g1 + col), bq = *(const GAS f32x4*)(b1 + col);
                const f32x4 o = (f32x4){v[4 * j] * rstd * gq.x + bq.x, v[4 * j + 1] * rstd * gq.y + bq.y, v[4 * j + 2] * rstd * gq.z + bq.z, v[4 * j + 3] * rstd * gq.w + bq.w};
                *(GAS f32x4*)(row + col) = o;
                *(LAS f32x4*)(XT + rl * XS + col) = o;
#if MOE_FP8
                *(GAS unsigned*)((unsigned char*)xb + (size_t)t * DM + col) = pg8::pk4_fp8(o.x, o.y, o.z, o.w);
#else
                v2u pk; pk.x = pk2(o.x, o.y); pk.y = pk2(o.z, o.w);
                *(GAS v2u*)(xb + (size_t)t * DM + col) = pk;
#endif
            }
        }
        __syncthreads();
        {
            f32x4 acc0 = (f32x4){0.f, 0.f, 0.f, 0.f}, acc1 = (f32x4){0.f, 0.f, 0.f, 0.f};
            const LAS float* xp = XT + fr * XS + 128 * w + fq;
#pragma unroll
            for (int s = 0; s < 32; ++s) { const float av = xp[4 * s];
                acc0 = __builtin_amdgcn_mfma_f32_16x16x4f32(av, bw[s][0], acc0, 0, 0, 0);
                acc1 = __builtin_amdgcn_mfma_f32_16x16x4f32(av, bw[s][1], acc1, 0, 0, 0); }
#pragma unroll
            for (int r = 0; r < 4; ++r) { PT[(w * 16 + fq * 4 + r) * 32 + fr] = acc0[r]; PT[(w * 16 + fq * 4 + r) * 32 + 16 + fr] = acc1[r]; }
        }
        __syncthreads();
#pragma unroll
        for (int q = 0; q < 2; ++q) {
            const int rl = 2 * w + q, t = t0 + rl, myexp = lane & 31;
            float cur = mybr;
#pragma unroll
            for (int ww = 0; ww < 8; ++ww) cur += PT[(ww * 16 + rl) * 32 + myexp];
            int idx[4]; float val[4];
#pragma unroll
            for (int k = 0; k < 4; ++k) {
                const float m = wave_max(cur);
                int cand = (cur == m) ? myexp : 99;
#pragma unroll
                for (int o = 1; o < 64; o <<= 1) cand = min(cand, __shfl_xor(cand, o));
                idx[k] = cand; val[k] = m; if (myexp == cand) cur = -INFINITY;
            }
            float ex[4], se = 0.f;
#pragma unroll
            for (int k = 0; k < 4; ++k) { ex[k] = expf(val[k] - val[0]); se += ex[k]; }
            if (lane < 4) {
                int e_ = idx[0]; float g_ = ex[0];
                if (lane == 1) { e_ = idx[1]; g_ = ex[1]; } else if (lane == 2) { e_ = idx[2]; g_ = ex[2]; } else if (lane == 3) { e_ = idx[3]; g_ = ex[3]; }
                const int lr = __hip_atomic_fetch_add(lcnt + e_, 1, __ATOMIC_RELAXED, __HIP_MEMORY_SCOPE_WORKGROUP);
                rec[(ch * 16 + rl) * 4 + lane] = e_ | (lr << 8);
                re[t * 4 + lane] = e_; rg[t * 4 + lane] = g_ / se;
            }
        }
    }
    __syncthreads();
    if (tid < 32) lbase[tid] = (int)__hip_atomic_fetch_add((unsigned*)(F.ctl + CW_CNT + tid), (unsigned)lcnt[tid], RLX_AGENT);
    __syncthreads();
    { const int rw = tid >> 2, k = tid & 3; const int t = blockIdx.x * RPB + rw; const int rc = rec[tid]; const int e_ = rc & 255, r_ = lbase[e_] + (rc >> 8);
      rr[t * 4 + k] = r_; list[e_ * NTOK + r_] = t; }
}
__device__ __forceinline__ void build_tab(Frame& F) {
    LAS int* tab = (LAS int*)(F.lds + TAB_OFF);
    if (F.tid < 32) tab[40 + F.tid] = (int)__hip_atomic_load(F.ctl + CW_CNT + F.tid, RLX_AGENT);
    __syncthreads();
    if (F.tid == 0) { int p = 0; for (int e = 0; e < NE; ++e) { tab[e] = p; p += (tab[40 + e] + 255) >> 8; } tab[NE] = p; }
    __syncthreads();
}
__device__ __forceinline__ void combine_phase(Frame& F, const Args& a) {
    const float* x1 = (const float*)(a.ws + WS_H1); const bf16_t* y = (const bf16_t*)(a.ws + WS_Y);
    const int* re = (const int*)(a.ws + WS_RE); const int* rr = (const int*)(a.ws + WS_RR); const float* rg = (const float*)(a.ws + WS_RG);
    const float *g2 = a.in[20], *b2 = a.in[21]; float* out = a.out;
    const LAS int* tab = (const LAS int*)(F.lds + TAB_OFF);
    const int lane = F.lane, gw = F.vcu * NWAVES + F.wave, NGW = F.G * NWAVES;
    for (int t = gw; t < NTOK; t += NGW) {
        float v[16];
#pragma unroll
        for (int j = 0; j < 4; ++j) { const f32x4 q = *(const GAS f32x4*)(x1 + (size_t)t * DM + j * 256 + lane * 4); v[4 * j] = ALPHA * q.x; v[4 * j + 1] = ALPHA * q.y; v[4 * j + 2] = ALPHA * q.z; v[4 * j + 3] = ALPHA * q.w; }
#pragma unroll
        for (int k = 0; k < 4; ++k) {
            const int e = re[t * 4 + k], slot = tab[e] * 256 + rr[t * 4 + k]; const float g = rg[t * 4 + k];
            const bf16_t* yr = y + (size_t)slot * DM;
#pragma unroll
            for (int j = 0; j < 4; ++j) { const v2u pk = *(const GAS v2u*)(yr + j * 256 + lane * 4);
                v[4 * j] = fmaf(g, bf2f((bf16_t)(pk.x & 0xffff)), v[4 * j]); v[4 * j + 1] = fmaf(g, bf2f((bf16_t)(pk.x >> 16)), v[4 * j + 1]);
                v[4 * j + 2] = fmaf(g, bf2f((bf16_t)(pk.y & 0xffff)), v[4 * j + 2]); v[4 * j + 3] = fmaf(g, bf2f((bf16_t)(pk.y >> 16)), v[4 * j + 3]); }
        }
        float s = 0.f;
#pragma unroll
        for (int i = 0; i < 16; ++i) s += v[i];
        const float mean = wave_sum(s) * (1.0f / DM); float q2 = 0.f;
#pragma unroll
        for (int i = 0; i < 16; ++i) { v[i] -= mean; q2 += v[i] * v[i]; }
        const float rstd = rsqrtf(wave_sum(q2) * (1.0f / DM) + LN_EPS);
#pragma unroll
        for (int j = 0; j < 4; ++j) { const int col = j * 256 + lane * 4; const f32x4 gg = *(const GAS f32x4*)(g2 + col), bb = *(const GAS f32x4*)(b2 + col);
            *(GAS f32x4*)(out + (size_t)t * DM + col) = (f32x4){v[4 * j] * rstd * gg.x + bb.x, v[4 * j + 1] * rstd * gg.y + bb.y, v[4 * j + 2] * rstd * gg.z + bb.z, v[4 * j + 3] * rstd * gg.w + bb.w}; }
    }
}

constexpr int N_PHASES = 9;
__global__ void __launch_bounds__(NWAVES * 64, 2) mega_fwd(Args args) {
    extern __shared__ __attribute__((aligned(16))) unsigned char lds[];
    Frame F;
    F.lds = (LAS unsigned char*)lds;
    F.MISC = (volatile LAS unsigned*)(F.lds + MISC_OFF);
    F.tid = threadIdx.x; F.lane = F.tid & 63; F.wave = __builtin_amdgcn_readfirstlane(F.tid >> 6);
    F.G = gridDim.x; { const int bx = blockIdx.x; F.vcu = (F.G % 8 == 0) ? (bx % 8) * (F.G / 8) + bx / 8 : bx; }
    F.ctl = (gu32*)(args.ws + WS_CTL);
    for (int u = F.tid; u < (LDS_BYTES - LDSCTL_OFF) / 4; u += NWAVES * 64) ((LAS unsigned*)(F.lds + LDSCTL_OFF))[u] = 0u;
    __syncthreads();
    const int lo = args.ph_lo, hi = args.ph_hi;
    const bool multi = (hi - lo) > 1;
    XcdBarrier bar; bar.bar = (unsigned*)(F.ctl + CW_BAR); bar.x = 0; bar.st = nullptr;
    if (multi) bar = xcd_barrier_post((unsigned*)(F.ctl + CW_BAR), F.MISC + 8);
#ifndef PH_MASK
#define PH_MASK 0x1FF
#endif
#define IN(k) ((((PH_MASK) >> (k)) & 1) && lo <= (k) && (k) < hi)
#define SEAM(k) do { if (IN(k) && IN((k) + 1)) xcd_barrier(bar); } while (0)
#ifndef DOUBLE_MASK
#define DOUBLE_MASK 0
#endif
#define REP(k) for (int rep_ = 0; rep_ < ((((DOUBLE_MASK) >> (k)) & 1) + 1); ++rep_)
    if (IN(0)) { REP(0) { refresh_frame(F); const Args A = fetch_args(); p0_prologue(F, A); } SEAM(0); }
    if (IN(1)) { REP(1) {
        refresh_frame(F); const Args A = fetch_args(); unsigned char* ws = A.ws;
        pg8::Gemm g{(const bf16_t*)(ws + WS_XB), (const bf16_t*)(ws + WS_WIN), NTOK, INW, DM, 0}; pg8::StaticOrder S; S.init(NTOK, INW, F.G, (int)blockIdx.x);
        pg8::EpiProj E{(bf16_t*)(ws + WS_PROJ)};
        pg8::gemm_phase<pg8::EpiProj, pg8::StaticOrder, false>(F.lds + RING_OFF, g, S, E);
        } SEAM(1);
    }
    if (IN(2)) { REP(2) {
        refresh_frame(F); const Args A = fetch_args(); unsigned char* ws = A.ws;
        if (A.pad0 & 1) attn_body::attn_phase<8>((char*)lds + RING_OFF, (const bf16_t*)(ws + WS_PROJ), (bf16_t*)(ws + WS_ATTO), F.vcu);
        if (A.pad0 & 2) gmlp_phase(F, A);
        } SEAM(2);
    }
    if (IN(3)) { REP(3) { refresh_frame(F); const Args A = fetch_args(); attn_combine_phase(F, A); } SEAM(3); }
    if (IN(4)) { REP(4) {
        refresh_frame(F); const Args A = fetch_args(); unsigned char* ws = A.ws;
        pg8::Gemm g{(const bf16_t*)(ws + WS_MIX), (const bf16_t*)(ws + WS_WO), NTOK, DM, DM, 0}; pg8::StaticOrder S; S.init(NTOK, DM, F.G, (int)blockIdx.x);
        pg8::EpiH1 E{A.in[0], (float*)(ws + WS_H1)};
        pg8::gemm_phase<pg8::EpiH1, pg8::StaticOrder, false>(F.lds + RING_OFF, g, S, E);
        } SEAM(4);
    }
    if (IN(5)) { REP(5) { refresh_frame(F); const Args A = fetch_args(); route_phase(F, A); } SEAM(5); }
    if (IN(6)) { REP(6) {
        refresh_frame(F); const Args A = fetch_args(); unsigned char* ws = A.ws;
        build_tab(F);
        pg8::MoeOrder S; S.init((const LAS int*)(F.lds + TAB_OFF), (const int*)(ws + WS_LIST), 8, (int)blockIdx.x);
#if MOE_FP8
        pg8::Gemm g{(const bf16_t*)(ws + WS_XB), (const bf16_t*)(ws + WS_WUP), PADROWS, 2 * DFF, DM, (size_t)2 * DFF * DM / 2};
        pg8::EpiSwiglu8 E{(unsigned char*)(ws + WS_ACT), A.in[17]};
        pg8::gemm_phase<pg8::EpiSwiglu8, pg8::MoeOrder, true, true>(F.lds + RING_OFF, g, S, E);
#else
        pg8::Gemm g{(const bf16_t*)(ws + WS_XB), (const bf16_t*)(ws + WS_WUP), PADROWS, 2 * DFF, DM, (size_t)2 * DFF * DM};
        pg8::EpiSwiglu E{(bf16_t*)(ws + WS_ACT), A.in[17]};
        pg8::gemm_phase<pg8::EpiSwiglu, pg8::MoeOrder, true>(F.lds + RING_OFF, g, S, E);
#endif
        } SEAM(6);
    }
    if (IN(7)) { REP(7) {
        refresh_frame(F); const Args A = fetch_args(); unsigned char* ws = A.ws;
        build_tab(F);
        pg8::MoeOrder S; S.init((const LAS int*)(F.lds + TAB_OFF), (const int*)(ws + WS_LIST), 4, (int)blockIdx.x);
        pg8::EpiDown E{(bf16_t*)(ws + WS_Y), A.in[19]};
#if MOE_FP8
        pg8::Gemm g{(const bf16_t*)(ws + WS_ACT), (const bf16_t*)(ws + WS_WDN), PADROWS, DM, DFF, (size_t)DM * DFF / 2};
        pg8::gemm_phase<pg8::EpiDown, pg8::MoeOrder, false, true>(F.lds + RING_OFF, g, S, E);
#else
        pg8::Gemm g{(const bf16_t*)(ws + WS_ACT), (const bf16_t*)(ws + WS_WDN), PADROWS, DM, DFF, (size_t)DM * DFF};
        pg8::gemm_phase<pg8::EpiDown, pg8::MoeOrder, false>(F.lds + RING_OFF, g, S, E);
#endif
        } SEAM(7);
    }
    if (IN(8)) { REP(8) { refresh_frame(F); const Args A = fetch_args(); build_tab(F); combine_phase(F, A); } }
#undef IN
#undef SEAM
}

struct NArgs {
    const float* x; const float* B; const float* bias; const float* bias2;
    const bf16_t* Ab; bf16_t* Ob; float* Of; const int* ctl; const int* list;
};
template <int MODE> __global__ void __launch_bounds__(256) ngemm(NArgs a) {
    constexpr int K = 1024;
    constexpr int LDB = (MODE == 0) ? INW : (MODE == 2 ? 2048 : 1024);
    constexpr bool DUAL = (MODE == 2);
    __shared__ float As[16][68];
    __shared__ float Bs[16][64];
    __shared__ float Bs2[DUAL ? 16 : 1][64];
    const int tid = threadIdx.x, ty = tid >> 4, tx = tid & 15;
    const int row0 = blockIdx.y * 64, col0 = blockIdx.x * 64;
    const float* B = a.B; int e = 0, pst = 0, cnt = 0;
    if (MODE >= 2) {
        const int* ps = a.ctl + CW_PSTART;
        while (e < NE && row0 >= ps[e + 1]) ++e;
        if (e >= NE) return;
        pst = ps[e]; cnt = a.ctl[CW_CNT + e];
        B += (size_t)e * K * LDB;
    }
    const int ar = tid >> 2, ak = (tid & 3) * 4;
    const float* arow_f = nullptr; const bf16_t* arow_b = nullptr;
    if (MODE == 0) arow_f = a.x + (size_t)(row0 + ar) * K;
    else if (MODE == 1 || MODE == 3) arow_b = a.Ab + (size_t)(row0 + ar) * K;
    else { const int r = row0 + ar - pst; const int tok = (r < cnt) ? a.list[e * NTOK + r] : 0; arow_b = a.Ab + (size_t)tok * K; }
    const int bk = tid >> 4, bn = (tid & 15) * 4;
    float acc[4][4], acc2[4][4];
#pragma unroll
    for (int i = 0; i < 4; ++i)
#pragma unroll
        for (int j = 0; j < 4; ++j) { acc[i][j] = 0.f; acc2[i][j] = 0.f; }
    for (int k0 = 0; k0 < K; k0 += 16) {
        float av[4];
        if (MODE == 0) { const float4 t = *(const float4*)(arow_f + k0 + ak); av[0] = t.x; av[1] = t.y; av[2] = t.z; av[3] = t.w; }
        else { const uint2 t = *(const uint2*)(arow_b + k0 + ak); av[0] = bf2f((bf16_t)(t.x & 0xffff)); av[1] = bf2f((bf16_t)(t.x >> 16)); av[2] = bf2f((bf16_t)(t.y & 0xffff)); av[3] = bf2f((bf16_t)(t.y >> 16)); }
        const float4 bv = *(const float4*)(B + (size_t)(k0 + bk) * LDB + col0 + bn);
        float4 bv2 = bv;
        if (DUAL) bv2 = *(const float4*)(B + (size_t)(k0 + bk) * LDB + 1024 + col0 + bn);
        __syncthreads();
#pragma unroll
        for (int c = 0; c < 4; ++c) As[ak + c][ar] = av[c];
        *(float4*)&Bs[bk][bn] = bv;
        if (DUAL) *(float4*)&Bs2[bk][bn] = bv2;
        __syncthreads();
#pragma unroll
        for (int k = 0; k < 16; ++k) {
            const float4 a4 = *(const float4*)&As[k][ty * 4];
            const float4 b4 = *(const float4*)&Bs[k][tx * 4];
            const float aa[4] = {a4.x, a4.y, a4.z, a4.w}, bb[4] = {b4.x, b4.y, b4.z, b4.w};
#pragma unroll
            for (int i = 0; i < 4; ++i)
#pragma unroll
                for (int j = 0; j < 4; ++j) acc[i][j] = fmaf(aa[i], bb[j], acc[i][j]);
            if (DUAL) {
                const float4 c4 = *(const float4*)&Bs2[k][tx * 4];
                const float cc[4] = {c4.x, c4.y, c4.z, c4.w};
#pragma unroll
                for (int i = 0; i < 4; ++i)
#pragma unroll
                    for (int j = 0; j < 4; ++j) acc2[i][j] = fmaf(aa[i], cc[j], acc2[i][j]);
            }
        }
    }
#pragma unroll
    for (int i = 0; i < 4; ++i) {
        const int row = row0 + ty * 4 + i;
#pragma unroll
        for (int j = 0; j < 4; ++j) {
            const int col = col0 + tx * 4 + j;
            if (MODE == 0) { float v = acc[i][j]; if (col < C_K) v *= QSCALE; a.Ob[(size_t)row * INW + col] = f2bf(v); }
            else if (MODE == 1) { a.Of[(size_t)row * DM + col] = ALPHA * a.x[(size_t)row * DM + col] + acc[i][j]; }
            else if (MODE == 2) {
                float g = acc[i][j] + a.bias[e * 2048 + col], l = acc2[i][j] + a.bias[e * 2048 + 1024 + col];
                g = fminf(g, 7.0f); l = fminf(fmaxf(l, -7.0f), 7.0f);
                const float act = (l + 1.0f) * g * (1.0f / (1.0f + expf(-1.702f * g)));
                a.Ob[(size_t)row * DFF + col] = f2bf(act);
            } else { a.Ob[(size_t)row * DM + col] = f2bf(acc[i][j] + a.bias[e * DM + col]); }
        }
    }
}

__global__ void __launch_bounds__(128) nattn(const bf16_t* __restrict__ proj, bf16_t* __restrict__ mix, const float* lq1, const float* lk1, const float* lq2, const float* lk2, const float* subg) {
    __shared__ float sc[2][SEQ];
    const int w = threadIdx.x >> 6, lane = threadIdx.x & 63;
    const int task = blockIdx.x * 2 + w, t = task >> 2, h = task & 3, b = t / SEQ, qpos = t % SEQ;
    const float lam = expf(wave_sum(lq1[lane] * lk1[lane])) - expf(wave_sum(lq2[lane] * lk2[lane])) + LAMBDA_INIT;
    const bf16_t* pb = proj + (size_t)b * SEQ * INW;
    float o[2][2];
    for (int s = 0; s < 2; ++s) {
        float q[DH];
        const bf16_t* qp = proj + (size_t)t * INW + C_Q + s * 256 + h * DH;
#pragma unroll
        for (int d = 0; d < DH; ++d) q[d] = bf2f(qp[d]);
        float m = -INFINITY;
        for (int j = lane; j <= qpos; j += 64) {
            const uint4* kp = (const uint4*)(pb + (size_t)j * INW + C_K + s * 256 + h * DH);
            float acc = 0.f;
#pragma unroll
            for (int c = 0; c < 8; ++c) {
                const uint4 kk = kp[c];
                const uint32_t ww[4] = {kk.x, kk.y, kk.z, kk.w};
#pragma unroll
                for (int z = 0; z < 4; ++z) { acc = fmaf(q[c * 8 + 2 * z], bf2f((bf16_t)(ww[z] & 0xffff)), acc); acc = fmaf(q[c * 8 + 2 * z + 1], bf2f((bf16_t)(ww[z] >> 16)), acc); }
            }
            sc[w][j] = acc; m = fmaxf(m, acc);
        }
        m = wave_max(m);
        float l = 0.f;
        for (int j = lane; j <= qpos; j += 64) { const float p = exp2f(sc[w][j] - m); sc[w][j] = p; l += p; }
        l = wave_sum(l);
        __syncthreads();
        float o0 = 0.f, o1 = 0.f;
        const bf16_t* vp = pb + C_V + h * DV + lane * 2;
        for (int j = 0; j <= qpos; ++j) {
            const float p = sc[w][j];
            const uint32_t vv = *(const uint32_t*)(vp + (size_t)j * INW);
            o0 = fmaf(p, bf2f((bf16_t)(vv & 0xffff)), o0); o1 = fmaf(p, bf2f((bf16_t)(vv >> 16)), o1);
        }
        o[s][0] = o0 / l; o[s][1] = o1 / l;
        __syncthreads();
    }
    const float d0 = o[0][0] - lam * o[1][0], d1 = o[0][1] - lam * o[1][1];
    const float ss = wave_sum(d0 * d0 + d1 * d1);
    const float r = rsqrtf(ss * (1.0f / DV) + LN_EPS) * (1.0f - LAMBDA_INIT);
    const uint32_t pk = (uint32_t)f2bf(d0 * r * subg[lane * 2]) | ((uint32_t)f2bf(d1 * r * subg[lane * 2 + 1]) << 16);
    *(uint32_t*)(mix + (size_t)t * DM + h * DV + lane * 2) = pk;
}

__global__ void __launch_bounds__(256) ngmlp(const bf16_t* __restrict__ proj, bf16_t* __restrict__ mix, const float* lng, const float* lnb, const float* wsp, const float* bsp) {
    __shared__ float mu[CHUNK], rs[CHUNK];
    __shared__ float vn[CHUNK][GD];
    const int c = blockIdx.x, g = blockIdx.y, tid = threadIdx.x, w = tid >> 6, lane = tid & 63;
    const size_t row0 = (size_t)c * CHUNK;
    for (int s = w; s < CHUNK; s += 4) {
        const bf16_t* p = proj + (row0 + s) * INW + C_GV;
        float v[8]; float sum = 0.f;
#pragma unroll
        for (int i = 0; i < 8; ++i) { v[i] = gelu_exact(bf2f(p[lane + 64 * i])); sum += v[i]; }
        const float mean = wave_sum(sum) * (1.0f / GW); float q = 0.f;
#pragma unroll
        for (int i = 0; i < 8; ++i) { const float d = v[i] - mean; q += d * d; }
        const float var = wave_sum(q) * (1.0f / GW);
        if (lane == 0) { mu[s] = mean; rs[s] = rsqrtf(var + LN_EPS); }
    }
    __syncthreads();
    for (int i = tid; i < CHUNK * GD; i += 256) {
        const int s = i >> 6, d = i & 63, col = g * GD + d;
        const float v = gelu_exact(bf2f(proj[(row0 + s) * INW + C_GV + col]));
        vn[s][d] = (v - mu[s]) * rs[s] * lng[col] + lnb[col];
    }
    __syncthreads();
    const int t = tid >> 1, dh = (tid & 1) * 32;
    float z[32];
#pragma unroll
    for (int d = 0; d < 32; ++d) z[d] = 0.f;
    const float* wr = wsp + ((size_t)g * CHUNK + t) * CHUNK;
    for (int s = 0; s <= t; ++s) {
        const float wv = wr[s];
#pragma unroll
        for (int d = 0; d < 32; ++d) z[d] = fmaf(wv, vn[s][dh + d], z[d]);
    }
    const float bb = bsp[g * CHUNK + t];
#pragma unroll
    for (int d = 0; d < 32; ++d) {
        const int col = g * GD + dh + d;
        const float u = gelu_exact(bf2f(proj[(row0 + t) * INW + C_GU + col]));
        mix[(row0 + t) * DM + GW + col] = f2bf(u * (z[d] + bb));
    }
}

__global__ void __launch_bounds__(256) nroute(float* __restrict__ h1, bf16_t* __restrict__ xb, const float* g1, const float* b1, const float* wr, const float* br, int* ctl, int* list, int* re, int* rr, float* rg) {
    const int w = threadIdx.x >> 6, lane = threadIdx.x & 63, t = blockIdx.x * 4 + w;
    float* row = h1 + (size_t)t * DM;
    float v[16]; float s = 0.f;
#pragma unroll
    for (int j = 0; j < 4; ++j) { const float4 q = *(const float4*)(row + j * 256 + lane * 4); v[4 * j] = q.x; v[4 * j + 1] = q.y; v[4 * j + 2] = q.z; v[4 * j + 3] = q.w; s += (q.x + q.y) + (q.z + q.w); }
    const float mean = wave_sum(s) * (1.0f / DM); float q2 = 0.f;
#pragma unroll
    for (int i = 0; i < 16; ++i) { v[i] -= mean; q2 += v[i] * v[i]; }
    const float rstd = rsqrtf(wave_sum(q2) * (1.0f / DM) + LN_EPS);
#pragma unroll
    for (int j = 0; j < 4; ++j) {
        const int col = j * 256 + lane * 4;
#pragma unroll
        for (int c = 0; c < 4; ++c) v[4 * j + c] = v[4 * j + c] * rstd * g1[col + c] + b1[col + c];
        *(float4*)(row + col) = make_float4(v[4 * j], v[4 * j + 1], v[4 * j + 2], v[4 * j + 3]);
        uint2 pk; pk.x = (uint32_t)f2bf(v[4 * j]) | ((uint32_t)f2bf(v[4 * j + 1]) << 16); pk.y = (uint32_t)f2bf(v[4 * j + 2]) | ((uint32_t)f2bf(v[4 * j + 3]) << 16);
        *(uint2*)(xb + (size_t)t * DM + col) = pk;
    }
    float lg[NE];
#pragma unroll
    for (int e = 0; e < NE; ++e) lg[e] = 0.f;
#pragma unroll
    for (int j = 0; j < 4; ++j)
#pragma unroll
        for (int c = 0; c < 4; ++c) {
            const float xv = v[4 * j + c]; const float4* wp = (const float4*)(wr + (size_t)(j * 256 + lane * 4 + c) * NE);
#pragma unroll
            for (int e4 = 0; e4 < 8; ++e4) { const float4 ww = wp[e4]; lg[4 * e4] = fmaf(xv, ww.x, lg[4 * e4]); lg[4 * e4 + 1] = fmaf(xv, ww.y, lg[4 * e4 + 1]); lg[4 * e4 + 2] = fmaf(xv, ww.z, lg[4 * e4 + 2]); lg[4 * e4 + 3] = fmaf(xv, ww.w, lg[4 * e4 + 3]); }
        }
#pragma unroll
    for (int e = 0; e < NE; ++e) lg[e] = wave_sum(lg[e]) + br[e];
    int idx[4]; float val[4]; unsigned taken = 0u;
#pragma unroll
    for (int k = 0; k < 4; ++k) {
        float best = -INFINITY; int bi = 0;
#pragma unroll
        for (int e = 0; e < NE; ++e) { const bool ok = !((taken >> e) & 1u) && lg[e] > best; best = ok ? lg[e] : best; bi = ok ? e : bi; }
        idx[k] = bi; val[k] = best; taken |= 1u << bi;
    }
    float ex[4], se = 0.f;
#pragma unroll
    for (int k = 0; k < 4; ++k) { ex[k] = expf(val[k] - val[0]); se += ex[k]; }
    if (lane == 0) {
#pragma unroll
        for (int k = 0; k < 4; ++k) {
            const int r = atomicAdd(ctl + CW_CNT + idx[k], 1);
            list[idx[k] * NTOK + r] = t;
            re[t * 4 + k] = idx[k]; rr[t * 4 + k] = r; rg[t * 4 + k] = ex[k] / se;
        }
    }
}
__global__ void npstart(int* ctl) {
    if (threadIdx.x == 0 && blockIdx.x == 0) { int p = 0; for (int e = 0; e < NE; ++e) { ctl[CW_PSTART + e] = p; p += ((ctl[CW_CNT + e] + 255) / 256) * 256; } ctl[CW_PSTART + NE] = p; }
}
__global__ void __launch_bounds__(256) ncombine(const float* __restrict__ x1, const bf16_t* __restrict__ y, const int* ctl, const int* re, const int* rr, const float* rg, const float* g2, const float* b2, float* __restrict__ out) {
    const int w = threadIdx.x >> 6, lane = threadIdx.x & 63, t = blockIdx.x * 4 + w;
    float v[16];
#pragma unroll
    for (int j = 0; j < 4; ++j) { const float4 q = *(const float4*)(x1 + (size_t)t * DM + j * 256 + lane * 4); v[4 * j] = ALPHA * q.x; v[4 * j + 1] = ALPHA * q.y; v[4 * j + 2] = ALPHA * q.z; v[4 * j + 3] = ALPHA * q.w; }
#pragma unroll
    for (int k = 0; k < 4; ++k) {
        const int e = re[t * 4 + k], slot = ctl[CW_PSTART + e] + rr[t * 4 + k]; const float g = rg[t * 4 + k];
        const bf16_t* yr = y + (size_t)slot * DM;
#pragma unroll
        for (int j = 0; j < 4; ++j) { const uint2 pk = *(const uint2*)(yr + j * 256 + lane * 4);
            v[4 * j] = fmaf(g, bf2f((bf16_t)(pk.x & 0xffff)), v[4 * j]); v[4 * j + 1] = fmaf(g, bf2f((bf16_t)(pk.x >> 16)), v[4 * j + 1]);
            v[4 * j + 2] = fmaf(g, bf2f((bf16_t)(pk.y & 0xffff)), v[4 * j + 2]); v[4 * j + 3] = fmaf(g, bf2f((bf16_t)(pk.y >> 16)), v[4 * j + 3]); }
    }
    float s = 0.f;
#pragma unroll
    for (int i = 0; i < 16; ++i) s += v[i];
    const float mean = wave_sum(s) * (1.0f / DM); float q2 = 0.f;
#pragma unroll
    for (int i = 0; i < 16; ++i) { v[i] -= mean; q2 += v[i] * v[i]; }
    const float rstd = rsqrtf(wave_sum(q2) * (1.0f / DM) + LN_EPS);
#pragma unroll
    for (int j = 0; j < 4; ++j) { const int col = j * 256 + lane * 4;
        *(float4*)(out + (size_t)t * DM + col) = make_float4(v[4 * j] * rstd * g2[col] + b2[col], v[4 * j + 1] * rstd * g2[col + 1] + b2[col + 1], v[4 * j + 2] * rstd * g2[col + 2] + b2[col + 2], v[4 * j + 3] * rstd * g2[col + 3] + b2[col + 3]); }
}

#ifndef OPT_MASK
#define OPT_MASK 0x1FF
#endif
#ifndef FUSED
#define FUSED 0
#endif
static void launch_mega(const Args& base, int lo, int hi, int sub, hipStream_t stream) {
    Args a = base; a.ph_lo = lo; a.ph_hi = hi; a.pad0 = sub; a.pad1 = 0;
    hipLaunchKernelGGL(mega_fwd, dim3(256), dim3(NWAVES * 64), LDS_BYTES, stream, a);
}
extern "C" void kernel_launch(void* const* d_in, const int* in_sizes, int n_in, void* d_out, int out_size, void* d_ws, size_t ws_size, hipStream_t stream) {
    static int ready = 0;
    if (ready == 0) {
        if (n_in != 22 || in_sizes[0] != NTOK * DM || out_size != NTOK * DM || ws_size < WS_END) { fprintf(stderr, "kernel_launch: unexpected shapes (n_in %d, in0 %d, out %d, ws %zu)\n", n_in, n_in > 0 ? in_sizes[0] : -1, out_size, ws_size); ready = -1; return; }
        if (hipFuncSetAttribute((const void*)mega_fwd, hipFuncAttributeMaxDynamicSharedMemorySize, LDS_BYTES) != hipSuccess) { fprintf(stderr, "kernel_launch: hipFuncSetAttribute failed\n"); ready = -1; return; }
        ready = 1;
    }
    if (ready < 0) return;
    const float* x = (const float*)d_in[0]; const float* w_in = (const float*)d_in[1];
    const float *lq1 = (const float*)d_in[2], *lk1 = (const float*)d_in[3], *lq2 = (const float*)d_in[4], *lk2 = (const float*)d_in[5];
    const float *subg = (const float*)d_in[6], *glng = (const float*)d_in[7], *glnb = (const float*)d_in[8], *wsp = (const float*)d_in[9], *bsp = (const float*)d_in[10];
    const float *w_o = (const float*)d_in[11], *ln1g = (const float*)d_in[12], *ln1b = (const float*)d_in[13], *w_r = (const float*)d_in[14], *b_r = (const float*)d_in[15];
    const float *w_up = (const float*)d_in[16], *b_up = (const float*)d_in[17], *w_dn = (const float*)d_in[18], *b_dn = (const float*)d_in[19], *ln2g = (const float*)d_in[20], *ln2b = (const float*)d_in[21];
    unsigned char* ws = (unsigned char*)d_ws;
    int* ctl = (int*)(ws + WS_CTL); int* list = (int*)(ws + WS_LIST); int* re = (int*)(ws + WS_RE); int* rr = (int*)(ws + WS_RR); float* rg = (float*)(ws + WS_RG);
    bf16_t* xb = (bf16_t*)(ws + WS_XB); bf16_t* proj = (bf16_t*)(ws + WS_PROJ); bf16_t* mix = (bf16_t*)(ws + WS_MIX); bf16_t* yb = (bf16_t*)(ws + WS_Y);
    float* h1 = (float*)(ws + WS_H1); bf16_t* act = (bf16_t*)(ws + WS_ACT);
    (void)hipMemsetAsync(ws + WS_CTL, 0, CTL_BYTES, stream);
    Args base{};
    for (int i = 0; i < 22; ++i) base.in[i] = (const float*)d_in[i];
    base.out = (float*)d_out; base.ws = ws;
    constexpr unsigned OM = OPT_MASK;
#if FUSED
    static_assert(OM == 0x1FFu, "FUSED needs every stage in the persistent kernel");
    launch_mega(base, 0, N_PHASES, 3, stream);
#else
    if (OM & 0xD3u) launch_mega(base, 0, 1, 0, stream);
    if (OM & 2u) launch_mega(base, 1, 2, 0, stream);
    else { NArgs a{}; a.x = x; a.B = w_in; a.Ob = proj; ngemm<0><<<dim3(INW / 64, NTOK / 64), 256, 0, stream>>>(a); }
    if ((OM & 4u) || (OM & 8u)) launch_mega(base, 2, 3, ((OM & 4u) ? 1 : 0) | ((OM & 8u) ? 2 : 0), stream);
    if (OM & 4u) launch_mega(base, 3, 4, 0, stream);
    else nattn<<<NTOK * NH / 2, 128, 0, stream>>>(proj, mix, lq1, lk1, lq2, lk2, subg);
    if (!(OM & 8u)) ngmlp<<<dim3(NTOK / CHUNK, NG), 256, 0, stream>>>(proj, mix, glng, glnb, wsp, bsp);
    if (OM & 16u) launch_mega(base, 4, 5, 0, stream);
    else { NArgs a{}; a.x = x; a.B = w_o; a.Ab = mix; a.Of = h1; ngemm<1><<<dim3(DM / 64, NTOK / 64), 256, 0, stream>>>(a); }
    if (OM & 32u) launch_mega(base, 5, 6, 0, stream);
    else nroute<<<NTOK / 4, 256, 0, stream>>>(h1, xb, ln1g, ln1b, w_r, b_r, ctl, list, re, rr, rg);
    if ((OM & 0x1C0u) != 0x1C0u) npstart<<<1, 64, 0, stream>>>(ctl);
    if (OM & 64u) launch_mega(base, 6, 7, 0, stream);
    else { NArgs a{}; a.B = w_up; a.bias = b_up; a.Ab = xb; a.Ob = act; a.ctl = ctl; a.list = list; ngemm<2><<<dim3(DFF / 64, PADROWS / 64), 256, 0, stream>>>(a); }
    if (OM & 128u) launch_mega(base, 7, 8, 0, stream);
    else { NArgs a{}; a.B = w_dn; a.bias = b_dn; a.Ab = act; a.Ob = yb; a.ctl = ctl; a.list = list; ngemm<3><<<dim3(DM / 64, PADROWS / 64), 256, 0, stream>>>(a); }
    if (OM & 256u) launch_mega(base, 8, 9, 0, stream);
    else ncombine<<<NTOK / 4, 256, 0, stream>>>(h1, yb, ctl, re, rr, rg, ln2g, ln2b, (float*)d_out);
#endif
}
```

```cpp
#include <hip/hip_runtime.h>
#include <hip/hip_bf16.h>
#include <cstdint>
#include <cstdio>
#include <cmath>

#ifndef MOE_FP8
#define MOE_FP8 1
#endif
namespace cfg {
constexpr int BATCH = 8, SEQ = 4096, NTOK = BATCH * SEQ, DM = 1024;
constexpr int INW = 2560, NH = 4, DH = 64, DV = 128;
constexpr int C_Q = 0, C_K = 512, C_V = 1024, C_GU = 1536, C_GV = 2048;
constexpr int GW = 512, NG = 8, GD = 64, CHUNK = 128;
constexpr int NE = 32, TOPK = 4, DFF = 1024;
constexpr int PADROWS = 139264;
constexpr float LN_EPS = 1e-5f;
constexpr float ALPHA = 1.189207115002721f;
constexpr float LAMBDA_INIT = 0.2f;
constexpr float QSCALE = 0.125f * 1.4426950408889634f;
constexpr size_t MiB = 1u << 20;
constexpr size_t WS_CTL = 0, CTL_BYTES = 1 * MiB;
constexpr size_t WS_LIST = 1 * MiB;
constexpr size_t WS_RE = 5 * MiB, WS_RR = 5 * MiB + 512 * 1024, WS_RG = 6 * MiB;
constexpr size_t WS_WIN = 8 * MiB;
constexpr size_t WS_WO = 13 * MiB;
constexpr size_t WS_WUP = 16 * MiB;
constexpr size_t WS_WDN = 144 * MiB;
constexpr size_t WS_XB = 208 * MiB;
constexpr size_t WS_PROJ = 272 * MiB;
constexpr size_t WS_MIX = 432 * MiB;
constexpr size_t WS_ATTO = 496 * MiB;
constexpr size_t WS_Y = 272 * MiB;
constexpr size_t WS_H1 = 560 * MiB;
constexpr size_t WS_ACT = 688 * MiB;
constexpr size_t WS_END = 960 * MiB;
constexpr int CW_CNT = 0;
constexpr int CW_PSTART = 64;
constexpr int CW_BAR = 4096;
}
using namespace cfg;
typedef uint16_t bf16_t;

__device__ __forceinline__ float bf2f(bf16_t b) { return __uint_as_float((uint32_t)b << 16); }
__device__ __forceinline__ bf16_t f2bf(float f) { uint32_t u = __float_as_uint(f); u += 0x7fffu + ((u >> 16) & 1u); return (bf16_t)(u >> 16); }
__device__ __forceinline__ uint32_t pk2(float lo, float hi) { return (uint32_t)f2bf(lo) | ((uint32_t)f2bf(hi) << 16); }
__device__ __forceinline__ float wave_sum(float v) {
#pragma unroll
    for (int o = 1; o < 64; o <<= 1) v += __shfl_xor(v, o);
    return v;
}
__device__ __forceinline__ float wave_max(float v) {
#pragma unroll
    for (int o = 1; o < 64; o <<= 1) v = fmaxf(v, __shfl_xor(v, o));
    return v;
}
__device__ __forceinline__ float gelu_exact(float x) { return 0.5f * x * (1.0f + erff(x * 0.70710678118654752f)); }

#define OPT_MASK 0x1FF
#define FUSED 1
#define DOUBLE_MASK 0
#define P2_REP_SUB 3
namespace pg8 {
#define PG8_LAS __attribute__((address_space(3)))
typedef short bf16x8 __attribute__((ext_vector_type(8)));
typedef float f32x4 __attribute__((ext_vector_type(4)));
typedef float f32x2 __attribute__((ext_vector_type(2)));
typedef unsigned u32x4 __attribute__((ext_vector_type(4)));
typedef int v4i_t __attribute__((ext_vector_type(4)));
typedef int v8i_t __attribute__((ext_vector_type(8)));
constexpr int WSHIFT = 6;
constexpr int WSCALE_E8M0 = (127 - WSHIFT) * 0x01010101;
constexpr int BM = 256, BK = 64, HALF = 128, HTB = HALF * BK * 2  , STAGE_BYTES = 8 * HTB, NXCD = 8, WGM = 8;

__host__ __device__ __forceinline__ int lds_byte(int r, int c) { const int st = (r >> 4) * 2 + (c >> 5), rr = r & 15, cc = c & 31, ob = rr * 64 + cc * 2; return st * 1024 + (ob ^ (((ob >> 9) & 1) << 5)); }
__host__ __device__ __forceinline__ void stage_rc(int b, int& R, int& C) { const int st = b / 1024, sb = b % 1024, swz = sb ^ (((sb >> 9) & 1) << 5); R = (st >> 1) * 16 + swz / 64; C = (st & 1) * 32 + (swz % 64) / 2; }
__host__ __device__ __forceinline__ int perm32(int rho) { const int n = rho >> 4, i = rho & 15; return 8 * (i >> 2) + 4 * n + (i & 3); }

struct Unit { int pm, pn, e; };
struct Gemm { const bf16_t* A; const bf16_t* Bt; int M, N, K; size_t strideB; };

struct StaticOrder {
    int nM, nN, nwg, G, c;
    __host__ __device__ void init(int M, int N, int G_, int c_) { nM = M / BM; nN = N / BM; nwg = nM * nN; G = G_; c = c_; }
    __host__ __device__ bool next(int i, Unit& u) const {
        const long L = (long)i * G + c; if (L >= nwg) return false;
        int wgid = (int)L; { const int q = nwg / NXCD, r = nwg % NXCD, xcd = wgid % NXCD, off = wgid / NXCD; wgid = (xcd < r ? xcd * (q + 1) : r * (q + 1) + (xcd - r) * q) + off; }
        const int nig = WGM * nN, gid = wgid / nig, fm = gid * WGM, gsz = (nM - fm) < WGM ? (nM - fm) : WGM;
        u.pm = fm + ((wgid % nig) % gsz); u.pn = (wgid % nig) / gsz; u.e = 0; return true;
    }
    __device__ __forceinline__ void gather(const Unit&, const int (&)[2], const int (&)[2], unsigned (&)[2][2], unsigned) const {}
};
struct MoeOrder {
    const PG8_LAS int* tab; const int* list; int NC, RG, chunk0, nrt, j0;
    __device__ __forceinline__ void init(const PG8_LAS int* tab_, const int* list_, int NC_, int bid) {
        tab = tab_; list = list_; NC = NC_; RG = 32 / NC_; const int x = bid & 7; j0 = bid >> 3;
        const int T = __builtin_amdgcn_readfirstlane(tab_[32]); chunk0 = (T * x) / 8; nrt = (T * (x + 1)) / 8 - chunk0;
    }
    __device__ __forceinline__ bool next(int i, Unit& u) const {
        const int pml = i * RG + (j0 % RG); if (pml >= nrt) return false;
        u.pm = chunk0 + pml; u.pn = j0 / RG; int e = 0;
        while (e < NE - 1 && u.pm >= __builtin_amdgcn_readfirstlane(tab[e + 1])) ++e;
        u.e = e; return true;
    }
    __device__ __forceinline__ void gather(const Unit& u, const int (&RA)[2], const int (&CA2)[2], unsigned (&go)[2][2], unsigned rowbytes) const {
        const int r0 = (u.pm - __builtin_amdgcn_readfirstlane(tab[u.e])) * BM, cnt = __builtin_amdgcn_readfirstlane(tab[40 + u.e]);
#pragma unroll
        for (int h = 0; h < 2; ++h)
#pragma unroll
            for (int i = 0; i < 2; ++i) { const int r = r0 + h * HALF + RA[i]; const int tok = (r < cnt) ? list[u.e * NTOK + r] : 0; go[h][i] = (unsigned)tok * rowbytes + (unsigned)CA2[i]; }
    }
};

__device__ __forceinline__ unsigned cvt_pk_bf16(float lo, float hi) { unsigned r; asm volatile("v_cvt_pk_bf16_f32 %0, %1, %2" : "=v"(r) : "v"(lo), "v"(hi)); return r; }
__device__ __forceinline__ f32x2 gelu_pk(f32x2 v) {
    const f32x2 av = __builtin_elementwise_abs(v), d = av * 0.2316418882f + 1.0f;
    f32x2 t; t.x = __builtin_amdgcn_rcpf(d.x); t.y = __builtin_amdgcn_rcpf(d.y);
    f32x2 q = t * 0.5307027145f + (-0.7265760135f); q = q * t + 0.7107068705f; q = q * t + (-0.142248368f); q = q * t + 0.127414796f; q = q * t;
    const f32x2 s = (v * v) * (-0.72134752044f);
    f32x2 e; e.x = __builtin_amdgcn_exp2f(s.x); e.y = __builtin_amdgcn_exp2f(s.y);
    const f32x2 m = v * (q * e), r = v - m;
    f32x2 o; o.x = v.x < 0.f ? m.x : r.x; o.y = v.y < 0.f ? m.y : r.y; return o;
}
__device__ __forceinline__ float gelu1(float v) { return gelu_pk((f32x2){v, v}).x; }

struct EpiProj {
    static constexpr bool PERM = true;
    bf16_t* O;
    __device__ __forceinline__ void operator()(const f32x4 (&acc)[2][2][4][2], const Unit& u, int wr, int wc, int fr, int fq) const {
        const int row0 = u.pm * BM + wr * 64 + fr, col0 = u.pn * BM + wc * 32 + 8 * fq; const float sc = (u.pn < 2) ? QSCALE : 1.0f;
#pragma unroll
        for (int ai = 0; ai < 2; ++ai)
#pragma unroll
            for (int m = 0; m < 4; ++m) { bf16_t* rowp = O + (size_t)(row0 + ai * HALF + m * 16) * INW + col0;
#pragma unroll
                for (int bj = 0; bj < 2; ++bj) { const f32x4 v0 = acc[ai][bj][m][0] * sc, v1 = acc[ai][bj][m][1] * sc;
                    u32x4 w; w.x = cvt_pk_bf16(v0[0], v0[1]); w.y = cvt_pk_bf16(v0[2], v0[3]); w.z = cvt_pk_bf16(v1[0], v1[1]); w.w = cvt_pk_bf16(v1[2], v1[3]);
                    *(u32x4*)(rowp + bj * HALF) = w; } }
    }
};
struct EpiH1 {
    static constexpr bool PERM = false;
    const float* X; float* C;
    __device__ __forceinline__ void operator()(const f32x4 (&acc)[2][2][4][2], const Unit& u, int wr, int wc, int fr, int fq) const {
        const int row0 = u.pm * BM + wr * 64 + fr, col0 = u.pn * BM + wc * 32 + 4 * fq;
#pragma unroll
        for (int ai = 0; ai < 2; ++ai)
#pragma unroll
            for (int m = 0; m < 4; ++m) { const size_t off = (size_t)(row0 + ai * HALF + m * 16) * DM + col0;
#pragma unroll
                for (int bj = 0; bj < 2; ++bj)
#pragma unroll
                    for (int n = 0; n < 2; ++n) { const f32x4 xv = *(const f32x4*)(X + off + bj * HALF + n * 16); *(f32x4*)(C + off + bj * HALF + n * 16) = xv * ALPHA + acc[ai][bj][m][n]; } }
    }
};
struct EpiSwiglu {
    static constexpr bool PERM = true;
    bf16_t* O; const float* bias;
    __device__ __forceinline__ void operator()(const f32x4 (&acc)[2][2][4][2], const Unit& u, int wr, int wc, int fr, int fq) const {
        const int row0 = u.pm * BM + wr * 64 + fr, col0 = u.pn * HALF + wc * 32 + 8 * fq;
        const float* bp = bias + (size_t)u.e * (2 * DFF) + col0;
        f32x4 bg[2], bl[2];
#pragma unroll
        for (int n = 0; n < 2; ++n) { bg[n] = *(const f32x4*)(bp + 4 * n); bl[n] = *(const f32x4*)(bp + DFF + 4 * n); }
#pragma unroll
        for (int ai = 0; ai < 2; ++ai)
#pragma unroll
            for (int m = 0; m < 4; ++m) { float a8[8];
#pragma unroll
                for (int n = 0; n < 2; ++n) { const f32x4 g4 = acc[ai][0][m][n] + bg[n], l4 = acc[ai][1][m][n] + bl[n];
#pragma unroll
                    for (int j = 0; j < 4; ++j) { const float g = fminf(g4[j], 7.0f), l = fminf(fmaxf(l4[j], -7.0f), 7.0f);
                        const float sg = __builtin_amdgcn_rcpf(1.0f + __builtin_amdgcn_exp2f(g * (-1.702f * 1.4426950408889634f)));
                        a8[4 * n + j] = (l + 1.0f) * g * sg; } }
                u32x4 w; w.x = cvt_pk_bf16(a8[0], a8[1]); w.y = cvt_pk_bf16(a8[2], a8[3]); w.z = cvt_pk_bf16(a8[4], a8[5]); w.w = cvt_pk_bf16(a8[6], a8[7]);
                *(u32x4*)(O + (size_t)(row0 + ai * HALF + m * 16) * DFF + col0) = w; }
    }
};
struct EpiDown {
    static constexpr bool PERM = true;
    bf16_t* O; const float* bias;
    __device__ __forceinline__ void operator()(const f32x4 (&acc)[2][2][4][2], const Unit& u, int wr, int wc, int fr, int fq) const {
        const int row0 = u.pm * BM + wr * 64 + fr, col0 = u.pn * BM + wc * 32 + 8 * fq;
        const float* bp = bias + (size_t)u.e * DM + col0;
        f32x4 bv[2][2];
#pragma unroll
        for (int bj = 0; bj < 2; ++bj)
#pragma unroll
            for (int n = 0; n < 2; ++n) bv[bj][n] = *(const f32x4*)(bp + bj * HALF + 4 * n);
#pragma unroll
        for (int ai = 0; ai < 2; ++ai)
#pragma unroll
            for (int m = 0; m < 4; ++m) { bf16_t* rowp = O + (size_t)(row0 + ai * HALF + m * 16) * DM + col0;
#pragma unroll
                for (int bj = 0; bj < 2; ++bj) { const f32x4 v0 = acc[ai][bj][m][0] + bv[bj][0], v1 = acc[ai][bj][m][1] + bv[bj][1];
                    u32x4 w; w.x = cvt_pk_bf16(v0[0], v0[1]); w.y = cvt_pk_bf16(v0[2], v0[3]); w.z = cvt_pk_bf16(v1[0], v1[1]); w.w = cvt_pk_bf16(v1[2], v1[3]);
                    *(u32x4*)(rowp + bj * HALF) = w; } }
    }
};

__device__ __forceinline__ unsigned pk4_fp8(float a, float b, float c, float d) { int w = 0; w = __builtin_amdgcn_cvt_pk_fp8_f32(a, b, w, false); w = __builtin_amdgcn_cvt_pk_fp8_f32(c, d, w, true); return (unsigned)w; }
typedef unsigned u32x2 __attribute__((ext_vector_type(2)));
struct EpiSwiglu8 {
    static constexpr bool PERM = true;
    unsigned char* O; const float* bias;
    __device__ __forceinline__ void operator()(const f32x4 (&acc)[2][2][4][2], const Unit& u, int wr, int wc, int fr, int fq) const {
        const int row0 = u.pm * BM + wr * 64 + fr, col0 = u.pn * HALF + wc * 32 + 8 * fq;
        const float* bp = bias + (size_t)u.e * (2 * DFF) + col0;
        f32x4 bg[2], bl[2];
#pragma unroll
        for (int n = 0; n < 2; ++n) { bg[n] = *(const f32x4*)(bp + 4 * n); bl[n] = *(const f32x4*)(bp + DFF + 4 * n); }
#pragma unroll
        for (int ai = 0; ai < 2; ++ai)
#pragma unroll
            for (int m = 0; m < 4; ++m) { float a8[8];
#pragma unroll
                for (int n = 0; n < 2; ++n) { const f32x4 g4 = acc[ai][0][m][n] + bg[n], l4 = acc[ai][1][m][n] + bl[n];
#pragma unroll
                    for (int j = 0; j < 4; ++j) { const float g = fminf(g4[j], 7.0f), l = fminf(fmaxf(l4[j], -7.0f), 7.0f);
                        const float sg = __builtin_amdgcn_rcpf(1.0f + __builtin_amdgcn_exp2f(g * (-1.702f * 1.4426950408889634f)));
                        a8[4 * n + j] = (l + 1.0f) * g * sg; } }
                u32x2 w; w.x = pk4_fp8(a8[0], a8[1], a8[2], a8[3]); w.y = pk4_fp8(a8[4], a8[5], a8[6], a8[7]);
                *(u32x2*)(O + (size_t)(row0 + ai * HALF + m * 16) * DFF + col0) = w; }
    }
};

template <class Epi, class Sched, bool GATHER, bool FP8 = false>
__device__ __forceinline__ void gemm_phase(PG8_LAS unsigned char* lds, const Gemm g, const Sched& S, const Epi& E) {
    int tid_ = threadIdx.x; asm volatile("" : "+v"(tid_));
    const int tid = tid_, wid = __builtin_amdgcn_readfirstlane(tid >> 6), lane = tid & 63, wr = wid >> 2, wc = wid & 3, fr = lane & 15, fq = lane >> 4;
    const int K = FP8 ? g.K / 2 : g.K, nt = K / BK;
    unsigned voffB[2]; int RA[2], CA2[2]; unsigned voffA[2];
#pragma unroll
    for (int i = 0; i < 2; ++i) { int R, C; stage_rc(tid * 16 + i * 8192, R, C); const int Rb = Epi::PERM ? ((R & ~31) + perm32(R & 31)) : R;
        voffA[i] = (unsigned)(R * K + C) * 2u; voffB[i] = (unsigned)(Rb * K + C) * 2u; RA[i] = R; CA2[i] = C * 2; }
    const size_t kstep = (size_t)(BK * 2);
    const size_t hstep = (size_t)HALF * K * 2;
    const size_t tstep = 2 * hstep;
    const unsigned ldsw = (unsigned)wid * 1024u;
    const int aoff = lds_byte(wr * 64 + fr, fq * 8), boff = lds_byte(wc * 32 + fr, fq * 8);
    const unsigned lds0 = (unsigned)(uintptr_t)lds;
#define PG8_SA(b, h) (((b) * 2 + (h)) * HTB)
#define PG8_SB(b, h) ((4 + (b) * 2 + (h)) * HTB)
#define PG8_GLDS(sbase, voff, ldsoff) do { unsigned keep_; asm volatile("s_mov_b32 %0, m0\n\ts_mov_b32 m0, %3\n\ts_nop 0\n\tglobal_load_lds_dwordx4 %1, %2\n\ts_mov_b32 m0, %0" \
        : "=&s"(keep_) : "v"(voff), "s"(sbase), "s"((unsigned)__builtin_amdgcn_readfirstlane((int)(lds0 + (unsigned)(ldsoff)))) : "memory"); } while (0)
#define PG8_STAGE_B(bufoff, gbase) do { PG8_GLDS((const char*)(gbase), voffB[0], (bufoff) + ldsw); PG8_GLDS((const char*)(gbase), voffB[1], (bufoff) + ldsw + 8192); } while (0)
#define PG8_STAGE_A(bufoff, gbase, o0, o1) do { PG8_GLDS((const char*)(gbase), (o0), (bufoff) + ldsw); PG8_GLDS((const char*)(gbase), (o1), (bufoff) + ldsw + 8192); } while (0)
#define PG8_LDA(dst, b, h) do { _Pragma("unroll") for (int m = 0; m < 4; ++m) _Pragma("unroll") for (int k = 0; k < 2; ++k) dst[m][k] = *(const PG8_LAS bf16x8*)(lds + PG8_SA(b, h) + aoff + m * 2048 + k * 1024); } while (0)
#define PG8_LDB(dst, b, h) do { _Pragma("unroll") for (int n = 0; n < 2; ++n) _Pragma("unroll") for (int k = 0; k < 2; ++k) dst[n][k] = *(const PG8_LAS bf16x8*)(lds + PG8_SB(b, h) + boff + n * 2048 + k * 1024); } while (0)
#define PG8_LD8(p) __builtin_shufflevector(*(const PG8_LAS v4i_t*)(p), *(const PG8_LAS v4i_t*)((p) + 1024), 0, 1, 2, 3, 4, 5, 6, 7)
#define PG8_LDA8(dst, b, h) do { _Pragma("unroll") for (int m = 0; m < 4; ++m) dst[m] = PG8_LD8(lds + PG8_SA(b, h) + aoff + m * 2048); } while (0)
#define PG8_LDB8(dst, b, h) do { _Pragma("unroll") for (int n = 0; n < 2; ++n) dst[n] = PG8_LD8(lds + PG8_SB(b, h) + boff + n * 2048); } while (0)
#define PG8_MMA(ai, bj, At, Bt) do { __builtin_amdgcn_s_setprio(1); \
        if constexpr (FP8) { _Pragma("unroll") for (int m = 0; m < 4; ++m) _Pragma("unroll") for (int n = 0; n < 2; ++n) \
            acc[ai][bj][m][n] = __builtin_amdgcn_mfma_scale_f32_16x16x128_f8f6f4(Bt##8[n], At##8[m], acc[ai][bj][m][n], 0, 0, 0, WSCALE_E8M0, 0, 0x7f7f7f7f); \
              \
            _Pragma("unroll") for (int m = 0; m < 4; ++m) _Pragma("unroll") for (int n = 0; n < 2; ++n) asm volatile("" : "+v"(acc[ai][bj][m][n])); } \
        else { _Pragma("unroll") for (int m = 0; m < 4; ++m) _Pragma("unroll") for (int n = 0; n < 2; ++n) _Pragma("unroll") for (int k = 0; k < 2; ++k) \
            acc[ai][bj][m][n] = __builtin_amdgcn_mfma_f32_16x16x32_bf16(Bt[n][k], At[m][k], acc[ai][bj][m][n], 0, 0, 0); } \
        __builtin_amdgcn_s_setprio(0); } while (0)
#define PG8_XLDA(dst, b, h) do { if constexpr (FP8) PG8_LDA8(dst##8, b, h); else PG8_LDA(dst, b, h); } while (0)
#define PG8_XLDB(dst, b, h) do { if constexpr (FP8) PG8_LDB8(dst##8, b, h); else PG8_LDB(dst, b, h); } while (0)
#define PG8_WAIT_V(n) asm volatile("s_waitcnt vmcnt(" #n ")" ::: "memory")
#define PG8_WAIT_L(n) asm volatile("s_waitcnt lgkmcnt(" #n ")" ::: "memory")
#define PG8_BAR __builtin_amdgcn_s_barrier()
#define PG8_SCHED __builtin_amdgcn_sched_barrier(0)
    Unit cur, nxt; int ui = 0;
    if (!S.next(0, cur)) return;
    f32x4 acc[2][2][4][2];
#pragma unroll
    for (int a = 0; a < 2; ++a)
#pragma unroll
        for (int b = 0; b < 2; ++b)
#pragma unroll
            for (int m = 0; m < 4; ++m)
#pragma unroll
                for (int n = 0; n < 2; ++n) acc[a][b][m][n] = (f32x4){0.f, 0.f, 0.f, 0.f};
    bf16x8 At[4][2], B0[2][2], B1[2][2]; v8i_t At8[4], B08[2], B18[2];
    const char* cA = GATHER ? (const char*)g.A : (const char*)g.A + (size_t)cur.pm * tstep;
    const char* cB = (const char*)g.Bt + ((size_t)cur.e * g.strideB) * 2 + (size_t)cur.pn * tstep;
    unsigned gc[2][2], gn[2][2];
    if constexpr (GATHER) { S.gather(cur, RA, CA2, gc, (unsigned)(K * 2)); }
    else {
#pragma unroll
        for (int h = 0; h < 2; ++h)
#pragma unroll
            for (int i = 0; i < 2; ++i) gc[h][i] = (unsigned)(h * hstep) + voffA[i]; }
#pragma unroll
    for (int h = 0; h < 2; ++h)
#pragma unroll
        for (int i = 0; i < 2; ++i) gn[h][i] = gc[h][i];
    PG8_STAGE_B(PG8_SB(0, 0), cB); PG8_STAGE_B(PG8_SB(0, 1), cB + hstep); PG8_STAGE_A(PG8_SA(0, 0), cA, gc[0][0], gc[0][1]); PG8_STAGE_A(PG8_SA(0, 1), cA, gc[1][0], gc[1][1]);
    if (wr == 1) PG8_BAR;
    PG8_WAIT_V(2); PG8_BAR;
    PG8_STAGE_B(PG8_SB(1, 0), cB + kstep); PG8_STAGE_A(PG8_SA(1, 0), cA + kstep, gc[0][0], gc[0][1]); PG8_STAGE_B(PG8_SB(1, 1), cB + hstep + kstep);
    PG8_WAIT_V(6); PG8_BAR;
    for (;;) {
        const bool has_next = S.next(ui + 1, nxt);
        const char* nA = GATHER ? cA : (has_next ? (const char*)g.A + (size_t)nxt.pm * tstep : cA);
        const char* nB = has_next ? (const char*)g.Bt + ((size_t)nxt.e * g.strideB) * 2 + (size_t)nxt.pn * tstep : cB;
        if constexpr (GATHER) { if (has_next) S.gather(nxt, RA, CA2, gn, (unsigned)(K * 2)); }
        for (int t = 0; t < nt; t += 2) {
            const bool last = (t == nt - 2);
            const char* a1 = cA + (size_t)(t + 1) * kstep;
            const char* a2 = last ? nA : cA + (size_t)(t + 2) * kstep; const char* b2 = last ? nB : cB + (size_t)(t + 2) * kstep;
            const char* a3 = a2 + kstep; const char* b3 = b2 + kstep;
            unsigned o00 = gc[0][0], o01 = gc[0][1], o10 = gc[1][0], o11 = gc[1][1];
            if constexpr (GATHER) { if (last) { o00 = gn[0][0]; o01 = gn[0][1]; o10 = gn[1][0]; o11 = gn[1][1]; } }
            PG8_XLDB(B0, 0, 0); PG8_XLDB(B1, 0, 1); PG8_SCHED; PG8_XLDA(At, 0, 0); PG8_STAGE_A(PG8_SA(1, 1), a1, gc[1][0], gc[1][1]);
            PG8_WAIT_V(8); PG8_WAIT_L(0); PG8_BAR; PG8_MMA(0, 0, At, B0); PG8_MMA(0, 1, At, B1); PG8_BAR; PG8_SCHED;
            PG8_XLDA(At, 0, 1); PG8_STAGE_B(PG8_SB(0, 0), b2); PG8_STAGE_B(PG8_SB(0, 1), b2 + hstep); PG8_STAGE_A(PG8_SA(0, 0), a2, o00, o01);
            PG8_WAIT_V(8); PG8_WAIT_L(0); PG8_BAR; PG8_MMA(1, 0, At, B0); PG8_MMA(1, 1, At, B1); PG8_BAR; PG8_SCHED;
            PG8_XLDB(B0, 1, 0); PG8_XLDB(B1, 1, 1); PG8_SCHED; PG8_XLDA(At, 1, 0); PG8_STAGE_A(PG8_SA(0, 1), a2, o10, o11);
            PG8_WAIT_V(8); PG8_WAIT_L(0); PG8_BAR; PG8_MMA(0, 0, At, B0); PG8_MMA(0, 1, At, B1); PG8_BAR; PG8_SCHED;
            PG8_XLDA(At, 1, 1); PG8_STAGE_B(PG8_SB(1, 0), b3); PG8_STAGE_B(PG8_SB(1, 1), b3 + hstep); PG8_STAGE_A(PG8_SA(1, 0), a3, o00, o01);
            PG8_WAIT_V(8); PG8_WAIT_L(0); PG8_BAR; PG8_MMA(1, 0, At, B0); PG8_MMA(1, 1, At, B1); PG8_BAR; PG8_SCHED;
        }
        if (wr == 0) PG8_BAR;
        { int fr_ = fr, fq_ = fq; asm volatile("" : "+v"(fr_), "+v"(fq_));
          E(acc, cur, wr, wc, fr_, fq_); }
        if (!has_next) break;
#pragma unroll
        for (int a = 0; a < 2; ++a)
#pragma unroll
            for (int b = 0; b < 2; ++b)
#pragma unroll
                for (int m = 0; m < 4; ++m)
#pragma unroll
                    for (int n = 0; n < 2; ++n) acc[a][b][m][n] = (f32x4){0.f, 0.f, 0.f, 0.f};
        cur = nxt; cA = nA; cB = nB; ++ui;
#pragma unroll
        for (int h = 0; h < 2; ++h)
#pragma unroll
            for (int i = 0; i < 2; ++i) gc[h][i] = gn[h][i];
        if (wr == 1) PG8_BAR;
    }
    PG8_WAIT_V(0);
    PG8_BAR;
#undef PG8_SA
#undef PG8_SB
#undef PG8_GLDS
#undef PG8_STAGE_A
#undef PG8_STAGE_B
#undef PG8_LDA
#undef PG8_LDB
#undef PG8_MMA
#undef PG8_LD8
#undef PG8_LDA8
#undef PG8_LDB8
#undef PG8_XLDA
#undef PG8_XLDB
#undef PG8_WAIT_V
#undef PG8_WAIT_L
#undef PG8_BAR
#undef PG8_SCHED
}
}

namespace attn_body {
using bf16=__hip_bfloat16;
using bf16x8=__attribute__((ext_vector_type(8)))short;
using s16x4=__attribute__((ext_vector_type(4)))short;
using f32x16=__attribute__((ext_vector_type(16)))float;
using u32x4=__attribute__((ext_vector_type(4)))unsigned;
constexpr int D=64,PQ=INW,PO=DM;
constexpr int NW=8,QBLK=32,QB=QBLK*NW,KVBLK=64,NQB=SEQ/QB;
constexpr int ATTN_UNIT_ROWS=QB;
__device__ __forceinline__ int crow(int r,int hi){return (r&3)+8*(r>>2)+4*hi;}
#define SBAR() __builtin_amdgcn_sched_barrier(0)
__device__ __forceinline__ void cmask(f32x16&p0,f32x16&p1,int jb,int qrel,int hi){
  const float NEG=-INFINITY; int kb=64*jb+4*hi;
  #pragma unroll
  for(int r=0;r<16;++r){int kv=kb+(r&3)+8*(r>>2); if(kv>qrel)p0[r]=NEG; if(kv+32>qrel)p1[r]=NEG;}
}

constexpr int NSLOT=3, SLOTB=8192;
constexpr int LDS_K=0, LDS_V=NSLOT*SLOTB, LDS_WS=2*NSLOT*SLOTB, LDS_OST=LDS_WS+NW*64*4, LDS_BYTES=LDS_OST+NW*4096;
constexpr float C2=0.125f*1.4426950408889634f;
__device__ __forceinline__ void glds16(const void*gsrc,unsigned lds_dst){unsigned keep;
  asm volatile("s_mov_b32 %0, m0\n\ts_mov_b32 m0, %2\n\ts_nop 0\n\tglobal_load_lds_dwordx4 %1, off\n\ts_mov_b32 m0, %0":"=&s"(keep):"v"(gsrc),"s"(lds_dst):"memory");}
__device__ __forceinline__ float max3f(float a,float b,float c){float r;asm("v_max3_f32 %0, %1, %2, %3":"=v"(r):"v"(a),"v"(b),"v"(c));return r;}
__device__ __forceinline__ float max2f(float a,float b){float r;asm("v_max_f32_e32 %0, %1, %2":"=v"(r):"v"(a),"v"(b));return r;}
__device__ __forceinline__ float fadd_s(float a,float b){float r;asm("v_add_f32_e32 %0, %1, %2":"=v"(r):"v"(a),"v"(b));return r;}
__device__ __forceinline__ float fsub_s(float a,float b){float r;asm("v_sub_f32_e32 %0, %1, %2":"=v"(r):"v"(a),"v"(b));return r;}
typedef float f32x2_t __attribute__((ext_vector_type(2))); typedef __bf16 bf16x2_t __attribute__((ext_vector_type(2)));
__device__ __forceinline__ unsigned cvtpk_s(float lo,float hi){f32x2_t v={lo,hi};bf16x2_t b=__builtin_convertvector(v,bf16x2_t);return __builtin_bit_cast(unsigned,b);}
#define WAIT_BAR(N) asm volatile("s_waitcnt vmcnt(" #N ") lgkmcnt(0)\n\ts_barrier":::"memory")

__device__ __forceinline__ void qkt(f32x16&p0,f32x16&p1,const char*Kslot,const bf16x8*qr,const f32x16&negm,int r32,int hi){
  const char*kb=Kslot+hi*1024+r32*16;
  #pragma unroll
  for(int d0=0;d0<4;++d0){
    const bf16x8 b0=*reinterpret_cast<const bf16x8*>(kb+d0*2048);
    const bf16x8 b1=*reinterpret_cast<const bf16x8*>(kb+d0*2048+512);
    if(d0==0){p0=__builtin_amdgcn_mfma_f32_32x32x16_bf16(b0,qr[0],negm,0,0,0);p1=__builtin_amdgcn_mfma_f32_32x32x16_bf16(b1,qr[0],negm,0,0,0);}
    else{p0=__builtin_amdgcn_mfma_f32_32x32x16_bf16(b0,qr[d0],p0,0,0,0);p1=__builtin_amdgcn_mfma_f32_32x32x16_bf16(b1,qr[d0],p1,0,0,0);}}
}
typedef __attribute__((address_space(3))) const char* lds_cptr;
typedef short v4i16_t __attribute__((ext_vector_type(4)));
__device__ __forceinline__ void kload8(bf16x8*kf,lds_cptr kp){
  kf[0]=*(const __attribute__((address_space(3))) bf16x8*)(kp);      kf[1]=*(const __attribute__((address_space(3))) bf16x8*)(kp+512);
  kf[2]=*(const __attribute__((address_space(3))) bf16x8*)(kp+2048); kf[3]=*(const __attribute__((address_space(3))) bf16x8*)(kp+2560);
  kf[4]=*(const __attribute__((address_space(3))) bf16x8*)(kp+4096); kf[5]=*(const __attribute__((address_space(3))) bf16x8*)(kp+4608);
  kf[6]=*(const __attribute__((address_space(3))) bf16x8*)(kp+6144); kf[7]=*(const __attribute__((address_space(3))) bf16x8*)(kp+6656);
}
__device__ __forceinline__ void kload2(bf16x8*kf,lds_cptr kp,int j){ kf[2*j]=*(const __attribute__((address_space(3))) bf16x8*)(kp+j*2048); kf[2*j+1]=*(const __attribute__((address_space(3))) bf16x8*)(kp+j*2048+512); }
__device__ __forceinline__ s16x4 vtr(lds_cptr p){ return __builtin_bit_cast(s16x4,__builtin_amdgcn_ds_read_tr16_b64_v4i16((__attribute__((address_space(3))) v4i16_t*)p)); }
__device__ __forceinline__ float rowmax(const f32x16&p0,const f32x16&p1){
  float a=max3f(p0[0],p0[1],p1[0]),b=max3f(p0[2],p0[3],p1[1]);a=max3f(a,p1[2],p1[3]);
  #pragma unroll
  for(int r=4;r<16;r+=4){a=max3f(a,p0[r],p0[r+1]);b=max3f(b,p0[r+2],p0[r+3]);a=max3f(a,p1[r],p1[r+1]);b=max3f(b,p1[r+2],p1[r+3]);}
  const float m=max2f(a,b);
  auto rr=__builtin_amdgcn_permlane32_swap(__float_as_uint(m),__float_as_uint(m),false,false);
  return max2f(__uint_as_float(rr[0]),__uint_as_float(rr[1]));
}
__device__ __forceinline__ void pv(f32x16*o,int vb,bf16x8 pa0,bf16x8 pa1,bf16x8 pa2,bf16x8 pa3){
  #pragma unroll
  for(int d0=0;d0<2;++d0){s16x4 lo[4],hi[4];
    #pragma unroll
    for(int ks=0;ks<4;++ks){
      asm volatile("ds_read_b64_tr_b16 %0,%1 offset:%c2":"=&v"(lo[ks]):"v"(vb),"i"(d0*4096+ks*1024):"memory");
      asm volatile("ds_read_b64_tr_b16 %0,%1 offset:%c2":"=&v"(hi[ks]):"v"(vb),"i"(d0*4096+ks*1024+512):"memory");}
    asm volatile("s_waitcnt lgkmcnt(0)":::"memory");SBAR();
    #define PK(k) (bf16x8){lo[k][0],lo[k][1],lo[k][2],lo[k][3],hi[k][0],hi[k][1],hi[k][2],hi[k][3]}
    o[d0]=__builtin_amdgcn_mfma_f32_32x32x16_bf16(pa0,PK(0),o[d0],0,0,0);
    o[d0]=__builtin_amdgcn_mfma_f32_32x32x16_bf16(pa1,PK(1),o[d0],0,0,0);
    o[d0]=__builtin_amdgcn_mfma_f32_32x32x16_bf16(pa2,PK(2),o[d0],0,0,0);
    o[d0]=__builtin_amdgcn_mfma_f32_32x32x16_bf16(pa3,PK(3),o[d0],0,0,0);
    #undef PK
  }
}

#ifndef ATTN_STORE16
#define ATTN_STORE16(p,v) (*(u32x4*)(p)=(v))
#endif
template<int THRL> __device__ __forceinline__ void attn_unit(int qb,const bf16*Qb,const bf16*__restrict__ Kb,const bf16*__restrict__ Vb,bf16*Ob,char*shm){
  int tid_=threadIdx.x; asm volatile("":"+v"(tid_));
  const int tid=tid_,lane=tid&63,r32=lane&31,hi=lane>>5; const int wid=__builtin_amdgcn_readfirstlane(tid>>6);
  const int q0=qb*QB;
  const bf16*Qw=Qb+(long)(q0+wid*QBLK)*PQ;
  const bf16*Kh=Kb,*Vh=Vb;
  const unsigned lds0=(unsigned)(uintptr_t)shm;
  float*wsf=(float*)(shm+LDS_WS)+wid*64;
  const bf16*ksrc=Kh+(long)lane*PQ+wid*8;
  const bf16*vsrc=Vh+(long)(16*(wid&3)+(lane>>2))*PQ+(wid>>2)*32+(lane&3)*8;
  const unsigned kdst=lds0+LDS_K+wid*1024, vdst=lds0+LDS_V+wid*1024;
  #define DMA_K(t,slot) glds16(ksrc+(long)(t)*KVBLK*PQ,(unsigned)__builtin_amdgcn_readfirstlane(kdst+(slot)))
  #define DMA_V(t,slot) glds16(vsrc+(long)(t)*KVBLK*PQ,(unsigned)__builtin_amdgcn_readfirstlane(vdst+(slot)))
  const int vb0=(int)(lds0+LDS_V)+((lane>>4)&1)*32+(lane&3)*8+(4*hi+((lane&15)>>2))*64;
  const char*Kbase=shm+LDS_K; bf16x8 kf[8];
  const lds_cptr shm3=(lds_cptr)shm; const lds_cptr kp0=shm3+LDS_K+hi*1024+r32*16; const lds_cptr vp0=shm3+LDS_V+((lane>>4)&1)*32+(lane&3)*8+(4*hi+((lane&15)>>2))*64;
  const int NT=(q0+QB)/KVBLK;
  DMA_K(0,0);DMA_V(0,0);DMA_K(1,SLOTB);
  bf16x8 qr[4];
  #pragma unroll
  for(int d0=0;d0<4;++d0)qr[d0]=*reinterpret_cast<const bf16x8*>(&Qw[(long)r32*PQ+d0*16+hi*8]);
  float mhat=0.f,l_reg=0.f;f32x16 o[2];o[0]=f32x16{};o[1]=f32x16{};f32x16 negm=f32x16{};asm volatile("":"+v"(negm));
  const int qrel=wid*QBLK+r32;
  #define CMASK(P0,P1,t) do{int jb_=(t)-(NT-4); if(jb_>=0)cmask(P0,P1,jb_,qrel,hi);}while(0)
  bool resc=false;
  #define START(P0,P1) do{ const float rm=rowmax(P0,P1); resc=false; \
    { const float dl=rm; mhat=fadd_s(mhat,dl); \
      _Pragma("unroll") for(int r=0;r<16;++r){P0[r]=fsub_s(P0[r],dl);P1[r]=fsub_s(P1[r],dl);} \
      _Pragma("unroll") for(int r=0;r<16;++r)negm[r]=-mhat; asm volatile("":"+v"(negm)); } \
    _Pragma("unroll") for(int r=0;r<16;++r)P0[r]=__builtin_amdgcn_exp2f(P0[r]); }while(0)
  #define RESC() do{ if(resc){ asm volatile("s_waitcnt lgkmcnt(0)":::"memory"); \
      _Pragma("unroll") for(int d_=0;d_<2;++d_) _Pragma("unroll") for(int r=0;r<16;++r)o[d_][r]*=wsf[crow(r,hi)]; } }while(0)
  f32x16 pA0,pA1,pB0,pB1;
  int sl_prev=0,sl_cur=0,sl_next=SLOTB;
  #define ROT() do{sl_prev=sl_cur;sl_cur=sl_next;sl_next=(sl_next==(NSLOT-1)*SLOTB)?0:sl_next+SLOTB;}while(0)
  DMA_K(2,2*SLOTB);
  WAIT_BAR(3);
  qkt(pA0,pA1,Kbase,qr,negm,r32,hi);asm volatile("s_nop 15\n\ts_nop 7":"+v"(pA0),"+v"(pA1));CMASK(pA0,pA1,0);
  START(pA0,pA1);
  _Pragma("unroll") for(int r=0;r<16;++r)pA1[r]=__builtin_amdgcn_exp2f(pA1[r]);
  WAIT_BAR(0);
  DMA_K(3,0);DMA_V(1,SLOTB);
  ROT();
  kload8(kf,kp0+sl_cur);
  WAIT_BAR(2);
  s16x4 vlo[8],vhi[8]; u32x4 pw0,pw1,pw2,pw3;
  #define PKW(P,B) cvtpk_s(P[B],P[B+1])
  #define PAF(k) __builtin_bit_cast(bf16x8,pw##k)
  #define VFR(i) (bf16x8){vlo[i][0],vlo[i][1],vlo[i][2],vlo[i][3],vhi[i][0],vhi[i][1],vhi[i][2],vhi[i][3]}
  #define PIN(x) asm volatile("":"+v"(x))
  #define MX3(a,b,c) __builtin_fmaxf(__builtin_fmaxf((a),(b)),(c))
  #define GAPA(MF,A0,A1,A2,A3,W0,W1,PW) do{ MF; sacc+=A0; sacc+=A1; sacc+=A2; sacc+=A3; PIN(sacc); W0; W1; PIN(PW); SBAR(); }while(0)
  #define EX(v) __builtin_amdgcn_exp2f(v)
  #define GAPB(MF,X,B) do{ MF; X[B]=EX(X[B]); X[B+1]=EX(X[B+1]); X[B+2]=EX(X[B+2]); X[B+3]=EX(X[B+3]); PIN(X); SBAR(); }while(0)
  #define VRD(i) do{ vlo[i]=vtr(vp_+(((i)>>2)*4096+((i)&3)*1024)); vhi[i]=vtr(vp_+(((i)>>2)*4096+((i)&3)*1024+512)); }while(0)
  #define KRD(G,j) do{ if(G){ kload2(kf,kp0+sl_next,j); SBAR(); } }while(0)
  #define STEP(C0,C1,P0,P1,t,GK,GV,GL) do{ SBAR(); \
    const lds_cptr vp_=vp0+sl_prev; \
    VRD(0); SBAR(); float sacc=(P0[0]+P0[1]); \
    GAPA(C0=__builtin_amdgcn_mfma_f32_32x32x16_bf16(kf[0],qr[0],negm,0,0,0), P0[2],P0[3],P0[4],P0[5],     pw0[0]=PKW(P0,0), pw0[1]=PKW(P0,2), pw0); \
    VRD(4); SBAR(); GAPA(C1=__builtin_amdgcn_mfma_f32_32x32x16_bf16(kf[1],qr[0],negm,0,0,0), P0[6],P0[7],P0[8],P0[9],     pw0[2]=PKW(P0,4), pw0[3]=PKW(P0,6), pw0); \
    VRD(1); SBAR(); GAPA(C0=__builtin_amdgcn_mfma_f32_32x32x16_bf16(kf[2],qr[1],C0,0,0,0),   P0[10],P0[11],P0[12],P0[13], pw1[0]=PKW(P0,8), pw1[1]=PKW(P0,10), pw1); \
    VRD(5); SBAR(); GAPA(C1=__builtin_amdgcn_mfma_f32_32x32x16_bf16(kf[3],qr[1],C1,0,0,0),   P0[14],P0[15],P1[0],P1[1],   pw1[2]=PKW(P0,12),pw1[3]=PKW(P0,14), pw1); \
    VRD(2); SBAR(); GAPA(C0=__builtin_amdgcn_mfma_f32_32x32x16_bf16(kf[4],qr[2],C0,0,0,0),   P1[2],P1[3],P1[4],P1[5],     pw2[0]=PKW(P1,0), pw2[1]=PKW(P1,2), pw2); \
    VRD(6); SBAR(); GAPA(C1=__builtin_amdgcn_mfma_f32_32x32x16_bf16(kf[5],qr[2],C1,0,0,0),   P1[6],P1[7],P1[8],P1[9],     pw2[2]=PKW(P1,4), pw2[3]=PKW(P1,6), pw2); \
    VRD(3); SBAR(); GAPA(C0=__builtin_amdgcn_mfma_f32_32x32x16_bf16(kf[6],qr[3],C0,0,0,0),   P1[10],P1[11],P1[12],P1[13], pw3[0]=PKW(P1,8), pw3[1]=PKW(P1,10), pw3); \
    VRD(7); SBAR(); GAPA(C1=__builtin_amdgcn_mfma_f32_32x32x16_bf16(kf[7],qr[3],C1,0,0,0),   P1[14],P1[15],0.f,0.f,       pw3[2]=PKW(P1,12),pw3[3]=PKW(P1,14), pw3); \
    l_reg+=sacc; \
    if(GK){DMA_K((t)+3,sl_cur);} if(GV){DMA_V((t)+1,sl_next);} \
    CMASK(C0,C1,t); \
    { float a=MX3(C0[0],C0[1],C1[0]),b=MX3(C0[2],C0[3],C1[1]); a=MX3(a,C1[2],C1[3]); \
      _Pragma("unroll") for(int r=4;r<16;r+=4){a=MX3(a,C0[r],C0[r+1]);b=MX3(b,C0[r+2],C0[r+3]);a=MX3(a,C1[r],C1[r+1]);b=MX3(b,C1[r+2],C1[r+3]);} \
      float rm=__builtin_fmaxf(a,b); { auto rr=__builtin_amdgcn_permlane32_swap(__float_as_uint(rm),__float_as_uint(rm),false,false); rm=__builtin_fmaxf(__uint_as_float(rr[0]),__uint_as_float(rr[1])); } \
      resc=false; \
      if(__builtin_expect(__any(rm>(float)THRL),0)){ const float dl=__builtin_fmaxf(rm,0.f); mhat+=dl; \
        _Pragma("unroll") for(int r=0;r<16;++r){C0[r]-=dl;C1[r]-=dl;} \
        _Pragma("unroll") for(int r=0;r<16;++r)negm[r]=-mhat; asm volatile("":"+v"(negm)); \
        const float f=__builtin_amdgcn_exp2f(-dl); l_reg*=f; if(hi==0)wsf[r32]=f; resc=true; } } \
    SBAR(); \
    GAPB(o[0]=__builtin_amdgcn_mfma_f32_32x32x16_bf16(PAF(0),VFR(0),o[0],0,0,0), C0,0); \
    GAPB(o[1]=__builtin_amdgcn_mfma_f32_32x32x16_bf16(PAF(0),VFR(4),o[1],0,0,0), C0,4); \
    KRD(GL,0); GAPB(o[0]=__builtin_amdgcn_mfma_f32_32x32x16_bf16(PAF(1),VFR(1),o[0],0,0,0), C0,8); \
    KRD(GL,1); GAPB(o[1]=__builtin_amdgcn_mfma_f32_32x32x16_bf16(PAF(1),VFR(5),o[1],0,0,0), C0,12); \
    KRD(GL,2); GAPB(o[0]=__builtin_amdgcn_mfma_f32_32x32x16_bf16(PAF(2),VFR(2),o[0],0,0,0), C1,0); \
    KRD(GL,3); GAPB(o[1]=__builtin_amdgcn_mfma_f32_32x32x16_bf16(PAF(2),VFR(6),o[1],0,0,0), C1,4); \
    GAPB(o[0]=__builtin_amdgcn_mfma_f32_32x32x16_bf16(PAF(3),VFR(3),o[0],0,0,0), C1,8); \
    GAPB(o[1]=__builtin_amdgcn_mfma_f32_32x32x16_bf16(PAF(3),VFR(7),o[1],0,0,0), C1,12); \
    }while(0)
  int t=1;
  #undef CMASK
  #define CMASK(P0,P1,t) do{}while(0)
  for(;t+5<NT;t+=2){
    STEP(pB0,pB1,pA0,pA1,t,true,true,true);     WAIT_BAR(2); RESC(); ROT();
    STEP(pA0,pA1,pB0,pB1,t+1,true,true,true);   WAIT_BAR(2); RESC(); ROT();
  }
  #undef CMASK
  #define CMASK(P0,P1,t) do{int jb_=(t)-(NT-4); if(jb_>=0)cmask(P0,P1,jb_,qrel,hi);}while(0)
  #define ENDW(tt) do{ if((tt)+3<NT){WAIT_BAR(2);} else if((tt)+2<NT){WAIT_BAR(1);} else {WAIT_BAR(0);} }while(0)
  for(;t+1<NT;t+=2){
    STEP(pB0,pB1,pA0,pA1,t,(t+3<NT),(t+1<NT),(t+1<NT));       ENDW(t);   RESC(); ROT();
    STEP(pA0,pA1,pB0,pB1,t+1,(t+4<NT),(t+2<NT),(t+2<NT));     ENDW(t+1); RESC(); ROT();
  }
  STEP(pB0,pB1,pA0,pA1,NT-1,false,false,false); RESC();
  { float sacc=pB0[0]+pB0[1]; _Pragma("unroll") for(int r=2;r<16;++r)sacc+=pB0[r]; _Pragma("unroll") for(int r=0;r<16;++r)sacc+=pB1[r]; l_reg+=sacc;
    pw0=(u32x4){PKW(pB0,0),PKW(pB0,2),PKW(pB0,4),PKW(pB0,6)};pw1=(u32x4){PKW(pB0,8),PKW(pB0,10),PKW(pB0,12),PKW(pB0,14)};pw2=(u32x4){PKW(pB1,0),PKW(pB1,2),PKW(pB1,4),PKW(pB1,6)};pw3=(u32x4){PKW(pB1,8),PKW(pB1,10),PKW(pB1,12),PKW(pB1,14)};
    SBAR(); pv(o,vb0+sl_cur,PAF(0),PAF(1),PAF(2),PAF(3)); }
  #undef PKW
  #undef PAF
  #undef VFR
  #undef PIN
  #undef MX3
  #undef GAPA
  #undef GAPB
  #undef EX
  #undef VRD
  #undef KRD
  #undef STEP
  #undef ENDW
  {auto rr=__builtin_amdgcn_permlane32_swap(__float_as_uint(l_reg),__float_as_uint(l_reg),false,false);l_reg=__uint_as_float(rr[0])+__uint_as_float(rr[1]);}
  if(hi==0)wsf[32+r32]=l_reg;asm volatile("s_waitcnt lgkmcnt(0)":::"memory");
  float rli[16];
  #pragma unroll
  for(int r=0;r<16;++r)rli[r]=__builtin_amdgcn_rcpf(wsf[32+crow(r,hi)]);
  bf16*Ow=Ob+(long)(q0+wid*QBLK)*PO;
  { bf16*stg=(bf16*)(shm+LDS_OST)+wid*2048;
    #pragma unroll
    for(int r=0;r<16;++r){const int orow=crow(r,hi);
      #pragma unroll
      for(int d0=0;d0<2;++d0)stg[orow*64+d0*32+r32]=__float2bfloat16(o[d0][r]*rli[r]);}
    asm volatile("s_waitcnt lgkmcnt(0)":::"memory");
    #pragma unroll
    for(int i=0;i<4;++i){const int row=i*8+(lane>>3),ch=lane&7; const u32x4 v=*(const u32x4*)(stg+row*64+ch*8); ATTN_STORE16(Ow+(long)row*PO+ch*8,v);} }
  asm volatile("s_waitcnt lgkmcnt(0)\n\ts_barrier":::"memory");
  #undef DMA_K
  #undef DMA_V
  #undef CMASK
  #undef START
  #undef RESC
  #undef ROT
}
constexpr int ATTN_LDS_BYTES=LDS_BYTES;
template<int THRL=8> __device__ __forceinline__ void attn_phase(char*lds,const bf16_t*proj,bf16_t*atto,int vcu){
  const int bh=vcu>>3,s8=vcu&7,b=bh>>2,h=bh&3;
  const bf16*P0=(const bf16*)proj+(long)b*SEQ*PQ; bf16*O0=(bf16*)atto+(long)b*SEQ*PO;
  for(int i=0;i<8;++i){ const int qb=(i<4)?(15-s8):s8, sub=i&3, st=sub>>1, vh=sub&1;
    attn_unit<THRL>(qb,P0+C_Q+st*256+h*64,P0+C_K+st*256+h*64,P0+C_V+h*128+vh*64,O0+h*256+st*128+vh*64,lds); }
}
#undef SBAR
#undef WAIT_BAR
}

constexpr int NWAVES = 8;
constexpr int RING_OFF = 0, RING_BYTES = 131072;
constexpr int LDSCTL_OFF = RING_BYTES, MISC_OFF = LDSCTL_OFF + 320;
constexpr int TAB_OFF = LDSCTL_OFF + 1024;
constexpr int REC_OFF = LDSCTL_OFF + 2048;
constexpr int LDS_BYTES = 147456;
static_assert(REC_OFF + (64 + 512) * 4 <= LDS_BYTES, "LDS map");

#define GAS __attribute__((address_space(1)))
#define LAS __attribute__((address_space(3)))
typedef unsigned v4u __attribute__((ext_vector_type(4)));
typedef unsigned v2u __attribute__((ext_vector_type(2)));
typedef float f32x4 __attribute__((ext_vector_type(4)));
typedef float f32x2 __attribute__((ext_vector_type(2)));
typedef short bf16x8 __attribute__((ext_vector_type(8)));
typedef GAS unsigned gu32;
#define RLX_AGENT __ATOMIC_RELAXED, __HIP_MEMORY_SCOPE_AGENT
#define LDS_WAIT() asm volatile("s_waitcnt lgkmcnt(0)" ::: "memory")
#define VM_WAIT() asm volatile("s_waitcnt vmcnt(0)" ::: "memory")

#define XB_TMO      128
#define XB_XCNT(j)  (256  + 64 * (j))
#define XB_XSUB(j)  (1280 + 64 * (j))
#define XB_XGEN(j)  (2304 + 64 * (j))
#define XB_TOP      3328
#define XB_TOPGEN   3392
#define XCD_BAR_WORDS 3456
#define XB_SPIN_CAP (1u << 18)
__device__ __forceinline__ unsigned xb_ld(unsigned* p)              { return __hip_atomic_load(p, __ATOMIC_RELAXED, __HIP_MEMORY_SCOPE_AGENT); }
__device__ __forceinline__ unsigned xb_add(unsigned* p, unsigned v) { return __hip_atomic_fetch_add(p, v, __ATOMIC_RELAXED, __HIP_MEMORY_SCOPE_AGENT); }
__device__ __forceinline__ unsigned xb_xcc_id() { return (unsigned)__builtin_amdgcn_s_getreg((3 << 11) | 20) & 0xFu; }
#define XB_SPIN(cond, bar) do { unsigned _sp = 0; while (cond) { __builtin_amdgcn_s_sleep(1); \
    if ((++_sp & 255u) == 0u) { if (xb_ld(&(bar)[XB_TMO])) break; if (_sp > XB_SPIN_CAP) { atomicAdd(&(bar)[XB_TMO], 1u); break; } } } } while (0)
struct XcdBarrier { unsigned* bar; unsigned x; volatile LAS unsigned* st; };
__device__ __forceinline__ XcdBarrier xcd_barrier_post(unsigned* bar, volatile LAS unsigned* st) {
    XcdBarrier b; b.bar = bar; b.x = xb_xcc_id(); b.st = st;
    if (threadIdx.x == 0) (void)xb_add(&bar[XB_XCNT(b.x)], 1u);
    return b;
}
__device__ __forceinline__ void xcd_barrier_complete(unsigned* bar, unsigned x, unsigned& nloc, unsigned& nx) {
    const unsigned G = gridDim.x * gridDim.y * gridDim.z;
    unsigned sum, cnt, mine, sp = 0u;
    for (;;) {
        sum = 0u; cnt = 0u; mine = 0u;
#pragma unroll
        for (unsigned j = 0; j < 16; ++j) { const unsigned c = xb_ld(&bar[XB_XCNT(j)]); sum += c; cnt += (c > 0u) ? 1u : 0u; mine = (j == x) ? c : mine; }
        if (sum == G) break;
        __builtin_amdgcn_s_sleep(1);
        if ((++sp & 255u) == 0u) { if (xb_ld(&bar[XB_TMO])) break; if (sp > XB_SPIN_CAP) { atomicAdd(&bar[XB_TMO], 1u); break; } }
    }
    nloc = mine > 0u ? mine : 1u; nx = cnt > 0u ? cnt : 1u;
}
__device__ __forceinline__ void xcd_barrier(const XcdBarrier& b) {
    asm volatile("s_waitcnt vmcnt(0)" ::: "memory");
    __syncthreads();
    if (threadIdx.x == 0) {
        unsigned* bar = b.bar;
        __builtin_amdgcn_s_waitcnt(0);
        unsigned nloc = b.st[0], nx = b.st[1];
        if (nloc == 0u) { xcd_barrier_complete(bar, b.x, nloc, nx); b.st[0] = nloc; b.st[1] = nx; }
        const unsigned old = xb_add(&bar[XB_XSUB(b.x)], 1u);
        const unsigned gen = old / nloc;
        if (old + 1u == (gen + 1u) * nloc) {
            __builtin_amdgcn_fence(__ATOMIC_RELEASE, "agent");
            asm volatile("s_waitcnt vmcnt(0)" ::: "memory");
            const unsigned og = xb_add(&bar[XB_TOP], 1u);
            const unsigned tg = og / nx;
            if (og + 1u == (tg + 1u) * nx) xb_add(&bar[XB_TOPGEN], 1u);
            else XB_SPIN(xb_ld(&bar[XB_TOPGEN]) == tg, bar);
            __builtin_amdgcn_fence(__ATOMIC_ACQUIRE, "agent");
            xb_add(&bar[XB_XGEN(b.x)], 1u);
            asm volatile("s_waitcnt vmcnt(0)" ::: "memory");
        } else {
            XB_SPIN(xb_ld(&bar[XB_XGEN(b.x)]) == gen, bar);
            __builtin_amdgcn_fence(__ATOMIC_ACQUIRE, "agent");
            asm volatile("s_waitcnt vmcnt(0)" ::: "memory");
        }
    }
    __syncthreads();
}

struct Args { const float* in[22]; float* out; unsigned char* ws; int ph_lo, ph_hi, pad0, pad1; };
struct Frame {
    LAS unsigned char* lds; volatile LAS unsigned* MISC; gu32* ctl;
    int tid, lane, wave, vcu, G;
};

typedef const __attribute__((address_space(4))) Args* kargs_t;
__device__ __forceinline__ Args fetch_args() {
    kargs_t kp = (kargs_t)__builtin_amdgcn_kernarg_segment_ptr();
    asm volatile("" : "+s"(kp));
    Args a;
#pragma unroll
    for (int i = 0; i < 22; ++i) a.in[i] = kp->in[i];
    a.out = kp->out; a.ws = kp->ws; a.ph_lo = kp->ph_lo; a.ph_hi = kp->ph_hi; a.pad0 = kp->pad0; a.pad1 = kp->pad1;
    return a;
}
__device__ __forceinline__ void refresh_frame(Frame& F) { int t = threadIdx.x; asm volatile("" : "+v"(t)); F.tid = t; F.lane = t & 63; F.wave = __builtin_amdgcn_readfirstlane(t >> 6); }

__device__ __forceinline__ void p0_transpose_item(const float* W, int K, int N, bf16_t* WT, long row_off, LAS float* scr, int item, int lane) {
    const int nblk = N / 32, kb = item / nblk, nb = item % nblk, k0 = 64 * kb, n0 = 32 * nb;
#pragma unroll 8
    for (int i = 0; i < 32; ++i) { const int kk = 2 * i + (lane >> 5); scr[kk * 33 + (lane & 31)] = W[(size_t)(k0 + kk) * N + n0 + (lane & 31)]; }
    LDS_WAIT(); asm volatile("" ::: "memory");
    const int c = lane & 7;
#pragma unroll
    for (int j = 0; j < 4; ++j) { const int n = (lane >> 3) + 8 * j; const LAS float* s = scr + (8 * c) * 33 + n;
        v4u o; o.x = pk2(s[0 * 33], s[1 * 33]); o.y = pk2(s[2 * 33], s[3 * 33]); o.z = pk2(s[4 * 33], s[5 * 33]); o.w = pk2(s[6 * 33], s[7 * 33]);
        *(GAS v4u*)(WT + (size_t)(row_off + n0 + n) * K + k0 + 8 * c) = o; }
    LDS_WAIT(); asm volatile("" ::: "memory");
}
__device__ __forceinline__ void p0_transpose_item8(const float* W, int K, int N, unsigned char* WT, long row_off, LAS float* scr, int item, int lane) {
    const int nblk = N / 32, kb = item / nblk, nb = item % nblk, k0 = 64 * kb, n0 = 32 * nb;
#pragma unroll 8
    for (int i = 0; i < 32; ++i) { const int kk = 2 * i + (lane >> 5); scr[kk * 33 + (lane & 31)] = W[(size_t)(k0 + kk) * N + n0 + (lane & 31)]; }
    LDS_WAIT(); asm volatile("" ::: "memory");
    const int c = lane & 3; constexpr float SC = (float)(1 << pg8::WSHIFT);
#pragma unroll
    for (int j = 0; j < 2; ++j) { const int n = (lane >> 2) + 16 * j; const LAS float* s = scr + (16 * c) * 33 + n;
        v4u o; o.x = pg8::pk4_fp8(s[0 * 33] * SC, s[1 * 33] * SC, s[2 * 33] * SC, s[3 * 33] * SC); o.y = pg8::pk4_fp8(s[4 * 33] * SC, s[5 * 33] * SC, s[6 * 33] * SC, s[7 * 33] * SC);
        o.z = pg8::pk4_fp8(s[8 * 33] * SC, s[9 * 33] * SC, s[10 * 33] * SC, s[11 * 33] * SC); o.w = pg8::pk4_fp8(s[12 * 33] * SC, s[13 * 33] * SC, s[14 * 33] * SC, s[15 * 33] * SC);
        *(GAS v4u*)(WT + (size_t)(row_off + n0 + n) * K + k0 + 16 * c) = o; }
    LDS_WAIT(); asm volatile("" ::: "memory");
}
__device__ __forceinline__ void p0_prologue(Frame& F, const Args& a) {
    LAS float* scr = (LAS float*)(F.lds + RING_OFF + F.wave * 16384);
    const int gw = F.vcu * NWAVES + F.wave, NGW = F.G * NWAVES;
    unsigned char* ws = a.ws;
    constexpr int I_IN = (DM / 64) * (INW / 32), I_O = (DM / 64) * (DM / 32), I_UP1 = (DM / 64) * (2 * DFF / 32), I_DN1 = (DFF / 64) * (DM / 32);
    constexpr int NITEMS = I_IN + I_O + NE * I_UP1 + NE * I_DN1;
    for (int it = gw; it < NITEMS; it += NGW) {
        int r = it;
        if (r < I_IN) { p0_transpose_item(a.in[1], DM, INW, (bf16_t*)(ws + WS_WIN), 0, scr, r, F.lane); continue; } r -= I_IN;
        if (r < I_O) { p0_transpose_item(a.in[11], DM, DM, (bf16_t*)(ws + WS_WO), 0, scr, r, F.lane); continue; } r -= I_O;
        if (r < NE * I_UP1) { const int e = r / I_UP1, ii = r % I_UP1; const int n0 = 32 * (ii % (2 * DFF / 32));
            const int bj = n0 / DFF, f = n0 % DFF, rho0 = 256 * (f / 128) + 128 * bj + (f % 128);
#if MOE_FP8
            p0_transpose_item8(a.in[16] + (size_t)e * DM * 2 * DFF, DM, 2 * DFF, (unsigned char*)(ws + WS_WUP) + (size_t)e * 2 * DFF * DM, (long)rho0 - n0, scr, ii, F.lane); continue; }
#else
            p0_transpose_item(a.in[16] + (size_t)e * DM * 2 * DFF, DM, 2 * DFF, (bf16_t*)(ws + WS_WUP) + (size_t)e * 2 * DFF * DM, (long)rho0 - n0, scr, ii, F.lane); continue; }
#endif
        r -= NE * I_UP1;
        { const int e = r / I_DN1, ii = r % I_DN1;
#if MOE_FP8
            p0_transpose_item8(a.in[18] + (size_t)e * DFF * DM, DFF, DM, (unsigned char*)(ws + WS_WDN) + (size_t)e * DM * DFF, 0, scr, ii, F.lane); }
#else
            p0_transpose_item(a.in[18] + (size_t)e * DFF * DM, DFF, DM, (bf16_t*)(ws + WS_WDN) + (size_t)e * DM * DFF, 0, scr, ii, F.lane); }
#endif
    }
    const float* x = a.in[0]; bf16_t* xb = (bf16_t*)(ws + WS_XB);
    for (int m = gw; m < NTOK; m += NGW) {
        const GAS f32x4* xr = (const GAS f32x4*)(x + (size_t)m * DM) + F.lane; GAS v2u* o8 = (GAS v2u*)(xb + (size_t)m * DM) + F.lane;
        f32x4 v[4];
#pragma unroll
        for (int j = 0; j < 4; ++j) v[j] = xr[64 * j];
#pragma unroll
        for (int j = 0; j < 4; ++j) { v2u o; o.x = pk2(v[j].x, v[j].y); o.y = pk2(v[j].z, v[j].w); o8[64 * j] = o; }
    }
}

__device__ __forceinline__ void gmlp_phase(Frame& F, const Args& a) {
    const bf16_t* proj = (const bf16_t*)(a.ws + WS_PROJ); bf16_t* mix = (bf16_t*)(a.ws + WS_MIX);
    const float *lng = a.in[7], *lnb = a.in[8], *wsp = a.in[9], *bsp = a.in[10];
    LAS f32x2* st = (LAS f32x2*)(F.lds + RING_OFF);
    LAS bf16_t* Vg = (LAS bf16_t*)(F.lds + RING_OFF + 1024);
    LAS bf16_t* Wg = (LAS bf16_t*)(F.lds + RING_OFF + 19456);
    LAS float* Zg = (LAS float*)(F.lds + RING_OFF + 54272);
    const int tid = F.tid, lane = F.lane, w = F.wave;
    for (int c = blockIdx.x; c < NTOK / CHUNK; c += F.G) {
        const size_t row0 = (size_t)c * CHUNK;
        for (int s = 16 * w; s < 16 * w + 16; ++s) {
            const v4u raw = *(const GAS v4u*)(proj + (row0 + s) * INW + C_GV + lane * 8);
            const unsigned rw[4] = {raw.x, raw.y, raw.z, raw.w}; float v[8]; float sum = 0.f;
#pragma unroll
            for (int i = 0; i < 4; ++i) { const f32x2 gg = pg8::gelu_pk((f32x2){bf2f((bf16_t)(rw[i] & 0xffff)), bf2f((bf16_t)(rw[i] >> 16))}); v[2 * i] = gg.x; v[2 * i + 1] = gg.y; sum += gg.x + gg.y; }
            const float mean = wave_sum(sum) * (1.0f / GW); float q = 0.f;
#pragma unroll
            for (int i = 0; i < 8; ++i) { const float d = v[i] - mean; q += d * d; }
            const float var = wave_sum(q) * (1.0f / GW);
            if (lane == 0) st[s] = (f32x2){mean, rsqrtf(var + LN_EPS)};
        }
        __syncthreads();
        for (int g = 0; g < NG; ++g) {
            {
                const int row = tid >> 2, cq = (tid & 3) * 16, col = g * GD + cq; const f32x2 ms = st[row];
                const GAS v4u* src = (const GAS v4u*)(proj + (row0 + row) * INW + C_GV + col);
                unsigned ow[8];
#pragma unroll
                for (int hh = 0; hh < 2; ++hh) { const v4u raw = src[hh]; const unsigned rw[4] = {raw.x, raw.y, raw.z, raw.w};
#pragma unroll
                    for (int i = 0; i < 4; ++i) { const f32x2 gg = pg8::gelu_pk((f32x2){bf2f((bf16_t)(rw[i] & 0xffff)), bf2f((bf16_t)(rw[i] >> 16))});
                        const int cc = col + hh * 8 + 2 * i;
                        ow[hh * 4 + i] = pk2((gg.x - ms.x) * ms.y * lng[cc] + lnb[cc], (gg.y - ms.x) * ms.y * lng[cc + 1] + lnb[cc + 1]); } }
                *(LAS v4u*)(Vg + row * 72 + cq) = (v4u){ow[0], ow[1], ow[2], ow[3]};
                *(LAS v4u*)(Vg + row * 72 + cq + 8) = (v4u){ow[4], ow[5], ow[6], ow[7]};
#pragma unroll
                for (int k = 0; k < 8; ++k) { const int i = tid + 512 * k, t = i >> 5, s4 = (i & 31) * 4;
                    const f32x4 wv = *(const GAS f32x4*)(wsp + ((size_t)g * CHUNK + t) * CHUNK + s4);
                    v2u o; o.x = pk2(s4 <= t ? wv.x : 0.f, s4 + 1 <= t ? wv.y : 0.f); o.y = pk2(s4 + 2 <= t ? wv.z : 0.f, s4 + 3 <= t ? wv.w : 0.f);
                    *(LAS v2u*)(Wg + t * 136 + s4) = o; }
            }
            __syncthreads();
            {
                f32x4 acc[4];
#pragma unroll
                for (int n = 0; n < 4; ++n) acc[n] = (f32x4){0.f, 0.f, 0.f, 0.f};
                const int t0 = 16 * w, fr = lane & 15, fq = lane >> 4;
                for (int ks = 0; ks * 32 <= t0 + 15; ++ks) {
                    const bf16x8 af = *(const LAS bf16x8*)(Wg + (t0 + fr) * 136 + ks * 32 + fq * 8);
#pragma unroll
                    for (int n = 0; n < 4; ++n) { bf16x8 bfv;
#pragma unroll
                        for (int j = 0; j < 8; ++j) bfv[j] = (short)Vg[(ks * 32 + fq * 8 + j) * 72 + n * 16 + fr];
                        acc[n] = __builtin_amdgcn_mfma_f32_16x16x32_bf16(af, bfv, acc[n], 0, 0, 0); }
                }
#pragma unroll
                for (int n = 0; n < 4; ++n)
#pragma unroll
                    for (int r = 0; r < 4; ++r) Zg[(t0 + fq * 4 + r) * 68 + n * 16 + fr] = acc[n][r];
            }
            __syncthreads();
            {
                const int row = tid >> 2, cq = (tid & 3) * 16, col = g * GD + cq; const float bb = bsp[g * CHUNK + row];
                const GAS v4u* src = (const GAS v4u*)(proj + (row0 + row) * INW + C_GU + col);
                unsigned ow[8];
#pragma unroll
                for (int hh = 0; hh < 2; ++hh) { const v4u raw = src[hh]; const unsigned rw[4] = {raw.x, raw.y, raw.z, raw.w};
#pragma unroll
                    for (int i = 0; i < 4; ++i) { const f32x2 uu = pg8::gelu_pk((f32x2){bf2f((bf16_t)(rw[i] & 0xffff)), bf2f((bf16_t)(rw[i] >> 16))});
                        const f32x2 zz = *(const LAS f32x2*)(Zg + row * 68 + cq + hh * 8 + 2 * i);
                        ow[hh * 4 + i] = pk2(uu.x * (zz.x + bb), uu.y * (zz.y + bb)); } }
                GAS v4u* dst = (GAS v4u*)(mix + (row0 + row) * DM + GW + col);
                dst[0] = (v4u){ow[0], ow[1], ow[2], ow[3]}; dst[1] = (v4u){ow[4], ow[5], ow[6], ow[7]};
            }
            __syncthreads();
        }
    }
}

__device__ __forceinline__ void attn_combine_phase(Frame& F, const Args& a) {
    const bf16_t* atto = (const bf16_t*)(a.ws + WS_ATTO); bf16_t* mix = (bf16_t*)(a.ws + WS_MIX);
    const int lane = F.lane, gw = F.vcu * NWAVES + F.wave, NGW = F.G * NWAVES;
    const float lam = expf(wave_sum(a.in[2][lane] * a.in[3][lane])) - expf(wave_sum(a.in[4][lane] * a.in[5][lane])) + LAMBDA_INIT;
    const int h = lane >> 4, e0 = (lane & 15) * 8;
    float sg[8];
#pragma unroll
    for (int i = 0; i < 8; ++i) sg[i] = a.in[6][e0 + i] * (1.0f - LAMBDA_INIT);
    for (int t = gw; t < NTOK; t += NGW) {
        const v4u r1 = *(const GAS v4u*)(atto + (size_t)t * DM + h * 256 + e0), r2 = *(const GAS v4u*)(atto + (size_t)t * DM + h * 256 + 128 + e0);
        const unsigned w1[4] = {r1.x, r1.y, r1.z, r1.w}, w2[4] = {r2.x, r2.y, r2.z, r2.w};
        float d[8]; float ss = 0.f;
#pragma unroll
        for (int i = 0; i < 4; ++i) { d[2 * i] = bf2f((bf16_t)(w1[i] & 0xffff)) - lam * bf2f((bf16_t)(w2[i] & 0xffff)); d[2 * i + 1] = bf2f((bf16_t)(w1[i] >> 16)) - lam * bf2f((bf16_t)(w2[i] >> 16)); ss += d[2 * i] * d[2 * i] + d[2 * i + 1] * d[2 * i + 1]; }
        ss += __shfl_xor(ss, 1); ss += __shfl_xor(ss, 2); ss += __shfl_xor(ss, 4); ss += __shfl_xor(ss, 8);
        const float r = rsqrtf(ss * (1.0f / DV) + LN_EPS);
        v4u o; o.x = pk2(d[0] * r * sg[0], d[1] * r * sg[1]); o.y = pk2(d[2] * r * sg[2], d[3] * r * sg[3]); o.z = pk2(d[4] * r * sg[4], d[5] * r * sg[5]); o.w = pk2(d[6] * r * sg[6], d[7] * r * sg[7]);
        *(GAS v4u*)(mix + (size_t)t * DM + h * DV + e0) = o;
    }
}

template <int CTRL> __device__ __forceinline__ float dppf(float v) { return __builtin_bit_cast(float, __builtin_amdgcn_update_dpp(0, __builtin_bit_cast(int, v), CTRL, 0xF, 0xF, true)); }
template <int CTRL> __device__ __forceinline__ int dppi(int v) { return __builtin_amdgcn_update_dpp(0, v, CTRL, 0xF, 0xF, true); }
__device__ __forceinline__ float rlf(float v, int l) { return __builtin_bit_cast(float, __builtin_amdgcn_readlane(__builtin_bit_cast(int, v), l)); }
__device__ __forceinline__ float wsum_dpp(float v) {
    v += dppf<0xB1>(v); v += dppf<0x4E>(v); v += dppf<0x141>(v); v += dppf<0x140>(v);
    return (rlf(v, 0) + rlf(v, 16)) + (rlf(v, 32) + rlf(v, 48));
}
__device__ __forceinline__ float wmax_dpp(float v) {
    v = fmaxf(v, dppf<0xB1>(v)); v = fmaxf(v, dppf<0x4E>(v)); v = fmaxf(v, dppf<0x141>(v)); v = fmaxf(v, dppf<0x140>(v));
    return fmaxf(fmaxf(rlf(v, 0), rlf(v, 16)), fmaxf(rlf(v, 32), rlf(v, 48)));
}
__device__ __forceinline__ int wmin_dpp(int v) {
    v = min(v, dppi<0xB1>(v)); v = min(v, dppi<0x4E>(v)); v = min(v, dppi<0x141>(v)); v = min(v, dppi<0x140>(v));
    return min(min(__builtin_amdgcn_readlane(v, 0), __builtin_amdgcn_readlane(v, 16)), min(__builtin_amdgcn_readlane(v, 32), __builtin_amdgcn_readlane(v, 48)));
}
__device__ __forceinline__ void route_phase(Frame& F, const Args& a) {
    float* h1 = (float*)(a.ws + WS_H1); bf16_t* xb = (bf16_t*)(a.ws + WS_XB);
    int* list = (int*)(a.ws + WS_LIST); int* re = (int*)(a.ws + WS_RE); int* rr = (int*)(a.ws + WS_RR); float* rg = (float*)(a.ws + WS_RG);
    const float *g1 = a.in[12], *b1 = a.in[13], *wr = a.in[14], *br = a.in[15];
    constexpr int XS = 1028;
    LAS float* XT = (LAS float*)(F.lds + RING_OFF);
    LAS float* PT = (LAS float*)(F.lds + RING_OFF + 16 * XS * 4);
    LAS int* lcnt = (LAS int*)(F.lds + REC_OFF); LAS int* lbase = lcnt + 32; LAS int* rec = lcnt + 64;
    const int tid = F.tid, lane = F.lane, w = F.wave, fr = lane & 15, fq = lane >> 4;
    if (tid < 32) lcnt[tid] = 0;
    constexpr int RPB = NTOK / 256;
    const int tblk = blockIdx.x * RPB;
    f32x4 pv[2][4];
#define ROUTE_LOAD(ch_) do { _Pragma("unroll") for (int q = 0; q < 2; ++q) _Pragma("unroll") for (int j = 0; j < 4; ++j) \
        pv[q][j] = *(const GAS f32x4*)(h1 + (size_t)(tblk + (ch_) * 16 + 2 * w + q) * DM + j * 256 + lane * 4); } while (0)
    ROUTE_LOAD(0);
    float bw[32][2];
#pragma unroll
    for (int s = 0; s < 32; ++s)
#pragma unroll
        for (int n = 0; n < 2; ++n) bw[s][n] = wr[(size_t)(128 * w + 4 * s + fq) * NE + 16 * n + fr];
    const int myexp = lane & 31; const float mybr = br[myexp];
    for (int ch = 0; ch < 8; ++ch) {
        const int t0 = tblk + ch * 16;
        {
            float mean[2], rstd[2];
#pragma unroll
            for (int q = 0; q < 2; ++q) { float s = 0.f;
#pragma unroll
                for (int j = 0; j < 4; ++j) s += (pv[q][j].x + pv[q][j].y) + (pv[q][j].z + pv[q][j].w);
                mean[q] = wsum_dpp(s) * (1.0f / DM); }
#pragma unroll
            for (int q = 0; q < 2; ++q) { float q2 = 0.f;
#pragma unroll
                for (int j = 0; j < 4; ++j) { pv[q][j] = pv[q][j] - mean[q]; q2 += (pv[q][j].x * pv[q][j].x + pv[q][j].y * pv[q][j].y) + (pv[q][j].z * pv[q][j].z + pv[q][j].w * pv[q][j].w); }
                rstd[q] = rsqrtf(wsum_dpp(q2) * (1.0f / DM) + LN_EPS); }
#pragma unroll
            for (int j = 0; j < 4; ++j) {
                const int col = j * 256 + lane * 4;
                const f32x4 gq = *(const GAS f32x4*)(g1 + col), bq = *(const GAS f32x4*)(b1 + col);
#pragma unroll
                for (int q = 0; q < 2; ++q) {
                    const int rl = 2 * w + q, t = t0 + rl;
                    const f32x4 o = pv[q][j] * rstd[q] * gq + bq;
                    *(GAS f32x4*)(h1 + (size_t)t * DM + col) = o;
                    *(LAS f32x4*)(XT + rl * XS + col) = o;
#if MOE_FP8
                    *(GAS unsigned*)((unsigned char*)xb + (size_t)t * DM + col) = pg8::pk4_fp8(o.x, o.y, o.z, o.w);
#else
                    v2u pk; pk.x = pk2(o.x, o.y); pk.y = pk2(o.z, o.w);
                    *(GAS v2u*)(xb + (size_t)t * DM + col) = pk;
#endif
                }
            }
        }
        if (ch < 7) ROUTE_LOAD(ch + 1);
        __syncthreads();
        {
            f32x4 acc0 = (f32x4){0.f, 0.f, 0.f, 0.f}, acc1 = (f32x4){0.f, 0.f, 0.f, 0.f};
            const LAS float* xp = XT + fr * XS + 128 * w + fq;
#pragma unroll
            for (int s = 0; s < 32; ++s) { const float av = xp[4 * s];
                acc0 = __builtin_amdgcn_mfma_f32_16x16x4f32(av, bw[s][0], acc0, 0, 0, 0);
                acc1 = __builtin_amdgcn_mfma_f32_16x16x4f32(av, bw[s][1], acc1, 0, 0, 0); }
#pragma unroll
            for (int r = 0; r < 4; ++r) { PT[(w * 16 + fq * 4 + r) * 32 + fr] = acc0[r]; PT[(w * 16 + fq * 4 + r) * 32 + 16 + fr] = acc1[r]; }
        }
        __syncthreads();
        {
            float cur[2];
#pragma unroll
            for (int q = 0; q < 2; ++q) { cur[q] = mybr;
#pragma unroll
                for (int ww = 0; ww < 8; ++ww) cur[q] += PT[(ww * 16 + 2 * w + q) * 32 + myexp]; }
            int idx[2][4]; float val[2][4];
#pragma unroll
            for (int k = 0; k < 4; ++k)
#pragma unroll
                for (int q = 0; q < 2; ++q) {
                    const float m = wmax_dpp(cur[q]);
                    const int cand = wmin_dpp((cur[q] == m) ? myexp : 99);
                    idx[q][k] = cand; val[q][k] = m; if (myexp == cand) cur[q] = -INFINITY;
                }
#pragma unroll
            for (int q = 0; q < 2; ++q) {
                const int rl = 2 * w + q, t = t0 + rl;
                float ex[4], se = 0.f;
#pragma unroll
                for (int k = 0; k < 4; ++k) { ex[k] = expf(val[q][k] - val[q][0]); se += ex[k]; }
                if (lane < 4) {
                    int e_ = idx[q][0]; float g_ = ex[0];
                    if (lane == 1) { e_ = idx[q][1]; g_ = ex[1]; } else if (lane == 2) { e_ = idx[q][2]; g_ = ex[2]; } else if (lane == 3) { e_ = idx[q][3]; g_ = ex[3]; }
                    const int lr = __hip_atomic_fetch_add(lcnt + e_, 1, __ATOMIC_RELAXED, __HIP_MEMORY_SCOPE_WORKGROUP);
                    rec[(ch * 16 + rl) * 4 + lane] = e_ | (lr << 8);
                    re[t * 4 + lane] = e_; rg[t * 4 + lane] = g_ / se;
                }
            }
        }
    }
#undef ROUTE_LOAD
    __syncthreads();
    if (tid < 32) lbase[tid] = (int)__hip_atomic_fetch_add((unsigned*)(F.ctl + CW_CNT + tid), (unsigned)lcnt[tid], RLX_AGENT);
    __syncthreads();
    { const int rw = tid >> 2, k = tid & 3; const int t = tblk + rw; const int rc = rec[tid]; const int e_ = rc & 255, r_ = lbase[e_] + (rc >> 8);
      rr[t * 4 + k] = r_; list[e_ * NTOK + r_] = t; }
}
__device__ __forceinline__ void build_tab(Frame& F) {
    LAS int* tab = (LAS int*)(F.lds + TAB_OFF);
    if (F.tid < 32) tab[40 + F.tid] = (int)__hip_atomic_load(F.ctl + CW_CNT + F.tid, RLX_AGENT);
    __syncthreads();
    if (F.tid == 0) { int p = 0; for (int e = 0; e < NE; ++e) { tab[e] = p; p += (tab[40 + e] + 255) >> 8; } tab[NE] = p; }
    __syncthreads();
}
__device__ __forceinline__ void combine_phase(Frame& F, const Args& a) {
    const float* x1 = (const float*)(a.ws + WS_H1); const bf16_t* y = (const bf16_t*)(a.ws + WS_Y);
    const int* re = (const int*)(a.ws + WS_RE); const int* rr = (const int*)(a.ws + WS_RR); const float* rg = (const float*)(a.ws + WS_RG);
    const float *g2 = a.in[20], *b2 = a.in[21]; float* out = a.out;
    const LAS int* tab = (const LAS int*)(F.lds + TAB_OFF);
    const int lane = F.lane, gw = F.vcu * NWAVES + F.wave, NGW = F.G * NWAVES;
    for (int t = gw; t < NTOK; t += NGW) {
        float v[16];
#pragma unroll
        for (int j = 0; j < 4; ++j) { const f32x4 q = *(const GAS f32x4*)(x1 + (size_t)t * DM + j * 256 + lane * 4); v[4 * j] = ALPHA * q.x; v[4 * j + 1] = ALPHA * q.y; v[4 * j + 2] = ALPHA * q.z; v[4 * j + 3] = ALPHA * q.w; }
#pragma unroll
        for (int k = 0; k < 4; ++k) {
            const int e = re[t * 4 + k], slot = tab[e] * 256 + rr[t * 4 + k]; const float g = rg[t * 4 + k];
            const bf16_t* yr = y + (size_t)slot * DM;
#pragma unroll
            for (int j = 0; j < 4; ++j) { const v2u pk = *(const GAS v2u*)(yr + j * 256 + lane * 4);
                v[4 * j] = fmaf(g, bf2f((bf16_t)(pk.x & 0xffff)), v[4 * j]); v[4 * j + 1] = fmaf(g, bf2f((bf16_t)(pk.x >> 16)), v[4 * j + 1]);
                v[4 * j + 2] = fmaf(g, bf2f((bf16_t)(pk.y & 0xffff)), v[4 * j + 2]); v[4 * j + 3] = fmaf(g, bf2f((bf16_t)(pk.y >> 16)), v[4 * j + 3]); }
        }
        float s = 0.f;
#pragma unroll
        for (int i = 0; i < 16; ++i) s += v[i];
        const float mean = wave_sum(s) * (1.0f / DM); float q2 = 0.f;
#pragma unroll
        for (int i = 0; i < 16; ++i) { v[i] -= mean; q2 += v[i] * v[i]; }
        const float rstd = rsqrtf(wave_sum(q2) * (1.0f / DM) + LN_EPS);
#pragma unroll
        for (int j = 0; j < 4; ++j) { const int col = j * 256 + lane * 4; const f32x4 gg = *(const GAS f32x4*)(g2 + col), bb = *(const GAS f32x4*)(b2 + col);
            *(GAS f32x4*)(out + (size_t)t * DM + col) = (f32x4){v[4 * j] * rstd * gg.x + bb.x, v[4 * j + 1] * rstd * gg.y + bb.y, v[4 * j + 2] * rstd * gg.z + bb.z, v[4 * j + 3] * rstd * gg.w + bb.w}; }
    }
}

constexpr int N_PHASES = 9;
__global__ void __launch_bounds__(NWAVES * 64, 2) mega_fwd(Args args) {
    extern __shared__ __attribute__((aligned(16))) unsigned char lds[];
    Frame F;
    F.lds = (LAS unsigned char*)lds;
    F.MISC = (volatile LAS unsigned*)(F.lds + MISC_OFF);
    F.tid = threadIdx.x; F.lane = F.tid & 63; F.wave = __builtin_amdgcn_readfirstlane(F.tid >> 6);
    F.G = gridDim.x; { const int bx = blockIdx.x; F.vcu = (F.G % 8 == 0) ? (bx % 8) * (F.G / 8) + bx / 8 : bx; }
    F.ctl = (gu32*)(args.ws + WS_CTL);
    for (int u = F.tid; u < (LDS_BYTES - LDSCTL_OFF) / 4; u += NWAVES * 64) ((LAS unsigned*)(F.lds + LDSCTL_OFF))[u] = 0u;
    __syncthreads();
    const int lo = args.ph_lo, hi = args.ph_hi;
    const bool multi = (hi - lo) > 1;
    XcdBarrier bar; bar.bar = (unsigned*)(F.ctl + CW_BAR); bar.x = 0; bar.st = nullptr;
    if (multi) bar = xcd_barrier_post((unsigned*)(F.ctl + CW_BAR), F.MISC + 8);
#ifndef PH_MASK
#define PH_MASK 0x1FF
#endif
#define IN(k) ((((PH_MASK) >> (k)) & 1) && lo <= (k) && (k) < hi)
#define SEAM(k) do { if (IN(k) && IN((k) + 1)) xcd_barrier(bar); } while (0)
#ifndef DOUBLE_MASK
#define DOUBLE_MASK 0
#endif
#define REP(k) for (int rep_ = 0; rep_ < ((((DOUBLE_MASK) >> (k)) & 1) + 1); ++rep_)
    if (IN(0)) { REP(0) { refresh_frame(F); const Args A = fetch_args(); p0_prologue(F, A); } SEAM(0); }
    if (IN(1)) { REP(1) {
        refresh_frame(F); const Args A = fetch_args(); unsigned char* ws = A.ws;
        pg8::Gemm g{(const bf16_t*)(ws + WS_XB), (const bf16_t*)(ws + WS_WIN), NTOK, INW, DM, 0}; pg8::StaticOrder S; S.init(NTOK, INW, F.G, (int)blockIdx.x);
        pg8::EpiProj E{(bf16_t*)(ws + WS_PROJ)};
        pg8::gemm_phase<pg8::EpiProj, pg8::StaticOrder, false>(F.lds + RING_OFF, g, S, E);
        } SEAM(1);
    }
    if (IN(2)) { REP(2) {
        refresh_frame(F); const Args A = fetch_args(); unsigned char* ws = A.ws;
#ifndef P2_REP_SUB
#define P2_REP_SUB 3
#endif
        const int sub_ = (rep_ == 0) ? A.pad0 : (A.pad0 & P2_REP_SUB);
        if (sub_ & 1) attn_body::attn_phase<8>((char*)lds + RING_OFF, (const bf16_t*)(ws + WS_PROJ), (bf16_t*)(ws + WS_ATTO), F.vcu);
        if (sub_ & 2) gmlp_phase(F, A);
        } SEAM(2);
    }
    if (IN(3)) { REP(3) { refresh_frame(F); const Args A = fetch_args(); attn_combine_phase(F, A); } SEAM(3); }
    if (IN(4)) { REP(4) {
        refresh_frame(F); const Args A = fetch_args(); unsigned char* ws = A.ws;
        pg8::Gemm g{(const bf16_t*)(ws + WS_MIX), (const bf16_t*)(ws + WS_WO), NTOK, DM, DM, 0}; pg8::StaticOrder S; S.init(NTOK, DM, F.G, (int)blockIdx.x);
        pg8::EpiH1 E{A.in[0], (float*)(ws + WS_H1)};
        pg8::gemm_phase<pg8::EpiH1, pg8::StaticOrder, false>(F.lds + RING_OFF, g, S, E);
        } SEAM(4);
    }
    if (IN(5)) { REP(5) { refresh_frame(F); const Args A = fetch_args(); route_phase(F, A); } SEAM(5); }
    if (IN(6)) { REP(6) {
        refresh_frame(F); const Args A = fetch_args(); unsigned char* ws = A.ws;
        build_tab(F);
        pg8::MoeOrder S; S.init((const LAS int*)(F.lds + TAB_OFF), (const int*)(ws + WS_LIST), 8, (int)blockIdx.x);
#if MOE_FP8
        pg8::Gemm g{(const bf16_t*)(ws + WS_XB), (const bf16_t*)(ws + WS_WUP), PADROWS, 2 * DFF, DM, (size_t)2 * DFF * DM / 2};
        pg8::EpiSwiglu8 E{(unsigned char*)(ws + WS_ACT), A.in[17]};
        pg8::gemm_phase<pg8::EpiSwiglu8, pg8::MoeOrder, true, true>(F.lds + RING_OFF, g, S, E);
#else
        pg8::Gemm g{(const bf16_t*)(ws + WS_XB), (const bf16_t*)(ws + WS_WUP), PADROWS, 2 * DFF, DM, (size_t)2 * DFF * DM};
        pg8::EpiSwiglu E{(bf16_t*)(ws + WS_ACT), A.in[17]};
        pg8::gemm_phase<pg8::EpiSwiglu, pg8::MoeOrder, true>(F.lds + RING_OFF, g, S, E);
#endif
        } SEAM(6);
    }
    if (IN(7)) { REP(7) {
        refresh_frame(F); const Args A = fetch_args(); unsigned char* ws = A.ws;
        build_tab(F);
        pg8::MoeOrder S; S.init((const LAS int*)(F.lds + TAB_OFF), (const int*)(ws + WS_LIST), 4, (int)blockIdx.x);
        pg8::EpiDown E{(bf16_t*)(ws + WS_Y), A.in[19]};
#if MOE_FP8
        pg8::Gemm g{(const bf16_t*)(ws + WS_ACT), (const bf16_t*)(ws + WS_WDN), PADROWS, DM, DFF, (size_t)DM * DFF / 2};
        pg8::gemm_phase<pg8::EpiDown, pg8::MoeOrder, false, true>(F.lds + RING_OFF, g, S, E);
#else
        pg8::Gemm g{(const bf16_t*)(ws + WS_ACT), (const bf16_t*)(ws + WS_WDN), PADROWS, DM, DFF, (size_t)DM * DFF};
        pg8::gemm_phase<pg8::EpiDown, pg8::MoeOrder, false>(F.lds + RING_OFF, g, S, E);
#endif
        } SEAM(7);
    }
    if (IN(8)) { REP(8) { refresh_frame(F); const Args A = fetch_args(); build_tab(F); combine_phase(F, A); } }
#undef IN
#undef SEAM
}

struct NArgs {
    const float* x; const float* B; const float* bias; const float* bias2;
    const bf16_t* Ab; bf16_t* Ob; float* Of; const int* ctl; const int* list;
};
template <int MODE> __global__ void __launch_bounds__(256) ngemm(NArgs a) {
    constexpr int K = 1024;
    constexpr int LDB = (MODE == 0) ? INW : (MODE == 2 ? 2048 : 1024);
    constexpr bool DUAL = (MODE == 2);
    __shared__ float As[16][68];
    __shared__ float Bs[16][64];
    __shared__ float Bs2[DUAL ? 16 : 1][64];
    const int tid = threadIdx.x, ty = tid >> 4, tx = tid & 15;
    const int row0 = blockIdx.y * 64, col0 = blockIdx.x * 64;
    const float* B = a.B; int e = 0, pst = 0, cnt = 0;
    if (MODE >= 2) {
        const int* ps = a.ctl + CW_PSTART;
        while (e < NE && row0 >= ps[e + 1]) ++e;
        if (e >= NE) return;
        pst = ps[e]; cnt = a.ctl[CW_CNT + e];
        B += (size_t)e * K * LDB;
    }
    const int ar = tid >> 2, ak = (tid & 3) * 4;
    const float* arow_f = nullptr; const bf16_t* arow_b = nullptr;
    if (MODE == 0) arow_f = a.x + (size_t)(row0 + ar) * K;
    else if (MODE == 1 || MODE == 3) arow_b = a.Ab + (size_t)(row0 + ar) * K;
    else { const int r = row0 + ar - pst; const int tok = (r < cnt) ? a.list[e * NTOK + r] : 0; arow_b = a.Ab + (size_t)tok * K; }
    const int bk = tid >> 4, bn = (tid & 15) * 4;
    float acc[4][4], acc2[4][4];
#pragma unroll
    for (int i = 0; i < 4; ++i)
#pragma unroll
        for (int j = 0; j < 4; ++j) { acc[i][j] = 0.f; acc2[i][j] = 0.f; }
    for (int k0 = 0; k0 < K; k0 += 16) {
        float av[4];
        if (MODE == 0) { const float4 t = *(const float4*)(arow_f + k0 + ak); av[0] = t.x; av[1] = t.y; av[2] = t.z; av[3] = t.w; }
        else { const uint2 t = *(const uint2*)(arow_b + k0 + ak); av[0] = bf2f((bf16_t)(t.x & 0xffff)); av[1] = bf2f((bf16_t)(t.x >> 16)); av[2] = bf2f((bf16_t)(t.y & 0xffff)); av[3] = bf2f((bf16_t)(t.y >> 16)); }
        const float4 bv = *(const float4*)(B + (size_t)(k0 + bk) * LDB + col0 + bn);
        float4 bv2 = bv;
        if (DUAL) bv2 = *(const float4*)(B + (size_t)(k0 + bk) * LDB + 1024 + col0 + bn);
        __syncthreads();
#pragma unroll
        for (int c = 0; c < 4; ++c) As[ak + c][ar] = av[c];
        *(float4*)&Bs[bk][bn] = bv;
        if (DUAL) *(float4*)&Bs2[bk][bn] = bv2;
        __syncthreads();
#pragma unroll
        for (int k = 0; k < 16; ++k) {
            const float4 a4 = *(const float4*)&As[k][ty * 4];
            const float4 b4 = *(const float4*)&Bs[k][tx * 4];
            const float aa[4] = {a4.x, a4.y, a4.z, a4.w}, bb[4] = {b4.x, b4.y, b4.z, b4.w};
#pragma unroll
            for (int i = 0; i < 4; ++i)
#pragma unroll
                for (int j = 0; j < 4; ++j) acc[i][j] = fmaf(aa[i], bb[j], acc[i][j]);
            if (DUAL) {
                const float4 c4 = *(const float4*)&Bs2[k][tx * 4];
                const float cc[4] = {c4.x, c4.y, c4.z, c4.w};
#pragma unroll
                for (int i = 0; i < 4; ++i)
#pragma unroll
                    for (int j = 0; j < 4; ++j) acc2[i][j] = fmaf(aa[i], cc[j], acc2[i][j]);
            }
        }
    }
#pragma unroll
    for (int i = 0; i < 4; ++i) {
        const int row = row0 + ty * 4 + i;
#pragma unroll
        for (int j = 0; j < 4; ++j) {
            const int col = col0 + tx * 4 + j;
            if (MODE == 0) { float v = acc[i][j]; if (col < C_K) v *= QSCALE; a.Ob[(size_t)row * INW + col] = f2bf(v); }
            else if (MODE == 1) { a.Of[(size_t)row * DM + col] = ALPHA * a.x[(size_t)row * DM + col] + acc[i][j]; }
            else if (MODE == 2) {
                float g = acc[i][j] + a.bias[e * 2048 + col], l = acc2[i][j] + a.bias[e * 2048 + 1024 + col];
                g = fminf(g, 7.0f); l = fminf(fmaxf(l, -7.0f), 7.0f);
                const float act = (l + 1.0f) * g * (1.0f / (1.0f + expf(-1.702f * g)));
                a.Ob[(size_t)row * DFF + col] = f2bf(act);
            } else { a.Ob[(size_t)row * DM + col] = f2bf(acc[i][j] + a.bias[e * DM + col]); }
        }
    }
}

__global__ void __launch_bounds__(128) nattn(const bf16_t* __restrict__ proj, bf16_t* __restrict__ mix, const float* lq1, const float* lk1, const float* lq2, const float* lk2, const float* subg) {
    __shared__ float sc[2][SEQ];
    const int w = threadIdx.x >> 6, lane = threadIdx.x & 63;
    const int task = blockIdx.x * 2 + w, t = task >> 2, h = task & 3, b = t / SEQ, qpos = t % SEQ;
    const float lam = expf(wave_sum(lq1[lane] * lk1[lane])) - expf(wave_sum(lq2[lane] * lk2[lane])) + LAMBDA_INIT;
    const bf16_t* pb = proj + (size_t)b * SEQ * INW;
    float o[2][2];
    for (int s = 0; s < 2; ++s) {
        float q[DH];
        const bf16_t* qp = proj + (size_t)t * INW + C_Q + s * 256 + h * DH;
#pragma unroll
        for (int d = 0; d < DH; ++d) q[d] = bf2f(qp[d]);
        float m = -INFINITY;
        for (int j = lane; j <= qpos; j += 64) {
            const uint4* kp = (const uint4*)(pb + (size_t)j * INW + C_K + s * 256 + h * DH);
            float acc = 0.f;
#pragma unroll
            for (int c = 0; c < 8; ++c) {
                const uint4 kk = kp[c];
                const uint32_t ww[4] = {kk.x, kk.y, kk.z, kk.w};
#pragma unroll
                for (int z = 0; z < 4; ++z) { acc = fmaf(q[c * 8 + 2 * z], bf2f((bf16_t)(ww[z] & 0xffff)), acc); acc = fmaf(q[c * 8 + 2 * z + 1], bf2f((bf16_t)(ww[z] >> 16)), acc); }
            }
            sc[w][j] = acc; m = fmaxf(m, acc);
        }
        m = wave_max(m);
        float l = 0.f;
        for (int j = lane; j <= qpos; j += 64) { const float p = exp2f(sc[w][j] - m); sc[w][j] = p; l += p; }
        l = wave_sum(l);
        __syncthreads();
        float o0 = 0.f, o1 = 0.f;
        const bf16_t* vp = pb + C_V + h * DV + lane * 2;
        for (int j = 0; j <= qpos; ++j) {
            const float p = sc[w][j];
            const uint32_t vv = *(const uint32_t*)(vp + (size_t)j * INW);
            o0 = fmaf(p, bf2f((bf16_t)(vv & 0xffff)), o0); o1 = fmaf(p, bf2f((bf16_t)(vv >> 16)), o1);
        }
        o[s][0] = o0 / l; o[s][1] = o1 / l;
        __syncthreads();
    }
    const float d0 = o[0][0] - lam * o[1][0], d1 = o[0][1] - lam * o[1][1];
    const float ss = wave_sum(d0 * d0 + d1 * d1);
    const float r = rsqrtf(ss * (1.0f / DV) + LN_EPS) * (1.0f - LAMBDA_INIT);
    const uint32_t pk = (uint32_t)f2bf(d0 * r * subg[lane * 2]) | ((uint32_t)f2bf(d1 * r * subg[lane * 2 + 1]) << 16);
    *(uint32_t*)(mix + (size_t)t * DM + h * DV + lane * 2) = pk;
}

__global__ void __launch_bounds__(256) ngmlp(const bf16_t* __restrict__ proj, bf16_t* __restrict__ mix, const float* lng, const float* lnb, const float* wsp, const float* bsp) {
    __shared__ float mu[CHUNK], rs[CHUNK];
    __shared__ float vn[CHUNK][GD];
    const int c = blockIdx.x, g = blockIdx.y, tid = threadIdx.x, w = tid >> 6, lane = tid & 63;
    const size_t row0 = (size_t)c * CHUNK;
    for (int s = w; s < CHUNK; s += 4) {
        const bf16_t* p = proj + (row0 + s) * INW + C_GV;
        float v[8]; float sum = 0.f;
#pragma unroll
        for (int i = 0; i < 8; ++i) { v[i] = gelu_exact(bf2f(p[lane + 64 * i])); sum += v[i]; }
        const float mean = wave_sum(sum) * (1.0f / GW); float q = 0.f;
#pragma unroll
        for (int i = 0; i < 8; ++i) { const float d = v[i] - mean; q += d * d; }
        const float var = wave_sum(q) * (1.0f / GW);
        if (lane == 0) { mu[s] = mean; rs[s] = rsqrtf(var + LN_EPS); }
    }
    __syncthreads();
    for (int i = tid; i < CHUNK * GD; i += 256) {
        const int s = i >> 6, d = i & 63, col = g * GD + d;
        const float v = gelu_exact(bf2f(proj[(row0 + s) * INW + C_GV + col]));
        vn[s][d] = (v - mu[s]) * rs[s] * lng[col] + lnb[col];
    }
    __syncthreads();
    const int t = tid >> 1, dh = (tid & 1) * 32;
    float z[32];
#pragma unroll
    for (int d = 0; d < 32; ++d) z[d] = 0.f;
    const float* wr = wsp + ((size_t)g * CHUNK + t) * CHUNK;
    for (int s = 0; s <= t; ++s) {
        const float wv = wr[s];
#pragma unroll
        for (int d = 0; d < 32; ++d) z[d] = fmaf(wv, vn[s][dh + d], z[d]);
    }
    const float bb = bsp[g * CHUNK + t];
#pragma unroll
    for (int d = 0; d < 32; ++d) {
        const int col = g * GD + dh + d;
        const float u = gelu_exact(bf2f(proj[(row0 + t) * INW + C_GU + col]));
        mix[(row0 + t) * DM + GW + col] = f2bf(u * (z[d] + bb));
    }
}

__global__ void __launch_bounds__(256) nroute(float* __restrict__ h1, bf16_t* __restrict__ xb, const float* g1, const float* b1, const float* wr, const float* br, int* ctl, int* list, int* re, int* rr, float* rg) {
    const int w = threadIdx.x >> 6, lane = threadIdx.x & 63, t = blockIdx.x * 4 + w;
    float* row = h1 + (size_t)t * DM;
    float v[16]; float s = 0.f;
#pragma unroll
    for (int j = 0; j < 4; ++j) { const float4 q = *(const float4*)(row + j * 256 + lane * 4); v[4 * j] = q.x; v[4 * j + 1] = q.y; v[4 * j + 2] = q.z; v[4 * j + 3] = q.w; s += (q.x + q.y) + (q.z + q.w); }
    const float mean = wave_sum(s) * (1.0f / DM); float q2 = 0.f;
#pragma unroll
    for (int i = 0; i < 16; ++i) { v[i] -= mean; q2 += v[i] * v[i]; }
    const float rstd = rsqrtf(wave_sum(q2) * (1.0f / DM) + LN_EPS);
#pragma unroll
    for (int j = 0; j < 4; ++j) {
        const int col = j * 256 + lane * 4;
#pragma unroll
        for (int c = 0; c < 4; ++c) v[4 * j + c] = v[4 * j + c] * rstd * g1[col + c] + b1[col + c];
        *(float4*)(row + col) = make_float4(v[4 * j], v[4 * j + 1], v[4 * j + 2], v[4 * j + 3]);
        uint2 pk; pk.x = (uint32_t)f2bf(v[4 * j]) | ((uint32_t)f2bf(v[4 * j + 1]) << 16); pk.y = (uint32_t)f2bf(v[4 * j + 2]) | ((uint32_t)f2bf(v[4 * j + 3]) << 16);
        *(uint2*)(xb + (size_t)t * DM + col) = pk;
    }
    float lg[NE];
#pragma unroll
    for (int e = 0; e < NE; ++e) lg[e] = 0.f;
#pragma unroll
    for (int j = 0; j < 4; ++j)
#pragma unroll
        for (int c = 0; c < 4; ++c) {
            const float xv = v[4 * j + c]; const float4* wp = (const float4*)(wr + (size_t)(j * 256 + lane * 4 + c) * NE);
#pragma unroll
            for (int e4 = 0; e4 < 8; ++e4) { const float4 ww = wp[e4]; lg[4 * e4] = fmaf(xv, ww.x, lg[4 * e4]); lg[4 * e4 + 1] = fmaf(xv, ww.y, lg[4 * e4 + 1]); lg[4 * e4 + 2] = fmaf(xv, ww.z, lg[4 * e4 + 2]); lg[4 * e4 + 3] = fmaf(xv, ww.w, lg[4 * e4 + 3]); }
        }
#pragma unroll
    for (int e = 0; e < NE; ++e) lg[e] = wave_sum(lg[e]) + br[e];
    int idx[4]; float val[4]; unsigned taken = 0u;
#pragma unroll
    for (int k = 0; k < 4; ++k) {
        float best = -INFINITY; int bi = 0;
#pragma unroll
        for (int e = 0; e < NE; ++e) { const bool ok = !((taken >> e) & 1u) && lg[e] > best; best = ok ? lg[e] : best; bi = ok ? e : bi; }
        idx[k] = bi; val[k] = best; taken |= 1u << bi;
    }
    float ex[4], se = 0.f;
#pragma unroll
    for (int k = 0; k < 4; ++k) { ex[k] = expf(val[k] - val[0]); se += ex[k]; }
    if (lane == 0) {
#pragma unroll
        for (int k = 0; k < 4; ++k) {
            const int r = atomicAdd(ctl + CW_CNT + idx[k], 1);
            list[idx[k] * NTOK + r] = t;
            re[t * 4 + k] = idx[k]; rr[t * 4 + k] = r; rg[t * 4 + k] = ex[k] / se;
        }
    }
}
__global__ void npstart(int* ctl) {
    if (threadIdx.x == 0 && blockIdx.x == 0) { int p = 0; for (int e = 0; e < NE; ++e) { ctl[CW_PSTART + e] = p; p += ((ctl[CW_CNT + e] + 255) / 256) * 256; } ctl[CW_PSTART + NE] = p; }
}
__global__ void __launch_bounds__(256) ncombine(const float* __restrict__ x1, const bf16_t* __restrict__ y, const int* ctl, const int* re, const int* rr, const float* rg, const float* g2, const float* b2, float* __restrict__ out) {
    const int w = threadIdx.x >> 6, lane = threadIdx.x & 63, t = blockIdx.x * 4 + w;
    float v[16];
#pragma unroll
    for (int j = 0; j < 4; ++j) { const float4 q = *(const float4*)(x1 + (size_t)t * DM + j * 256 + lane * 4); v[4 * j] = ALPHA * q.x; v[4 * j + 1] = ALPHA * q.y; v[4 * j + 2] = ALPHA * q.z; v[4 * j + 3] = ALPHA * q.w; }
#pragma unroll
    for (int k = 0; k < 4; ++k) {
        const int e = re[t * 4 + k], slot = ctl[CW_PSTART + e] + rr[t * 4 + k]; const float g = rg[t * 4 + k];
        const bf16_t* yr = y + (size_t)slot * DM;
#pragma unroll
        for (int j = 0; j < 4; ++j) { const uint2 pk = *(const uint2*)(yr + j * 256 + lane * 4);
            v[4 * j] = fmaf(g, bf2f((bf16_t)(pk.x & 0xffff)), v[4 * j]); v[4 * j + 1] = fmaf(g, bf2f((bf16_t)(pk.x >> 16)), v[4 * j + 1]);
            v[4 * j + 2] = fmaf(g, bf2f((bf16_t)(pk.y & 0xffff)), v[4 * j + 2]); v[4 * j + 3] = fmaf(g, bf2f((bf16_t)(pk.y >> 16)), v[4 * j + 3]); }
    }
    float s = 0.f;
#pragma unroll
    for (int i = 0; i < 16; ++i) s += v[i];
    const float mean = wave_sum(s) * (1.0f / DM); float q2 = 0.f;
#pragma unroll
    for (int i = 0; i < 16; ++i) { v[i] -= mean; q2 += v[i] * v[i]; }
    const float rstd = rsqrtf(wave_sum(q2) * (1.0f / DM) + LN_EPS);
#pragma unroll
    for (int j = 0; j < 4; ++j) { const int col = j * 256 + lane * 4;
        *(float4*)(out + (size_t)t * DM + col) = make_float4(v[4 * j] * rstd * g2[col] + b2[col], v[4 * j + 1] * rstd * g2[col + 1] + b2[col + 1], v[4 * j + 2] * rstd * g2[col + 2] + b2[col + 2], v[4 * j + 3] * rstd * g2[col + 3] + b2[col + 3]); }
}

#ifndef OPT_MASK
#define OPT_MASK 0x1FF
#endif
#ifndef FUSED
#define FUSED 0
#endif
static void launch_mega(const Args& base, int lo, int hi, int sub, hipStream_t stream) {
    Args a = base; a.ph_lo = lo; a.ph_hi = hi; a.pad0 = sub; a.pad1 = 0;
    hipLaunchKernelGGL(mega_fwd, dim3(256), dim3(NWAVES * 64), LDS_BYTES, stream, a);
}
extern "C" void kernel_launch(void* const* d_in, const int* in_sizes, int n_in, void* d_out, int out_size, void* d_ws, size_t ws_size, hipStream_t stream) {
    static int ready = 0;
    if (ready == 0) {
        if (n_in != 22 || in_sizes[0] != NTOK * DM || out_size != NTOK * DM || ws_size < WS_END) { fprintf(stderr, "kernel_launch: unexpected shapes (n_in %d, in0 %d, out %d, ws %zu)\n", n_in, n_in > 0 ? in_sizes[0] : -1, out_size, ws_size); ready = -1; return; }
        if (hipFuncSetAttribute((const void*)mega_fwd, hipFuncAttributeMaxDynamicSharedMemorySize, LDS_BYTES) != hipSuccess) { fprintf(stderr, "kernel_launch: hipFuncSetAttribute failed\n"); ready = -1; return; }
        ready = 1;
    }
    if (ready < 0) return;
    const float* x = (const float*)d_in[0]; const float* w_in = (const float*)d_in[1];
    const float *lq1 = (const float*)d_in[2], *lk1 = (const float*)d_in[3], *lq2 = (const float*)d_in[4], *lk2 = (const float*)d_in[5];
    const float *subg = (const float*)d_in[6], *glng = (const float*)d_in[7], *glnb = (const float*)d_in[8], *wsp = (const float*)d_in[9], *bsp = (const float*)d_in[10];
    const float *w_o = (const float*)d_in[11], *ln1g = (const float*)d_in[12], *ln1b = (const float*)d_in[13], *w_r = (const float*)d_in[14], *b_r = (const float*)d_in[15];
    const float *w_up = (const float*)d_in[16], *b_up = (const float*)d_in[17], *w_dn = (const float*)d_in[18], *b_dn = (const float*)d_in[19], *ln2g = (const float*)d_in[20], *ln2b = (const float*)d_in[21];
    unsigned char* ws = (unsigned char*)d_ws;
    int* ctl = (int*)(ws + WS_CTL); int* list = (int*)(ws + WS_LIST); int* re = (int*)(ws + WS_RE); int* rr = (int*)(ws + WS_RR); float* rg = (float*)(ws + WS_RG);
    bf16_t* xb = (bf16_t*)(ws + WS_XB); bf16_t* proj = (bf16_t*)(ws + WS_PROJ); bf16_t* mix = (bf16_t*)(ws + WS_MIX); bf16_t* yb = (bf16_t*)(ws + WS_Y);
    float* h1 = (float*)(ws + WS_H1); bf16_t* act = (bf16_t*)(ws + WS_ACT);
    (void)hipMemsetAsync(ws + WS_CTL, 0, CTL_BYTES, stream);
    Args base{};
    for (int i = 0; i < 22; ++i) base.in[i] = (const float*)d_in[i];
    base.out = (float*)d_out; base.ws = ws;
    constexpr unsigned OM = OPT_MASK;
#if FUSED
    static_assert(OM == 0x1FFu, "FUSED needs every stage in the persistent kernel");
    launch_mega(base, 0, N_PHASES, 3, stream);
#else
    if (OM & 0xD3u) launch_mega(base, 0, 1, 0, stream);
    if (OM & 2u) launch_mega(base, 1, 2, 0, stream);
    else { NArgs a{}; a.x = x; a.B = w_in; a.Ob = proj; ngemm<0><<<dim3(INW / 64, NTOK / 64), 256, 0, stream>>>(a); }
    if ((OM & 4u) || (OM & 8u)) launch_mega(base, 2, 3, ((OM & 4u) ? 1 : 0) | ((OM & 8u) ? 2 : 0), stream);
    if (OM & 4u) launch_mega(base, 3, 4, 0, stream);
    else nattn<<<NTOK * NH / 2, 128, 0, stream>>>(proj, mix, lq1, lk1, lq2, lk2, subg);
    if (!(OM & 8u)) ngmlp<<<dim3(NTOK / CHUNK, NG), 256, 0, stream>>>(proj, mix, glng, glnb, wsp, bsp);
    if (OM & 16u) launch_mega(base, 4, 5, 0, stream);
    else { NArgs a{}; a.x = x; a.B = w_o; a.Ab = mix; a.Of = h1; ngemm<1><<<dim3(DM / 64, NTOK / 64), 256, 0, stream>>>(a); }
    if (OM & 32u) launch_mega(base, 5, 6, 0, stream);
    else nroute<<<NTOK / 4, 256, 0, stream>>>(h1, xb, ln1g, ln1b, w_r, b_r, ctl, list, re, rr, rg);
    if ((OM & 0x1C0u) != 0x1C0u) npstart<<<1, 64, 0, stream>>>(ctl);
    if (OM & 64u) launch_mega(base, 6, 7, 0, stream);
    else { NArgs a{}; a.B = w_up; a.bias = b_up; a.Ab = xb; a.Ob = act; a.ctl = ctl; a.list = list; ngemm<2><<<dim3(DFF / 64, PADROWS / 64), 256, 0, stream>>>(a); }
    if (OM & 128u) launch_mega(base, 7, 8, 0, stream);
    else { NArgs a{}; a.B = w_dn; a.bias = b_dn; a.Ab = act; a.Ob = yb; a.ctl = ctl; a.list = list; ngemm<3><<<dim3(DM / 64, PADROWS / 64), 256, 0, stream>>>(a); }
    if (OM & 256u) launch_mega(base, 8, 9, 0, stream);
    else ncombine<<<NTOK / 4, 256, 0, stream>>>(h1, yb, ctl, re, rr, rg, ln2g, ln2b, (float*)d_out);
#endif
}
```

```cpp
#include <hip/hip_runtime.h>
#include <hip/hip_bf16.h>
#include <cstdint>
#include <cstdio>
#include <cmath>

#ifndef MOE_FP8
#define MOE_FP8 1
#endif
namespace cfg {
constexpr int BATCH = 8, SEQ = 4096, NTOK = BATCH * SEQ, DM = 1024;
constexpr int INW = 2560, NH = 4, DH = 64, DV = 128;
constexpr int C_Q = 0, C_K = 512, C_V = 1024, C_GU = 1536, C_GV = 2048;
constexpr int GW = 512, NG = 8, GD = 64, CHUNK = 128;
constexpr int NE = 32, TOPK = 4, DFF = 1024;
constexpr int PADROWS = 139264;
constexpr float LN_EPS = 1e-5f;
constexpr float ALPHA = 1.189207115002721f;
constexpr float LAMBDA_INIT = 0.2f;
constexpr float QSCALE = 0.125f * 1.4426950408889634f;
constexpr size_t MiB = 1u << 20;
constexpr size_t WS_CTL = 0, CTL_BYTES = 1 * MiB;
constexpr size_t WS_LIST = 1 * MiB;
constexpr size_t WS_RE = 5 * MiB, WS_RR = 5 * MiB + 512 * 1024, WS_RG = 6 * MiB;
constexpr size_t WS_WIN = 8 * MiB;
constexpr size_t WS_WO = 13 * MiB;
constexpr size_t WS_WUP = 16 * MiB;
constexpr size_t WS_WDN = 144 * MiB;
constexpr size_t WS_X1B = 80 * MiB;
constexpr size_t WS_XB = 208 * MiB;
constexpr size_t WS_PROJ = 272 * MiB;
constexpr size_t WS_MIX = 432 * MiB;
constexpr size_t WS_ATTO = 496 * MiB;
constexpr size_t WS_Y = 272 * MiB;
constexpr size_t WS_H1 = 560 * MiB;
constexpr size_t WS_ACT = 688 * MiB;
constexpr size_t WS_END = 960 * MiB;
constexpr int CW_CNT = 0;
constexpr int CW_PSTART = 64;
constexpr int CW_BAR = 4096;
}
using namespace cfg;
typedef uint16_t bf16_t;

__device__ __forceinline__ float bf2f(bf16_t b) { return __uint_as_float((uint32_t)b << 16); }
__device__ __forceinline__ bf16_t f2bf(float f) { uint32_t u = __float_as_uint(f); u += 0x7fffu + ((u >> 16) & 1u); return (bf16_t)(u >> 16); }
__device__ __forceinline__ uint32_t pk2(float lo, float hi) { return (uint32_t)f2bf(lo) | ((uint32_t)f2bf(hi) << 16); }
__device__ __forceinline__ float wave_sum(float v) {
#pragma unroll
    for (int o = 1; o < 64; o <<= 1) v += __shfl_xor(v, o);
    return v;
}
__device__ __forceinline__ float wave_max(float v) {
#pragma unroll
    for (int o = 1; o < 64; o <<= 1) v = fmaxf(v, __shfl_xor(v, o));
    return v;
}
__device__ __forceinline__ float gelu_exact(float x) { return 0.5f * x * (1.0f + erff(x * 0.70710678118654752f)); }

#define OPT_MASK 0x1FF
#define FUSED 1
#define DOUBLE_MASK 0
#define P2_REP_SUB 3
namespace pg8 {
#define PG8_LAS __attribute__((address_space(3)))
typedef short bf16x8 __attribute__((ext_vector_type(8)));
typedef float f32x4 __attribute__((ext_vector_type(4)));
typedef float f32x2 __attribute__((ext_vector_type(2)));
typedef unsigned u32x4 __attribute__((ext_vector_type(4)));
typedef int v4i_t __attribute__((ext_vector_type(4)));
typedef int v8i_t __attribute__((ext_vector_type(8)));
constexpr int WSHIFT = 6;
constexpr int WSCALE_E8M0 = (127 - WSHIFT) * 0x01010101;
constexpr int BM = 256, BK = 64, HALF = 128, HTB = HALF * BK * 2  , STAGE_BYTES = 8 * HTB, NXCD = 8, WGM = 8;

__host__ __device__ __forceinline__ int lds_byte(int r, int c) { const int st = (r >> 4) * 2 + (c >> 5), rr = r & 15, cc = c & 31, ob = rr * 64 + cc * 2; return st * 1024 + (ob ^ (((ob >> 9) & 1) << 5)); }
__host__ __device__ __forceinline__ void stage_rc(int b, int& R, int& C) { const int st = b / 1024, sb = b % 1024, swz = sb ^ (((sb >> 9) & 1) << 5); R = (st >> 1) * 16 + swz / 64; C = (st & 1) * 32 + (swz % 64) / 2; }
__host__ __device__ __forceinline__ int perm32(int rho) { const int n = rho >> 4, i = rho & 15; return 8 * (i >> 2) + 4 * n + (i & 3); }

struct Unit { int pm, pn, e; };
struct Gemm { const bf16_t* A; const bf16_t* Bt; int M, N, K; size_t strideB; };

struct StaticOrder {
    int nM, nN, nwg, G, c;
    __host__ __device__ void init(int M, int N, int G_, int c_) { nM = M / BM; nN = N / BM; nwg = nM * nN; G = G_; c = c_; }
    __host__ __device__ bool next(int i, Unit& u) const {
        const long L = (long)i * G + c; if (L >= nwg) return false;
        int wgid = (int)L; { const int q = nwg / NXCD, r = nwg % NXCD, xcd = wgid % NXCD, off = wgid / NXCD; wgid = (xcd < r ? xcd * (q + 1) : r * (q + 1) + (xcd - r) * q) + off; }
        const int nig = WGM * nN, gid = wgid / nig, fm = gid * WGM, gsz = (nM - fm) < WGM ? (nM - fm) : WGM;
        u.pm = fm + ((wgid % nig) % gsz); u.pn = (wgid % nig) / gsz; u.e = 0; return true;
    }
    __device__ __forceinline__ void gather(const Unit&, const int (&)[2], const int (&)[2], unsigned (&)[2][2], unsigned) const {}
};
struct MoeOrder {
    const PG8_LAS int* tab; const int* list; int NC, RG, chunk0, nrt, j0;
    __device__ __forceinline__ void init(const PG8_LAS int* tab_, const int* list_, int NC_, int bid) {
        tab = tab_; list = list_; NC = NC_; RG = 32 / NC_; const int x = bid & 7; j0 = bid >> 3;
        const int T = __builtin_amdgcn_readfirstlane(tab_[32]); chunk0 = (T * x) / 8; nrt = (T * (x + 1)) / 8 - chunk0;
    }
    __device__ __forceinline__ bool next(int i, Unit& u) const {
        const int pml = i * RG + (j0 % RG); if (pml >= nrt) return false;
        u.pm = chunk0 + pml; u.pn = j0 / RG; int e = 0;
        while (e < NE - 1 && u.pm >= __builtin_amdgcn_readfirstlane(tab[e + 1])) ++e;
        u.e = e; return true;
    }
    __device__ __forceinline__ void gather(const Unit& u, const int (&RA)[2], const int (&CA2)[2], unsigned (&go)[2][2], unsigned rowbytes) const {
        const int r0 = (u.pm - __builtin_amdgcn_readfirstlane(tab[u.e])) * BM, cnt = __builtin_amdgcn_readfirstlane(tab[40 + u.e]);
#pragma unroll
        for (int h = 0; h < 2; ++h)
#pragma unroll
            for (int i = 0; i < 2; ++i) { const int r = r0 + h * HALF + RA[i]; const int tok = (r < cnt) ? list[u.e * NTOK + r] : 0; go[h][i] = (unsigned)tok * rowbytes + (unsigned)CA2[i]; }
    }
};

__device__ __forceinline__ unsigned cvt_pk_bf16(float lo, float hi) { unsigned r; asm volatile("v_cvt_pk_bf16_f32 %0, %1, %2" : "=v"(r) : "v"(lo), "v"(hi)); return r; }
__device__ __forceinline__ f32x2 gelu_pk(f32x2 v) {
    const f32x2 av = __builtin_elementwise_abs(v), d = av * 0.2316418882f + 1.0f;
    f32x2 t; t.x = __builtin_amdgcn_rcpf(d.x); t.y = __builtin_amdgcn_rcpf(d.y);
    f32x2 q = t * 0.5307027145f + (-0.7265760135f); q = q * t + 0.7107068705f; q = q * t + (-0.142248368f); q = q * t + 0.127414796f; q = q * t;
    const f32x2 s = (v * v) * (-0.72134752044f);
    f32x2 e; e.x = __builtin_amdgcn_exp2f(s.x); e.y = __builtin_amdgcn_exp2f(s.y);
    const f32x2 m = v * (q * e), r = v - m;
    f32x2 o; o.x = v.x < 0.f ? m.x : r.x; o.y = v.y < 0.f ? m.y : r.y; return o;
}
__device__ __forceinline__ float gelu1(float v) { return gelu_pk((f32x2){v, v}).x; }

struct EpiProj {
    static constexpr bool PERM = true;
    bf16_t* O;
    __device__ __forceinline__ void operator()(const f32x4 (&acc)[2][2][4][2], const Unit& u, int wr, int wc, int fr, int fq) const {
        const int row0 = u.pm * BM + wr * 64 + fr, col0 = u.pn * BM + wc * 32 + 8 * fq; const float sc = (u.pn < 2) ? QSCALE : 1.0f;
#pragma unroll
        for (int ai = 0; ai < 2; ++ai)
#pragma unroll
            for (int m = 0; m < 4; ++m) { bf16_t* rowp = O + (size_t)(row0 + ai * HALF + m * 16) * INW + col0;
#pragma unroll
                for (int bj = 0; bj < 2; ++bj) { const f32x4 v0 = acc[ai][bj][m][0] * sc, v1 = acc[ai][bj][m][1] * sc;
                    u32x4 w; w.x = cvt_pk_bf16(v0[0], v0[1]); w.y = cvt_pk_bf16(v0[2], v0[3]); w.z = cvt_pk_bf16(v1[0], v1[1]); w.w = cvt_pk_bf16(v1[2], v1[3]);
                    *(u32x4*)(rowp + bj * HALF) = w; } }
    }
};
struct EpiH1 {
    static constexpr bool PERM = false;
    const float* X; float* C;
    __device__ __forceinline__ void operator()(const f32x4 (&acc)[2][2][4][2], const Unit& u, int wr, int wc, int fr, int fq) const {
        const int row0 = u.pm * BM + wr * 64 + fr, col0 = u.pn * BM + wc * 32 + 4 * fq;
#pragma unroll
        for (int ai = 0; ai < 2; ++ai)
#pragma unroll
            for (int m = 0; m < 4; ++m) { const size_t off = (size_t)(row0 + ai * HALF + m * 16) * DM + col0;
#pragma unroll
                for (int bj = 0; bj < 2; ++bj)
#pragma unroll
                    for (int n = 0; n < 2; ++n) { const f32x4 xv = *(const f32x4*)(X + off + bj * HALF + n * 16); *(f32x4*)(C + off + bj * HALF + n * 16) = xv * ALPHA + acc[ai][bj][m][n]; } }
    }
};
struct EpiSwiglu {
    static constexpr bool PERM = true;
    bf16_t* O; const float* bias;
    __device__ __forceinline__ void operator()(const f32x4 (&acc)[2][2][4][2], const Unit& u, int wr, int wc, int fr, int fq) const {
        const int row0 = u.pm * BM + wr * 64 + fr, col0 = u.pn * HALF + wc * 32 + 8 * fq;
        const float* bp = bias + (size_t)u.e * (2 * DFF) + col0;
        f32x4 bg[2], bl[2];
#pragma unroll
        for (int n = 0; n < 2; ++n) { bg[n] = *(const f32x4*)(bp + 4 * n); bl[n] = *(const f32x4*)(bp + DFF + 4 * n); }
#pragma unroll
        for (int ai = 0; ai < 2; ++ai)
#pragma unroll
            for (int m = 0; m < 4; ++m) { float a8[8];
#pragma unroll
                for (int n = 0; n < 2; ++n) { const f32x4 g4 = acc[ai][0][m][n] + bg[n], l4 = acc[ai][1][m][n] + bl[n];
#pragma unroll
                    for (int j = 0; j < 4; ++j) { const float g = fminf(g4[j], 7.0f), l = fminf(fmaxf(l4[j], -7.0f), 7.0f);
                        const float sg = __builtin_amdgcn_rcpf(1.0f + __builtin_amdgcn_exp2f(g * (-1.702f * 1.4426950408889634f)));
                        a8[4 * n + j] = (l + 1.0f) * g * sg; } }
                u32x4 w; w.x = cvt_pk_bf16(a8[0], a8[1]); w.y = cvt_pk_bf16(a8[2], a8[3]); w.z = cvt_pk_bf16(a8[4], a8[5]); w.w = cvt_pk_bf16(a8[6], a8[7]);
                *(u32x4*)(O + (size_t)(row0 + ai * HALF + m * 16) * DFF + col0) = w; }
    }
};
struct EpiDown {
    static constexpr bool PERM = true;
    bf16_t* O; const float* bias;
    __device__ __forceinline__ void operator()(const f32x4 (&acc)[2][2][4][2], const Unit& u, int wr, int wc, int fr, int fq) const {
        const int row0 = u.pm * BM + wr * 64 + fr, col0 = u.pn * BM + wc * 32 + 8 * fq;
        const float* bp = bias + (size_t)u.e * DM + col0;
        f32x4 bv[2][2];
#pragma unroll
        for (int bj = 0; bj < 2; ++bj)
#pragma unroll
            for (int n = 0; n < 2; ++n) bv[bj][n] = *(const f32x4*)(bp + bj * HALF + 4 * n);
#pragma unroll
        for (int ai = 0; ai < 2; ++ai)
#pragma unroll
            for (int m = 0; m < 4; ++m) { bf16_t* rowp = O + (size_t)(row0 + ai * HALF + m * 16) * DM + col0;
#pragma unroll
                for (int bj = 0; bj < 2; ++bj) { const f32x4 v0 = acc[ai][bj][m][0] + bv[bj][0], v1 = acc[ai][bj][m][1] + bv[bj][1];
                    u32x4 w; w.x = cvt_pk_bf16(v0[0], v0[1]); w.y = cvt_pk_bf16(v0[2], v0[3]); w.z = cvt_pk_bf16(v1[0], v1[1]); w.w = cvt_pk_bf16(v1[2], v1[3]);
                    *(u32x4*)(rowp + bj * HALF) = w; } }
    }
};

__device__ __forceinline__ unsigned pk4_fp8(float a, float b, float c, float d) { int w = 0; w = __builtin_amdgcn_cvt_pk_fp8_f32(a, b, w, false); w = __builtin_amdgcn_cvt_pk_fp8_f32(c, d, w, true); return (unsigned)w; }
typedef unsigned u32x2 __attribute__((ext_vector_type(2)));
struct EpiSwiglu8 {
    static constexpr bool PERM = true;
    unsigned char* O; const float* bias;
    __device__ __forceinline__ void operator()(const f32x4 (&acc)[2][2][4][2], const Unit& u, int wr, int wc, int fr, int fq) const {
        const int row0 = u.pm * BM + wr * 64 + fr, col0 = u.pn * HALF + wc * 32 + 8 * fq;
        const float* bp = bias + (size_t)u.e * (2 * DFF) + col0;
        f32x4 bg[2], bl[2];
#pragma unroll
        for (int n = 0; n < 2; ++n) { bg[n] = *(const f32x4*)(bp + 4 * n); bl[n] = *(const f32x4*)(bp + DFF + 4 * n); }
#pragma unroll
        for (int ai = 0; ai < 2; ++ai)
#pragma unroll
            for (int m = 0; m < 4; ++m) { float a8[8];
#pragma unroll
                for (int n = 0; n < 2; ++n) { const f32x4 g4 = acc[ai][0][m][n] + bg[n], l4 = acc[ai][1][m][n] + bl[n];
#pragma unroll
                    for (int j = 0; j < 4; ++j) { const float g = fminf(g4[j], 7.0f), l = fminf(fmaxf(l4[j], -7.0f), 7.0f);
                        const float sg = __builtin_amdgcn_rcpf(1.0f + __builtin_amdgcn_exp2f(g * (-1.702f * 1.4426950408889634f)));
                        a8[4 * n + j] = (l + 1.0f) * g * sg; } }
                u32x2 w; w.x = pk4_fp8(a8[0], a8[1], a8[2], a8[3]); w.y = pk4_fp8(a8[4], a8[5], a8[6], a8[7]);
                *(u32x2*)(O + (size_t)(row0 + ai * HALF + m * 16) * DFF + col0) = w; }
    }
};

struct EpiDown8 {
    static constexpr bool PERM = true;
    unsigned char* O; const float* bias;
    __device__ __forceinline__ void operator()(const f32x4 (&acc)[2][2][4][2], const Unit& u, int wr, int wc, int fr, int fq) const {
        const int row0 = u.pm * BM + wr * 64 + fr, col0 = u.pn * BM + wc * 32 + 8 * fq;
        const float* bp = bias + (size_t)u.e * DM + col0;
        f32x4 bv[2][2];
#pragma unroll
        for (int bj = 0; bj < 2; ++bj)
#pragma unroll
            for (int n = 0; n < 2; ++n) bv[bj][n] = *(const f32x4*)(bp + bj * HALF + 4 * n);
#pragma unroll
        for (int ai = 0; ai < 2; ++ai)
#pragma unroll
            for (int m = 0; m < 4; ++m) { unsigned char* rowp = O + (size_t)(row0 + ai * HALF + m * 16) * DM + col0;
#pragma unroll
                for (int bj = 0; bj < 2; ++bj) { const f32x4 v0 = acc[ai][bj][m][0] + bv[bj][0], v1 = acc[ai][bj][m][1] + bv[bj][1];
                    u32x2 w; w.x = pk4_fp8(v0[0], v0[1], v0[2], v0[3]); w.y = pk4_fp8(v1[0], v1[1], v1[2], v1[3]);
                    *(u32x2*)(rowp + bj * HALF) = w; } }
    }
};

template <class Epi, class Sched, bool GATHER, bool FP8 = false>
__device__ __forceinline__ void gemm_phase(PG8_LAS unsigned char* lds, const Gemm g, const Sched& S, const Epi& E) {
    int tid_ = threadIdx.x; asm volatile("" : "+v"(tid_));
    const int tid = tid_, wid = __builtin_amdgcn_readfirstlane(tid >> 6), lane = tid & 63, wr = wid >> 2, wc = wid & 3, fr = lane & 15, fq = lane >> 4;
    const int K = FP8 ? g.K / 2 : g.K, nt = K / BK;
    unsigned voffB[2]; int RA[2], CA2[2]; unsigned voffA[2];
#pragma unroll
    for (int i = 0; i < 2; ++i) { int R, C; stage_rc(tid * 16 + i * 8192, R, C); const int Rb = Epi::PERM ? ((R & ~31) + perm32(R & 31)) : R;
        voffA[i] = (unsigned)(R * K + C) * 2u; voffB[i] = (unsigned)(Rb * K + C) * 2u; RA[i] = R; CA2[i] = C * 2; }
    const size_t kstep = (size_t)(BK * 2);
    const size_t hstep = (size_t)HALF * K * 2;
    const size_t tstep = 2 * hstep;
    const unsigned ldsw = (unsigned)wid * 1024u;
    const int aoff = lds_byte(wr * 64 + fr, fq * 8), boff = lds_byte(wc * 32 + fr, fq * 8);
    const unsigned lds0 = (unsigned)(uintptr_t)lds;
#define PG8_SA(b, h) (((b) * 2 + (h)) * HTB)
#define PG8_SB(b, h) ((4 + (b) * 2 + (h)) * HTB)
#define PG8_GLDS(sbase, voff, ldsoff) do { unsigned keep_; asm volatile("s_mov_b32 %0, m0\n\ts_mov_b32 m0, %3\n\ts_nop 0\n\tglobal_load_lds_dwordx4 %1, %2\n\ts_mov_b32 m0, %0" \
        : "=&s"(keep_) : "v"(voff), "s"(sbase), "s"((unsigned)__builtin_amdgcn_readfirstlane((int)(lds0 + (unsigned)(ldsoff)))) : "memory"); } while (0)
#define PG8_STAGE_B(bufoff, gbase) do { PG8_GLDS((const char*)(gbase), voffB[0], (bufoff) + ldsw); PG8_GLDS((const char*)(gbase), voffB[1], (bufoff) + ldsw + 8192); } while (0)
#define PG8_STAGE_A(bufoff, gbase, o0, o1) do { PG8_GLDS((const char*)(gbase), (o0), (bufoff) + ldsw); PG8_GLDS((const char*)(gbase), (o1), (bufoff) + ldsw + 8192); } while (0)
#define PG8_LDA(dst, b, h) do { _Pragma("unroll") for (int m = 0; m < 4; ++m) _Pragma("unroll") for (int k = 0; k < 2; ++k) dst[m][k] = *(const PG8_LAS bf16x8*)(lds + PG8_SA(b, h) + aoff + m * 2048 + k * 1024); } while (0)
#define PG8_LDB(dst, b, h) do { _Pragma("unroll") for (int n = 0; n < 2; ++n) _Pragma("unroll") for (int k = 0; k < 2; ++k) dst[n][k] = *(const PG8_LAS bf16x8*)(lds + PG8_SB(b, h) + boff + n * 2048 + k * 1024); } while (0)
#define PG8_LD8(p) __builtin_shufflevector(*(const PG8_LAS v4i_t*)(p), *(const PG8_LAS v4i_t*)((p) + 1024), 0, 1, 2, 3, 4, 5, 6, 7)
#define PG8_LDA8(dst, b, h) do { _Pragma("unroll") for (int m = 0; m < 4; ++m) dst[m] = PG8_LD8(lds + PG8_SA(b, h) + aoff + m * 2048); } while (0)
#define PG8_LDB8(dst, b, h) do { _Pragma("unroll") for (int n = 0; n < 2; ++n) dst[n] = PG8_LD8(lds + PG8_SB(b, h) + boff + n * 2048); } while (0)
#define PG8_MMA(ai, bj, At, Bt) do { __builtin_amdgcn_s_setprio(1); \
        if constexpr (FP8) { _Pragma("unroll") for (int m = 0; m < 4; ++m) _Pragma("unroll") for (int n = 0; n < 2; ++n) \
            acc[ai][bj][m][n] = __builtin_amdgcn_mfma_scale_f32_16x16x128_f8f6f4(Bt##8[n], At##8[m], acc[ai][bj][m][n], 0, 0, 0, WSCALE_E8M0, 0, 0x7f7f7f7f); \
              \
            _Pragma("unroll") for (int m = 0; m < 4; ++m) _Pragma("unroll") for (int n = 0; n < 2; ++n) asm volatile("" : "+v"(acc[ai][bj][m][n])); } \
        else { _Pragma("unroll") for (int m = 0; m < 4; ++m) _Pragma("unroll") for (int n = 0; n < 2; ++n) _Pragma("unroll") for (int k = 0; k < 2; ++k) \
            acc[ai][bj][m][n] = __builtin_amdgcn_mfma_f32_16x16x32_bf16(Bt[n][k], At[m][k], acc[ai][bj][m][n], 0, 0, 0); } \
        __builtin_amdgcn_s_setprio(0); } while (0)
#define PG8_XLDA(dst, b, h) do { if constexpr (FP8) PG8_LDA8(dst##8, b, h); else PG8_LDA(dst, b, h); } while (0)
#define PG8_XLDB(dst, b, h) do { if constexpr (FP8) PG8_LDB8(dst##8, b, h); else PG8_LDB(dst, b, h); } while (0)
#define PG8_WAIT_V(n) asm volatile("s_waitcnt vmcnt(" #n ")" ::: "memory")
#define PG8_WAIT_L(n) asm volatile("s_waitcnt lgkmcnt(" #n ")" ::: "memory")
#define PG8_BAR __builtin_amdgcn_s_barrier()
#define PG8_SCHED __builtin_amdgcn_sched_barrier(0)
    Unit cur, nxt; int ui = 0;
    if (!S.next(0, cur)) return;
    f32x4 acc[2][2][4][2];
#pragma unroll
    for (int a = 0; a < 2; ++a)
#pragma unroll
        for (int b = 0; b < 2; ++b)
#pragma unroll
            for (int m = 0; m < 4; ++m)
#pragma unroll
                for (int n = 0; n < 2; ++n) acc[a][b][m][n] = (f32x4){0.f, 0.f, 0.f, 0.f};
    bf16x8 At[4][2], B0[2][2], B1[2][2]; v8i_t At8[4], B08[2], B18[2];
    const char* cA = GATHER ? (const char*)g.A : (const char*)g.A + (size_t)cur.pm * tstep;
    const char* cB = (const char*)g.Bt + ((size_t)cur.e * g.strideB) * 2 + (size_t)cur.pn * tstep;
    unsigned gc[2][2], gn[2][2];
    if constexpr (GATHER) { S.gather(cur, RA, CA2, gc, (unsigned)(K * 2)); }
    else {
#pragma unroll
        for (int h = 0; h < 2; ++h)
#pragma unroll
            for (int i = 0; i < 2; ++i) gc[h][i] = (unsigned)(h * hstep) + voffA[i]; }
#pragma unroll
    for (int h = 0; h < 2; ++h)
#pragma unroll
        for (int i = 0; i < 2; ++i) gn[h][i] = gc[h][i];
    PG8_STAGE_B(PG8_SB(0, 0), cB); PG8_STAGE_B(PG8_SB(0, 1), cB + hstep); PG8_STAGE_A(PG8_SA(0, 0), cA, gc[0][0], gc[0][1]); PG8_STAGE_A(PG8_SA(0, 1), cA, gc[1][0], gc[1][1]);
    if (wr == 1) PG8_BAR;
    PG8_WAIT_V(2); PG8_BAR;
    PG8_STAGE_B(PG8_SB(1, 0), cB + kstep); PG8_STAGE_A(PG8_SA(1, 0), cA + kstep, gc[0][0], gc[0][1]); PG8_STAGE_B(PG8_SB(1, 1), cB + hstep + kstep);
    PG8_WAIT_V(6); PG8_BAR;
    for (;;) {
        const bool has_next = S.next(ui + 1, nxt);
        const char* nA = GATHER ? cA : (has_next ? (const char*)g.A + (size_t)nxt.pm * tstep : cA);
        const char* nB = has_next ? (const char*)g.Bt + ((size_t)nxt.e * g.strideB) * 2 + (size_t)nxt.pn * tstep : cB;
        if constexpr (GATHER) { if (has_next) S.gather(nxt, RA, CA2, gn, (unsigned)(K * 2)); }
        for (int t = 0; t < nt; t += 2) {
            const bool last = (t == nt - 2);
            const char* a1 = cA + (size_t)(t + 1) * kstep;
            const char* a2 = last ? nA : cA + (size_t)(t + 2) * kstep; const char* b2 = last ? nB : cB + (size_t)(t + 2) * kstep;
            const char* a3 = a2 + kstep; const char* b3 = b2 + kstep;
            unsigned o00 = gc[0][0], o01 = gc[0][1], o10 = gc[1][0], o11 = gc[1][1];
            if constexpr (GATHER) { if (last) { o00 = gn[0][0]; o01 = gn[0][1]; o10 = gn[1][0]; o11 = gn[1][1]; } }
            PG8_XLDB(B0, 0, 0); PG8_XLDB(B1, 0, 1); PG8_SCHED; PG8_XLDA(At, 0, 0); PG8_STAGE_A(PG8_SA(1, 1), a1, gc[1][0], gc[1][1]);
            PG8_WAIT_V(8); PG8_WAIT_L(0); PG8_BAR; PG8_MMA(0, 0, At, B0); PG8_MMA(0, 1, At, B1); PG8_BAR; PG8_SCHED;
            PG8_XLDA(At, 0, 1); PG8_STAGE_B(PG8_SB(0, 0), b2); PG8_STAGE_B(PG8_SB(0, 1), b2 + hstep); PG8_STAGE_A(PG8_SA(0, 0), a2, o00, o01);
            PG8_WAIT_V(8); PG8_WAIT_L(0); PG8_BAR; PG8_MMA(1, 0, At, B0); PG8_MMA(1, 1, At, B1); PG8_BAR; PG8_SCHED;
            PG8_XLDB(B0, 1, 0); PG8_XLDB(B1, 1, 1); PG8_SCHED; PG8_XLDA(At, 1, 0); PG8_STAGE_A(PG8_SA(0, 1), a2, o10, o11);
            PG8_WAIT_V(8); PG8_WAIT_L(0); PG8_BAR; PG8_MMA(0, 0, At, B0); PG8_MMA(0, 1, At, B1); PG8_BAR; PG8_SCHED;
            PG8_XLDA(At, 1, 1); PG8_STAGE_B(PG8_SB(1, 0), b3); PG8_STAGE_B(PG8_SB(1, 1), b3 + hstep); PG8_STAGE_A(PG8_SA(1, 0), a3, o00, o01);
            PG8_WAIT_V(8); PG8_WAIT_L(0); PG8_BAR; PG8_MMA(1, 0, At, B0); PG8_MMA(1, 1, At, B1); PG8_BAR; PG8_SCHED;
        }
        if (wr == 0) PG8_BAR;
        { int fr_ = fr, fq_ = fq; asm volatile("" : "+v"(fr_), "+v"(fq_));
          E(acc, cur, wr, wc, fr_, fq_); }
        if (!has_next) break;
#pragma unroll
        for (int a = 0; a < 2; ++a)
#pragma unroll
            for (int b = 0; b < 2; ++b)
#pragma unroll
                for (int m = 0; m < 4; ++m)
#pragma unroll
                    for (int n = 0; n < 2; ++n) acc[a][b][m][n] = (f32x4){0.f, 0.f, 0.f, 0.f};
        cur = nxt; cA = nA; cB = nB; ++ui;
#pragma unroll
        for (int h = 0; h < 2; ++h)
#pragma unroll
            for (int i = 0; i < 2; ++i) gc[h][i] = gn[h][i];
        if (wr == 1) PG8_BAR;
    }
    PG8_WAIT_V(0);
    PG8_BAR;
#undef PG8_SA
#undef PG8_SB
#undef PG8_GLDS
#undef PG8_STAGE_A
#undef PG8_STAGE_B
#undef PG8_LDA
#undef PG8_LDB
#undef PG8_MMA
#undef PG8_LD8
#undef PG8_LDA8
#undef PG8_LDB8
#undef PG8_XLDA
#undef PG8_XLDB
#undef PG8_WAIT_V
#undef PG8_WAIT_L
#undef PG8_BAR
#undef PG8_SCHED
}
}

namespace attn_body {
using bf16=__hip_bfloat16;
using bf16x8=__attribute__((ext_vector_type(8)))short;
using s16x4=__attribute__((ext_vector_type(4)))short;
using f32x16=__attribute__((ext_vector_type(16)))float;
using u32x4=__attribute__((ext_vector_type(4)))unsigned;
constexpr int D=64,PQ=INW,PO=DM;
constexpr int NW=8,QBLK=32,QB=QBLK*NW,KVBLK=64,NQB=SEQ/QB;
constexpr int ATTN_UNIT_ROWS=QB;
__device__ __forceinline__ int crow(int r,int hi){return (r&3)+8*(r>>2)+4*hi;}
#define SBAR() __builtin_amdgcn_sched_barrier(0)
__device__ __forceinline__ void cmask(f32x16&p0,f32x16&p1,int jb,int qrel,int hi){
  const float NEG=-INFINITY; int kb=64*jb+4*hi;
  #pragma unroll
  for(int r=0;r<16;++r){int kv=kb+(r&3)+8*(r>>2); if(kv>qrel)p0[r]=NEG; if(kv+32>qrel)p1[r]=NEG;}
}

constexpr int NSLOT=3, SLOTB=8192;
constexpr int LDS_K=0, LDS_V=NSLOT*SLOTB, LDS_WS=2*NSLOT*SLOTB, LDS_OST=LDS_WS+NW*64*4, LDS_BYTES=LDS_OST+NW*4096;
constexpr float C2=0.125f*1.4426950408889634f;
__device__ __forceinline__ void glds16(const void*gsrc,unsigned lds_dst){unsigned keep;
  asm volatile("s_mov_b32 %0, m0\n\ts_mov_b32 m0, %2\n\ts_nop 0\n\tglobal_load_lds_dwordx4 %1, off\n\ts_mov_b32 m0, %0":"=&s"(keep):"v"(gsrc),"s"(lds_dst):"memory");}
__device__ __forceinline__ float max3f(float a,float b,float c){float r;asm("v_max3_f32 %0, %1, %2, %3":"=v"(r):"v"(a),"v"(b),"v"(c));return r;}
__device__ __forceinline__ float max2f(float a,float b){float r;asm("v_max_f32_e32 %0, %1, %2":"=v"(r):"v"(a),"v"(b));return r;}
__device__ __forceinline__ float fadd_s(float a,float b){float r;asm("v_add_f32_e32 %0, %1, %2":"=v"(r):"v"(a),"v"(b));return r;}
__device__ __forceinline__ float fsub_s(float a,float b){float r;asm("v_sub_f32_e32 %0, %1, %2":"=v"(r):"v"(a),"v"(b));return r;}
typedef float f32x2_t __attribute__((ext_vector_type(2))); typedef __bf16 bf16x2_t __attribute__((ext_vector_type(2)));
__device__ __forceinline__ unsigned cvtpk_s(float lo,float hi){f32x2_t v={lo,hi};bf16x2_t b=__builtin_convertvector(v,bf16x2_t);return __builtin_bit_cast(unsigned,b);}
#define WAIT_BAR(N) asm volatile("s_waitcnt vmcnt(" #N ") lgkmcnt(0)\n\ts_barrier":::"memory")

__device__ __forceinline__ void qkt(f32x16&p0,f32x16&p1,const char*Kslot,const bf16x8*qr,const f32x16&negm,int r32,int hi){
  const char*kb=Kslot+hi*1024+r32*16;
  #pragma unroll
  for(int d0=0;d0<4;++d0){
    const bf16x8 b0=*reinterpret_cast<const bf16x8*>(kb+d0*2048);
    const bf16x8 b1=*reinterpret_cast<const bf16x8*>(kb+d0*2048+512);
    if(d0==0){p0=__builtin_amdgcn_mfma_f32_32x32x16_bf16(b0,qr[0],negm,0,0,0);p1=__builtin_amdgcn_mfma_f32_32x32x16_bf16(b1,qr[0],negm,0,0,0);}
    else{p0=__builtin_amdgcn_mfma_f32_32x32x16_bf16(b0,qr[d0],p0,0,0,0);p1=__builtin_amdgcn_mfma_f32_32x32x16_bf16(b1,qr[d0],p1,0,0,0);}}
}
typedef __attribute__((address_space(3))) const char* lds_cptr;
typedef short v4i16_t __attribute__((ext_vector_type(4)));
__device__ __forceinline__ void kload8(bf16x8*kf,lds_cptr kp){
  kf[0]=*(const __attribute__((address_space(3))) bf16x8*)(kp);      kf[1]=*(const __attribute__((address_space(3))) bf16x8*)(kp+512);
  kf[2]=*(const __attribute__((address_space(3))) bf16x8*)(kp+2048); kf[3]=*(const __attribute__((address_space(3))) bf16x8*)(kp+2560);
  kf[4]=*(const __attribute__((address_space(3))) bf16x8*)(kp+4096); kf[5]=*(const __attribute__((address_space(3))) bf16x8*)(kp+4608);
  kf[6]=*(const __attribute__((address_space(3))) bf16x8*)(kp+6144); kf[7]=*(const __attribute__((address_space(3))) bf16x8*)(kp+6656);
}
__device__ __forceinline__ void kload2(bf16x8*kf,lds_cptr kp,int j){ kf[2*j]=*(const __attribute__((address_space(3))) bf16x8*)(kp+j*2048); kf[2*j+1]=*(const __attribute__((address_space(3))) bf16x8*)(kp+j*2048+512); }
__device__ __forceinline__ s16x4 vtr(lds_cptr p){ return __builtin_bit_cast(s16x4,__builtin_amdgcn_ds_read_tr16_b64_v4i16((__attribute__((address_space(3))) v4i16_t*)p)); }
__device__ __forceinline__ float rowmax(const f32x16&p0,const f32x16&p1){
  float a=max3f(p0[0],p0[1],p1[0]),b=max3f(p0[2],p0[3],p1[1]);a=max3f(a,p1[2],p1[3]);
  #pragma unroll
  for(int r=4;r<16;r+=4){a=max3f(a,p0[r],p0[r+1]);b=max3f(b,p0[r+2],p0[r+3]);a=max3f(a,p1[r],p1[r+1]);b=max3f(b,p1[r+2],p1[r+3]);}
  const float m=max2f(a,b);
  auto rr=__builtin_amdgcn_permlane32_swap(__float_as_uint(m),__float_as_uint(m),false,false);
  return max2f(__uint_as_float(rr[0]),__uint_as_float(rr[1]));
}
__device__ __forceinline__ void pv(f32x16*o,int vb,bf16x8 pa0,bf16x8 pa1,bf16x8 pa2,bf16x8 pa3){
  #pragma unroll
  for(int d0=0;d0<2;++d0){s16x4 lo[4],hi[4];
    #pragma unroll
    for(int ks=0;ks<4;++ks){
      asm volatile("ds_read_b64_tr_b16 %0,%1 offset:%c2":"=&v"(lo[ks]):"v"(vb),"i"(d0*4096+ks*1024):"memory");
      asm volatile("ds_read_b64_tr_b16 %0,%1 offset:%c2":"=&v"(hi[ks]):"v"(vb),"i"(d0*4096+ks*1024+512):"memory");}
    asm volatile("s_waitcnt lgkmcnt(0)":::"memory");SBAR();
    #define PK(k) (bf16x8){lo[k][0],lo[k][1],lo[k][2],lo[k][3],hi[k][0],hi[k][1],hi[k][2],hi[k][3]}
    o[d0]=__builtin_amdgcn_mfma_f32_32x32x16_bf16(pa0,PK(0),o[d0],0,0,0);
    o[d0]=__builtin_amdgcn_mfma_f32_32x32x16_bf16(pa1,PK(1),o[d0],0,0,0);
    o[d0]=__builtin_amdgcn_mfma_f32_32x32x16_bf16(pa2,PK(2),o[d0],0,0,0);
    o[d0]=__builtin_amdgcn_mfma_f32_32x32x16_bf16(pa3,PK(3),o[d0],0,0,0);
    #undef PK
  }
}

#ifndef ATTN_STORE16
#define ATTN_STORE16(p,v) (*(u32x4*)(p)=(v))
#endif
template<int THRL> __device__ __forceinline__ void attn_unit(int qb,const bf16*Qb,const bf16*__restrict__ Kb,const bf16*__restrict__ Vb,bf16*Ob,char*shm){
  int tid_=threadIdx.x; asm volatile("":"+v"(tid_));
  const int tid=tid_,lane=tid&63,r32=lane&31,hi=lane>>5; const int wid=__builtin_amdgcn_readfirstlane(tid>>6);
  const int q0=qb*QB;
  const bf16*Qw=Qb+(long)(q0+wid*QBLK)*PQ;
  const bf16*Kh=Kb,*Vh=Vb;
  const unsigned lds0=(unsigned)(uintptr_t)shm;
  float*wsf=(float*)(shm+LDS_WS)+wid*64;
  const bf16*ksrc=Kh+(long)lane*PQ+wid*8;
  const bf16*vsrc=Vh+(long)(16*(wid&3)+(lane>>2))*PQ+(wid>>2)*32+(lane&3)*8;
  const unsigned kdst=lds0+LDS_K+wid*1024, vdst=lds0+LDS_V+wid*1024;
  #define DMA_K(t,slot) glds16(ksrc+(long)(t)*KVBLK*PQ,(unsigned)__builtin_amdgcn_readfirstlane(kdst+(slot)))
  #define DMA_V(t,slot) glds16(vsrc+(long)(t)*KVBLK*PQ,(unsigned)__builtin_amdgcn_readfirstlane(vdst+(slot)))
  const int vb0=(int)(lds0+LDS_V)+((lane>>4)&1)*32+(lane&3)*8+(4*hi+((lane&15)>>2))*64;
  const char*Kbase=shm+LDS_K; bf16x8 kf[8];
  const lds_cptr shm3=(lds_cptr)shm; const lds_cptr kp0=shm3+LDS_K+hi*1024+r32*16; const lds_cptr vp0=shm3+LDS_V+((lane>>4)&1)*32+(lane&3)*8+(4*hi+((lane&15)>>2))*64;
  const int NT=(q0+QB)/KVBLK;
  DMA_K(0,0);DMA_V(0,0);DMA_K(1,SLOTB);
  bf16x8 qr[4];
  #pragma unroll
  for(int d0=0;d0<4;++d0)qr[d0]=*reinterpret_cast<const bf16x8*>(&Qw[(long)r32*PQ+d0*16+hi*8]);
  float mhat=0.f,l_reg=0.f;f32x16 o[2];o[0]=f32x16{};o[1]=f32x16{};f32x16 negm=f32x16{};asm volatile("":"+v"(negm));
  const int qrel=wid*QBLK+r32;
  #define CMASK(P0,P1,t) do{int jb_=(t)-(NT-4); if(jb_>=0)cmask(P0,P1,jb_,qrel,hi);}while(0)
  bool resc=false;
  #define START(P0,P1) do{ const float rm=rowmax(P0,P1); resc=false; \
    { const float dl=rm; mhat=fadd_s(mhat,dl); \
      _Pragma("unroll") for(int r=0;r<16;++r){P0[r]=fsub_s(P0[r],dl);P1[r]=fsub_s(P1[r],dl);} \
      _Pragma("unroll") for(int r=0;r<16;++r)negm[r]=-mhat; asm volatile("":"+v"(negm)); } \
    _Pragma("unroll") for(int r=0;r<16;++r)P0[r]=__builtin_amdgcn_exp2f(P0[r]); }while(0)
  #define RESC() do{ if(resc){ asm volatile("s_waitcnt lgkmcnt(0)":::"memory"); \
      _Pragma("unroll") for(int d_=0;d_<2;++d_) _Pragma("unroll") for(int r=0;r<16;++r)o[d_][r]*=wsf[crow(r,hi)]; } }while(0)
  f32x16 pA0,pA1,pB0,pB1;
  int sl_prev=0,sl_cur=0,sl_next=SLOTB;
  #define ROT() do{sl_prev=sl_cur;sl_cur=sl_next;sl_next=(sl_next==(NSLOT-1)*SLOTB)?0:sl_next+SLOTB;}while(0)
  DMA_K(2,2*SLOTB);
  WAIT_BAR(3);
  qkt(pA0,pA1,Kbase,qr,negm,r32,hi);asm volatile("s_nop 15\n\ts_nop 7":"+v"(pA0),"+v"(pA1));CMASK(pA0,pA1,0);
  START(pA0,pA1);
  _Pragma("unroll") for(int r=0;r<16;++r)pA1[r]=__builtin_amdgcn_exp2f(pA1[r]);
  WAIT_BAR(0);
  DMA_K(3,0);DMA_V(1,SLOTB);
  ROT();
  kload8(kf,kp0+sl_cur);
  WAIT_BAR(2);
  s16x4 vlo[8],vhi[8]; u32x4 pw0,pw1,pw2,pw3;
  #define PKW(P,B) cvtpk_s(P[B],P[B+1])
  #define PAF(k) __builtin_bit_cast(bf16x8,pw##k)
  #define VFR(i) (bf16x8){vlo[i][0],vlo[i][1],vlo[i][2],vlo[i][3],vhi[i][0],vhi[i][1],vhi[i][2],vhi[i][3]}
  #define PIN(x) asm volatile("":"+v"(x))
  #define MX3(a,b,c) __builtin_fmaxf(__builtin_fmaxf((a),(b)),(c))
  #define GAPA(MF,A0,A1,A2,A3,W0,W1,PW) do{ MF; sacc+=A0; sacc+=A1; sacc+=A2; sacc+=A3; PIN(sacc); W0; W1; PIN(PW); SBAR(); }while(0)
  #define EX(v) __builtin_amdgcn_exp2f(v)
  #define GAPB(MF,X,B) do{ MF; X[B]=EX(X[B]); X[B+1]=EX(X[B+1]); X[B+2]=EX(X[B+2]); X[B+3]=EX(X[B+3]); PIN(X); SBAR(); }while(0)
  #define VRD(i) do{ vlo[i]=vtr(vp_+(((i)>>2)*4096+((i)&3)*1024)); vhi[i]=vtr(vp_+(((i)>>2)*4096+((i)&3)*1024+512)); }while(0)
  #define KRD(G,j) do{ if(G){ kload2(kf,kp0+sl_next,j); SBAR(); } }while(0)
  #define STEP(C0,C1,P0,P1,t,GK,GV,GL) do{ SBAR(); \
    const lds_cptr vp_=vp0+sl_prev; \
    VRD(0); SBAR(); float sacc=(P0[0]+P0[1]); \
    GAPA(C0=__builtin_amdgcn_mfma_f32_32x32x16_bf16(kf[0],qr[0],negm,0,0,0), P0[2],P0[3],P0[4],P0[5],     pw0[0]=PKW(P0,0), pw0[1]=PKW(P0,2), pw0); \
    VRD(4); SBAR(); GAPA(C1=__builtin_amdgcn_mfma_f32_32x32x16_bf16(kf[1],qr[0],negm,0,0,0), P0[6],P0[7],P0[8],P0[9],     pw0[2]=PKW(P0,4), pw0[3]=PKW(P0,6), pw0); \
    VRD(1); SBAR(); GAPA(C0=__builtin_amdgcn_mfma_f32_32x32x16_bf16(kf[2],qr[1],C0,0,0,0),   P0[10],P0[11],P0[12],P0[13], pw1[0]=PKW(P0,8), pw1[1]=PKW(P0,10), pw1); \
    VRD(5); SBAR(); GAPA(C1=__builtin_amdgcn_mfma_f32_32x32x16_bf16(kf[3],qr[1],C1,0,0,0),   P0[14],P0[15],P1[0],P1[1],   pw1[2]=PKW(P0,12),pw1[3]=PKW(P0,14), pw1); \
    VRD(2); SBAR(); GAPA(C0=__builtin_amdgcn_mfma_f32_32x32x16_bf16(kf[4],qr[2],C0,0,0,0),   P1[2],P1[3],P1[4],P1[5],     pw2[0]=PKW(P1,0), pw2[1]=PKW(P1,2), pw2); \
    VRD(6); SBAR(); GAPA(C1=__builtin_amdgcn_mfma_f32_32x32x16_bf16(kf[5],qr[2],C1,0,0,0),   P1[6],P1[7],P1[8],P1[9],     pw2[2]=PKW(P1,4), pw2[3]=PKW(P1,6), pw2); \
    VRD(3); SBAR(); GAPA(C0=__builtin_amdgcn_mfma_f32_32x32x16_bf16(kf[6],qr[3],C0,0,0,0),   P1[10],P1[11],P1[12],P1[13], pw3[0]=PKW(P1,8), pw3[1]=PKW(P1,10), pw3); \
    VRD(7); SBAR(); GAPA(C1=__builtin_amdgcn_mfma_f32_32x32x16_bf16(kf[7],qr[3],C1,0,0,0),   P1[14],P1[15],0.f,0.f,       pw3[2]=PKW(P1,12),pw3[3]=PKW(P1,14), pw3); \
    l_reg+=sacc; \
    if(GK){DMA_K((t)+3,sl_cur);} if(GV){DMA_V((t)+1,sl_next);} \
    CMASK(C0,C1,t); \
    { float a=MX3(C0[0],C0[1],C1[0]),b=MX3(C0[2],C0[3],C1[1]); a=MX3(a,C1[2],C1[3]); \
      _Pragma("unroll") for(int r=4;r<16;r+=4){a=MX3(a,C0[r],C0[r+1]);b=MX3(b,C0[r+2],C0[r+3]);a=MX3(a,C1[r],C1[r+1]);b=MX3(b,C1[r+2],C1[r+3]);} \
      float rm=__builtin_fmaxf(a,b); { auto rr=__builtin_amdgcn_permlane32_swap(__float_as_uint(rm),__float_as_uint(rm),false,false); rm=__builtin_fmaxf(__uint_as_float(rr[0]),__uint_as_float(rr[1])); } \
      resc=false; \
      if(__builtin_expect(__any(rm>(float)THRL),0)){ const float dl=__builtin_fmaxf(rm,0.f); mhat+=dl; \
        _Pragma("unroll") for(int r=0;r<16;++r){C0[r]-=dl;C1[r]-=dl;} \
        _Pragma("unroll") for(int r=0;r<16;++r)negm[r]=-mhat; asm volatile("":"+v"(negm)); \
        const float f=__builtin_amdgcn_exp2f(-dl); l_reg*=f; if(hi==0)wsf[r32]=f; resc=true; } } \
    SBAR(); \
    GAPB(o[0]=__builtin_amdgcn_mfma_f32_32x32x16_bf16(PAF(0),VFR(0),o[0],0,0,0), C0,0); \
    GAPB(o[1]=__builtin_amdgcn_mfma_f32_32x32x16_bf16(PAF(0),VFR(4),o[1],0,0,0), C0,4); \
    KRD(GL,0); GAPB(o[0]=__builtin_amdgcn_mfma_f32_32x32x16_bf16(PAF(1),VFR(1),o[0],0,0,0), C0,8); \
    KRD(GL,1); GAPB(o[1]=__builtin_amdgcn_mfma_f32_32x32x16_bf16(PAF(1),VFR(5),o[1],0,0,0), C0,12); \
    KRD(GL,2); GAPB(o[0]=__builtin_amdgcn_mfma_f32_32x32x16_bf16(PAF(2),VFR(2),o[0],0,0,0), C1,0); \
    KRD(GL,3); GAPB(o[1]=__builtin_amdgcn_mfma_f32_32x32x16_bf16(PAF(2),VFR(6),o[1],0,0,0), C1,4); \
    GAPB(o[0]=__builtin_amdgcn_mfma_f32_32x32x16_bf16(PAF(3),VFR(3),o[0],0,0,0), C1,8); \
    GAPB(o[1]=__builtin_amdgcn_mfma_f32_32x32x16_bf16(PAF(3),VFR(7),o[1],0,0,0), C1,12); \
    }while(0)
  int t=1;
  #undef CMASK
  #define CMASK(P0,P1,t) do{}while(0)
  for(;t+5<NT;t+=2){
    STEP(pB0,pB1,pA0,pA1,t,true,true,true);     WAIT_BAR(2); RESC(); ROT();
    STEP(pA0,pA1,pB0,pB1,t+1,true,true,true);   WAIT_BAR(2); RESC(); ROT();
  }
  #undef CMASK
  #define CMASK(P0,P1,t) do{int jb_=(t)-(NT-4); if(jb_>=0)cmask(P0,P1,jb_,qrel,hi);}while(0)
  #define ENDW(tt) do{ if((tt)+3<NT){WAIT_BAR(2);} else if((tt)+2<NT){WAIT_BAR(1);} else {WAIT_BAR(0);} }while(0)
  for(;t+1<NT;t+=2){
    STEP(pB0,pB1,pA0,pA1,t,(t+3<NT),(t+1<NT),(t+1<NT));       ENDW(t);   RESC(); ROT();
    STEP(pA0,pA1,pB0,pB1,t+1,(t+4<NT),(t+2<NT),(t+2<NT));     ENDW(t+1); RESC(); ROT();
  }
  STEP(pB0,pB1,pA0,pA1,NT-1,false,false,false); RESC();
  { float sacc=pB0[0]+pB0[1]; _Pragma("unroll") for(int r=2;r<16;++r)sacc+=pB0[r]; _Pragma("unroll") for(int r=0;r<16;++r)sacc+=pB1[r]; l_reg+=sacc;
    pw0=(u32x4){PKW(pB0,0),PKW(pB0,2),PKW(pB0,4),PKW(pB0,6)};pw1=(u32x4){PKW(pB0,8),PKW(pB0,10),PKW(pB0,12),PKW(pB0,14)};pw2=(u32x4){PKW(pB1,0),PKW(pB1,2),PKW(pB1,4),PKW(pB1,6)};pw3=(u32x4){PKW(pB1,8),PKW(pB1,10),PKW(pB1,12),PKW(pB1,14)};
    SBAR(); pv(o,vb0+sl_cur,PAF(0),PAF(1),PAF(2),PAF(3)); }
  #undef PKW
  #undef PAF
  #undef VFR
  #undef PIN
  #undef MX3
  #undef GAPA
  #undef GAPB
  #undef EX
  #undef VRD
  #undef KRD
  #undef STEP
  #undef ENDW
  {auto rr=__builtin_amdgcn_permlane32_swap(__float_as_uint(l_reg),__float_as_uint(l_reg),false,false);l_reg=__uint_as_float(rr[0])+__uint_as_float(rr[1]);}
  if(hi==0)wsf[32+r32]=l_reg;asm volatile("s_waitcnt lgkmcnt(0)":::"memory");
  float rli[16];
  #pragma unroll
  for(int r=0;r<16;++r)rli[r]=__builtin_amdgcn_rcpf(wsf[32+crow(r,hi)]);
  bf16*Ow=Ob+(long)(q0+wid*QBLK)*PO;
  { bf16*stg=(bf16*)(shm+LDS_OST)+wid*2048;
    #pragma unroll
    for(int r=0;r<16;++r){const int orow=crow(r,hi);
      #pragma unroll
      for(int d0=0;d0<2;++d0)stg[orow*64+d0*32+r32]=__float2bfloat16(o[d0][r]*rli[r]);}
    asm volatile("s_waitcnt lgkmcnt(0)":::"memory");
    #pragma unroll
    for(int i=0;i<4;++i){const int row=i*8+(lane>>3),ch=lane&7; const u32x4 v=*(const u32x4*)(stg+row*64+ch*8); ATTN_STORE16(Ow+(long)row*PO+ch*8,v);} }
  asm volatile("s_waitcnt lgkmcnt(0)\n\ts_barrier":::"memory");
  #undef DMA_K
  #undef DMA_V
  #undef CMASK
  #undef START
  #undef RESC
  #undef ROT
}
constexpr int ATTN_LDS_BYTES=LDS_BYTES;
template<int THRL=8> __device__ __forceinline__ void attn_phase(char*lds,const bf16_t*proj,bf16_t*atto,int vcu){
  const int bh=vcu>>3,s8=vcu&7,b=bh>>2,h=bh&3;
  const bf16*P0=(const bf16*)proj+(long)b*SEQ*PQ; bf16*O0=(bf16*)atto+(long)b*SEQ*PO;
  for(int i=0;i<8;++i){ const int qb=(i<4)?(15-s8):s8, sub=i&3, st=sub>>1, vh=sub&1;
    attn_unit<THRL>(qb,P0+C_Q+st*256+h*64,P0+C_K+st*256+h*64,P0+C_V+h*128+vh*64,O0+h*256+st*128+vh*64,lds); }
}
#undef SBAR
#undef WAIT_BAR
}

constexpr int NWAVES = 8;
constexpr int RING_OFF = 0, RING_BYTES = 131072;
constexpr int LDSCTL_OFF = RING_BYTES, MISC_OFF = LDSCTL_OFF + 320;
constexpr int TAB_OFF = LDSCTL_OFF + 1024;
constexpr int REC_OFF = LDSCTL_OFF + 2048;
constexpr int LDS_BYTES = 147456;
static_assert(REC_OFF + (64 + 512) * 4 <= LDS_BYTES, "LDS map");

#define GAS __attribute__((address_space(1)))
#define LAS __attribute__((address_space(3)))
typedef unsigned v4u __attribute__((ext_vector_type(4)));
typedef unsigned v2u __attribute__((ext_vector_type(2)));
typedef float f32x4 __attribute__((ext_vector_type(4)));
typedef float f32x2 __attribute__((ext_vector_type(2)));
typedef short bf16x8 __attribute__((ext_vector_type(8)));
typedef GAS unsigned gu32;
#define RLX_AGENT __ATOMIC_RELAXED, __HIP_MEMORY_SCOPE_AGENT
#define LDS_WAIT() asm volatile("s_waitcnt lgkmcnt(0)" ::: "memory")
#define VM_WAIT() asm volatile("s_waitcnt vmcnt(0)" ::: "memory")

#define XB_TMO      128
#define XB_XCNT(j)  (256  + 64 * (j))
#define XB_XSUB(j)  (1280 + 64 * (j))
#define XB_XGEN(j)  (2304 + 64 * (j))
#define XB_TOP      3328
#define XB_TOPGEN   3392
#define XCD_BAR_WORDS 3456
#define XB_SPIN_CAP (1u << 18)
__device__ __forceinline__ unsigned xb_ld(unsigned* p)              { return __hip_atomic_load(p, __ATOMIC_RELAXED, __HIP_MEMORY_SCOPE_AGENT); }
__device__ __forceinline__ unsigned xb_add(unsigned* p, unsigned v) { return __hip_atomic_fetch_add(p, v, __ATOMIC_RELAXED, __HIP_MEMORY_SCOPE_AGENT); }
__device__ __forceinline__ unsigned xb_xcc_id() { return (unsigned)__builtin_amdgcn_s_getreg((3 << 11) | 20) & 0xFu; }
#define XB_SPIN(cond, bar) do { unsigned _sp = 0; while (cond) { __builtin_amdgcn_s_sleep(1); \
    if ((++_sp & 255u) == 0u) { if (xb_ld(&(bar)[XB_TMO])) break; if (_sp > XB_SPIN_CAP) { atomicAdd(&(bar)[XB_TMO], 1u); break; } } } } while (0)
struct XcdBarrier { unsigned* bar; unsigned x; volatile LAS unsigned* st; };
__device__ __forceinline__ XcdBarrier xcd_barrier_post(unsigned* bar, volatile LAS unsigned* st) {
    XcdBarrier b; b.bar = bar; b.x = xb_xcc_id(); b.st = st;
    if (threadIdx.x == 0) (void)xb_add(&bar[XB_XCNT(b.x)], 1u);
    return b;
}
__device__ __forceinline__ void xcd_barrier_complete(unsigned* bar, unsigned x, unsigned& nloc, unsigned& nx) {
    const unsigned G = gridDim.x * gridDim.y * gridDim.z;
    unsigned sum, cnt, mine, sp = 0u;
    for (;;) {
        sum = 0u; cnt = 0u; mine = 0u;
#pragma unroll
        for (unsigned j = 0; j < 16; ++j) { const unsigned c = xb_ld(&bar[XB_XCNT(j)]); sum += c; cnt += (c > 0u) ? 1u : 0u; mine = (j == x) ? c : mine; }
        if (sum == G) break;
        __builtin_amdgcn_s_sleep(1);
        if ((++sp & 255u) == 0u) { if (xb_ld(&bar[XB_TMO])) break; if (sp > XB_SPIN_CAP) { atomicAdd(&bar[XB_TMO], 1u); break; } }
    }
    nloc = mine > 0u ? mine : 1u; nx = cnt > 0u ? cnt : 1u;
}
__device__ __forceinline__ void xcd_barrier(const XcdBarrier& b) {
    asm volatile("s_waitcnt vmcnt(0)" ::: "memory");
    __syncthreads();
    if (threadIdx.x == 0) {
        unsigned* bar = b.bar;
        __builtin_amdgcn_s_waitcnt(0);
        unsigned nloc = b.st[0], nx = b.st[1];
        if (nloc == 0u) { xcd_barrier_complete(bar, b.x, nloc, nx); b.st[0] = nloc; b.st[1] = nx; }
        const unsigned old = xb_add(&bar[XB_XSUB(b.x)], 1u);
        const unsigned gen = old / nloc;
        if (old + 1u == (gen + 1u) * nloc) {
            __builtin_amdgcn_fence(__ATOMIC_RELEASE, "agent");
            asm volatile("s_waitcnt vmcnt(0)" ::: "memory");
            const unsigned og = xb_add(&bar[XB_TOP], 1u);
            const unsigned tg = og / nx;
            if (og + 1u == (tg + 1u) * nx) xb_add(&bar[XB_TOPGEN], 1u);
            else XB_SPIN(xb_ld(&bar[XB_TOPGEN]) == tg, bar);
            __builtin_amdgcn_fence(__ATOMIC_ACQUIRE, "agent");
            xb_add(&bar[XB_XGEN(b.x)], 1u);
            asm volatile("s_waitcnt vmcnt(0)" ::: "memory");
        } else {
            XB_SPIN(xb_ld(&bar[XB_XGEN(b.x)]) == gen, bar);
            __builtin_amdgcn_fence(__ATOMIC_ACQUIRE, "agent");
            asm volatile("s_waitcnt vmcnt(0)" ::: "memory");
        }
    }
    __syncthreads();
}

struct Args { const float* in[22]; float* out; unsigned char* ws; int ph_lo, ph_hi, pad0, pad1; };
struct Frame {
    LAS unsigned char* lds; volatile LAS unsigned* MISC; gu32* ctl;
    int tid, lane, wave, vcu, G;
};

typedef const __attribute__((address_space(4))) Args* kargs_t;
__device__ __forceinline__ Args fetch_args() {
    kargs_t kp = (kargs_t)__builtin_amdgcn_kernarg_segment_ptr();
    asm volatile("" : "+s"(kp));
    Args a;
#pragma unroll
    for (int i = 0; i < 22; ++i) a.in[i] = kp->in[i];
    a.out = kp->out; a.ws = kp->ws; a.ph_lo = kp->ph_lo; a.ph_hi = kp->ph_hi; a.pad0 = kp->pad0; a.pad1 = kp->pad1;
    return a;
}
__device__ __forceinline__ void refresh_frame(Frame& F) { int t = threadIdx.x; asm volatile("" : "+v"(t)); F.tid = t; F.lane = t & 63; F.wave = __builtin_amdgcn_readfirstlane(t >> 6); }

__device__ __forceinline__ void p0_transpose_item(const float* W, int K, int N, bf16_t* WT, long row_off, LAS float* scr, int item, int lane) {
    const int nblk = N / 32, kb = item / nblk, nb = item % nblk, k0 = 64 * kb, n0 = 32 * nb;
#pragma unroll 8
    for (int i = 0; i < 32; ++i) { const int kk = 2 * i + (lane >> 5); scr[kk * 33 + (lane & 31)] = W[(size_t)(k0 + kk) * N + n0 + (lane & 31)]; }
    LDS_WAIT(); asm volatile("" ::: "memory");
    const int c = lane & 7;
#pragma unroll
    for (int j = 0; j < 4; ++j) { const int n = (lane >> 3) + 8 * j; const LAS float* s = scr + (8 * c) * 33 + n;
        v4u o; o.x = pk2(s[0 * 33], s[1 * 33]); o.y = pk2(s[2 * 33], s[3 * 33]); o.z = pk2(s[4 * 33], s[5 * 33]); o.w = pk2(s[6 * 33], s[7 * 33]);
        *(GAS v4u*)(WT + (size_t)(row_off + n0 + n) * K + k0 + 8 * c) = o; }
    LDS_WAIT(); asm volatile("" ::: "memory");
}
__device__ __forceinline__ void p0_transpose_item8(const float* W, int K, int N, unsigned char* WT, long row_off, LAS float* scr, int item, int lane) {
    const int nblk = N / 32, kb = item / nblk, nb = item % nblk, k0 = 64 * kb, n0 = 32 * nb;
#pragma unroll 8
    for (int i = 0; i < 32; ++i) { const int kk = 2 * i + (lane >> 5); scr[kk * 33 + (lane & 31)] = W[(size_t)(k0 + kk) * N + n0 + (lane & 31)]; }
    LDS_WAIT(); asm volatile("" ::: "memory");
    const int c = lane & 3; constexpr float SC = (float)(1 << pg8::WSHIFT);
#pragma unroll
    for (int j = 0; j < 2; ++j) { const int n = (lane >> 2) + 16 * j; const LAS float* s = scr + (16 * c) * 33 + n;
        v4u o; o.x = pg8::pk4_fp8(s[0 * 33] * SC, s[1 * 33] * SC, s[2 * 33] * SC, s[3 * 33] * SC); o.y = pg8::pk4_fp8(s[4 * 33] * SC, s[5 * 33] * SC, s[6 * 33] * SC, s[7 * 33] * SC);
        o.z = pg8::pk4_fp8(s[8 * 33] * SC, s[9 * 33] * SC, s[10 * 33] * SC, s[11 * 33] * SC); o.w = pg8::pk4_fp8(s[12 * 33] * SC, s[13 * 33] * SC, s[14 * 33] * SC, s[15 * 33] * SC);
        *(GAS v4u*)(WT + (size_t)(row_off + n0 + n) * K + k0 + 16 * c) = o; }
    LDS_WAIT(); asm volatile("" ::: "memory");
}
__device__ __forceinline__ void p0_prologue(Frame& F, const Args& a) {
    LAS float* scr = (LAS float*)(F.lds + RING_OFF + F.wave * 16384);
    const int gw = F.vcu * NWAVES + F.wave, NGW = F.G * NWAVES;
    unsigned char* ws = a.ws;
    constexpr int I_IN = (DM / 64) * (INW / 32), I_O = (DM / 64) * (DM / 32), I_UP1 = (DM / 64) * (2 * DFF / 32), I_DN1 = (DFF / 64) * (DM / 32);
    constexpr int NITEMS = I_IN + I_O + NE * I_UP1 + NE * I_DN1;
    for (int it = gw; it < NITEMS; it += NGW) {
        int r = it;
        if (r < I_IN) { p0_transpose_item(a.in[1], DM, INW, (bf16_t*)(ws + WS_WIN), 0, scr, r, F.lane); continue; } r -= I_IN;
        if (r < I_O) { p0_transpose_item(a.in[11], DM, DM, (bf16_t*)(ws + WS_WO), 0, scr, r, F.lane); continue; } r -= I_O;
        if (r < NE * I_UP1) { const int e = r / I_UP1, ii = r % I_UP1; const int n0 = 32 * (ii % (2 * DFF / 32));
            const int bj = n0 / DFF, f = n0 % DFF, rho0 = 256 * (f / 128) + 128 * bj + (f % 128);
#if MOE_FP8
            p0_transpose_item8(a.in[16] + (size_t)e * DM * 2 * DFF, DM, 2 * DFF, (unsigned char*)(ws + WS_WUP) + (size_t)e * 2 * DFF * DM, (long)rho0 - n0, scr, ii, F.lane); continue; }
#else
            p0_transpose_item(a.in[16] + (size_t)e * DM * 2 * DFF, DM, 2 * DFF, (bf16_t*)(ws + WS_WUP) + (size_t)e * 2 * DFF * DM, (long)rho0 - n0, scr, ii, F.lane); continue; }
#endif
        r -= NE * I_UP1;
        { const int e = r / I_DN1, ii = r % I_DN1;
#if MOE_FP8
            p0_transpose_item8(a.in[18] + (size_t)e * DFF * DM, DFF, DM, (unsigned char*)(ws + WS_WDN) + (size_t)e * DM * DFF, 0, scr, ii, F.lane); }
#else
            p0_transpose_item(a.in[18] + (size_t)e * DFF * DM, DFF, DM, (bf16_t*)(ws + WS_WDN) + (size_t)e * DM * DFF, 0, scr, ii, F.lane); }
#endif
    }
    const float* x = a.in[0]; bf16_t* xb = (bf16_t*)(ws + WS_XB);
    for (int m = gw; m < NTOK; m += NGW) {
        const GAS f32x4* xr = (const GAS f32x4*)(x + (size_t)m * DM) + F.lane; GAS v2u* o8 = (GAS v2u*)(xb + (size_t)m * DM) + F.lane;
        f32x4 v[4];
#pragma unroll
        for (int j = 0; j < 4; ++j) v[j] = xr[64 * j];
#pragma unroll
        for (int j = 0; j < 4; ++j) { v2u o; o.x = pk2(v[j].x, v[j].y); o.y = pk2(v[j].z, v[j].w); o8[64 * j] = o; }
    }
}

__device__ __forceinline__ void gmlp_phase(Frame& F, const Args& a) {
    const bf16_t* proj = (const bf16_t*)(a.ws + WS_PROJ); bf16_t* mix = (bf16_t*)(a.ws + WS_MIX);
    const float *lng = a.in[7], *lnb = a.in[8], *wsp = a.in[9], *bsp = a.in[10];
    LAS f32x2* st = (LAS f32x2*)(F.lds + RING_OFF);
    LAS bf16_t* Vg = (LAS bf16_t*)(F.lds + RING_OFF + 1024);
    LAS bf16_t* Wg = (LAS bf16_t*)(F.lds + RING_OFF + 19456);
    LAS float* Zg = (LAS float*)(F.lds + RING_OFF + 54272);
    const int tid = F.tid, lane = F.lane, w = F.wave;
    for (int c = blockIdx.x; c < NTOK / CHUNK; c += F.G) {
        const size_t row0 = (size_t)c * CHUNK;
        for (int s = 16 * w; s < 16 * w + 16; ++s) {
            const v4u raw = *(const GAS v4u*)(proj + (row0 + s) * INW + C_GV + lane * 8);
            const unsigned rw[4] = {raw.x, raw.y, raw.z, raw.w}; float v[8]; float sum = 0.f;
#pragma unroll
            for (int i = 0; i < 4; ++i) { const f32x2 gg = pg8::gelu_pk((f32x2){bf2f((bf16_t)(rw[i] & 0xffff)), bf2f((bf16_t)(rw[i] >> 16))}); v[2 * i] = gg.x; v[2 * i + 1] = gg.y; sum += gg.x + gg.y; }
            const float mean = wave_sum(sum) * (1.0f / GW); float q = 0.f;
#pragma unroll
            for (int i = 0; i < 8; ++i) { const float d = v[i] - mean; q += d * d; }
            const float var = wave_sum(q) * (1.0f / GW);
            if (lane == 0) st[s] = (f32x2){mean, rsqrtf(var + LN_EPS)};
        }
        __syncthreads();
        for (int g = 0; g < NG; ++g) {
            {
                const int row = tid >> 2, cq = (tid & 3) * 16, col = g * GD + cq; const f32x2 ms = st[row];
                const GAS v4u* src = (const GAS v4u*)(proj + (row0 + row) * INW + C_GV + col);
                unsigned ow[8];
#pragma unroll
                for (int hh = 0; hh < 2; ++hh) { const v4u raw = src[hh]; const unsigned rw[4] = {raw.x, raw.y, raw.z, raw.w};
#pragma unroll
                    for (int i = 0; i < 4; ++i) { const f32x2 gg = pg8::gelu_pk((f32x2){bf2f((bf16_t)(rw[i] & 0xffff)), bf2f((bf16_t)(rw[i] >> 16))});
                        const int cc = col + hh * 8 + 2 * i;
                        ow[hh * 4 + i] = pk2((gg.x - ms.x) * ms.y * lng[cc] + lnb[cc], (gg.y - ms.x) * ms.y * lng[cc + 1] + lnb[cc + 1]); } }
                *(LAS v4u*)(Vg + row * 72 + cq) = (v4u){ow[0], ow[1], ow[2], ow[3]};
                *(LAS v4u*)(Vg + row * 72 + cq + 8) = (v4u){ow[4], ow[5], ow[6], ow[7]};
#pragma unroll
                for (int k = 0; k < 8; ++k) { const int i = tid + 512 * k, t = i >> 5, s4 = (i & 31) * 4;
                    const f32x4 wv = *(const GAS f32x4*)(wsp + ((size_t)g * CHUNK + t) * CHUNK + s4);
                    v2u o; o.x = pk2(s4 <= t ? wv.x : 0.f, s4 + 1 <= t ? wv.y : 0.f); o.y = pk2(s4 + 2 <= t ? wv.z : 0.f, s4 + 3 <= t ? wv.w : 0.f);
                    *(LAS v2u*)(Wg + t * 136 + s4) = o; }
            }
            __syncthreads();
            {
                f32x4 acc[4];
#pragma unroll
                for (int n = 0; n < 4; ++n) acc[n] = (f32x4){0.f, 0.f, 0.f, 0.f};
                const int t0 = 16 * w, fr = lane & 15, fq = lane >> 4;
                for (int ks = 0; ks * 32 <= t0 + 15; ++ks) {
                    const bf16x8 af = *(const LAS bf16x8*)(Wg + (t0 + fr) * 136 + ks * 32 + fq * 8);
#pragma unroll
                    for (int n = 0; n < 4; ++n) { bf16x8 bfv;
#pragma unroll
                        for (int j = 0; j < 8; ++j) bfv[j] = (short)Vg[(ks * 32 + fq * 8 + j) * 72 + n * 16 + fr];
                        acc[n] = __builtin_amdgcn_mfma_f32_16x16x32_bf16(af, bfv, acc[n], 0, 0, 0); }
                }
#pragma unroll
                for (int n = 0; n < 4; ++n)
#pragma unroll
                    for (int r = 0; r < 4; ++r) Zg[(t0 + fq * 4 + r) * 68 + n * 16 + fr] = acc[n][r];
            }
            __syncthreads();
            {
                const int row = tid >> 2, cq = (tid & 3) * 16, col = g * GD + cq; const float bb = bsp[g * CHUNK + row];
                const GAS v4u* src = (const GAS v4u*)(proj + (row0 + row) * INW + C_GU + col);
                unsigned ow[8];
#pragma unroll
                for (int hh = 0; hh < 2; ++hh) { const v4u raw = src[hh]; const unsigned rw[4] = {raw.x, raw.y, raw.z, raw.w};
#pragma unroll
                    for (int i = 0; i < 4; ++i) { const f32x2 uu = pg8::gelu_pk((f32x2){bf2f((bf16_t)(rw[i] & 0xffff)), bf2f((bf16_t)(rw[i] >> 16))});
                        const f32x2 zz = *(const LAS f32x2*)(Zg + row * 68 + cq + hh * 8 + 2 * i);
                        ow[hh * 4 + i] = pk2(uu.x * (zz.x + bb), uu.y * (zz.y + bb)); } }
                GAS v4u* dst = (GAS v4u*)(mix + (row0 + row) * DM + GW + col);
                dst[0] = (v4u){ow[0], ow[1], ow[2], ow[3]}; dst[1] = (v4u){ow[4], ow[5], ow[6], ow[7]};
            }
            __syncthreads();
        }
    }
}

__device__ __forceinline__ void attn_combine_phase(Frame& F, const Args& a) {
    const bf16_t* atto = (const bf16_t*)(a.ws + WS_ATTO); bf16_t* mix = (bf16_t*)(a.ws + WS_MIX);
    const int lane = F.lane, gw = F.vcu * NWAVES + F.wave, NGW = F.G * NWAVES;
    const float lam = expf(wave_sum(a.in[2][lane] * a.in[3][lane])) - expf(wave_sum(a.in[4][lane] * a.in[5][lane])) + LAMBDA_INIT;
    const int h = lane >> 4, e0 = (lane & 15) * 8;
    float sg[8];
#pragma unroll
    for (int i = 0; i < 8; ++i) sg[i] = a.in[6][e0 + i] * (1.0f - LAMBDA_INIT);
    for (int t = gw; t < NTOK; t += NGW) {
        const v4u r1 = *(const GAS v4u*)(atto + (size_t)t * DM + h * 256 + e0), r2 = *(const GAS v4u*)(atto + (size_t)t * DM + h * 256 + 128 + e0);
        const unsigned w1[4] = {r1.x, r1.y, r1.z, r1.w}, w2[4] = {r2.x, r2.y, r2.z, r2.w};
        float d[8]; float ss = 0.f;
#pragma unroll
        for (int i = 0; i < 4; ++i) { d[2 * i] = bf2f((bf16_t)(w1[i] & 0xffff)) - lam * bf2f((bf16_t)(w2[i] & 0xffff)); d[2 * i + 1] = bf2f((bf16_t)(w1[i] >> 16)) - lam * bf2f((bf16_t)(w2[i] >> 16)); ss += d[2 * i] * d[2 * i] + d[2 * i + 1] * d[2 * i + 1]; }
        ss += __shfl_xor(ss, 1); ss += __shfl_xor(ss, 2); ss += __shfl_xor(ss, 4); ss += __shfl_xor(ss, 8);
        const float r = rsqrtf(ss * (1.0f / DV) + LN_EPS);
        v4u o; o.x = pk2(d[0] * r * sg[0], d[1] * r * sg[1]); o.y = pk2(d[2] * r * sg[2], d[3] * r * sg[3]); o.z = pk2(d[4] * r * sg[4], d[5] * r * sg[5]); o.w = pk2(d[6] * r * sg[6], d[7] * r * sg[7]);
        *(GAS v4u*)(mix + (size_t)t * DM + h * DV + e0) = o;
    }
}

template <int CTRL> __device__ __forceinline__ float dppf(float v) { return __builtin_bit_cast(float, __builtin_amdgcn_update_dpp(0, __builtin_bit_cast(int, v), CTRL, 0xF, 0xF, true)); }
template <int CTRL> __device__ __forceinline__ int dppi(int v) { return __builtin_amdgcn_update_dpp(0, v, CTRL, 0xF, 0xF, true); }
__device__ __forceinline__ float rlf(float v, int l) { return __builtin_bit_cast(float, __builtin_amdgcn_readlane(__builtin_bit_cast(int, v), l)); }
__device__ __forceinline__ float wsum_dpp(float v) {
    v += dppf<0xB1>(v); v += dppf<0x4E>(v); v += dppf<0x141>(v); v += dppf<0x140>(v);
    return (rlf(v, 0) + rlf(v, 16)) + (rlf(v, 32) + rlf(v, 48));
}
__device__ __forceinline__ float wmax_dpp(float v) {
    v = fmaxf(v, dppf<0xB1>(v)); v = fmaxf(v, dppf<0x4E>(v)); v = fmaxf(v, dppf<0x141>(v)); v = fmaxf(v, dppf<0x140>(v));
    return fmaxf(fmaxf(rlf(v, 0), rlf(v, 16)), fmaxf(rlf(v, 32), rlf(v, 48)));
}
__device__ __forceinline__ int wmin_dpp(int v) {
    v = min(v, dppi<0xB1>(v)); v = min(v, dppi<0x4E>(v)); v = min(v, dppi<0x141>(v)); v = min(v, dppi<0x140>(v));
    return min(min(__builtin_amdgcn_readlane(v, 0), __builtin_amdgcn_readlane(v, 16)), min(__builtin_amdgcn_readlane(v, 32), __builtin_amdgcn_readlane(v, 48)));
}
__device__ __forceinline__ void route_phase(Frame& F, const Args& a) {
    const float* h1 = (const float*)(a.ws + WS_H1); bf16_t* xb = (bf16_t*)(a.ws + WS_XB); bf16_t* x1b = (bf16_t*)(a.ws + WS_X1B);
    int* list = (int*)(a.ws + WS_LIST); int* re = (int*)(a.ws + WS_RE); int* rr = (int*)(a.ws + WS_RR); float* rg = (float*)(a.ws + WS_RG);
    const float *g1 = a.in[12], *b1 = a.in[13], *wr = a.in[14], *br = a.in[15];
    constexpr int XS = 1028;
    LAS float* XT = (LAS float*)(F.lds + RING_OFF);
    LAS float* PT = (LAS float*)(F.lds + RING_OFF + 16 * XS * 4);
    LAS int* lcnt = (LAS int*)(F.lds + REC_OFF); LAS int* lbase = lcnt + 32; LAS int* rec = lcnt + 64;
    const int tid = F.tid, lane = F.lane, w = F.wave, fr = lane & 15, fq = lane >> 4;
    if (tid < 32) lcnt[tid] = 0;
    constexpr int RPB = NTOK / 256;
    const int tblk = blockIdx.x * RPB;
    f32x4 pv[2][4];
#define ROUTE_LOAD(ch_) do { _Pragma("unroll") for (int q = 0; q < 2; ++q) _Pragma("unroll") for (int j = 0; j < 4; ++j) \
        pv[q][j] = *(const GAS f32x4*)(h1 + (size_t)(tblk + (ch_) * 16 + 2 * w + q) * DM + j * 256 + lane * 4); } while (0)
    ROUTE_LOAD(0);
    float bw[32][2];
#pragma unroll
    for (int s = 0; s < 32; ++s)
#pragma unroll
        for (int n = 0; n < 2; ++n) bw[s][n] = wr[(size_t)(128 * w + 4 * s + fq) * NE + 16 * n + fr];
    const int myexp = lane & 31; const float mybr = br[myexp];
    for (int ch = 0; ch < 8; ++ch) {
        const int t0 = tblk + ch * 16;
        {
            float mean[2], rstd[2];
#pragma unroll
            for (int q = 0; q < 2; ++q) { float s = 0.f;
#pragma unroll
                for (int j = 0; j < 4; ++j) s += (pv[q][j].x + pv[q][j].y) + (pv[q][j].z + pv[q][j].w);
                mean[q] = wsum_dpp(s) * (1.0f / DM); }
#pragma unroll
            for (int q = 0; q < 2; ++q) { float q2 = 0.f;
#pragma unroll
                for (int j = 0; j < 4; ++j) { pv[q][j] = pv[q][j] - mean[q]; q2 += (pv[q][j].x * pv[q][j].x + pv[q][j].y * pv[q][j].y) + (pv[q][j].z * pv[q][j].z + pv[q][j].w * pv[q][j].w); }
                rstd[q] = rsqrtf(wsum_dpp(q2) * (1.0f / DM) + LN_EPS); }
#pragma unroll
            for (int j = 0; j < 4; ++j) {
                const int col = j * 256 + lane * 4;
                const f32x4 gq = *(const GAS f32x4*)(g1 + col), bq = *(const GAS f32x4*)(b1 + col);
#pragma unroll
                for (int q = 0; q < 2; ++q) {
                    const int rl = 2 * w + q, t = t0 + rl;
                    const f32x4 o = pv[q][j] * rstd[q] * gq + bq;
                    { v2u pk1; pk1.x = pk2(o.x, o.y); pk1.y = pk2(o.z, o.w); *(GAS v2u*)(x1b + (size_t)t * DM + col) = pk1; }
                    *(LAS f32x4*)(XT + rl * XS + col) = o;
#if MOE_FP8
                    *(GAS unsigned*)((unsigned char*)xb + (size_t)t * DM + col) = pg8::pk4_fp8(o.x, o.y, o.z, o.w);
#else
                    v2u pk; pk.x = pk2(o.x, o.y); pk.y = pk2(o.z, o.w);
                    *(GAS v2u*)(xb + (size_t)t * DM + col) = pk;
#endif
                }
            }
        }
        if (ch < 7) ROUTE_LOAD(ch + 1);
        __syncthreads();
        {
            f32x4 acc0 = (f32x4){0.f, 0.f, 0.f, 0.f}, acc1 = (f32x4){0.f, 0.f, 0.f, 0.f};
            const LAS float* xp = XT + fr * XS + 128 * w + fq;
#pragma unroll
            for (int s = 0; s < 32; ++s) { const float av = xp[4 * s];
                acc0 = __builtin_amdgcn_mfma_f32_16x16x4f32(av, bw[s][0], acc0, 0, 0, 0);
                acc1 = __builtin_amdgcn_mfma_f32_16x16x4f32(av, bw[s][1], acc1, 0, 0, 0); }
#pragma unroll
            for (int r = 0; r < 4; ++r) { PT[(w * 16 + fq * 4 + r) * 32 + fr] = acc0[r]; PT[(w * 16 + fq * 4 + r) * 32 + 16 + fr] = acc1[r]; }
        }
        __syncthreads();
        {
            float cur[2];
#pragma unroll
            for (int q = 0; q < 2; ++q) { cur[q] = mybr;
#pragma unroll
                for (int ww = 0; ww < 8; ++ww) cur[q] += PT[(ww * 16 + 2 * w + q) * 32 + myexp]; }
            int idx[2][4]; float val[2][4];
#pragma unroll
            for (int k = 0; k < 4; ++k)
#pragma unroll
                for (int q = 0; q < 2; ++q) {
                    const float m = wmax_dpp(cur[q]);
                    const int cand = wmin_dpp((cur[q] == m) ? myexp : 99);
                    idx[q][k] = cand; val[q][k] = m; if (myexp == cand) cur[q] = -INFINITY;
                }
#pragma unroll
            for (int q = 0; q < 2; ++q) {
                const int rl = 2 * w + q, t = t0 + rl;
                float ex[4], se = 0.f;
#pragma unroll
                for (int k = 0; k < 4; ++k) { ex[k] = expf(val[q][k] - val[q][0]); se += ex[k]; }
                if (lane < 4) {
                    int e_ = idx[q][0]; float g_ = ex[0];
                    if (lane == 1) { e_ = idx[q][1]; g_ = ex[1]; } else if (lane == 2) { e_ = idx[q][2]; g_ = ex[2]; } else if (lane == 3) { e_ = idx[q][3]; g_ = ex[3]; }
                    const int lr = __hip_atomic_fetch_add(lcnt + e_, 1, __ATOMIC_RELAXED, __HIP_MEMORY_SCOPE_WORKGROUP);
                    rec[(ch * 16 + rl) * 4 + lane] = e_ | (lr << 8);
                    re[t * 4 + lane] = e_; rg[t * 4 + lane] = g_ / se;
                }
            }
        }
    }
#undef ROUTE_LOAD
    __syncthreads();
    if (tid < 32) lbase[tid] = (int)__hip_atomic_fetch_add((unsigned*)(F.ctl + CW_CNT + tid), (unsigned)lcnt[tid], RLX_AGENT);
    __syncthreads();
    { const int rw = tid >> 2, k = tid & 3; const int t = tblk + rw; const int rc = rec[tid]; const int e_ = rc & 255, r_ = lbase[e_] + (rc >> 8);
      rr[t * 4 + k] = r_; list[e_ * NTOK + r_] = t; }
}
__device__ __forceinline__ void build_tab(Frame& F) {
    LAS int* tab = (LAS int*)(F.lds + TAB_OFF);
    if (F.tid < 32) tab[40 + F.tid] = (int)__hip_atomic_load(F.ctl + CW_CNT + F.tid, RLX_AGENT);
    __syncthreads();
    if (F.tid == 0) { int p = 0; for (int e = 0; e < NE; ++e) { tab[e] = p; p += (tab[40 + e] + 255) >> 8; } tab[NE] = p; }
    __syncthreads();
}
__device__ __forceinline__ void combine_phase(Frame& F, const Args& a) {
    const bf16_t* x1 = (const bf16_t*)(a.ws + WS_X1B); const unsigned char* y = (const unsigned char*)(a.ws + WS_Y);
    const int* re = (const int*)(a.ws + WS_RE); const int* rr = (const int*)(a.ws + WS_RR); const float* rg = (const float*)(a.ws + WS_RG);
    float* out = a.out;
    const LAS int* tab = (const LAS int*)(F.lds + TAB_OFF);
    const int lane = F.lane, gw = F.vcu * NWAVES + F.wave, NGW = F.G * NWAVES, c0 = lane * 16;
    f32x4 g2v[4], b2v[4];
#pragma unroll
    for (int j = 0; j < 4; ++j) { g2v[j] = *(const GAS f32x4*)(a.in[20] + c0 + 4 * j); b2v[j] = *(const GAS f32x4*)(a.in[21] + c0 + 4 * j); }
    for (int tt = gw; tt < NTOK; tt += 2 * NGW) {
        float v[2][16];
#pragma unroll
        for (int q = 0; q < 2; ++q) {
            const int t = tt + q * NGW;
            const v4u xa = *(const GAS v4u*)(x1 + (size_t)t * DM + c0), xb_ = *(const GAS v4u*)(x1 + (size_t)t * DM + c0 + 8);
            const unsigned xw[8] = {xa.x, xa.y, xa.z, xa.w, xb_.x, xb_.y, xb_.z, xb_.w};
#pragma unroll
            for (int i = 0; i < 8; ++i) { v[q][2 * i] = ALPHA * bf2f((bf16_t)(xw[i] & 0xffff)); v[q][2 * i + 1] = ALPHA * bf2f((bf16_t)(xw[i] >> 16)); }
#pragma unroll
            for (int k = 0; k < 4; ++k) {
                const int e = re[t * 4 + k], slot = tab[e] * 256 + rr[t * 4 + k]; const float g = rg[t * 4 + k];
#if MOE_FP8
                const v4u yw = *(const GAS v4u*)(y + (size_t)slot * DM + c0); const unsigned yy[4] = {yw.x, yw.y, yw.z, yw.w};
#pragma unroll
                for (int i = 0; i < 4; ++i) { const f32x2 lo = __builtin_amdgcn_cvt_pk_f32_fp8((int)yy[i], false), hi = __builtin_amdgcn_cvt_pk_f32_fp8((int)yy[i], true);
                    v[q][4 * i] = fmaf(g, lo.x, v[q][4 * i]); v[q][4 * i + 1] = fmaf(g, lo.y, v[q][4 * i + 1]); v[q][4 * i + 2] = fmaf(g, hi.x, v[q][4 * i + 2]); v[q][4 * i + 3] = fmaf(g, hi.y, v[q][4 * i + 3]); }
#else
                const v4u ya = *(const GAS v4u*)((const bf16_t*)y + (size_t)slot * DM + c0), yb = *(const GAS v4u*)((const bf16_t*)y + (size_t)slot * DM + c0 + 8);
                const unsigned yy[8] = {ya.x, ya.y, ya.z, ya.w, yb.x, yb.y, yb.z, yb.w};
#pragma unroll
                for (int i = 0; i < 8; ++i) { v[q][2 * i] = fmaf(g, bf2f((bf16_t)(yy[i] & 0xffff)), v[q][2 * i]); v[q][2 * i + 1] = fmaf(g, bf2f((bf16_t)(yy[i] >> 16)), v[q][2 * i + 1]); }
#endif
            }
        }
#pragma unroll
        for (int q = 0; q < 2; ++q) {
            const int t = tt + q * NGW;
            float s = 0.f;
#pragma unroll
            for (int i = 0; i < 16; ++i) s += v[q][i];
            const float mean = wsum_dpp(s) * (1.0f / DM); float q2 = 0.f;
#pragma unroll
            for (int i = 0; i < 16; ++i) { v[q][i] -= mean; q2 += v[q][i] * v[q][i]; }
            const float rstd = rsqrtf(wsum_dpp(q2) * (1.0f / DM) + LN_EPS);
#pragma unroll
            for (int j = 0; j < 4; ++j)
                *(GAS f32x4*)(out + (size_t)t * DM + c0 + 4 * j) = (f32x4){v[q][4 * j] * rstd * g2v[j].x + b2v[j].x, v[q][4 * j + 1] * rstd * g2v[j].y + b2v[j].y, v[q][4 * j + 2] * rstd * g2v[j].z + b2v[j].z, v[q][4 * j + 3] * rstd * g2v[j].w + b2v[j].w};
        }
    }
}

constexpr int N_PHASES = 9;
__global__ void __launch_bounds__(NWAVES * 64, 2) mega_fwd(Args args) {
    extern __shared__ __attribute__((aligned(16))) unsigned char lds[];
    Frame F;
    F.lds = (LAS unsigned char*)lds;
    F.MISC = (volatile LAS unsigned*)(F.lds + MISC_OFF);
    F.tid = threadIdx.x; F.lane = F.tid & 63; F.wave = __builtin_amdgcn_readfirstlane(F.tid >> 6);
    F.G = gridDim.x; { const int bx = blockIdx.x; F.vcu = (F.G % 8 == 0) ? (bx % 8) * (F.G / 8) + bx / 8 : bx; }
    F.ctl = (gu32*)(args.ws + WS_CTL);
    for (int u = F.tid; u < (LDS_BYTES - LDSCTL_OFF) / 4; u += NWAVES * 64) ((LAS unsigned*)(F.lds + LDSCTL_OFF))[u] = 0u;
    __syncthreads();
    const int lo = args.ph_lo, hi = args.ph_hi;
    const bool multi = (hi - lo) > 1;
    XcdBarrier bar; bar.bar = (unsigned*)(F.ctl + CW_BAR); bar.x = 0; bar.st = nullptr;
    if (multi) bar = xcd_barrier_post((unsigned*)(F.ctl + CW_BAR), F.MISC + 8);
#ifndef PH_MASK
#define PH_MASK 0x1FF
#endif
#define IN(k) ((((PH_MASK) >> (k)) & 1) && lo <= (k) && (k) < hi)
#define SEAM(k) do { if (IN(k) && IN((k) + 1)) xcd_barrier(bar); } while (0)
#ifndef DOUBLE_MASK
#define DOUBLE_MASK 0
#endif
#define REP(k) for (int rep_ = 0; rep_ < ((((DOUBLE_MASK) >> (k)) & 1) + 1); ++rep_)
    if (IN(0)) { REP(0) { refresh_frame(F); const Args A = fetch_args(); p0_prologue(F, A); } SEAM(0); }
    if (IN(1)) { REP(1) {
        refresh_frame(F); const Args A = fetch_args(); unsigned char* ws = A.ws;
        pg8::Gemm g{(const bf16_t*)(ws + WS_XB), (const bf16_t*)(ws + WS_WIN), NTOK, INW, DM, 0}; pg8::StaticOrder S; S.init(NTOK, INW, F.G, (int)blockIdx.x);
        pg8::EpiProj E{(bf16_t*)(ws + WS_PROJ)};
        pg8::gemm_phase<pg8::EpiProj, pg8::StaticOrder, false>(F.lds + RING_OFF, g, S, E);
        } SEAM(1);
    }
    if (IN(2)) { REP(2) {
        refresh_frame(F); const Args A = fetch_args(); unsigned char* ws = A.ws;
#ifndef P2_REP_SUB
#define P2_REP_SUB 3
#endif
        const int sub_ = (rep_ == 0) ? A.pad0 : (A.pad0 & P2_REP_SUB);
        if (sub_ & 1) attn_body::attn_phase<8>((char*)lds + RING_OFF, (const bf16_t*)(ws + WS_PROJ), (bf16_t*)(ws + WS_ATTO), F.vcu);
        if (sub_ & 2) gmlp_phase(F, A);
        } SEAM(2);
    }
    if (IN(3)) { REP(3) { refresh_frame(F); const Args A = fetch_args(); attn_combine_phase(F, A); } SEAM(3); }
    if (IN(4)) { REP(4) {
        refresh_frame(F); const Args A = fetch_args(); unsigned char* ws = A.ws;
        pg8::Gemm g{(const bf16_t*)(ws + WS_MIX), (const bf16_t*)(ws + WS_WO), NTOK, DM, DM, 0}; pg8::StaticOrder S; S.init(NTOK, DM, F.G, (int)blockIdx.x);
        pg8::EpiH1 E{A.in[0], (float*)(ws + WS_H1)};
        pg8::gemm_phase<pg8::EpiH1, pg8::StaticOrder, false>(F.lds + RING_OFF, g, S, E);
        } SEAM(4);
    }
    if (IN(5)) { REP(5) { refresh_frame(F); const Args A = fetch_args(); route_phase(F, A); } SEAM(5); }
    if (IN(6)) { REP(6) {
        refresh_frame(F); const Args A = fetch_args(); unsigned char* ws = A.ws;
        build_tab(F);
        pg8::MoeOrder S; S.init((const LAS int*)(F.lds + TAB_OFF), (const int*)(ws + WS_LIST), 8, (int)blockIdx.x);
#if MOE_FP8
        pg8::Gemm g{(const bf16_t*)(ws + WS_XB), (const bf16_t*)(ws + WS_WUP), PADROWS, 2 * DFF, DM, (size_t)2 * DFF * DM / 2};
        pg8::EpiSwiglu8 E{(unsigned char*)(ws + WS_ACT), A.in[17]};
        pg8::gemm_phase<pg8::EpiSwiglu8, pg8::MoeOrder, true, true>(F.lds + RING_OFF, g, S, E);
#else
        pg8::Gemm g{(const bf16_t*)(ws + WS_XB), (const bf16_t*)(ws + WS_WUP), PADROWS, 2 * DFF, DM, (size_t)2 * DFF * DM};
        pg8::EpiSwiglu E{(bf16_t*)(ws + WS_ACT), A.in[17]};
        pg8::gemm_phase<pg8::EpiSwiglu, pg8::MoeOrder, true>(F.lds + RING_OFF, g, S, E);
#endif
        } SEAM(6);
    }
    if (IN(7)) { REP(7) {
        refresh_frame(F); const Args A = fetch_args(); unsigned char* ws = A.ws;
        build_tab(F);
        pg8::MoeOrder S; S.init((const LAS int*)(F.lds + TAB_OFF), (const int*)(ws + WS_LIST), 4, (int)blockIdx.x);
#if MOE_FP8
        pg8::EpiDown8 E{(unsigned char*)(ws + WS_Y), A.in[19]};
        pg8::Gemm g{(const bf16_t*)(ws + WS_ACT), (const bf16_t*)(ws + WS_WDN), PADROWS, DM, DFF, (size_t)DM * DFF / 2};
        pg8::gemm_phase<pg8::EpiDown8, pg8::MoeOrder, false, true>(F.lds + RING_OFF, g, S, E);
#else
        pg8::EpiDown E{(bf16_t*)(ws + WS_Y), A.in[19]};
        pg8::Gemm g{(const bf16_t*)(ws + WS_ACT), (const bf16_t*)(ws + WS_WDN), PADROWS, DM, DFF, (size_t)DM * DFF};
        pg8::gemm_phase<pg8::EpiDown, pg8::MoeOrder, false>(F.lds + RING_OFF, g, S, E);
#endif
        } SEAM(7);
    }
    if (IN(8)) { REP(8) { refresh_frame(F); const Args A = fetch_args(); build_tab(F); combine_phase(F, A); } }
#undef IN
#undef SEAM
}

struct NArgs {
    const float* x; const float* B; const float* bias; const float* bias2;
    const bf16_t* Ab; bf16_t* Ob; float* Of; const int* ctl; const int* list;
};
template <int MODE> __global__ void __launch_bounds__(256) ngemm(NArgs a) {
    constexpr int K = 1024;
    constexpr int LDB = (MODE == 0) ? INW : (MODE == 2 ? 2048 : 1024);
    constexpr bool DUAL = (MODE == 2);
    __shared__ float As[16][68];
    __shared__ float Bs[16][64];
    __shared__ float Bs2[DUAL ? 16 : 1][64];
    const int tid = threadIdx.x, ty = tid >> 4, tx = tid & 15;
    const int row0 = blockIdx.y * 64, col0 = blockIdx.x * 64;
    const float* B = a.B; int e = 0, pst = 0, cnt = 0;
    if (MODE >= 2) {
        const int* ps = a.ctl + CW_PSTART;
        while (e < NE && row0 >= ps[e + 1]) ++e;
        if (e >= NE) return;
        pst = ps[e]; cnt = a.ctl[CW_CNT + e];
        B += (size_t)e * K * LDB;
    }
    const int ar = tid >> 2, ak = (tid & 3) * 4;
    const float* arow_f = nullptr; const bf16_t* arow_b = nullptr;
    if (MODE == 0) arow_f = a.x + (size_t)(row0 + ar) * K;
    else if (MODE == 1 || MODE == 3) arow_b = a.Ab + (size_t)(row0 + ar) * K;
    else { const int r = row0 + ar - pst; const int tok = (r < cnt) ? a.list[e * NTOK + r] : 0; arow_b = a.Ab + (size_t)tok * K; }
    const int bk = tid >> 4, bn = (tid & 15) * 4;
    float acc[4][4], acc2[4][4];
#pragma unroll
    for (int i = 0; i < 4; ++i)
#pragma unroll
        for (int j = 0; j < 4; ++j) { acc[i][j] = 0.f; acc2[i][j] = 0.f; }
    for (int k0 = 0; k0 < K; k0 += 16) {
        float av[4];
        if (MODE == 0) { const float4 t = *(const float4*)(arow_f + k0 + ak); av[0] = t.x; av[1] = t.y; av[2] = t.z; av[3] = t.w; }
        else { const uint2 t = *(const uint2*)(arow_b + k0 + ak); av[0] = bf2f((bf16_t)(t.x & 0xffff)); av[1] = bf2f((bf16_t)(t.x >> 16)); av[2] = bf2f((bf16_t)(t.y & 0xffff)); av[3] = bf2f((bf16_t)(t.y >> 16)); }
        const float4 bv = *(const float4*)(B + (size_t)(k0 + bk) * LDB + col0 + bn);
        float4 bv2 = bv;
        if (DUAL) bv2 = *(const float4*)(B + (size_t)(k0 + bk) * LDB + 1024 + col0 + bn);
        __syncthreads();
#pragma unroll
        for (int c = 0; c < 4; ++c) As[ak + c][ar] = av[c];
        *(float4*)&Bs[bk][bn] = bv;
        if (DUAL) *(float4*)&Bs2[bk][bn] = bv2;
        __syncthreads();
#pragma unroll
        for (int k = 0; k < 16; ++k) {
            const float4 a4 = *(const float4*)&As[k][ty * 4];
            const float4 b4 = *(const float4*)&Bs[k][tx * 4];
            const float aa[4] = {a4.x, a4.y, a4.z, a4.w}, bb[4] = {b4.x, b4.y, b4.z, b4.w};
#pragma unroll
            for (int i = 0; i < 4; ++i)
#pragma unroll
                for (int j = 0; j < 4; ++j) acc[i][j] = fmaf(aa[i], bb[j], acc[i][j]);
            if (DUAL) {
                const float4 c4 = *(const float4*)&Bs2[k][tx * 4];
                const float cc[4] = {c4.x, c4.y, c4.z, c4.w};
#pragma unroll
                for (int i = 0; i < 4; ++i)
#pragma unroll
                    for (int j = 0; j < 4; ++j) acc2[i][j] = fmaf(aa[i], cc[j], acc2[i][j]);
            }
        }
    }
#pragma unroll
    for (int i = 0; i < 4; ++i) {
        const int row = row0 + ty * 4 + i;
#pragma unroll
        for (int j = 0; j < 4; ++j) {
            const int col = col0 + tx * 4 + j;
            if (MODE == 0) { float v = acc[i][j]; if (col < C_K) v *= QSCALE; a.Ob[(size_t)row * INW + col] = f2bf(v); }
            else if (MODE == 1) { a.Of[(size_t)row * DM + col] = ALPHA * a.x[(size_t)row * DM + col] + acc[i][j]; }
            else if (MODE == 2) {
                float g = acc[i][j] + a.bias[e * 2048 + col], l = acc2[i][j] + a.bias[e * 2048 + 1024 + col];
                g = fminf(g, 7.0f); l = fminf(fmaxf(l, -7.0f), 7.0f);
                const float act = (l + 1.0f) * g * (1.0f / (1.0f + expf(-1.702f * g)));
                a.Ob[(size_t)row * DFF + col] = f2bf(act);
            } else { a.Ob[(size_t)row * DM + col] = f2bf(acc[i][j] + a.bias[e * DM + col]); }
        }
    }
}

__global__ void __launch_bounds__(128) nattn(const bf16_t* __restrict__ proj, bf16_t* __restrict__ mix, const float* lq1, const float* lk1, const float* lq2, const float* lk2, const float* subg) {
    __shared__ float sc[2][SEQ];
    const int w = threadIdx.x >> 6, lane = threadIdx.x & 63;
    const int task = blockIdx.x * 2 + w, t = task >> 2, h = task & 3, b = t / SEQ, qpos = t % SEQ;
    const float lam = expf(wave_sum(lq1[lane] * lk1[lane])) - expf(wave_sum(lq2[lane] * lk2[lane])) + LAMBDA_INIT;
    const bf16_t* pb = proj + (size_t)b * SEQ * INW;
    float o[2][2];
    for (int s = 0; s < 2; ++s) {
        float q[DH];
        const bf16_t* qp = proj + (size_t)t * INW + C_Q + s * 256 + h * DH;
#pragma unroll
        for (int d = 0; d < DH; ++d) q[d] = bf2f(qp[d]);
        float m = -INFINITY;
        for (int j = lane; j <= qpos; j += 64) {
            const uint4* kp = (const uint4*)(pb + (size_t)j * INW + C_K + s * 256 + h * DH);
            float acc = 0.f;
#pragma unroll
            for (int c = 0; c < 8; ++c) {
                const uint4 kk = kp[c];
                const uint32_t ww[4] = {kk.x, kk.y, kk.z, kk.w};
#pragma unroll
                for (int z = 0; z < 4; ++z) { acc = fmaf(q[c * 8 + 2 * z], bf2f((bf16_t)(ww[z] & 0xffff)), acc); acc = fmaf(q[c * 8 + 2 * z + 1], bf2f((bf16_t)(ww[z] >> 16)), acc); }
            }
            sc[w][j] = acc; m = fmaxf(m, acc);
        }
        m = wave_max(m);
        float l = 0.f;
        for (int j = lane; j <= qpos; j += 64) { const float p = exp2f(sc[w][j] - m); sc[w][j] = p; l += p; }
        l = wave_sum(l);
        __syncthreads();
        float o0 = 0.f, o1 = 0.f;
        const bf16_t* vp = pb + C_V + h * DV + lane * 2;
        for (int j = 0; j <= qpos; ++j) {
            const float p = sc[w][j];
            const uint32_t vv = *(const uint32_t*)(vp + (size_t)j * INW);
            o0 = fmaf(p, bf2f((bf16_t)(vv & 0xffff)), o0); o1 = fmaf(p, bf2f((bf16_t)(vv >> 16)), o1);
        }
        o[s][0] = o0 / l; o[s][1] = o1 / l;
        __syncthreads();
    }
    const float d0 = o[0][0] - lam * o[1][0], d1 = o[0][1] - lam * o[1][1];
    const float ss = wave_sum(d0 * d0 + d1 * d1);
    const float r = rsqrtf(ss * (1.0f / DV) + LN_EPS) * (1.0f - LAMBDA_INIT);
    const uint32_t pk = (uint32_t)f2bf(d0 * r * subg[lane * 2]) | ((uint32_t)f2bf(d1 * r * subg[lane * 2 + 1]) << 16);
    *(uint32_t*)(mix + (size_t)t * DM + h * DV + lane * 2) = pk;
}

__global__ void __launch_bounds__(256) ngmlp(const bf16_t* __restrict__ proj, bf16_t* __restrict__ mix, const float* lng, const float* lnb, const float* wsp, const float* bsp) {
    __shared__ float mu[CHUNK], rs[CHUNK];
    __shared__ float vn[CHUNK][GD];
    const int c = blockIdx.x, g = blockIdx.y, tid = threadIdx.x, w = tid >> 6, lane = tid & 63;
    const size_t row0 = (size_t)c * CHUNK;
    for (int s = w; s < CHUNK; s += 4) {
        const bf16_t* p = proj + (row0 + s) * INW + C_GV;
        float v[8]; float sum = 0.f;
#pragma unroll
        for (int i = 0; i < 8; ++i) { v[i] = gelu_exact(bf2f(p[lane + 64 * i])); sum += v[i]; }
        const float mean = wave_sum(sum) * (1.0f / GW); float q = 0.f;
#pragma unroll
        for (int i = 0; i < 8; ++i) { const float d = v[i] - mean; q += d * d; }
        const float var = wave_sum(q) * (1.0f / GW);
        if (lane == 0) { mu[s] = mean; rs[s] = rsqrtf(var + LN_EPS); }
    }
    __syncthreads();
    for (int i = tid; i < CHUNK * GD; i += 256) {
        const int s = i >> 6, d = i & 63, col = g * GD + d;
        const float v = gelu_exact(bf2f(proj[(row0 + s) * INW + C_GV + col]));
        vn[s][d] = (v - mu[s]) * rs[s] * lng[col] + lnb[col];
    }
    __syncthreads();
    const int t = tid >> 1, dh = (tid & 1) * 32;
    float z[32];
#pragma unroll
    for (int d = 0; d < 32; ++d) z[d] = 0.f;
    const float* wr = wsp + ((size_t)g * CHUNK + t) * CHUNK;
    for (int s = 0; s <= t; ++s) {
        const float wv = wr[s];
#pragma unroll
        for (int d = 0; d < 32; ++d) z[d] = fmaf(wv, vn[s][dh + d], z[d]);
    }
    const float bb = bsp[g * CHUNK + t];
#pragma unroll
    for (int d = 0; d < 32; ++d) {
        const int col = g * GD + dh + d;
        const float u = gelu_exact(bf2f(proj[(row0 + t) * INW + C_GU + col]));
        mix[(row0 + t) * DM + GW + col] = f2bf(u * (z[d] + bb));
    }
}

__global__ void __launch_bounds__(256) nroute(float* __restrict__ h1, bf16_t* __restrict__ xb, const float* g1, const float* b1, const float* wr, const float* br, int* ctl, int* list, int* re, int* rr, float* rg) {
    const int w = threadIdx.x >> 6, lane = threadIdx.x & 63, t = blockIdx.x * 4 + w;
    float* row = h1 + (size_t)t * DM;
    float v[16]; float s = 0.f;
#pragma unroll
    for (int j = 0; j < 4; ++j) { const float4 q = *(const float4*)(row + j * 256 + lane * 4); v[4 * j] = q.x; v[4 * j + 1] = q.y; v[4 * j + 2] = q.z; v[4 * j + 3] = q.w; s += (q.x + q.y) + (q.z + q.w); }
    const float mean = wave_sum(s) * (1.0f / DM); float q2 = 0.f;
#pragma unroll
    for (int i = 0; i < 16; ++i) { v[i] -= mean; q2 += v[i] * v[i]; }
    const float rstd = rsqrtf(wave_sum(q2) * (1.0f / DM) + LN_EPS);
#pragma unroll
    for (int j = 0; j < 4; ++j) {
        const int col = j * 256 + lane * 4;
#pragma unroll
        for (int c = 0; c < 4; ++c) v[4 * j + c] = v[4 * j + c] * rstd * g1[col + c] + b1[col + c];
        *(float4*)(row + col) = make_float4(v[4 * j], v[4 * j + 1], v[4 * j + 2], v[4 * j + 3]);
        uint2 pk; pk.x = (uint32_t)f2bf(v[4 * j]) | ((uint32_t)f2bf(v[4 * j + 1]) << 16); pk.y = (uint32_t)f2bf(v[4 * j + 2]) | ((uint32_t)f2bf(v[4 * j + 3]) << 16);
        *(uint2*)(xb + (size_t)t * DM + col) = pk;
    }
    float lg[NE];
#pragma unroll
    for (int e = 0; e < NE; ++e) lg[e] = 0.f;
#pragma unroll
    for (int j = 0; j < 4; ++j)
#pragma unroll
        for (int c = 0; c < 4; ++c) {
            const float xv = v[4 * j + c]; const float4* wp = (const float4*)(wr + (size_t)(j * 256 + lane * 4 + c) * NE);
#pragma unroll
            for (int e4 = 0; e4 < 8; ++e4) { const float4 ww = wp[e4]; lg[4 * e4] = fmaf(xv, ww.x, lg[4 * e4]); lg[4 * e4 + 1] = fmaf(xv, ww.y, lg[4 * e4 + 1]); lg[4 * e4 + 2] = fmaf(xv, ww.z, lg[4 * e4 + 2]); lg[4 * e4 + 3] = fmaf(xv, ww.w, lg[4 * e4 + 3]); }
        }
#pragma unroll
    for (int e = 0; e < NE; ++e) lg[e] = wave_sum(lg[e]) + br[e];
    int idx[4]; float val[4]; unsigned taken = 0u;
#pragma unroll
    for (int k = 0; k < 4; ++k) {
        float best = -INFINITY; int bi = 0;
#pragma unroll
        for (int e = 0; e < NE; ++e) { const bool ok = !((taken >> e) & 1u) && lg[e] > best; best = ok ? lg[e] : best; bi = ok ? e : bi; }
        idx[k] = bi; val[k] = best; taken |= 1u << bi;
    }
    float ex[4], se = 0.f;
#pragma unroll
    for (int k = 0; k < 4; ++k) { ex[k] = expf(val[k] - val[0]); se += ex[k]; }
    if (lane == 0) {
#pragma unroll
        for (int k = 0; k < 4; ++k) {
            const int r = atomicAdd(ctl + CW_CNT + idx[k], 1);
            list[idx[k] * NTOK + r] = t;
            re[t * 4 + k] = idx[k]; rr[t * 4 + k] = r; rg[t * 4 + k] = ex[k] / se;
        }
    }
}
__global__ void npstart(int* ctl) {
    if (threadIdx.x == 0 && blockIdx.x == 0) { int p = 0; for (int e = 0; e < NE; ++e) { ctl[CW_PSTART + e] = p; p += ((ctl[CW_CNT + e] + 255) / 256) * 256; } ctl[CW_PSTART + NE] = p; }
}
__global__ void __launch_bounds__(256) ncombine(const float* __restrict__ x1, const bf16_t* __restrict__ y, const int* ctl, const int* re, const int* rr, const float* rg, const float* g2, const float* b2, float* __restrict__ out) {
    const int w = threadIdx.x >> 6, lane = threadIdx.x & 63, t = blockIdx.x * 4 + w;
    float v[16];
#pragma unroll
    for (int j = 0; j < 4; ++j) { const float4 q = *(const float4*)(x1 + (size_t)t * DM + j * 256 + lane * 4); v[4 * j] = ALPHA * q.x; v[4 * j + 1] = ALPHA * q.y; v[4 * j + 2] = ALPHA * q.z; v[4 * j + 3] = ALPHA * q.w; }
#pragma unroll
    for (int k = 0; k < 4; ++k) {
        const int e = re[t * 4 + k], slot = ctl[CW_PSTART + e] + rr[t * 4 + k]; const float g = rg[t * 4 + k];
        const bf16_t* yr = y + (size_t)slot * DM;
#pragma unroll
        for (int j = 0; j < 4; ++j) { const uint2 pk = *(const uint2*)(yr + j * 256 + lane * 4);
            v[4 * j] = fmaf(g, bf2f((bf16_t)(pk.x & 0xffff)), v[4 * j]); v[4 * j + 1] = fmaf(g, bf2f((bf16_t)(pk.x >> 16)), v[4 * j + 1]);
            v[4 * j + 2] = fmaf(g, bf2f((bf16_t)(pk.y & 0xffff)), v[4 * j + 2]); v[4 * j + 3] = fmaf(g, bf2f((bf16_t)(pk.y >> 16)), v[4 * j + 3]); }
    }
    float s = 0.f;
#pragma unroll
    for (int i = 0; i < 16; ++i) s += v[i];
    const float mean = wave_sum(s) * (1.0f / DM); float q2 = 0.f;
#pragma unroll
    for (int i = 0; i < 16; ++i) { v[i] -= mean; q2 += v[i] * v[i]; }
    const float rstd = rsqrtf(wave_sum(q2) * (1.0f / DM) + LN_EPS);
#pragma unroll
    for (int j = 0; j < 4; ++j) { const int col = j * 256 + lane * 4;
        *(float4*)(out + (size_t)t * DM + col) = make_float4(v[4 * j] * rstd * g2[col] + b2[col], v[4 * j + 1] * rstd * g2[col + 1] + b2[col + 1], v[4 * j + 2] * rstd * g2[col + 2] + b2[col + 2], v[4 * j + 3] * rstd * g2[col + 3] + b2[col + 3]); }
}

#ifndef OPT_MASK
#define OPT_MASK 0x1FF
#endif
#ifndef FUSED
#define FUSED 0
#endif
static void launch_mega(const Args& base, int lo, int hi, int sub, hipStream_t stream) {
    Args a = base; a.ph_lo = lo; a.ph_hi = hi; a.pad0 = sub; a.pad1 = 0;
    hipLaunchKernelGGL(mega_fwd, dim3(256), dim3(NWAVES * 64), LDS_BYTES, stream, a);
}
extern "C" void kernel_launch(void* const* d_in, const int* in_sizes, int n_in, void* d_out, int out_size, void* d_ws, size_t ws_size, hipStream_t stream) {
    static int ready = 0;
    if (ready == 0) {
        if (n_in != 22 || in_sizes[0] != NTOK * DM || out_size != NTOK * DM || ws_size < WS_END) { fprintf(stderr, "kernel_launch: unexpected shapes (n_in %d, in0 %d, out %d, ws %zu)\n", n_in, n_in > 0 ? in_sizes[0] : -1, out_size, ws_size); ready = -1; return; }
        if (hipFuncSetAttribute((const void*)mega_fwd, hipFuncAttributeMaxDynamicSharedMemorySize, LDS_BYTES) != hipSuccess) { fprintf(stderr, "kernel_launch: hipFuncSetAttribute failed\n"); ready = -1; return; }
        ready = 1;
    }
    if (ready < 0) return;
    const float* x = (const float*)d_in[0]; const float* w_in = (const float*)d_in[1];
    const float *lq1 = (const float*)d_in[2], *lk1 = (const float*)d_in[3], *lq2 = (const float*)d_in[4], *lk2 = (const float*)d_in[5];
    const float *subg = (const float*)d_in[6], *glng = (const float*)d_in[7], *glnb = (const float*)d_in[8], *wsp = (const float*)d_in[9], *bsp = (const float*)d_in[10];
    const float *w_o = (const float*)d_in[11], *ln1g = (const float*)d_in[12], *ln1b = (const float*)d_in[13], *w_r = (const float*)d_in[14], *b_r = (const float*)d_in[15];
    const float *w_up = (const float*)d_in[16], *b_up = (const float*)d_in[17], *w_dn = (const float*)d_in[18], *b_dn = (const float*)d_in[19], *ln2g = (const float*)d_in[20], *ln2b = (const float*)d_in[21];
    unsigned char* ws = (unsigned char*)d_ws;
    int* ctl = (int*)(ws + WS_CTL); int* list = (int*)(ws + WS_LIST); int* re = (int*)(ws + WS_RE); int* rr = (int*)(ws + WS_RR); float* rg = (float*)(ws + WS_RG);
    bf16_t* xb = (bf16_t*)(ws + WS_XB); bf16_t* proj = (bf16_t*)(ws + WS_PROJ); bf16_t* mix = (bf16_t*)(ws + WS_MIX); bf16_t* yb = (bf16_t*)(ws + WS_Y);
    float* h1 = (float*)(ws + WS_H1); bf16_t* act = (bf16_t*)(ws + WS_ACT);
    (void)hipMemsetAsync(ws + WS_CTL, 0, CTL_BYTES, stream);
    Args base{};
    for (int i = 0; i < 22; ++i) base.in[i] = (const float*)d_in[i];
    base.out = (float*)d_out; base.ws = ws;
    constexpr unsigned OM = OPT_MASK;
#if FUSED
    static_assert(OM == 0x1FFu, "FUSED needs every stage in the persistent kernel");
    launch_mega(base, 0, N_PHASES, 3, stream);
#else
    if (OM & 0xD3u) launch_mega(base, 0, 1, 0, stream);
    if (OM & 2u) launch_mega(base, 1, 2, 0, stream);
    else { NArgs a{}; a.x = x; a.B = w_in; a.Ob = proj; ngemm<0><<<dim3(INW / 64, NTOK / 64), 256, 0, stream>>>(a); }
    if ((OM & 4u) || (OM & 8u)) launch_mega(base, 2, 3, ((OM & 4u) ? 1 : 0) | ((OM & 8u) ? 2 : 0), stream);
    if (OM & 4u) launch_mega(base, 3, 4, 0, stream);
    else nattn<<<NTOK * NH / 2, 128, 0, stream>>>(proj, mix, lq1, lk1, lq2, lk2, subg);
    if (!(OM & 8u)) ngmlp<<<dim3(NTOK / CHUNK, NG), 256, 0, stream>>>(proj, mix, glng, glnb, wsp, bsp);
    if (OM & 16u) launch_mega(base, 4, 5, 0, stream);
    else { NArgs a{}; a.x = x; a.B = w_o; a.Ab = mix; a.Of = h1; ngemm<1><<<dim3(DM / 64, NTOK / 64), 256, 0, stream>>>(a); }
    if (OM & 32u) launch_mega(base, 5, 6, 0, stream);
    else nroute<<<NTOK / 4, 256, 0, stream>>>(h1, xb, ln1g, ln1b, w_r, b_r, ctl, list, re, rr, rg);
    if ((OM & 0x1C0u) != 0x1C0u) npstart<<<1, 64, 0, stream>>>(ctl);
    if (OM & 64u) launch_mega(base, 6, 7, 0, stream);
    else { NArgs a{}; a.B = w_up; a.bias = b_up; a.Ab = xb; a.Ob = act; a.ctl = ctl; a.list = list; ngemm<2><<<dim3(DFF / 64, PADROWS / 64), 256, 0, stream>>>(a); }
    if (OM & 128u) launch_mega(base, 7, 8, 0, stream);
    else { NArgs a{}; a.B = w_dn; a.bias = b_dn; a.Ab = act; a.Ob = yb; a.ctl = ctl; a.list = list; ngemm<3><<<dim3(DM / 64, PADROWS / 64), 256, 0, stream>>>(a); }
    if (OM & 256u) launch_mega(base, 8, 9, 0, stream);
    else ncombine<<<NTOK / 4, 256, 0, stream>>>(h1, yb, ctl, re, rr, rg, ln2g, ln2b, (float*)d_out);
#endif
}
```

```cpp
#include <hip/hip_runtime.h>
#include <hip/hip_bf16.h>
#include <cstdint>
#include <cstdio>
#include <cmath>

#ifndef MOE_FP8
#define MOE_FP8 1
#endif
namespace cfg {
constexpr int BATCH = 8, SEQ = 4096, NTOK = BATCH * SEQ, DM = 1024;
constexpr int INW = 2560, NH = 4, DH = 64, DV = 128;
constexpr int C_Q = 0, C_K = 512, C_V = 1024, C_GU = 1536, C_GV = 2048;
constexpr int GW = 512, NG = 8, GD = 64, CHUNK = 128;
constexpr int NE = 32, TOPK = 4, DFF = 1024;
constexpr int PADROWS = 139264;
constexpr float LN_EPS = 1e-5f;
constexpr float ALPHA = 1.189207115002721f;
constexpr float LAMBDA_INIT = 0.2f;
constexpr float QSCALE = 0.125f * 1.4426950408889634f;
constexpr size_t MiB = 1u << 20;
constexpr size_t WS_CTL = 0, CTL_BYTES = 1 * MiB;
constexpr size_t WS_LIST = 1 * MiB;
constexpr size_t WS_RE = 5 * MiB, WS_RR = 5 * MiB + 512 * 1024, WS_RG = 6 * MiB;
constexpr size_t WS_WIN = 8 * MiB;
constexpr size_t WS_WO = 13 * MiB;
constexpr size_t WS_WUP = 16 * MiB;
constexpr size_t WS_WDN = 144 * MiB;
constexpr size_t WS_X1B = 80 * MiB;
constexpr size_t WS_XB = 208 * MiB;
constexpr size_t WS_PROJ = 272 * MiB;
constexpr size_t WS_MIX = 432 * MiB;
constexpr size_t WS_ATTO = 496 * MiB;
constexpr size_t WS_Y = 272 * MiB;
constexpr size_t WS_H1 = 560 * MiB;
constexpr size_t WS_ACT = 688 * MiB;
constexpr size_t WS_END = 960 * MiB;
constexpr int CW_CNT = 0;
constexpr int CW_PSTART = 64;
constexpr int CW_BAR = 4096;
}
using namespace cfg;
typedef uint16_t bf16_t;

__device__ __forceinline__ float bf2f(bf16_t b) { return __uint_as_float((uint32_t)b << 16); }
__device__ __forceinline__ bf16_t f2bf(float f) { uint32_t u = __float_as_uint(f); u += 0x7fffu + ((u >> 16) & 1u); return (bf16_t)(u >> 16); }
__device__ __forceinline__ uint32_t pk2(float lo, float hi) { return (uint32_t)f2bf(lo) | ((uint32_t)f2bf(hi) << 16); }
__device__ __forceinline__ float wave_sum(float v) {
#pragma unroll
    for (int o = 1; o < 64; o <<= 1) v += __shfl_xor(v, o);
    return v;
}
__device__ __forceinline__ float wave_max(float v) {
#pragma unroll
    for (int o = 1; o < 64; o <<= 1) v = fmaxf(v, __shfl_xor(v, o));
    return v;
}
__device__ __forceinline__ float gelu_exact(float x) { return 0.5f * x * (1.0f + erff(x * 0.70710678118654752f)); }

#define OPT_MASK 0x1FF
#define FUSED 1
#define DOUBLE_MASK 0
#define P2_REP_SUB 3
namespace pg8 {
#define PG8_LAS __attribute__((address_space(3)))
typedef short bf16x8 __attribute__((ext_vector_type(8)));
typedef float f32x4 __attribute__((ext_vector_type(4)));
typedef float f32x2 __attribute__((ext_vector_type(2)));
typedef unsigned u32x4 __attribute__((ext_vector_type(4)));
typedef int v4i_t __attribute__((ext_vector_type(4)));
typedef int v8i_t __attribute__((ext_vector_type(8)));
constexpr int WSHIFT = 6;
constexpr int WSCALE_E8M0 = (127 - WSHIFT) * 0x01010101;
constexpr int BM = 256, BK = 64, HALF = 128, HTB = HALF * BK * 2  , STAGE_BYTES = 8 * HTB, NXCD = 8, WGM = 8;

__host__ __device__ __forceinline__ int lds_byte(int r, int c) { const int st = (r >> 4) * 2 + (c >> 5), rr = r & 15, cc = c & 31, ob = rr * 64 + cc * 2; return st * 1024 + (ob ^ (((ob >> 9) & 1) << 5)); }
__host__ __device__ __forceinline__ void stage_rc(int b, int& R, int& C) { const int st = b / 1024, sb = b % 1024, swz = sb ^ (((sb >> 9) & 1) << 5); R = (st >> 1) * 16 + swz / 64; C = (st & 1) * 32 + (swz % 64) / 2; }
__host__ __device__ __forceinline__ int perm32(int rho) { const int n = rho >> 4, i = rho & 15; return 8 * (i >> 2) + 4 * n + (i & 3); }

struct Unit { int pm, pn, e; };
struct Gemm { const bf16_t* A; const bf16_t* Bt; int M, N, K; size_t strideB; };

struct StaticOrder {
    int nM, nN, nwg, G, c;
    __host__ __device__ void init(int M, int N, int G_, int c_) { nM = M / BM; nN = N / BM; nwg = nM * nN; G = G_; c = c_; }
    __host__ __device__ bool next(int i, Unit& u) const {
        const long L = (long)i * G + c; if (L >= nwg) return false;
        int wgid = (int)L; { const int q = nwg / NXCD, r = nwg % NXCD, xcd = wgid % NXCD, off = wgid / NXCD; wgid = (xcd < r ? xcd * (q + 1) : r * (q + 1) + (xcd - r) * q) + off; }
        const int nig = WGM * nN, gid = wgid / nig, fm = gid * WGM, gsz = (nM - fm) < WGM ? (nM - fm) : WGM;
        u.pm = fm + ((wgid % nig) % gsz); u.pn = (wgid % nig) / gsz; u.e = 0; return true;
    }
    __device__ __forceinline__ void gather(const Unit&, const int (&)[2], const int (&)[2], unsigned (&)[2][2], unsigned) const {}
};
struct MoeOrder {
    const PG8_LAS int* tab; const int* list; int NC, RG, chunk0, nrt, j0;
    __device__ __forceinline__ void init(const PG8_LAS int* tab_, const int* list_, int NC_, int bid) {
        tab = tab_; list = list_; NC = NC_; RG = 32 / NC_; const int x = bid & 7; j0 = bid >> 3;
        const int T = __builtin_amdgcn_readfirstlane(tab_[32]); chunk0 = (T * x) / 8; nrt = (T * (x + 1)) / 8 - chunk0;
    }
    __device__ __forceinline__ bool next(int i, Unit& u) const {
        const int pml = i * RG + (j0 % RG); if (pml >= nrt) return false;
        u.pm = chunk0 + pml; u.pn = j0 / RG; int e = 0;
        while (e < NE - 1 && u.pm >= __builtin_amdgcn_readfirstlane(tab[e + 1])) ++e;
        u.e = e; return true;
    }
    __device__ __forceinline__ void gather(const Unit& u, const int (&RA)[2], const int (&CA2)[2], unsigned (&go)[2][2], unsigned rowbytes) const {
        const int r0 = (u.pm - __builtin_amdgcn_readfirstlane(tab[u.e])) * BM, cnt = __builtin_amdgcn_readfirstlane(tab[40 + u.e]);
#pragma unroll
        for (int h = 0; h < 2; ++h)
#pragma unroll
            for (int i = 0; i < 2; ++i) { const int r = r0 + h * HALF + RA[i]; const int tok = (r < cnt) ? list[u.e * NTOK + r] : 0; go[h][i] = (unsigned)tok * rowbytes + (unsigned)CA2[i]; }
    }
};

__device__ __forceinline__ unsigned cvt_pk_bf16(float lo, float hi) { unsigned r; asm volatile("v_cvt_pk_bf16_f32 %0, %1, %2" : "=v"(r) : "v"(lo), "v"(hi)); return r; }
__device__ __forceinline__ f32x2 gelu_pk(f32x2 v) {
    const f32x2 av = __builtin_elementwise_abs(v), d = av * 0.2316418882f + 1.0f;
    f32x2 t; t.x = __builtin_amdgcn_rcpf(d.x); t.y = __builtin_amdgcn_rcpf(d.y);
    f32x2 q = t * 0.5307027145f + (-0.7265760135f); q = q * t + 0.7107068705f; q = q * t + (-0.142248368f); q = q * t + 0.127414796f; q = q * t;
    const f32x2 s = (v * v) * (-0.72134752044f);
    f32x2 e; e.x = __builtin_amdgcn_exp2f(s.x); e.y = __builtin_amdgcn_exp2f(s.y);
    const f32x2 m = v * (q * e), r = v - m;
    f32x2 o; o.x = v.x < 0.f ? m.x : r.x; o.y = v.y < 0.f ? m.y : r.y; return o;
}
__device__ __forceinline__ float gelu1(float v) { return gelu_pk((f32x2){v, v}).x; }

struct EpiProj {
    static constexpr bool PERM = true;
    bf16_t* O;
    __device__ __forceinline__ void operator()(const f32x4 (&acc)[2][2][4][2], const Unit& u, int wr, int wc, int fr, int fq) const {
        const int row0 = u.pm * BM + wr * 64 + fr, col0 = u.pn * BM + wc * 32 + 8 * fq; const float sc = (u.pn < 2) ? QSCALE : 1.0f;
#pragma unroll
        for (int ai = 0; ai < 2; ++ai)
#pragma unroll
            for (int m = 0; m < 4; ++m) { bf16_t* rowp = O + (size_t)(row0 + ai * HALF + m * 16) * INW + col0;
#pragma unroll
                for (int bj = 0; bj < 2; ++bj) { const f32x4 v0 = acc[ai][bj][m][0] * sc, v1 = acc[ai][bj][m][1] * sc;
                    u32x4 w; w.x = cvt_pk_bf16(v0[0], v0[1]); w.y = cvt_pk_bf16(v0[2], v0[3]); w.z = cvt_pk_bf16(v1[0], v1[1]); w.w = cvt_pk_bf16(v1[2], v1[3]);
                    *(u32x4*)(rowp + bj * HALF) = w; } }
    }
};
struct EpiH1 {
    static constexpr bool PERM = false;
    const float* X; float* C;
    __device__ __forceinline__ void operator()(const f32x4 (&acc)[2][2][4][2], const Unit& u, int wr, int wc, int fr, int fq) const {
        const int row0 = u.pm * BM + wr * 64 + fr, col0 = u.pn * BM + wc * 32 + 4 * fq;
#pragma unroll
        for (int ai = 0; ai < 2; ++ai)
#pragma unroll
            for (int m = 0; m < 4; ++m) { const size_t off = (size_t)(row0 + ai * HALF + m * 16) * DM + col0;
#pragma unroll
                for (int bj = 0; bj < 2; ++bj)
#pragma unroll
                    for (int n = 0; n < 2; ++n) { const f32x4 xv = *(const f32x4*)(X + off + bj * HALF + n * 16); *(f32x4*)(C + off + bj * HALF + n * 16) = xv * ALPHA + acc[ai][bj][m][n]; } }
    }
};
struct EpiSwiglu {
    static constexpr bool PERM = true;
    bf16_t* O; const float* bias;
    __device__ __forceinline__ void operator()(const f32x4 (&acc)[2][2][4][2], const Unit& u, int wr, int wc, int fr, int fq) const {
        const int row0 = u.pm * BM + wr * 64 + fr, col0 = u.pn * HALF + wc * 32 + 8 * fq;
        const float* bp = bias + (size_t)u.e * (2 * DFF) + col0;
        f32x4 bg[2], bl[2];
#pragma unroll
        for (int n = 0; n < 2; ++n) { bg[n] = *(const f32x4*)(bp + 4 * n); bl[n] = *(const f32x4*)(bp + DFF + 4 * n); }
#pragma unroll
        for (int ai = 0; ai < 2; ++ai)
#pragma unroll
            for (int m = 0; m < 4; ++m) { float a8[8];
#pragma unroll
                for (int n = 0; n < 2; ++n) { const f32x4 g4 = acc[ai][0][m][n] + bg[n], l4 = acc[ai][1][m][n] + bl[n];
#pragma unroll
                    for (int j = 0; j < 4; ++j) { const float g = fminf(g4[j], 7.0f), l = fminf(fmaxf(l4[j], -7.0f), 7.0f);
                        const float sg = __builtin_amdgcn_rcpf(1.0f + __builtin_amdgcn_exp2f(g * (-1.702f * 1.4426950408889634f)));
                        a8[4 * n + j] = (l + 1.0f) * g * sg; } }
                u32x4 w; w.x = cvt_pk_bf16(a8[0], a8[1]); w.y = cvt_pk_bf16(a8[2], a8[3]); w.z = cvt_pk_bf16(a8[4], a8[5]); w.w = cvt_pk_bf16(a8[6], a8[7]);
                *(u32x4*)(O + (size_t)(row0 + ai * HALF + m * 16) * DFF + col0) = w; }
    }
};
struct EpiDown {
    static constexpr bool PERM = true;
    bf16_t* O; const float* bias;
    __device__ __forceinline__ void operator()(const f32x4 (&acc)[2][2][4][2], const Unit& u, int wr, int wc, int fr, int fq) const {
        const int row0 = u.pm * BM + wr * 64 + fr, col0 = u.pn * BM + wc * 32 + 8 * fq;
        const float* bp = bias + (size_t)u.e * DM + col0;
        f32x4 bv[2][2];
#pragma unroll
        for (int bj = 0; bj < 2; ++bj)
#pragma unroll
            for (int n = 0; n < 2; ++n) bv[bj][n] = *(const f32x4*)(bp + bj * HALF + 4 * n);
#pragma unroll
        for (int ai = 0; ai < 2; ++ai)
#pragma unroll
            for (int m = 0; m < 4; ++m) { bf16_t* rowp = O + (size_t)(row0 + ai * HALF + m * 16) * DM + col0;
#pragma unroll
                for (int bj = 0; bj < 2; ++bj) { const f32x4 v0 = acc[ai][bj][m][0] + bv[bj][0], v1 = acc[ai][bj][m][1] + bv[bj][1];
                    u32x4 w; w.x = cvt_pk_bf16(v0[0], v0[1]); w.y = cvt_pk_bf16(v0[2], v0[3]); w.z = cvt_pk_bf16(v1[0], v1[1]); w.w = cvt_pk_bf16(v1[2], v1[3]);
                    *(u32x4*)(rowp + bj * HALF) = w; } }
    }
};

__device__ __forceinline__ unsigned pk4_fp8(float a, float b, float c, float d) { int w = 0; w = __builtin_amdgcn_cvt_pk_fp8_f32(a, b, w, false); w = __builtin_amdgcn_cvt_pk_fp8_f32(c, d, w, true); return (unsigned)w; }
typedef unsigned u32x2 __attribute__((ext_vector_type(2)));
struct EpiSwiglu8 {
    static constexpr bool PERM = true;
    unsigned char* O; const float* bias;
    __device__ __forceinline__ void operator()(const f32x4 (&acc)[2][2][4][2], const Unit& u, int wr, int wc, int fr, int fq) const {
        const int row0 = u.pm * BM + wr * 64 + fr, col0 = u.pn * HALF + wc * 32 + 8 * fq;
        const float* bp = bias + (size_t)u.e * (2 * DFF) + col0;
        f32x4 bg[2], bl[2];
#pragma unroll
        for (int n = 0; n < 2; ++n) { bg[n] = *(const f32x4*)(bp + 4 * n); bl[n] = *(const f32x4*)(bp + DFF + 4 * n); }
#pragma unroll
        for (int ai = 0; ai < 2; ++ai)
#pragma unroll
            for (int m = 0; m < 4; ++m) { float a8[8];
#pragma unroll
                for (int n = 0; n < 2; ++n) { const f32x4 g4 = acc[ai][0][m][n] + bg[n], l4 = acc[ai][1][m][n] + bl[n];
#pragma unroll
                    for (int j = 0; j < 4; ++j) { const float g = fminf(g4[j], 7.0f), l = fminf(fmaxf(l4[j], -7.0f), 7.0f);
                        const float sg = __builtin_amdgcn_rcpf(1.0f + __builtin_amdgcn_exp2f(g * (-1.702f * 1.4426950408889634f)));
                        a8[4 * n + j] = (l + 1.0f) * g * sg; } }
                u32x2 w; w.x = pk4_fp8(a8[0], a8[1], a8[2], a8[3]); w.y = pk4_fp8(a8[4], a8[5], a8[6], a8[7]);
                *(u32x2*)(O + (size_t)(row0 + ai * HALF + m * 16) * DFF + col0) = w; }
    }
};

struct EpiDown8 {
    static constexpr bool PERM = true;
    unsigned char* O; const float* bias;
    __device__ __forceinline__ void operator()(const f32x4 (&acc)[2][2][4][2], const Unit& u, int wr, int wc, int fr, int fq) const {
        const int row0 = u.pm * BM + wr * 64 + fr, col0 = u.pn * BM + wc * 32 + 8 * fq;
        const float* bp = bias + (size_t)u.e * DM + col0;
        f32x4 bv[2][2];
#pragma unroll
        for (int bj = 0; bj < 2; ++bj)
#pragma unroll
            for (int n = 0; n < 2; ++n) bv[bj][n] = *(const f32x4*)(bp + bj * HALF + 4 * n);
#pragma unroll
        for (int ai = 0; ai < 2; ++ai)
#pragma unroll
            for (int m = 0; m < 4; ++m) { unsigned char* rowp = O + (size_t)(row0 + ai * HALF + m * 16) * DM + col0;
#pragma unroll
                for (int bj = 0; bj < 2; ++bj) { const f32x4 v0 = acc[ai][bj][m][0] + bv[bj][0], v1 = acc[ai][bj][m][1] + bv[bj][1];
                    u32x2 w; w.x = pk4_fp8(v0[0], v0[1], v0[2], v0[3]); w.y = pk4_fp8(v1[0], v1[1], v1[2], v1[3]);
                    *(u32x2*)(rowp + bj * HALF) = w; } }
    }
};

template <class Epi, class Sched, bool GATHER, bool FP8 = false>
__device__ __forceinline__ void gemm_phase(PG8_LAS unsigned char* lds, const Gemm g, const Sched& S, const Epi& E) {
    int tid_ = threadIdx.x; asm volatile("" : "+v"(tid_));
    const int tid = tid_, wid = __builtin_amdgcn_readfirstlane(tid >> 6), lane = tid & 63, wr = wid >> 2, wc = wid & 3, fr = lane & 15, fq = lane >> 4;
    const int K = FP8 ? g.K / 2 : g.K, nt = K / BK;
    unsigned voffB[2]; int RA[2], CA2[2]; unsigned voffA[2];
#pragma unroll
    for (int i = 0; i < 2; ++i) { int R, C; stage_rc(tid * 16 + i * 8192, R, C); const int Rb = Epi::PERM ? ((R & ~31) + perm32(R & 31)) : R;
        voffA[i] = (unsigned)(R * K + C) * 2u; voffB[i] = (unsigned)(Rb * K + C) * 2u; RA[i] = R; CA2[i] = C * 2; }
    const size_t kstep = (size_t)(BK * 2);
    const size_t hstep = (size_t)HALF * K * 2;
    const size_t tstep = 2 * hstep;
    const unsigned ldsw = (unsigned)wid * 1024u;
    const int aoff = lds_byte(wr * 64 + fr, fq * 8), boff = lds_byte(wc * 32 + fr, fq * 8);
    const unsigned lds0 = (unsigned)(uintptr_t)lds;
#define PG8_SA(b, h) (((b) * 2 + (h)) * HTB)
#define PG8_SB(b, h) ((4 + (b) * 2 + (h)) * HTB)
#define PG8_GLDS(sbase, voff, ldsoff) do { unsigned keep_; asm volatile("s_mov_b32 %0, m0\n\ts_mov_b32 m0, %3\n\ts_nop 0\n\tglobal_load_lds_dwordx4 %1, %2\n\ts_mov_b32 m0, %0" \
        : "=&s"(keep_) : "v"(voff), "s"(sbase), "s"((unsigned)__builtin_amdgcn_readfirstlane((int)(lds0 + (unsigned)(ldsoff)))) : "memory"); } while (0)
#define PG8_STAGE_B(bufoff, gbase) do { PG8_GLDS((const char*)(gbase), voffB[0], (bufoff) + ldsw); PG8_GLDS((const char*)(gbase), voffB[1], (bufoff) + ldsw + 8192); } while (0)
#define PG8_STAGE_A(bufoff, gbase, o0, o1) do { PG8_GLDS((const char*)(gbase), (o0), (bufoff) + ldsw); PG8_GLDS((const char*)(gbase), (o1), (bufoff) + ldsw + 8192); } while (0)
#define PG8_LDA(dst, b, h) do { _Pragma("unroll") for (int m = 0; m < 4; ++m) _Pragma("unroll") for (int k = 0; k < 2; ++k) dst[m][k] = *(const PG8_LAS bf16x8*)(lds + PG8_SA(b, h) + aoff + m * 2048 + k * 1024); } while (0)
#define PG8_LDB(dst, b, h) do { _Pragma("unroll") for (int n = 0; n < 2; ++n) _Pragma("unroll") for (int k = 0; k < 2; ++k) dst[n][k] = *(const PG8_LAS bf16x8*)(lds + PG8_SB(b, h) + boff + n * 2048 + k * 1024); } while (0)
#define PG8_LD8(p) __builtin_shufflevector(*(const PG8_LAS v4i_t*)(p), *(const PG8_LAS v4i_t*)((p) + 1024), 0, 1, 2, 3, 4, 5, 6, 7)
#define PG8_LDA8(dst, b, h) do { _Pragma("unroll") for (int m = 0; m < 4; ++m) dst[m] = PG8_LD8(lds + PG8_SA(b, h) + aoff + m * 2048); } while (0)
#define PG8_LDB8(dst, b, h) do { _Pragma("unroll") for (int n = 0; n < 2; ++n) dst[n] = PG8_LD8(lds + PG8_SB(b, h) + boff + n * 2048); } while (0)
#define PG8_MMA(ai, bj, At, Bt) do { __builtin_amdgcn_s_setprio(1); \
        if constexpr (FP8) { _Pragma("unroll") for (int m = 0; m < 4; ++m) _Pragma("unroll") for (int n = 0; n < 2; ++n) \
            acc[ai][bj][m][n] = __builtin_amdgcn_mfma_scale_f32_16x16x128_f8f6f4(Bt##8[n], At##8[m], acc[ai][bj][m][n], 0, 0, 0, WSCALE_E8M0, 0, 0x7f7f7f7f); \
              \
            _Pragma("unroll") for (int m = 0; m < 4; ++m) _Pragma("unroll") for (int n = 0; n < 2; ++n) asm volatile("" : "+v"(acc[ai][bj][m][n])); } \
        else { _Pragma("unroll") for (int m = 0; m < 4; ++m) _Pragma("unroll") for (int n = 0; n < 2; ++n) _Pragma("unroll") for (int k = 0; k < 2; ++k) \
            acc[ai][bj][m][n] = __builtin_amdgcn_mfma_f32_16x16x32_bf16(Bt[n][k], At[m][k], acc[ai][bj][m][n], 0, 0, 0); } \
        __builtin_amdgcn_s_setprio(0); } while (0)
#define PG8_XLDA(dst, b, h) do { if constexpr (FP8) PG8_LDA8(dst##8, b, h); else PG8_LDA(dst, b, h); } while (0)
#define PG8_XLDB(dst, b, h) do { if constexpr (FP8) PG8_LDB8(dst##8, b, h); else PG8_LDB(dst, b, h); } while (0)
#define PG8_WAIT_V(n) asm volatile("s_waitcnt vmcnt(" #n ")" ::: "memory")
#define PG8_WAIT_L(n) asm volatile("s_waitcnt lgkmcnt(" #n ")" ::: "memory")
#define PG8_BAR __builtin_amdgcn_s_barrier()
#define PG8_SCHED __builtin_amdgcn_sched_barrier(0)
    Unit cur, nxt; int ui = 0;
    if (!S.next(0, cur)) return;
    f32x4 acc[2][2][4][2];
#pragma unroll
    for (int a = 0; a < 2; ++a)
#pragma unroll
        for (int b = 0; b < 2; ++b)
#pragma unroll
            for (int m = 0; m < 4; ++m)
#pragma unroll
                for (int n = 0; n < 2; ++n) acc[a][b][m][n] = (f32x4){0.f, 0.f, 0.f, 0.f};
    bf16x8 At[4][2], B0[2][2], B1[2][2]; v8i_t At8[4], B08[2], B18[2];
    const char* cA = GATHER ? (const char*)g.A : (const char*)g.A + (size_t)cur.pm * tstep;
    const char* cB = (const char*)g.Bt + ((size_t)cur.e * g.strideB) * 2 + (size_t)cur.pn * tstep;
    unsigned gc[2][2], gn[2][2];
    if constexpr (GATHER) { S.gather(cur, RA, CA2, gc, (unsigned)(K * 2)); }
    else {
#pragma unroll
        for (int h = 0; h < 2; ++h)
#pragma unroll
            for (int i = 0; i < 2; ++i) gc[h][i] = (unsigned)(h * hstep) + voffA[i]; }
#pragma unroll
    for (int h = 0; h < 2; ++h)
#pragma unroll
        for (int i = 0; i < 2; ++i) gn[h][i] = gc[h][i];
    PG8_STAGE_B(PG8_SB(0, 0), cB); PG8_STAGE_B(PG8_SB(0, 1), cB + hstep); PG8_STAGE_A(PG8_SA(0, 0), cA, gc[0][0], gc[0][1]); PG8_STAGE_A(PG8_SA(0, 1), cA, gc[1][0], gc[1][1]);
    if (wr == 1) PG8_BAR;
    PG8_WAIT_V(2); PG8_BAR;
    PG8_STAGE_B(PG8_SB(1, 0), cB + kstep); PG8_STAGE_A(PG8_SA(1, 0), cA + kstep, gc[0][0], gc[0][1]); PG8_STAGE_B(PG8_SB(1, 1), cB + hstep + kstep);
    PG8_WAIT_V(6); PG8_BAR;
    for (;;) {
        const bool has_next = S.next(ui + 1, nxt);
        const char* nA = GATHER ? cA : (has_next ? (const char*)g.A + (size_t)nxt.pm * tstep : cA);
        const char* nB = has_next ? (const char*)g.Bt + ((size_t)nxt.e * g.strideB) * 2 + (size_t)nxt.pn * tstep : cB;
        if constexpr (GATHER) { if (has_next) S.gather(nxt, RA, CA2, gn, (unsigned)(K * 2)); }
        for (int t = 0; t < nt; t += 2) {
            const bool last = (t == nt - 2);
            const char* a1 = cA + (size_t)(t + 1) * kstep;
            const char* a2 = last ? nA : cA + (size_t)(t + 2) * kstep; const char* b2 = last ? nB : cB + (size_t)(t + 2) * kstep;
            const char* a3 = a2 + kstep; const char* b3 = b2 + kstep;
            unsigned o00 = gc[0][0], o01 = gc[0][1], o10 = gc[1][0], o11 = gc[1][1];
            if constexpr (GATHER) { if (last) { o00 = gn[0][0]; o01 = gn[0][1]; o10 = gn[1][0]; o11 = gn[1][1]; } }
            PG8_XLDB(B0, 0, 0); PG8_XLDB(B1, 0, 1); PG8_SCHED; PG8_XLDA(At, 0, 0); PG8_STAGE_A(PG8_SA(1, 1), a1, gc[1][0], gc[1][1]);
            PG8_WAIT_V(8); PG8_WAIT_L(0); PG8_BAR; PG8_MMA(0, 0, At, B0); PG8_MMA(0, 1, At, B1); PG8_BAR; PG8_SCHED;
            PG8_XLDA(At, 0, 1); PG8_STAGE_B(PG8_SB(0, 0), b2); PG8_STAGE_B(PG8_SB(0, 1), b2 + hstep); PG8_STAGE_A(PG8_SA(0, 0), a2, o00, o01);
            PG8_WAIT_V(8); PG8_WAIT_L(0); PG8_BAR; PG8_MMA(1, 0, At, B0); PG8_MMA(1, 1, At, B1); PG8_BAR; PG8_SCHED;
            PG8_XLDB(B0, 1, 0); PG8_XLDB(B1, 1, 1); PG8_SCHED; PG8_XLDA(At, 1, 0); PG8_STAGE_A(PG8_SA(0, 1), a2, o10, o11);
            PG8_WAIT_V(8); PG8_WAIT_L(0); PG8_BAR; PG8_MMA(0, 0, At, B0); PG8_MMA(0, 1, At, B1); PG8_BAR; PG8_SCHED;
            PG8_XLDA(At, 1, 1); PG8_STAGE_B(PG8_SB(1, 0), b3); PG8_STAGE_B(PG8_SB(1, 1), b3 + hstep); PG8_STAGE_A(PG8_SA(1, 0), a3, o00, o01);
            PG8_WAIT_V(8); PG8_WAIT_L(0); PG8_BAR; PG8_MMA(1, 0, At, B0); PG8_MMA(1, 1, At, B1); PG8_BAR; PG8_SCHED;
        }
        if (wr == 0) PG8_BAR;
        { int fr_ = fr, fq_ = fq; asm volatile("" : "+v"(fr_), "+v"(fq_));
          E(acc, cur, wr, wc, fr_, fq_); }
        if (!has_next) break;
#pragma unroll
        for (int a = 0; a < 2; ++a)
#pragma unroll
            for (int b = 0; b < 2; ++b)
#pragma unroll
                for (int m = 0; m < 4; ++m)
#pragma unroll
                    for (int n = 0; n < 2; ++n) acc[a][b][m][n] = (f32x4){0.f, 0.f, 0.f, 0.f};
        cur = nxt; cA = nA; cB = nB; ++ui;
#pragma unroll
        for (int h = 0; h < 2; ++h)
#pragma unroll
            for (int i = 0; i < 2; ++i) gc[h][i] = gn[h][i];
        if (wr == 1) PG8_BAR;
    }
    PG8_WAIT_V(0);
    PG8_BAR;
#undef PG8_SA
#undef PG8_SB
#undef PG8_GLDS
#undef PG8_STAGE_A
#undef PG8_STAGE_B
#undef PG8_LDA
#undef PG8_LDB
#undef PG8_MMA
#undef PG8_LD8
#undef PG8_LDA8
#undef PG8_LDB8
#undef PG8_XLDA
#undef PG8_XLDB
#undef PG8_WAIT_V
#undef PG8_WAIT_L
#undef PG8_BAR
#undef PG8_SCHED
}
}

namespace attn_body {
using bf16=__hip_bfloat16;
using bf16x8=__attribute__((ext_vector_type(8)))short;
using s16x4=__attribute__((ext_vector_type(4)))short;
using f32x16=__attribute__((ext_vector_type(16)))float;
using u32x4=__attribute__((ext_vector_type(4)))unsigned;
constexpr int D=64,PQ=INW,PO=DM;
constexpr int NW=8,QBLK=32,QB=QBLK*NW,KVBLK=64,NQB=SEQ/QB;
constexpr int ATTN_UNIT_ROWS=QB;
__device__ __forceinline__ int crow(int r,int hi){return (r&3)+8*(r>>2)+4*hi;}
#define SBAR() __builtin_amdgcn_sched_barrier(0)
__device__ __forceinline__ void cmask(f32x16&p0,f32x16&p1,int jb,int qrel,int hi){
  const float NEG=-INFINITY; int kb=64*jb+4*hi;
  #pragma unroll
  for(int r=0;r<16;++r){int kv=kb+(r&3)+8*(r>>2); if(kv>qrel)p0[r]=NEG; if(kv+32>qrel)p1[r]=NEG;}
}

constexpr int NSLOT=3, SLOTB=8192;
constexpr int LDS_K=0, LDS_V=NSLOT*SLOTB, LDS_WS=3*NSLOT*SLOTB, LDS_STASH=LDS_WS+NW*64*4, LDS_BYTES=LDS_STASH+NW*8192;
constexpr float C2=0.125f*1.4426950408889634f;
__device__ __forceinline__ void glds16(const void*gsrc,unsigned lds_dst){unsigned keep;
  asm volatile("s_mov_b32 %0, m0\n\ts_mov_b32 m0, %2\n\ts_nop 0\n\tglobal_load_lds_dwordx4 %1, off\n\ts_mov_b32 m0, %0":"=&s"(keep):"v"(gsrc),"s"(lds_dst):"memory");}
__device__ __forceinline__ float max3f(float a,float b,float c){float r;asm("v_max3_f32 %0, %1, %2, %3":"=v"(r):"v"(a),"v"(b),"v"(c));return r;}
__device__ __forceinline__ float max2f(float a,float b){float r;asm("v_max_f32_e32 %0, %1, %2":"=v"(r):"v"(a),"v"(b));return r;}
__device__ __forceinline__ float fadd_s(float a,float b){float r;asm("v_add_f32_e32 %0, %1, %2":"=v"(r):"v"(a),"v"(b));return r;}
__device__ __forceinline__ float fsub_s(float a,float b){float r;asm("v_sub_f32_e32 %0, %1, %2":"=v"(r):"v"(a),"v"(b));return r;}
typedef float f32x2_t __attribute__((ext_vector_type(2))); typedef __bf16 bf16x2_t __attribute__((ext_vector_type(2)));
__device__ __forceinline__ unsigned cvtpk_s(float lo,float hi){f32x2_t v={lo,hi};bf16x2_t b=__builtin_convertvector(v,bf16x2_t);return __builtin_bit_cast(unsigned,b);}
#define WAIT_BAR(N) asm volatile("s_waitcnt vmcnt(" #N ") lgkmcnt(0)\n\ts_barrier":::"memory")

__device__ __forceinline__ void qkt(f32x16&p0,f32x16&p1,const char*Kslot,const bf16x8*qr,int r32,int hi){ const f32x16 negm=f32x16{};
  const char*kb=Kslot+hi*1024+r32*16;
  #pragma unroll
  for(int d0=0;d0<4;++d0){
    const bf16x8 b0=*reinterpret_cast<const bf16x8*>(kb+d0*2048);
    const bf16x8 b1=*reinterpret_cast<const bf16x8*>(kb+d0*2048+512);
    if(d0==0){p0=__builtin_amdgcn_mfma_f32_32x32x16_bf16(b0,qr[0],negm,0,0,0);p1=__builtin_amdgcn_mfma_f32_32x32x16_bf16(b1,qr[0],negm,0,0,0);}
    else{p0=__builtin_amdgcn_mfma_f32_32x32x16_bf16(b0,qr[d0],p0,0,0,0);p1=__builtin_amdgcn_mfma_f32_32x32x16_bf16(b1,qr[d0],p1,0,0,0);}}
}
typedef __attribute__((address_space(3))) const char* lds_cptr;
typedef short v4i16_t __attribute__((ext_vector_type(4)));
__device__ __forceinline__ void kload8(bf16x8*kf,lds_cptr kp){
  kf[0]=*(const __attribute__((address_space(3))) bf16x8*)(kp);      kf[1]=*(const __attribute__((address_space(3))) bf16x8*)(kp+512);
  kf[2]=*(const __attribute__((address_space(3))) bf16x8*)(kp+2048); kf[3]=*(const __attribute__((address_space(3))) bf16x8*)(kp+2560);
  kf[4]=*(const __attribute__((address_space(3))) bf16x8*)(kp+4096); kf[5]=*(const __attribute__((address_space(3))) bf16x8*)(kp+4608);
  kf[6]=*(const __attribute__((address_space(3))) bf16x8*)(kp+6144); kf[7]=*(const __attribute__((address_space(3))) bf16x8*)(kp+6656);
}
__device__ __forceinline__ void kload2(bf16x8*kf,lds_cptr kp,int j){ kf[2*j]=*(const __attribute__((address_space(3))) bf16x8*)(kp+j*2048); kf[2*j+1]=*(const __attribute__((address_space(3))) bf16x8*)(kp+j*2048+512); }
__device__ __forceinline__ s16x4 vtr(lds_cptr p){ return __builtin_bit_cast(s16x4,__builtin_amdgcn_ds_read_tr16_b64_v4i16((__attribute__((address_space(3))) v4i16_t*)p)); }
__device__ __forceinline__ float rowmax(const f32x16&p0,const f32x16&p1){
  float a=max3f(p0[0],p0[1],p1[0]),b=max3f(p0[2],p0[3],p1[1]);a=max3f(a,p1[2],p1[3]);
  #pragma unroll
  for(int r=4;r<16;r+=4){a=max3f(a,p0[r],p0[r+1]);b=max3f(b,p0[r+2],p0[r+3]);a=max3f(a,p1[r],p1[r+1]);b=max3f(b,p1[r+2],p1[r+3]);}
  const float m=max2f(a,b);
  auto rr=__builtin_amdgcn_permlane32_swap(__float_as_uint(m),__float_as_uint(m),false,false);
  return max2f(__uint_as_float(rr[0]),__uint_as_float(rr[1]));
}
__device__ __forceinline__ void pv(f32x16*o,int vb,bf16x8 pa0,bf16x8 pa1,bf16x8 pa2,bf16x8 pa3){
  #pragma unroll
  for(int d0=0;d0<4;++d0){s16x4 lo[4],hi[4];
    #pragma unroll
    for(int ks=0;ks<4;++ks){
      asm volatile("ds_read_b64_tr_b16 %0,%1 offset:%c2":"=&v"(lo[ks]):"v"(vb),"i"(d0*4096+ks*1024):"memory");
      asm volatile("ds_read_b64_tr_b16 %0,%1 offset:%c2":"=&v"(hi[ks]):"v"(vb),"i"(d0*4096+ks*1024+512):"memory");}
    asm volatile("s_waitcnt lgkmcnt(0)":::"memory");SBAR();
    #define PK(k) (bf16x8){lo[k][0],lo[k][1],lo[k][2],lo[k][3],hi[k][0],hi[k][1],hi[k][2],hi[k][3]}
    o[d0]=__builtin_amdgcn_mfma_f32_32x32x16_bf16(pa0,PK(0),o[d0],0,0,0);
    o[d0]=__builtin_amdgcn_mfma_f32_32x32x16_bf16(pa1,PK(1),o[d0],0,0,0);
    o[d0]=__builtin_amdgcn_mfma_f32_32x32x16_bf16(pa2,PK(2),o[d0],0,0,0);
    o[d0]=__builtin_amdgcn_mfma_f32_32x32x16_bf16(pa3,PK(3),o[d0],0,0,0);
    #undef PK
  }
}

#ifndef ATTN_STORE16
#define ATTN_STORE16(p,v) (*(u32x4*)(p)=(v))
#endif
template<int THRL> __device__ __forceinline__ void attn_unit(int qb,int st,float lam,const float*sgp,const bf16*Qb,const bf16*__restrict__ Kb,const bf16*__restrict__ Vb,bf16*Ob,char*shm){
  int tid_=threadIdx.x; asm volatile("":"+v"(tid_));
  const int tid=tid_,lane=tid&63,r32=lane&31,hi=lane>>5; const int wid=__builtin_amdgcn_readfirstlane(tid>>6);
  const int q0=qb*QB;
  const bf16*Qw=Qb+(long)(q0+wid*QBLK)*PQ;
  const bf16*Kh=Kb,*Vh=Vb;
  const unsigned lds0=(unsigned)(uintptr_t)shm;
  float*wsf=(float*)(shm+LDS_WS)+wid*64;
  const bf16*ksrc=Kh+(long)lane*PQ+wid*8;
  const bf16*vsrc=Vh+(long)(16*(wid&3)+(lane>>2))*PQ+(wid>>2)*32+(lane&3)*8;
  const unsigned kdst=lds0+LDS_K+wid*1024, vdst=lds0+LDS_V+wid*1024;
  #define DMA_K(t,slot) glds16(ksrc+(long)(t)*KVBLK*PQ,(unsigned)__builtin_amdgcn_readfirstlane(kdst+(slot)))
  #define DMA_V(t,slot) do{ glds16(vsrc+(long)(t)*KVBLK*PQ,(unsigned)__builtin_amdgcn_readfirstlane(vdst+2*(slot))); glds16(vsrc+(long)(t)*KVBLK*PQ+64,(unsigned)__builtin_amdgcn_readfirstlane(vdst+2*(slot)+8192)); }while(0)
  const int vb0=(int)(lds0+LDS_V)+((lane>>4)&1)*32+(lane&3)*8+(4*hi+((lane&15)>>2))*64;
  const char*Kbase=shm+LDS_K; bf16x8 kf[8];
  const lds_cptr shm3=(lds_cptr)shm; const lds_cptr kp0=shm3+LDS_K+hi*1024+r32*16; const lds_cptr vp0=shm3+LDS_V+((lane>>4)&1)*32+(lane&3)*8+(4*hi+((lane&15)>>2))*64;
  const int NT=(q0+QB)/KVBLK;
  DMA_K(0,0);DMA_V(0,0);DMA_K(1,SLOTB);
  bf16x8 qr[4];
  #pragma unroll
  for(int d0=0;d0<4;++d0)qr[d0]=*reinterpret_cast<const bf16x8*>(&Qw[(long)r32*PQ+d0*16+hi*8]);
  float mhat=0.f,l_reg=0.f;f32x16 o[4];o[0]=f32x16{};o[1]=f32x16{};o[2]=f32x16{};o[3]=f32x16{};
  const int qrel=wid*QBLK+r32;
  #define CMASK(P0,P1,t) do{int jb_=(t)-(NT-4); if(jb_>=0)cmask(P0,P1,jb_,qrel,hi);}while(0)
  bool resc=false;
  #define START(P0,P1) do{ const float rm=rowmax(P0,P1); resc=false; mhat=rm; \
    _Pragma("unroll") for(int r=0;r<16;++r)P0[r]=__builtin_amdgcn_exp2f(P0[r]-mhat); }while(0)
  #define RESC() do{ if(resc){ asm volatile("s_waitcnt lgkmcnt(0)":::"memory"); \
      _Pragma("unroll") for(int d_=0;d_<4;++d_) _Pragma("unroll") for(int r=0;r<16;++r)o[d_][r]*=wsf[crow(r,hi)]; } }while(0)
  f32x16 pA0,pA1,pB0,pB1;
  int sl_prev=0,sl_cur=0,sl_next=SLOTB;
  #define ROT() do{sl_prev=sl_cur;sl_cur=sl_next;sl_next=(sl_next==(NSLOT-1)*SLOTB)?0:sl_next+SLOTB;}while(0)
  DMA_K(2,2*SLOTB);
  WAIT_BAR(4);
  qkt(pA0,pA1,Kbase,qr,r32,hi);asm volatile("s_nop 15\n\ts_nop 7":"+v"(pA0),"+v"(pA1));CMASK(pA0,pA1,0);
  START(pA0,pA1);
  _Pragma("unroll") for(int r=0;r<16;++r)pA1[r]=__builtin_amdgcn_exp2f(pA1[r]-mhat);
  WAIT_BAR(0);
  DMA_K(3,0);DMA_V(1,SLOTB);
  ROT();
  kload8(kf,kp0+sl_cur);
  WAIT_BAR(3);
  s16x4 vlo[4],vhi[4]; u32x4 pw0,pw1,pw2,pw3;
  #define PKW(P,B) cvtpk_s(P[B],P[B+1])
  #define PAF(k) __builtin_bit_cast(bf16x8,pw##k)
  #define PAFJ(j) __builtin_bit_cast(bf16x8,((j)<4?pw0:(j)<8?pw1:(j)<12?pw2:pw3))
  #define VFR(i) (bf16x8){vlo[i][0],vlo[i][1],vlo[i][2],vlo[i][3],vhi[i][0],vhi[i][1],vhi[i][2],vhi[i][3]}
  #define PIN(x) asm volatile("":"+v"(x))
  #define MX3(a,b,c) __builtin_fmaxf(__builtin_fmaxf((a),(b)),(c))
  #define GAPA(MF,A0,A1,A2,A3,W0,W1,PW) do{ MF; sacc+=A0; sacc+=A1; sacc+=A2; sacc+=A3; PIN(sacc); W0; W1; PIN(PW); SBAR(); }while(0)
  #define EX(v) __builtin_amdgcn_exp2f(v)
  #define GAPB(MF,X,B) do{ MF; X[B]=EX(X[B]-mhat); X[B+1]=EX(X[B+1]-mhat); PIN(X); SBAR(); }while(0)
  #define VRD(S,ks,d0) do{ vlo[S]=vtr(vp_+((d0)*4096+(ks)*1024)); vhi[S]=vtr(vp_+((d0)*4096+(ks)*1024+512)); }while(0)
  #define KRD(G,j) do{ if(G){ kload2(kf,kp0+sl_next,j); SBAR(); } }while(0)
  #define PVG(j,X,B) GAPB(o[(j)&3]=__builtin_amdgcn_mfma_f32_32x32x16_bf16(PAFJ(j),VFR((j)&3),o[(j)&3],0,0,0), X,B)
  #define STEP(C0,C1,P0,P1,t,GK,GV,GL) do{ SBAR(); \
    const lds_cptr vp_=vp0+2*sl_prev; \
    float sacc=(P0[0]+P0[1]); \
    GAPA(C0=__builtin_amdgcn_mfma_f32_32x32x16_bf16(kf[0],qr[0],f32x16{},0,0,0), P0[2],P0[3],P0[4],P0[5],     pw0[0]=PKW(P0,0), pw0[1]=PKW(P0,2), pw0); \
    GAPA(C1=__builtin_amdgcn_mfma_f32_32x32x16_bf16(kf[1],qr[0],f32x16{},0,0,0), P0[6],P0[7],P0[8],P0[9],     pw0[2]=PKW(P0,4), pw0[3]=PKW(P0,6), pw0); \
    GAPA(C0=__builtin_amdgcn_mfma_f32_32x32x16_bf16(kf[2],qr[1],C0,0,0,0),   P0[10],P0[11],P0[12],P0[13], pw1[0]=PKW(P0,8), pw1[1]=PKW(P0,10), pw1); \
    GAPA(C1=__builtin_amdgcn_mfma_f32_32x32x16_bf16(kf[3],qr[1],C1,0,0,0),   P0[14],P0[15],P1[0],P1[1],   pw1[2]=PKW(P0,12),pw1[3]=PKW(P0,14), pw1); \
    VRD(0,0,0); SBAR(); GAPA(C0=__builtin_amdgcn_mfma_f32_32x32x16_bf16(kf[4],qr[2],C0,0,0,0),   P1[2],P1[3],P1[4],P1[5],     pw2[0]=PKW(P1,0), pw2[1]=PKW(P1,2), pw2); \
    VRD(1,0,1); SBAR(); GAPA(C1=__builtin_amdgcn_mfma_f32_32x32x16_bf16(kf[5],qr[2],C1,0,0,0),   P1[6],P1[7],P1[8],P1[9],     pw2[2]=PKW(P1,4), pw2[3]=PKW(P1,6), pw2); \
    VRD(2,0,2); SBAR(); GAPA(C0=__builtin_amdgcn_mfma_f32_32x32x16_bf16(kf[6],qr[3],C0,0,0,0),   P1[10],P1[11],P1[12],P1[13], pw3[0]=PKW(P1,8), pw3[1]=PKW(P1,10), pw3); \
    VRD(3,0,3); SBAR(); GAPA(C1=__builtin_amdgcn_mfma_f32_32x32x16_bf16(kf[7],qr[3],C1,0,0,0),   P1[14],P1[15],0.f,0.f,       pw3[2]=PKW(P1,12),pw3[3]=PKW(P1,14), pw3); \
    l_reg+=sacc; \
    if(GK){DMA_K((t)+3,sl_cur);} if(GV){DMA_V((t)+1,sl_next);} \
    CMASK(C0,C1,t); \
    { float a=MX3(C0[0],C0[1],C1[0]),b=MX3(C0[2],C0[3],C1[1]); a=MX3(a,C1[2],C1[3]); \
      _Pragma("unroll") for(int r=4;r<16;r+=4){a=MX3(a,C0[r],C0[r+1]);b=MX3(b,C0[r+2],C0[r+3]);a=MX3(a,C1[r],C1[r+1]);b=MX3(b,C1[r+2],C1[r+3]);} \
      float rm=__builtin_fmaxf(a,b); { auto rr=__builtin_amdgcn_permlane32_swap(__float_as_uint(rm),__float_as_uint(rm),false,false); rm=__builtin_fmaxf(__uint_as_float(rr[0]),__uint_as_float(rr[1])); } \
      resc=false; rm-=mhat;                                   \
      if(__builtin_expect(__any(rm>(float)THRL),0)){ const float dl=__builtin_fmaxf(rm,0.f); mhat+=dl; \
        const float f=__builtin_amdgcn_exp2f(-dl); l_reg*=f; if(hi==0)wsf[r32]=f; resc=true; } } \
    SBAR(); \
      \
    PVG(0,C0,0);  VRD(0,1,0); SBAR(); \
    PVG(1,C0,2);  VRD(1,1,1); SBAR(); \
    PVG(2,C0,4);  VRD(2,1,2); SBAR(); \
    PVG(3,C0,6);  VRD(3,1,3); SBAR(); \
    PVG(4,C0,8);  VRD(0,2,0); SBAR(); \
    PVG(5,C0,10); VRD(1,2,1); SBAR(); \
    PVG(6,C0,12); VRD(2,2,2); SBAR(); \
    PVG(7,C0,14); VRD(3,2,3); SBAR(); \
    KRD(GL,0); PVG(8,C1,0);   VRD(0,3,0); SBAR(); \
    KRD(GL,1); PVG(9,C1,2);   VRD(1,3,1); SBAR(); \
    KRD(GL,2); PVG(10,C1,4);  VRD(2,3,2); SBAR(); \
    KRD(GL,3); PVG(11,C1,6);  VRD(3,3,3); SBAR(); \
    PVG(12,C1,8); PVG(13,C1,10); PVG(14,C1,12); PVG(15,C1,14); \
    }while(0)
  int t=1;
  #undef CMASK
  #define CMASK(P0,P1,t) do{}while(0)
  for(;t+5<NT;t+=2){
    STEP(pB0,pB1,pA0,pA1,t,true,true,true);     WAIT_BAR(3); RESC(); ROT();
    STEP(pA0,pA1,pB0,pB1,t+1,true,true,true);   WAIT_BAR(3); RESC(); ROT();
  }
  #undef CMASK
  #define CMASK(P0,P1,t) do{int jb_=(t)-(NT-4); if(jb_>=0)cmask(P0,P1,jb_,qrel,hi);}while(0)
  #define ENDW(tt) do{ if((tt)+3<NT){WAIT_BAR(3);} else if((tt)+2<NT){WAIT_BAR(2);} else {WAIT_BAR(0);} }while(0)
  for(;t+1<NT;t+=2){
    STEP(pB0,pB1,pA0,pA1,t,(t+3<NT),(t+1<NT),(t+1<NT));       ENDW(t);   RESC(); ROT();
    STEP(pA0,pA1,pB0,pB1,t+1,(t+4<NT),(t+2<NT),(t+2<NT));     ENDW(t+1); RESC(); ROT();
  }
  STEP(pB0,pB1,pA0,pA1,NT-1,false,false,false); RESC();
  { float sacc=pB0[0]+pB0[1]; _Pragma("unroll") for(int r=2;r<16;++r)sacc+=pB0[r]; _Pragma("unroll") for(int r=0;r<16;++r)sacc+=pB1[r]; l_reg+=sacc;
    pw0=(u32x4){PKW(pB0,0),PKW(pB0,2),PKW(pB0,4),PKW(pB0,6)};pw1=(u32x4){PKW(pB0,8),PKW(pB0,10),PKW(pB0,12),PKW(pB0,14)};pw2=(u32x4){PKW(pB1,0),PKW(pB1,2),PKW(pB1,4),PKW(pB1,6)};pw3=(u32x4){PKW(pB1,8),PKW(pB1,10),PKW(pB1,12),PKW(pB1,14)};
    SBAR(); pv(o,vb0+2*sl_cur,PAF(0),PAF(1),PAF(2),PAF(3)); }
  #undef PKW
  #undef PAF
  #undef PAFJ
  #undef PVG
  #undef VFR
  #undef PIN
  #undef MX3
  #undef GAPA
  #undef GAPB
  #undef EX
  #undef VRD
  #undef KRD
  #undef STEP
  #undef ENDW
  {auto rr=__builtin_amdgcn_permlane32_swap(__float_as_uint(l_reg),__float_as_uint(l_reg),false,false);l_reg=__uint_as_float(rr[0])+__uint_as_float(rr[1]);}
  if(hi==0)wsf[32+r32]=l_reg;asm volatile("s_waitcnt lgkmcnt(0)":::"memory");
  float rli[16];
  #pragma unroll
  for(int r=0;r<16;++r)rli[r]=__builtin_amdgcn_rcpf(wsf[32+crow(r,hi)]);
  bf16*stash=(bf16*)(shm+LDS_STASH)+wid*4096;
  if(st==0){
    #pragma unroll
    for(int r=0;r<16;++r){const int orow=crow(r,hi);
      #pragma unroll
      for(int d0=0;d0<4;++d0)stash[orow*128+d0*32+r32]=__float2bfloat16(o[d0][r]*rli[r]);}
  } else {
    asm volatile("s_waitcnt lgkmcnt(0)\n\ts_barrier":::"memory");
    bf16*stg=(bf16*)(shm+LDS_K)+wid*4096;
    #pragma unroll
    for(int r=0;r<16;++r){const int orow=crow(r,hi);
      #pragma unroll
      for(int d0=0;d0<4;++d0)stg[orow*128+d0*32+r32]=__float2bfloat16(o[d0][r]*rli[r]);}
    asm volatile("s_waitcnt lgkmcnt(0)":::"memory");
    bf16*Ow=Ob+(long)(q0+wid*QBLK)*PO;
    const int ch=lane&15; float sgv[8];
    #pragma unroll
    for(int i=0;i<8;++i)sgv[i]=sgp[ch*8+i]*(1.0f-LAMBDA_INIT);
    #pragma unroll
    for(int i=0;i<8;++i){const int row=i*4+(lane>>4);
      const u32x4 a4=*(const u32x4*)(stash+row*128+ch*8), b4=*(const u32x4*)(stg+row*128+ch*8);
      const unsigned aw[4]={a4.x,a4.y,a4.z,a4.w}, bw[4]={b4.x,b4.y,b4.z,b4.w}; float d[8]; float ss=0.f;
      #pragma unroll
      for(int c=0;c<4;++c){ d[2*c]=__uint_as_float(aw[c]<<16)-lam*__uint_as_float(bw[c]<<16); d[2*c+1]=__uint_as_float(aw[c]&0xffff0000u)-lam*__uint_as_float(bw[c]&0xffff0000u); ss+=d[2*c]*d[2*c]+d[2*c+1]*d[2*c+1]; }
      ss+=__shfl_xor(ss,1); ss+=__shfl_xor(ss,2); ss+=__shfl_xor(ss,4); ss+=__shfl_xor(ss,8);
      const float rn=rsqrtf(ss*(1.0f/128.0f)+LN_EPS);
      u32x4 ov; ov.x=cvtpk_s(d[0]*rn*sgv[0],d[1]*rn*sgv[1]); ov.y=cvtpk_s(d[2]*rn*sgv[2],d[3]*rn*sgv[3]); ov.z=cvtpk_s(d[4]*rn*sgv[4],d[5]*rn*sgv[5]); ov.w=cvtpk_s(d[6]*rn*sgv[6],d[7]*rn*sgv[7]);
      ATTN_STORE16(Ow+(long)row*PO+ch*8,ov); }
  }
  asm volatile("s_waitcnt lgkmcnt(0)\n\ts_barrier":::"memory");
  #undef DMA_K
  #undef DMA_V
  #undef CMASK
  #undef START
  #undef RESC
  #undef ROT
}
constexpr int ATTN_LDS_BYTES=LDS_BYTES;
template<int THRL=8> __device__ __forceinline__ void attn_phase(char*lds,const bf16_t*proj,bf16_t*mix,int vcu,float lam,const float*sgp){
  const int bh=vcu>>3,s8=vcu&7,b=bh>>2,h=bh&3;
  const bf16*P0=(const bf16*)proj+(long)b*SEQ*PQ; bf16*O0=(bf16*)mix+(long)b*SEQ*PO+h*128;
  for(int i=0;i<4;++i){ const int qb=(i<2)?(15-s8):s8, st=i&1;
    attn_unit<THRL>(qb,st,lam,sgp,P0+C_Q+st*256+h*64,P0+C_K+st*256+h*64,P0+C_V+h*128,O0,lds); }
}
#undef SBAR
#undef WAIT_BAR
}

constexpr int NWAVES = 8;
constexpr int RING_OFF = 0, RING_BYTES = 131072;
constexpr int LDSCTL_OFF = 155648, MISC_OFF = LDSCTL_OFF + 320;
constexpr int TAB_OFF = LDSCTL_OFF + 1024;
constexpr int REC_OFF = LDSCTL_OFF + 2048;
constexpr int LDS_BYTES = 163840;
static_assert(REC_OFF + (64 + 512) * 4 <= LDS_BYTES && attn_body::ATTN_LDS_BYTES <= LDSCTL_OFF && RING_BYTES <= LDSCTL_OFF, "LDS map");

#define GAS __attribute__((address_space(1)))
#define LAS __attribute__((address_space(3)))
typedef unsigned v4u __attribute__((ext_vector_type(4)));
typedef unsigned v2u __attribute__((ext_vector_type(2)));
typedef float f32x4 __attribute__((ext_vector_type(4)));
typedef float f32x2 __attribute__((ext_vector_type(2)));
typedef short bf16x8 __attribute__((ext_vector_type(8)));
typedef GAS unsigned gu32;
#define RLX_AGENT __ATOMIC_RELAXED, __HIP_MEMORY_SCOPE_AGENT
#define LDS_WAIT() asm volatile("s_waitcnt lgkmcnt(0)" ::: "memory")
#define VM_WAIT() asm volatile("s_waitcnt vmcnt(0)" ::: "memory")

#define XB_TMO      128
#define XB_XCNT(j)  (256  + 64 * (j))
#define XB_XSUB(j)  (1280 + 64 * (j))
#define XB_XGEN(j)  (2304 + 64 * (j))
#define XB_TOP      3328
#define XB_TOPGEN   3392
#define XCD_BAR_WORDS 3456
#define XB_SPIN_CAP (1u << 18)
__device__ __forceinline__ unsigned xb_ld(unsigned* p)              { return __hip_atomic_load(p, __ATOMIC_RELAXED, __HIP_MEMORY_SCOPE_AGENT); }
__device__ __forceinline__ unsigned xb_add(unsigned* p, unsigned v) { return __hip_atomic_fetch_add(p, v, __ATOMIC_RELAXED, __HIP_MEMORY_SCOPE_AGENT); }
__device__ __forceinline__ unsigned xb_xcc_id() { return (unsigned)__builtin_amdgcn_s_getreg((3 << 11) | 20) & 0xFu; }
#define XB_SPIN(cond, bar) do { unsigned _sp = 0; while (cond) { __builtin_amdgcn_s_sleep(1); \
    if ((++_sp & 255u) == 0u) { if (xb_ld(&(bar)[XB_TMO])) break; if (_sp > XB_SPIN_CAP) { atomicAdd(&(bar)[XB_TMO], 1u); break; } } } } while (0)
struct XcdBarrier { unsigned* bar; unsigned x; volatile LAS unsigned* st; };
__device__ __forceinline__ XcdBarrier xcd_barrier_post(unsigned* bar, volatile LAS unsigned* st) {
    XcdBarrier b; b.bar = bar; b.x = xb_xcc_id(); b.st = st;
    if (threadIdx.x == 0) (void)xb_add(&bar[XB_XCNT(b.x)], 1u);
    return b;
}
__device__ __forceinline__ void xcd_barrier_complete(unsigned* bar, unsigned x, unsigned& nloc, unsigned& nx) {
    const unsigned G = gridDim.x * gridDim.y * gridDim.z;
    unsigned sum, cnt, mine, sp = 0u;
    for (;;) {
        sum = 0u; cnt = 0u; mine = 0u;
#pragma unroll
        for (unsigned j = 0; j < 16; ++j) { const unsigned c = xb_ld(&bar[XB_XCNT(j)]); sum += c; cnt += (c > 0u) ? 1u : 0u; mine = (j == x) ? c : mine; }
        if (sum == G) break;
        __builtin_amdgcn_s_sleep(1);
        if ((++sp & 255u) == 0u) { if (xb_ld(&bar[XB_TMO])) break; if (sp > XB_SPIN_CAP) { atomicAdd(&bar[XB_TMO], 1u); break; } }
    }
    nloc = mine > 0u ? mine : 1u; nx = cnt > 0u ? cnt : 1u;
}
__device__ __forceinline__ void xcd_barrier(const XcdBarrier& b) {
    asm volatile("s_waitcnt vmcnt(0)" ::: "memory");
    __syncthreads();
    if (threadIdx.x == 0) {
        unsigned* bar = b.bar;
        __builtin_amdgcn_s_waitcnt(0);
        unsigned nloc = b.st[0], nx = b.st[1];
        if (nloc == 0u) { xcd_barrier_complete(bar, b.x, nloc, nx); b.st[0] = nloc; b.st[1] = nx; }
        const unsigned old = xb_add(&bar[XB_XSUB(b.x)], 1u);
        const unsigned gen = old / nloc;
        if (old + 1u == (gen + 1u) * nloc) {
            __builtin_amdgcn_fence(__ATOMIC_RELEASE, "agent");
            asm volatile("s_waitcnt vmcnt(0)" ::: "memory");
            const unsigned og = xb_add(&bar[XB_TOP], 1u);
            const unsigned tg = og / nx;
            if (og + 1u == (tg + 1u) * nx) xb_add(&bar[XB_TOPGEN], 1u);
            else XB_SPIN(xb_ld(&bar[XB_TOPGEN]) == tg, bar);
            __builtin_amdgcn_fence(__ATOMIC_ACQUIRE, "agent");
            xb_add(&bar[XB_XGEN(b.x)], 1u);
            asm volatile("s_waitcnt vmcnt(0)" ::: "memory");
        } else {
            XB_SPIN(xb_ld(&bar[XB_XGEN(b.x)]) == gen, bar);
            __builtin_amdgcn_fence(__ATOMIC_ACQUIRE, "agent");
            asm volatile("s_waitcnt vmcnt(0)" ::: "memory");
        }
    }
    __syncthreads();
}

struct Args { const float* in[22]; float* out; unsigned char* ws; int ph_lo, ph_hi, pad0, pad1; };
struct Frame {
    LAS unsigned char* lds; volatile LAS unsigned* MISC; gu32* ctl;
    int tid, lane, wave, vcu, G;
};

typedef const __attribute__((address_space(4))) Args* kargs_t;
__device__ __forceinline__ Args fetch_args() {
    kargs_t kp = (kargs_t)__builtin_amdgcn_kernarg_segment_ptr();
    asm volatile("" : "+s"(kp));
    Args a;
#pragma unroll
    for (int i = 0; i < 22; ++i) a.in[i] = kp->in[i];
    a.out = kp->out; a.ws = kp->ws; a.ph_lo = kp->ph_lo; a.ph_hi = kp->ph_hi; a.pad0 = kp->pad0; a.pad1 = kp->pad1;
    return a;
}
__device__ __forceinline__ void refresh_frame(Frame& F) { int t = threadIdx.x; asm volatile("" : "+v"(t)); F.tid = t; F.lane = t & 63; F.wave = __builtin_amdgcn_readfirstlane(t >> 6); }

__device__ __forceinline__ void p0_transpose_item(const float* W, int K, int N, bf16_t* WT, long row_off, LAS float* scr, int item, int lane) {
    const int nblk = N / 32, kb = item / nblk, nb = item % nblk, k0 = 64 * kb, n0 = 32 * nb;
#pragma unroll 8
    for (int i = 0; i < 32; ++i) { const int kk = 2 * i + (lane >> 5); scr[kk * 33 + (lane & 31)] = W[(size_t)(k0 + kk) * N + n0 + (lane & 31)]; }
    LDS_WAIT(); asm volatile("" ::: "memory");
    const int c = lane & 7;
#pragma unroll
    for (int j = 0; j < 4; ++j) { const int n = (lane >> 3) + 8 * j; const LAS float* s = scr + (8 * c) * 33 + n;
        v4u o; o.x = pk2(s[0 * 33], s[1 * 33]); o.y = pk2(s[2 * 33], s[3 * 33]); o.z = pk2(s[4 * 33], s[5 * 33]); o.w = pk2(s[6 * 33], s[7 * 33]);
        *(GAS v4u*)(WT + (size_t)(row_off + n0 + n) * K + k0 + 8 * c) = o; }
    LDS_WAIT(); asm volatile("" ::: "memory");
}
__device__ __forceinline__ void p0_transpose_item8(const float* W, int K, int N, unsigned char* WT, long row_off, LAS float* scr, int item, int lane) {
    const int nblk = N / 32, kb = item / nblk, nb = item % nblk, k0 = 64 * kb, n0 = 32 * nb;
#pragma unroll 8
    for (int i = 0; i < 32; ++i) { const int kk = 2 * i + (lane >> 5); scr[kk * 33 + (lane & 31)] = W[(size_t)(k0 + kk) * N + n0 + (lane & 31)]; }
    LDS_WAIT(); asm volatile("" ::: "memory");
    const int c = lane & 3; constexpr float SC = (float)(1 << pg8::WSHIFT);
#pragma unroll
    for (int j = 0; j < 2; ++j) { const int n = (lane >> 2) + 16 * j; const LAS float* s = scr + (16 * c) * 33 + n;
        v4u o; o.x = pg8::pk4_fp8(s[0 * 33] * SC, s[1 * 33] * SC, s[2 * 33] * SC, s[3 * 33] * SC); o.y = pg8::pk4_fp8(s[4 * 33] * SC, s[5 * 33] * SC, s[6 * 33] * SC, s[7 * 33] * SC);
        o.z = pg8::pk4_fp8(s[8 * 33] * SC, s[9 * 33] * SC, s[10 * 33] * SC, s[11 * 33] * SC); o.w = pg8::pk4_fp8(s[12 * 33] * SC, s[13 * 33] * SC, s[14 * 33] * SC, s[15 * 33] * SC);
        *(GAS v4u*)(WT + (size_t)(row_off + n0 + n) * K + k0 + 16 * c) = o; }
    LDS_WAIT(); asm volatile("" ::: "memory");
}
__device__ __forceinline__ void p0_prologue(Frame& F, const Args& a) {
    LAS float* scr = (LAS float*)(F.lds + RING_OFF + F.wave * 16384);
    const int gw = F.vcu * NWAVES + F.wave, NGW = F.G * NWAVES;
    unsigned char* ws = a.ws;
    constexpr int I_IN = (DM / 64) * (INW / 32), I_O = (DM / 64) * (DM / 32), I_UP1 = (DM / 64) * (2 * DFF / 32), I_DN1 = (DFF / 64) * (DM / 32);
    constexpr int NITEMS = I_IN + I_O + NE * I_UP1 + NE * I_DN1;
    for (int it = gw; it < NITEMS; it += NGW) {
        int r = it;
        if (r < I_IN) { p0_transpose_item(a.in[1], DM, INW, (bf16_t*)(ws + WS_WIN), 0, scr, r, F.lane); continue; } r -= I_IN;
        if (r < I_O) { p0_transpose_item(a.in[11], DM, DM, (bf16_t*)(ws + WS_WO), 0, scr, r, F.lane); continue; } r -= I_O;
        if (r < NE * I_UP1) { const int e = r / I_UP1, ii = r % I_UP1; const int n0 = 32 * (ii % (2 * DFF / 32));
            const int bj = n0 / DFF, f = n0 % DFF, rho0 = 256 * (f / 128) + 128 * bj + (f % 128);
#if MOE_FP8
            p0_transpose_item8(a.in[16] + (size_t)e * DM * 2 * DFF, DM, 2 * DFF, (unsigned char*)(ws + WS_WUP) + (size_t)e * 2 * DFF * DM, (long)rho0 - n0, scr, ii, F.lane); continue; }
#else
            p0_transpose_item(a.in[16] + (size_t)e * DM * 2 * DFF, DM, 2 * DFF, (bf16_t*)(ws + WS_WUP) + (size_t)e * 2 * DFF * DM, (long)rho0 - n0, scr, ii, F.lane); continue; }
#endif
        r -= NE * I_UP1;
        { const int e = r / I_DN1, ii = r % I_DN1;
#if MOE_FP8
            p0_transpose_item8(a.in[18] + (size_t)e * DFF * DM, DFF, DM, (unsigned char*)(ws + WS_WDN) + (size_t)e * DM * DFF, 0, scr, ii, F.lane); }
#else
            p0_transpose_item(a.in[18] + (size_t)e * DFF * DM, DFF, DM, (bf16_t*)(ws + WS_WDN) + (size_t)e * DM * DFF, 0, scr, ii, F.lane); }
#endif
    }
    const float* x = a.in[0]; bf16_t* xb = (bf16_t*)(ws + WS_XB);
    for (int m = gw; m < NTOK; m += NGW) {
        const GAS f32x4* xr = (const GAS f32x4*)(x + (size_t)m * DM) + F.lane; GAS v2u* o8 = (GAS v2u*)(xb + (size_t)m * DM) + F.lane;
        f32x4 v[4];
#pragma unroll
        for (int j = 0; j < 4; ++j) v[j] = xr[64 * j];
#pragma unroll
        for (int j = 0; j < 4; ++j) { v2u o; o.x = pk2(v[j].x, v[j].y); o.y = pk2(v[j].z, v[j].w); o8[64 * j] = o; }
    }
}

__device__ __forceinline__ void gmlp_phase(Frame& F, const Args& a) {
    const bf16_t* proj = (const bf16_t*)(a.ws + WS_PROJ); bf16_t* mix = (bf16_t*)(a.ws + WS_MIX);
    const float *lng = a.in[7], *lnb = a.in[8], *wsp = a.in[9], *bsp = a.in[10];
    LAS f32x2* st = (LAS f32x2*)(F.lds + RING_OFF);
    LAS bf16_t* Vg = (LAS bf16_t*)(F.lds + RING_OFF + 1024);
    LAS bf16_t* Wg = (LAS bf16_t*)(F.lds + RING_OFF + 19456);
    LAS float* Zg = (LAS float*)(F.lds + RING_OFF + 54272);
    const int tid = F.tid, lane = F.lane, w = F.wave;
    for (int c = blockIdx.x; c < NTOK / CHUNK; c += F.G) {
        const size_t row0 = (size_t)c * CHUNK;
        for (int s = 16 * w; s < 16 * w + 16; ++s) {
            const v4u raw = *(const GAS v4u*)(proj + (row0 + s) * INW + C_GV + lane * 8);
            const unsigned rw[4] = {raw.x, raw.y, raw.z, raw.w}; float v[8]; float sum = 0.f;
#pragma unroll
            for (int i = 0; i < 4; ++i) { const f32x2 gg = pg8::gelu_pk((f32x2){bf2f((bf16_t)(rw[i] & 0xffff)), bf2f((bf16_t)(rw[i] >> 16))}); v[2 * i] = gg.x; v[2 * i + 1] = gg.y; sum += gg.x + gg.y; }
            const float mean = wave_sum(sum) * (1.0f / GW); float q = 0.f;
#pragma unroll
            for (int i = 0; i < 8; ++i) { const float d = v[i] - mean; q += d * d; }
            const float var = wave_sum(q) * (1.0f / GW);
            if (lane == 0) st[s] = (f32x2){mean, rsqrtf(var + LN_EPS)};
        }
        __syncthreads();
        for (int g = 0; g < NG; ++g) {
            {
                const int row = tid >> 2, cq = (tid & 3) * 16, col = g * GD + cq; const f32x2 ms = st[row];
                const GAS v4u* src = (const GAS v4u*)(proj + (row0 + row) * INW + C_GV + col);
                unsigned ow[8];
#pragma unroll
                for (int hh = 0; hh < 2; ++hh) { const v4u raw = src[hh]; const unsigned rw[4] = {raw.x, raw.y, raw.z, raw.w};
#pragma unroll
                    for (int i = 0; i < 4; ++i) { const f32x2 gg = pg8::gelu_pk((f32x2){bf2f((bf16_t)(rw[i] & 0xffff)), bf2f((bf16_t)(rw[i] >> 16))});
                        const int cc = col + hh * 8 + 2 * i;
                        ow[hh * 4 + i] = pk2((gg.x - ms.x) * ms.y * lng[cc] + lnb[cc], (gg.y - ms.x) * ms.y * lng[cc + 1] + lnb[cc + 1]); } }
                *(LAS v4u*)(Vg + row * 72 + cq) = (v4u){ow[0], ow[1], ow[2], ow[3]};
                *(LAS v4u*)(Vg + row * 72 + cq + 8) = (v4u){ow[4], ow[5], ow[6], ow[7]};
#pragma unroll
                for (int k = 0; k < 8; ++k) { const int i = tid + 512 * k, t = i >> 5, s4 = (i & 31) * 4;
                    const f32x4 wv = *(const GAS f32x4*)(wsp + ((size_t)g * CHUNK + t) * CHUNK + s4);
                    v2u o; o.x = pk2(s4 <= t ? wv.x : 0.f, s4 + 1 <= t ? wv.y : 0.f); o.y = pk2(s4 + 2 <= t ? wv.z : 0.f, s4 + 3 <= t ? wv.w : 0.f);
                    *(LAS v2u*)(Wg + t * 136 + s4) = o; }
            }
            __syncthreads();
            {
                f32x4 acc[4];
#pragma unroll
                for (int n = 0; n < 4; ++n) acc[n] = (f32x4){0.f, 0.f, 0.f, 0.f};
                const int t0 = 16 * w, fr = lane & 15, fq = lane >> 4;
                for (int ks = 0; ks * 32 <= t0 + 15; ++ks) {
                    const bf16x8 af = *(const LAS bf16x8*)(Wg + (t0 + fr) * 136 + ks * 32 + fq * 8);
#pragma unroll
                    for (int n = 0; n < 4; ++n) { bf16x8 bfv;
#pragma unroll
                        for (int j = 0; j < 8; ++j) bfv[j] = (short)Vg[(ks * 32 + fq * 8 + j) * 72 + n * 16 + fr];
                        acc[n] = __builtin_amdgcn_mfma_f32_16x16x32_bf16(af, bfv, acc[n], 0, 0, 0); }
                }
#pragma unroll
                for (int n = 0; n < 4; ++n)
#pragma unroll
                    for (int r = 0; r < 4; ++r) Zg[(t0 + fq * 4 + r) * 68 + n * 16 + fr] = acc[n][r];
            }
            __syncthreads();
            {
                const int row = tid >> 2, cq = (tid & 3) * 16, col = g * GD + cq; const float bb = bsp[g * CHUNK + row];
                const GAS v4u* src = (const GAS v4u*)(proj + (row0 + row) * INW + C_GU + col);
                unsigned ow[8];
#pragma unroll
                for (int hh = 0; hh < 2; ++hh) { const v4u raw = src[hh]; const unsigned rw[4] = {raw.x, raw.y, raw.z, raw.w};
#pragma unroll
                    for (int i = 0; i < 4; ++i) { const f32x2 uu = pg8::gelu_pk((f32x2){bf2f((bf16_t)(rw[i] & 0xffff)), bf2f((bf16_t)(rw[i] >> 16))});
                        const f32x2 zz = *(const LAS f32x2*)(Zg + row * 68 + cq + hh * 8 + 2 * i);
                        ow[hh * 4 + i] = pk2(uu.x * (zz.x + bb), uu.y * (zz.y + bb)); } }
                GAS v4u* dst = (GAS v4u*)(mix + (row0 + row) * DM + GW + col);
                dst[0] = (v4u){ow[0], ow[1], ow[2], ow[3]}; dst[1] = (v4u){ow[4], ow[5], ow[6], ow[7]};
            }
            __syncthreads();
        }
    }
}

__device__ __forceinline__ void attn_combine_phase(Frame& F, const Args& a) {
    const bf16_t* atto = (const bf16_t*)(a.ws + WS_ATTO); bf16_t* mix = (bf16_t*)(a.ws + WS_MIX);
    const int lane = F.lane, gw = F.vcu * NWAVES + F.wave, NGW = F.G * NWAVES;
    const float lam = expf(wave_sum(a.in[2][lane] * a.in[3][lane])) - expf(wave_sum(a.in[4][lane] * a.in[5][lane])) + LAMBDA_INIT;
    const int h = lane >> 4, e0 = (lane & 15) * 8;
    float sg[8];
#pragma unroll
    for (int i = 0; i < 8; ++i) sg[i] = a.in[6][e0 + i] * (1.0f - LAMBDA_INIT);
    for (int t = gw; t < NTOK; t += NGW) {
        const v4u r1 = *(const GAS v4u*)(atto + (size_t)t * DM + h * 256 + e0), r2 = *(const GAS v4u*)(atto + (size_t)t * DM + h * 256 + 128 + e0);
        const unsigned w1[4] = {r1.x, r1.y, r1.z, r1.w}, w2[4] = {r2.x, r2.y, r2.z, r2.w};
        float d[8]; float ss = 0.f;
#pragma unroll
        for (int i = 0; i < 4; ++i) { d[2 * i] = bf2f((bf16_t)(w1[i] & 0xffff)) - lam * bf2f((bf16_t)(w2[i] & 0xffff)); d[2 * i + 1] = bf2f((bf16_t)(w1[i] >> 16)) - lam * bf2f((bf16_t)(w2[i] >> 16)); ss += d[2 * i] * d[2 * i] + d[2 * i + 1] * d[2 * i + 1]; }
        ss += __shfl_xor(ss, 1); ss += __shfl_xor(ss, 2); ss += __shfl_xor(ss, 4); ss += __shfl_xor(ss, 8);
        const float r = rsqrtf(ss * (1.0f / DV) + LN_EPS);
        v4u o; o.x = pk2(d[0] * r * sg[0], d[1] * r * sg[1]); o.y = pk2(d[2] * r * sg[2], d[3] * r * sg[3]); o.z = pk2(d[4] * r * sg[4], d[5] * r * sg[5]); o.w = pk2(d[6] * r * sg[6], d[7] * r * sg[7]);
        *(GAS v4u*)(mix + (size_t)t * DM + h * DV + e0) = o;
    }
}

template <int CTRL> __device__ __forceinline__ float dppf(float v) { return __builtin_bit_cast(float, __builtin_amdgcn_update_dpp(0, __builtin_bit_cast(int, v), CTRL, 0xF, 0xF, true)); }
template <int CTRL> __device__ __forceinline__ int dppi(int v) { return __builtin_amdgcn_update_dpp(0, v, CTRL, 0xF, 0xF, true); }
__device__ __forceinline__ float rlf(float v, int l) { return __builtin_bit_cast(float, __builtin_amdgcn_readlane(__builtin_bit_cast(int, v), l)); }
__device__ __forceinline__ float wsum_dpp(float v) {
    v += dppf<0xB1>(v); v += dppf<0x4E>(v); v += dppf<0x141>(v); v += dppf<0x140>(v);
    return (rlf(v, 0) + rlf(v, 16)) + (rlf(v, 32) + rlf(v, 48));
}
__device__ __forceinline__ float wmax_dpp(float v) {
    v = fmaxf(v, dppf<0xB1>(v)); v = fmaxf(v, dppf<0x4E>(v)); v = fmaxf(v, dppf<0x141>(v)); v = fmaxf(v, dppf<0x140>(v));
    return fmaxf(fmaxf(rlf(v, 0), rlf(v, 16)), fmaxf(rlf(v, 32), rlf(v, 48)));
}
__device__ __forceinline__ int wmin_dpp(int v) {
    v = min(v, dppi<0xB1>(v)); v = min(v, dppi<0x4E>(v)); v = min(v, dppi<0x141>(v)); v = min(v, dppi<0x140>(v));
    return min(min(__builtin_amdgcn_readlane(v, 0), __builtin_amdgcn_readlane(v, 16)), min(__builtin_amdgcn_readlane(v, 32), __builtin_amdgcn_readlane(v, 48)));
}
__device__ __forceinline__ void route_phase(Frame& F, const Args& a) {
    const float* h1 = (const float*)(a.ws + WS_H1); bf16_t* xb = (bf16_t*)(a.ws + WS_XB); bf16_t* x1b = (bf16_t*)(a.ws + WS_X1B);
    int* list = (int*)(a.ws + WS_LIST); int* re = (int*)(a.ws + WS_RE); int* rr = (int*)(a.ws + WS_RR); float* rg = (float*)(a.ws + WS_RG);
    const float *g1 = a.in[12], *b1 = a.in[13], *wr = a.in[14], *br = a.in[15];
    constexpr int XS = 1028;
    LAS float* XT = (LAS float*)(F.lds + RING_OFF);
    LAS float* PT = (LAS float*)(F.lds + RING_OFF + 16 * XS * 4);
    LAS int* lcnt = (LAS int*)(F.lds + REC_OFF); LAS int* lbase = lcnt + 32; LAS int* rec = lcnt + 64;
    const int tid = F.tid, lane = F.lane, w = F.wave, fr = lane & 15, fq = lane >> 4;
    if (tid < 32) lcnt[tid] = 0;
    constexpr int RPB = NTOK / 256;
    const int tblk = blockIdx.x * RPB;
    f32x4 pv[2][4];
#define ROUTE_LOAD(ch_) do { _Pragma("unroll") for (int q = 0; q < 2; ++q) _Pragma("unroll") for (int j = 0; j < 4; ++j) \
        pv[q][j] = *(const GAS f32x4*)(h1 + (size_t)(tblk + (ch_) * 16 + 2 * w + q) * DM + j * 256 + lane * 4); } while (0)
    ROUTE_LOAD(0);
    float bw[32][2];
#pragma unroll
    for (int s = 0; s < 32; ++s)
#pragma unroll
        for (int n = 0; n < 2; ++n) bw[s][n] = wr[(size_t)(128 * w + 4 * s + fq) * NE + 16 * n + fr];
    const int myexp = lane & 31; const float mybr = br[myexp];
    for (int ch = 0; ch < 8; ++ch) {
        const int t0 = tblk + ch * 16;
        {
            float mean[2], rstd[2];
#pragma unroll
            for (int q = 0; q < 2; ++q) { float s = 0.f;
#pragma unroll
                for (int j = 0; j < 4; ++j) s += (pv[q][j].x + pv[q][j].y) + (pv[q][j].z + pv[q][j].w);
                mean[q] = wsum_dpp(s) * (1.0f / DM); }
#pragma unroll
            for (int q = 0; q < 2; ++q) { float q2 = 0.f;
#pragma unroll
                for (int j = 0; j < 4; ++j) { pv[q][j] = pv[q][j] - mean[q]; q2 += (pv[q][j].x * pv[q][j].x + pv[q][j].y * pv[q][j].y) + (pv[q][j].z * pv[q][j].z + pv[q][j].w * pv[q][j].w); }
                rstd[q] = rsqrtf(wsum_dpp(q2) * (1.0f / DM) + LN_EPS); }
#pragma unroll
            for (int j = 0; j < 4; ++j) {
                const int col = j * 256 + lane * 4;
                const f32x4 gq = *(const GAS f32x4*)(g1 + col), bq = *(const GAS f32x4*)(b1 + col);
#pragma unroll
                for (int q = 0; q < 2; ++q) {
                    const int rl = 2 * w + q, t = t0 + rl;
                    const f32x4 o = pv[q][j] * rstd[q] * gq + bq;
                    { v2u pk1; pk1.x = pk2(o.x, o.y); pk1.y = pk2(o.z, o.w); *(GAS v2u*)(x1b + (size_t)t * DM + col) = pk1; }
                    *(LAS f32x4*)(XT + rl * XS + col) = o;
#if MOE_FP8
                    *(GAS unsigned*)((unsigned char*)xb + (size_t)t * DM + col) = pg8::pk4_fp8(o.x, o.y, o.z, o.w);
#else
                    v2u pk; pk.x = pk2(o.x, o.y); pk.y = pk2(o.z, o.w);
                    *(GAS v2u*)(xb + (size_t)t * DM + col) = pk;
#endif
                }
            }
        }
        if (ch < 7) ROUTE_LOAD(ch + 1);
        __syncthreads();
        {
            f32x4 acc0 = (f32x4){0.f, 0.f, 0.f, 0.f}, acc1 = (f32x4){0.f, 0.f, 0.f, 0.f};
            const LAS float* xp = XT + fr * XS + 128 * w + fq;
#pragma unroll
            for (int s = 0; s < 32; ++s) { const float av = xp[4 * s];
                acc0 = __builtin_amdgcn_mfma_f32_16x16x4f32(av, bw[s][0], acc0, 0, 0, 0);
                acc1 = __builtin_amdgcn_mfma_f32_16x16x4f32(av, bw[s][1], acc1, 0, 0, 0); }
#pragma unroll
            for (int r = 0; r < 4; ++r) { PT[(w * 16 + fq * 4 + r) * 32 + fr] = acc0[r]; PT[(w * 16 + fq * 4 + r) * 32 + 16 + fr] = acc1[r]; }
        }
        __syncthreads();
        {
            float cur[2];
#pragma unroll
            for (int q = 0; q < 2; ++q) { cur[q] = mybr;
#pragma unroll
                for (int ww = 0; ww < 8; ++ww) cur[q] += PT[(ww * 16 + 2 * w + q) * 32 + myexp]; }
            int idx[2][4]; float val[2][4];
#pragma unroll
            for (int k = 0; k < 4; ++k)
#pragma unroll
                for (int q = 0; q < 2; ++q) {
                    const float m = wmax_dpp(cur[q]);
                    const int cand = wmin_dpp((cur[q] == m) ? myexp : 99);
                    idx[q][k] = cand; val[q][k] = m; if (myexp == cand) cur[q] = -INFINITY;
                }
#pragma unroll
            for (int q = 0; q < 2; ++q) {
                const int rl = 2 * w + q, t = t0 + rl;
                float ex[4], se = 0.f;
#pragma unroll
                for (int k = 0; k < 4; ++k) { ex[k] = expf(val[q][k] - val[q][0]); se += ex[k]; }
                if (lane < 4) {
                    int e_ = idx[q][0]; float g_ = ex[0];
                    if (lane == 1) { e_ = idx[q][1]; g_ = ex[1]; } else if (lane == 2) { e_ = idx[q][2]; g_ = ex[2]; } else if (lane == 3) { e_ = idx[q][3]; g_ = ex[3]; }
                    const int lr = __hip_atomic_fetch_add(lcnt + e_, 1, __ATOMIC_RELAXED, __HIP_MEMORY_SCOPE_WORKGROUP);
                    rec[(ch * 16 + rl) * 4 + lane] = e_ | (lr << 8);
                    re[t * 4 + lane] = e_; rg[t * 4 + lane] = g_ / se;
                }
            }
        }
    }
#undef ROUTE_LOAD
    __syncthreads();
    if (tid < 32) lbase[tid] = (int)__hip_atomic_fetch_add((unsigned*)(F.ctl + CW_CNT + tid), (unsigned)lcnt[tid], RLX_AGENT);
    __syncthreads();
    { const int rw = tid >> 2, k = tid & 3; const int t = tblk + rw; const int rc = rec[tid]; const int e_ = rc & 255, r_ = lbase[e_] + (rc >> 8);
      rr[t * 4 + k] = r_; list[e_ * NTOK + r_] = t; }
}
__device__ __forceinline__ void build_tab(Frame& F) {
    LAS int* tab = (LAS int*)(F.lds + TAB_OFF);
    if (F.tid < 32) tab[40 + F.tid] = (int)__hip_atomic_load(F.ctl + CW_CNT + F.tid, RLX_AGENT);
    __syncthreads();
    if (F.tid == 0) { int p = 0; for (int e = 0; e < NE; ++e) { tab[e] = p; p += (tab[40 + e] + 255) >> 8; } tab[NE] = p; }
    __syncthreads();
}
__device__ __forceinline__ void combine_phase(Frame& F, const Args& a) {
    const bf16_t* x1 = (const bf16_t*)(a.ws + WS_X1B); const unsigned char* y = (const unsigned char*)(a.ws + WS_Y);
    const int* re = (const int*)(a.ws + WS_RE); const int* rr = (const int*)(a.ws + WS_RR); const float* rg = (const float*)(a.ws + WS_RG);
    float* out = a.out;
    const LAS int* tab = (const LAS int*)(F.lds + TAB_OFF);
    const int lane = F.lane, gw = F.vcu * NWAVES + F.wave, NGW = F.G * NWAVES, c0 = lane * 16;
    f32x4 g2v[4], b2v[4];
#pragma unroll
    for (int j = 0; j < 4; ++j) { g2v[j] = *(const GAS f32x4*)(a.in[20] + c0 + 4 * j); b2v[j] = *(const GAS f32x4*)(a.in[21] + c0 + 4 * j); }
    for (int tt = gw; tt < NTOK; tt += 2 * NGW) {
        float v[2][16];
#pragma unroll
        for (int q = 0; q < 2; ++q) {
            const int t = tt + q * NGW;
            const v4u xa = *(const GAS v4u*)(x1 + (size_t)t * DM + c0), xb_ = *(const GAS v4u*)(x1 + (size_t)t * DM + c0 + 8);
            const unsigned xw[8] = {xa.x, xa.y, xa.z, xa.w, xb_.x, xb_.y, xb_.z, xb_.w};
#pragma unroll
            for (int i = 0; i < 8; ++i) { v[q][2 * i] = ALPHA * bf2f((bf16_t)(xw[i] & 0xffff)); v[q][2 * i + 1] = ALPHA * bf2f((bf16_t)(xw[i] >> 16)); }
#pragma unroll
            for (int k = 0; k < 4; ++k) {
                const int e = re[t * 4 + k], slot = tab[e] * 256 + rr[t * 4 + k]; const float g = rg[t * 4 + k];
#if MOE_FP8
                const v4u yw = *(const GAS v4u*)(y + (size_t)slot * DM + c0); const unsigned yy[4] = {yw.x, yw.y, yw.z, yw.w};
#pragma unroll
                for (int i = 0; i < 4; ++i) { const f32x2 lo = __builtin_amdgcn_cvt_pk_f32_fp8((int)yy[i], false), hi = __builtin_amdgcn_cvt_pk_f32_fp8((int)yy[i], true);
                    v[q][4 * i] = fmaf(g, lo.x, v[q][4 * i]); v[q][4 * i + 1] = fmaf(g, lo.y, v[q][4 * i + 1]); v[q][4 * i + 2] = fmaf(g, hi.x, v[q][4 * i + 2]); v[q][4 * i + 3] = fmaf(g, hi.y, v[q][4 * i + 3]); }
#else
                const v4u ya = *(const GAS v4u*)((const bf16_t*)y + (size_t)slot * DM + c0), yb = *(const GAS v4u*)((const bf16_t*)y + (size_t)slot * DM + c0 + 8);
                const unsigned yy[8] = {ya.x, ya.y, ya.z, ya.w, yb.x, yb.y, yb.z, yb.w};
#pragma unroll
                for (int i = 0; i < 8; ++i) { v[q][2 * i] = fmaf(g, bf2f((bf16_t)(yy[i] & 0xffff)), v[q][2 * i]); v[q][2 * i + 1] = fmaf(g, bf2f((bf16_t)(yy[i] >> 16)), v[q][2 * i + 1]); }
#endif
            }
        }
#pragma unroll
        for (int q = 0; q < 2; ++q) {
            const int t = tt + q * NGW;
            float s = 0.f;
#pragma unroll
            for (int i = 0; i < 16; ++i) s += v[q][i];
            const float mean = wsum_dpp(s) * (1.0f / DM); float q2 = 0.f;
#pragma unroll
            for (int i = 0; i < 16; ++i) { v[q][i] -= mean; q2 += v[q][i] * v[q][i]; }
            const float rstd = rsqrtf(wsum_dpp(q2) * (1.0f / DM) + LN_EPS);
#pragma unroll
            for (int j = 0; j < 4; ++j)
                *(GAS f32x4*)(out + (size_t)t * DM + c0 + 4 * j) = (f32x4){v[q][4 * j] * rstd * g2v[j].x + b2v[j].x, v[q][4 * j + 1] * rstd * g2v[j].y + b2v[j].y, v[q][4 * j + 2] * rstd * g2v[j].z + b2v[j].z, v[q][4 * j + 3] * rstd * g2v[j].w + b2v[j].w};
        }
    }
}

constexpr int N_PHASES = 9;
__global__ void __launch_bounds__(NWAVES * 64, 2) mega_fwd(Args args) {
    extern __shared__ __attribute__((aligned(16))) unsigned char lds[];
    Frame F;
    F.lds = (LAS unsigned char*)lds;
    F.MISC = (volatile LAS unsigned*)(F.lds + MISC_OFF);
    F.tid = threadIdx.x; F.lane = F.tid & 63; F.wave = __builtin_amdgcn_readfirstlane(F.tid >> 6);
    F.G = gridDim.x; { const int bx = blockIdx.x; F.vcu = (F.G % 8 == 0) ? (bx % 8) * (F.G / 8) + bx / 8 : bx; }
    F.ctl = (gu32*)(args.ws + WS_CTL);
    for (int u = F.tid; u < (LDS_BYTES - LDSCTL_OFF) / 4; u += NWAVES * 64) ((LAS unsigned*)(F.lds + LDSCTL_OFF))[u] = 0u;
    __syncthreads();
    const int lo = args.ph_lo, hi = args.ph_hi;
    const bool multi = (hi - lo) > 1;
    XcdBarrier bar; bar.bar = (unsigned*)(F.ctl + CW_BAR); bar.x = 0; bar.st = nullptr;
    if (multi) bar = xcd_barrier_post((unsigned*)(F.ctl + CW_BAR), F.MISC + 8);
#ifndef PH_MASK
#define PH_MASK 0x1FF
#endif
#define IN(k) ((((PH_MASK) >> (k)) & 1) && lo <= (k) && (k) < hi)
#define SEAM(k) do { if (IN(k) && IN((k) + 1)) xcd_barrier(bar); } while (0)
#ifndef DOUBLE_MASK
#define DOUBLE_MASK 0
#endif
#define REP(k) for (int rep_ = 0; rep_ < ((((DOUBLE_MASK) >> (k)) & 1) + 1); ++rep_)
    if (IN(0)) { REP(0) { refresh_frame(F); const Args A = fetch_args(); p0_prologue(F, A); } SEAM(0); }
    if (IN(1)) { REP(1) {
        refresh_frame(F); const Args A = fetch_args(); unsigned char* ws = A.ws;
        pg8::Gemm g{(const bf16_t*)(ws + WS_XB), (const bf16_t*)(ws + WS_WIN), NTOK, INW, DM, 0}; pg8::StaticOrder S; S.init(NTOK, INW, F.G, (int)blockIdx.x);
        pg8::EpiProj E{(bf16_t*)(ws + WS_PROJ)};
        pg8::gemm_phase<pg8::EpiProj, pg8::StaticOrder, false>(F.lds + RING_OFF, g, S, E);
        } SEAM(1);
    }
    if (IN(2)) { REP(2) {
        refresh_frame(F); const Args A = fetch_args(); unsigned char* ws = A.ws;
#ifndef P2_REP_SUB
#define P2_REP_SUB 3
#endif
        const int sub_ = (rep_ == 0) ? A.pad0 : (A.pad0 & P2_REP_SUB);
        if (sub_ & 1) { const float lam = expf(wave_sum(A.in[2][F.lane] * A.in[3][F.lane])) - expf(wave_sum(A.in[4][F.lane] * A.in[5][F.lane])) + LAMBDA_INIT;
            attn_body::attn_phase<8>((char*)lds + RING_OFF, (const bf16_t*)(ws + WS_PROJ), (bf16_t*)(ws + WS_MIX), F.vcu, lam, A.in[6]); }
        if (sub_ & 2) gmlp_phase(F, A);
        }
    }
    if (IN(3)) { SEAM(3); }
    if (IN(4)) { REP(4) {
        refresh_frame(F); const Args A = fetch_args(); unsigned char* ws = A.ws;
        pg8::Gemm g{(const bf16_t*)(ws + WS_MIX), (const bf16_t*)(ws + WS_WO), NTOK, DM, DM, 0}; pg8::StaticOrder S; S.init(NTOK, DM, F.G, (int)blockIdx.x);
        pg8::EpiH1 E{A.in[0], (float*)(ws + WS_H1)};
        pg8::gemm_phase<pg8::EpiH1, pg8::StaticOrder, false>(F.lds + RING_OFF, g, S, E);
        } SEAM(4);
    }
    if (IN(5)) { REP(5) { refresh_frame(F); const Args A = fetch_args(); route_phase(F, A); } SEAM(5); }
    if (IN(6)) { REP(6) {
        refresh_frame(F); const Args A = fetch_args(); unsigned char* ws = A.ws;
        build_tab(F);
        pg8::MoeOrder S; S.init((const LAS int*)(F.lds + TAB_OFF), (const int*)(ws + WS_LIST), 8, (int)blockIdx.x);
#if MOE_FP8
        pg8::Gemm g{(const bf16_t*)(ws + WS_XB), (const bf16_t*)(ws + WS_WUP), PADROWS, 2 * DFF, DM, (size_t)2 * DFF * DM / 2};
        pg8::EpiSwiglu8 E{(unsigned char*)(ws + WS_ACT), A.in[17]};
        pg8::gemm_phase<pg8::EpiSwiglu8, pg8::MoeOrder, true, true>(F.lds + RING_OFF, g, S, E);
#else
        pg8::Gemm g{(const bf16_t*)(ws + WS_XB), (const bf16_t*)(ws + WS_WUP), PADROWS, 2 * DFF, DM, (size_t)2 * DFF * DM};
        pg8::EpiSwiglu E{(bf16_t*)(ws + WS_ACT), A.in[17]};
        pg8::gemm_phase<pg8::EpiSwiglu, pg8::MoeOrder, true>(F.lds + RING_OFF, g, S, E);
#endif
        } SEAM(6);
    }
    if (IN(7)) { REP(7) {
        refresh_frame(F); const Args A = fetch_args(); unsigned char* ws = A.ws;
        build_tab(F);
        pg8::MoeOrder S; S.init((const LAS int*)(F.lds + TAB_OFF), (const int*)(ws + WS_LIST), 4, (int)blockIdx.x);
#if MOE_FP8
        pg8::EpiDown8 E{(unsigned char*)(ws + WS_Y), A.in[19]};
        pg8::Gemm g{(const bf16_t*)(ws + WS_ACT), (const bf16_t*)(ws + WS_WDN), PADROWS, DM, DFF, (size_t)DM * DFF / 2};
        pg8::gemm_phase<pg8::EpiDown8, pg8::MoeOrder, false, true>(F.lds + RING_OFF, g, S, E);
#else
        pg8::EpiDown E{(bf16_t*)(ws + WS_Y), A.in[19]};
        pg8::Gemm g{(const bf16_t*)(ws + WS_ACT), (const bf16_t*)(ws + WS_WDN), PADROWS, DM, DFF, (size_t)DM * DFF};
        pg8::gemm_phase<pg8::EpiDown, pg8::MoeOrder, false>(F.lds + RING_OFF, g, S, E);
#endif
        } SEAM(7);
    }
    if (IN(8)) { REP(8) { refresh_frame(F); const Args A = fetch_args(); build_tab(F); combine_phase(F, A); } }
#undef IN
#undef SEAM
}

struct NArgs {
    const float* x; const float* B; const float* bias; const float* bias2;
    const bf16_t* Ab; bf16_t* Ob; float* Of; const int* ctl; const int* list;
};
template <int MODE> __global__ void __launch_bounds__(256) ngemm(NArgs a) {
    constexpr int K = 1024;
    constexpr int LDB = (MODE == 0) ? INW : (MODE == 2 ? 2048 : 1024);
    constexpr bool DUAL = (MODE == 2);
    __shared__ float As[16][68];
    __shared__ float Bs[16][64];
    __shared__ float Bs2[DUAL ? 16 : 1][64];
    const int tid = threadIdx.x, ty = tid >> 4, tx = tid & 15;
    const int row0 = blockIdx.y * 64, col0 = blockIdx.x * 64;
    const float* B = a.B; int e = 0, pst = 0, cnt = 0;
    if (MODE >= 2) {
        const int* ps = a.ctl + CW_PSTART;
        while (e < NE && row0 >= ps[e + 1]) ++e;
        if (e >= NE) return;
        pst = ps[e]; cnt = a.ctl[CW_CNT + e];
        B += (size_t)e * K * LDB;
    }
    const int ar = tid >> 2, ak = (tid & 3) * 4;
    const float* arow_f = nullptr; const bf16_t* arow_b = nullptr;
    if (MODE == 0) arow_f = a.x + (size_t)(row0 + ar) * K;
    else if (MODE == 1 || MODE == 3) arow_b = a.Ab + (size_t)(row0 + ar) * K;
    else { const int r = row0 + ar - pst; const int tok = (r < cnt) ? a.list[e * NTOK + r] : 0; arow_b = a.Ab + (size_t)tok * K; }
    const int bk = tid >> 4, bn = (tid & 15) * 4;
    float acc[4][4], acc2[4][4];
#pragma unroll
    for (int i = 0; i < 4; ++i)
#pragma unroll
        for (int j = 0; j < 4; ++j) { acc[i][j] = 0.f; acc2[i][j] = 0.f; }
    for (int k0 = 0; k0 < K; k0 += 16) {
        float av[4];
        if (MODE == 0) { const float4 t = *(const float4*)(arow_f + k0 + ak); av[0] = t.x; av[1] = t.y; av[2] = t.z; av[3] = t.w; }
        else { const uint2 t = *(const uint2*)(arow_b + k0 + ak); av[0] = bf2f((bf16_t)(t.x & 0xffff)); av[1] = bf2f((bf16_t)(t.x >> 16)); av[2] = bf2f((bf16_t)(t.y & 0xffff)); av[3] = bf2f((bf16_t)(t.y >> 16)); }
        const float4 bv = *(const float4*)(B + (size_t)(k0 + bk) * LDB + col0 + bn);
        float4 bv2 = bv;
        if (DUAL) bv2 = *(const float4*)(B + (size_t)(k0 + bk) * LDB + 1024 + col0 + bn);
        __syncthreads();
#pragma unroll
        for (int c = 0; c < 4; ++c) As[ak + c][ar] = av[c];
        *(float4*)&Bs[bk][bn] = bv;
        if (DUAL) *(float4*)&Bs2[bk][bn] = bv2;
        __syncthreads();
#pragma unroll
        for (int k = 0; k < 16; ++k) {
            const float4 a4 = *(const float4*)&As[k][ty * 4];
            const float4 b4 = *(const float4*)&Bs[k][tx * 4];
            const float aa[4] = {a4.x, a4.y, a4.z, a4.w}, bb[4] = {b4.x, b4.y, b4.z, b4.w};
#pragma unroll
            for (int i = 0; i < 4; ++i)
#pragma unroll
                for (int j = 0; j < 4; ++j) acc[i][j] = fmaf(aa[i], bb[j], acc[i][j]);
            if (DUAL) {
                const float4 c4 = *(const float4*)&Bs2[k][tx * 4];
                const float cc[4] = {c4.x, c4.y, c4.z, c4.w};
#pragma unroll
                for (int i = 0; i < 4; ++i)
#pragma unroll
                    for (int j = 0; j < 4; ++j) acc2[i][j] = fmaf(aa[i], cc[j], acc2[i][j]);
            }
        }
    }
#pragma unroll
    for (int i = 0; i < 4; ++i) {
        const int row = row0 + ty * 4 + i;
#pragma unroll
        for (int j = 0; j < 4; ++j) {
            const int col = col0 + tx * 4 + j;
            if (MODE == 0) { float v = acc[i][j]; if (col < C_K) v *= QSCALE; a.Ob[(size_t)row * INW + col] = f2bf(v); }
            else if (MODE == 1) { a.Of[(size_t)row * DM + col] = ALPHA * a.x[(size_t)row * DM + col] + acc[i][j]; }
            else if (MODE == 2) {
                float g = acc[i][j] + a.bias[e * 2048 + col], l = acc2[i][j] + a.bias[e * 2048 + 1024 + col];
                g = fminf(g, 7.0f); l = fminf(fmaxf(l, -7.0f), 7.0f);
                const float act = (l + 1.0f) * g * (1.0f / (1.0f + expf(-1.702f * g)));
                a.Ob[(size_t)row * DFF + col] = f2bf(act);
            } else { a.Ob[(size_t)row * DM + col] = f2bf(acc[i][j] + a.bias[e * DM + col]); }
        }
    }
}

__global__ void __launch_bounds__(128) nattn(const bf16_t* __restrict__ proj, bf16_t* __restrict__ mix, const float* lq1, const float* lk1, const float* lq2, const float* lk2, const float* subg) {
    __shared__ float sc[2][SEQ];
    const int w = threadIdx.x >> 6, lane = threadIdx.x & 63;
    const int task = blockIdx.x * 2 + w, t = task >> 2, h = task & 3, b = t / SEQ, qpos = t % SEQ;
    const float lam = expf(wave_sum(lq1[lane] * lk1[lane])) - expf(wave_sum(lq2[lane] * lk2[lane])) + LAMBDA_INIT;
    const bf16_t* pb = proj + (size_t)b * SEQ * INW;
    float o[2][2];
    for (int s = 0; s < 2; ++s) {
        float q[DH];
        const bf16_t* qp = proj + (size_t)t * INW + C_Q + s * 256 + h * DH;
#pragma unroll
        for (int d = 0; d < DH; ++d) q[d] = bf2f(qp[d]);
        float m = -INFINITY;
        for (int j = lane; j <= qpos; j += 64) {
            const uint4* kp = (const uint4*)(pb + (size_t)j * INW + C_K + s * 256 + h * DH);
            float acc = 0.f;
#pragma unroll
            for (int c = 0; c < 8; ++c) {
                const uint4 kk = kp[c];
                const uint32_t ww[4] = {kk.x, kk.y, kk.z, kk.w};
#pragma unroll
                for (int z = 0; z < 4; ++z) { acc = fmaf(q[c * 8 + 2 * z], bf2f((bf16_t)(ww[z] & 0xffff)), acc); acc = fmaf(q[c * 8 + 2 * z + 1], bf2f((bf16_t)(ww[z] >> 16)), acc); }
            }
            sc[w][j] = acc; m = fmaxf(m, acc);
        }
        m = wave_max(m);
        float l = 0.f;
        for (int j = lane; j <= qpos; j += 64) { const float p = exp2f(sc[w][j] - m); sc[w][j] = p; l += p; }
        l = wave_sum(l);
        __syncthreads();
        float o0 = 0.f, o1 = 0.f;
        const bf16_t* vp = pb + C_V + h * DV + lane * 2;
        for (int j = 0; j <= qpos; ++j) {
            const float p = sc[w][j];
            const uint32_t vv = *(const uint32_t*)(vp + (size_t)j * INW);
            o0 = fmaf(p, bf2f((bf16_t)(vv & 0xffff)), o0); o1 = fmaf(p, bf2f((bf16_t)(vv >> 16)), o1);
        }
        o[s][0] = o0 / l; o[s][1] = o1 / l;
        __syncthreads();
    }
    const float d0 = o[0][0] - lam * o[1][0], d1 = o[0][1] - lam * o[1][1];
    const float ss = wave_sum(d0 * d0 + d1 * d1);
    const float r = rsqrtf(ss * (1.0f / DV) + LN_EPS) * (1.0f - LAMBDA_INIT);
    const uint32_t pk = (uint32_t)f2bf(d0 * r * subg[lane * 2]) | ((uint32_t)f2bf(d1 * r * subg[lane * 2 + 1]) << 16);
    *(uint32_t*)(mix + (size_t)t * DM + h * DV + lane * 2) = pk;
}

__global__ void __launch_bounds__(256) ngmlp(const bf16_t* __restrict__ proj, bf16_t* __restrict__ mix, const float* lng, const float* lnb, const float* wsp, const float* bsp) {
    __shared__ float mu[CHUNK], rs[CHUNK];
    __shared__ float vn[CHUNK][GD];
    const int c = blockIdx.x, g = blockIdx.y, tid = threadIdx.x, w = tid >> 6, lane = tid & 63;
    const size_t row0 = (size_t)c * CHUNK;
    for (int s = w; s < CHUNK; s += 4) {
        const bf16_t* p = proj + (row0 + s) * INW + C_GV;
        float v[8]; float sum = 0.f;
#pragma unroll
        for (int i = 0; i < 8; ++i) { v[i] = gelu_exact(bf2f(p[lane + 64 * i])); sum += v[i]; }
        const float mean = wave_sum(sum) * (1.0f / GW); float q = 0.f;
#pragma unroll
        for (int i = 0; i < 8; ++i) { const float d = v[i] - mean; q += d * d; }
        const float var = wave_sum(q) * (1.0f / GW);
        if (lane == 0) { mu[s] = mean; rs[s] = rsqrtf(var + LN_EPS); }
    }
    __syncthreads();
    for (int i = tid; i < CHUNK * GD; i += 256) {
        const int s = i >> 6, d = i & 63, col = g * GD + d;
        const float v = gelu_exact(bf2f(proj[(row0 + s) * INW + C_GV + col]));
        vn[s][d] = (v - mu[s]) * rs[s] * lng[col] + lnb[col];
    }
    __syncthreads();
    const int t = tid >> 1, dh = (tid & 1) * 32;
    float z[32];
#pragma unroll
    for (int d = 0; d < 32; ++d) z[d] = 0.f;
    const float* wr = wsp + ((size_t)g * CHUNK + t) * CHUNK;
    for (int s = 0; s <= t; ++s) {
        const float wv = wr[s];
#pragma unroll
        for (int d = 0; d < 32; ++d) z[d] = fmaf(wv, vn[s][dh + d], z[d]);
    }
    const float bb = bsp[g * CHUNK + t];
#pragma unroll
    for (int d = 0; d < 32; ++d) {
        const int col = g * GD + dh + d;
        const float u = gelu_exact(bf2f(proj[(row0 + t) * INW + C_GU + col]));
        mix[(row0 + t) * DM + GW + col] = f2bf(u * (z[d] + bb));
    }
}

__global__ void __launch_bounds__(256) nroute(float* __restrict__ h1, bf16_t* __restrict__ xb, const float* g1, const float* b1, const float* wr, const float* br, int* ctl, int* list, int* re, int* rr, float* rg) {
    const int w = threadIdx.x >> 6, lane = threadIdx.x & 63, t = blockIdx.x * 4 + w;
    float* row = h1 + (size_t)t * DM;
    float v[16]; float s = 0.f;
#pragma unroll
    for (int j = 0; j < 4; ++j) { const float4 q = *(const float4*)(row + j * 256 + lane * 4); v[4 * j] = q.x; v[4 * j + 1] = q.y; v[4 * j + 2] = q.z; v[4 * j + 3] = q.w; s += (q.x + q.y) + (q.z + q.w); }
    const float mean = wave_sum(s) * (1.0f / DM); float q2 = 0.f;
#pragma unroll
    for (int i = 0; i < 16; ++i) { v[i] -= mean; q2 += v[i] * v[i]; }
    const float rstd = rsqrtf(wave_sum(q2) * (1.0f / DM) + LN_EPS);
#pragma unroll
    for (int j = 0; j < 4; ++j) {
        const int col = j * 256 + lane * 4;
#pragma unroll
        for (int c = 0; c < 4; ++c) v[4 * j + c] = v[4 * j + c] * rstd * g1[col + c] + b1[col + c];
        *(float4*)(row + col) = make_float4(v[4 * j], v[4 * j + 1], v[4 * j + 2], v[4 * j + 3]);
        uint2 pk; pk.x = (uint32_t)f2bf(v[4 * j]) | ((uint32_t)f2bf(v[4 * j + 1]) << 16); pk.y = (uint32_t)f2bf(v[4 * j + 2]) | ((uint32_t)f2bf(v[4 * j + 3]) << 16);
        *(uint2*)(xb + (size_t)t * DM + col) = pk;
    }
    float lg[NE];
#pragma unroll
    for (int e = 0; e < NE; ++e) lg[e] = 0.f;
#pragma unroll
    for (int j = 0; j < 4; ++j)
#pragma unroll
        for (int c = 0; c < 4; ++c) {
            const float xv = v[4 * j + c]; const float4* wp = (const float4*)(wr + (size_t)(j * 256 + lane * 4 + c) * NE);
#pragma unroll
            for (int e4 = 0; e4 < 8; ++e4) { const float4 ww = wp[e4]; lg[4 * e4] = fmaf(xv, ww.x, lg[4 * e4]); lg[4 * e4 + 1] = fmaf(xv, ww.y, lg[4 * e4 + 1]); lg[4 * e4 + 2] = fmaf(xv, ww.z, lg[4 * e4 + 2]); lg[4 * e4 + 3] = fmaf(xv, ww.w, lg[4 * e4 + 3]); }
        }
#pragma unroll
    for (int e = 0; e < NE; ++e) lg[e] = wave_sum(lg[e]) + br[e];
    int idx[4]; float val[4]; unsigned taken = 0u;
#pragma unroll
    for (int k = 0; k < 4; ++k) {
        float best = -INFINITY; int bi = 0;
#pragma unroll
        for (int e = 0; e < NE; ++e) { const bool ok = !((taken >> e) & 1u) && lg[e] > best; best = ok ? lg[e] : best; bi = ok ? e : bi; }
        idx[k] = bi; val[k] = best; taken |= 1u << bi;
    }
    float ex[4], se = 0.f;
#pragma unroll
    for (int k = 0; k < 4; ++k) { ex[k] = expf(val[k] - val[0]); se += ex[k]; }
    if (lane == 0) {
#pragma unroll
        for (int k = 0; k < 4; ++k) {
            const int r = atomicAdd(ctl + CW_CNT + idx[k], 1);
            list[idx[k] * NTOK + r] = t;
            re[t * 4 + k] = idx[k]; rr[t * 4 + k] = r; rg[t * 4 + k] = ex[k] / se;
        }
    }
}
__global__ void npstart(int* ctl) {
    if (threadIdx.x == 0 && blockIdx.x == 0) { int p = 0; for (int e = 0; e < NE; ++e) { ctl[CW_PSTART + e] = p; p += ((ctl[CW_CNT + e] + 255) / 256) * 256; } ctl[CW_PSTART + NE] = p; }
}
__global__ void __launch_bounds__(256) ncombine(const float* __restrict__ x1, const bf16_t* __restrict__ y, const int* ctl, const int* re, const int* rr, const float* rg, const float* g2, const float* b2, float* __restrict__ out) {
    const int w = threadIdx.x >> 6, lane = threadIdx.x & 63, t = blockIdx.x * 4 + w;
    float v[16];
#pragma unroll
    for (int j = 0; j < 4; ++j) { const float4 q = *(const float4*)(x1 + (size_t)t * DM + j * 256 + lane * 4); v[4 * j] = ALPHA * q.x; v[4 * j + 1] = ALPHA * q.y; v[4 * j + 2] = ALPHA * q.z; v[4 * j + 3] = ALPHA * q.w; }
#pragma unroll
    for (int k = 0; k < 4; ++k) {
        const int e = re[t * 4 + k], slot = ctl[CW_PSTART + e] + rr[t * 4 + k]; const float g = rg[t * 4 + k];
        const bf16_t* yr = y + (size_t)slot * DM;
#pragma unroll
        for (int j = 0; j < 4; ++j) { const uint2 pk = *(const uint2*)(yr + j * 256 + lane * 4);
            v[4 * j] = fmaf(g, bf2f((bf16_t)(pk.x & 0xffff)), v[4 * j]); v[4 * j + 1] = fmaf(g, bf2f((bf16_t)(pk.x >> 16)), v[4 * j + 1]);
            v[4 * j + 2] = fmaf(g, bf2f((bf16_t)(pk.y & 0xffff)), v[4 * j + 2]); v[4 * j + 3] = fmaf(g, bf2f((bf16_t)(pk.y >> 16)), v[4 * j + 3]); }
    }
    float s = 0.f;
#pragma unroll
    for (int i = 0; i < 16; ++i) s += v[i];
    const float mean = wave_sum(s) * (1.0f / DM); float q2 = 0.f;
#pragma unroll
    for (int i = 0; i < 16; ++i) { v[i] -= mean; q2 += v[i] * v[i]; }
    const float rstd = rsqrtf(wave_sum(q2) * (1.0f / DM) + LN_EPS);
#pragma unroll
    for (int j = 0; j < 4; ++j) { const int col = j * 256 + lane * 4;
        *(float4*)(out + (size_t)t * DM + col) = make_float4(v[4 * j] * rstd * g2[col] + b2[col], v[4 * j + 1] * rstd * g2[col + 1] + b2[col + 1], v[4 * j + 2] * rstd * g2[col + 2] + b2[col + 2], v[4 * j + 3] * rstd * g2[col + 3] + b2[col + 3]); }
}

#ifndef OPT_MASK
#define OPT_MASK 0x1FF
#endif
#ifndef FUSED
#define FUSED 0
#endif
static void launch_mega(const Args& base, int lo, int hi, int sub, hipStream_t stream) {
    Args a = base; a.ph_lo = lo; a.ph_hi = hi; a.pad0 = sub; a.pad1 = 0;
    hipLaunchKernelGGL(mega_fwd, dim3(256), dim3(NWAVES * 64), LDS_BYTES, stream, a);
}
extern "C" void kernel_launch(void* const* d_in, const int* in_sizes, int n_in, void* d_out, int out_size, void* d_ws, size_t ws_size, hipStream_t stream) {
    static int ready = 0;
    if (ready == 0) {
        if (n_in != 22 || in_sizes[0] != NTOK * DM || out_size != NTOK * DM || ws_size < WS_END) { fprintf(stderr, "kernel_launch: unexpected shapes (n_in %d, in0 %d, out %d, ws %zu)\n", n_in, n_in > 0 ? in_sizes[0] : -1, out_size, ws_size); ready = -1; return; }
        if (hipFuncSetAttribute((const void*)mega_fwd, hipFuncAttributeMaxDynamicSharedMemorySize, LDS_BYTES) != hipSuccess) { fprintf(stderr, "kernel_launch: hipFuncSetAttribute failed\n"); ready = -1; return; }
        ready = 1;
    }
    if (ready < 0) return;
    const float* x = (const float*)d_in[0]; const float* w_in = (const float*)d_in[1];
    const float *lq1 = (const float*)d_in[2], *lk1 = (const float*)d_in[3], *lq2 = (const float*)d_in[4], *lk2 = (const float*)d_in[5];
    const float *subg = (const float*)d_in[6], *glng = (const float*)d_in[7], *glnb = (const float*)d_in[8], *wsp = (const float*)d_in[9], *bsp = (const float*)d_in[10];
    const float *w_o = (const float*)d_in[11], *ln1g = (const float*)d_in[12], *ln1b = (const float*)d_in[13], *w_r = (const float*)d_in[14], *b_r = (const float*)d_in[15];
    const float *w_up = (const float*)d_in[16], *b_up = (const float*)d_in[17], *w_dn = (const float*)d_in[18], *b_dn = (const float*)d_in[19], *ln2g = (const float*)d_in[20], *ln2b = (const float*)d_in[21];
    unsigned char* ws = (unsigned char*)d_ws;
    int* ctl = (int*)(ws + WS_CTL); int* list = (int*)(ws + WS_LIST); int* re = (int*)(ws + WS_RE); int* rr = (int*)(ws + WS_RR); float* rg = (float*)(ws + WS_RG);
    bf16_t* xb = (bf16_t*)(ws + WS_XB); bf16_t* proj = (bf16_t*)(ws + WS_PROJ); bf16_t* mix = (bf16_t*)(ws + WS_MIX); bf16_t* yb = (bf16_t*)(ws + WS_Y);
    float* h1 = (float*)(ws + WS_H1); bf16_t* act = (bf16_t*)(ws + WS_ACT);
    (void)hipMemsetAsync(ws + WS_CTL, 0, CTL_BYTES, stream);
    Args base{};
    for (int i = 0; i < 22; ++i) base.in[i] = (const float*)d_in[i];
    base.out = (float*)d_out; base.ws = ws;
    constexpr unsigned OM = OPT_MASK;
#if FUSED
    static_assert(OM == 0x1FFu, "FUSED needs every stage in the persistent kernel");
    launch_mega(base, 0, N_PHASES, 3, stream);
#else
    if (OM & 0xD3u) launch_mega(base, 0, 1, 0, stream);
    if (OM & 2u) launch_mega(base, 1, 2, 0, stream);
    else { NArgs a{}; a.x = x; a.B = w_in; a.Ob = proj; ngemm<0><<<dim3(INW / 64, NTOK / 64), 256, 0, stream>>>(a); }
    if ((OM & 4u) || (OM & 8u)) launch_mega(base, 2, 3, ((OM & 4u) ? 1 : 0) | ((OM & 8u) ? 2 : 0), stream);
    if (OM & 4u) launch_mega(base, 3, 4, 0, stream);
    else nattn<<<NTOK * NH / 2, 128, 0, stream>>>(proj, mix, lq1, lk1, lq2, lk2, subg);
    if (!(OM & 8u)) ngmlp<<<dim3(NTOK / CHUNK, NG), 256, 0, stream>>>(proj, mix, glng, glnb, wsp, bsp);
    if (OM & 16u) launch_mega(base, 4, 5, 0, stream);
    else { NArgs a{}; a.x = x; a.B = w_o; a.Ab = mix; a.Of = h1; ngemm<1><<<dim3(DM / 64, NTOK / 64), 256, 0, stream>>>(a); }
    if (OM & 32u) launch_mega(base, 5, 6, 0, stream);
    else nroute<<<NTOK / 4, 256, 0, stream>>>(h1, xb, ln1g, ln1b, w_r, b_r, ctl, list, re, rr, rg);
    if ((OM & 0x1C0u) != 0x1C0u) npstart<<<1, 64, 0, stream>>>(ctl);
    if (OM & 64u) launch_mega(base, 6, 7, 0, stream);
    else { NArgs a{}; a.B = w_up; a.bias = b_up; a.Ab = xb; a.Ob = act; a.ctl = ctl; a.list = list; ngemm<2><<<dim3(DFF / 64, PADROWS / 64), 256, 0, stream>>>(a); }
    if (OM & 128u) launch_mega(base, 7, 8, 0, stream);
    else { NArgs a{}; a.B = w_dn; a.bias = b_dn; a.Ab = act; a.Ob = yb; a.ctl = ctl; a.list = list; ngemm<3><<<dim3(DM / 64, PADROWS / 64), 256, 0, stream>>>(a); }
    if (OM & 256u) launch_mega(base, 8, 9, 0, stream);
    else ncombine<<<NTOK / 4, 256, 0, stream>>>(h1, yb, ctl, re, rr, rg, ln2g, ln2b, (float*)d_out);
#endif
}
```

```cpp
#include <hip/hip_runtime.h>
#include <hip/hip_bf16.h>
#include <cstdint>
#include <cstdio>
#include <cmath>

#ifndef MOE_FP8
#define MOE_FP8 1
#endif
namespace cfg {
constexpr int BATCH = 8, SEQ = 4096, NTOK = BATCH * SEQ, DM = 1024;
constexpr int INW = 2560, NH = 4, DH = 64, DV = 128;
constexpr int C_Q = 0, C_K = 512, C_V = 1024, C_GU = 1536, C_GV = 2048;
constexpr int GW = 512, NG = 8, GD = 64, CHUNK = 128;
constexpr int NE = 32, TOPK = 4, DFF = 1024;
constexpr int PADROWS = 139264;
constexpr float LN_EPS = 1e-5f;
constexpr float ALPHA = 1.189207115002721f;
constexpr float LAMBDA_INIT = 0.2f;
constexpr float QSCALE = 0.125f * 1.4426950408889634f;
constexpr size_t MiB = 1u << 20;
constexpr size_t WS_CTL = 0, CTL_BYTES = 1 * MiB;
constexpr size_t WS_LIST = 1 * MiB;
constexpr size_t WS_RE = 5 * MiB, WS_RR = 5 * MiB + 512 * 1024, WS_RG = 6 * MiB;
constexpr size_t WS_WIN = 8 * MiB;
constexpr size_t WS_WO = 13 * MiB;
constexpr size_t WS_WUP = 16 * MiB;
constexpr size_t WS_WDN = 144 * MiB;
constexpr size_t WS_X1B = 80 * MiB;
constexpr size_t WS_XB = 208 * MiB;
constexpr size_t WS_PROJ = 272 * MiB;
constexpr size_t WS_MIX = 432 * MiB;
constexpr size_t WS_ATTO = 496 * MiB;
constexpr size_t WS_Y = 272 * MiB;
constexpr size_t WS_H1 = 560 * MiB;
constexpr size_t WS_ACT = 688 * MiB;
constexpr size_t WS_END = 960 * MiB;
constexpr int CW_CNT = 0;
constexpr int CW_PSTART = 64;
constexpr int CW_BAR = 4096;
}
using namespace cfg;
typedef uint16_t bf16_t;

__device__ __forceinline__ float bf2f(bf16_t b) { return __uint_as_float((uint32_t)b << 16); }
__device__ __forceinline__ bf16_t f2bf(float f) { uint32_t u = __float_as_uint(f); u += 0x7fffu + ((u >> 16) & 1u); return (bf16_t)(u >> 16); }
typedef float pk2_f32x2_t __attribute__((ext_vector_type(2))); typedef __bf16 pk2_bf16x2_t __attribute__((ext_vector_type(2)));
__device__ __forceinline__ uint32_t pk2(float lo, float hi) { pk2_f32x2_t v = {lo, hi}; pk2_bf16x2_t b = __builtin_convertvector(v, pk2_bf16x2_t); return __builtin_bit_cast(uint32_t, b); }
__device__ __forceinline__ float wave_sum(float v) {
#pragma unroll
    for (int o = 1; o < 64; o <<= 1) v += __shfl_xor(v, o);
    return v;
}
__device__ __forceinline__ float wave_max(float v) {
#pragma unroll
    for (int o = 1; o < 64; o <<= 1) v = fmaxf(v, __shfl_xor(v, o));
    return v;
}
__device__ __forceinline__ float gelu_exact(float x) { return 0.5f * x * (1.0f + erff(x * 0.70710678118654752f)); }

#define OPT_MASK 0x1FF
#define FUSED 1
#define DOUBLE_MASK 0
#define P2_REP_SUB 3
namespace pg8 {
#define PG8_LAS __attribute__((address_space(3)))
typedef short bf16x8 __attribute__((ext_vector_type(8)));
typedef float f32x4 __attribute__((ext_vector_type(4)));
typedef float f32x2 __attribute__((ext_vector_type(2)));
typedef unsigned u32x4 __attribute__((ext_vector_type(4)));
typedef int v4i_t __attribute__((ext_vector_type(4)));
typedef int v8i_t __attribute__((ext_vector_type(8)));
constexpr int WSHIFT = 6;
constexpr int WSCALE_E8M0 = (127 - WSHIFT) * 0x01010101;
constexpr int BM = 256, BK = 64, HALF = 128, HTB = HALF * BK * 2  , STAGE_BYTES = 8 * HTB, NXCD = 8, WGM = 8;

__host__ __device__ __forceinline__ int lds_byte(int r, int c) { const int st = (r >> 4) * 2 + (c >> 5), rr = r & 15, cc = c & 31, ob = rr * 64 + cc * 2; return st * 1024 + (ob ^ (((ob >> 9) & 1) << 5)); }
__host__ __device__ __forceinline__ void stage_rc(int b, int& R, int& C) { const int st = b / 1024, sb = b % 1024, swz = sb ^ (((sb >> 9) & 1) << 5); R = (st >> 1) * 16 + swz / 64; C = (st & 1) * 32 + (swz % 64) / 2; }
__host__ __device__ __forceinline__ int perm32(int rho) { const int n = rho >> 4, i = rho & 15; return 8 * (i >> 2) + 4 * n + (i & 3); }

struct Unit { int pm, pn, e; };
struct Gemm { const bf16_t* A; const bf16_t* Bt; int M, N, K; size_t strideB; };

struct StaticOrder {
    int nM, nN, nwg, G, c;
    __host__ __device__ void init(int M, int N, int G_, int c_) { nM = M / BM; nN = N / BM; nwg = nM * nN; G = G_; c = c_; }
    __host__ __device__ bool next(int i, Unit& u) const {
        const long L = (long)i * G + c; if (L >= nwg) return false;
        int wgid = (int)L; { const int q = nwg / NXCD, r = nwg % NXCD, xcd = wgid % NXCD, off = wgid / NXCD; wgid = (xcd < r ? xcd * (q + 1) : r * (q + 1) + (xcd - r) * q) + off; }
        const int nig = WGM * nN, gid = wgid / nig, fm = gid * WGM, gsz = (nM - fm) < WGM ? (nM - fm) : WGM;
        u.pm = fm + ((wgid % nig) % gsz); u.pn = (wgid % nig) / gsz; u.e = 0; return true;
    }
    __device__ __forceinline__ void gather(const Unit&, const int (&)[2], const int (&)[2], unsigned (&)[2][2], unsigned) const {}
};
struct MoeOrder {
    const PG8_LAS int* tab; const int* list; int NC, RG, chunk0, nrt, j0;
    __device__ __forceinline__ void init(const PG8_LAS int* tab_, const int* list_, int NC_, int bid) {
        tab = tab_; list = list_; NC = NC_; RG = 32 / NC_; const int x = bid & 7; j0 = bid >> 3;
        const int T = __builtin_amdgcn_readfirstlane(tab_[32]); chunk0 = (T * x) / 8; nrt = (T * (x + 1)) / 8 - chunk0;
    }
    __device__ __forceinline__ bool next(int i, Unit& u) const {
        const int pml = i * RG + (j0 % RG); if (pml >= nrt) return false;
        u.pm = chunk0 + pml; u.pn = j0 / RG; int e = 0;
        while (e < NE - 1 && u.pm >= __builtin_amdgcn_readfirstlane(tab[e + 1])) ++e;
        u.e = e; return true;
    }
    __device__ __forceinline__ void gather(const Unit& u, const int (&RA)[2], const int (&CA2)[2], unsigned (&go)[2][2], unsigned rowbytes) const {
        const int r0 = (u.pm - __builtin_amdgcn_readfirstlane(tab[u.e])) * BM, cnt = __builtin_amdgcn_readfirstlane(tab[40 + u.e]);
#pragma unroll
        for (int h = 0; h < 2; ++h)
#pragma unroll
            for (int i = 0; i < 2; ++i) { const int r = r0 + h * HALF + RA[i]; const int tok = (r < cnt) ? list[u.e * NTOK + r] : 0; go[h][i] = (unsigned)tok * rowbytes + (unsigned)CA2[i]; }
    }
};

__device__ __forceinline__ unsigned cvt_pk_bf16(float lo, float hi) { unsigned r; asm volatile("v_cvt_pk_bf16_f32 %0, %1, %2" : "=v"(r) : "v"(lo), "v"(hi)); return r; }
__device__ __forceinline__ f32x2 gelu_pk(f32x2 v) {
    const f32x2 av = __builtin_elementwise_abs(v), d = av * 0.2316418882f + 1.0f;
    f32x2 t; t.x = __builtin_amdgcn_rcpf(d.x); t.y = __builtin_amdgcn_rcpf(d.y);
    f32x2 q = t * 0.5307027145f + (-0.7265760135f); q = q * t + 0.7107068705f; q = q * t + (-0.142248368f); q = q * t + 0.127414796f; q = q * t;
    const f32x2 s = (v * v) * (-0.72134752044f);
    f32x2 e; e.x = __builtin_amdgcn_exp2f(s.x); e.y = __builtin_amdgcn_exp2f(s.y);
    const f32x2 m = v * (q * e), r = v - m;
    f32x2 o; o.x = v.x < 0.f ? m.x : r.x; o.y = v.y < 0.f ? m.y : r.y; return o;
}
__device__ __forceinline__ float gelu1(float v) { return gelu_pk((f32x2){v, v}).x; }

struct EpiProj {
    static constexpr bool PERM = true;
    bf16_t* O;
    __device__ __forceinline__ void operator()(const f32x4 (&acc)[2][2][4][2], const Unit& u, int wr, int wc, int fr, int fq) const {
        const int row0 = u.pm * BM + wr * 64 + fr, col0 = u.pn * BM + wc * 32 + 8 * fq; const float sc = (u.pn < 2) ? QSCALE : 1.0f;
#pragma unroll
        for (int ai = 0; ai < 2; ++ai)
#pragma unroll
            for (int m = 0; m < 4; ++m) { bf16_t* rowp = O + (size_t)(row0 + ai * HALF + m * 16) * INW + col0;
#pragma unroll
                for (int bj = 0; bj < 2; ++bj) { const f32x4 v0 = acc[ai][bj][m][0] * sc, v1 = acc[ai][bj][m][1] * sc;
                    u32x4 w; w.x = cvt_pk_bf16(v0[0], v0[1]); w.y = cvt_pk_bf16(v0[2], v0[3]); w.z = cvt_pk_bf16(v1[0], v1[1]); w.w = cvt_pk_bf16(v1[2], v1[3]);
                    *(u32x4*)(rowp + bj * HALF) = w; } }
    }
};
struct EpiH1 {
    static constexpr bool PERM = false;
    const float* X; float* C;
    __device__ __forceinline__ void operator()(const f32x4 (&acc)[2][2][4][2], const Unit& u, int wr, int wc, int fr, int fq) const {
        const int row0 = u.pm * BM + wr * 64 + fr, col0 = u.pn * BM + wc * 32 + 4 * fq;
#pragma unroll
        for (int ai = 0; ai < 2; ++ai)
#pragma unroll
            for (int m = 0; m < 4; ++m) { const size_t off = (size_t)(row0 + ai * HALF + m * 16) * DM + col0;
#pragma unroll
                for (int bj = 0; bj < 2; ++bj)
#pragma unroll
                    for (int n = 0; n < 2; ++n) { const f32x4 xv = *(const f32x4*)(X + off + bj * HALF + n * 16); *(f32x4*)(C + off + bj * HALF + n * 16) = xv * ALPHA + acc[ai][bj][m][n]; } }
    }
};
struct EpiSwiglu {
    static constexpr bool PERM = true;
    bf16_t* O; const float* bias;
    __device__ __forceinline__ void operator()(const f32x4 (&acc)[2][2][4][2], const Unit& u, int wr, int wc, int fr, int fq) const {
        const int row0 = u.pm * BM + wr * 64 + fr, col0 = u.pn * HALF + wc * 32 + 8 * fq;
        const float* bp = bias + (size_t)u.e * (2 * DFF) + col0;
        f32x4 bg[2], bl[2];
#pragma unroll
        for (int n = 0; n < 2; ++n) { bg[n] = *(const f32x4*)(bp + 4 * n); bl[n] = *(const f32x4*)(bp + DFF + 4 * n); }
#pragma unroll
        for (int ai = 0; ai < 2; ++ai)
#pragma unroll
            for (int m = 0; m < 4; ++m) { float a8[8];
#pragma unroll
                for (int n = 0; n < 2; ++n) { const f32x4 g4 = acc[ai][0][m][n] + bg[n], l4 = acc[ai][1][m][n] + bl[n];
#pragma unroll
                    for (int j = 0; j < 4; ++j) { const float g = fminf(g4[j], 7.0f), l = fminf(fmaxf(l4[j], -7.0f), 7.0f);
                        const float sg = __builtin_amdgcn_rcpf(1.0f + __builtin_amdgcn_exp2f(g * (-1.702f * 1.4426950408889634f)));
                        a8[4 * n + j] = (l + 1.0f) * g * sg; } }
                u32x4 w; w.x = cvt_pk_bf16(a8[0], a8[1]); w.y = cvt_pk_bf16(a8[2], a8[3]); w.z = cvt_pk_bf16(a8[4], a8[5]); w.w = cvt_pk_bf16(a8[6], a8[7]);
                *(u32x4*)(O + (size_t)(row0 + ai * HALF + m * 16) * DFF + col0) = w; }
    }
};
struct EpiDown {
    static constexpr bool PERM = true;
    bf16_t* O; const float* bias;
    __device__ __forceinline__ void operator()(const f32x4 (&acc)[2][2][4][2], const Unit& u, int wr, int wc, int fr, int fq) const {
        const int row0 = u.pm * BM + wr * 64 + fr, col0 = u.pn * BM + wc * 32 + 8 * fq;
        const float* bp = bias + (size_t)u.e * DM + col0;
        f32x4 bv[2][2];
#pragma unroll
        for (int bj = 0; bj < 2; ++bj)
#pragma unroll
            for (int n = 0; n < 2; ++n) bv[bj][n] = *(const f32x4*)(bp + bj * HALF + 4 * n);
#pragma unroll
        for (int ai = 0; ai < 2; ++ai)
#pragma unroll
            for (int m = 0; m < 4; ++m) { bf16_t* rowp = O + (size_t)(row0 + ai * HALF + m * 16) * DM + col0;
#pragma unroll
                for (int bj = 0; bj < 2; ++bj) { const f32x4 v0 = acc[ai][bj][m][0] + bv[bj][0], v1 = acc[ai][bj][m][1] + bv[bj][1];
                    u32x4 w; w.x = cvt_pk_bf16(v0[0], v0[1]); w.y = cvt_pk_bf16(v0[2], v0[3]); w.z = cvt_pk_bf16(v1[0], v1[1]); w.w = cvt_pk_bf16(v1[2], v1[3]);
                    *(u32x4*)(rowp + bj * HALF) = w; } }
    }
};

__device__ __forceinline__ unsigned pk4_fp8(float a, float b, float c, float d) { int w = 0; w = __builtin_amdgcn_cvt_pk_fp8_f32(a, b, w, false); w = __builtin_amdgcn_cvt_pk_fp8_f32(c, d, w, true); return (unsigned)w; }
typedef unsigned u32x2 __attribute__((ext_vector_type(2)));
struct EpiSwiglu8 {
    static constexpr bool PERM = true;
    unsigned char* O; const float* bias;
    __device__ __forceinline__ void operator()(const f32x4 (&acc)[2][2][4][2], const Unit& u, int wr, int wc, int fr, int fq) const {
        const int row0 = u.pm * BM + wr * 64 + fr, col0 = u.pn * HALF + wc * 32 + 8 * fq;
        const float* bp = bias + (size_t)u.e * (2 * DFF) + col0;
        f32x4 bg[2], bl[2];
#pragma unroll
        for (int n = 0; n < 2; ++n) { bg[n] = *(const f32x4*)(bp + 4 * n); bl[n] = *(const f32x4*)(bp + DFF + 4 * n); }
#pragma unroll
        for (int ai = 0; ai < 2; ++ai)
#pragma unroll
            for (int m = 0; m < 4; ++m) { float a8[8];
#pragma unroll
                for (int n = 0; n < 2; ++n) { const f32x4 g4 = acc[ai][0][m][n] + bg[n], l4 = acc[ai][1][m][n] + bl[n];
#pragma unroll
                    for (int j = 0; j < 4; ++j) { const float g = fminf(g4[j], 7.0f), l = fminf(fmaxf(l4[j], -7.0f), 7.0f);
                        const float sg = __builtin_amdgcn_rcpf(1.0f + __builtin_amdgcn_exp2f(g * (-1.702f * 1.4426950408889634f)));
                        a8[4 * n + j] = (l + 1.0f) * g * sg; } }
                u32x2 w; w.x = pk4_fp8(a8[0], a8[1], a8[2], a8[3]); w.y = pk4_fp8(a8[4], a8[5], a8[6], a8[7]);
                *(u32x2*)(O + (size_t)(row0 + ai * HALF + m * 16) * DFF + col0) = w; }
    }
};

struct EpiDown8 {
    static constexpr bool PERM = true;
    unsigned char* O; const float* bias;
    __device__ __forceinline__ void operator()(const f32x4 (&acc)[2][2][4][2], const Unit& u, int wr, int wc, int fr, int fq) const {
        const int row0 = u.pm * BM + wr * 64 + fr, col0 = u.pn * BM + wc * 32 + 8 * fq;
        const float* bp = bias + (size_t)u.e * DM + col0;
        f32x4 bv[2][2];
#pragma unroll
        for (int bj = 0; bj < 2; ++bj)
#pragma unroll
            for (int n = 0; n < 2; ++n) bv[bj][n] = *(const f32x4*)(bp + bj * HALF + 4 * n);
#pragma unroll
        for (int ai = 0; ai < 2; ++ai)
#pragma unroll
            for (int m = 0; m < 4; ++m) { unsigned char* rowp = O + (size_t)(row0 + ai * HALF + m * 16) * DM + col0;
#pragma unroll
                for (int bj = 0; bj < 2; ++bj) { const f32x4 v0 = acc[ai][bj][m][0] + bv[bj][0], v1 = acc[ai][bj][m][1] + bv[bj][1];
                    u32x2 w; w.x = pk4_fp8(v0[0], v0[1], v0[2], v0[3]); w.y = pk4_fp8(v1[0], v1[1], v1[2], v1[3]);
                    *(u32x2*)(rowp + bj * HALF) = w; } }
    }
};

template <class Epi, class Sched, bool GATHER, bool FP8 = false>
__device__ __forceinline__ void gemm_phase(PG8_LAS unsigned char* lds, const Gemm g, const Sched& S, const Epi& E) {
    int tid_ = threadIdx.x; asm volatile("" : "+v"(tid_));
    const int tid = tid_, wid = __builtin_amdgcn_readfirstlane(tid >> 6), lane = tid & 63, wr = wid >> 2, wc = wid & 3, fr = lane & 15, fq = lane >> 4;
    const int K = FP8 ? g.K / 2 : g.K, nt = K / BK;
    unsigned voffB[2]; int RA[2], CA2[2]; unsigned voffA[2];
#pragma unroll
    for (int i = 0; i < 2; ++i) { int R, C; stage_rc(tid * 16 + i * 8192, R, C); const int Rb = Epi::PERM ? ((R & ~31) + perm32(R & 31)) : R;
        voffA[i] = (unsigned)(R * K + C) * 2u; voffB[i] = (unsigned)(Rb * K + C) * 2u; RA[i] = R; CA2[i] = C * 2; }
    const size_t kstep = (size_t)(BK * 2);
    const size_t hstep = (size_t)HALF * K * 2;
    const size_t tstep = 2 * hstep;
    const unsigned ldsw = (unsigned)wid * 1024u;
    const int aoff = lds_byte(wr * 64 + fr, fq * 8), boff = lds_byte(wc * 32 + fr, fq * 8);
    const unsigned lds0 = (unsigned)(uintptr_t)lds;
#define PG8_SA(b, h) (((b) * 2 + (h)) * HTB)
#define PG8_SB(b, h) ((4 + (b) * 2 + (h)) * HTB)
#define PG8_GLDS(sbase, voff, ldsoff) do { unsigned keep_; asm volatile("s_mov_b32 %0, m0\n\ts_mov_b32 m0, %3\n\ts_nop 0\n\tglobal_load_lds_dwordx4 %1, %2\n\ts_mov_b32 m0, %0" \
        : "=&s"(keep_) : "v"(voff), "s"(sbase), "s"((unsigned)__builtin_amdgcn_readfirstlane((int)(lds0 + (unsigned)(ldsoff)))) : "memory"); } while (0)
#define PG8_STAGE_B(bufoff, gbase) do { PG8_GLDS((const char*)(gbase), voffB[0], (bufoff) + ldsw); PG8_GLDS((const char*)(gbase), voffB[1], (bufoff) + ldsw + 8192); } while (0)
#define PG8_STAGE_A(bufoff, gbase, o0, o1) do { PG8_GLDS((const char*)(gbase), (o0), (bufoff) + ldsw); PG8_GLDS((const char*)(gbase), (o1), (bufoff) + ldsw + 8192); } while (0)
#define PG8_LDA(dst, b, h) do { _Pragma("unroll") for (int m = 0; m < 4; ++m) _Pragma("unroll") for (int k = 0; k < 2; ++k) dst[m][k] = *(const PG8_LAS bf16x8*)(lds + PG8_SA(b, h) + aoff + m * 2048 + k * 1024); } while (0)
#define PG8_LDB(dst, b, h) do { _Pragma("unroll") for (int n = 0; n < 2; ++n) _Pragma("unroll") for (int k = 0; k < 2; ++k) dst[n][k] = *(const PG8_LAS bf16x8*)(lds + PG8_SB(b, h) + boff + n * 2048 + k * 1024); } while (0)
#define PG8_LD8(p) __builtin_shufflevector(*(const PG8_LAS v4i_t*)(p), *(const PG8_LAS v4i_t*)((p) + 1024), 0, 1, 2, 3, 4, 5, 6, 7)
#define PG8_LDA8(dst, b, h) do { _Pragma("unroll") for (int m = 0; m < 4; ++m) dst[m] = PG8_LD8(lds + PG8_SA(b, h) + aoff + m * 2048); } while (0)
#define PG8_LDB8(dst, b, h) do { _Pragma("unroll") for (int n = 0; n < 2; ++n) dst[n] = PG8_LD8(lds + PG8_SB(b, h) + boff + n * 2048); } while (0)
#define PG8_MMA(ai, bj, At, Bt) do { __builtin_amdgcn_s_setprio(1); \
        if constexpr (FP8) { _Pragma("unroll") for (int m = 0; m < 4; ++m) _Pragma("unroll") for (int n = 0; n < 2; ++n) \
            acc[ai][bj][m][n] = __builtin_amdgcn_mfma_scale_f32_16x16x128_f8f6f4(Bt##8[n], At##8[m], acc[ai][bj][m][n], 0, 0, 0, WSCALE_E8M0, 0, 0x7f7f7f7f); \
              \
            _Pragma("unroll") for (int m = 0; m < 4; ++m) _Pragma("unroll") for (int n = 0; n < 2; ++n) asm volatile("" : "+v"(acc[ai][bj][m][n])); } \
        else { _Pragma("unroll") for (int m = 0; m < 4; ++m) _Pragma("unroll") for (int n = 0; n < 2; ++n) _Pragma("unroll") for (int k = 0; k < 2; ++k) \
            acc[ai][bj][m][n] = __builtin_amdgcn_mfma_f32_16x16x32_bf16(Bt[n][k], At[m][k], acc[ai][bj][m][n], 0, 0, 0); } \
        __builtin_amdgcn_s_setprio(0); } while (0)
#define PG8_XLDA(dst, b, h) do { if constexpr (FP8) PG8_LDA8(dst##8, b, h); else PG8_LDA(dst, b, h); } while (0)
#define PG8_XLDB(dst, b, h) do { if constexpr (FP8) PG8_LDB8(dst##8, b, h); else PG8_LDB(dst, b, h); } while (0)
#define PG8_WAIT_V(n) asm volatile("s_waitcnt vmcnt(" #n ")" ::: "memory")
#define PG8_WAIT_L(n) asm volatile("s_waitcnt lgkmcnt(" #n ")" ::: "memory")
#define PG8_BAR __builtin_amdgcn_s_barrier()
#define PG8_SCHED __builtin_amdgcn_sched_barrier(0)
    Unit cur, nxt; int ui = 0;
#if defined(PROBE_DOUBLE_K)
    constexpr bool DKSEL = (PROBE_DOUBLE_K == 1) ? GATHER : (PROBE_DOUBLE_K == 2) ? (FP8 && !GATHER) : (!FP8 && !GATHER && Epi::PERM);
#define PG8_UIDX(i) (DKSEL ? ((i) >> 1) : (i))
#else
#define PG8_UIDX(i) (i)
#endif
    if (!S.next(PG8_UIDX(0), cur)) return;
    f32x4 acc[2][2][4][2];
#pragma unroll
    for (int a = 0; a < 2; ++a)
#pragma unroll
        for (int b = 0; b < 2; ++b)
#pragma unroll
            for (int m = 0; m < 4; ++m)
#pragma unroll
                for (int n = 0; n < 2; ++n) acc[a][b][m][n] = (f32x4){0.f, 0.f, 0.f, 0.f};
    bf16x8 At[4][2], B0[2][2], B1[2][2]; v8i_t At8[4], B08[2], B18[2];
    const char* cA = GATHER ? (const char*)g.A : (const char*)g.A + (size_t)cur.pm * tstep;
    const char* cB = (const char*)g.Bt + ((size_t)cur.e * g.strideB) * 2 + (size_t)cur.pn * tstep;
    unsigned gc[2][2], gn[2][2];
    if constexpr (GATHER) { S.gather(cur, RA, CA2, gc, (unsigned)(K * 2)); }
    else {
#pragma unroll
        for (int h = 0; h < 2; ++h)
#pragma unroll
            for (int i = 0; i < 2; ++i) gc[h][i] = (unsigned)(h * hstep) + voffA[i]; }
#pragma unroll
    for (int h = 0; h < 2; ++h)
#pragma unroll
        for (int i = 0; i < 2; ++i) gn[h][i] = gc[h][i];
    PG8_STAGE_B(PG8_SB(0, 0), cB); PG8_STAGE_B(PG8_SB(0, 1), cB + hstep); PG8_STAGE_A(PG8_SA(0, 0), cA, gc[0][0], gc[0][1]); PG8_STAGE_A(PG8_SA(0, 1), cA, gc[1][0], gc[1][1]);
    if (wr == 1) PG8_BAR;
    PG8_WAIT_V(2); PG8_BAR;
    PG8_STAGE_B(PG8_SB(1, 0), cB + kstep); PG8_STAGE_A(PG8_SA(1, 0), cA + kstep, gc[0][0], gc[0][1]); PG8_STAGE_B(PG8_SB(1, 1), cB + hstep + kstep);
    PG8_WAIT_V(6); PG8_BAR;
    for (;;) {
        const bool has_next = S.next(PG8_UIDX(ui + 1), nxt);
        const char* nA = GATHER ? cA : (has_next ? (const char*)g.A + (size_t)nxt.pm * tstep : cA);
        const char* nB = has_next ? (const char*)g.Bt + ((size_t)nxt.e * g.strideB) * 2 + (size_t)nxt.pn * tstep : cB;
        if constexpr (GATHER) { if (has_next) S.gather(nxt, RA, CA2, gn, (unsigned)(K * 2)); }
        for (int t = 0; t < nt; t += 2) {
            const bool last = (t == nt - 2);
            const char* a1 = cA + (size_t)(t + 1) * kstep;
            const char* a2 = last ? nA : cA + (size_t)(t + 2) * kstep; const char* b2 = last ? nB : cB + (size_t)(t + 2) * kstep;
            const char* a3 = a2 + kstep; const char* b3 = b2 + kstep;
            unsigned o00 = gc[0][0], o01 = gc[0][1], o10 = gc[1][0], o11 = gc[1][1];
            if constexpr (GATHER) { if (last) { o00 = gn[0][0]; o01 = gn[0][1]; o10 = gn[1][0]; o11 = gn[1][1]; } }
            PG8_XLDB(B0, 0, 0); PG8_XLDB(B1, 0, 1); PG8_SCHED; PG8_XLDA(At, 0, 0); PG8_STAGE_A(PG8_SA(1, 1), a1, gc[1][0], gc[1][1]);
            PG8_WAIT_V(8); PG8_WAIT_L(0); PG8_BAR; PG8_MMA(0, 0, At, B0); PG8_MMA(0, 1, At, B1); PG8_BAR; PG8_SCHED;
            PG8_XLDA(At, 0, 1); PG8_STAGE_B(PG8_SB(0, 0), b2); PG8_STAGE_B(PG8_SB(0, 1), b2 + hstep); PG8_STAGE_A(PG8_SA(0, 0), a2, o00, o01);
            PG8_WAIT_V(8); PG8_WAIT_L(0); PG8_BAR; PG8_MMA(1, 0, At, B0); PG8_MMA(1, 1, At, B1); PG8_BAR; PG8_SCHED;
            PG8_XLDB(B0, 1, 0); PG8_XLDB(B1, 1, 1); PG8_SCHED; PG8_XLDA(At, 1, 0); PG8_STAGE_A(PG8_SA(0, 1), a2, o10, o11);
            PG8_WAIT_V(8); PG8_WAIT_L(0); PG8_BAR; PG8_MMA(0, 0, At, B0); PG8_MMA(0, 1, At, B1); PG8_BAR; PG8_SCHED;
            PG8_XLDA(At, 1, 1); PG8_STAGE_B(PG8_SB(1, 0), b3); PG8_STAGE_B(PG8_SB(1, 1), b3 + hstep); PG8_STAGE_A(PG8_SA(1, 0), a3, o00, o01);
            PG8_WAIT_V(8); PG8_WAIT_L(0); PG8_BAR; PG8_MMA(1, 0, At, B0); PG8_MMA(1, 1, At, B1); PG8_BAR; PG8_SCHED;
        }
        if (wr == 0) PG8_BAR;
#if defined(PROBE_DOUBLE_K)
        const bool dk_first = DKSEL && ((ui & 1) == 0);
        if (DKSEL && !dk_first) { _Pragma("unroll") for (int a = 0; a < 2; ++a) _Pragma("unroll") for (int b = 0; b < 2; ++b) _Pragma("unroll") for (int m = 0; m < 4; ++m) _Pragma("unroll") for (int n = 0; n < 2; ++n) acc[a][b][m][n] *= 0.5f; }
#else
        constexpr bool dk_first = false;
#endif
        if (!dk_first)
        { int fr_ = fr, fq_ = fq; asm volatile("" : "+v"(fr_), "+v"(fq_));
          E(acc, cur, wr, wc, fr_, fq_);
#if defined(PROBE_DOUBLE_EPI)
          if constexpr (GATHER) { asm volatile("" : "+v"(fr_), "+v"(fq_)); E(acc, cur, wr, wc, fr_, fq_); }
#endif
          }
        if (!has_next) break;
        if (!dk_first) {
#pragma unroll
        for (int a = 0; a < 2; ++a)
#pragma unroll
            for (int b = 0; b < 2; ++b)
#pragma unroll
                for (int m = 0; m < 4; ++m)
#pragma unroll
                    for (int n = 0; n < 2; ++n) acc[a][b][m][n] = (f32x4){0.f, 0.f, 0.f, 0.f};
        }
        cur = nxt; cA = nA; cB = nB; ++ui;
#pragma unroll
        for (int h = 0; h < 2; ++h)
#pragma unroll
            for (int i = 0; i < 2; ++i) gc[h][i] = gn[h][i];
        if (wr == 1) PG8_BAR;
    }
    PG8_WAIT_V(0);
    PG8_BAR;
#undef PG8_UIDX
#undef PG8_SA
#undef PG8_SB
#undef PG8_GLDS
#undef PG8_STAGE_A
#undef PG8_STAGE_B
#undef PG8_LDA
#undef PG8_LDB
#undef PG8_MMA
#undef PG8_LD8
#undef PG8_LDA8
#undef PG8_LDB8
#undef PG8_XLDA
#undef PG8_XLDB
#undef PG8_WAIT_V
#undef PG8_WAIT_L
#undef PG8_BAR
#undef PG8_SCHED
}
}

namespace attn_body {
using bf16=__hip_bfloat16;
using bf16x8=__attribute__((ext_vector_type(8)))short;
using s16x4=__attribute__((ext_vector_type(4)))short;
using f32x16=__attribute__((ext_vector_type(16)))float;
using u32x4=__attribute__((ext_vector_type(4)))unsigned;
constexpr int D=64,PQ=INW,PO=DM;
constexpr int NW=8,QBLK=32,QB=QBLK*NW,KVBLK=64,NQB=SEQ/QB;
constexpr int ATTN_UNIT_ROWS=QB;
__device__ __forceinline__ int crow(int r,int hi){return (r&3)+8*(r>>2)+4*hi;}
#define SBAR() __builtin_amdgcn_sched_barrier(0)
__device__ __forceinline__ void cmask(f32x16&p0,f32x16&p1,int jb,int qrel,int hi){
  const float NEG=-INFINITY; int kb=64*jb+4*hi;
  #pragma unroll
  for(int r=0;r<16;++r){int kv=kb+(r&3)+8*(r>>2); if(kv>qrel)p0[r]=NEG; if(kv+32>qrel)p1[r]=NEG;}
}

constexpr int NSLOT=3, SLOTB=8192;
constexpr int LDS_K=0, LDS_V=NSLOT*SLOTB, LDS_WS=3*NSLOT*SLOTB, LDS_STASH=LDS_WS+NW*64*4, LDS_BYTES=LDS_STASH+NW*8192;
constexpr float C2=0.125f*1.4426950408889634f;
__device__ __forceinline__ void glds16(const void*gsrc,unsigned lds_dst){unsigned keep;
  asm volatile("s_mov_b32 %0, m0\n\ts_mov_b32 m0, %2\n\ts_nop 0\n\tglobal_load_lds_dwordx4 %1, off\n\ts_mov_b32 m0, %0":"=&s"(keep):"v"(gsrc),"s"(lds_dst):"memory");}
__device__ __forceinline__ float max3f(float a,float b,float c){float r;asm("v_max3_f32 %0, %1, %2, %3":"=v"(r):"v"(a),"v"(b),"v"(c));return r;}
__device__ __forceinline__ float max2f(float a,float b){float r;asm("v_max_f32_e32 %0, %1, %2":"=v"(r):"v"(a),"v"(b));return r;}
__device__ __forceinline__ float fadd_s(float a,float b){float r;asm("v_add_f32_e32 %0, %1, %2":"=v"(r):"v"(a),"v"(b));return r;}
__device__ __forceinline__ float fsub_s(float a,float b){float r;asm("v_sub_f32_e32 %0, %1, %2":"=v"(r):"v"(a),"v"(b));return r;}
typedef float f32x2_t __attribute__((ext_vector_type(2))); typedef __bf16 bf16x2_t __attribute__((ext_vector_type(2)));
__device__ __forceinline__ unsigned cvtpk_s(float lo,float hi){f32x2_t v={lo,hi};bf16x2_t b=__builtin_convertvector(v,bf16x2_t);return __builtin_bit_cast(unsigned,b);}
#define WAIT_BAR(N) asm volatile("s_waitcnt vmcnt(" #N ") lgkmcnt(0)\n\ts_barrier":::"memory")

__device__ __forceinline__ void qkt(f32x16&p0,f32x16&p1,const char*Kslot,const bf16x8*qr,int r32,int hi){ const f32x16 negm=f32x16{};
  const char*kb=Kslot+hi*1024+r32*16;
  #pragma unroll
  for(int d0=0;d0<4;++d0){
    const bf16x8 b0=*reinterpret_cast<const bf16x8*>(kb+d0*2048);
    const bf16x8 b1=*reinterpret_cast<const bf16x8*>(kb+d0*2048+512);
    if(d0==0){p0=__builtin_amdgcn_mfma_f32_32x32x16_bf16(b0,qr[0],negm,0,0,0);p1=__builtin_amdgcn_mfma_f32_32x32x16_bf16(b1,qr[0],negm,0,0,0);}
    else{p0=__builtin_amdgcn_mfma_f32_32x32x16_bf16(b0,qr[d0],p0,0,0,0);p1=__builtin_amdgcn_mfma_f32_32x32x16_bf16(b1,qr[d0],p1,0,0,0);}}
}
typedef __attribute__((address_space(3))) const char* lds_cptr;
typedef short v4i16_t __attribute__((ext_vector_type(4)));
__device__ __forceinline__ void kload8(bf16x8*kf,lds_cptr kp){
  kf[0]=*(const __attribute__((address_space(3))) bf16x8*)(kp);      kf[1]=*(const __attribute__((address_space(3))) bf16x8*)(kp+512);
  kf[2]=*(const __attribute__((address_space(3))) bf16x8*)(kp+2048); kf[3]=*(const __attribute__((address_space(3))) bf16x8*)(kp+2560);
  kf[4]=*(const __attribute__((address_space(3))) bf16x8*)(kp+4096); kf[5]=*(const __attribute__((address_space(3))) bf16x8*)(kp+4608);
  kf[6]=*(const __attribute__((address_space(3))) bf16x8*)(kp+6144); kf[7]=*(const __attribute__((address_space(3))) bf16x8*)(kp+6656);
}
__device__ __forceinline__ void kload2(bf16x8*kf,lds_cptr kp,int j){ kf[2*j]=*(const __attribute__((address_space(3))) bf16x8*)(kp+j*2048); kf[2*j+1]=*(const __attribute__((address_space(3))) bf16x8*)(kp+j*2048+512); }
__device__ __forceinline__ s16x4 vtr(lds_cptr p){ return __builtin_bit_cast(s16x4,__builtin_amdgcn_ds_read_tr16_b64_v4i16((__attribute__((address_space(3))) v4i16_t*)p)); }
__device__ __forceinline__ float rowmax(const f32x16&p0,const f32x16&p1){
  float a=max3f(p0[0],p0[1],p1[0]),b=max3f(p0[2],p0[3],p1[1]);a=max3f(a,p1[2],p1[3]);
  #pragma unroll
  for(int r=4;r<16;r+=4){a=max3f(a,p0[r],p0[r+1]);b=max3f(b,p0[r+2],p0[r+3]);a=max3f(a,p1[r],p1[r+1]);b=max3f(b,p1[r+2],p1[r+3]);}
  const float m=max2f(a,b);
  auto rr=__builtin_amdgcn_permlane32_swap(__float_as_uint(m),__float_as_uint(m),false,false);
  return max2f(__uint_as_float(rr[0]),__uint_as_float(rr[1]));
}
__device__ __forceinline__ void pv(f32x16*o,int vb,bf16x8 pa0,bf16x8 pa1,bf16x8 pa2,bf16x8 pa3){
  #pragma unroll
  for(int d0=0;d0<4;++d0){s16x4 lo[4],hi[4];
    #pragma unroll
    for(int ks=0;ks<4;++ks){
      asm volatile("ds_read_b64_tr_b16 %0,%1 offset:%c2":"=&v"(lo[ks]):"v"(vb),"i"(d0*4096+ks*1024):"memory");
      asm volatile("ds_read_b64_tr_b16 %0,%1 offset:%c2":"=&v"(hi[ks]):"v"(vb),"i"(d0*4096+ks*1024+512):"memory");}
    asm volatile("s_waitcnt lgkmcnt(0)":::"memory");SBAR();
    #define PK(k) (bf16x8){lo[k][0],lo[k][1],lo[k][2],lo[k][3],hi[k][0],hi[k][1],hi[k][2],hi[k][3]}
    o[d0]=__builtin_amdgcn_mfma_f32_32x32x16_bf16(pa0,PK(0),o[d0],0,0,0);
    o[d0]=__builtin_amdgcn_mfma_f32_32x32x16_bf16(pa1,PK(1),o[d0],0,0,0);
    o[d0]=__builtin_amdgcn_mfma_f32_32x32x16_bf16(pa2,PK(2),o[d0],0,0,0);
    o[d0]=__builtin_amdgcn_mfma_f32_32x32x16_bf16(pa3,PK(3),o[d0],0,0,0);
    #undef PK
  }
}

#ifndef ATTN_STORE16
#define ATTN_STORE16(p,v) (*(u32x4*)(p)=(v))
#endif
template<int THRL> __device__ __forceinline__ void attn_unit(int qb,int st,float lam,const float*sgp,const bf16*Qb,const bf16*__restrict__ Kb,const bf16*__restrict__ Vb,bf16*Ob,char*shm){
  int tid_=threadIdx.x; asm volatile("":"+v"(tid_));
  const int tid=tid_,lane=tid&63,r32=lane&31,hi=lane>>5; const int wid=__builtin_amdgcn_readfirstlane(tid>>6);
  const int q0=qb*QB;
  const bf16*Qw=Qb+(long)(q0+wid*QBLK)*PQ;
  const bf16*Kh=Kb,*Vh=Vb;
  const unsigned lds0=(unsigned)(uintptr_t)shm;
  float*wsf=(float*)(shm+LDS_WS)+wid*64;
  const bf16*ksrc=Kh+(long)lane*PQ+wid*8;
  const bf16*vsrc=Vh+(long)(16*(wid&3)+(lane>>2))*PQ+(wid>>2)*32+(lane&3)*8;
  const unsigned kdst=lds0+LDS_K+wid*1024, vdst=lds0+LDS_V+wid*1024;
  #define DMA_K(t,slot) glds16(ksrc+(long)(t)*KVBLK*PQ,(unsigned)__builtin_amdgcn_readfirstlane(kdst+(slot)))
  #define DMA_V(t,slot) do{ glds16(vsrc+(long)(t)*KVBLK*PQ,(unsigned)__builtin_amdgcn_readfirstlane(vdst+2*(slot))); glds16(vsrc+(long)(t)*KVBLK*PQ+64,(unsigned)__builtin_amdgcn_readfirstlane(vdst+2*(slot)+8192)); }while(0)
  const int vb0=(int)(lds0+LDS_V)+((lane>>4)&1)*32+(lane&3)*8+(4*hi+((lane&15)>>2))*64;
  const char*Kbase=shm+LDS_K; bf16x8 kf[8];
  const lds_cptr shm3=(lds_cptr)shm; const lds_cptr kp0=shm3+LDS_K+hi*1024+r32*16; const lds_cptr vp0=shm3+LDS_V+((lane>>4)&1)*32+(lane&3)*8+(4*hi+((lane&15)>>2))*64;
  const int NT=(q0+QB)/KVBLK;
  DMA_K(0,0);DMA_V(0,0);DMA_K(1,SLOTB);
  bf16x8 qr[4];
  #pragma unroll
  for(int d0=0;d0<4;++d0)qr[d0]=*reinterpret_cast<const bf16x8*>(&Qw[(long)r32*PQ+d0*16+hi*8]);
  float mhat=0.f,l_reg=0.f;f32x16 o[4];o[0]=f32x16{};o[1]=f32x16{};o[2]=f32x16{};o[3]=f32x16{};
  const int qrel=wid*QBLK+r32;
  #define CMASK(P0,P1,t) do{int jb_=(t)-(NT-4); if(jb_>=0)cmask(P0,P1,jb_,qrel,hi);}while(0)
  bool resc=false;
  #define START(P0,P1) do{ const float rm=rowmax(P0,P1); resc=false; mhat=rm; \
    _Pragma("unroll") for(int r=0;r<16;++r)P0[r]=__builtin_amdgcn_exp2f(P0[r]-mhat); }while(0)
  #define RESC() do{ if(resc){ asm volatile("s_waitcnt lgkmcnt(0)":::"memory"); \
      _Pragma("unroll") for(int d_=0;d_<4;++d_) _Pragma("unroll") for(int r=0;r<16;++r)o[d_][r]*=wsf[crow(r,hi)]; } }while(0)
  f32x16 pA0,pA1,pB0,pB1;
  int sl_prev=0,sl_cur=0,sl_next=SLOTB;
  #define ROT() do{sl_prev=sl_cur;sl_cur=sl_next;sl_next=(sl_next==(NSLOT-1)*SLOTB)?0:sl_next+SLOTB;}while(0)
  DMA_K(2,2*SLOTB);
  WAIT_BAR(4);
  qkt(pA0,pA1,Kbase,qr,r32,hi);asm volatile("s_nop 15\n\ts_nop 7":"+v"(pA0),"+v"(pA1));CMASK(pA0,pA1,0);
  START(pA0,pA1);
  _Pragma("unroll") for(int r=0;r<16;++r)pA1[r]=__builtin_amdgcn_exp2f(pA1[r]-mhat);
  WAIT_BAR(0);
  DMA_K(3,0);DMA_V(1,SLOTB);
  ROT();
  kload8(kf,kp0+sl_cur);
  WAIT_BAR(3);
  s16x4 vlo[4],vhi[4]; u32x4 pw0,pw1,pw2,pw3;
  #define PKW(P,B) cvtpk_s(P[B],P[B+1])
  #define PAF(k) __builtin_bit_cast(bf16x8,pw##k)
  #define PAFJ(j) __builtin_bit_cast(bf16x8,((j)<4?pw0:(j)<8?pw1:(j)<12?pw2:pw3))
  #define VFR(i) (bf16x8){vlo[i][0],vlo[i][1],vlo[i][2],vlo[i][3],vhi[i][0],vhi[i][1],vhi[i][2],vhi[i][3]}
  #define PIN(x) asm volatile("":"+v"(x))
  #define MX3(a,b,c) __builtin_fmaxf(__builtin_fmaxf((a),(b)),(c))
  #define GAPA(MF,A0,A1,A2,A3,W0,W1,PW) do{ MF; sacc+=A0; sacc+=A1; sacc+=A2; sacc+=A3; PIN(sacc); W0; W1; PIN(PW); SBAR(); }while(0)
  #define EX(v) __builtin_amdgcn_exp2f(v)
  #define GAPB(MF,X,B) do{ MF; X[B]=EX(X[B]-mhat); X[B+1]=EX(X[B+1]-mhat); PIN(X); SBAR(); }while(0)
  #define VRD(S,ks,d0) do{ vlo[S]=vtr(vp_+((d0)*4096+(ks)*1024)); vhi[S]=vtr(vp_+((d0)*4096+(ks)*1024+512)); }while(0)
  #define KRD(G,j) do{ if(G){ kload2(kf,kp0+sl_next,j); SBAR(); } }while(0)
  #define PVG(j,X,B) GAPB(o[(j)&3]=__builtin_amdgcn_mfma_f32_32x32x16_bf16(PAFJ(j),VFR((j)&3),o[(j)&3],0,0,0), X,B)
  #define STEP(C0,C1,P0,P1,t,GK,GV,GL) do{ SBAR(); \
    const lds_cptr vp_=vp0+2*sl_prev; \
    float sacc=(P0[0]+P0[1]); \
    GAPA(C0=__builtin_amdgcn_mfma_f32_32x32x16_bf16(kf[0],qr[0],f32x16{},0,0,0), P0[2],P0[3],P0[4],P0[5],     pw0[0]=PKW(P0,0), pw0[1]=PKW(P0,2), pw0); \
    GAPA(C1=__builtin_amdgcn_mfma_f32_32x32x16_bf16(kf[1],qr[0],f32x16{},0,0,0), P0[6],P0[7],P0[8],P0[9],     pw0[2]=PKW(P0,4), pw0[3]=PKW(P0,6), pw0); \
    GAPA(C0=__builtin_amdgcn_mfma_f32_32x32x16_bf16(kf[2],qr[1],C0,0,0,0),   P0[10],P0[11],P0[12],P0[13], pw1[0]=PKW(P0,8), pw1[1]=PKW(P0,10), pw1); \
    GAPA(C1=__builtin_amdgcn_mfma_f32_32x32x16_bf16(kf[3],qr[1],C1,0,0,0),   P0[14],P0[15],P1[0],P1[1],   pw1[2]=PKW(P0,12),pw1[3]=PKW(P0,14), pw1); \
    VRD(0,0,0); SBAR(); GAPA(C0=__builtin_amdgcn_mfma_f32_32x32x16_bf16(kf[4],qr[2],C0,0,0,0),   P1[2],P1[3],P1[4],P1[5],     pw2[0]=PKW(P1,0), pw2[1]=PKW(P1,2), pw2); \
    VRD(1,0,1); SBAR(); GAPA(C1=__builtin_amdgcn_mfma_f32_32x32x16_bf16(kf[5],qr[2],C1,0,0,0),   P1[6],P1[7],P1[8],P1[9],     pw2[2]=PKW(P1,4), pw2[3]=PKW(P1,6), pw2); \
    VRD(2,0,2); SBAR(); GAPA(C0=__builtin_amdgcn_mfma_f32_32x32x16_bf16(kf[6],qr[3],C0,0,0,0),   P1[10],P1[11],P1[12],P1[13], pw3[0]=PKW(P1,8), pw3[1]=PKW(P1,10), pw3); \
    VRD(3,0,3); SBAR(); GAPA(C1=__builtin_amdgcn_mfma_f32_32x32x16_bf16(kf[7],qr[3],C1,0,0,0),   P1[14],P1[15],0.f,0.f,       pw3[2]=PKW(P1,12),pw3[3]=PKW(P1,14), pw3); \
    l_reg+=sacc; \
    if(GK){DMA_K((t)+3,sl_cur);} if(GV){DMA_V((t)+1,sl_next);} \
    CMASK(C0,C1,t); \
    { float a=MX3(C0[0],C0[1],C1[0]),b=MX3(C0[2],C0[3],C1[1]); a=MX3(a,C1[2],C1[3]); \
      _Pragma("unroll") for(int r=4;r<16;r+=4){a=MX3(a,C0[r],C0[r+1]);b=MX3(b,C0[r+2],C0[r+3]);a=MX3(a,C1[r],C1[r+1]);b=MX3(b,C1[r+2],C1[r+3]);} \
      float rm=__builtin_fmaxf(a,b); { auto rr=__builtin_amdgcn_permlane32_swap(__float_as_uint(rm),__float_as_uint(rm),false,false); rm=__builtin_fmaxf(__uint_as_float(rr[0]),__uint_as_float(rr[1])); } \
      resc=false; rm-=mhat;                                   \
      if(__builtin_expect(__any(rm>(float)THRL),0)){ const float dl=__builtin_fmaxf(rm,0.f); mhat+=dl; \
        const float f=__builtin_amdgcn_exp2f(-dl); l_reg*=f; if(hi==0)wsf[r32]=f; resc=true; } } \
    SBAR(); \
      \
    PVG(0,C0,0);  VRD(0,1,0); SBAR(); \
    PVG(1,C0,2);  VRD(1,1,1); SBAR(); \
    PVG(2,C0,4);  VRD(2,1,2); SBAR(); \
    PVG(3,C0,6);  VRD(3,1,3); SBAR(); \
    PVG(4,C0,8);  VRD(0,2,0); SBAR(); \
    PVG(5,C0,10); VRD(1,2,1); SBAR(); \
    PVG(6,C0,12); VRD(2,2,2); SBAR(); \
    PVG(7,C0,14); VRD(3,2,3); SBAR(); \
    KRD(GL,0); PVG(8,C1,0);   VRD(0,3,0); SBAR(); \
    KRD(GL,1); PVG(9,C1,2);   VRD(1,3,1); SBAR(); \
    KRD(GL,2); PVG(10,C1,4);  VRD(2,3,2); SBAR(); \
    KRD(GL,3); PVG(11,C1,6);  VRD(3,3,3); SBAR(); \
    PVG(12,C1,8); PVG(13,C1,10); PVG(14,C1,12); PVG(15,C1,14); \
    }while(0)
  int t=1;
  #undef CMASK
  #define CMASK(P0,P1,t) do{}while(0)
  for(;t+5<NT;t+=2){
    STEP(pB0,pB1,pA0,pA1,t,true,true,true);     WAIT_BAR(3); RESC(); ROT();
    STEP(pA0,pA1,pB0,pB1,t+1,true,true,true);   WAIT_BAR(3); RESC(); ROT();
  }
  #undef CMASK
  #define CMASK(P0,P1,t) do{int jb_=(t)-(NT-4); if(jb_>=0)cmask(P0,P1,jb_,qrel,hi);}while(0)
  #define ENDW(tt) do{ if((tt)+3<NT){WAIT_BAR(3);} else if((tt)+2<NT){WAIT_BAR(2);} else {WAIT_BAR(0);} }while(0)
  for(;t+1<NT;t+=2){
    STEP(pB0,pB1,pA0,pA1,t,(t+3<NT),(t+1<NT),(t+1<NT));       ENDW(t);   RESC(); ROT();
    STEP(pA0,pA1,pB0,pB1,t+1,(t+4<NT),(t+2<NT),(t+2<NT));     ENDW(t+1); RESC(); ROT();
  }
  STEP(pB0,pB1,pA0,pA1,NT-1,false,false,false); RESC();
  { float sacc=pB0[0]+pB0[1]; _Pragma("unroll") for(int r=2;r<16;++r)sacc+=pB0[r]; _Pragma("unroll") for(int r=0;r<16;++r)sacc+=pB1[r]; l_reg+=sacc;
    pw0=(u32x4){PKW(pB0,0),PKW(pB0,2),PKW(pB0,4),PKW(pB0,6)};pw1=(u32x4){PKW(pB0,8),PKW(pB0,10),PKW(pB0,12),PKW(pB0,14)};pw2=(u32x4){PKW(pB1,0),PKW(pB1,2),PKW(pB1,4),PKW(pB1,6)};pw3=(u32x4){PKW(pB1,8),PKW(pB1,10),PKW(pB1,12),PKW(pB1,14)};
    SBAR(); pv(o,vb0+2*sl_cur,PAF(0),PAF(1),PAF(2),PAF(3)); }
  #undef PKW
  #undef PAF
  #undef PAFJ
  #undef PVG
  #undef VFR
  #undef PIN
  #undef MX3
  #undef GAPA
  #undef GAPB
  #undef EX
  #undef VRD
  #undef KRD
  #undef STEP
  #undef ENDW
  {auto rr=__builtin_amdgcn_permlane32_swap(__float_as_uint(l_reg),__float_as_uint(l_reg),false,false);l_reg=__uint_as_float(rr[0])+__uint_as_float(rr[1]);}
  if(hi==0)wsf[32+r32]=l_reg;asm volatile("s_waitcnt lgkmcnt(0)":::"memory");
  float rli[16];
  #pragma unroll
  for(int r=0;r<16;++r)rli[r]=__builtin_amdgcn_rcpf(wsf[32+crow(r,hi)]);
  bf16*stash=(bf16*)(shm+LDS_STASH)+wid*4096;
  if(st==0){
    #pragma unroll
    for(int r=0;r<16;++r){const int orow=crow(r,hi);
      #pragma unroll
      for(int d0=0;d0<4;++d0)stash[orow*128+d0*32+r32]=__float2bfloat16(o[d0][r]*rli[r]);}
  } else {
    asm volatile("s_waitcnt lgkmcnt(0)\n\ts_barrier":::"memory");
    bf16*stg=(bf16*)(shm+LDS_K)+wid*4096;
    #pragma unroll
    for(int r=0;r<16;++r){const int orow=crow(r,hi);
      #pragma unroll
      for(int d0=0;d0<4;++d0)stg[orow*128+d0*32+r32]=__float2bfloat16(o[d0][r]*rli[r]);}
    asm volatile("s_waitcnt lgkmcnt(0)":::"memory");
    bf16*Ow=Ob+(long)(q0+wid*QBLK)*PO;
    const int ch=lane&15; float sgv[8];
    #pragma unroll
    for(int i=0;i<8;++i)sgv[i]=sgp[ch*8+i]*(1.0f-LAMBDA_INIT);
    #pragma unroll
    for(int i=0;i<8;++i){const int row=i*4+(lane>>4);
      const u32x4 a4=*(const u32x4*)(stash+row*128+ch*8), b4=*(const u32x4*)(stg+row*128+ch*8);
      const unsigned aw[4]={a4.x,a4.y,a4.z,a4.w}, bw[4]={b4.x,b4.y,b4.z,b4.w}; float d[8]; float ss=0.f;
      #pragma unroll
      for(int c=0;c<4;++c){ d[2*c]=__uint_as_float(aw[c]<<16)-lam*__uint_as_float(bw[c]<<16); d[2*c+1]=__uint_as_float(aw[c]&0xffff0000u)-lam*__uint_as_float(bw[c]&0xffff0000u); ss+=d[2*c]*d[2*c]+d[2*c+1]*d[2*c+1]; }
      ss+=__shfl_xor(ss,1); ss+=__shfl_xor(ss,2); ss+=__shfl_xor(ss,4); ss+=__shfl_xor(ss,8);
      const float rn=rsqrtf(ss*(1.0f/128.0f)+LN_EPS);
      u32x4 ov; ov.x=cvtpk_s(d[0]*rn*sgv[0],d[1]*rn*sgv[1]); ov.y=cvtpk_s(d[2]*rn*sgv[2],d[3]*rn*sgv[3]); ov.z=cvtpk_s(d[4]*rn*sgv[4],d[5]*rn*sgv[5]); ov.w=cvtpk_s(d[6]*rn*sgv[6],d[7]*rn*sgv[7]);
      ATTN_STORE16(Ow+(long)row*PO+ch*8,ov); }
  }
  asm volatile("s_waitcnt lgkmcnt(0)\n\ts_barrier":::"memory");
  #undef DMA_K
  #undef DMA_V
  #undef CMASK
  #undef START
  #undef RESC
  #undef ROT
}
constexpr int ATTN_LDS_BYTES=LDS_BYTES;
template<int THRL=8> __device__ __forceinline__ void attn_phase(char*lds,const bf16_t*proj,bf16_t*mix,int vcu,float lam,const float*sgp){
  const int bh=vcu>>3,s8=vcu&7,b=bh>>2,h=bh&3;
  const bf16*P0=(const bf16*)proj+(long)b*SEQ*PQ; bf16*O0=(bf16*)mix+(long)b*SEQ*PO+h*128;
  for(int i=0;i<4;++i){ const int qb=(i<2)?(15-s8):s8, st=i&1;
    attn_unit<THRL>(qb,st,lam,sgp,P0+C_Q+st*256+h*64,P0+C_K+st*256+h*64,P0+C_V+h*128,O0,lds); }
}
#undef SBAR
#undef WAIT_BAR
}

constexpr int NWAVES = 8;
constexpr int RING_OFF = 0, RING_BYTES = 131072;
constexpr int LDSCTL_OFF = 155648, MISC_OFF = LDSCTL_OFF + 320;
constexpr int TAB_OFF = LDSCTL_OFF + 1024;
constexpr int REC_OFF = LDSCTL_OFF + 2048;
constexpr int LDS_BYTES = 163840;
static_assert(REC_OFF + (64 + 512) * 4 <= LDS_BYTES && attn_body::ATTN_LDS_BYTES <= LDSCTL_OFF && RING_BYTES <= LDSCTL_OFF, "LDS map");

#define GAS __attribute__((address_space(1)))
#define LAS __attribute__((address_space(3)))
typedef unsigned v4u __attribute__((ext_vector_type(4)));
typedef unsigned v2u __attribute__((ext_vector_type(2)));
typedef float f32x4 __attribute__((ext_vector_type(4)));
typedef float f32x2 __attribute__((ext_vector_type(2)));
typedef short bf16x8 __attribute__((ext_vector_type(8)));
typedef GAS unsigned gu32;
#define RLX_AGENT __ATOMIC_RELAXED, __HIP_MEMORY_SCOPE_AGENT
#define LDS_WAIT() asm volatile("s_waitcnt lgkmcnt(0)" ::: "memory")
#define VM_WAIT() asm volatile("s_waitcnt vmcnt(0)" ::: "memory")

#define XB_TMO      128
#define XB_XCNT(j)  (256  + 64 * (j))
#define XB_XSUB(j)  (1280 + 64 * (j))
#define XB_XGEN(j)  (2304 + 64 * (j))
#define XB_TOP      3328
#define XB_TOPGEN   3392
#define XCD_BAR_WORDS 3456
#define XB_SPIN_CAP (1u << 18)
__device__ __forceinline__ unsigned xb_ld(unsigned* p)              { return __hip_atomic_load(p, __ATOMIC_RELAXED, __HIP_MEMORY_SCOPE_AGENT); }
__device__ __forceinline__ unsigned xb_add(unsigned* p, unsigned v) { return __hip_atomic_fetch_add(p, v, __ATOMIC_RELAXED, __HIP_MEMORY_SCOPE_AGENT); }
__device__ __forceinline__ unsigned xb_xcc_id() { return (unsigned)__builtin_amdgcn_s_getreg((3 << 11) | 20) & 0xFu; }
#define XB_SPIN(cond, bar) do { unsigned _sp = 0; while (cond) { __builtin_amdgcn_s_sleep(1); \
    if ((++_sp & 255u) == 0u) { if (xb_ld(&(bar)[XB_TMO])) break; if (_sp > XB_SPIN_CAP) { atomicAdd(&(bar)[XB_TMO], 1u); break; } } } } while (0)
struct XcdBarrier { unsigned* bar; unsigned x; volatile LAS unsigned* st; };
__device__ __forceinline__ XcdBarrier xcd_barrier_post(unsigned* bar, volatile LAS unsigned* st) {
    XcdBarrier b; b.bar = bar; b.x = xb_xcc_id(); b.st = st;
    if (threadIdx.x == 0) (void)xb_add(&bar[XB_XCNT(b.x)], 1u);
    return b;
}
__device__ __forceinline__ void xcd_barrier_complete(unsigned* bar, unsigned x, unsigned& nloc, unsigned& nx) {
    const unsigned G = gridDim.x * gridDim.y * gridDim.z;
    unsigned sum, cnt, mine, sp = 0u;
    for (;;) {
        sum = 0u; cnt = 0u; mine = 0u;
#pragma unroll
        for (unsigned j = 0; j < 16; ++j) { const unsigned c = xb_ld(&bar[XB_XCNT(j)]); sum += c; cnt += (c > 0u) ? 1u : 0u; mine = (j == x) ? c : mine; }
        if (sum == G) break;
        __builtin_amdgcn_s_sleep(1);
        if ((++sp & 255u) == 0u) { if (xb_ld(&bar[XB_TMO])) break; if (sp > XB_SPIN_CAP) { atomicAdd(&bar[XB_TMO], 1u); break; } }
    }
    nloc = mine > 0u ? mine : 1u; nx = cnt > 0u ? cnt : 1u;
}
__device__ __forceinline__ void xcd_barrier(const XcdBarrier& b) {
    asm volatile("s_waitcnt vmcnt(0)" ::: "memory");
    __syncthreads();
    if (threadIdx.x == 0) {
        unsigned* bar = b.bar;
        __builtin_amdgcn_s_waitcnt(0);
        unsigned nloc = b.st[0], nx = b.st[1];
        if (nloc == 0u) { xcd_barrier_complete(bar, b.x, nloc, nx); b.st[0] = nloc; b.st[1] = nx; }
        const unsigned old = xb_add(&bar[XB_XSUB(b.x)], 1u);
        const unsigned gen = old / nloc;
        if (old + 1u == (gen + 1u) * nloc) {
            __builtin_amdgcn_fence(__ATOMIC_RELEASE, "agent");
            asm volatile("s_waitcnt vmcnt(0)" ::: "memory");
            const unsigned og = xb_add(&bar[XB_TOP], 1u);
            const unsigned tg = og / nx;
            if (og + 1u == (tg + 1u) * nx) xb_add(&bar[XB_TOPGEN], 1u);
            else XB_SPIN(xb_ld(&bar[XB_TOPGEN]) == tg, bar);
            __builtin_amdgcn_fence(__ATOMIC_ACQUIRE, "agent");
            xb_add(&bar[XB_XGEN(b.x)], 1u);
            asm volatile("s_waitcnt vmcnt(0)" ::: "memory");
        } else {
            XB_SPIN(xb_ld(&bar[XB_XGEN(b.x)]) == gen, bar);
            __builtin_amdgcn_fence(__ATOMIC_ACQUIRE, "agent");
            asm volatile("s_waitcnt vmcnt(0)" ::: "memory");
        }
    }
    __syncthreads();
}

struct Args { const float* in[22]; float* out; unsigned char* ws; int ph_lo, ph_hi, pad0, pad1; };
struct Frame {
    LAS unsigned char* lds; volatile LAS unsigned* MISC; gu32* ctl;
    int tid, lane, wave, vcu, G;
};

typedef const __attribute__((address_space(4))) Args* kargs_t;
__device__ __forceinline__ Args fetch_args() {
    kargs_t kp = (kargs_t)__builtin_amdgcn_kernarg_segment_ptr();
    asm volatile("" : "+s"(kp));
    Args a;
#pragma unroll
    for (int i = 0; i < 22; ++i) a.in[i] = kp->in[i];
    a.out = kp->out; a.ws = kp->ws; a.ph_lo = kp->ph_lo; a.ph_hi = kp->ph_hi; a.pad0 = kp->pad0; a.pad1 = kp->pad1;
    return a;
}
__device__ __forceinline__ void refresh_frame(Frame& F) { int t = threadIdx.x; asm volatile("" : "+v"(t)); F.tid = t; F.lane = t & 63; F.wave = __builtin_amdgcn_readfirstlane(t >> 6); }

template <int CTRL> __device__ __forceinline__ float dppf(float v) { return __builtin_bit_cast(float, __builtin_amdgcn_update_dpp(0, __builtin_bit_cast(int, v), CTRL, 0xF, 0xF, true)); }
template <int CTRL> __device__ __forceinline__ int dppi(int v) { return __builtin_amdgcn_update_dpp(0, v, CTRL, 0xF, 0xF, true); }
__device__ __forceinline__ float rlf(float v, int l) { return __builtin_bit_cast(float, __builtin_amdgcn_readlane(__builtin_bit_cast(int, v), l)); }
__device__ __forceinline__ float wsum_dpp(float v) {
    v += dppf<0xB1>(v); v += dppf<0x4E>(v); v += dppf<0x141>(v); v += dppf<0x140>(v);
    return (rlf(v, 0) + rlf(v, 16)) + (rlf(v, 32) + rlf(v, 48));
}
__device__ __forceinline__ float wmax_dpp(float v) {
    v = fmaxf(v, dppf<0xB1>(v)); v = fmaxf(v, dppf<0x4E>(v)); v = fmaxf(v, dppf<0x141>(v)); v = fmaxf(v, dppf<0x140>(v));
    return fmaxf(fmaxf(rlf(v, 0), rlf(v, 16)), fmaxf(rlf(v, 32), rlf(v, 48)));
}
__device__ __forceinline__ int wmin_dpp(int v) {
    v = min(v, dppi<0xB1>(v)); v = min(v, dppi<0x4E>(v)); v = min(v, dppi<0x141>(v)); v = min(v, dppi<0x140>(v));
    return min(min(__builtin_amdgcn_readlane(v, 0), __builtin_amdgcn_readlane(v, 16)), min(__builtin_amdgcn_readlane(v, 32), __builtin_amdgcn_readlane(v, 48)));
}

__device__ __forceinline__ void p0_transpose_item(const float* W, int K, int N, bf16_t* WT, long row_off, LAS float* scr, int item, int lane) {
    const int nblk = N / 32, kb = item / nblk, nb = item % nblk, k0 = 64 * kb, n0 = 32 * nb;
#pragma unroll 8
    for (int i = 0; i < 32; ++i) { const int kk = 2 * i + (lane >> 5); scr[kk * 33 + (lane & 31)] = W[(size_t)(k0 + kk) * N + n0 + (lane & 31)]; }
    LDS_WAIT(); asm volatile("" ::: "memory");
    const int c = lane & 7;
#pragma unroll
    for (int j = 0; j < 4; ++j) { const int n = (lane >> 3) + 8 * j; const LAS float* s = scr + (8 * c) * 33 + n;
        v4u o; o.x = pk2(s[0 * 33], s[1 * 33]); o.y = pk2(s[2 * 33], s[3 * 33]); o.z = pk2(s[4 * 33], s[5 * 33]); o.w = pk2(s[6 * 33], s[7 * 33]);
        *(GAS v4u*)(WT + (size_t)(row_off + n0 + n) * K + k0 + 8 * c) = o; }
    LDS_WAIT(); asm volatile("" ::: "memory");
}
__device__ __forceinline__ void p0_transpose_item8(const float* W, int K, int N, unsigned char* WT, long row_off, LAS float* scr, int item, int lane) {
    const int nblk = N / 32, kb = item / nblk, nb = item % nblk, k0 = 64 * kb, n0 = 32 * nb;
#pragma unroll 8
    for (int i = 0; i < 32; ++i) { const int kk = 2 * i + (lane >> 5); scr[kk * 33 + (lane & 31)] = W[(size_t)(k0 + kk) * N + n0 + (lane & 31)]; }
    LDS_WAIT(); asm volatile("" ::: "memory");
    const int c = lane & 3; constexpr float SC = (float)(1 << pg8::WSHIFT);
#pragma unroll
    for (int j = 0; j < 2; ++j) { const int n = (lane >> 2) + 16 * j; const LAS float* s = scr + (16 * c) * 33 + n;
        v4u o; o.x = pg8::pk4_fp8(s[0 * 33] * SC, s[1 * 33] * SC, s[2 * 33] * SC, s[3 * 33] * SC); o.y = pg8::pk4_fp8(s[4 * 33] * SC, s[5 * 33] * SC, s[6 * 33] * SC, s[7 * 33] * SC);
        o.z = pg8::pk4_fp8(s[8 * 33] * SC, s[9 * 33] * SC, s[10 * 33] * SC, s[11 * 33] * SC); o.w = pg8::pk4_fp8(s[12 * 33] * SC, s[13 * 33] * SC, s[14 * 33] * SC, s[15 * 33] * SC);
        *(GAS v4u*)(WT + (size_t)(row_off + n0 + n) * K + k0 + 16 * c) = o; }
    LDS_WAIT(); asm volatile("" ::: "memory");
}
__device__ __forceinline__ void p0_prologue(Frame& F, const Args& a) {
    LAS float* scr = (LAS float*)(F.lds + RING_OFF + F.wave * 16384);
    const int gw = F.vcu * NWAVES + F.wave, NGW = F.G * NWAVES;
    unsigned char* ws = a.ws;
    constexpr int I_IN = (DM / 64) * (INW / 32), I_O = (DM / 64) * (DM / 32), I_UP1 = (DM / 64) * (2 * DFF / 32), I_DN1 = (DFF / 64) * (DM / 32);
    constexpr int NITEMS = I_IN + I_O + NE * I_UP1 + NE * I_DN1;
    for (int it = gw; it < NITEMS; it += NGW) {
        int r = it;
        if (r < I_IN) { p0_transpose_item(a.in[1], DM, INW, (bf16_t*)(ws + WS_WIN), 0, scr, r, F.lane); continue; } r -= I_IN;
        if (r < I_O) { p0_transpose_item(a.in[11], DM, DM, (bf16_t*)(ws + WS_WO), 0, scr, r, F.lane); continue; } r -= I_O;
        if (r < NE * I_UP1) { const int e = r / I_UP1, ii = r % I_UP1; const int n0 = 32 * (ii % (2 * DFF / 32));
            const int bj = n0 / DFF, f = n0 % DFF, rho0 = 256 * (f / 128) + 128 * bj + (f % 128);
#if MOE_FP8
            p0_transpose_item8(a.in[16] + (size_t)e * DM * 2 * DFF, DM, 2 * DFF, (unsigned char*)(ws + WS_WUP) + (size_t)e * 2 * DFF * DM, (long)rho0 - n0, scr, ii, F.lane); continue; }
#else
            p0_transpose_item(a.in[16] + (size_t)e * DM * 2 * DFF, DM, 2 * DFF, (bf16_t*)(ws + WS_WUP) + (size_t)e * 2 * DFF * DM, (long)rho0 - n0, scr, ii, F.lane); continue; }
#endif
        r -= NE * I_UP1;
        { const int e = r / I_DN1, ii = r % I_DN1;
#if MOE_FP8
            p0_transpose_item8(a.in[18] + (size_t)e * DFF * DM, DFF, DM, (unsigned char*)(ws + WS_WDN) + (size_t)e * DM * DFF, 0, scr, ii, F.lane); }
#else
            p0_transpose_item(a.in[18] + (size_t)e * DFF * DM, DFF, DM, (bf16_t*)(ws + WS_WDN) + (size_t)e * DM * DFF, 0, scr, ii, F.lane); }
#endif
    }
    const float* x = a.in[0]; bf16_t* xb = (bf16_t*)(ws + WS_XB);
    for (int m = gw; m < NTOK; m += NGW) {
        const GAS f32x4* xr = (const GAS f32x4*)(x + (size_t)m * DM) + F.lane; GAS v2u* o8 = (GAS v2u*)(xb + (size_t)m * DM) + F.lane;
        f32x4 v[4];
#pragma unroll
        for (int j = 0; j < 4; ++j) v[j] = xr[64 * j];
#pragma unroll
        for (int j = 0; j < 4; ++j) { v2u o; o.x = pk2(v[j].x, v[j].y); o.y = pk2(v[j].z, v[j].w); o8[64 * j] = o; }
    }
}

__device__ __forceinline__ void gmlp_phase(Frame& F, const Args& a) {
    const bf16_t* proj = (const bf16_t*)(a.ws + WS_PROJ); bf16_t* mix = (bf16_t*)(a.ws + WS_MIX);
    const float *lng = a.in[7], *lnb = a.in[8], *wsp = a.in[9], *bsp = a.in[10];
    LAS f32x2* st = (LAS f32x2*)(F.lds + RING_OFF);
    LAS bf16_t* Vg = (LAS bf16_t*)(F.lds + RING_OFF + 1024);
    LAS bf16_t* Wg = (LAS bf16_t*)(F.lds + RING_OFF + 19456);
    LAS float* Zg = (LAS float*)(F.lds + RING_OFF + 54272);
    const int tid = F.tid, lane = F.lane, w = F.wave;
    const int row = tid >> 2, cq = (tid & 3) * 16;
    for (int c = blockIdx.x; c < NTOK / CHUNK; c += F.G) {
        const size_t row0 = (size_t)c * CHUNK;
        v4u pgv[2], pgu[2]; f32x4 pwv[8], plg[4], plb[4]; float pbb;
#define GMLP_LOAD(g_) do { const int col_ = (g_) * GD + cq; \
            pgv[0] = *(const GAS v4u*)(proj + (row0 + row) * INW + C_GV + col_); pgv[1] = *(const GAS v4u*)(proj + (row0 + row) * INW + C_GV + col_ + 8); \
            pgu[0] = *(const GAS v4u*)(proj + (row0 + row) * INW + C_GU + col_); pgu[1] = *(const GAS v4u*)(proj + (row0 + row) * INW + C_GU + col_ + 8); \
            _Pragma("unroll") for (int k = 0; k < 8; ++k) { const int i_ = tid + 512 * k; pwv[k] = *(const GAS f32x4*)(wsp + ((size_t)(g_) * CHUNK + (i_ >> 5)) * CHUNK + (i_ & 31) * 4); } \
            _Pragma("unroll") for (int k = 0; k < 4; ++k) { plg[k] = *(const GAS f32x4*)(lng + col_ + 4 * k); plb[k] = *(const GAS f32x4*)(lnb + col_ + 4 * k); } \
            pbb = bsp[(g_) * CHUNK + row]; } while (0)
        GMLP_LOAD(0);
        {
            v4u raw[16];
#pragma unroll
            for (int i = 0; i < 16; ++i) raw[i] = *(const GAS v4u*)(proj + (row0 + 16 * w + i) * INW + C_GV + lane * 8);
#pragma unroll
            for (int i = 0; i < 16; ++i) {
                const unsigned rw[4] = {raw[i].x, raw[i].y, raw[i].z, raw[i].w}; float v[8]; float sum = 0.f;
#pragma unroll
                for (int k = 0; k < 4; ++k) { const f32x2 gg = pg8::gelu_pk((f32x2){bf2f((bf16_t)(rw[k] & 0xffff)), bf2f((bf16_t)(rw[k] >> 16))}); v[2 * k] = gg.x; v[2 * k + 1] = gg.y; sum += gg.x + gg.y; }
                const float mean = wsum_dpp(sum) * (1.0f / GW); float q = 0.f;
#pragma unroll
                for (int k = 0; k < 8; ++k) { const float d = v[k] - mean; q += d * d; }
                const float var = wsum_dpp(q) * (1.0f / GW);
                if (lane == 0) st[16 * w + i] = (f32x2){mean, rsqrtf(var + LN_EPS)};
            }
        }
        __syncthreads();
        for (int g = 0; g < NG; ++g) {
            const int col = g * GD + cq;
            const v4u cgu0 = pgu[0], cgu1 = pgu[1]; const float bb = pbb;
            {
                const f32x2 ms = st[row]; unsigned ow[8];
#pragma unroll
                for (int hh = 0; hh < 2; ++hh) { const unsigned rw[4] = {pgv[hh].x, pgv[hh].y, pgv[hh].z, pgv[hh].w};
#pragma unroll
                    for (int i = 0; i < 4; ++i) { const f32x2 gg = pg8::gelu_pk((f32x2){bf2f((bf16_t)(rw[i] & 0xffff)), bf2f((bf16_t)(rw[i] >> 16))});
                        const int e = hh * 8 + 2 * i; const f32x4 lg = plg[e >> 2], lb = plb[e >> 2];
                        const float g0 = (e & 2) ? lg.z : lg.x, g1 = (e & 2) ? lg.w : lg.y, b0 = (e & 2) ? lb.z : lb.x, b1 = (e & 2) ? lb.w : lb.y;
                        ow[hh * 4 + i] = pk2((gg.x - ms.x) * ms.y * g0 + b0, (gg.y - ms.x) * ms.y * g1 + b1); } }
                { const int sx = row ^ ((cq >> 4) << 4);
#pragma unroll
                  for (int e = 0; e < 8; ++e) { Vg[(cq + 2 * e) * 136 + sx] = (bf16_t)(ow[e] & 0xffffu); Vg[(cq + 2 * e + 1) * 136 + sx] = (bf16_t)(ow[e] >> 16); } }
#pragma unroll
                for (int k = 0; k < 8; ++k) { const int i = tid + 512 * k, t = i >> 5, s4 = (i & 31) * 4; const f32x4 wv = pwv[k];
                    v2u o; o.x = pk2(s4 <= t ? wv.x : 0.f, s4 + 1 <= t ? wv.y : 0.f); o.y = pk2(s4 + 2 <= t ? wv.z : 0.f, s4 + 3 <= t ? wv.w : 0.f);
                    *(LAS v2u*)(Wg + t * 136 + s4) = o; }
            }
            if (g + 1 < NG) GMLP_LOAD(g + 1);
            __syncthreads();
            {
                f32x4 acc[4];
#pragma unroll
                for (int n = 0; n < 4; ++n) acc[n] = (f32x4){0.f, 0.f, 0.f, 0.f};
                const int t0 = 16 * w, fr = lane & 15, fq = lane >> 4;
                for (int ks = 0; ks * 32 <= t0 + 15; ++ks) {
                    const bf16x8 af = *(const LAS bf16x8*)(Wg + (t0 + fr) * 136 + ks * 32 + fq * 8);
#pragma unroll
                    for (int n = 0; n < 4; ++n) { const bf16x8 bfv = *(const LAS bf16x8*)(Vg + (n * 16 + fr) * 136 + ((ks * 32 + fq * 8) ^ (n << 4)));
                        acc[n] = __builtin_amdgcn_mfma_f32_16x16x32_bf16(af, bfv, acc[n], 0, 0, 0); }
                }
#pragma unroll
                for (int n = 0; n < 4; ++n)
#pragma unroll
                    for (int r = 0; r < 4; ++r) Zg[(t0 + fq * 4 + r) * 68 + n * 16 + fr] = acc[n][r];
            }
            __syncthreads();
            {
                unsigned ow[8];
#pragma unroll
                for (int hh = 0; hh < 2; ++hh) { const v4u rawu = hh ? cgu1 : cgu0; const unsigned rw[4] = {rawu.x, rawu.y, rawu.z, rawu.w};
#pragma unroll
                    for (int i = 0; i < 4; ++i) { const f32x2 uu = pg8::gelu_pk((f32x2){bf2f((bf16_t)(rw[i] & 0xffff)), bf2f((bf16_t)(rw[i] >> 16))});
                        const f32x2 zz = *(const LAS f32x2*)(Zg + row * 68 + cq + hh * 8 + 2 * i);
                        ow[hh * 4 + i] = pk2(uu.x * (zz.x + bb), uu.y * (zz.y + bb)); } }
                GAS v4u* dst = (GAS v4u*)(mix + (row0 + row) * DM + GW + col);
                dst[0] = (v4u){ow[0], ow[1], ow[2], ow[3]}; dst[1] = (v4u){ow[4], ow[5], ow[6], ow[7]};
            }
        }
        __syncthreads();
#undef GMLP_LOAD
    }
}

__device__ __forceinline__ void attn_combine_phase(Frame& F, const Args& a) {
    const bf16_t* atto = (const bf16_t*)(a.ws + WS_ATTO); bf16_t* mix = (bf16_t*)(a.ws + WS_MIX);
    const int lane = F.lane, gw = F.vcu * NWAVES + F.wave, NGW = F.G * NWAVES;
    const float lam = expf(wave_sum(a.in[2][lane] * a.in[3][lane])) - expf(wave_sum(a.in[4][lane] * a.in[5][lane])) + LAMBDA_INIT;
    const int h = lane >> 4, e0 = (lane & 15) * 8;
    float sg[8];
#pragma unroll
    for (int i = 0; i < 8; ++i) sg[i] = a.in[6][e0 + i] * (1.0f - LAMBDA_INIT);
    for (int t = gw; t < NTOK; t += NGW) {
        const v4u r1 = *(const GAS v4u*)(atto + (size_t)t * DM + h * 256 + e0), r2 = *(const GAS v4u*)(atto + (size_t)t * DM + h * 256 + 128 + e0);
        const unsigned w1[4] = {r1.x, r1.y, r1.z, r1.w}, w2[4] = {r2.x, r2.y, r2.z, r2.w};
        float d[8]; float ss = 0.f;
#pragma unroll
        for (int i = 0; i < 4; ++i) { d[2 * i] = bf2f((bf16_t)(w1[i] & 0xffff)) - lam * bf2f((bf16_t)(w2[i] & 0xffff)); d[2 * i + 1] = bf2f((bf16_t)(w1[i] >> 16)) - lam * bf2f((bf16_t)(w2[i] >> 16)); ss += d[2 * i] * d[2 * i] + d[2 * i + 1] * d[2 * i + 1]; }
        ss += __shfl_xor(ss, 1); ss += __shfl_xor(ss, 2); ss += __shfl_xor(ss, 4); ss += __shfl_xor(ss, 8);
        const float r = rsqrtf(ss * (1.0f / DV) + LN_EPS);
        v4u o; o.x = pk2(d[0] * r * sg[0], d[1] * r * sg[1]); o.y = pk2(d[2] * r * sg[2], d[3] * r * sg[3]); o.z = pk2(d[4] * r * sg[4], d[5] * r * sg[5]); o.w = pk2(d[6] * r * sg[6], d[7] * r * sg[7]);
        *(GAS v4u*)(mix + (size_t)t * DM + h * DV + e0) = o;
    }
}

__device__ __forceinline__ void route_phase(Frame& F, const Args& a) {
    const float* h1 = (const float*)(a.ws + WS_H1); bf16_t* xb = (bf16_t*)(a.ws + WS_XB); bf16_t* x1b = (bf16_t*)(a.ws + WS_X1B);
    int* list = (int*)(a.ws + WS_LIST); int* re = (int*)(a.ws + WS_RE); int* rr = (int*)(a.ws + WS_RR); float* rg = (float*)(a.ws + WS_RG);
    const float *g1 = a.in[12], *b1 = a.in[13], *wr = a.in[14], *br = a.in[15];
    constexpr int XS = 1028;
    LAS float* XT = (LAS float*)(F.lds + RING_OFF);
    LAS float* PT = (LAS float*)(F.lds + RING_OFF + 16 * XS * 4);
    LAS int* lcnt = (LAS int*)(F.lds + REC_OFF); LAS int* lbase = lcnt + 32; LAS int* rec = lcnt + 64;
    const int tid = F.tid, lane = F.lane, w = F.wave, fr = lane & 15, fq = lane >> 4;
    if (tid < 32) lcnt[tid] = 0;
    constexpr int RPB = NTOK / 256;
    const int tblk = blockIdx.x * RPB;
    f32x4 pv[2][4];
#define ROUTE_LOAD(ch_) do { _Pragma("unroll") for (int q = 0; q < 2; ++q) _Pragma("unroll") for (int j = 0; j < 4; ++j) \
        pv[q][j] = *(const GAS f32x4*)(h1 + (size_t)(tblk + (ch_) * 16 + 2 * w + q) * DM + j * 256 + lane * 4); } while (0)
    ROUTE_LOAD(0);
    float bw[32][2];
#pragma unroll
    for (int s = 0; s < 32; ++s)
#pragma unroll
        for (int n = 0; n < 2; ++n) bw[s][n] = wr[(size_t)(128 * w + 4 * s + fq) * NE + 16 * n + fr];
    const int myexp = lane & 31; const float mybr = br[myexp];
    for (int ch = 0; ch < 8; ++ch) {
        const int t0 = tblk + ch * 16;
        {
            float mean[2], rstd[2];
#pragma unroll
            for (int q = 0; q < 2; ++q) { float s = 0.f;
#pragma unroll
                for (int j = 0; j < 4; ++j) s += (pv[q][j].x + pv[q][j].y) + (pv[q][j].z + pv[q][j].w);
                mean[q] = wsum_dpp(s) * (1.0f / DM); }
#pragma unroll
            for (int q = 0; q < 2; ++q) { float q2 = 0.f;
#pragma unroll
                for (int j = 0; j < 4; ++j) { pv[q][j] = pv[q][j] - mean[q]; q2 += (pv[q][j].x * pv[q][j].x + pv[q][j].y * pv[q][j].y) + (pv[q][j].z * pv[q][j].z + pv[q][j].w * pv[q][j].w); }
                rstd[q] = rsqrtf(wsum_dpp(q2) * (1.0f / DM) + LN_EPS); }
#pragma unroll
            for (int j = 0; j < 4; ++j) {
                const int col = j * 256 + lane * 4;
                const f32x4 gq = *(const GAS f32x4*)(g1 + col), bq = *(const GAS f32x4*)(b1 + col);
#pragma unroll
                for (int q = 0; q < 2; ++q) {
                    const int rl = 2 * w + q, t = t0 + rl;
                    const f32x4 o = pv[q][j] * rstd[q] * gq + bq;
                    { v2u pk1; pk1.x = pk2(o.x, o.y); pk1.y = pk2(o.z, o.w); *(GAS v2u*)(x1b + (size_t)t * DM + col) = pk1; }
                    *(LAS f32x4*)(XT + rl * XS + col) = o;
#if MOE_FP8
                    *(GAS unsigned*)((unsigned char*)xb + (size_t)t * DM + col) = pg8::pk4_fp8(o.x, o.y, o.z, o.w);
#else
                    v2u pk; pk.x = pk2(o.x, o.y); pk.y = pk2(o.z, o.w);
                    *(GAS v2u*)(xb + (size_t)t * DM + col) = pk;
#endif
                }
            }
        }
        if (ch < 7) ROUTE_LOAD(ch + 1);
        __syncthreads();
        {
            f32x4 acc0 = (f32x4){0.f, 0.f, 0.f, 0.f}, acc1 = (f32x4){0.f, 0.f, 0.f, 0.f};
            const LAS float* xp = XT + fr * XS + 128 * w + fq;
#pragma unroll
            for (int s = 0; s < 32; ++s) { const float av = xp[4 * s];
                acc0 = __builtin_amdgcn_mfma_f32_16x16x4f32(av, bw[s][0], acc0, 0, 0, 0);
                acc1 = __builtin_amdgcn_mfma_f32_16x16x4f32(av, bw[s][1], acc1, 0, 0, 0); }
#pragma unroll
            for (int r = 0; r < 4; ++r) { PT[(w * 16 + fq * 4 + r) * 32 + fr] = acc0[r]; PT[(w * 16 + fq * 4 + r) * 32 + 16 + fr] = acc1[r]; }
        }
        __syncthreads();
        {
            float cur[2];
#pragma unroll
            for (int q = 0; q < 2; ++q) { cur[q] = mybr;
#pragma unroll
                for (int ww = 0; ww < 8; ++ww) cur[q] += PT[(ww * 16 + 2 * w + q) * 32 + myexp]; }
            int idx[2][4]; float val[2][4];
#pragma unroll
            for (int k = 0; k < 4; ++k)
#pragma unroll
                for (int q = 0; q < 2; ++q) {
                    const float m = wmax_dpp(cur[q]);
                    const int cand = wmin_dpp((cur[q] == m) ? myexp : 99);
                    idx[q][k] = cand; val[q][k] = m; if (myexp == cand) cur[q] = -INFINITY;
                }
#pragma unroll
            for (int q = 0; q < 2; ++q) {
                const int rl = 2 * w + q, t = t0 + rl;
                float ex[4], se = 0.f;
#pragma unroll
                for (int k = 0; k < 4; ++k) { ex[k] = expf(val[q][k] - val[q][0]); se += ex[k]; }
                if (lane < 4) {
                    int e_ = idx[q][0]; float g_ = ex[0];
                    if (lane == 1) { e_ = idx[q][1]; g_ = ex[1]; } else if (lane == 2) { e_ = idx[q][2]; g_ = ex[2]; } else if (lane == 3) { e_ = idx[q][3]; g_ = ex[3]; }
                    const int lr = __hip_atomic_fetch_add(lcnt + e_, 1, __ATOMIC_RELAXED, __HIP_MEMORY_SCOPE_WORKGROUP);
                    rec[(ch * 16 + rl) * 4 + lane] = e_ | (lr << 8);
                    re[t * 4 + lane] = e_; rg[t * 4 + lane] = g_ / se;
                }
            }
        }
    }
#undef ROUTE_LOAD
    __syncthreads();
    if (tid < 32) lbase[tid] = (int)__hip_atomic_fetch_add((unsigned*)(F.ctl + CW_CNT + tid), (unsigned)lcnt[tid], RLX_AGENT);
    __syncthreads();
    { const int rw = tid >> 2, k = tid & 3; const int t = tblk + rw; const int rc = rec[tid]; const int e_ = rc & 255, r_ = lbase[e_] + (rc >> 8);
      rr[t * 4 + k] = r_; list[e_ * NTOK + r_] = t; }
}
__device__ __forceinline__ void build_tab(Frame& F) {
    LAS int* tab = (LAS int*)(F.lds + TAB_OFF);
    if (F.tid < 32) tab[40 + F.tid] = (int)__hip_atomic_load(F.ctl + CW_CNT + F.tid, RLX_AGENT);
    __syncthreads();
    if (F.tid == 0) { int p = 0; for (int e = 0; e < NE; ++e) { tab[e] = p; p += (tab[40 + e] + 255) >> 8; } tab[NE] = p; }
    __syncthreads();
}
__device__ __forceinline__ void combine_phase(Frame& F, const Args& a) {
    const bf16_t* x1 = (const bf16_t*)(a.ws + WS_X1B); const unsigned char* y = (const unsigned char*)(a.ws + WS_Y);
    const int* re = (const int*)(a.ws + WS_RE); const int* rr = (const int*)(a.ws + WS_RR); const float* rg = (const float*)(a.ws + WS_RG);
    float* out = a.out;
    const LAS int* tab = (const LAS int*)(F.lds + TAB_OFF);
    const int lane = F.lane, gw = F.vcu * NWAVES + F.wave, NGW = F.G * NWAVES, c0 = lane * 16;
    f32x4 g2v[4], b2v[4];
#pragma unroll
    for (int j = 0; j < 4; ++j) { g2v[j] = *(const GAS f32x4*)(a.in[20] + c0 + 4 * j); b2v[j] = *(const GAS f32x4*)(a.in[21] + c0 + 4 * j); }
    for (int tt = gw; tt < NTOK; tt += 2 * NGW) {
        float v[2][16];
#pragma unroll
        for (int q = 0; q < 2; ++q) {
            const int t = tt + q * NGW;
            const v4u xa = *(const GAS v4u*)(x1 + (size_t)t * DM + c0), xb_ = *(const GAS v4u*)(x1 + (size_t)t * DM + c0 + 8);
            const unsigned xw[8] = {xa.x, xa.y, xa.z, xa.w, xb_.x, xb_.y, xb_.z, xb_.w};
#pragma unroll
            for (int i = 0; i < 8; ++i) { v[q][2 * i] = ALPHA * bf2f((bf16_t)(xw[i] & 0xffff)); v[q][2 * i + 1] = ALPHA * bf2f((bf16_t)(xw[i] >> 16)); }
#pragma unroll
            for (int k = 0; k < 4; ++k) {
                const int e = re[t * 4 + k], slot = tab[e] * 256 + rr[t * 4 + k]; const float g = rg[t * 4 + k];
#if MOE_FP8
                const v4u yw = *(const GAS v4u*)(y + (size_t)slot * DM + c0); const unsigned yy[4] = {yw.x, yw.y, yw.z, yw.w};
#pragma unroll
                for (int i = 0; i < 4; ++i) { const f32x2 lo = __builtin_amdgcn_cvt_pk_f32_fp8((int)yy[i], false), hi = __builtin_amdgcn_cvt_pk_f32_fp8((int)yy[i], true);
                    v[q][4 * i] = fmaf(g, lo.x, v[q][4 * i]); v[q][4 * i + 1] = fmaf(g, lo.y, v[q][4 * i + 1]); v[q][4 * i + 2] = fmaf(g, hi.x, v[q][4 * i + 2]); v[q][4 * i + 3] = fmaf(g, hi.y, v[q][4 * i + 3]); }
#else
                const v4u ya = *(const GAS v4u*)((const bf16_t*)y + (size_t)slot * DM + c0), yb = *(const GAS v4u*)((const bf16_t*)y + (size_t)slot * DM + c0 + 8);
                const unsigned yy[8] = {ya.x, ya.y, ya.z, ya.w, yb.x, yb.y, yb.z, yb.w};
#pragma unroll
                for (int i = 0; i < 8; ++i) { v[q][2 * i] = fmaf(g, bf2f((bf16_t)(yy[i] & 0xffff)), v[q][2 * i]); v[q][2 * i + 1] = fmaf(g, bf2f((bf16_t)(yy[i] >> 16)), v[q][2 * i + 1]); }
#endif
            }
        }
#pragma unroll
        for (int q = 0; q < 2; ++q) {
            const int t = tt + q * NGW;
            float s = 0.f;
#pragma unroll
            for (int i = 0; i < 16; ++i) s += v[q][i];
            const float mean = wsum_dpp(s) * (1.0f / DM); float q2 = 0.f;
#pragma unroll
            for (int i = 0; i < 16; ++i) { v[q][i] -= mean; q2 += v[q][i] * v[q][i]; }
            const float rstd = rsqrtf(wsum_dpp(q2) * (1.0f / DM) + LN_EPS);
#pragma unroll
            for (int j = 0; j < 4; ++j)
                *(GAS f32x4*)(out + (size_t)t * DM + c0 + 4 * j) = (f32x4){v[q][4 * j] * rstd * g2v[j].x + b2v[j].x, v[q][4 * j + 1] * rstd * g2v[j].y + b2v[j].y, v[q][4 * j + 2] * rstd * g2v[j].z + b2v[j].z, v[q][4 * j + 3] * rstd * g2v[j].w + b2v[j].w};
        }
    }
}

constexpr int N_PHASES = 9;
__global__ void __launch_bounds__(NWAVES * 64, 2) mega_fwd(Args args) {
    extern __shared__ __attribute__((aligned(16))) unsigned char lds[];
    Frame F;
    F.lds = (LAS unsigned char*)lds;
    F.MISC = (volatile LAS unsigned*)(F.lds + MISC_OFF);
    F.tid = threadIdx.x; F.lane = F.tid & 63; F.wave = __builtin_amdgcn_readfirstlane(F.tid >> 6);
    F.G = gridDim.x; { const int bx = blockIdx.x; F.vcu = (F.G % 8 == 0) ? (bx % 8) * (F.G / 8) + bx / 8 : bx; }
    F.ctl = (gu32*)(args.ws + WS_CTL);
    for (int u = F.tid; u < (LDS_BYTES - LDSCTL_OFF) / 4; u += NWAVES * 64) ((LAS unsigned*)(F.lds + LDSCTL_OFF))[u] = 0u;
    __syncthreads();
    const int lo = args.ph_lo, hi = args.ph_hi;
    const bool multi = (hi - lo) > 1;
    XcdBarrier bar; bar.bar = (unsigned*)(F.ctl + CW_BAR); bar.x = 0; bar.st = nullptr;
    if (multi) bar = xcd_barrier_post((unsigned*)(F.ctl + CW_BAR), F.MISC + 8);
#ifndef PH_MASK
#define PH_MASK 0x1FF
#endif
#define IN(k) ((((PH_MASK) >> (k)) & 1) && lo <= (k) && (k) < hi)
#define SEAM(k) do { if (IN(k) && IN((k) + 1)) xcd_barrier(bar); } while (0)
#ifndef DOUBLE_MASK
#define DOUBLE_MASK 0
#endif
#define REP(k) for (int rep_ = 0; rep_ < ((((DOUBLE_MASK) >> (k)) & 1) + 1); ++rep_)
    if (IN(0)) { REP(0) { refresh_frame(F); const Args A = fetch_args(); p0_prologue(F, A); } SEAM(0); }
    if (IN(1)) { REP(1) {
        refresh_frame(F); const Args A = fetch_args(); unsigned char* ws = A.ws;
        pg8::Gemm g{(const bf16_t*)(ws + WS_XB), (const bf16_t*)(ws + WS_WIN), NTOK, INW, DM, 0}; pg8::StaticOrder S; S.init(NTOK, INW, F.G, (int)blockIdx.x);
        pg8::EpiProj E{(bf16_t*)(ws + WS_PROJ)};
        pg8::gemm_phase<pg8::EpiProj, pg8::StaticOrder, false>(F.lds + RING_OFF, g, S, E);
        } SEAM(1);
    }
    if (IN(2)) { REP(2) {
        refresh_frame(F); const Args A = fetch_args(); unsigned char* ws = A.ws;
#ifndef P2_REP_SUB
#define P2_REP_SUB 3
#endif
        const int sub_ = (rep_ == 0) ? A.pad0 : (A.pad0 & P2_REP_SUB);
        if (sub_ & 1) { const float lam = expf(wave_sum(A.in[2][F.lane] * A.in[3][F.lane])) - expf(wave_sum(A.in[4][F.lane] * A.in[5][F.lane])) + LAMBDA_INIT;
            attn_body::attn_phase<8>((char*)lds + RING_OFF, (const bf16_t*)(ws + WS_PROJ), (bf16_t*)(ws + WS_MIX), F.vcu, lam, A.in[6]); }
        if (sub_ & 2) gmlp_phase(F, A);
        }
    }
    if (IN(3)) { SEAM(3); }
    if (IN(4)) { REP(4) {
        refresh_frame(F); const Args A = fetch_args(); unsigned char* ws = A.ws;
        pg8::Gemm g{(const bf16_t*)(ws + WS_MIX), (const bf16_t*)(ws + WS_WO), NTOK, DM, DM, 0}; pg8::StaticOrder S; S.init(NTOK, DM, F.G, (int)blockIdx.x);
        pg8::EpiH1 E{A.in[0], (float*)(ws + WS_H1)};
        pg8::gemm_phase<pg8::EpiH1, pg8::StaticOrder, false>(F.lds + RING_OFF, g, S, E);
        } SEAM(4);
    }
    if (IN(5)) { REP(5) { refresh_frame(F); const Args A = fetch_args(); route_phase(F, A); } SEAM(5); }
    if (IN(6)) { REP(6) {
        refresh_frame(F); const Args A = fetch_args(); unsigned char* ws = A.ws;
        build_tab(F);
        pg8::MoeOrder S; S.init((const LAS int*)(F.lds + TAB_OFF), (const int*)(ws + WS_LIST), 8, (int)blockIdx.x);
#if MOE_FP8
        pg8::Gemm g{(const bf16_t*)(ws + WS_XB), (const bf16_t*)(ws + WS_WUP), PADROWS, 2 * DFF, DM, (size_t)2 * DFF * DM / 2};
        pg8::EpiSwiglu8 E{(unsigned char*)(ws + WS_ACT), A.in[17]};
        pg8::gemm_phase<pg8::EpiSwiglu8, pg8::MoeOrder, true, true>(F.lds + RING_OFF, g, S, E);
#else
        pg8::Gemm g{(const bf16_t*)(ws + WS_XB), (const bf16_t*)(ws + WS_WUP), PADROWS, 2 * DFF, DM, (size_t)2 * DFF * DM};
        pg8::EpiSwiglu E{(bf16_t*)(ws + WS_ACT), A.in[17]};
        pg8::gemm_phase<pg8::EpiSwiglu, pg8::MoeOrder, true>(F.lds + RING_OFF, g, S, E);
#endif
        } SEAM(6);
    }
    if (IN(7)) { REP(7) {
        refresh_frame(F); const Args A = fetch_args(); unsigned char* ws = A.ws;
        build_tab(F);
        pg8::MoeOrder S; S.init((const LAS int*)(F.lds + TAB_OFF), (const int*)(ws + WS_LIST), 4, (int)blockIdx.x);
#if MOE_FP8
        pg8::EpiDown8 E{(unsigned char*)(ws + WS_Y), A.in[19]};
        pg8::Gemm g{(const bf16_t*)(ws + WS_ACT), (const bf16_t*)(ws + WS_WDN), PADROWS, DM, DFF, (size_t)DM * DFF / 2};
        pg8::gemm_phase<pg8::EpiDown8, pg8::MoeOrder, false, true>(F.lds + RING_OFF, g, S, E);
#else
        pg8::EpiDown E{(bf16_t*)(ws + WS_Y), A.in[19]};
        pg8::Gemm g{(const bf16_t*)(ws + WS_ACT), (const bf16_t*)(ws + WS_WDN), PADROWS, DM, DFF, (size_t)DM * DFF};
        pg8::gemm_phase<pg8::EpiDown, pg8::MoeOrder, false>(F.lds + RING_OFF, g, S, E);
#endif
        } SEAM(7);
    }
    if (IN(8)) { REP(8) { refresh_frame(F); const Args A = fetch_args(); build_tab(F); combine_phase(F, A); } }
#undef IN
#undef SEAM
}

struct NArgs {
    const float* x; const float* B; const float* bias; const float* bias2;
    const bf16_t* Ab; bf16_t* Ob; float* Of; const int* ctl; const int* list;
};
template <int MODE> __global__ void __launch_bounds__(256) ngemm(NArgs a) {
    constexpr int K = 1024;
    constexpr int LDB = (MODE == 0) ? INW : (MODE == 2 ? 2048 : 1024);
    constexpr bool DUAL = (MODE == 2);
    __shared__ float As[16][68];
    __shared__ float Bs[16][64];
    __shared__ float Bs2[DUAL ? 16 : 1][64];
    const int tid = threadIdx.x, ty = tid >> 4, tx = tid & 15;
    const int row0 = blockIdx.y * 64, col0 = blockIdx.x * 64;
    const float* B = a.B; int e = 0, pst = 0, cnt = 0;
    if (MODE >= 2) {
        const int* ps = a.ctl + CW_PSTART;
        while (e < NE && row0 >= ps[e + 1]) ++e;
        if (e >= NE) return;
        pst = ps[e]; cnt = a.ctl[CW_CNT + e];
        B += (size_t)e * K * LDB;
    }
    const int ar = tid >> 2, ak = (tid & 3) * 4;
    const float* arow_f = nullptr; const bf16_t* arow_b = nullptr;
    if (MODE == 0) arow_f = a.x + (size_t)(row0 + ar) * K;
    else if (MODE == 1 || MODE == 3) arow_b = a.Ab + (size_t)(row0 + ar) * K;
    else { const int r = row0 + ar - pst; const int tok = (r < cnt) ? a.list[e * NTOK + r] : 0; arow_b = a.Ab + (size_t)tok * K; }
    const int bk = tid >> 4, bn = (tid & 15) * 4;
    float acc[4][4], acc2[4][4];
#pragma unroll
    for (int i = 0; i < 4; ++i)
#pragma unroll
        for (int j = 0; j < 4; ++j) { acc[i][j] = 0.f; acc2[i][j] = 0.f; }
    for (int k0 = 0; k0 < K; k0 += 16) {
        float av[4];
        if (MODE == 0) { const float4 t = *(const float4*)(arow_f + k0 + ak); av[0] = t.x; av[1] = t.y; av[2] = t.z; av[3] = t.w; }
        else { const uint2 t = *(const uint2*)(arow_b + k0 + ak); av[0] = bf2f((bf16_t)(t.x & 0xffff)); av[1] = bf2f((bf16_t)(t.x >> 16)); av[2] = bf2f((bf16_t)(t.y & 0xffff)); av[3] = bf2f((bf16_t)(t.y >> 16)); }
        const float4 bv = *(const float4*)(B + (size_t)(k0 + bk) * LDB + col0 + bn);
        float4 bv2 = bv;
        if (DUAL) bv2 = *(const float4*)(B + (size_t)(k0 + bk) * LDB + 1024 + col0 + bn);
        __syncthreads();
#pragma unroll
        for (int c = 0; c < 4; ++c) As[ak + c][ar] = av[c];
        *(float4*)&Bs[bk][bn] = bv;
        if (DUAL) *(float4*)&Bs2[bk][bn] = bv2;
        __syncthreads();
#pragma unroll
        for (int k = 0; k < 16; ++k) {
            const float4 a4 = *(const float4*)&As[k][ty * 4];
            const float4 b4 = *(const float4*)&Bs[k][tx * 4];
            const float aa[4] = {a4.x, a4.y, a4.z, a4.w}, bb[4] = {b4.x, b4.y, b4.z, b4.w};
#pragma unroll
            for (int i = 0; i < 4; ++i)
#pragma unroll
                for (int j = 0; j < 4; ++j) acc[i][j] = fmaf(aa[i], bb[j], acc[i][j]);
            if (DUAL) {
                const float4 c4 = *(const float4*)&Bs2[k][tx * 4];
                const float cc[4] = {c4.x, c4.y, c4.z, c4.w};
#pragma unroll
                for (int i = 0; i < 4; ++i)
#pragma unroll
                    for (int j = 0; j < 4; ++j) acc2[i][j] = fmaf(aa[i], cc[j], acc2[i][j]);
            }
        }
    }
#pragma unroll
    for (int i = 0; i < 4; ++i) {
        const int row = row0 + ty * 4 + i;
#pragma unroll
        for (int j = 0; j < 4; ++j) {
            const int col = col0 + tx * 4 + j;
            if (MODE == 0) { float v = acc[i][j]; if (col < C_K) v *= QSCALE; a.Ob[(size_t)row * INW + col] = f2bf(v); }
            else if (MODE == 1) { a.Of[(size_t)row * DM + col] = ALPHA * a.x[(size_t)row * DM + col] + acc[i][j]; }
            else if (MODE == 2) {
                float g = acc[i][j] + a.bias[e * 2048 + col], l = acc2[i][j] + a.bias[e * 2048 + 1024 + col];
                g = fminf(g, 7.0f); l = fminf(fmaxf(l, -7.0f), 7.0f);
                const float act = (l + 1.0f) * g * (1.0f / (1.0f + expf(-1.702f * g)));
                a.Ob[(size_t)row * DFF + col] = f2bf(act);
            } else { a.Ob[(size_t)row * DM + col] = f2bf(acc[i][j] + a.bias[e * DM + col]); }
        }
    }
}

__global__ void __launch_bounds__(128) nattn(const bf16_t* __restrict__ proj, bf16_t* __restrict__ mix, const float* lq1, const float* lk1, const float* lq2, const float* lk2, const float* subg) {
    __shared__ float sc[2][SEQ];
    const int w = threadIdx.x >> 6, lane = threadIdx.x & 63;
    const int task = blockIdx.x * 2 + w, t = task >> 2, h = task & 3, b = t / SEQ, qpos = t % SEQ;
    const float lam = expf(wave_sum(lq1[lane] * lk1[lane])) - expf(wave_sum(lq2[lane] * lk2[lane])) + LAMBDA_INIT;
    const bf16_t* pb = proj + (size_t)b * SEQ * INW;
    float o[2][2];
    for (int s = 0; s < 2; ++s) {
        float q[DH];
        const bf16_t* qp = proj + (size_t)t * INW + C_Q + s * 256 + h * DH;
#pragma unroll
        for (int d = 0; d < DH; ++d) q[d] = bf2f(qp[d]);
        float m = -INFINITY;
        for (int j = lane; j <= qpos; j += 64) {
            const uint4* kp = (const uint4*)(pb + (size_t)j * INW + C_K + s * 256 + h * DH);
            float acc = 0.f;
#pragma unroll
            for (int c = 0; c < 8; ++c) {
                const uint4 kk = kp[c];
                const uint32_t ww[4] = {kk.x, kk.y, kk.z, kk.w};
#pragma unroll
                for (int z = 0; z < 4; ++z) { acc = fmaf(q[c * 8 + 2 * z], bf2f((bf16_t)(ww[z] & 0xffff)), acc); acc = fmaf(q[c * 8 + 2 * z + 1], bf2f((bf16_t)(ww[z] >> 16)), acc); }
            }
            sc[w][j] = acc; m = fmaxf(m, acc);
        }
        m = wave_max(m);
        float l = 0.f;
        for (int j = lane; j <= qpos; j += 64) { const float p = exp2f(sc[w][j] - m); sc[w][j] = p; l += p; }
        l = wave_sum(l);
        __syncthreads();
        float o0 = 0.f, o1 = 0.f;
        const bf16_t* vp = pb + C_V + h * DV + lane * 2;
        for (int j = 0; j <= qpos; ++j) {
            const float p = sc[w][j];
            const uint32_t vv = *(const uint32_t*)(vp + (size_t)j * INW);
            o0 = fmaf(p, bf2f((bf16_t)(vv & 0xffff)), o0); o1 = fmaf(p, bf2f((bf16_t)(vv >> 16)), o1);
        }
        o[s][0] = o0 / l; o[s][1] = o1 / l;
        __syncthreads();
    }
    const float d0 = o[0][0] - lam * o[1][0], d1 = o[0][1] - lam * o[1][1];
    const float ss = wave_sum(d0 * d0 + d1 * d1);
    const float r = rsqrtf(ss * (1.0f / DV) + LN_EPS) * (1.0f - LAMBDA_INIT);
    const uint32_t pk = (uint32_t)f2bf(d0 * r * subg[lane * 2]) | ((uint32_t)f2bf(d1 * r * subg[lane * 2 + 1]) << 16);
    *(uint32_t*)(mix + (size_t)t * DM + h * DV + lane * 2) = pk;
}

__global__ void __launch_bounds__(256) ngmlp(const bf16_t* __restrict__ proj, bf16_t* __restrict__ mix, const float* lng, const float* lnb, const float* wsp, const float* bsp) {
    __shared__ float mu[CHUNK], rs[CHUNK];
    __shared__ float vn[CHUNK][GD];
    const int c = blockIdx.x, g = blockIdx.y, tid = threadIdx.x, w = tid >> 6, lane = tid & 63;
    const size_t row0 = (size_t)c * CHUNK;
    for (int s = w; s < CHUNK; s += 4) {
        const bf16_t* p = proj + (row0 + s) * INW + C_GV;
        float v[8]; float sum = 0.f;
#pragma unroll
        for (int i = 0; i < 8; ++i) { v[i] = gelu_exact(bf2f(p[lane + 64 * i])); sum += v[i]; }
        const float mean = wave_sum(sum) * (1.0f / GW); float q = 0.f;
#pragma unroll
        for (int i = 0; i < 8; ++i) { const float d = v[i] - mean; q += d * d; }
        const float var = wave_sum(q) * (1.0f / GW);
        if (lane == 0) { mu[s] = mean; rs[s] = rsqrtf(var + LN_EPS); }
    }
    __syncthreads();
    for (int i = tid; i < CHUNK * GD; i += 256) {
        const int s = i >> 6, d = i & 63, col = g * GD + d;
        const float v = gelu_exact(bf2f(proj[(row0 + s) * INW + C_GV + col]));
        vn[s][d] = (v - mu[s]) * rs[s] * lng[col] + lnb[col];
    }
    __syncthreads();
    const int t = tid >> 1, dh = (tid & 1) * 32;
    float z[32];
#pragma unroll
    for (int d = 0; d < 32; ++d) z[d] = 0.f;
    const float* wr = wsp + ((size_t)g * CHUNK + t) * CHUNK;
    for (int s = 0; s <= t; ++s) {
        const float wv = wr[s];
#pragma unroll
        for (int d = 0; d < 32; ++d) z[d] = fmaf(wv, vn[s][dh + d], z[d]);
    }
    const float bb = bsp[g * CHUNK + t];
#pragma unroll
    for (int d = 0; d < 32; ++d) {
        const int col = g * GD + dh + d;
        const float u = gelu_exact(bf2f(proj[(row0 + t) * INW + C_GU + col]));
        mix[(row0 + t) * DM + GW + col] = f2bf(u * (z[d] + bb));
    }
}

__global__ void __launch_bounds__(256) nroute(float* __restrict__ h1, bf16_t* __restrict__ xb, const float* g1, const float* b1, const float* wr, const float* br, int* ctl, int* list, int* re, int* rr, float* rg) {
    const int w = threadIdx.x >> 6, lane = threadIdx.x & 63, t = blockIdx.x * 4 + w;
    float* row = h1 + (size_t)t * DM;
    float v[16]; float s = 0.f;
#pragma unroll
    for (int j = 0; j < 4; ++j) { const float4 q = *(const float4*)(row + j * 256 + lane * 4); v[4 * j] = q.x; v[4 * j + 1] = q.y; v[4 * j + 2] = q.z; v[4 * j + 3] = q.w; s += (q.x + q.y) + (q.z + q.w); }
    const float mean = wave_sum(s) * (1.0f / DM); float q2 = 0.f;
#pragma unroll
    for (int i = 0; i < 16; ++i) { v[i] -= mean; q2 += v[i] * v[i]; }
    const float rstd = rsqrtf(wave_sum(q2) * (1.0f / DM) + LN_EPS);
#pragma unroll
    for (int j = 0; j < 4; ++j) {
        const int col = j * 256 + lane * 4;
#pragma unroll
        for (int c = 0; c < 4; ++c) v[4 * j + c] = v[4 * j + c] * rstd * g1[col + c] + b1[col + c];
        *(float4*)(row + col) = make_float4(v[4 * j], v[4 * j + 1], v[4 * j + 2], v[4 * j + 3]);
        uint2 pk; pk.x = (uint32_t)f2bf(v[4 * j]) | ((uint32_t)f2bf(v[4 * j + 1]) << 16); pk.y = (uint32_t)f2bf(v[4 * j + 2]) | ((uint32_t)f2bf(v[4 * j + 3]) << 16);
        *(uint2*)(xb + (size_t)t * DM + col) = pk;
    }
    float lg[NE];
#pragma unroll
    for (int e = 0; e < NE; ++e) lg[e] = 0.f;
#pragma unroll
    for (int j = 0; j < 4; ++j)
#pragma unroll
        for (int c = 0; c < 4; ++c) {
            const float xv = v[4 * j + c]; const float4* wp = (const float4*)(wr + (size_t)(j * 256 + lane * 4 + c) * NE);
#pragma unroll
            for (int e4 = 0; e4 < 8; ++e4) { const float4 ww = wp[e4]; lg[4 * e4] = fmaf(xv, ww.x, lg[4 * e4]); lg[4 * e4 + 1] = fmaf(xv, ww.y, lg[4 * e4 + 1]); lg[4 * e4 + 2] = fmaf(xv, ww.z, lg[4 * e4 + 2]); lg[4 * e4 + 3] = fmaf(xv, ww.w, lg[4 * e4 + 3]); }
        }
#pragma unroll
    for (int e = 0; e < NE; ++e) lg[e] = wave_sum(lg[e]) + br[e];
    int idx[4]; float val[4]; unsigned taken = 0u;
#pragma unroll
    for (int k = 0; k < 4; ++k) {
        float best = -INFINITY; int bi = 0;
#pragma unroll
        for (int e = 0; e < NE; ++e) { const bool ok = !((taken >> e) & 1u) && lg[e] > best; best = ok ? lg[e] : best; bi = ok ? e : bi; }
        idx[k] = bi; val[k] = best; taken |= 1u << bi;
    }
    float ex[4], se = 0.f;
#pragma unroll
    for (int k = 0; k < 4; ++k) { ex[k] = expf(val[k] - val[0]); se += ex[k]; }
    if (lane == 0) {
#pragma unroll
        for (int k = 0; k < 4; ++k) {
            const int r = atomicAdd(ctl + CW_CNT + idx[k], 1);
            list[idx[k] * NTOK + r] = t;
            re[t * 4 + k] = idx[k]; rr[t * 4 + k] = r; rg[t * 4 + k] = ex[k] / se;
        }
    }
}
__global__ void npstart(int* ctl) {
    if (threadIdx.x == 0 && blockIdx.x == 0) { int p = 0; for (int e = 0; e < NE; ++e) { ctl[CW_PSTART + e] = p; p += ((ctl[CW_CNT + e] + 255) / 256) * 256; } ctl[CW_PSTART + NE] = p; }
}
__global__ void __launch_bounds__(256) ncombine(const float* __restrict__ x1, const bf16_t* __restrict__ y, const int* ctl, const int* re, const int* rr, const float* rg, const float* g2, const float* b2, float* __restrict__ out) {
    const int w = threadIdx.x >> 6, lane = threadIdx.x & 63, t = blockIdx.x * 4 + w;
    float v[16];
#pragma unroll
    for (int j = 0; j < 4; ++j) { const float4 q = *(const float4*)(x1 + (size_t)t * DM + j * 256 + lane * 4); v[4 * j] = ALPHA * q.x; v[4 * j + 1] = ALPHA * q.y; v[4 * j + 2] = ALPHA * q.z; v[4 * j + 3] = ALPHA * q.w; }
#pragma unroll
    for (int k = 0; k < 4; ++k) {
        const int e = re[t * 4 + k], slot = ctl[CW_PSTART + e] + rr[t * 4 + k]; const float g = rg[t * 4 + k];
        const bf16_t* yr = y + (size_t)slot * DM;
#pragma unroll
        for (int j = 0; j < 4; ++j) { const uint2 pk = *(const uint2*)(yr + j * 256 + lane * 4);
            v[4 * j] = fmaf(g, bf2f((bf16_t)(pk.x & 0xffff)), v[4 * j]); v[4 * j + 1] = fmaf(g, bf2f((bf16_t)(pk.x >> 16)), v[4 * j + 1]);
            v[4 * j + 2] = fmaf(g, bf2f((bf16_t)(pk.y & 0xffff)), v[4 * j + 2]); v[4 * j + 3] = fmaf(g, bf2f((bf16_t)(pk.y >> 16)), v[4 * j + 3]); }
    }
    float s = 0.f;
#pragma unroll
    for (int i = 0; i < 16; ++i) s += v[i];
    const float mean = wave_sum(s) * (1.0f / DM); float q2 = 0.f;
#pragma unroll
    for (int i = 0; i < 16; ++i) { v[i] -= mean; q2 += v[i] * v[i]; }
    const float rstd = rsqrtf(wave_sum(q2) * (1.0f / DM) + LN_EPS);
#pragma unroll
    for (int j = 0; j < 4; ++j) { const int col = j * 256 + lane * 4;
        *(float4*)(out + (size_t)t * DM + col) = make_float4(v[4 * j] * rstd * g2[col] + b2[col], v[4 * j + 1] * rstd * g2[col + 1] + b2[col + 1], v[4 * j + 2] * rstd * g2[col + 2] + b2[col + 2], v[4 * j + 3] * rstd * g2[col + 3] + b2[col + 3]); }
}

#ifndef OPT_MASK
#define OPT_MASK 0x1FF
#endif
#ifndef FUSED
#define FUSED 0
#endif
static void launch_mega(const Args& base, int lo, int hi, int sub, hipStream_t stream) {
    Args a = base; a.ph_lo = lo; a.ph_hi = hi; a.pad0 = sub; a.pad1 = 0;
    hipLaunchKernelGGL(mega_fwd, dim3(256), dim3(NWAVES * 64), LDS_BYTES, stream, a);
}
extern "C" void kernel_launch(void* const* d_in, const int* in_sizes, int n_in, void* d_out, int out_size, void* d_ws, size_t ws_size, hipStream_t stream) {
    static int ready = 0;
    if (ready == 0) {
        if (n_in != 22 || in_sizes[0] != NTOK * DM || out_size != NTOK * DM || ws_size < WS_END) { fprintf(stderr, "kernel_launch: unexpected shapes (n_in %d, in0 %d, out %d, ws %zu)\n", n_in, n_in > 0 ? in_sizes[0] : -1, out_size, ws_size); ready = -1; return; }
        if (hipFuncSetAttribute((const void*)mega_fwd, hipFuncAttributeMaxDynamicSharedMemorySize, LDS_BYTES) != hipSuccess) { fprintf(stderr, "kernel_launch: hipFuncSetAttribute failed\n"); ready = -1; return; }
        ready = 1;
    }
    if (ready < 0) return;
    const float* x = (const float*)d_in[0]; const float* w_in = (const float*)d_in[1];
    const float *lq1 = (const float*)d_in[2], *lk1 = (const float*)d_in[3], *lq2 = (const float*)d_in[4], *lk2 = (const float*)d_in[5];
    const float *subg = (const float*)d_in[6], *glng = (const float*)d_in[7], *glnb = (const float*)d_in[8], *wsp = (const float*)d_in[9], *bsp = (const float*)d_in[10];
    const float *w_o = (const float*)d_in[11], *ln1g = (const float*)d_in[12], *ln1b = (const float*)d_in[13], *w_r = (const float*)d_in[14], *b_r = (const float*)d_in[15];
    const float *w_up = (const float*)d_in[16], *b_up = (const float*)d_in[17], *w_dn = (const float*)d_in[18], *b_dn = (const float*)d_in[19], *ln2g = (const float*)d_in[20], *ln2b = (const float*)d_in[21];
    unsigned char* ws = (unsigned char*)d_ws;
    int* ctl = (int*)(ws + WS_CTL); int* list = (int*)(ws + WS_LIST); int* re = (int*)(ws + WS_RE); int* rr = (int*)(ws + WS_RR); float* rg = (float*)(ws + WS_RG);
    bf16_t* xb = (bf16_t*)(ws + WS_XB); bf16_t* proj = (bf16_t*)(ws + WS_PROJ); bf16_t* mix = (bf16_t*)(ws + WS_MIX); bf16_t* yb = (bf16_t*)(ws + WS_Y);
    float* h1 = (float*)(ws + WS_H1); bf16_t* act = (bf16_t*)(ws + WS_ACT);
    (void)hipMemsetAsync(ws + WS_CTL, 0, CTL_BYTES, stream);
    Args base{};
    for (int i = 0; i < 22; ++i) base.in[i] = (const float*)d_in[i];
    base.out = (float*)d_out; base.ws = ws;
    constexpr unsigned OM = OPT_MASK;
#if FUSED
    static_assert(OM == 0x1FFu, "FUSED needs every stage in the persistent kernel");
    launch_mega(base, 0, N_PHASES, 3, stream);
#else
    if (OM & 0xD3u) launch_mega(base, 0, 1, 0, stream);
    if (OM & 2u) launch_mega(base, 1, 2, 0, stream);
    else { NArgs a{}; a.x = x; a.B = w_in; a.Ob = proj; ngemm<0><<<dim3(INW / 64, NTOK / 64), 256, 0, stream>>>(a); }
    if ((OM & 4u) || (OM & 8u)) launch_mega(base, 2, 3, ((OM & 4u) ? 1 : 0) | ((OM & 8u) ? 2 : 0), stream);
    if (OM & 4u) launch_mega(base, 3, 4, 0, stream);
    else nattn<<<NTOK * NH / 2, 128, 0, stream>>>(proj, mix, lq1, lk1, lq2, lk2, subg);
    if (!(OM & 8u)) ngmlp<<<dim3(NTOK / CHUNK, NG), 256, 0, stream>>>(proj, mix, glng, glnb, wsp, bsp);
    if (OM & 16u) launch_mega(base, 4, 5, 0, stream);
    else { NArgs a{}; a.x = x; a.B = w_o; a.Ab = mix; a.Of = h1; ngemm<1><<<dim3(DM / 64, NTOK / 64), 256, 0, stream>>>(a); }
    if (OM & 32u) launch_mega(base, 5, 6, 0, stream);
    else nroute<<<NTOK / 4, 256, 0, stream>>>(h1, xb, ln1g, ln1b, w_r, b_r, ctl, list, re, rr, rg);
    if ((OM & 0x1C0u) != 0x1C0u) npstart<<<1, 64, 0, stream>>>(ctl);
    if (OM & 64u) launch_mega(base, 6, 7, 0, stream);
    else { NArgs a{}; a.B = w_up; a.bias = b_up; a.Ab = xb; a.Ob = act; a.ctl = ctl; a.list = list; ngemm<2><<<dim3(DFF / 64, PADROWS / 64), 256, 0, stream>>>(a); }
    if (OM & 128u) launch_mega(base, 7, 8, 0, stream);
    else { NArgs a{}; a.B = w_dn; a.bias = b_dn; a.Ab = act; a.Ob = yb; a.ctl = ctl; a.list = list; ngemm<3><<<dim3(DM / 64, PADROWS / 64), 256, 0, stream>>>(a); }
    if (OM & 256u) launch_mega(base, 8, 9, 0, stream);
    else ncombine<<<NTOK / 4, 256, 0, stream>>>(h1, yb, ctl, re, rr, rg, ln2g, ln2b, (float*)d_out);
#endif
}
```

```cpp
#include <hip/hip_runtime.h>
#include <hip/hip_bf16.h>
#include <cstdint>
#include <cstdio>
#include <cmath>

#ifndef MOE_FP8
#define MOE_FP8 1
#endif
#ifndef CONV_IN_ATTN
#define CONV_IN_ATTN 1
#endif
namespace cfg {
constexpr int BATCH = 8, SEQ = 4096, NTOK = BATCH * SEQ, DM = 1024;
constexpr int INW = 2560, NH = 4, DH = 64, DV = 128;
constexpr int C_Q = 0, C_K = 512, C_V = 1024, C_GU = 1536, C_GV = 2048;
constexpr int GW = 512, NG = 8, GD = 64, CHUNK = 128;
constexpr int NE = 32, TOPK = 4, DFF = 1024;
constexpr int PADROWS = 139264;
constexpr float LN_EPS = 1e-5f;
constexpr float ALPHA = 1.189207115002721f;
constexpr float LAMBDA_INIT = 0.2f;
constexpr float QSCALE = 0.125f * 1.4426950408889634f;
constexpr size_t MiB = 1u << 20;
constexpr size_t WS_CTL = 0, CTL_BYTES = 1 * MiB;
constexpr size_t WS_LIST = 1 * MiB;
constexpr size_t WS_RE = 5 * MiB, WS_RR = 5 * MiB + 512 * 1024, WS_RG = 6 * MiB;
constexpr size_t WS_WIN = 8 * MiB;
constexpr size_t WS_WO = 13 * MiB;
constexpr size_t WS_WUP = 16 * MiB;
constexpr size_t WS_WDN = 144 * MiB;
constexpr size_t WS_X1B = 80 * MiB;
constexpr size_t WS_XB = 208 * MiB;
constexpr size_t WS_PROJ = 272 * MiB;
constexpr size_t WS_MIX = 432 * MiB;
constexpr size_t WS_ATTO = 496 * MiB;
constexpr size_t WS_Y = 272 * MiB;
constexpr size_t WS_H1 = 560 * MiB;
constexpr size_t WS_ACT = 688 * MiB;
constexpr size_t WS_END = 960 * MiB;
constexpr int CW_CNT = 0;
constexpr int CW_PSTART = 64;
constexpr int CW_BAR = 4096;
}
using namespace cfg;
typedef uint16_t bf16_t;

__device__ __forceinline__ float bf2f(bf16_t b) { return __uint_as_float((uint32_t)b << 16); }
__device__ __forceinline__ bf16_t f2bf(float f) { uint32_t u = __float_as_uint(f); u += 0x7fffu + ((u >> 16) & 1u); return (bf16_t)(u >> 16); }
typedef float pk2_f32x2_t __attribute__((ext_vector_type(2))); typedef __bf16 pk2_bf16x2_t __attribute__((ext_vector_type(2)));
__device__ __forceinline__ uint32_t pk2(float lo, float hi) { pk2_f32x2_t v = {lo, hi}; pk2_bf16x2_t b = __builtin_convertvector(v, pk2_bf16x2_t); return __builtin_bit_cast(uint32_t, b); }
__device__ __forceinline__ float wave_sum(float v) {
#pragma unroll
    for (int o = 1; o < 64; o <<= 1) v += __shfl_xor(v, o);
    return v;
}
__device__ __forceinline__ float wave_max(float v) {
#pragma unroll
    for (int o = 1; o < 64; o <<= 1) v = fmaxf(v, __shfl_xor(v, o));
    return v;
}
__device__ __forceinline__ float gelu_exact(float x) { return 0.5f * x * (1.0f + erff(x * 0.70710678118654752f)); }

#define OPT_MASK 0x1FF
#define FUSED 1
#define DOUBLE_MASK 0
#define P2_REP_SUB 3
namespace pg8 {
#define PG8_LAS __attribute__((address_space(3)))
typedef short bf16x8 __attribute__((ext_vector_type(8)));
typedef float f32x4 __attribute__((ext_vector_type(4)));
typedef float f32x2 __attribute__((ext_vector_type(2)));
typedef unsigned u32x4 __attribute__((ext_vector_type(4)));
typedef int v4i_t __attribute__((ext_vector_type(4)));
typedef int v8i_t __attribute__((ext_vector_type(8)));
constexpr int WSHIFT = 6;
constexpr float WUNSCALE = 1.0f / (float)(1 << WSHIFT);
constexpr int BM = 256, BK = 64, HALF = 128, HTB = HALF * BK * 2  , STAGE_BYTES = 8 * HTB, NXCD = 8, WGM = 8;

__host__ __device__ __forceinline__ int lds_byte(int r, int c) { const int st = (r >> 4) * 2 + (c >> 5), rr = r & 15, cc = c & 31, ob = rr * 64 + cc * 2; return st * 1024 + (ob ^ (((ob >> 9) & 1) << 5)); }
__host__ __device__ __forceinline__ void stage_rc(int b, int& R, int& C) { const int st = b / 1024, sb = b % 1024, swz = sb ^ (((sb >> 9) & 1) << 5); R = (st >> 1) * 16 + swz / 64; C = (st & 1) * 32 + (swz % 64) / 2; }
__host__ __device__ __forceinline__ int perm32(int rho) { const int n = rho >> 4, i = rho & 15; return 8 * (i >> 2) + 4 * n + (i & 3); }

struct Unit { int pm, pn, e; };
struct Gemm { const bf16_t* A; const bf16_t* Bt; int M, N, K; size_t strideB; };

struct StaticOrder {
    int nM, nN, nwg, G, c;
    __host__ __device__ void init(int M, int N, int G_, int c_) { nM = M / BM; nN = N / BM; nwg = nM * nN; G = G_; c = c_; }
    __host__ __device__ bool next(int i, Unit& u) const {
        const long L = (long)i * G + c; if (L >= nwg) return false;
        int wgid = (int)L; { const int q = nwg / NXCD, r = nwg % NXCD, xcd = wgid % NXCD, off = wgid / NXCD; wgid = (xcd < r ? xcd * (q + 1) : r * (q + 1) + (xcd - r) * q) + off; }
        const int nig = WGM * nN, gid = wgid / nig, fm = gid * WGM, gsz = (nM - fm) < WGM ? (nM - fm) : WGM;
        u.pm = fm + ((wgid % nig) % gsz); u.pn = (wgid % nig) / gsz; u.e = 0; return true;
    }
    __device__ __forceinline__ void gather(const Unit&, const int (&)[2], const int (&)[2], unsigned (&)[2][2], unsigned) const {}
};
struct MoeOrder {
    const PG8_LAS int* tab; const int* list; int NC, RG, chunk0, nrt, j0;
    __device__ __forceinline__ void init(const PG8_LAS int* tab_, const int* list_, int NC_, int bid) {
        tab = tab_; list = list_; NC = NC_; RG = 32 / NC_; const int x = bid & 7; j0 = bid >> 3;
        const int T = __builtin_amdgcn_readfirstlane(tab_[32]); chunk0 = (T * x) / 8; nrt = (T * (x + 1)) / 8 - chunk0;
    }
    __device__ __forceinline__ bool next(int i, Unit& u) const {
        const int pml = i * RG + (j0 % RG); if (pml >= nrt) return false;
        u.pm = chunk0 + pml; u.pn = j0 / RG; int e = 0;
        while (e < NE - 1 && u.pm >= __builtin_amdgcn_readfirstlane(tab[e + 1])) ++e;
        u.e = e; return true;
    }
    __device__ __forceinline__ void gather(const Unit& u, const int (&RA)[2], const int (&CA2)[2], unsigned (&go)[2][2], unsigned rowbytes) const {
        const int r0 = (u.pm - __builtin_amdgcn_readfirstlane(tab[u.e])) * BM, cnt = __builtin_amdgcn_readfirstlane(tab[40 + u.e]);
#pragma unroll
        for (int h = 0; h < 2; ++h)
#pragma unroll
            for (int i = 0; i < 2; ++i) { const int r = r0 + h * HALF + RA[i]; const int tok = (r < cnt) ? list[u.e * NTOK + r] : 0; go[h][i] = (unsigned)tok * rowbytes + (unsigned)CA2[i]; }
    }
};

__device__ __forceinline__ unsigned cvt_pk_bf16(float lo, float hi) { unsigned r; asm volatile("v_cvt_pk_bf16_f32 %0, %1, %2" : "=v"(r) : "v"(lo), "v"(hi)); return r; }
__device__ __forceinline__ f32x2 gelu_pk(f32x2 v) {
    const f32x2 av = __builtin_elementwise_abs(v), d = av * 0.2316418882f + 1.0f;
    f32x2 t; t.x = __builtin_amdgcn_rcpf(d.x); t.y = __builtin_amdgcn_rcpf(d.y);
    f32x2 q = t * 0.5307027145f + (-0.7265760135f); q = q * t + 0.7107068705f; q = q * t + (-0.142248368f); q = q * t + 0.127414796f; q = q * t;
    const f32x2 s = (v * v) * (-0.72134752044f);
    f32x2 e; e.x = __builtin_amdgcn_exp2f(s.x); e.y = __builtin_amdgcn_exp2f(s.y);
    const f32x2 m = v * (q * e), r = v - m;
    f32x2 o; o.x = v.x < 0.f ? m.x : r.x; o.y = v.y < 0.f ? m.y : r.y; return o;
}
__device__ __forceinline__ float gelu1(float v) { return gelu_pk((f32x2){v, v}).x; }

struct EpiProj {
    static constexpr bool PERM = true;
    bf16_t* O;
    __device__ __forceinline__ void operator()(const f32x4 (&acc)[2][2][4][2], const Unit& u, int wr, int wc, int fr, int fq) const {
        const int row0 = u.pm * BM + wr * 64 + fr, col0 = u.pn * BM + wc * 32 + 8 * fq; const float sc = (u.pn < 2) ? QSCALE : 1.0f;
#pragma unroll
        for (int ai = 0; ai < 2; ++ai)
#pragma unroll
            for (int m = 0; m < 4; ++m) { bf16_t* rowp = O + (size_t)(row0 + ai * HALF + m * 16) * INW + col0;
#pragma unroll
                for (int bj = 0; bj < 2; ++bj) { const f32x4 v0 = acc[ai][bj][m][0] * sc, v1 = acc[ai][bj][m][1] * sc;
                    u32x4 w; w.x = cvt_pk_bf16(v0[0], v0[1]); w.y = cvt_pk_bf16(v0[2], v0[3]); w.z = cvt_pk_bf16(v1[0], v1[1]); w.w = cvt_pk_bf16(v1[2], v1[3]);
                    *(u32x4*)(rowp + bj * HALF) = w; } }
    }
};
struct EpiH1 {
    static constexpr bool PERM = false;
    const float* X; float* C;
    __device__ __forceinline__ void operator()(const f32x4 (&acc)[2][2][4][2], const Unit& u, int wr, int wc, int fr, int fq) const {
        const int row0 = u.pm * BM + wr * 64 + fr, col0 = u.pn * BM + wc * 32 + 4 * fq;
#pragma unroll
        for (int ai = 0; ai < 2; ++ai)
#pragma unroll
            for (int m = 0; m < 4; ++m) { const size_t off = (size_t)(row0 + ai * HALF + m * 16) * DM + col0;
#pragma unroll
                for (int bj = 0; bj < 2; ++bj)
#pragma unroll
                    for (int n = 0; n < 2; ++n) { const f32x4 xv = *(const f32x4*)(X + off + bj * HALF + n * 16); *(f32x4*)(C + off + bj * HALF + n * 16) = xv * ALPHA + acc[ai][bj][m][n]; } }
    }
};
struct EpiSwiglu {
    static constexpr bool PERM = true;
    bf16_t* O; const float* bias;
    __device__ __forceinline__ void operator()(const f32x4 (&acc)[2][2][4][2], const Unit& u, int wr, int wc, int fr, int fq) const {
        const int row0 = u.pm * BM + wr * 64 + fr, col0 = u.pn * HALF + wc * 32 + 8 * fq;
        const float* bp = bias + (size_t)u.e * (2 * DFF) + col0;
        f32x4 bg[2], bl[2];
#pragma unroll
        for (int n = 0; n < 2; ++n) { bg[n] = *(const f32x4*)(bp + 4 * n); bl[n] = *(const f32x4*)(bp + DFF + 4 * n); }
#pragma unroll
        for (int ai = 0; ai < 2; ++ai)
#pragma unroll
            for (int m = 0; m < 4; ++m) { float a8[8];
#pragma unroll
                for (int n = 0; n < 2; ++n) { const f32x4 g4 = acc[ai][0][m][n] + bg[n], l4 = acc[ai][1][m][n] + bl[n];
#pragma unroll
                    for (int j = 0; j < 4; ++j) { const float g = fminf(g4[j], 7.0f), l = fminf(fmaxf(l4[j], -7.0f), 7.0f);
                        const float sg = __builtin_amdgcn_rcpf(1.0f + __builtin_amdgcn_exp2f(g * (-1.702f * 1.4426950408889634f)));
                        a8[4 * n + j] = (l + 1.0f) * g * sg; } }
                u32x4 w; w.x = cvt_pk_bf16(a8[0], a8[1]); w.y = cvt_pk_bf16(a8[2], a8[3]); w.z = cvt_pk_bf16(a8[4], a8[5]); w.w = cvt_pk_bf16(a8[6], a8[7]);
                *(u32x4*)(O + (size_t)(row0 + ai * HALF + m * 16) * DFF + col0) = w; }
    }
};
struct EpiDown {
    static constexpr bool PERM = true;
    bf16_t* O; const float* bias;
    __device__ __forceinline__ void operator()(const f32x4 (&acc)[2][2][4][2], const Unit& u, int wr, int wc, int fr, int fq) const {
        const int row0 = u.pm * BM + wr * 64 + fr, col0 = u.pn * BM + wc * 32 + 8 * fq;
        const float* bp = bias + (size_t)u.e * DM + col0;
        f32x4 bv[2][2];
#pragma unroll
        for (int bj = 0; bj < 2; ++bj)
#pragma unroll
            for (int n = 0; n < 2; ++n) bv[bj][n] = *(const f32x4*)(bp + bj * HALF + 4 * n);
#pragma unroll
        for (int ai = 0; ai < 2; ++ai)
#pragma unroll
            for (int m = 0; m < 4; ++m) { bf16_t* rowp = O + (size_t)(row0 + ai * HALF + m * 16) * DM + col0;
#pragma unroll
                for (int bj = 0; bj < 2; ++bj) { const f32x4 v0 = acc[ai][bj][m][0] + bv[bj][0], v1 = acc[ai][bj][m][1] + bv[bj][1];
                    u32x4 w; w.x = cvt_pk_bf16(v0[0], v0[1]); w.y = cvt_pk_bf16(v0[2], v0[3]); w.z = cvt_pk_bf16(v1[0], v1[1]); w.w = cvt_pk_bf16(v1[2], v1[3]);
                    *(u32x4*)(rowp + bj * HALF) = w; } }
    }
};

__device__ __forceinline__ unsigned pk4_fp8(float a, float b, float c, float d) { int w = 0; w = __builtin_amdgcn_cvt_pk_fp8_f32(a, b, w, false); w = __builtin_amdgcn_cvt_pk_fp8_f32(c, d, w, true); return (unsigned)w; }
typedef unsigned u32x2 __attribute__((ext_vector_type(2)));
struct EpiSwiglu8 {
    static constexpr bool PERM = true;
    unsigned char* O; const float* bias;
    __device__ __forceinline__ void operator()(const f32x4 (&acc)[2][2][4][2], const Unit& u, int wr, int wc, int fr, int fq) const {
        const int row0 = u.pm * BM + wr * 64 + fr, col0 = u.pn * HALF + wc * 32 + 8 * fq;
        const float* bp = bias + (size_t)u.e * (2 * DFF) + col0;
        f32x4 bg[2], bl[2];
#pragma unroll
        for (int n = 0; n < 2; ++n) { bg[n] = *(const f32x4*)(bp + 4 * n); bl[n] = *(const f32x4*)(bp + DFF + 4 * n); }
#pragma unroll
        for (int ai = 0; ai < 2; ++ai)
#pragma unroll
            for (int m = 0; m < 4; ++m) { float a8[8];
#pragma unroll
                for (int n = 0; n < 2; ++n) { const f32x4 g4 = acc[ai][0][m][n] * WUNSCALE + bg[n], l4 = acc[ai][1][m][n] * WUNSCALE + bl[n];
#pragma unroll
                    for (int j = 0; j < 4; ++j) { const float g = fminf(g4[j], 7.0f), l = fminf(fmaxf(l4[j], -7.0f), 7.0f);
                        const float sg = __builtin_amdgcn_rcpf(1.0f + __builtin_amdgcn_exp2f(g * (-1.702f * 1.4426950408889634f)));
                        a8[4 * n + j] = (l + 1.0f) * g * sg; } }
                u32x2 w; w.x = pk4_fp8(a8[0], a8[1], a8[2], a8[3]); w.y = pk4_fp8(a8[4], a8[5], a8[6], a8[7]);
                *(u32x2*)(O + (size_t)(row0 + ai * HALF + m * 16) * DFF + col0) = w; }
    }
};

struct EpiDown8 {
    static constexpr bool PERM = true;
    unsigned char* O; const float* bias;
    __device__ __forceinline__ void operator()(const f32x4 (&acc)[2][2][4][2], const Unit& u, int wr, int wc, int fr, int fq) const {
        const int row0 = u.pm * BM + wr * 64 + fr, col0 = u.pn * BM + wc * 32 + 8 * fq;
        const float* bp = bias + (size_t)u.e * DM + col0;
        f32x4 bv[2][2];
#pragma unroll
        for (int bj = 0; bj < 2; ++bj)
#pragma unroll
            for (int n = 0; n < 2; ++n) bv[bj][n] = *(const f32x4*)(bp + bj * HALF + 4 * n);
#pragma unroll
        for (int ai = 0; ai < 2; ++ai)
#pragma unroll
            for (int m = 0; m < 4; ++m) { unsigned char* rowp = O + (size_t)(row0 + ai * HALF + m * 16) * DM + col0;
#pragma unroll
                for (int bj = 0; bj < 2; ++bj) { const f32x4 v0 = acc[ai][bj][m][0] * WUNSCALE + bv[bj][0], v1 = acc[ai][bj][m][1] * WUNSCALE + bv[bj][1];
                    u32x2 w; w.x = pk4_fp8(v0[0], v0[1], v0[2], v0[3]); w.y = pk4_fp8(v1[0], v1[1], v1[2], v1[3]);
                    *(u32x2*)(rowp + bj * HALF) = w; } }
    }
};

template <class Epi, class Sched, bool GATHER, bool FP8 = false>
__device__ __forceinline__ void gemm_phase(PG8_LAS unsigned char* lds, const Gemm g, const Sched& S, const Epi& E) {
    int tid_ = threadIdx.x; asm volatile("" : "+v"(tid_));
    const int tid = tid_, wid = __builtin_amdgcn_readfirstlane(tid >> 6), lane = tid & 63, wr = wid >> 2, wc = wid & 3, fr = lane & 15, fq = lane >> 4;
    const int K = FP8 ? g.K / 2 : g.K, nt = K / BK;
    unsigned voffB[2]; int RA[2], CA2[2]; unsigned voffA[2];
#pragma unroll
    for (int i = 0; i < 2; ++i) { int R, C; stage_rc(tid * 16 + i * 8192, R, C); const int Rb = Epi::PERM ? ((R & ~31) + perm32(R & 31)) : R;
        voffA[i] = (unsigned)(R * K + C) * 2u; voffB[i] = (unsigned)(Rb * K + C) * 2u; RA[i] = R; CA2[i] = C * 2; }
    const size_t kstep = (size_t)(BK * 2);
    const size_t hstep = (size_t)HALF * K * 2;
    const size_t tstep = 2 * hstep;
    const unsigned ldsw = (unsigned)wid * 1024u;
    const int aoff = lds_byte(wr * 64 + fr, fq * 8), boff = lds_byte(wc * 32 + fr, fq * 8);
    const unsigned lds0 = (unsigned)(uintptr_t)lds;
#define PG8_SA(b, h) (((b) * 2 + (h)) * HTB)
#define PG8_SB(b, h) ((4 + (b) * 2 + (h)) * HTB)
#define PG8_GLDS(sbase, voff, ldsoff) do { unsigned keep_; asm volatile("s_mov_b32 %0, m0\n\ts_mov_b32 m0, %3\n\ts_nop 0\n\tglobal_load_lds_dwordx4 %1, %2\n\ts_mov_b32 m0, %0" \
        : "=&s"(keep_) : "v"(voff), "s"(sbase), "s"((unsigned)__builtin_amdgcn_readfirstlane((int)(lds0 + (unsigned)(ldsoff)))) : "memory"); } while (0)
#define PG8_STAGE_B(bufoff, gbase) do { PG8_GLDS((const char*)(gbase), voffB[0], (bufoff) + ldsw); PG8_GLDS((const char*)(gbase), voffB[1], (bufoff) + ldsw + 8192); } while (0)
#define PG8_STAGE_A(bufoff, gbase, o0, o1) do { PG8_GLDS((const char*)(gbase), (o0), (bufoff) + ldsw); PG8_GLDS((const char*)(gbase), (o1), (bufoff) + ldsw + 8192); } while (0)
#define PG8_LDA(dst, b, h) do { _Pragma("unroll") for (int m = 0; m < 4; ++m) _Pragma("unroll") for (int k = 0; k < 2; ++k) dst[m][k] = *(const PG8_LAS bf16x8*)(lds + PG8_SA(b, h) + aoff + m * 2048 + k * 1024); } while (0)
#define PG8_LDB(dst, b, h) do { _Pragma("unroll") for (int n = 0; n < 2; ++n) _Pragma("unroll") for (int k = 0; k < 2; ++k) dst[n][k] = *(const PG8_LAS bf16x8*)(lds + PG8_SB(b, h) + boff + n * 2048 + k * 1024); } while (0)
#define PG8_LD8(p) __builtin_shufflevector(*(const PG8_LAS v4i_t*)(p), *(const PG8_LAS v4i_t*)((p) + 1024), 0, 1, 2, 3, 4, 5, 6, 7)
#define PG8_LDA8(dst, b, h) do { _Pragma("unroll") for (int m = 0; m < 4; ++m) dst[m] = PG8_LD8(lds + PG8_SA(b, h) + aoff + m * 2048); } while (0)
#define PG8_LDB8(dst, b, h) do { _Pragma("unroll") for (int n = 0; n < 2; ++n) dst[n] = PG8_LD8(lds + PG8_SB(b, h) + boff + n * 2048); } while (0)
#define PG8_MMA(ai, bj, At, Bt) do { __builtin_amdgcn_s_setprio(1); \
        if constexpr (FP8) { _Pragma("unroll") for (int m = 0; m < 4; ++m) _Pragma("unroll") for (int n = 0; n < 2; ++n) \
            acc[ai][bj][m][n] = __builtin_amdgcn_mfma_scale_f32_16x16x128_f8f6f4(Bt##8[n], At##8[m], acc[ai][bj][m][n], 0, 0, 0, 0, 0, 0);     \
              \
            _Pragma("unroll") for (int m = 0; m < 4; ++m) _Pragma("unroll") for (int n = 0; n < 2; ++n) asm volatile("" : "+v"(acc[ai][bj][m][n])); } \
        else { _Pragma("unroll") for (int m = 0; m < 4; ++m) _Pragma("unroll") for (int n = 0; n < 2; ++n) _Pragma("unroll") for (int k = 0; k < 2; ++k) \
            acc[ai][bj][m][n] = __builtin_amdgcn_mfma_f32_16x16x32_bf16(Bt[n][k], At[m][k], acc[ai][bj][m][n], 0, 0, 0); } \
        __builtin_amdgcn_s_setprio(0); } while (0)
#define PG8_XLDA(dst, b, h) do { if constexpr (FP8) PG8_LDA8(dst##8, b, h); else PG8_LDA(dst, b, h); } while (0)
#define PG8_XLDB(dst, b, h) do { if constexpr (FP8) PG8_LDB8(dst##8, b, h); else PG8_LDB(dst, b, h); } while (0)
#define PG8_WAIT_V(n) asm volatile("s_waitcnt vmcnt(" #n ")" ::: "memory")
#define PG8_WAIT_L(n) asm volatile("s_waitcnt lgkmcnt(" #n ")" ::: "memory")
#define PG8_BAR __builtin_amdgcn_s_barrier()
#define PG8_SCHED __builtin_amdgcn_sched_barrier(0)
    Unit cur, nxt; int ui = 0;
#if defined(PROBE_DOUBLE_K)
    constexpr bool DKSEL = (PROBE_DOUBLE_K == 1) ? GATHER : (PROBE_DOUBLE_K == 2) ? (FP8 && !GATHER) : (!FP8 && !GATHER && Epi::PERM);
#define PG8_UIDX(i) (DKSEL ? ((i) >> 1) : (i))
#else
#define PG8_UIDX(i) (i)
#endif
    if (!S.next(PG8_UIDX(0), cur)) return;
    f32x4 acc[2][2][4][2];
#pragma unroll
    for (int a = 0; a < 2; ++a)
#pragma unroll
        for (int b = 0; b < 2; ++b)
#pragma unroll
            for (int m = 0; m < 4; ++m)
#pragma unroll
                for (int n = 0; n < 2; ++n) acc[a][b][m][n] = (f32x4){0.f, 0.f, 0.f, 0.f};
    bf16x8 At[4][2], B0[2][2], B1[2][2]; v8i_t At8[4], B08[2], B18[2];
    const char* cA = GATHER ? (const char*)g.A : (const char*)g.A + (size_t)cur.pm * tstep;
    const char* cB = (const char*)g.Bt + ((size_t)cur.e * g.strideB) * 2 + (size_t)cur.pn * tstep;
    unsigned gc[2][2], gn[2][2];
    if constexpr (GATHER) { S.gather(cur, RA, CA2, gc, (unsigned)(K * 2)); }
    else {
#pragma unroll
        for (int h = 0; h < 2; ++h)
#pragma unroll
            for (int i = 0; i < 2; ++i) gc[h][i] = (unsigned)(h * hstep) + voffA[i]; }
#pragma unroll
    for (int h = 0; h < 2; ++h)
#pragma unroll
        for (int i = 0; i < 2; ++i) gn[h][i] = gc[h][i];
    PG8_STAGE_B(PG8_SB(0, 0), cB); PG8_STAGE_B(PG8_SB(0, 1), cB + hstep); PG8_STAGE_A(PG8_SA(0, 0), cA, gc[0][0], gc[0][1]); PG8_STAGE_A(PG8_SA(0, 1), cA, gc[1][0], gc[1][1]);
    if (wr == 1) PG8_BAR;
    PG8_WAIT_V(2); PG8_BAR;
    PG8_STAGE_B(PG8_SB(1, 0), cB + kstep); PG8_STAGE_A(PG8_SA(1, 0), cA + kstep, gc[0][0], gc[0][1]); PG8_STAGE_B(PG8_SB(1, 1), cB + hstep + kstep);
    PG8_WAIT_V(6); PG8_BAR;
    for (;;) {
        const bool has_next = S.next(PG8_UIDX(ui + 1), nxt);
        const char* nA = GATHER ? cA : (has_next ? (const char*)g.A + (size_t)nxt.pm * tstep : cA);
        const char* nB = has_next ? (const char*)g.Bt + ((size_t)nxt.e * g.strideB) * 2 + (size_t)nxt.pn * tstep : cB;
        if constexpr (GATHER) { if (has_next) S.gather(nxt, RA, CA2, gn, (unsigned)(K * 2)); }
        for (int t = 0; t < nt; t += 2) {
            const bool last = (t == nt - 2);
            const char* a1 = cA + (size_t)(t + 1) * kstep;
            const char* a2 = last ? nA : cA + (size_t)(t + 2) * kstep; const char* b2 = last ? nB : cB + (size_t)(t + 2) * kstep;
            const char* a3 = a2 + kstep; const char* b3 = b2 + kstep;
            unsigned o00 = gc[0][0], o01 = gc[0][1], o10 = gc[1][0], o11 = gc[1][1];
            if constexpr (GATHER) { if (last) { o00 = gn[0][0]; o01 = gn[0][1]; o10 = gn[1][0]; o11 = gn[1][1]; } }
            PG8_XLDB(B0, 0, 0); PG8_XLDB(B1, 0, 1); PG8_SCHED; PG8_XLDA(At, 0, 0); PG8_STAGE_A(PG8_SA(1, 1), a1, gc[1][0], gc[1][1]);
            PG8_WAIT_V(8); PG8_WAIT_L(0); PG8_BAR; PG8_MMA(0, 0, At, B0); PG8_MMA(0, 1, At, B1); PG8_BAR; PG8_SCHED;
            PG8_XLDA(At, 0, 1); PG8_STAGE_B(PG8_SB(0, 0), b2); PG8_STAGE_B(PG8_SB(0, 1), b2 + hstep); PG8_STAGE_A(PG8_SA(0, 0), a2, o00, o01);
            PG8_WAIT_V(8); PG8_WAIT_L(0); PG8_BAR; PG8_MMA(1, 0, At, B0); PG8_MMA(1, 1, At, B1); PG8_BAR; PG8_SCHED;
            PG8_XLDB(B0, 1, 0); PG8_XLDB(B1, 1, 1); PG8_SCHED; PG8_XLDA(At, 1, 0); PG8_STAGE_A(PG8_SA(0, 1), a2, o10, o11);
            PG8_WAIT_V(8); PG8_WAIT_L(0); PG8_BAR; PG8_MMA(0, 0, At, B0); PG8_MMA(0, 1, At, B1); PG8_BAR; PG8_SCHED;
            PG8_XLDA(At, 1, 1); PG8_STAGE_B(PG8_SB(1, 0), b3); PG8_STAGE_B(PG8_SB(1, 1), b3 + hstep); PG8_STAGE_A(PG8_SA(1, 0), a3, o00, o01);
            PG8_WAIT_V(8); PG8_WAIT_L(0); PG8_BAR; PG8_MMA(1, 0, At, B0); PG8_MMA(1, 1, At, B1); PG8_BAR; PG8_SCHED;
        }
        if (wr == 0) PG8_BAR;
#if defined(PROBE_DOUBLE_K)
        const bool dk_first = DKSEL && ((ui & 1) == 0);
        if (DKSEL && !dk_first) { _Pragma("unroll") for (int a = 0; a < 2; ++a) _Pragma("unroll") for (int b = 0; b < 2; ++b) _Pragma("unroll") for (int m = 0; m < 4; ++m) _Pragma("unroll") for (int n = 0; n < 2; ++n) acc[a][b][m][n] *= 0.5f; }
#else
        constexpr bool dk_first = false;
#endif
        if (!dk_first)
        { int fr_ = fr, fq_ = fq; asm volatile("" : "+v"(fr_), "+v"(fq_));
          E(acc, cur, wr, wc, fr_, fq_);
#if defined(PROBE_DOUBLE_EPI)
          if constexpr (GATHER) { asm volatile("" : "+v"(fr_), "+v"(fq_)); E(acc, cur, wr, wc, fr_, fq_); }
#endif
          }
        if (!has_next) break;
        if (!dk_first) {
#pragma unroll
        for (int a = 0; a < 2; ++a)
#pragma unroll
            for (int b = 0; b < 2; ++b)
#pragma unroll
                for (int m = 0; m < 4; ++m)
#pragma unroll
                    for (int n = 0; n < 2; ++n) acc[a][b][m][n] = (f32x4){0.f, 0.f, 0.f, 0.f};
        }
        cur = nxt; cA = nA; cB = nB; ++ui;
#pragma unroll
        for (int h = 0; h < 2; ++h)
#pragma unroll
            for (int i = 0; i < 2; ++i) gc[h][i] = gn[h][i];
        if (wr == 1) PG8_BAR;
    }
    PG8_WAIT_V(0);
    PG8_BAR;
#undef PG8_UIDX
#undef PG8_SA
#undef PG8_SB
#undef PG8_GLDS
#undef PG8_STAGE_A
#undef PG8_STAGE_B
#undef PG8_LDA
#undef PG8_LDB
#undef PG8_MMA
#undef PG8_LD8
#undef PG8_LDA8
#undef PG8_LDB8
#undef PG8_XLDA
#undef PG8_XLDB
#undef PG8_WAIT_V
#undef PG8_WAIT_L
#undef PG8_BAR
#undef PG8_SCHED
}
}

namespace attn_body {
using bf16=__hip_bfloat16;
using bf16x8=__attribute__((ext_vector_type(8)))short;
using s16x4=__attribute__((ext_vector_type(4)))short;
using f32x16=__attribute__((ext_vector_type(16)))float;
using u32x4=__attribute__((ext_vector_type(4)))unsigned;
constexpr int D=64,PQ=INW,PO=DM;
constexpr int NW=8,QBLK=32,QB=QBLK*NW,KVBLK=64,NQB=SEQ/QB;
constexpr int ATTN_UNIT_ROWS=QB;
__device__ __forceinline__ int crow(int r,int hi){return (r&3)+8*(r>>2)+4*hi;}
#define SBAR() __builtin_amdgcn_sched_barrier(0)
__device__ __forceinline__ void cmask(f32x16&p0,f32x16&p1,int jb,int qrel,int hi){
  const float NEG=-INFINITY; int kb=64*jb+4*hi;
  #pragma unroll
  for(int r=0;r<16;++r){int kv=kb+(r&3)+8*(r>>2); if(kv>qrel)p0[r]=NEG; if(kv+32>qrel)p1[r]=NEG;}
}

constexpr int NSLOT=3, SLOTB=8192;
constexpr int LDS_K=0, LDS_V=NSLOT*SLOTB, LDS_WS=3*NSLOT*SLOTB, LDS_STASH=LDS_WS+NW*64*4, LDS_BYTES=LDS_STASH+NW*8192;
constexpr float C2=0.125f*1.4426950408889634f;
__device__ __forceinline__ void glds16(const void*gsrc,unsigned lds_dst){unsigned keep;
  asm volatile("s_mov_b32 %0, m0\n\ts_mov_b32 m0, %2\n\ts_nop 0\n\tglobal_load_lds_dwordx4 %1, off\n\ts_mov_b32 m0, %0":"=&s"(keep):"v"(gsrc),"s"(lds_dst):"memory");}
__device__ __forceinline__ float max3f(float a,float b,float c){float r;asm("v_max3_f32 %0, %1, %2, %3":"=v"(r):"v"(a),"v"(b),"v"(c));return r;}
__device__ __forceinline__ float max2f(float a,float b){float r;asm("v_max_f32_e32 %0, %1, %2":"=v"(r):"v"(a),"v"(b));return r;}
__device__ __forceinline__ float fadd_s(float a,float b){float r;asm("v_add_f32_e32 %0, %1, %2":"=v"(r):"v"(a),"v"(b));return r;}
__device__ __forceinline__ float fsub_s(float a,float b){float r;asm("v_sub_f32_e32 %0, %1, %2":"=v"(r):"v"(a),"v"(b));return r;}
typedef float f32x2_t __attribute__((ext_vector_type(2))); typedef __bf16 bf16x2_t __attribute__((ext_vector_type(2)));
__device__ __forceinline__ unsigned cvtpk_s(float lo,float hi){f32x2_t v={lo,hi};bf16x2_t b=__builtin_convertvector(v,bf16x2_t);return __builtin_bit_cast(unsigned,b);}
#define WAIT_BAR(N) asm volatile("s_waitcnt vmcnt(" #N ") lgkmcnt(0)\n\ts_barrier":::"memory")

__device__ __forceinline__ void qkt(f32x16&p0,f32x16&p1,const char*Kslot,const bf16x8*qr,int r32,int hi){ const f32x16 negm=f32x16{};
  const char*kb=Kslot+hi*1024+r32*16;
  #pragma unroll
  for(int d0=0;d0<4;++d0){
    const bf16x8 b0=*reinterpret_cast<const bf16x8*>(kb+d0*2048);
    const bf16x8 b1=*reinterpret_cast<const bf16x8*>(kb+d0*2048+512);
    if(d0==0){p0=__builtin_amdgcn_mfma_f32_32x32x16_bf16(b0,qr[0],negm,0,0,0);p1=__builtin_amdgcn_mfma_f32_32x32x16_bf16(b1,qr[0],negm,0,0,0);}
    else{p0=__builtin_amdgcn_mfma_f32_32x32x16_bf16(b0,qr[d0],p0,0,0,0);p1=__builtin_amdgcn_mfma_f32_32x32x16_bf16(b1,qr[d0],p1,0,0,0);}}
}
typedef __attribute__((address_space(3))) const char* lds_cptr;
typedef short v4i16_t __attribute__((ext_vector_type(4)));
__device__ __forceinline__ void kload8(bf16x8*kf,lds_cptr kp){
  kf[0]=*(const __attribute__((address_space(3))) bf16x8*)(kp);      kf[1]=*(const __attribute__((address_space(3))) bf16x8*)(kp+512);
  kf[2]=*(const __attribute__((address_space(3))) bf16x8*)(kp+2048); kf[3]=*(const __attribute__((address_space(3))) bf16x8*)(kp+2560);
  kf[4]=*(const __attribute__((address_space(3))) bf16x8*)(kp+4096); kf[5]=*(const __attribute__((address_space(3))) bf16x8*)(kp+4608);
  kf[6]=*(const __attribute__((address_space(3))) bf16x8*)(kp+6144); kf[7]=*(const __attribute__((address_space(3))) bf16x8*)(kp+6656);
}
__device__ __forceinline__ void kload2(bf16x8*kf,lds_cptr kp,int j){ kf[2*j]=*(const __attribute__((address_space(3))) bf16x8*)(kp+j*2048); kf[2*j+1]=*(const __attribute__((address_space(3))) bf16x8*)(kp+j*2048+512); }
__device__ __forceinline__ s16x4 vtr(lds_cptr p){ return __builtin_bit_cast(s16x4,__builtin_amdgcn_ds_read_tr16_b64_v4i16((__attribute__((address_space(3))) v4i16_t*)p)); }
__device__ __forceinline__ float rowmax(const f32x16&p0,const f32x16&p1){
  float a=max3f(p0[0],p0[1],p1[0]),b=max3f(p0[2],p0[3],p1[1]);a=max3f(a,p1[2],p1[3]);
  #pragma unroll
  for(int r=4;r<16;r+=4){a=max3f(a,p0[r],p0[r+1]);b=max3f(b,p0[r+2],p0[r+3]);a=max3f(a,p1[r],p1[r+1]);b=max3f(b,p1[r+2],p1[r+3]);}
  const float m=max2f(a,b);
  auto rr=__builtin_amdgcn_permlane32_swap(__float_as_uint(m),__float_as_uint(m),false,false);
  return max2f(__uint_as_float(rr[0]),__uint_as_float(rr[1]));
}
__device__ __forceinline__ void pv(f32x16*o,int vb,bf16x8 pa0,bf16x8 pa1,bf16x8 pa2,bf16x8 pa3){
  #pragma unroll
  for(int d0=0;d0<4;++d0){s16x4 lo[4],hi[4];
    #pragma unroll
    for(int ks=0;ks<4;++ks){
      asm volatile("ds_read_b64_tr_b16 %0,%1 offset:%c2":"=&v"(lo[ks]):"v"(vb),"i"(d0*4096+ks*1024):"memory");
      asm volatile("ds_read_b64_tr_b16 %0,%1 offset:%c2":"=&v"(hi[ks]):"v"(vb),"i"(d0*4096+ks*1024+512):"memory");}
    asm volatile("s_waitcnt lgkmcnt(0)":::"memory");SBAR();
    #define PK(k) (bf16x8){lo[k][0],lo[k][1],lo[k][2],lo[k][3],hi[k][0],hi[k][1],hi[k][2],hi[k][3]}
    o[d0]=__builtin_amdgcn_mfma_f32_32x32x16_bf16(pa0,PK(0),o[d0],0,0,0);
    o[d0]=__builtin_amdgcn_mfma_f32_32x32x16_bf16(pa1,PK(1),o[d0],0,0,0);
    o[d0]=__builtin_amdgcn_mfma_f32_32x32x16_bf16(pa2,PK(2),o[d0],0,0,0);
    o[d0]=__builtin_amdgcn_mfma_f32_32x32x16_bf16(pa3,PK(3),o[d0],0,0,0);
    #undef PK
  }
}

#ifndef ATTN_STORE16
#define ATTN_STORE16(p,v) (*(u32x4*)(p)=(v))
#endif
template<int THRL> __device__ __forceinline__ void attn_unit(int qb,int st,float lam,const float*sgp,const bf16*Qb,const bf16*__restrict__ Kb,const bf16*__restrict__ Vb,bf16*Ob,char*shm){
  int tid_=threadIdx.x; asm volatile("":"+v"(tid_));
  const int tid=tid_,lane=tid&63,r32=lane&31,hi=lane>>5; const int wid=__builtin_amdgcn_readfirstlane(tid>>6);
  const int q0=qb*QB;
  const bf16*Qw=Qb+(long)(q0+wid*QBLK)*PQ;
  const bf16*Kh=Kb,*Vh=Vb;
  const unsigned lds0=(unsigned)(uintptr_t)shm;
  float*wsf=(float*)(shm+LDS_WS)+wid*64;
  const bf16*ksrc=Kh+(long)lane*PQ+wid*8;
  const bf16*vsrc=Vh+(long)(16*(wid&3)+(lane>>2))*PQ+(wid>>2)*32+(lane&3)*8;
  const unsigned kdst=lds0+LDS_K+wid*1024, vdst=lds0+LDS_V+wid*1024;
  #define DMA_K(t,slot) glds16(ksrc+(long)(t)*KVBLK*PQ,(unsigned)__builtin_amdgcn_readfirstlane(kdst+(slot)))
  #define DMA_V(t,slot) do{ glds16(vsrc+(long)(t)*KVBLK*PQ,(unsigned)__builtin_amdgcn_readfirstlane(vdst+2*(slot))); glds16(vsrc+(long)(t)*KVBLK*PQ+64,(unsigned)__builtin_amdgcn_readfirstlane(vdst+2*(slot)+8192)); }while(0)
  const int vb0=(int)(lds0+LDS_V)+((lane>>4)&1)*32+(lane&3)*8+(4*hi+((lane&15)>>2))*64;
  const char*Kbase=shm+LDS_K; bf16x8 kf[8];
  const lds_cptr shm3=(lds_cptr)shm; const lds_cptr kp0=shm3+LDS_K+hi*1024+r32*16; const lds_cptr vp0=shm3+LDS_V+((lane>>4)&1)*32+(lane&3)*8+(4*hi+((lane&15)>>2))*64;
  const int NT=(q0+QB)/KVBLK;
  DMA_K(0,0);DMA_V(0,0);DMA_K(1,SLOTB);
  bf16x8 qr[4];
  #pragma unroll
  for(int d0=0;d0<4;++d0)qr[d0]=*reinterpret_cast<const bf16x8*>(&Qw[(long)r32*PQ+d0*16+hi*8]);
  float mhat=0.f,l_reg=0.f;f32x16 o[4];o[0]=f32x16{};o[1]=f32x16{};o[2]=f32x16{};o[3]=f32x16{};
  const int qrel=wid*QBLK+r32;
  #define CMASK(P0,P1,t) do{int jb_=(t)-(NT-4); if(jb_>=0)cmask(P0,P1,jb_,qrel,hi);}while(0)
  bool resc=false;
  #define START(P0,P1) do{ const float rm=rowmax(P0,P1); resc=false; mhat=rm; \
    _Pragma("unroll") for(int r=0;r<16;++r)P0[r]=__builtin_amdgcn_exp2f(P0[r]-mhat); }while(0)
  #define RESC() do{ if(resc){ asm volatile("s_waitcnt lgkmcnt(0)":::"memory"); \
      _Pragma("unroll") for(int d_=0;d_<4;++d_) _Pragma("unroll") for(int r=0;r<16;++r)o[d_][r]*=wsf[crow(r,hi)]; } }while(0)
  f32x16 pA0,pA1,pB0,pB1;
  int sl_prev=0,sl_cur=0,sl_next=SLOTB;
  #define ROT() do{sl_prev=sl_cur;sl_cur=sl_next;sl_next=(sl_next==(NSLOT-1)*SLOTB)?0:sl_next+SLOTB;}while(0)
  DMA_K(2,2*SLOTB);
  WAIT_BAR(4);
  qkt(pA0,pA1,Kbase,qr,r32,hi);asm volatile("s_nop 15\n\ts_nop 7":"+v"(pA0),"+v"(pA1));CMASK(pA0,pA1,0);
  START(pA0,pA1);
  _Pragma("unroll") for(int r=0;r<16;++r)pA1[r]=__builtin_amdgcn_exp2f(pA1[r]-mhat);
  WAIT_BAR(0);
  DMA_K(3,0);DMA_V(1,SLOTB);
  ROT();
  kload8(kf,kp0+sl_cur);
  WAIT_BAR(3);
  s16x4 vlo[4],vhi[4]; u32x4 pw0,pw1,pw2,pw3;
  #define PKW(P,B) cvtpk_s(P[B],P[B+1])
  #define PAF(k) __builtin_bit_cast(bf16x8,pw##k)
  #define PAFJ(j) __builtin_bit_cast(bf16x8,((j)<4?pw0:(j)<8?pw1:(j)<12?pw2:pw3))
  #define VFR(i) (bf16x8){vlo[i][0],vlo[i][1],vlo[i][2],vlo[i][3],vhi[i][0],vhi[i][1],vhi[i][2],vhi[i][3]}
  #define PIN(x) asm volatile("":"+v"(x))
  #define MX3(a,b,c) __builtin_fmaxf(__builtin_fmaxf((a),(b)),(c))
  #define GAPA(MF,A0,A1,A2,A3,W0,W1,PW) do{ MF; sacc+=A0; sacc+=A1; sacc+=A2; sacc+=A3; PIN(sacc); W0; W1; PIN(PW); SBAR(); }while(0)
  #define EX(v) __builtin_amdgcn_exp2f(v)
  #define GAPB(MF,X,B) do{ MF; X[B]=EX(X[B]-mhat); X[B+1]=EX(X[B+1]-mhat); PIN(X); SBAR(); }while(0)
  #define VRD(S,ks,d0) do{ vlo[S]=vtr(vp_+((d0)*4096+(ks)*1024)); vhi[S]=vtr(vp_+((d0)*4096+(ks)*1024+512)); }while(0)
  #define KRD(G,j) do{ if(G){ kload2(kf,kp0+sl_next,j); SBAR(); } }while(0)
  #define PVG(j,X,B) GAPB(o[(j)&3]=__builtin_amdgcn_mfma_f32_32x32x16_bf16(PAFJ(j),VFR((j)&3),o[(j)&3],0,0,0), X,B)
  #define STEP(C0,C1,P0,P1,t,GK,GV,GL) do{ SBAR(); \
    const lds_cptr vp_=vp0+2*sl_prev; \
    float sacc=(P0[0]+P0[1]); \
    GAPA(C0=__builtin_amdgcn_mfma_f32_32x32x16_bf16(kf[0],qr[0],f32x16{},0,0,0), P0[2],P0[3],P0[4],P0[5],     pw0[0]=PKW(P0,0), pw0[1]=PKW(P0,2), pw0); \
    GAPA(C1=__builtin_amdgcn_mfma_f32_32x32x16_bf16(kf[1],qr[0],f32x16{},0,0,0), P0[6],P0[7],P0[8],P0[9],     pw0[2]=PKW(P0,4), pw0[3]=PKW(P0,6), pw0); \
    GAPA(C0=__builtin_amdgcn_mfma_f32_32x32x16_bf16(kf[2],qr[1],C0,0,0,0),   P0[10],P0[11],P0[12],P0[13], pw1[0]=PKW(P0,8), pw1[1]=PKW(P0,10), pw1); \
    GAPA(C1=__builtin_amdgcn_mfma_f32_32x32x16_bf16(kf[3],qr[1],C1,0,0,0),   P0[14],P0[15],P1[0],P1[1],   pw1[2]=PKW(P0,12),pw1[3]=PKW(P0,14), pw1); \
    VRD(0,0,0); SBAR(); GAPA(C0=__builtin_amdgcn_mfma_f32_32x32x16_bf16(kf[4],qr[2],C0,0,0,0),   P1[2],P1[3],P1[4],P1[5],     pw2[0]=PKW(P1,0), pw2[1]=PKW(P1,2), pw2); \
    VRD(1,0,1); SBAR(); GAPA(C1=__builtin_amdgcn_mfma_f32_32x32x16_bf16(kf[5],qr[2],C1,0,0,0),   P1[6],P1[7],P1[8],P1[9],     pw2[2]=PKW(P1,4), pw2[3]=PKW(P1,6), pw2); \
    VRD(2,0,2); SBAR(); GAPA(C0=__builtin_amdgcn_mfma_f32_32x32x16_bf16(kf[6],qr[3],C0,0,0,0),   P1[10],P1[11],P1[12],P1[13], pw3[0]=PKW(P1,8), pw3[1]=PKW(P1,10), pw3); \
    VRD(3,0,3); SBAR(); GAPA(C1=__builtin_amdgcn_mfma_f32_32x32x16_bf16(kf[7],qr[3],C1,0,0,0),   P1[14],P1[15],0.f,0.f,       pw3[2]=PKW(P1,12),pw3[3]=PKW(P1,14), pw3); \
    l_reg+=sacc; \
    if(GK){DMA_K((t)+3,sl_cur);} if(GV){DMA_V((t)+1,sl_next);} \
    CMASK(C0,C1,t); \
    { float a=MX3(C0[0],C0[1],C1[0]),b=MX3(C0[2],C0[3],C1[1]); a=MX3(a,C1[2],C1[3]); \
      _Pragma("unroll") for(int r=4;r<16;r+=4){a=MX3(a,C0[r],C0[r+1]);b=MX3(b,C0[r+2],C0[r+3]);a=MX3(a,C1[r],C1[r+1]);b=MX3(b,C1[r+2],C1[r+3]);} \
      float rm=__builtin_fmaxf(a,b); { auto rr=__builtin_amdgcn_permlane32_swap(__float_as_uint(rm),__float_as_uint(rm),false,false); rm=__builtin_fmaxf(__uint_as_float(rr[0]),__uint_as_float(rr[1])); } \
      resc=false; rm-=mhat;                                   \
      if(__builtin_expect(__any(rm>(float)THRL),0)){ const float dl=__builtin_fmaxf(rm,0.f); mhat+=dl; \
        const float f=__builtin_amdgcn_exp2f(-dl); l_reg*=f; if(hi==0)wsf[r32]=f; resc=true; } } \
    SBAR(); \
      \
    PVG(0,C0,0);  VRD(0,1,0); SBAR(); \
    PVG(1,C0,2);  VRD(1,1,1); SBAR(); \
    PVG(2,C0,4);  VRD(2,1,2); SBAR(); \
    PVG(3,C0,6);  VRD(3,1,3); SBAR(); \
    PVG(4,C0,8);  VRD(0,2,0); SBAR(); \
    PVG(5,C0,10); VRD(1,2,1); SBAR(); \
    PVG(6,C0,12); VRD(2,2,2); SBAR(); \
    PVG(7,C0,14); VRD(3,2,3); SBAR(); \
    KRD(GL,0); PVG(8,C1,0);   VRD(0,3,0); SBAR(); \
    KRD(GL,1); PVG(9,C1,2);   VRD(1,3,1); SBAR(); \
    KRD(GL,2); PVG(10,C1,4);  VRD(2,3,2); SBAR(); \
    KRD(GL,3); PVG(11,C1,6);  VRD(3,3,3); SBAR(); \
    PVG(12,C1,8); PVG(13,C1,10); PVG(14,C1,12); PVG(15,C1,14); \
    }while(0)
  int t=1;
  #undef CMASK
  #define CMASK(P0,P1,t) do{}while(0)
  for(;t+5<NT;t+=2){
    STEP(pB0,pB1,pA0,pA1,t,true,true,true);     WAIT_BAR(3); RESC(); ROT();
    STEP(pA0,pA1,pB0,pB1,t+1,true,true,true);   WAIT_BAR(3); RESC(); ROT();
  }
  #undef CMASK
  #define CMASK(P0,P1,t) do{int jb_=(t)-(NT-4); if(jb_>=0)cmask(P0,P1,jb_,qrel,hi);}while(0)
  #define ENDW(tt) do{ if((tt)+3<NT){WAIT_BAR(3);} else if((tt)+2<NT){WAIT_BAR(2);} else {WAIT_BAR(0);} }while(0)
  for(;t+1<NT;t+=2){
    STEP(pB0,pB1,pA0,pA1,t,(t+3<NT),(t+1<NT),(t+1<NT));       ENDW(t);   RESC(); ROT();
    STEP(pA0,pA1,pB0,pB1,t+1,(t+4<NT),(t+2<NT),(t+2<NT));     ENDW(t+1); RESC(); ROT();
  }
  STEP(pB0,pB1,pA0,pA1,NT-1,false,false,false); RESC();
  { float sacc=pB0[0]+pB0[1]; _Pragma("unroll") for(int r=2;r<16;++r)sacc+=pB0[r]; _Pragma("unroll") for(int r=0;r<16;++r)sacc+=pB1[r]; l_reg+=sacc;
    pw0=(u32x4){PKW(pB0,0),PKW(pB0,2),PKW(pB0,4),PKW(pB0,6)};pw1=(u32x4){PKW(pB0,8),PKW(pB0,10),PKW(pB0,12),PKW(pB0,14)};pw2=(u32x4){PKW(pB1,0),PKW(pB1,2),PKW(pB1,4),PKW(pB1,6)};pw3=(u32x4){PKW(pB1,8),PKW(pB1,10),PKW(pB1,12),PKW(pB1,14)};
    SBAR(); pv(o,vb0+2*sl_cur,PAF(0),PAF(1),PAF(2),PAF(3)); }
  #undef PKW
  #undef PAF
  #undef PAFJ
  #undef PVG
  #undef VFR
  #undef PIN
  #undef MX3
  #undef GAPA
  #undef GAPB
  #undef EX
  #undef VRD
  #undef KRD
  #undef STEP
  #undef ENDW
  {auto rr=__builtin_amdgcn_permlane32_swap(__float_as_uint(l_reg),__float_as_uint(l_reg),false,false);l_reg=__uint_as_float(rr[0])+__uint_as_float(rr[1]);}
  if(hi==0)wsf[32+r32]=l_reg;asm volatile("s_waitcnt lgkmcnt(0)":::"memory");
  float rli[16];
  #pragma unroll
  for(int r=0;r<16;++r)rli[r]=__builtin_amdgcn_rcpf(wsf[32+crow(r,hi)]);
  bf16*stash=(bf16*)(shm+LDS_STASH)+wid*4096;
  if(st==0){
    #pragma unroll
    for(int r=0;r<16;++r){const int orow=crow(r,hi);
      #pragma unroll
      for(int d0=0;d0<4;++d0)stash[orow*128+d0*32+r32]=__float2bfloat16(o[d0][r]*rli[r]);}
  } else {
    asm volatile("s_waitcnt lgkmcnt(0)\n\ts_barrier":::"memory");
    bf16*stg=(bf16*)(shm+LDS_K)+wid*4096;
    #pragma unroll
    for(int r=0;r<16;++r){const int orow=crow(r,hi);
      #pragma unroll
      for(int d0=0;d0<4;++d0)stg[orow*128+d0*32+r32]=__float2bfloat16(o[d0][r]*rli[r]);}
    asm volatile("s_waitcnt lgkmcnt(0)":::"memory");
    bf16*Ow=Ob+(long)(q0+wid*QBLK)*PO;
    const int ch=lane&15; float sgv[8];
    #pragma unroll
    for(int i=0;i<8;++i)sgv[i]=sgp[ch*8+i]*(1.0f-LAMBDA_INIT);
    #pragma unroll
    for(int i=0;i<8;++i){const int row=i*4+(lane>>4);
      const u32x4 a4=*(const u32x4*)(stash+row*128+ch*8), b4=*(const u32x4*)(stg+row*128+ch*8);
      const unsigned aw[4]={a4.x,a4.y,a4.z,a4.w}, bw[4]={b4.x,b4.y,b4.z,b4.w}; float d[8]; float ss=0.f;
      #pragma unroll
      for(int c=0;c<4;++c){ d[2*c]=__uint_as_float(aw[c]<<16)-lam*__uint_as_float(bw[c]<<16); d[2*c+1]=__uint_as_float(aw[c]&0xffff0000u)-lam*__uint_as_float(bw[c]&0xffff0000u); ss+=d[2*c]*d[2*c]+d[2*c+1]*d[2*c+1]; }
      ss+=__shfl_xor(ss,1); ss+=__shfl_xor(ss,2); ss+=__shfl_xor(ss,4); ss+=__shfl_xor(ss,8);
      const float rn=rsqrtf(ss*(1.0f/128.0f)+LN_EPS);
      u32x4 ov; ov.x=cvtpk_s(d[0]*rn*sgv[0],d[1]*rn*sgv[1]); ov.y=cvtpk_s(d[2]*rn*sgv[2],d[3]*rn*sgv[3]); ov.z=cvtpk_s(d[4]*rn*sgv[4],d[5]*rn*sgv[5]); ov.w=cvtpk_s(d[6]*rn*sgv[6],d[7]*rn*sgv[7]);
      ATTN_STORE16(Ow+(long)row*PO+ch*8,ov); }
  }
  asm volatile("s_waitcnt lgkmcnt(0)\n\ts_barrier":::"memory");
  #undef DMA_K
  #undef DMA_V
  #undef CMASK
  #undef START
  #undef RESC
  #undef ROT
}
constexpr int ATTN_LDS_BYTES=LDS_BYTES;
template<int THRL=8> __device__ __forceinline__ void attn_phase(char*lds,const bf16_t*proj,bf16_t*mix,int vcu,float lam,const float*sgp){
  const int bh=vcu>>3,s8=vcu&7,b=bh>>2,h=bh&3;
  const bf16*P0=(const bf16*)proj+(long)b*SEQ*PQ; bf16*O0=(bf16*)mix+(long)b*SEQ*PO+h*128;
  for(int i=0;i<4;++i){ const int qb=(i<2)?(15-s8):s8, st=i&1;
    attn_unit<THRL>(qb,st,lam,sgp,P0+C_Q+st*256+h*64,P0+C_K+st*256+h*64,P0+C_V+h*128,O0,lds); }
}
#undef SBAR
#undef WAIT_BAR
}

constexpr int NWAVES = 8;
constexpr int RING_OFF = 0, RING_BYTES = 131072;
constexpr int LDSCTL_OFF = 155648, MISC_OFF = LDSCTL_OFF + 320;
constexpr int TAB_OFF = LDSCTL_OFF + 1024;
constexpr int REC_OFF = LDSCTL_OFF + 2048;
constexpr int LDS_BYTES = 163840;
static_assert(REC_OFF + (64 + 512) * 4 <= LDS_BYTES && attn_body::ATTN_LDS_BYTES <= LDSCTL_OFF && RING_BYTES <= LDSCTL_OFF, "LDS map");

#define GAS __attribute__((address_space(1)))
#define LAS __attribute__((address_space(3)))
typedef unsigned v4u __attribute__((ext_vector_type(4)));
typedef unsigned v2u __attribute__((ext_vector_type(2)));
typedef float f32x4 __attribute__((ext_vector_type(4)));
typedef float f32x2 __attribute__((ext_vector_type(2)));
typedef short bf16x8 __attribute__((ext_vector_type(8)));
typedef GAS unsigned gu32;
#define RLX_AGENT __ATOMIC_RELAXED, __HIP_MEMORY_SCOPE_AGENT
#define LDS_WAIT() asm volatile("s_waitcnt lgkmcnt(0)" ::: "memory")
#define VM_WAIT() asm volatile("s_waitcnt vmcnt(0)" ::: "memory")

#define XB_TMO      128
#define XB_XCNT(j)  (256  + 64 * (j))
#define XB_XSUB(j)  (1280 + 64 * (j))
#define XB_XGEN(j)  (2304 + 64 * (j))
#define XB_TOP      3328
#define XB_TOPGEN   3392
#define XCD_BAR_WORDS 3456
#define XB_SPIN_CAP (1u << 18)
__device__ __forceinline__ unsigned xb_ld(unsigned* p)              { return __hip_atomic_load(p, __ATOMIC_RELAXED, __HIP_MEMORY_SCOPE_AGENT); }
__device__ __forceinline__ unsigned xb_add(unsigned* p, unsigned v) { return __hip_atomic_fetch_add(p, v, __ATOMIC_RELAXED, __HIP_MEMORY_SCOPE_AGENT); }
__device__ __forceinline__ unsigned xb_xcc_id() { return (unsigned)__builtin_amdgcn_s_getreg((3 << 11) | 20) & 0xFu; }
#define XB_SPIN(cond, bar) do { unsigned _sp = 0; while (cond) { __builtin_amdgcn_s_sleep(1); \
    if ((++_sp & 255u) == 0u) { if (xb_ld(&(bar)[XB_TMO])) break; if (_sp > XB_SPIN_CAP) { atomicAdd(&(bar)[XB_TMO], 1u); break; } } } } while (0)
struct XcdBarrier { unsigned* bar; unsigned x; volatile LAS unsigned* st; };
__device__ __forceinline__ XcdBarrier xcd_barrier_post(unsigned* bar, volatile LAS unsigned* st) {
    XcdBarrier b; b.bar = bar; b.x = xb_xcc_id(); b.st = st;
    if (threadIdx.x == 0) (void)xb_add(&bar[XB_XCNT(b.x)], 1u);
    return b;
}
__device__ __forceinline__ void xcd_barrier_complete(unsigned* bar, unsigned x, unsigned& nloc, unsigned& nx) {
    const unsigned G = gridDim.x * gridDim.y * gridDim.z;
    unsigned sum, cnt, mine, sp = 0u;
    for (;;) {
        sum = 0u; cnt = 0u; mine = 0u;
#pragma unroll
        for (unsigned j = 0; j < 16; ++j) { const unsigned c = xb_ld(&bar[XB_XCNT(j)]); sum += c; cnt += (c > 0u) ? 1u : 0u; mine = (j == x) ? c : mine; }
        if (sum == G) break;
        __builtin_amdgcn_s_sleep(1);
        if ((++sp & 255u) == 0u) { if (xb_ld(&bar[XB_TMO])) break; if (sp > XB_SPIN_CAP) { atomicAdd(&bar[XB_TMO], 1u); break; } }
    }
    nloc = mine > 0u ? mine : 1u; nx = cnt > 0u ? cnt : 1u;
}
__device__ __forceinline__ void xcd_barrier(const XcdBarrier& b) {
    asm volatile("s_waitcnt vmcnt(0)" ::: "memory");
    __syncthreads();
    if (threadIdx.x == 0) {
        unsigned* bar = b.bar;
        __builtin_amdgcn_s_waitcnt(0);
        unsigned nloc = b.st[0], nx = b.st[1];
        if (nloc == 0u) { xcd_barrier_complete(bar, b.x, nloc, nx); b.st[0] = nloc; b.st[1] = nx; }
        const unsigned old = xb_add(&bar[XB_XSUB(b.x)], 1u);
        const unsigned gen = old / nloc;
        if (old + 1u == (gen + 1u) * nloc) {
            __builtin_amdgcn_fence(__ATOMIC_RELEASE, "agent");
            asm volatile("s_waitcnt vmcnt(0)" ::: "memory");
            const unsigned og = xb_add(&bar[XB_TOP], 1u);
            const unsigned tg = og / nx;
            if (og + 1u == (tg + 1u) * nx) xb_add(&bar[XB_TOPGEN], 1u);
            else XB_SPIN(xb_ld(&bar[XB_TOPGEN]) == tg, bar);
            __builtin_amdgcn_fence(__ATOMIC_ACQUIRE, "agent");
            xb_add(&bar[XB_XGEN(b.x)], 1u);
            asm volatile("s_waitcnt vmcnt(0)" ::: "memory");
        } else {
            XB_SPIN(xb_ld(&bar[XB_XGEN(b.x)]) == gen, bar);
            __builtin_amdgcn_fence(__ATOMIC_ACQUIRE, "agent");
            asm volatile("s_waitcnt vmcnt(0)" ::: "memory");
        }
    }
    __syncthreads();
}

struct Args { const float* in[22]; float* out; unsigned char* ws; int ph_lo, ph_hi, pad0, pad1; };
struct Frame {
    LAS unsigned char* lds; volatile LAS unsigned* MISC; gu32* ctl;
    int tid, lane, wave, vcu, G;
};

typedef const __attribute__((address_space(4))) Args* kargs_t;
__device__ __forceinline__ Args fetch_args() {
    kargs_t kp = (kargs_t)__builtin_amdgcn_kernarg_segment_ptr();
    asm volatile("" : "+s"(kp));
    Args a;
#pragma unroll
    for (int i = 0; i < 22; ++i) a.in[i] = kp->in[i];
    a.out = kp->out; a.ws = kp->ws; a.ph_lo = kp->ph_lo; a.ph_hi = kp->ph_hi; a.pad0 = kp->pad0; a.pad1 = kp->pad1;
    return a;
}
__device__ __forceinline__ void refresh_frame(Frame& F) { int t = threadIdx.x; asm volatile("" : "+v"(t)); F.tid = t; F.lane = t & 63; F.wave = __builtin_amdgcn_readfirstlane(t >> 6); }

template <int CTRL> __device__ __forceinline__ float dppf(float v) { return __builtin_bit_cast(float, __builtin_amdgcn_update_dpp(0, __builtin_bit_cast(int, v), CTRL, 0xF, 0xF, true)); }
template <int CTRL> __device__ __forceinline__ int dppi(int v) { return __builtin_amdgcn_update_dpp(0, v, CTRL, 0xF, 0xF, true); }
__device__ __forceinline__ float rlf(float v, int l) { return __builtin_bit_cast(float, __builtin_amdgcn_readlane(__builtin_bit_cast(int, v), l)); }
__device__ __forceinline__ float wsum_dpp(float v) {
    v += dppf<0xB1>(v); v += dppf<0x4E>(v); v += dppf<0x141>(v); v += dppf<0x140>(v);
    return (rlf(v, 0) + rlf(v, 16)) + (rlf(v, 32) + rlf(v, 48));
}
__device__ __forceinline__ float wmax_dpp(float v) {
    v = fmaxf(v, dppf<0xB1>(v)); v = fmaxf(v, dppf<0x4E>(v)); v = fmaxf(v, dppf<0x141>(v)); v = fmaxf(v, dppf<0x140>(v));
    return fmaxf(fmaxf(rlf(v, 0), rlf(v, 16)), fmaxf(rlf(v, 32), rlf(v, 48)));
}
__device__ __forceinline__ int wmin_dpp(int v) {
    v = min(v, dppi<0xB1>(v)); v = min(v, dppi<0x4E>(v)); v = min(v, dppi<0x141>(v)); v = min(v, dppi<0x140>(v));
    return min(min(__builtin_amdgcn_readlane(v, 0), __builtin_amdgcn_readlane(v, 16)), min(__builtin_amdgcn_readlane(v, 32), __builtin_amdgcn_readlane(v, 48)));
}

__device__ __forceinline__ void p0_transpose_item(const float* W, int K, int N, bf16_t* WT, long row_off, LAS float* scr, int item, int lane) {
    const int nblk = N / 32, kb = item / nblk, nb = item % nblk, k0 = 64 * kb, n0 = 32 * nb;
#pragma unroll 8
    for (int i = 0; i < 32; ++i) { const int kk = 2 * i + (lane >> 5); scr[kk * 33 + (lane & 31)] = W[(size_t)(k0 + kk) * N + n0 + (lane & 31)]; }
    LDS_WAIT(); asm volatile("" ::: "memory");
    const int c = lane & 7;
#pragma unroll
    for (int j = 0; j < 4; ++j) { const int n = (lane >> 3) + 8 * j; const LAS float* s = scr + (8 * c) * 33 + n;
        v4u o; o.x = pk2(s[0 * 33], s[1 * 33]); o.y = pk2(s[2 * 33], s[3 * 33]); o.z = pk2(s[4 * 33], s[5 * 33]); o.w = pk2(s[6 * 33], s[7 * 33]);
        *(GAS v4u*)(WT + (size_t)(row_off + n0 + n) * K + k0 + 8 * c) = o; }
    LDS_WAIT(); asm volatile("" ::: "memory");
}
__device__ __forceinline__ void p0_transpose_item8(const float* W, int K, int N, unsigned char* WT, long row_off, LAS float* scr, int item, int lane) {
    const int nblk = N / 32, kb = item / nblk, nb = item % nblk, k0 = 64 * kb, n0 = 32 * nb;
#pragma unroll 8
    for (int i = 0; i < 32; ++i) { const int kk = 2 * i + (lane >> 5); scr[kk * 33 + (lane & 31)] = W[(size_t)(k0 + kk) * N + n0 + (lane & 31)]; }
    LDS_WAIT(); asm volatile("" ::: "memory");
    const int c = lane & 3; constexpr float SC = (float)(1 << pg8::WSHIFT);
#pragma unroll
    for (int j = 0; j < 2; ++j) { const int n = (lane >> 2) + 16 * j; const LAS float* s = scr + (16 * c) * 33 + n;
        v4u o; o.x = pg8::pk4_fp8(s[0 * 33] * SC, s[1 * 33] * SC, s[2 * 33] * SC, s[3 * 33] * SC); o.y = pg8::pk4_fp8(s[4 * 33] * SC, s[5 * 33] * SC, s[6 * 33] * SC, s[7 * 33] * SC);
        o.z = pg8::pk4_fp8(s[8 * 33] * SC, s[9 * 33] * SC, s[10 * 33] * SC, s[11 * 33] * SC); o.w = pg8::pk4_fp8(s[12 * 33] * SC, s[13 * 33] * SC, s[14 * 33] * SC, s[15 * 33] * SC);
        *(GAS v4u*)(WT + (size_t)(row_off + n0 + n) * K + k0 + 16 * c) = o; }
    LDS_WAIT(); asm volatile("" ::: "memory");
}
__device__ __forceinline__ void p0_prologue(Frame& F, const Args& a) {
    LAS float* scr = (LAS float*)(F.lds + RING_OFF + F.wave * 16384);
    const int gw = F.vcu * NWAVES + F.wave, NGW = F.G * NWAVES;
    unsigned char* ws = a.ws;
    constexpr int I_IN = (DM / 64) * (INW / 32), I_O = (DM / 64) * (DM / 32), I_UP1 = (DM / 64) * (2 * DFF / 32), I_DN1 = (DFF / 64) * (DM / 32);
    constexpr int NITEMS = I_IN + I_O + NE * I_UP1 + NE * I_DN1;
#if CONV_IN_ATTN
    constexpr int NITEMS_P0 = I_IN + I_O;
#else
    constexpr int NITEMS_P0 = NITEMS;
#endif
    for (int it = gw; it < NITEMS_P0; it += NGW) {
        int r = it;
        if (r < I_IN) { p0_transpose_item(a.in[1], DM, INW, (bf16_t*)(ws + WS_WIN), 0, scr, r, F.lane); continue; } r -= I_IN;
        if (r < I_O) { p0_transpose_item(a.in[11], DM, DM, (bf16_t*)(ws + WS_WO), 0, scr, r, F.lane); continue; } r -= I_O;
        if (r < NE * I_UP1) { const int e = r / I_UP1, ii = r % I_UP1; const int n0 = 32 * (ii % (2 * DFF / 32));
            const int bj = n0 / DFF, f = n0 % DFF, rho0 = 256 * (f / 128) + 128 * bj + (f % 128);
#if MOE_FP8
            p0_transpose_item8(a.in[16] + (size_t)e * DM * 2 * DFF, DM, 2 * DFF, (unsigned char*)(ws + WS_WUP) + (size_t)e * 2 * DFF * DM, (long)rho0 - n0, scr, ii, F.lane); continue; }
#else
            p0_transpose_item(a.in[16] + (size_t)e * DM * 2 * DFF, DM, 2 * DFF, (bf16_t*)(ws + WS_WUP) + (size_t)e * 2 * DFF * DM, (long)rho0 - n0, scr, ii, F.lane); continue; }
#endif
        r -= NE * I_UP1;
        { const int e = r / I_DN1, ii = r % I_DN1;
#if MOE_FP8
            p0_transpose_item8(a.in[18] + (size_t)e * DFF * DM, DFF, DM, (unsigned char*)(ws + WS_WDN) + (size_t)e * DM * DFF, 0, scr, ii, F.lane); }
#else
            p0_transpose_item(a.in[18] + (size_t)e * DFF * DM, DFF, DM, (bf16_t*)(ws + WS_WDN) + (size_t)e * DM * DFF, 0, scr, ii, F.lane); }
#endif
    }
    const float* x = a.in[0]; bf16_t* xb = (bf16_t*)(ws + WS_XB);
    for (int m = gw; m < NTOK; m += NGW) {
        const GAS f32x4* xr = (const GAS f32x4*)(x + (size_t)m * DM) + F.lane; GAS v2u* o8 = (GAS v2u*)(xb + (size_t)m * DM) + F.lane;
        f32x4 v[4];
#pragma unroll
        for (int j = 0; j < 4; ++j) v[j] = xr[64 * j];
#pragma unroll
        for (int j = 0; j < 4; ++j) { v2u o; o.x = pk2(v[j].x, v[j].y); o.y = pk2(v[j].z, v[j].w); o8[64 * j] = o; }
    }
}

struct CItem { const float* W; unsigned char* WT; int N, k0, n0, rowbase; };
__device__ __forceinline__ CItem conv_decode(int r, const Args& a) {
    constexpr int I_UP1 = (DM / 64) * (2 * DFF / 32), I_DN1 = (DFF / 64) * (DM / 32);
    CItem it;
    if (r < NE * I_UP1) { const int e = r / I_UP1, ii = r % I_UP1, nblk = 2 * DFF / 32; it.k0 = 64 * (ii / nblk); it.n0 = 32 * (ii % nblk);
        const int bj = it.n0 / DFF, f = it.n0 % DFF; it.rowbase = 256 * (f / 128) + 128 * bj + (f % 128);
        it.W = a.in[16] + (size_t)e * DM * 2 * DFF; it.WT = a.ws + WS_WUP + (size_t)e * 2 * DFF * DM; it.N = 2 * DFF; return it; }
    r -= NE * I_UP1;
    { const int e = r / I_DN1, ii = r % I_DN1, nblk = DM / 32; it.k0 = 64 * (ii / nblk); it.n0 = 32 * (ii % nblk); it.rowbase = it.n0;
        it.W = a.in[18] + (size_t)e * DFF * DM; it.WT = a.ws + WS_WDN + (size_t)e * DM * DFF; it.N = DM; return it; }
}
__device__ __forceinline__ void conv_load(const CItem& it, int lane, f32x4 (&t)[8]) {
    const int kr = lane >> 3, n4 = (lane & 7) * 4;
#pragma unroll
    for (int i = 0; i < 8; ++i) t[i] = __builtin_nontemporal_load((const f32x4*)(it.W + (size_t)(it.k0 + 8 * i + kr) * it.N + it.n0 + n4));
}
__device__ __forceinline__ void conv_finish(const CItem& it, int lane, const f32x4 (&t)[8], LAS float* scr) {
    const int kr = lane >> 3, n4 = (lane & 7) * 4;
#pragma unroll
    for (int i = 0; i < 8; ++i) { LAS float* d = scr + (8 * i + kr) * 33 + n4; d[0] = t[i].x; d[1] = t[i].y; d[2] = t[i].z; d[3] = t[i].w; }
    LDS_WAIT(); asm volatile("" ::: "memory");
    const int c = lane & 3; constexpr float SC = (float)(1 << pg8::WSHIFT);
#pragma unroll
    for (int j = 0; j < 2; ++j) { const int n = (lane >> 2) + 16 * j; const LAS float* sp = scr + (16 * c) * 33 + n;
        v4u o; o.x = pg8::pk4_fp8(sp[0 * 33] * SC, sp[1 * 33] * SC, sp[2 * 33] * SC, sp[3 * 33] * SC); o.y = pg8::pk4_fp8(sp[4 * 33] * SC, sp[5 * 33] * SC, sp[6 * 33] * SC, sp[7 * 33] * SC);
        o.z = pg8::pk4_fp8(sp[8 * 33] * SC, sp[9 * 33] * SC, sp[10 * 33] * SC, sp[11 * 33] * SC); o.w = pg8::pk4_fp8(sp[12 * 33] * SC, sp[13 * 33] * SC, sp[14 * 33] * SC, sp[15 * 33] * SC);
        __builtin_nontemporal_store(o, (v4u*)(it.WT + (size_t)(it.rowbase + n) * DM + it.k0 + 16 * c)); }
    LDS_WAIT(); asm volatile("" ::: "memory");
}
__device__ __forceinline__ void moe_weight_items(Frame& F, const Args& a, int first, int count) {
    LAS float* scr = (LAS float*)(F.lds + RING_OFF + F.wave * 8448);
    const int gw = F.vcu * NWAVES + F.wave, NGW = F.G * NWAVES, lane = F.lane;
    CItem ia = conv_decode(gw + first * NGW, a), ib = conv_decode(gw + (first + 1) * NGW, a);
    f32x4 ta[8], tb[8], na[8], nb[8];
    conv_load(ia, lane, ta); conv_load(ib, lane, tb);
    for (int k = first; k < first + count; k += 2) {
        const bool more = (k + 2 < first + count);
        const CItem ja = conv_decode(gw + (more ? k + 2 : first) * NGW, a), jb = conv_decode(gw + (more ? k + 3 : first) * NGW, a);
        if (more) { conv_load(ja, lane, na); conv_load(jb, lane, nb); }
        conv_finish(ia, lane, ta, scr); conv_finish(ib, lane, tb, scr);
        ia = ja; ib = jb;
#pragma unroll
        for (int i = 0; i < 8; ++i) { ta[i] = na[i]; tb[i] = nb[i]; }
    }
}

__device__ __forceinline__ void gmlp_phase(Frame& F, const Args& a) {
    const bf16_t* proj = (const bf16_t*)(a.ws + WS_PROJ); bf16_t* mix = (bf16_t*)(a.ws + WS_MIX);
    const float *lng = a.in[7], *lnb = a.in[8], *wsp = a.in[9], *bsp = a.in[10];
    LAS f32x2* st = (LAS f32x2*)(F.lds + RING_OFF);
    LAS bf16_t* Vg = (LAS bf16_t*)(F.lds + RING_OFF + 1024);
    LAS bf16_t* Wg = (LAS bf16_t*)(F.lds + RING_OFF + 19456);
    LAS float* Zg = (LAS float*)(F.lds + RING_OFF + 54272);
    const int tid = F.tid, lane = F.lane, w = F.wave;
    const int row = tid >> 2, cq = (tid & 3) * 16;
    for (int c = blockIdx.x; c < NTOK / CHUNK; c += F.G) {
        const size_t row0 = (size_t)c * CHUNK;
        v4u pgv[2], pgu[2]; f32x4 pwv[8], plg[4], plb[4]; float pbb;
#define GMLP_LOAD(g_) do { const int col_ = (g_) * GD + cq; \
            pgv[0] = *(const GAS v4u*)(proj + (row0 + row) * INW + C_GV + col_); pgv[1] = *(const GAS v4u*)(proj + (row0 + row) * INW + C_GV + col_ + 8); \
            pgu[0] = *(const GAS v4u*)(proj + (row0 + row) * INW + C_GU + col_); pgu[1] = *(const GAS v4u*)(proj + (row0 + row) * INW + C_GU + col_ + 8); \
            _Pragma("unroll") for (int k = 0; k < 8; ++k) { const int i_ = tid + 512 * k; pwv[k] = *(const GAS f32x4*)(wsp + ((size_t)(g_) * CHUNK + (i_ >> 5)) * CHUNK + (i_ & 31) * 4); } \
            _Pragma("unroll") for (int k = 0; k < 4; ++k) { plg[k] = *(const GAS f32x4*)(lng + col_ + 4 * k); plb[k] = *(const GAS f32x4*)(lnb + col_ + 4 * k); } \
            pbb = bsp[(g_) * CHUNK + row]; } while (0)
        GMLP_LOAD(0);
        {
            v4u raw[16];
#pragma unroll
            for (int i = 0; i < 16; ++i) raw[i] = *(const GAS v4u*)(proj + (row0 + 16 * w + i) * INW + C_GV + lane * 8);
#pragma unroll
            for (int i = 0; i < 16; ++i) {
                const unsigned rw[4] = {raw[i].x, raw[i].y, raw[i].z, raw[i].w}; float v[8]; float sum = 0.f;
#pragma unroll
                for (int k = 0; k < 4; ++k) { const f32x2 gg = pg8::gelu_pk((f32x2){bf2f((bf16_t)(rw[k] & 0xffff)), bf2f((bf16_t)(rw[k] >> 16))}); v[2 * k] = gg.x; v[2 * k + 1] = gg.y; sum += gg.x + gg.y; }
                const float mean = wsum_dpp(sum) * (1.0f / GW); float q = 0.f;
#pragma unroll
                for (int k = 0; k < 8; ++k) { const float d = v[k] - mean; q += d * d; }
                const float var = wsum_dpp(q) * (1.0f / GW);
                if (lane == 0) st[16 * w + i] = (f32x2){mean, rsqrtf(var + LN_EPS)};
            }
        }
        __syncthreads();
        for (int g = 0; g < NG; ++g) {
            const int col = g * GD + cq;
            const v4u cgu0 = pgu[0], cgu1 = pgu[1]; const float bb = pbb;
            {
                const f32x2 ms = st[row]; unsigned ow[8];
#pragma unroll
                for (int hh = 0; hh < 2; ++hh) { const unsigned rw[4] = {pgv[hh].x, pgv[hh].y, pgv[hh].z, pgv[hh].w};
#pragma unroll
                    for (int i = 0; i < 4; ++i) { const f32x2 gg = pg8::gelu_pk((f32x2){bf2f((bf16_t)(rw[i] & 0xffff)), bf2f((bf16_t)(rw[i] >> 16))});
                        const int e = hh * 8 + 2 * i; const f32x4 lg = plg[e >> 2], lb = plb[e >> 2];
                        const float g0 = (e & 2) ? lg.z : lg.x, g1 = (e & 2) ? lg.w : lg.y, b0 = (e & 2) ? lb.z : lb.x, b1 = (e & 2) ? lb.w : lb.y;
                        ow[hh * 4 + i] = pk2((gg.x - ms.x) * ms.y * g0 + b0, (gg.y - ms.x) * ms.y * g1 + b1); } }
                { const int sx = row ^ ((cq >> 4) << 4);
#pragma unroll
                  for (int e = 0; e < 8; ++e) { Vg[(cq + 2 * e) * 136 + sx] = (bf16_t)(ow[e] & 0xffffu); Vg[(cq + 2 * e + 1) * 136 + sx] = (bf16_t)(ow[e] >> 16); } }
#pragma unroll
                for (int k = 0; k < 8; ++k) { const int i = tid + 512 * k, t = i >> 5, s4 = (i & 31) * 4; const f32x4 wv = pwv[k];
                    v2u o; o.x = pk2(s4 <= t ? wv.x : 0.f, s4 + 1 <= t ? wv.y : 0.f); o.y = pk2(s4 + 2 <= t ? wv.z : 0.f, s4 + 3 <= t ? wv.w : 0.f);
                    *(LAS v2u*)(Wg + t * 136 + s4) = o; }
            }
            if (g + 1 < NG) GMLP_LOAD(g + 1);
            __syncthreads();
            {
                f32x4 acc[4];
#pragma unroll
                for (int n = 0; n < 4; ++n) acc[n] = (f32x4){0.f, 0.f, 0.f, 0.f};
                const int t0 = 16 * w, fr = lane & 15, fq = lane >> 4;
                for (int ks = 0; ks * 32 <= t0 + 15; ++ks) {
                    const bf16x8 af = *(const LAS bf16x8*)(Wg + (t0 + fr) * 136 + ks * 32 + fq * 8);
#pragma unroll
                    for (int n = 0; n < 4; ++n) { const bf16x8 bfv = *(const LAS bf16x8*)(Vg + (n * 16 + fr) * 136 + ((ks * 32 + fq * 8) ^ (n << 4)));
                        acc[n] = __builtin_amdgcn_mfma_f32_16x16x32_bf16(af, bfv, acc[n], 0, 0, 0); }
                }
#pragma unroll
                for (int n = 0; n < 4; ++n)
#pragma unroll
                    for (int r = 0; r < 4; ++r) Zg[(t0 + fq * 4 + r) * 68 + n * 16 + fr] = acc[n][r];
            }
            __syncthreads();
            {
                unsigned ow[8];
#pragma unroll
                for (int hh = 0; hh < 2; ++hh) { const v4u rawu = hh ? cgu1 : cgu0; const unsigned rw[4] = {rawu.x, rawu.y, rawu.z, rawu.w};
#pragma unroll
                    for (int i = 0; i < 4; ++i) { const f32x2 uu = pg8::gelu_pk((f32x2){bf2f((bf16_t)(rw[i] & 0xffff)), bf2f((bf16_t)(rw[i] >> 16))});
                        const f32x2 zz = *(const LAS f32x2*)(Zg + row * 68 + cq + hh * 8 + 2 * i);
                        ow[hh * 4 + i] = pk2(uu.x * (zz.x + bb), uu.y * (zz.y + bb)); } }
                GAS v4u* dst = (GAS v4u*)(mix + (row0 + row) * DM + GW + col);
                dst[0] = (v4u){ow[0], ow[1], ow[2], ow[3]}; dst[1] = (v4u){ow[4], ow[5], ow[6], ow[7]};
            }
        }
        __syncthreads();
#undef GMLP_LOAD
    }
}

__device__ __forceinline__ void attn_combine_phase(Frame& F, const Args& a) {
    const bf16_t* atto = (const bf16_t*)(a.ws + WS_ATTO); bf16_t* mix = (bf16_t*)(a.ws + WS_MIX);
    const int lane = F.lane, gw = F.vcu * NWAVES + F.wave, NGW = F.G * NWAVES;
    const float lam = expf(wave_sum(a.in[2][lane] * a.in[3][lane])) - expf(wave_sum(a.in[4][lane] * a.in[5][lane])) + LAMBDA_INIT;
    const int h = lane >> 4, e0 = (lane & 15) * 8;
    float sg[8];
#pragma unroll
    for (int i = 0; i < 8; ++i) sg[i] = a.in[6][e0 + i] * (1.0f - LAMBDA_INIT);
    for (int t = gw; t < NTOK; t += NGW) {
        const v4u r1 = *(const GAS v4u*)(atto + (size_t)t * DM + h * 256 + e0), r2 = *(const GAS v4u*)(atto + (size_t)t * DM + h * 256 + 128 + e0);
        const unsigned w1[4] = {r1.x, r1.y, r1.z, r1.w}, w2[4] = {r2.x, r2.y, r2.z, r2.w};
        float d[8]; float ss = 0.f;
#pragma unroll
        for (int i = 0; i < 4; ++i) { d[2 * i] = bf2f((bf16_t)(w1[i] & 0xffff)) - lam * bf2f((bf16_t)(w2[i] & 0xffff)); d[2 * i + 1] = bf2f((bf16_t)(w1[i] >> 16)) - lam * bf2f((bf16_t)(w2[i] >> 16)); ss += d[2 * i] * d[2 * i] + d[2 * i + 1] * d[2 * i + 1]; }
        ss += __shfl_xor(ss, 1); ss += __shfl_xor(ss, 2); ss += __shfl_xor(ss, 4); ss += __shfl_xor(ss, 8);
        const float r = rsqrtf(ss * (1.0f / DV) + LN_EPS);
        v4u o; o.x = pk2(d[0] * r * sg[0], d[1] * r * sg[1]); o.y = pk2(d[2] * r * sg[2], d[3] * r * sg[3]); o.z = pk2(d[4] * r * sg[4], d[5] * r * sg[5]); o.w = pk2(d[6] * r * sg[6], d[7] * r * sg[7]);
        *(GAS v4u*)(mix + (size_t)t * DM + h * DV + e0) = o;
    }
}

__device__ __forceinline__ void route_phase(Frame& F, const Args& a) {
    const float* h1 = (const float*)(a.ws + WS_H1); bf16_t* xb = (bf16_t*)(a.ws + WS_XB); bf16_t* x1b = (bf16_t*)(a.ws + WS_X1B);
    int* list = (int*)(a.ws + WS_LIST); int* re = (int*)(a.ws + WS_RE); int* rr = (int*)(a.ws + WS_RR); float* rg = (float*)(a.ws + WS_RG);
    const float *g1 = a.in[12], *b1 = a.in[13], *wr = a.in[14], *br = a.in[15];
    constexpr int XS = 1028;
    LAS float* XT = (LAS float*)(F.lds + RING_OFF);
    LAS float* PT = (LAS float*)(F.lds + RING_OFF + 16 * XS * 4);
    LAS int* lcnt = (LAS int*)(F.lds + REC_OFF); LAS int* lbase = lcnt + 32; LAS int* rec = lcnt + 64;
    const int tid = F.tid, lane = F.lane, w = F.wave, fr = lane & 15, fq = lane >> 4;
    if (tid < 32) lcnt[tid] = 0;
    constexpr int RPB = NTOK / 256;
    const int tblk = blockIdx.x * RPB;
    f32x4 pv[2][4];
#define ROUTE_LOAD(ch_) do { _Pragma("unroll") for (int q = 0; q < 2; ++q) _Pragma("unroll") for (int j = 0; j < 4; ++j) \
        pv[q][j] = *(const GAS f32x4*)(h1 + (size_t)(tblk + (ch_) * 16 + 2 * w + q) * DM + j * 256 + lane * 4); } while (0)
    ROUTE_LOAD(0);
    float bw[32][2];
#pragma unroll
    for (int s = 0; s < 32; ++s)
#pragma unroll
        for (int n = 0; n < 2; ++n) bw[s][n] = wr[(size_t)(128 * w + 4 * s + fq) * NE + 16 * n + fr];
    const int myexp = lane & 31; const float mybr = br[myexp];
    for (int ch = 0; ch < 8; ++ch) {
        const int t0 = tblk + ch * 16;
        {
            float mean[2], rstd[2];
#pragma unroll
            for (int q = 0; q < 2; ++q) { float s = 0.f;
#pragma unroll
                for (int j = 0; j < 4; ++j) s += (pv[q][j].x + pv[q][j].y) + (pv[q][j].z + pv[q][j].w);
                mean[q] = wsum_dpp(s) * (1.0f / DM); }
#pragma unroll
            for (int q = 0; q < 2; ++q) { float q2 = 0.f;
#pragma unroll
                for (int j = 0; j < 4; ++j) { pv[q][j] = pv[q][j] - mean[q]; q2 += (pv[q][j].x * pv[q][j].x + pv[q][j].y * pv[q][j].y) + (pv[q][j].z * pv[q][j].z + pv[q][j].w * pv[q][j].w); }
                rstd[q] = rsqrtf(wsum_dpp(q2) * (1.0f / DM) + LN_EPS); }
#pragma unroll
            for (int j = 0; j < 4; ++j) {
                const int col = j * 256 + lane * 4;
                const f32x4 gq = *(const GAS f32x4*)(g1 + col), bq = *(const GAS f32x4*)(b1 + col);
#pragma unroll
                for (int q = 0; q < 2; ++q) {
                    const int rl = 2 * w + q, t = t0 + rl;
                    const f32x4 o = pv[q][j] * rstd[q] * gq + bq;
                    { v2u pk1; pk1.x = pk2(o.x, o.y); pk1.y = pk2(o.z, o.w); *(GAS v2u*)(x1b + (size_t)t * DM + col) = pk1; }
                    *(LAS f32x4*)(XT + rl * XS + col) = o;
#if MOE_FP8
                    *(GAS unsigned*)((unsigned char*)xb + (size_t)t * DM + col) = pg8::pk4_fp8(o.x, o.y, o.z, o.w);
#else
                    v2u pk; pk.x = pk2(o.x, o.y); pk.y = pk2(o.z, o.w);
                    *(GAS v2u*)(xb + (size_t)t * DM + col) = pk;
#endif
                }
            }
        }
        if (ch < 7) ROUTE_LOAD(ch + 1);
        __syncthreads();
        {
            f32x4 acc0 = (f32x4){0.f, 0.f, 0.f, 0.f}, acc1 = (f32x4){0.f, 0.f, 0.f, 0.f};
            const LAS float* xp = XT + fr * XS + 128 * w + fq;
#pragma unroll
            for (int s = 0; s < 32; ++s) { const float av = xp[4 * s];
                acc0 = __builtin_amdgcn_mfma_f32_16x16x4f32(av, bw[s][0], acc0, 0, 0, 0);
                acc1 = __builtin_amdgcn_mfma_f32_16x16x4f32(av, bw[s][1], acc1, 0, 0, 0); }
#pragma unroll
            for (int r = 0; r < 4; ++r) { PT[(w * 16 + fq * 4 + r) * 32 + fr] = acc0[r]; PT[(w * 16 + fq * 4 + r) * 32 + 16 + fr] = acc1[r]; }
        }
        __syncthreads();
        {
            float cur[2];
#pragma unroll
            for (int q = 0; q < 2; ++q) { cur[q] = mybr;
#pragma unroll
                for (int ww = 0; ww < 8; ++ww) cur[q] += PT[(ww * 16 + 2 * w + q) * 32 + myexp]; }
            int idx[2][4]; float val[2][4];
#pragma unroll
            for (int k = 0; k < 4; ++k)
#pragma unroll
                for (int q = 0; q < 2; ++q) {
                    const float m = wmax_dpp(cur[q]);
                    const int cand = wmin_dpp((cur[q] == m) ? myexp : 99);
                    idx[q][k] = cand; val[q][k] = m; if (myexp == cand) cur[q] = -INFINITY;
                }
#pragma unroll
            for (int q = 0; q < 2; ++q) {
                const int rl = 2 * w + q, t = t0 + rl;
                float ex[4], se = 0.f;
#pragma unroll
                for (int k = 0; k < 4; ++k) { ex[k] = expf(val[q][k] - val[q][0]); se += ex[k]; }
                if (lane < 4) {
                    int e_ = idx[q][0]; float g_ = ex[0];
                    if (lane == 1) { e_ = idx[q][1]; g_ = ex[1]; } else if (lane == 2) { e_ = idx[q][2]; g_ = ex[2]; } else if (lane == 3) { e_ = idx[q][3]; g_ = ex[3]; }
                    const int lr = __hip_atomic_fetch_add(lcnt + e_, 1, __ATOMIC_RELAXED, __HIP_MEMORY_SCOPE_WORKGROUP);
                    rec[(ch * 16 + rl) * 4 + lane] = e_ | (lr << 8);
                    re[t * 4 + lane] = e_; rg[t * 4 + lane] = g_ / se;
                }
            }
        }
    }
#undef ROUTE_LOAD
    __syncthreads();
    if (tid < 32) lbase[tid] = (int)__hip_atomic_fetch_add((unsigned*)(F.ctl + CW_CNT + tid), (unsigned)lcnt[tid], RLX_AGENT);
    __syncthreads();
    { const int rw = tid >> 2, k = tid & 3; const int t = tblk + rw; const int rc = rec[tid]; const int e_ = rc & 255, r_ = lbase[e_] + (rc >> 8);
      rr[t * 4 + k] = r_; list[e_ * NTOK + r_] = t; }
}
__device__ __forceinline__ void build_tab(Frame& F) {
    LAS int* tab = (LAS int*)(F.lds + TAB_OFF);
    if (F.tid < 32) tab[40 + F.tid] = (int)__hip_atomic_load(F.ctl + CW_CNT + F.tid, RLX_AGENT);
    __syncthreads();
    if (F.tid == 0) { int p = 0; for (int e = 0; e < NE; ++e) { tab[e] = p; p += (tab[40 + e] + 255) >> 8; } tab[NE] = p; }
    __syncthreads();
}
__device__ __forceinline__ void combine_phase(Frame& F, const Args& a) {
    const bf16_t* x1 = (const bf16_t*)(a.ws + WS_X1B); const unsigned char* y = (const unsigned char*)(a.ws + WS_Y);
    const int* re = (const int*)(a.ws + WS_RE); const int* rr = (const int*)(a.ws + WS_RR); const float* rg = (const float*)(a.ws + WS_RG);
    float* out = a.out;
    const LAS int* tab = (const LAS int*)(F.lds + TAB_OFF);
    const int lane = F.lane, gw = F.vcu * NWAVES + F.wave, NGW = F.G * NWAVES, c0 = lane * 16;
    f32x4 g2v[4], b2v[4];
#pragma unroll
    for (int j = 0; j < 4; ++j) { g2v[j] = *(const GAS f32x4*)(a.in[20] + c0 + 4 * j); b2v[j] = *(const GAS f32x4*)(a.in[21] + c0 + 4 * j); }
    for (int tt = gw; tt < NTOK; tt += 2 * NGW) {
        float v[2][16];
#pragma unroll
        for (int q = 0; q < 2; ++q) {
            const int t = tt + q * NGW;
            const v4u xa = *(const GAS v4u*)(x1 + (size_t)t * DM + c0), xb_ = *(const GAS v4u*)(x1 + (size_t)t * DM + c0 + 8);
            const unsigned xw[8] = {xa.x, xa.y, xa.z, xa.w, xb_.x, xb_.y, xb_.z, xb_.w};
#pragma unroll
            for (int i = 0; i < 8; ++i) { v[q][2 * i] = ALPHA * bf2f((bf16_t)(xw[i] & 0xffff)); v[q][2 * i + 1] = ALPHA * bf2f((bf16_t)(xw[i] >> 16)); }
#pragma unroll
            for (int k = 0; k < 4; ++k) {
                const int e = re[t * 4 + k], slot = tab[e] * 256 + rr[t * 4 + k]; const float g = rg[t * 4 + k];
#if MOE_FP8
                const v4u yw = *(const GAS v4u*)(y + (size_t)slot * DM + c0); const unsigned yy[4] = {yw.x, yw.y, yw.z, yw.w};
#pragma unroll
                for (int i = 0; i < 4; ++i) { const f32x2 lo = __builtin_amdgcn_cvt_pk_f32_fp8((int)yy[i], false), hi = __builtin_amdgcn_cvt_pk_f32_fp8((int)yy[i], true);
                    v[q][4 * i] = fmaf(g, lo.x, v[q][4 * i]); v[q][4 * i + 1] = fmaf(g, lo.y, v[q][4 * i + 1]); v[q][4 * i + 2] = fmaf(g, hi.x, v[q][4 * i + 2]); v[q][4 * i + 3] = fmaf(g, hi.y, v[q][4 * i + 3]); }
#else
                const v4u ya = *(const GAS v4u*)((const bf16_t*)y + (size_t)slot * DM + c0), yb = *(const GAS v4u*)((const bf16_t*)y + (size_t)slot * DM + c0 + 8);
                const unsigned yy[8] = {ya.x, ya.y, ya.z, ya.w, yb.x, yb.y, yb.z, yb.w};
#pragma unroll
                for (int i = 0; i < 8; ++i) { v[q][2 * i] = fmaf(g, bf2f((bf16_t)(yy[i] & 0xffff)), v[q][2 * i]); v[q][2 * i + 1] = fmaf(g, bf2f((bf16_t)(yy[i] >> 16)), v[q][2 * i + 1]); }
#endif
            }
        }
#pragma unroll
        for (int q = 0; q < 2; ++q) {
            const int t = tt + q * NGW;
            float s = 0.f;
#pragma unroll
            for (int i = 0; i < 16; ++i) s += v[q][i];
            const float mean = wsum_dpp(s) * (1.0f / DM); float q2 = 0.f;
#pragma unroll
            for (int i = 0; i < 16; ++i) { v[q][i] -= mean; q2 += v[q][i] * v[q][i]; }
            const float rstd = rsqrtf(wsum_dpp(q2) * (1.0f / DM) + LN_EPS);
#pragma unroll
            for (int j = 0; j < 4; ++j)
                *(GAS f32x4*)(out + (size_t)t * DM + c0 + 4 * j) = (f32x4){v[q][4 * j] * rstd * g2v[j].x + b2v[j].x, v[q][4 * j + 1] * rstd * g2v[j].y + b2v[j].y, v[q][4 * j + 2] * rstd * g2v[j].z + b2v[j].z, v[q][4 * j + 3] * rstd * g2v[j].w + b2v[j].w};
        }
    }
}

constexpr int N_PHASES = 9;
__global__ void __launch_bounds__(NWAVES * 64, 2) mega_fwd(Args args) {
    extern __shared__ __attribute__((aligned(16))) unsigned char lds[];
    Frame F;
    F.lds = (LAS unsigned char*)lds;
    F.MISC = (volatile LAS unsigned*)(F.lds + MISC_OFF);
    F.tid = threadIdx.x; F.lane = F.tid & 63; F.wave = __builtin_amdgcn_readfirstlane(F.tid >> 6);
    F.G = gridDim.x; { const int bx = blockIdx.x; F.vcu = (F.G % 8 == 0) ? (bx % 8) * (F.G / 8) + bx / 8 : bx; }
    F.ctl = (gu32*)(args.ws + WS_CTL);
    for (int u = F.tid; u < (LDS_BYTES - LDSCTL_OFF) / 4; u += NWAVES * 64) ((LAS unsigned*)(F.lds + LDSCTL_OFF))[u] = 0u;
    __syncthreads();
    const int lo = args.ph_lo, hi = args.ph_hi;
    const bool multi = (hi - lo) > 1;
    XcdBarrier bar; bar.bar = (unsigned*)(F.ctl + CW_BAR); bar.x = 0; bar.st = nullptr;
    if (multi) bar = xcd_barrier_post((unsigned*)(F.ctl + CW_BAR), F.MISC + 8);
#ifndef PH_MASK
#define PH_MASK 0x1FF
#endif
#define IN(k) ((((PH_MASK) >> (k)) & 1) && lo <= (k) && (k) < hi)
#define SEAM(k) do { if (IN(k) && IN((k) + 1)) xcd_barrier(bar); } while (0)
#ifndef DOUBLE_MASK
#define DOUBLE_MASK 0
#endif
#define REP(k) for (int rep_ = 0; rep_ < ((((DOUBLE_MASK) >> (k)) & 1) + 1); ++rep_)
    if (IN(0)) { REP(0) { refresh_frame(F); const Args A = fetch_args(); p0_prologue(F, A); } SEAM(0); }
    if (IN(1)) { REP(1) {
        refresh_frame(F); const Args A = fetch_args(); unsigned char* ws = A.ws;
        pg8::Gemm g{(const bf16_t*)(ws + WS_XB), (const bf16_t*)(ws + WS_WIN), NTOK, INW, DM, 0}; pg8::StaticOrder S; S.init(NTOK, INW, F.G, (int)blockIdx.x);
        pg8::EpiProj E{(bf16_t*)(ws + WS_PROJ)};
        pg8::gemm_phase<pg8::EpiProj, pg8::StaticOrder, false>(F.lds + RING_OFF, g, S, E);
        } SEAM(1);
    }
    if (IN(2)) { REP(2) {
        refresh_frame(F); const Args A = fetch_args(); unsigned char* ws = A.ws;
#ifndef P2_REP_SUB
#define P2_REP_SUB 3
#endif
        const int sub_ = (rep_ == 0) ? A.pad0 : (A.pad0 & P2_REP_SUB);
        if (sub_ & 1) { const float lam = expf(wave_sum(A.in[2][F.lane] * A.in[3][F.lane])) - expf(wave_sum(A.in[4][F.lane] * A.in[5][F.lane])) + LAMBDA_INIT;
#if CONV_IN_ATTN
            {
                const int vcu = F.vcu, bh = vcu >> 3, s8 = vcu & 7, b = bh >> 2, h = bh & 3;
                const attn_body::bf16* P0 = (const attn_body::bf16*)(ws + WS_PROJ) + (long)b * SEQ * INW; attn_body::bf16* O0 = (attn_body::bf16*)(ws + WS_MIX) + (long)b * SEQ * DM + h * 128;
                for (int i = 0; i < 4; ++i) { const int qb = (i < 2) ? (15 - s8) : s8, st = i & 1;
                    attn_body::attn_unit<8>(qb, st, lam, A.in[6], P0 + C_Q + st * 256 + h * 64, P0 + C_K + st * 256 + h * 64, P0 + C_V + h * 128, O0, (char*)lds + RING_OFF);
                    if (rep_ == 0 && i < 3) { moe_weight_items(F, A, 8 * i, 8); __syncthreads(); } }
            }
#else
            attn_body::attn_phase<8>((char*)lds + RING_OFF, (const bf16_t*)(ws + WS_PROJ), (bf16_t*)(ws + WS_MIX), F.vcu, lam, A.in[6]);
#endif
            }
        if (sub_ & 2) gmlp_phase(F, A);
        }
    }
    if (IN(3)) { SEAM(3); }
    if (IN(4)) { REP(4) {
        refresh_frame(F); const Args A = fetch_args(); unsigned char* ws = A.ws;
        pg8::Gemm g{(const bf16_t*)(ws + WS_MIX), (const bf16_t*)(ws + WS_WO), NTOK, DM, DM, 0}; pg8::StaticOrder S; S.init(NTOK, DM, F.G, (int)blockIdx.x);
        pg8::EpiH1 E{A.in[0], (float*)(ws + WS_H1)};
        pg8::gemm_phase<pg8::EpiH1, pg8::StaticOrder, false>(F.lds + RING_OFF, g, S, E);
        } SEAM(4);
    }
    if (IN(5)) { REP(5) { refresh_frame(F); const Args A = fetch_args(); route_phase(F, A); } SEAM(5); }
    if (IN(6)) { REP(6) {
        refresh_frame(F); const Args A = fetch_args(); unsigned char* ws = A.ws;
        build_tab(F);
        pg8::MoeOrder S; S.init((const LAS int*)(F.lds + TAB_OFF), (const int*)(ws + WS_LIST), 8, (int)blockIdx.x);
#if MOE_FP8
        pg8::Gemm g{(const bf16_t*)(ws + WS_XB), (const bf16_t*)(ws + WS_WUP), PADROWS, 2 * DFF, DM, (size_t)2 * DFF * DM / 2};
        pg8::EpiSwiglu8 E{(unsigned char*)(ws + WS_ACT), A.in[17]};
        pg8::gemm_phase<pg8::EpiSwiglu8, pg8::MoeOrder, true, true>(F.lds + RING_OFF, g, S, E);
#else
        pg8::Gemm g{(const bf16_t*)(ws + WS_XB), (const bf16_t*)(ws + WS_WUP), PADROWS, 2 * DFF, DM, (size_t)2 * DFF * DM};
        pg8::EpiSwiglu E{(bf16_t*)(ws + WS_ACT), A.in[17]};
        pg8::gemm_phase<pg8::EpiSwiglu, pg8::MoeOrder, true>(F.lds + RING_OFF, g, S, E);
#endif
        } SEAM(6);
    }
    if (IN(7)) { REP(7) {
        refresh_frame(F); const Args A = fetch_args(); unsigned char* ws = A.ws;
        build_tab(F);
        pg8::MoeOrder S; S.init((const LAS int*)(F.lds + TAB_OFF), (const int*)(ws + WS_LIST), 4, (int)blockIdx.x);
#if MOE_FP8
        pg8::EpiDown8 E{(unsigned char*)(ws + WS_Y), A.in[19]};
        pg8::Gemm g{(const bf16_t*)(ws + WS_ACT), (const bf16_t*)(ws + WS_WDN), PADROWS, DM, DFF, (size_t)DM * DFF / 2};
        pg8::gemm_phase<pg8::EpiDown8, pg8::MoeOrder, false, true>(F.lds + RING_OFF, g, S, E);
#else
        pg8::EpiDown E{(bf16_t*)(ws + WS_Y), A.in[19]};
        pg8::Gemm g{(const bf16_t*)(ws + WS_ACT), (const bf16_t*)(ws + WS_WDN), PADROWS, DM, DFF, (size_t)DM * DFF};
        pg8::gemm_phase<pg8::EpiDown, pg8::MoeOrder, false>(F.lds + RING_OFF, g, S, E);
#endif
        } SEAM(7);
    }
    if (IN(8)) { REP(8) { refresh_frame(F); const Args A = fetch_args(); build_tab(F); combine_phase(F, A); } }
#undef IN
#undef SEAM
}

struct NArgs {
    const float* x; const float* B; const float* bias; const float* bias2;
    const bf16_t* Ab; bf16_t* Ob; float* Of; const int* ctl; const int* list;
};
template <int MODE> __global__ void __launch_bounds__(256) ngemm(NArgs a) {
    constexpr int K = 1024;
    constexpr int LDB = (MODE == 0) ? INW : (MODE == 2 ? 2048 : 1024);
    constexpr bool DUAL = (MODE == 2);
    __shared__ float As[16][68];
    __shared__ float Bs[16][64];
    __shared__ float Bs2[DUAL ? 16 : 1][64];
    const int tid = threadIdx.x, ty = tid >> 4, tx = tid & 15;
    const int row0 = blockIdx.y * 64, col0 = blockIdx.x * 64;
    const float* B = a.B; int e = 0, pst = 0, cnt = 0;
    if (MODE >= 2) {
        const int* ps = a.ctl + CW_PSTART;
        while (e < NE && row0 >= ps[e + 1]) ++e;
        if (e >= NE) return;
        pst = ps[e]; cnt = a.ctl[CW_CNT + e];
        B += (size_t)e * K * LDB;
    }
    const int ar = tid >> 2, ak = (tid & 3) * 4;
    const float* arow_f = nullptr; const bf16_t* arow_b = nullptr;
    if (MODE == 0) arow_f = a.x + (size_t)(row0 + ar) * K;
    else if (MODE == 1 || MODE == 3) arow_b = a.Ab + (size_t)(row0 + ar) * K;
    else { const int r = row0 + ar - pst; const int tok = (r < cnt) ? a.list[e * NTOK + r] : 0; arow_b = a.Ab + (size_t)tok * K; }
    const int bk = tid >> 4, bn = (tid & 15) * 4;
    float acc[4][4], acc2[4][4];
#pragma unroll
    for (int i = 0; i < 4; ++i)
#pragma unroll
        for (int j = 0; j < 4; ++j) { acc[i][j] = 0.f; acc2[i][j] = 0.f; }
    for (int k0 = 0; k0 < K; k0 += 16) {
        float av[4];
        if (MODE == 0) { const float4 t = *(const float4*)(arow_f + k0 + ak); av[0] = t.x; av[1] = t.y; av[2] = t.z; av[3] = t.w; }
        else { const uint2 t = *(const uint2*)(arow_b + k0 + ak); av[0] = bf2f((bf16_t)(t.x & 0xffff)); av[1] = bf2f((bf16_t)(t.x >> 16)); av[2] = bf2f((bf16_t)(t.y & 0xffff)); av[3] = bf2f((bf16_t)(t.y >> 16)); }
        const float4 bv = *(const float4*)(B + (size_t)(k0 + bk) * LDB + col0 + bn);
        float4 bv2 = bv;
        if (DUAL) bv2 = *(const float4*)(B + (size_t)(k0 + bk) * LDB + 1024 + col0 + bn);
        __syncthreads();
#pragma unroll
        for (int c = 0; c < 4; ++c) As[ak + c][ar] = av[c];
        *(float4*)&Bs[bk][bn] = bv;
        if (DUAL) *(float4*)&Bs2[bk][bn] = bv2;
        __syncthreads();
#pragma unroll
        for (int k = 0; k < 16; ++k) {
            const float4 a4 = *(const float4*)&As[k][ty * 4];
            const float4 b4 = *(const float4*)&Bs[k][tx * 4];
            const float aa[4] = {a4.x, a4.y, a4.z, a4.w}, bb[4] = {b4.x, b4.y, b4.z, b4.w};
#pragma unroll
            for (int i = 0; i < 4; ++i)
#pragma unroll
                for (int j = 0; j < 4; ++j) acc[i][j] = fmaf(aa[i], bb[j], acc[i][j]);
            if (DUAL) {
                const float4 c4 = *(const float4*)&Bs2[k][tx * 4];
                const float cc[4] = {c4.x, c4.y, c4.z, c4.w};
#pragma unroll
                for (int i = 0; i < 4; ++i)
#pragma unroll
                    for (int j = 0; j < 4; ++j) acc2[i][j] = fmaf(aa[i], cc[j], acc2[i][j]);
            }
        }
    }
#pragma unroll
    for (int i = 0; i < 4; ++i) {
        const int row = row0 + ty * 4 + i;
#pragma unroll
        for (int j = 0; j < 4; ++j) {
            const int col = col0 + tx * 4 + j;
            if (MODE == 0) { float v = acc[i][j]; if (col < C_K) v *= QSCALE; a.Ob[(size_t)row * INW + col] = f2bf(v); }
            else if (MODE == 1) { a.Of[(size_t)row * DM + col] = ALPHA * a.x[(size_t)row * DM + col] + acc[i][j]; }
            else if (MODE == 2) {
                float g = acc[i][j] + a.bias[e * 2048 + col], l = acc2[i][j] + a.bias[e * 2048 + 1024 + col];
                g = fminf(g, 7.0f); l = fminf(fmaxf(l, -7.0f), 7.0f);
                const float act = (l + 1.0f) * g * (1.0f / (1.0f + expf(-1.702f * g)));
                a.Ob[(size_t)row * DFF + col] = f2bf(act);
            } else { a.Ob[(size_t)row * DM + col] = f2bf(acc[i][j] + a.bias[e * DM + col]); }
        }
    }
}

__global__ void __launch_bounds__(128) nattn(const bf16_t* __restrict__ proj, bf16_t* __restrict__ mix, const float* lq1, const float* lk1, const float* lq2, const float* lk2, const float* subg) {
    __shared__ float sc[2][SEQ];
    const int w = threadIdx.x >> 6, lane = threadIdx.x & 63;
    const int task = blockIdx.x * 2 + w, t = task >> 2, h = task & 3, b = t / SEQ, qpos = t % SEQ;
    const float lam = expf(wave_sum(lq1[lane] * lk1[lane])) - expf(wave_sum(lq2[lane] * lk2[lane])) + LAMBDA_INIT;
    const bf16_t* pb = proj + (size_t)b * SEQ * INW;
    float o[2][2];
    for (int s = 0; s < 2; ++s) {
        float q[DH];
        const bf16_t* qp = proj + (size_t)t * INW + C_Q + s * 256 + h * DH;
#pragma unroll
        for (int d = 0; d < DH; ++d) q[d] = bf2f(qp[d]);
        float m = -INFINITY;
        for (int j = lane; j <= qpos; j += 64) {
            const uint4* kp = (const uint4*)(pb + (size_t)j * INW + C_K + s * 256 + h * DH);
            float acc = 0.f;
#pragma unroll
            for (int c = 0; c < 8; ++c) {
                const uint4 kk = kp[c];
                const uint32_t ww[4] = {kk.x, kk.y, kk.z, kk.w};
#pragma unroll
                for (int z = 0; z < 4; ++z) { acc = fmaf(q[c * 8 + 2 * z], bf2f((bf16_t)(ww[z] & 0xffff)), acc); acc = fmaf(q[c * 8 + 2 * z + 1], bf2f((bf16_t)(ww[z] >> 16)), acc); }
            }
            sc[w][j] = acc; m = fmaxf(m, acc);
        }
        m = wave_max(m);
        float l = 0.f;
        for (int j = lane; j <= qpos; j += 64) { const float p = exp2f(sc[w][j] - m); sc[w][j] = p; l += p; }
        l = wave_sum(l);
        __syncthreads();
        float o0 = 0.f, o1 = 0.f;
        const bf16_t* vp = pb + C_V + h * DV + lane * 2;
        for (int j = 0; j <= qpos; ++j) {
            const float p = sc[w][j];
            const uint32_t vv = *(const uint32_t*)(vp + (size_t)j * INW);
            o0 = fmaf(p, bf2f((bf16_t)(vv & 0xffff)), o0); o1 = fmaf(p, bf2f((bf16_t)(vv >> 16)), o1);
        }
        o[s][0] = o0 / l; o[s][1] = o1 / l;
        __syncthreads();
    }
    const float d0 = o[0][0] - lam * o[1][0], d1 = o[0][1] - lam * o[1][1];
    const float ss = wave_sum(d0 * d0 + d1 * d1);
    const float r = rsqrtf(ss * (1.0f / DV) + LN_EPS) * (1.0f - LAMBDA_INIT);
    const uint32_t pk = (uint32_t)f2bf(d0 * r * subg[lane * 2]) | ((uint32_t)f2bf(d1 * r * subg[lane * 2 + 1]) << 16);
    *(uint32_t*)(mix + (size_t)t * DM + h * DV + lane * 2) = pk;
}

__global__ void __launch_bounds__(256) ngmlp(const bf16_t* __restrict__ proj, bf16_t* __restrict__ mix, const float* lng, const float* lnb, const float* wsp, const float* bsp) {
    __shared__ float mu[CHUNK], rs[CHUNK];
    __shared__ float vn[CHUNK][GD];
    const int c = blockIdx.x, g = blockIdx.y, tid = threadIdx.x, w = tid >> 6, lane = tid & 63;
    const size_t row0 = (size_t)c * CHUNK;
    for (int s = w; s < CHUNK; s += 4) {
        const bf16_t* p = proj + (row0 + s) * INW + C_GV;
        float v[8]; float sum = 0.f;
#pragma unroll
        for (int i = 0; i < 8; ++i) { v[i] = gelu_exact(bf2f(p[lane + 64 * i])); sum += v[i]; }
        const float mean = wave_sum(sum) * (1.0f / GW); float q = 0.f;
#pragma unroll
        for (int i = 0; i < 8; ++i) { const float d = v[i] - mean; q += d * d; }
        const float var = wave_sum(q) * (1.0f / GW);
        if (lane == 0) { mu[s] = mean; rs[s] = rsqrtf(var + LN_EPS); }
    }
    __syncthreads();
    for (int i = tid; i < CHUNK * GD; i += 256) {
        const int s = i >> 6, d = i & 63, col = g * GD + d;
        const float v = gelu_exact(bf2f(proj[(row0 + s) * INW + C_GV + col]));
        vn[s][d] = (v - mu[s]) * rs[s] * lng[col] + lnb[col];
    }
    __syncthreads();
    const int t = tid >> 1, dh = (tid & 1) * 32;
    float z[32];
#pragma unroll
    for (int d = 0; d < 32; ++d) z[d] = 0.f;
    const float* wr = wsp + ((size_t)g * CHUNK + t) * CHUNK;
    for (int s = 0; s <= t; ++s) {
        const float wv = wr[s];
#pragma unroll
        for (int d = 0; d < 32; ++d) z[d] = fmaf(wv, vn[s][dh + d], z[d]);
    }
    const float bb = bsp[g * CHUNK + t];
#pragma unroll
    for (int d = 0; d < 32; ++d) {
        const int col = g * GD + dh + d;
        const float u = gelu_exact(bf2f(proj[(row0 + t) * INW + C_GU + col]));
        mix[(row0 + t) * DM + GW + col] = f2bf(u * (z[d] + bb));
    }
}

__global__ void __launch_bounds__(256) nroute(float* __restrict__ h1, bf16_t* __restrict__ xb, const float* g1, const float* b1, const float* wr, const float* br, int* ctl, int* list, int* re, int* rr, float* rg) {
    const int w = threadIdx.x >> 6, lane = threadIdx.x & 63, t = blockIdx.x * 4 + w;
    float* row = h1 + (size_t)t * DM;
    float v[16]; float s = 0.f;
#pragma unroll
    for (int j = 0; j < 4; ++j) { const float4 q = *(const float4*)(row + j * 256 + lane * 4); v[4 * j] = q.x; v[4 * j + 1] = q.y; v[4 * j + 2] = q.z; v[4 * j + 3] = q.w; s += (q.x + q.y) + (q.z + q.w); }
    const float mean = wave_sum(s) * (1.0f / DM); float q2 = 0.f;
#pragma unroll
    for (int i = 0; i < 16; ++i) { v[i] -= mean; q2 += v[i] * v[i]; }
    const float rstd = rsqrtf(wave_sum(q2) * (1.0f / DM) + LN_EPS);
#pragma unroll
    for (int j = 0; j < 4; ++j) {
        const int col = j * 256 + lane * 4;
#pragma unroll
        for (int c = 0; c < 4; ++c) v[4 * j + c] = v[4 * j + c] * rstd * g1[col + c] + b1[col + c];
        *(float4*)(row + col) = make_float4(v[4 * j], v[4 * j + 1], v[4 * j + 2], v[4 * j + 3]);
        uint2 pk; pk.x = (uint32_t)f2bf(v[4 * j]) | ((uint32_t)f2bf(v[4 * j + 1]) << 16); pk.y = (uint32_t)f2bf(v[4 * j + 2]) | ((uint32_t)f2bf(v[4 * j + 3]) << 16);
        *(uint2*)(xb + (size_t)t * DM + col) = pk;
    }
    float lg[NE];
#pragma unroll
    for (int e = 0; e < NE; ++e) lg[e] = 0.f;
#pragma unroll
    for (int j = 0; j < 4; ++j)
#pragma unroll
        for (int c = 0; c < 4; ++c) {
            const float xv = v[4 * j + c]; const float4* wp = (const float4*)(wr + (size_t)(j * 256 + lane * 4 + c) * NE);
#pragma unroll
            for (int e4 = 0; e4 < 8; ++e4) { const float4 ww = wp[e4]; lg[4 * e4] = fmaf(xv, ww.x, lg[4 * e4]); lg[4 * e4 + 1] = fmaf(xv, ww.y, lg[4 * e4 + 1]); lg[4 * e4 + 2] = fmaf(xv, ww.z, lg[4 * e4 + 2]); lg[4 * e4 + 3] = fmaf(xv, ww.w, lg[4 * e4 + 3]); }
        }
#pragma unroll
    for (int e = 0; e < NE; ++e) lg[e] = wave_sum(lg[e]) + br[e];
    int idx[4]; float val[4]; unsigned taken = 0u;
#pragma unroll
    for (int k = 0; k < 4; ++k) {
        float best = -INFINITY; int bi = 0;
#pragma unroll
        for (int e = 0; e < NE; ++e) { const bool ok = !((taken >> e) & 1u) && lg[e] > best; best = ok ? lg[e] : best; bi = ok ? e : bi; }
        idx[k] = bi; val[k] = best; taken |= 1u << bi;
    }
    float ex[4], se = 0.f;
#pragma unroll
    for (int k = 0; k < 4; ++k) { ex[k] = expf(val[k] - val[0]); se += ex[k]; }
    if (lane == 0) {
#pragma unroll
        for (int k = 0; k < 4; ++k) {
            const int r = atomicAdd(ctl + CW_CNT + idx[k], 1);
            list[idx[k] * NTOK + r] = t;
            re[t * 4 + k] = idx[k]; rr[t * 4 + k] = r; rg[t * 4 + k] = ex[k] / se;
        }
    }
}
__global__ void npstart(int* ctl) {
    if (threadIdx.x == 0 && blockIdx.x == 0) { int p = 0; for (int e = 0; e < NE; ++e) { ctl[CW_PSTART + e] = p; p += ((ctl[CW_CNT + e] + 255) / 256) * 256; } ctl[CW_PSTART + NE] = p; }
}
__global__ void __launch_bounds__(256) ncombine(const float* __restrict__ x1, const bf16_t* __restrict__ y, const int* ctl, const int* re, const int* rr, const float* rg, const float* g2, const float* b2, float* __restrict__ out) {
    const int w = threadIdx.x >> 6, lane = threadIdx.x & 63, t = blockIdx.x * 4 + w;
    float v[16];
#pragma unroll
    for (int j = 0; j < 4; ++j) { const float4 q = *(const float4*)(x1 + (size_t)t * DM + j * 256 + lane * 4); v[4 * j] = ALPHA * q.x; v[4 * j + 1] = ALPHA * q.y; v[4 * j + 2] = ALPHA * q.z; v[4 * j + 3] = ALPHA * q.w; }
#pragma unroll
    for (int k = 0; k < 4; ++k) {
        const int e = re[t * 4 + k], slot = ctl[CW_PSTART + e] + rr[t * 4 + k]; const float g = rg[t * 4 + k];
        const bf16_t* yr = y + (size_t)slot * DM;
#pragma unroll
        for (int j = 0; j < 4; ++j) { const uint2 pk = *(const uint2*)(yr + j * 256 + lane * 4);
            v[4 * j] = fmaf(g, bf2f((bf16_t)(pk.x & 0xffff)), v[4 * j]); v[4 * j + 1] = fmaf(g, bf2f((bf16_t)(pk.x >> 16)), v[4 * j + 1]);
            v[4 * j + 2] = fmaf(g, bf2f((bf16_t)(pk.y & 0xffff)), v[4 * j + 2]); v[4 * j + 3] = fmaf(g, bf2f((bf16_t)(pk.y >> 16)), v[4 * j + 3]); }
    }
    float s = 0.f;
#pragma unroll
    for (int i = 0; i < 16; ++i) s += v[i];
    const float mean = wave_sum(s) * (1.0f / DM); float q2 = 0.f;
#pragma unroll
    for (int i = 0; i < 16; ++i) { v[i] -= mean; q2 += v[i] * v[i]; }
    const float rstd = rsqrtf(wave_sum(q2) * (1.0f / DM) + LN_EPS);
#pragma unroll
    for (int j = 0; j < 4; ++j) { const int col = j * 256 + lane * 4;
        *(float4*)(out + (size_t)t * DM + col) = make_float4(v[4 * j] * rstd * g2[col] + b2[col], v[4 * j + 1] * rstd * g2[col + 1] + b2[col + 1], v[4 * j + 2] * rstd * g2[col + 2] + b2[col + 2], v[4 * j + 3] * rstd * g2[col + 3] + b2[col + 3]); }
}

#ifndef OPT_MASK
#define OPT_MASK 0x1FF
#endif
#ifndef FUSED
#define FUSED 0
#endif
static void launch_mega(const Args& base, int lo, int hi, int sub, hipStream_t stream) {
    Args a = base; a.ph_lo = lo; a.ph_hi = hi; a.pad0 = sub; a.pad1 = 0;
    hipLaunchKernelGGL(mega_fwd, dim3(256), dim3(NWAVES * 64), LDS_BYTES, stream, a);
}
extern "C" void kernel_launch(void* const* d_in, const int* in_sizes, int n_in, void* d_out, int out_size, void* d_ws, size_t ws_size, hipStream_t stream) {
    static int ready = 0;
    if (ready == 0) {
        if (n_in != 22 || in_sizes[0] != NTOK * DM || out_size != NTOK * DM || ws_size < WS_END) { fprintf(stderr, "kernel_launch: unexpected shapes (n_in %d, in0 %d, out %d, ws %zu)\n", n_in, n_in > 0 ? in_sizes[0] : -1, out_size, ws_size); ready = -1; return; }
        if (hipFuncSetAttribute((const void*)mega_fwd, hipFuncAttributeMaxDynamicSharedMemorySize, LDS_BYTES) != hipSuccess) { fprintf(stderr, "kernel_launch: hipFuncSetAttribute failed\n"); ready = -1; return; }
        ready = 1;
    }
    if (ready < 0) return;
    const float* x = (const float*)d_in[0]; const float* w_in = (const float*)d_in[1];
    const float *lq1 = (const float*)d_in[2], *lk1 = (const float*)d_in[3], *lq2 = (const float*)d_in[4], *lk2 = (const float*)d_in[5];
    const float *subg = (const float*)d_in[6], *glng = (const float*)d_in[7], *glnb = (const float*)d_in[8], *wsp = (const float*)d_in[9], *bsp = (const float*)d_in[10];
    const float *w_o = (const float*)d_in[11], *ln1g = (const float*)d_in[12], *ln1b = (const float*)d_in[13], *w_r = (const float*)d_in[14], *b_r = (const float*)d_in[15];
    const float *w_up = (const float*)d_in[16], *b_up = (const float*)d_in[17], *w_dn = (const float*)d_in[18], *b_dn = (const float*)d_in[19], *ln2g = (const float*)d_in[20], *ln2b = (const float*)d_in[21];
    unsigned char* ws = (unsigned char*)d_ws;
    int* ctl = (int*)(ws + WS_CTL); int* list = (int*)(ws + WS_LIST); int* re = (int*)(ws + WS_RE); int* rr = (int*)(ws + WS_RR); float* rg = (float*)(ws + WS_RG);
    bf16_t* xb = (bf16_t*)(ws + WS_XB); bf16_t* proj = (bf16_t*)(ws + WS_PROJ); bf16_t* mix = (bf16_t*)(ws + WS_MIX); bf16_t* yb = (bf16_t*)(ws + WS_Y);
    float* h1 = (float*)(ws + WS_H1); bf16_t* act = (bf16_t*)(ws + WS_ACT);
    (void)hipMemsetAsync(ws + WS_CTL, 0, CTL_BYTES, stream);
    Args base{};
    for (int i = 0; i < 22; ++i) base.in[i] = (const float*)d_in[i];
    base.out = (float*)d_out; base.ws = ws;
    constexpr unsigned OM = OPT_MASK;
#if FUSED
    static_assert(OM == 0x1FFu, "FUSED needs every stage in the persistent kernel");
    launch_mega(base, 0, N_PHASES, 3, stream);
#else
    if (OM & 0xD3u) launch_mega(base, 0, 1, 0, stream);
    if (OM & 2u) launch_mega(base, 1, 2, 0, stream);
    else { NArgs a{}; a.x = x; a.B = w_in; a.Ob = proj; ngemm<0><<<dim3(INW / 64, NTOK / 64), 256, 0, stream>>>(a); }
    if ((OM & 4u) || (OM & 8u)) launch_mega(base, 2, 3, ((OM & 4u) ? 1 : 0) | ((OM & 8u) ? 2 : 0), stream);
    if (OM & 4u) launch_mega(base, 3, 4, 0, stream);
    else nattn<<<NTOK * NH / 2, 128, 0, stream>>>(proj, mix, lq1, lk1, lq2, lk2, subg);
    if (!(OM & 8u)) ngmlp<<<dim3(NTOK / CHUNK, NG), 256, 0, stream>>>(proj, mix, glng, glnb, wsp, bsp);
    if (OM & 16u) launch_mega(base, 4, 5, 0, stream);
    else { NArgs a{}; a.x = x; a.B = w_o; a.Ab = mix; a.Of = h1; ngemm<1><<<dim3(DM / 64, NTOK / 64), 256, 0, stream>>>(a); }
    if (OM & 32u) launch_mega(base, 5, 6, 0, stream);
    else nroute<<<NTOK / 4, 256, 0, stream>>>(h1, xb, ln1g, ln1b, w_r, b_r, ctl, list, re, rr, rg);
    if ((OM & 0x1C0u) != 0x1C0u) npstart<<<1, 64, 0, stream>>>(ctl);
    if (OM & 64u) launch_mega(base, 6, 7, 0, stream);
    else { NArgs a{}; a.B = w_up; a.bias = b_up; a.Ab = xb; a.Ob = act; a.ctl = ctl; a.list = list; ngemm<2><<<dim3(DFF / 64, PADROWS / 64), 256, 0, stream>>>(a); }
    if (OM & 128u) launch_mega(base, 7, 8, 0, stream);
    else { NArgs a{}; a.B = w_dn; a.bias = b_dn; a.Ab = act; a.Ob = yb; a.ctl = ctl; a.list = list; ngemm<3><<<dim3(DM / 64, PADROWS / 64), 256, 0, stream>>>(a); }
    if (OM & 256u) launch_mega(base, 8, 9, 0, stream);
    else ncombine<<<NTOK / 4, 256, 0, stream>>>(h1, yb, ctl, re, rr, rg, ln2g, ln2b, (float*)d_out);
#endif
}
```

```cpp
#include <hip/hip_runtime.h>
#include <hip/hip_bf16.h>
#include <cstdint>
#include <cstdio>
#include <cmath>

#ifndef MOE_FP8
#define MOE_FP8 1
#endif
#ifndef CONV_IN_ATTN
#define CONV_IN_ATTN 1
#endif
#ifndef OUTPROJ_FP8
#define OUTPROJ_FP8 1
#endif
namespace cfg {
constexpr int BATCH = 8, SEQ = 4096, NTOK = BATCH * SEQ, DM = 1024;
constexpr int INW = 2560, NH = 4, DH = 64, DV = 128;
constexpr int C_Q = 0, C_K = 512, C_V = 1024, C_GU = 1536, C_GV = 2048;
constexpr int GW = 512, NG = 8, GD = 64, CHUNK = 128;
constexpr int NE = 32, TOPK = 4, DFF = 1024;
constexpr int PADROWS = 139264;
constexpr float LN_EPS = 1e-5f;
constexpr float ALPHA = 1.189207115002721f;
constexpr float LAMBDA_INIT = 0.2f;
constexpr float QSCALE = 0.125f * 1.4426950408889634f;
constexpr size_t MiB = 1u << 20;
constexpr size_t WS_CTL = 0, CTL_BYTES = 1 * MiB;
constexpr size_t WS_LIST = 1 * MiB;
constexpr size_t WS_RE = 5 * MiB, WS_RR = 5 * MiB + 512 * 1024, WS_RG = 6 * MiB;
constexpr size_t WS_WIN = 8 * MiB;
constexpr size_t WS_WO = 13 * MiB;
constexpr size_t WS_WUP = 16 * MiB;
constexpr size_t WS_WDN = 144 * MiB;
constexpr size_t WS_X1B = 80 * MiB;
constexpr size_t WS_XB = 208 * MiB;
constexpr size_t WS_PROJ = 272 * MiB;
constexpr size_t WS_MIX = 432 * MiB;
constexpr size_t WS_ATTO = 496 * MiB;
constexpr size_t WS_Y = 272 * MiB;
constexpr size_t WS_H1 = 560 * MiB;
constexpr size_t WS_ACT = 688 * MiB;
constexpr size_t WS_END = 960 * MiB;
constexpr int CW_CNT = 0;
constexpr int CW_PSTART = 64;
constexpr int CW_BAR = 4096;
}
using namespace cfg;
typedef uint16_t bf16_t;

__device__ __forceinline__ float bf2f(bf16_t b) { return __uint_as_float((uint32_t)b << 16); }
__device__ __forceinline__ bf16_t f2bf(float f) { uint32_t u = __float_as_uint(f); u += 0x7fffu + ((u >> 16) & 1u); return (bf16_t)(u >> 16); }
typedef float pk2_f32x2_t __attribute__((ext_vector_type(2))); typedef __bf16 pk2_bf16x2_t __attribute__((ext_vector_type(2)));
__device__ __forceinline__ uint32_t pk2(float lo, float hi) { pk2_f32x2_t v = {lo, hi}; pk2_bf16x2_t b = __builtin_convertvector(v, pk2_bf16x2_t); return __builtin_bit_cast(uint32_t, b); }
__device__ __forceinline__ float wave_sum(float v) {
#pragma unroll
    for (int o = 1; o < 64; o <<= 1) v += __shfl_xor(v, o);
    return v;
}
__device__ __forceinline__ float wave_max(float v) {
#pragma unroll
    for (int o = 1; o < 64; o <<= 1) v = fmaxf(v, __shfl_xor(v, o));
    return v;
}
__device__ __forceinline__ float gelu_exact(float x) { return 0.5f * x * (1.0f + erff(x * 0.70710678118654752f)); }

#define OPT_MASK 0x1FF
#define FUSED 1
#define DOUBLE_MASK 0
#define P2_REP_SUB 3
namespace pg8 {
#define PG8_LAS __attribute__((address_space(3)))
typedef short bf16x8 __attribute__((ext_vector_type(8)));
typedef float f32x4 __attribute__((ext_vector_type(4)));
typedef float f32x2 __attribute__((ext_vector_type(2)));
typedef unsigned u32x4 __attribute__((ext_vector_type(4)));
typedef int v4i_t __attribute__((ext_vector_type(4)));
typedef int v8i_t __attribute__((ext_vector_type(8)));
constexpr int WSHIFT = 6;
#if defined(PROBE_DOUBLE_MFMA)
constexpr float WUNSCALE = 0.5f / (float)(1 << WSHIFT);
#else
constexpr float WUNSCALE = 1.0f / (float)(1 << WSHIFT);
#endif
constexpr int BM = 256, BK = 64, HALF = 128, HTB = HALF * BK * 2  , STAGE_BYTES = 8 * HTB, NXCD = 8, WGM = 8;

__host__ __device__ __forceinline__ int lds_byte(int r, int c) { const int st = (r >> 4) * 2 + (c >> 5), rr = r & 15, cc = c & 31, ob = rr * 64 + cc * 2; return st * 1024 + (ob ^ (((ob >> 9) & 1) << 5)); }
__host__ __device__ __forceinline__ void stage_rc(int b, int& R, int& C) { const int st = b / 1024, sb = b % 1024, swz = sb ^ (((sb >> 9) & 1) << 5); R = (st >> 1) * 16 + swz / 64; C = (st & 1) * 32 + (swz % 64) / 2; }
__host__ __device__ __forceinline__ int perm32(int rho) { const int n = rho >> 4, i = rho & 15; return 8 * (i >> 2) + 4 * n + (i & 3); }

struct Unit { int pm, pn, e; };
struct Gemm { const bf16_t* A; const bf16_t* Bt; int M, N, K; size_t strideB; };

struct StaticOrder {
    int nM, nN, nwg, G, c;
    __host__ __device__ void init(int M, int N, int G_, int c_) { nM = M / BM; nN = N / BM; nwg = nM * nN; G = G_; c = c_; }
    __host__ __device__ bool next(int i, Unit& u) const {
        const long L = (long)i * G + c; if (L >= nwg) return false;
        int wgid = (int)L; { const int q = nwg / NXCD, r = nwg % NXCD, xcd = wgid % NXCD, off = wgid / NXCD; wgid = (xcd < r ? xcd * (q + 1) : r * (q + 1) + (xcd - r) * q) + off; }
        const int nig = WGM * nN, gid = wgid / nig, fm = gid * WGM, gsz = (nM - fm) < WGM ? (nM - fm) : WGM;
        u.pm = fm + ((wgid % nig) % gsz); u.pn = (wgid % nig) / gsz; u.e = 0; return true;
    }
    __device__ __forceinline__ void gather(const Unit&, const int (&)[2], const int (&)[2], unsigned (&)[2][2], unsigned) const {}
    __device__ __forceinline__ void gather_issue(const Unit&, const int (&)[2], unsigned (&)[4]) const {}
    __device__ __forceinline__ void gather_finish(const Unit&, const int (&)[2], const int (&)[2], const unsigned (&)[4], unsigned (&)[2][2], unsigned) const {}
};
struct MoeOrder {
    const PG8_LAS int* tab; const int* list; int NC, RG, chunk0, nrt, j0;
    __device__ __forceinline__ void init(const PG8_LAS int* tab_, const int* list_, int NC_, int bid) {
        tab = tab_; list = list_; NC = NC_; RG = 32 / NC_; const int x = bid & 7; j0 = bid >> 3;
        const int T = __builtin_amdgcn_readfirstlane(tab_[32]); chunk0 = (T * x) / 8; nrt = (T * (x + 1)) / 8 - chunk0;
    }
    __device__ __forceinline__ bool next(int i, Unit& u) const {
        const int pml = i * RG + (j0 % RG); if (pml >= nrt) return false;
        u.pm = chunk0 + pml; u.pn = j0 / RG;
        const int ln = (int)(threadIdx.x & 63u); const int tv = tab[(ln & 31) + 1];
        u.e = __builtin_amdgcn_readfirstlane(__popcll(__ballot(ln < NE - 1 && u.pm >= tv))); return true;
    }
    __device__ __forceinline__ void tok_src(const Unit& u, int lane, const char*& sbase, unsigned& voff) const {
        const int r0 = (u.pm - __builtin_amdgcn_readfirstlane(tab[u.e])) * BM; sbase = (const char*)(list + (size_t)u.e * NTOK); voff = (unsigned)(r0 + 4 * lane) * 4u; }
    __device__ __forceinline__ void gather_lds(const Unit& u, const int (&RA)[2], const int (&CA2)[2], unsigned (&go)[2][2], unsigned rowbytes, const PG8_LAS int* tokl) const {
        const int r0 = (u.pm - __builtin_amdgcn_readfirstlane(tab[u.e])) * BM, cnt = __builtin_amdgcn_readfirstlane(tab[40 + u.e]);
#pragma unroll
        for (int h = 0; h < 2; ++h)
#pragma unroll
            for (int i = 0; i < 2; ++i) { const int rr_ = h * HALF + RA[i]; const int tk = ((const volatile PG8_LAS int*)tokl)[rr_];     const int tok = (r0 + rr_ < cnt) ? tk : 0; go[h][i] = (unsigned)tok * rowbytes + (unsigned)CA2[i]; }
    }
    __device__ __forceinline__ void gather_issue(const Unit& u, const int (&RA)[2], unsigned (&tk)[4]) const {
        const int r0 = (u.pm - __builtin_amdgcn_readfirstlane(tab[u.e])) * BM; const char* sb = (const char*)(list + (size_t)u.e * NTOK);
#pragma unroll
        for (int h = 0; h < 2; ++h)
#pragma unroll
            for (int i = 0; i < 2; ++i) { const unsigned vo = (unsigned)(r0 + h * HALF + RA[i]) * 4u; asm volatile("global_load_dword %0, %1, %2" : "=v"(tk[h * 2 + i]) : "v"(vo), "s"(sb) : "memory"); }
    }
    __device__ __forceinline__ void gather_finish(const Unit& u, const int (&RA)[2], const int (&CA2)[2], const unsigned (&tk)[4], unsigned (&go)[2][2], unsigned rowbytes) const {
        const int r0 = (u.pm - __builtin_amdgcn_readfirstlane(tab[u.e])) * BM, cnt = __builtin_amdgcn_readfirstlane(tab[40 + u.e]);
#pragma unroll
        for (int h = 0; h < 2; ++h)
#pragma unroll
            for (int i = 0; i < 2; ++i) { const unsigned tok = (r0 + h * HALF + RA[i] < cnt) ? tk[h * 2 + i] : 0u; go[h][i] = tok * rowbytes + (unsigned)CA2[i]; }
    }
    __device__ __forceinline__ void gather(const Unit& u, const int (&RA)[2], const int (&CA2)[2], unsigned (&go)[2][2], unsigned rowbytes) const {
        const int r0 = (u.pm - __builtin_amdgcn_readfirstlane(tab[u.e])) * BM, cnt = __builtin_amdgcn_readfirstlane(tab[40 + u.e]);
#pragma unroll
        for (int h = 0; h < 2; ++h)
#pragma unroll
            for (int i = 0; i < 2; ++i) { const int r = r0 + h * HALF + RA[i]; const int tl = list[u.e * NTOK + r]; const int tok = (r < cnt) ? tl : 0; go[h][i] = (unsigned)tok * rowbytes + (unsigned)CA2[i]; }
    }
};

__device__ __forceinline__ unsigned cvt_pk_bf16(float lo, float hi) { unsigned r; asm volatile("v_cvt_pk_bf16_f32 %0, %1, %2" : "=v"(r) : "v"(lo), "v"(hi)); return r; }
__device__ __forceinline__ f32x2 gelu_pk(f32x2 v) {
    const f32x2 av = __builtin_elementwise_abs(v), d = av * 0.2316418882f + 1.0f;
    f32x2 t; t.x = __builtin_amdgcn_rcpf(d.x); t.y = __builtin_amdgcn_rcpf(d.y);
    f32x2 q = t * 0.5307027145f + (-0.7265760135f); q = q * t + 0.7107068705f; q = q * t + (-0.142248368f); q = q * t + 0.127414796f; q = q * t;
    const f32x2 s = (v * v) * (-0.72134752044f);
    f32x2 e; e.x = __builtin_amdgcn_exp2f(s.x); e.y = __builtin_amdgcn_exp2f(s.y);
    const f32x2 m = v * (q * e), r = v - m;
    f32x2 o; o.x = v.x < 0.f ? m.x : r.x; o.y = v.y < 0.f ? m.y : r.y; return o;
}
__device__ __forceinline__ float gelu1(float v) { return gelu_pk((f32x2){v, v}).x; }

struct EpiProj {
    static constexpr bool PERM = true; static constexpr bool BIAS = false;
    bf16_t* O;
    __device__ __forceinline__ void operator()(const f32x4 (&acc)[2][2][4][2], const Unit& u, int wr, int wc, int fr, int fq) const {
        const int row0 = u.pm * BM + wr * 64 + fr, col0 = u.pn * BM + wc * 32 + 8 * fq; const float sc = (u.pn < 2) ? QSCALE : 1.0f;
        const bool act = (u.pn >= C_GU / BM);
#pragma unroll
        for (int ai = 0; ai < 2; ++ai)
#pragma unroll
            for (int m = 0; m < 4; ++m) { bf16_t* rowp = O + (size_t)(row0 + ai * HALF + m * 16) * INW + col0;
#pragma unroll
                for (int bj = 0; bj < 2; ++bj) { f32x4 v0 = acc[ai][bj][m][0] * sc, v1 = acc[ai][bj][m][1] * sc;
                    if (act) { const f32x2 a = gelu_pk((f32x2){v0[0], v0[1]}), b = gelu_pk((f32x2){v0[2], v0[3]}), c = gelu_pk((f32x2){v1[0], v1[1]}), d = gelu_pk((f32x2){v1[2], v1[3]});
                        v0 = (f32x4){a.x, a.y, b.x, b.y}; v1 = (f32x4){c.x, c.y, d.x, d.y}; }
                    u32x4 w; w.x = cvt_pk_bf16(v0[0], v0[1]); w.y = cvt_pk_bf16(v0[2], v0[3]); w.z = cvt_pk_bf16(v1[0], v1[1]); w.w = cvt_pk_bf16(v1[2], v1[3]);
                    *(u32x4*)(rowp + bj * HALF) = w; } }
    }
};
struct EpiH1 {
    static constexpr bool PERM = true; static constexpr bool BIAS = false;
    const bf16_t* X; bf16_t* C; float sc;
    __device__ __forceinline__ void operator()(const f32x4 (&acc)[2][2][4][2], const Unit& u, int wr, int wc, int fr, int fq) const {
        const int row0 = u.pm * BM + wr * 64 + fr, col0 = u.pn * BM + wc * 32 + 8 * fq;
        u32x4 xv[2][4][2];
#pragma unroll
        for (int ai = 0; ai < 2; ++ai)
#pragma unroll
            for (int m = 0; m < 4; ++m)
#pragma unroll
                for (int bj = 0; bj < 2; ++bj) xv[ai][m][bj] = *(const u32x4*)(X + (size_t)(row0 + ai * HALF + m * 16) * DM + col0 + bj * HALF);
#pragma unroll
        for (int ai = 0; ai < 2; ++ai)
#pragma unroll
            for (int m = 0; m < 4; ++m) { const size_t off = (size_t)(row0 + ai * HALF + m * 16) * DM + col0;
#pragma unroll
                for (int bj = 0; bj < 2; ++bj) { const u32x4 xw = xv[ai][m][bj];
                    const f32x4 a0 = acc[ai][bj][m][0] * sc, a1 = acc[ai][bj][m][1] * sc;
                    u32x4 w;
                    w.x = cvt_pk_bf16(__uint_as_float(xw.x << 16) * ALPHA + a0[0], __uint_as_float(xw.x & 0xffff0000u) * ALPHA + a0[1]);
                    w.y = cvt_pk_bf16(__uint_as_float(xw.y << 16) * ALPHA + a0[2], __uint_as_float(xw.y & 0xffff0000u) * ALPHA + a0[3]);
                    w.z = cvt_pk_bf16(__uint_as_float(xw.z << 16) * ALPHA + a1[0], __uint_as_float(xw.z & 0xffff0000u) * ALPHA + a1[1]);
                    w.w = cvt_pk_bf16(__uint_as_float(xw.w << 16) * ALPHA + a1[2], __uint_as_float(xw.w & 0xffff0000u) * ALPHA + a1[3]);
                    *(u32x4*)(C + off + bj * HALF) = w; } }
    }
};
struct EpiSwiglu {
    static constexpr bool PERM = true; static constexpr bool BIAS = false;
    bf16_t* O; const float* bias;
    __device__ __forceinline__ void operator()(const f32x4 (&acc)[2][2][4][2], const Unit& u, int wr, int wc, int fr, int fq) const {
        const int row0 = u.pm * BM + wr * 64 + fr, col0 = u.pn * HALF + wc * 32 + 8 * fq;
        const float* bp = bias + (size_t)u.e * (2 * DFF) + col0;
        f32x4 bg[2], bl[2];
#pragma unroll
        for (int n = 0; n < 2; ++n) { bg[n] = *(const f32x4*)(bp + 4 * n); bl[n] = *(const f32x4*)(bp + DFF + 4 * n); }
#pragma unroll
        for (int ai = 0; ai < 2; ++ai)
#pragma unroll
            for (int m = 0; m < 4; ++m) { float a8[8];
#pragma unroll
                for (int n = 0; n < 2; ++n) { const f32x4 g4 = acc[ai][0][m][n] + bg[n], l4 = acc[ai][1][m][n] + bl[n];
#pragma unroll
                    for (int j = 0; j < 4; ++j) { const float g = fminf(g4[j], 7.0f), l = fminf(fmaxf(l4[j], -7.0f), 7.0f);
                        const float sg = __builtin_amdgcn_rcpf(1.0f + __builtin_amdgcn_exp2f(g * (-1.702f * 1.4426950408889634f)));
                        a8[4 * n + j] = (l + 1.0f) * g * sg; } }
                u32x4 w; w.x = cvt_pk_bf16(a8[0], a8[1]); w.y = cvt_pk_bf16(a8[2], a8[3]); w.z = cvt_pk_bf16(a8[4], a8[5]); w.w = cvt_pk_bf16(a8[6], a8[7]);
                *(u32x4*)(O + (size_t)(row0 + ai * HALF + m * 16) * DFF + col0) = w; }
    }
};
struct EpiDown {
    static constexpr bool PERM = true; static constexpr bool BIAS = false;
    bf16_t* O; const float* bias;
    __device__ __forceinline__ void operator()(const f32x4 (&acc)[2][2][4][2], const Unit& u, int wr, int wc, int fr, int fq) const {
        const int row0 = u.pm * BM + wr * 64 + fr, col0 = u.pn * BM + wc * 32 + 8 * fq;
        const float* bp = bias + (size_t)u.e * DM + col0;
        f32x4 bv[2][2];
#pragma unroll
        for (int bj = 0; bj < 2; ++bj)
#pragma unroll
            for (int n = 0; n < 2; ++n) bv[bj][n] = *(const f32x4*)(bp + bj * HALF + 4 * n);
#pragma unroll
        for (int ai = 0; ai < 2; ++ai)
#pragma unroll
            for (int m = 0; m < 4; ++m) { bf16_t* rowp = O + (size_t)(row0 + ai * HALF + m * 16) * DM + col0;
#pragma unroll
                for (int bj = 0; bj < 2; ++bj) { const f32x4 v0 = acc[ai][bj][m][0] + bv[bj][0], v1 = acc[ai][bj][m][1] + bv[bj][1];
                    u32x4 w; w.x = cvt_pk_bf16(v0[0], v0[1]); w.y = cvt_pk_bf16(v0[2], v0[3]); w.z = cvt_pk_bf16(v1[0], v1[1]); w.w = cvt_pk_bf16(v1[2], v1[3]);
                    *(u32x4*)(rowp + bj * HALF) = w; } }
    }
};

__device__ __forceinline__ unsigned pk4_fp8(float a, float b, float c, float d) { int w = 0; w = __builtin_amdgcn_cvt_pk_fp8_f32(a, b, w, false); w = __builtin_amdgcn_cvt_pk_fp8_f32(c, d, w, true); return (unsigned)w; }
typedef unsigned u32x2 __attribute__((ext_vector_type(2)));
__device__ __forceinline__ u32x4 widen16(u32x2 w0, u32x2 w1) {
    const auto sx = __builtin_amdgcn_permlane16_swap(w0.x, w1.x, false, false); const auto sy = __builtin_amdgcn_permlane16_swap(w0.y, w1.y, false, false);
    return (u32x4){sx[0], sy[0], sx[1], sy[1]}; }
struct EpiSwiglu8 {
    static constexpr bool PERM = true; static constexpr bool BIAS = true;
    unsigned char* O; const float* bias;
    __device__ __forceinline__ size_t bias_idx(const Unit& u, int j) const { return (size_t)u.e * (2 * DFF) + (j < HALF ? 0 : DFF - HALF) + u.pn * HALF + j; }
    __device__ __forceinline__ void bias_src(const Unit& u, int lane, const char*& sbase, unsigned& voff) const {
        sbase = (const char*)(bias + (size_t)u.e * (2 * DFF)); voff = (unsigned)((lane < 32 ? 0 : DFF - 128) + u.pn * HALF + 4 * lane) * 4u; }
    __device__ __forceinline__ void operator()(const f32x4 (&acc)[2][2][4][2], const Unit& u, int wr, int wc, int fr, int fq, const PG8_LAS float* brec) const {
        const int row0 = u.pm * BM + wr * 64 + fr, col0 = u.pn * HALF + wc * 32 + 8 * fq;
        f32x4 bg[2], bl[2];
#pragma unroll
        for (int n = 0; n < 2; ++n) {
            bg[n] = *(const PG8_LAS f32x4*)(brec + wc * 32 + 8 * fq + 4 * n); bl[n] = *(const PG8_LAS f32x4*)(brec + HALF + wc * 32 + 8 * fq + 4 * n); }
        u32x2 wq[2];
#pragma unroll
        for (int ai = 0; ai < 2; ++ai)
#pragma unroll
            for (int m = 0; m < 4; ++m) { float a8[8];
#pragma unroll
                for (int n = 0; n < 2; ++n) { const f32x4 g4 = acc[ai][0][m][n] * WUNSCALE + bg[n], l4 = acc[ai][1][m][n] * WUNSCALE + bl[n];
#pragma unroll
                    for (int pr = 0; pr < 2; ++pr) {
                        const f32x2 g = (f32x2){__builtin_amdgcn_fmed3f(g4[2 * pr], -3.0e38f, 7.0f), __builtin_amdgcn_fmed3f(g4[2 * pr + 1], -3.0e38f, 7.0f)};
                        const f32x2 l = (f32x2){__builtin_amdgcn_fmed3f(l4[2 * pr], -7.0f, 7.0f), __builtin_amdgcn_fmed3f(l4[2 * pr + 1], -7.0f, 7.0f)};
                        f32x2 e = g * (-1.702f * 1.4426950408889634f); e.x = __builtin_amdgcn_exp2f(e.x); e.y = __builtin_amdgcn_exp2f(e.y);
                        f32x2 d = e + 1.0f; d.x = __builtin_amdgcn_rcpf(d.x); d.y = __builtin_amdgcn_rcpf(d.y);
                        const f32x2 av = (l * g + g) * d;
                        a8[4 * n + 2 * pr] = av.x; a8[4 * n + 2 * pr + 1] = av.y; } }
                wq[m & 1].x = pk4_fp8(a8[0], a8[1], a8[2], a8[3]); wq[m & 1].y = pk4_fp8(a8[4], a8[5], a8[6], a8[7]);
                if (m & 1) { const u32x4 w16 = widen16(wq[0], wq[1]);
                    *(u32x4*)(O + (size_t)(row0 + ai * HALF + (m - 1 + (fq & 1)) * 16) * DFF + (col0 - 8 * (fq & 1))) = w16; } }
    }
};

struct EpiDown8 {
    static constexpr bool PERM = true; static constexpr bool BIAS = true;
    unsigned char* O; const float* bias;
    __device__ __forceinline__ size_t bias_idx(const Unit& u, int j) const { return (size_t)u.e * DM + u.pn * BM + j; }
    __device__ __forceinline__ void bias_src(const Unit& u, int lane, const char*& sbase, unsigned& voff) const {
        sbase = (const char*)(bias + (size_t)u.e * DM); voff = (unsigned)(u.pn * BM + 4 * lane) * 4u; }
    __device__ __forceinline__ void operator()(const f32x4 (&acc)[2][2][4][2], const Unit& u, int wr, int wc, int fr, int fq, const PG8_LAS float* brec) const {
        const int row0 = u.pm * BM + wr * 64 + fr, col0 = u.pn * BM + wc * 32 + 8 * fq;
        f32x4 bv[2][2];
#pragma unroll
        for (int bj = 0; bj < 2; ++bj)
#pragma unroll
            for (int n = 0; n < 2; ++n) bv[bj][n] = *(const PG8_LAS f32x4*)(brec + bj * HALF + wc * 32 + 8 * fq + 4 * n);
#pragma unroll
        for (int ai = 0; ai < 2; ++ai)
#pragma unroll
            for (int mp = 0; mp < 4; mp += 2) { unsigned char* rowp = O + (size_t)(row0 + ai * HALF + (mp + (fq & 1)) * 16) * DM + (col0 - 8 * (fq & 1));
#pragma unroll
                for (int bj = 0; bj < 2; ++bj) { u32x2 wq[2];
#pragma unroll
                    for (int q = 0; q < 2; ++q) { const f32x4 v0 = acc[ai][bj][mp + q][0] * WUNSCALE + bv[bj][0], v1 = acc[ai][bj][mp + q][1] * WUNSCALE + bv[bj][1];
                        wq[q].x = pk4_fp8(v0[0], v0[1], v0[2], v0[3]); wq[q].y = pk4_fp8(v1[0], v1[1], v1[2], v1[3]); }
                    *(u32x4*)(rowp + bj * HALF) = widen16(wq[0], wq[1]); } }
    }
};

constexpr int PG8_META_OFF = 157696, PG8_META_SLOT = 2048;
constexpr int PG8_BIAS_OFF = 131072, PG8_BIAS_MAX = 24;
template <class Epi, class Sched, bool GATHER, bool FP8 = false, bool META = false, bool ALIGN_EPI = true>
__device__ __forceinline__ void gemm_phase(PG8_LAS unsigned char* lds, const Gemm g, const Sched& S, const Epi& E) {
    int tid_ = threadIdx.x; asm volatile("" : "+v"(tid_));
    const int tid = tid_, wid = __builtin_amdgcn_readfirstlane(tid >> 6), lane = tid & 63, wr = wid >> 2, wc = wid & 3, fr = lane & 15, fq = lane >> 4;
    const int K = FP8 ? g.K / 2 : g.K, nt = K / BK;
    unsigned voffB[2]; int RA[2], CA2[2]; unsigned voffA[2];
#pragma unroll
    for (int i = 0; i < 2; ++i) { int R, C; stage_rc(tid * 16 + i * 8192, R, C); const int Rb = Epi::PERM ? ((R & ~31) + perm32(R & 31)) : R;
        voffA[i] = (unsigned)(R * K + C) * 2u; voffB[i] = (unsigned)(Rb * K + C) * 2u; RA[i] = R; CA2[i] = C * 2; }
    const size_t kstep = (size_t)(BK * 2);
    const size_t hstep = (size_t)HALF * K * 2;
    const size_t tstep = 2 * hstep;
    const unsigned ldsw = (unsigned)wid * 1024u;
    const int aoff = lds_byte(wr * 64 + fr, fq * 8), boff = lds_byte(wc * 32 + fr, fq * 8);
    const unsigned lds0 = (unsigned)(uintptr_t)lds;
#define PG8_SA(b, h) (((b) * 2 + (h)) * HTB)
#define PG8_SB(b, h) ((4 + (b) * 2 + (h)) * HTB)
#define PG8_GLDS(sbase, voff, ldsoff) do { unsigned keep_; asm volatile("s_mov_b32 %0, m0\n\ts_mov_b32 m0, %3\n\ts_nop 0\n\tglobal_load_lds_dwordx4 %1, %2\n\ts_mov_b32 m0, %0" \
        : "=&s"(keep_) : "v"(voff), "s"(sbase), "s"((unsigned)__builtin_amdgcn_readfirstlane((int)(lds0 + (unsigned)(ldsoff)))) : "memory"); } while (0)
#define PG8_STAGE_B(bufoff, gbase) do { PG8_GLDS((const char*)(gbase), voffB[0], (bufoff) + ldsw); PG8_GLDS((const char*)(gbase), voffB[1], (bufoff) + ldsw + 8192); } while (0)
#define PG8_STAGE_A(bufoff, gbase, o0, o1) do { PG8_GLDS((const char*)(gbase), (o0), (bufoff) + ldsw); PG8_GLDS((const char*)(gbase), (o1), (bufoff) + ldsw + 8192); } while (0)
#define PG8_LDA(dst, b, h) do { _Pragma("unroll") for (int m = 0; m < 4; ++m) _Pragma("unroll") for (int k = 0; k < 2; ++k) dst[m][k] = *(const PG8_LAS bf16x8*)(lds + PG8_SA(b, h) + aoff + m * 2048 + k * 1024); } while (0)
#define PG8_LDB(dst, b, h) do { _Pragma("unroll") for (int n = 0; n < 2; ++n) _Pragma("unroll") for (int k = 0; k < 2; ++k) dst[n][k] = *(const PG8_LAS bf16x8*)(lds + PG8_SB(b, h) + boff + n * 2048 + k * 1024); } while (0)
#define PG8_LD8(p) __builtin_shufflevector(*(const PG8_LAS v4i_t*)(p), *(const PG8_LAS v4i_t*)((p) + 1024), 0, 1, 2, 3, 4, 5, 6, 7)
#define PG8_LDA8(dst, b, h) do { _Pragma("unroll") for (int m = 0; m < 4; ++m) dst[m] = PG8_LD8(lds + PG8_SA(b, h) + aoff + m * 2048); } while (0)
#define PG8_LDB8(dst, b, h) do { _Pragma("unroll") for (int n = 0; n < 2; ++n) dst[n] = PG8_LD8(lds + PG8_SB(b, h) + boff + n * 2048); } while (0)
#if defined(PROBE_DOUBLE_MFMA)
#define PG8_MFMA_TWICE(ai, bj, m, n, At, Bt) acc[ai][bj][m][n] = __builtin_amdgcn_mfma_scale_f32_16x16x128_f8f6f4(Bt##8[n], At##8[m], acc[ai][bj][m][n], 0, 0, 0, 0, 0, 0);
#else
#define PG8_MFMA_TWICE(ai, bj, m, n, At, Bt)
#endif
#define PG8_MMA(ai, bj, At, Bt) do { __builtin_amdgcn_s_setprio(1); \
        if constexpr (FP8) { _Pragma("unroll") for (int m = 0; m < 4; ++m) _Pragma("unroll") for (int n = 0; n < 2; ++n) \
            { acc[ai][bj][m][n] = __builtin_amdgcn_mfma_scale_f32_16x16x128_f8f6f4(Bt##8[n], At##8[m], acc[ai][bj][m][n], 0, 0, 0, 0, 0, 0); PG8_MFMA_TWICE(ai, bj, m, n, At, Bt) }     \
              \
            _Pragma("unroll") for (int m = 0; m < 4; ++m) _Pragma("unroll") for (int n = 0; n < 2; ++n) asm volatile("" : "+v"(acc[ai][bj][m][n])); } \
        else { _Pragma("unroll") for (int m = 0; m < 4; ++m) _Pragma("unroll") for (int n = 0; n < 2; ++n) _Pragma("unroll") for (int k = 0; k < 2; ++k) \
            acc[ai][bj][m][n] = __builtin_amdgcn_mfma_f32_16x16x32_bf16(Bt[n][k], At[m][k], acc[ai][bj][m][n], 0, 0, 0); } \
        __builtin_amdgcn_s_setprio(0); } while (0)
#define PG8_XLDA(dst, b, h) do { if constexpr (FP8) PG8_LDA8(dst##8, b, h); else PG8_LDA(dst, b, h); } while (0)
#define PG8_XLDB(dst, b, h) do { if constexpr (FP8) PG8_LDB8(dst##8, b, h); else PG8_LDB(dst, b, h); } while (0)
#define PG8_WAIT_V(n) asm volatile("s_waitcnt vmcnt(" #n ")" ::: "memory")
#define PG8_WAIT_L(n) asm volatile("s_waitcnt lgkmcnt(" #n ")" ::: "memory")
#define PG8_BAR __builtin_amdgcn_s_barrier()
#define PG8_SCHED __builtin_amdgcn_sched_barrier(0)
    Unit cur, nxt; int ui = 0;
#if defined(PROBE_DOUBLE_K)
    constexpr bool DKSEL = (PROBE_DOUBLE_K == 1) ? GATHER : (PROBE_DOUBLE_K == 2) ? (FP8 && !GATHER) : (!FP8 && !GATHER && Epi::PERM);
#define PG8_UIDX(i) (DKSEL ? ((i) >> 1) : (i))
#else
#define PG8_UIDX(i) (i)
#endif
    if (!S.next(PG8_UIDX(0), cur)) return;
    if constexpr (FP8 && !META && Epi::BIAS) {
        f32x4 bv_[3]; bool ok_[3];
#pragma unroll
        for (int k = 0; k < 3; ++k) { Unit bu; ok_[k] = S.next(wid + 8 * k, bu); if (ok_[k]) bv_[k] = *(const f32x4*)&E.bias[E.bias_idx(bu, 4 * lane)]; }
#pragma unroll
        for (int k = 0; k < 3; ++k) if (ok_[k]) *(PG8_LAS f32x4*)(lds + PG8_BIAS_OFF + (wid + 8 * k) * 1024 + lane * 16) = bv_[k];
        PG8_WAIT_L(0); PG8_BAR; }
    f32x4 acc[2][2][4][2];
#pragma unroll
    for (int a = 0; a < 2; ++a)
#pragma unroll
        for (int b = 0; b < 2; ++b)
#pragma unroll
            for (int m = 0; m < 4; ++m)
#pragma unroll
                for (int n = 0; n < 2; ++n) acc[a][b][m][n] = (f32x4){0.f, 0.f, 0.f, 0.f};
    bf16x8 At[4][2], B0[2][2], B1[2][2]; v8i_t At8[4], B08[2], B18[2];
    const char* cA = GATHER ? (const char*)g.A : (const char*)g.A + (size_t)cur.pm * tstep;
    const char* cB = (const char*)g.Bt + ((size_t)cur.e * g.strideB) * 2 + (size_t)cur.pn * tstep;
    unsigned gc[2][2], gn[2][2];
    unsigned tkn[4] = {0u, 0u, 0u, 0u};
#define PG8_META_ISSUE(u_, slot_) do { const char* sb_; unsigned vo_; \
        if (GATHER && wid == 0) { S.tok_src(u_, lane, sb_, vo_); PG8_GLDS(sb_, vo_, PG8_META_OFF + (slot_) * PG8_META_SLOT); } \
        if (wid == 1) { E.bias_src(u_, lane, sb_, vo_); PG8_GLDS(sb_, vo_, PG8_META_OFF + (slot_) * PG8_META_SLOT + 1024); } } while (0)
    if constexpr (META) { PG8_META_ISSUE(cur, 0); PG8_WAIT_V(0); PG8_BAR; asm volatile("" ::: "memory");
        if constexpr (GATHER) S.gather_lds(cur, RA, CA2, gc, (unsigned)(K * 2), (const PG8_LAS int*)(lds + PG8_META_OFF)); }
    else if constexpr (GATHER) { S.gather(cur, RA, CA2, gc, (unsigned)(K * 2)); }
    else {
#pragma unroll
        for (int h = 0; h < 2; ++h)
#pragma unroll
            for (int i = 0; i < 2; ++i) gc[h][i] = (unsigned)(h * hstep) + voffA[i]; }
#pragma unroll
    for (int h = 0; h < 2; ++h)
#pragma unroll
        for (int i = 0; i < 2; ++i) gn[h][i] = gc[h][i];
    PG8_STAGE_B(PG8_SB(0, 0), cB); PG8_STAGE_B(PG8_SB(0, 1), cB + hstep); PG8_STAGE_A(PG8_SA(0, 0), cA, gc[0][0], gc[0][1]); PG8_STAGE_A(PG8_SA(0, 1), cA, gc[1][0], gc[1][1]);
    if (wr == 1) PG8_BAR;
    PG8_WAIT_V(2); PG8_BAR;
    PG8_STAGE_B(PG8_SB(1, 0), cB + kstep); PG8_STAGE_A(PG8_SA(1, 0), cA + kstep, gc[0][0], gc[0][1]); PG8_STAGE_B(PG8_SB(1, 1), cB + hstep + kstep);
    PG8_WAIT_V(6); PG8_BAR;
    for (;;) {
        const bool has_next = S.next(PG8_UIDX(ui + 1), nxt);
        const char* nA = GATHER ? cA : (has_next ? (const char*)g.A + (size_t)nxt.pm * tstep : cA);
        const char* nB = has_next ? (const char*)g.Bt + ((size_t)nxt.e * g.strideB) * 2 + (size_t)nxt.pn * tstep : cB;
        if constexpr (META) { if (has_next) PG8_META_ISSUE(nxt, (ui + 1) % 3); }
        else if constexpr (GATHER) { if (has_next) S.gather_issue(nxt, RA, tkn); }
        for (int t = 0; t < nt; t += 2) {
            const bool last = (t == nt - 2);
            const char* a1 = cA + (size_t)(t + 1) * kstep;
            const char* a2 = last ? nA : cA + (size_t)(t + 2) * kstep; const char* b2 = last ? nB : cB + (size_t)(t + 2) * kstep;
            const char* a3 = a2 + kstep; const char* b3 = b2 + kstep;
            if constexpr (GATHER && META) { if (last && has_next) S.gather_lds(nxt, RA, CA2, gn, (unsigned)(K * 2), (const PG8_LAS int*)(lds + PG8_META_OFF + ((ui + 1) % 3) * PG8_META_SLOT)); }
            if constexpr (GATHER && !META) { if (last && has_next) {
                asm volatile("s_waitcnt vmcnt(8)" : "+v"(tkn[0]), "+v"(tkn[1]), "+v"(tkn[2]), "+v"(tkn[3]) :: "memory");
                S.gather_finish(nxt, RA, CA2, tkn, gn, (unsigned)(K * 2)); } }
            unsigned o00 = gc[0][0], o01 = gc[0][1], o10 = gc[1][0], o11 = gc[1][1];
            if constexpr (GATHER) { if (last) { o00 = gn[0][0]; o01 = gn[0][1]; o10 = gn[1][0]; o11 = gn[1][1]; } }
            PG8_XLDB(B0, 0, 0); PG8_XLDB(B1, 0, 1); PG8_SCHED; PG8_XLDA(At, 0, 0); PG8_STAGE_A(PG8_SA(1, 1), a1, gc[1][0], gc[1][1]);
            PG8_WAIT_V(8); PG8_WAIT_L(0); PG8_BAR; PG8_MMA(0, 0, At, B0); PG8_MMA(0, 1, At, B1); PG8_BAR; PG8_SCHED;
            PG8_XLDA(At, 0, 1); PG8_STAGE_B(PG8_SB(0, 0), b2); PG8_STAGE_B(PG8_SB(0, 1), b2 + hstep); PG8_STAGE_A(PG8_SA(0, 0), a2, o00, o01);
            PG8_WAIT_V(8); PG8_WAIT_L(0); PG8_BAR; PG8_MMA(1, 0, At, B0); PG8_MMA(1, 1, At, B1); PG8_BAR; PG8_SCHED;
            PG8_XLDB(B0, 1, 0); PG8_XLDB(B1, 1, 1); PG8_SCHED; PG8_XLDA(At, 1, 0); PG8_STAGE_A(PG8_SA(0, 1), a2, o10, o11);
            PG8_WAIT_V(8); PG8_WAIT_L(0); PG8_BAR; PG8_MMA(0, 0, At, B0); PG8_MMA(0, 1, At, B1); PG8_BAR; PG8_SCHED;
            PG8_XLDA(At, 1, 1); PG8_STAGE_B(PG8_SB(1, 0), b3); PG8_STAGE_B(PG8_SB(1, 1), b3 + hstep); PG8_STAGE_A(PG8_SA(1, 0), a3, o00, o01);
            PG8_WAIT_V(8); PG8_WAIT_L(0); PG8_BAR; PG8_MMA(1, 0, At, B0); PG8_MMA(1, 1, At, B1); PG8_BAR; PG8_SCHED;
        }
        if constexpr (ALIGN_EPI) { if (wr == 0) PG8_BAR; }
#if defined(PROBE_DOUBLE_K)
        const bool dk_first = DKSEL && ((ui & 1) == 0);
        if (DKSEL && !dk_first) { _Pragma("unroll") for (int a = 0; a < 2; ++a) _Pragma("unroll") for (int b = 0; b < 2; ++b) _Pragma("unroll") for (int m = 0; m < 4; ++m) _Pragma("unroll") for (int n = 0; n < 2; ++n) acc[a][b][m][n] *= 0.5f; }
#else
        constexpr bool dk_first = false;
#endif
        if (!dk_first)
        { int fr_ = fr, fq_ = fq; asm volatile("" : "+v"(fr_), "+v"(fq_));
          if constexpr (META) PG8_WAIT_V(0);
          asm volatile("" ::: "memory");
          if constexpr (META) E(acc, cur, wr, wc, fr_, fq_, (const PG8_LAS float*)(lds + PG8_META_OFF + (ui % 3) * PG8_META_SLOT + 1024));
          else if constexpr (FP8 && Epi::BIAS) E(acc, cur, wr, wc, fr_, fq_, (const PG8_LAS float*)(lds + PG8_BIAS_OFF) + ui * 256);
          else E(acc, cur, wr, wc, fr_, fq_);
#if defined(PROBE_DOUBLE_EPI_OFF)
          if constexpr (GATHER) { asm volatile("" : "+v"(fr_), "+v"(fq_)); E(acc, cur, wr, wc, fr_, fq_); }
#endif
          }
        if (!has_next) break;
        if (!dk_first) {
#pragma unroll
        for (int a = 0; a < 2; ++a)
#pragma unroll
            for (int b = 0; b < 2; ++b)
#pragma unroll
                for (int m = 0; m < 4; ++m)
#pragma unroll
                    for (int n = 0; n < 2; ++n) acc[a][b][m][n] = (f32x4){0.f, 0.f, 0.f, 0.f};
        }
        cur = nxt; cA = nA; cB = nB; ++ui;
#pragma unroll
        for (int h = 0; h < 2; ++h)
#pragma unroll
            for (int i = 0; i < 2; ++i) gc[h][i] = gn[h][i];
        if constexpr (ALIGN_EPI) { if (wr == 1) PG8_BAR; }
    }
    PG8_WAIT_V(0);
    if constexpr (!ALIGN_EPI) { if (wr == 0) PG8_BAR; }
    PG8_BAR;
#undef PG8_UIDX
#undef PG8_META_ISSUE
#undef PG8_SA
#undef PG8_SB
#undef PG8_GLDS
#undef PG8_STAGE_A
#undef PG8_STAGE_B
#undef PG8_LDA
#undef PG8_LDB
#undef PG8_MMA
#undef PG8_LD8
#undef PG8_LDA8
#undef PG8_LDB8
#undef PG8_XLDA
#undef PG8_XLDB
#undef PG8_WAIT_V
#undef PG8_WAIT_L
#undef PG8_BAR
#undef PG8_SCHED
}
}

namespace attn_body {
using bf16=__hip_bfloat16;
using bf16x8=__attribute__((ext_vector_type(8)))short;
using s16x4=__attribute__((ext_vector_type(4)))short;
using f32x16=__attribute__((ext_vector_type(16)))float;
using u32x4=__attribute__((ext_vector_type(4)))unsigned;
constexpr int D=64,PQ=INW,PO=DM;
constexpr int NW=8,QBLK=32,QB=QBLK*NW,KVBLK=64,NQB=SEQ/QB;
constexpr int ATTN_UNIT_ROWS=QB;
__device__ __forceinline__ int crow(int r,int hi){return (r&3)+8*(r>>2)+4*hi;}
#define SBAR() __builtin_amdgcn_sched_barrier(0)
__device__ __forceinline__ void cmask(f32x16&p0,f32x16&p1,int jb,int qrel,int hi){
  const float NEG=-INFINITY; int kb=64*jb+4*hi;
  #pragma unroll
  for(int r=0;r<16;++r){int kv=kb+(r&3)+8*(r>>2); if(kv>qrel)p0[r]=NEG; if(kv+32>qrel)p1[r]=NEG;}
}

constexpr int NSLOT=3, SLOTB=8192;
constexpr int LDS_K=0, LDS_V=NSLOT*SLOTB, LDS_WS=3*NSLOT*SLOTB, LDS_STASH=LDS_WS+NW*64*4, LDS_BYTES=LDS_STASH+NW*8192;
constexpr float C2=0.125f*1.4426950408889634f;
__device__ __forceinline__ void glds16(const void*gsrc,unsigned lds_dst){unsigned keep;
  asm volatile("s_mov_b32 %0, m0\n\ts_mov_b32 m0, %2\n\ts_nop 0\n\tglobal_load_lds_dwordx4 %1, off\n\ts_mov_b32 m0, %0":"=&s"(keep):"v"(gsrc),"s"(lds_dst):"memory");}
__device__ __forceinline__ float max3f(float a,float b,float c){float r;asm("v_max3_f32 %0, %1, %2, %3":"=v"(r):"v"(a),"v"(b),"v"(c));return r;}
__device__ __forceinline__ float max2f(float a,float b){float r;asm("v_max_f32_e32 %0, %1, %2":"=v"(r):"v"(a),"v"(b));return r;}
__device__ __forceinline__ float fadd_s(float a,float b){float r;asm("v_add_f32_e32 %0, %1, %2":"=v"(r):"v"(a),"v"(b));return r;}
__device__ __forceinline__ float fsub_s(float a,float b){float r;asm("v_sub_f32_e32 %0, %1, %2":"=v"(r):"v"(a),"v"(b));return r;}
typedef float f32x2_t __attribute__((ext_vector_type(2))); typedef __bf16 bf16x2_t __attribute__((ext_vector_type(2)));
__device__ __forceinline__ unsigned cvtpk_s(float lo,float hi){f32x2_t v={lo,hi};bf16x2_t b=__builtin_convertvector(v,bf16x2_t);return __builtin_bit_cast(unsigned,b);}
#define WAIT_BAR(N) asm volatile("s_waitcnt vmcnt(" #N ") lgkmcnt(0)\n\ts_barrier":::"memory")

__device__ __forceinline__ void qkt(f32x16&p0,f32x16&p1,const char*Kslot,const bf16x8*qr,int r32,int hi){ const f32x16 negm=f32x16{};
  const char*kb=Kslot+hi*1024+r32*16;
  #pragma unroll
  for(int d0=0;d0<4;++d0){
    const bf16x8 b0=*reinterpret_cast<const bf16x8*>(kb+d0*2048);
    const bf16x8 b1=*reinterpret_cast<const bf16x8*>(kb+d0*2048+512);
    if(d0==0){p0=__builtin_amdgcn_mfma_f32_32x32x16_bf16(b0,qr[0],negm,0,0,0);p1=__builtin_amdgcn_mfma_f32_32x32x16_bf16(b1,qr[0],negm,0,0,0);}
    else{p0=__builtin_amdgcn_mfma_f32_32x32x16_bf16(b0,qr[d0],p0,0,0,0);p1=__builtin_amdgcn_mfma_f32_32x32x16_bf16(b1,qr[d0],p1,0,0,0);}}
}
typedef __attribute__((address_space(3))) const char* lds_cptr;
typedef short v4i16_t __attribute__((ext_vector_type(4)));
__device__ __forceinline__ void kload8(bf16x8*kf,lds_cptr kp){
  kf[0]=*(const __attribute__((address_space(3))) bf16x8*)(kp);      kf[1]=*(const __attribute__((address_space(3))) bf16x8*)(kp+512);
  kf[2]=*(const __attribute__((address_space(3))) bf16x8*)(kp+2048); kf[3]=*(const __attribute__((address_space(3))) bf16x8*)(kp+2560);
  kf[4]=*(const __attribute__((address_space(3))) bf16x8*)(kp+4096); kf[5]=*(const __attribute__((address_space(3))) bf16x8*)(kp+4608);
  kf[6]=*(const __attribute__((address_space(3))) bf16x8*)(kp+6144); kf[7]=*(const __attribute__((address_space(3))) bf16x8*)(kp+6656);
}
__device__ __forceinline__ void kload2(bf16x8*kf,lds_cptr kp,int j){ kf[2*j]=*(const __attribute__((address_space(3))) bf16x8*)(kp+j*2048); kf[2*j+1]=*(const __attribute__((address_space(3))) bf16x8*)(kp+j*2048+512); }
__device__ __forceinline__ s16x4 vtr(lds_cptr p){ return __builtin_bit_cast(s16x4,__builtin_amdgcn_ds_read_tr16_b64_v4i16((__attribute__((address_space(3))) v4i16_t*)p)); }
__device__ __forceinline__ float rowmax(const f32x16&p0,const f32x16&p1){
  float a=max3f(p0[0],p0[1],p1[0]),b=max3f(p0[2],p0[3],p1[1]);a=max3f(a,p1[2],p1[3]);
  #pragma unroll
  for(int r=4;r<16;r+=4){a=max3f(a,p0[r],p0[r+1]);b=max3f(b,p0[r+2],p0[r+3]);a=max3f(a,p1[r],p1[r+1]);b=max3f(b,p1[r+2],p1[r+3]);}
  const float m=max2f(a,b);
  auto rr=__builtin_amdgcn_permlane32_swap(__float_as_uint(m),__float_as_uint(m),false,false);
  return max2f(__uint_as_float(rr[0]),__uint_as_float(rr[1]));
}
__device__ __forceinline__ void pv(f32x16*o,int vb,bf16x8 pa0,bf16x8 pa1,bf16x8 pa2,bf16x8 pa3){
  #pragma unroll
  for(int d0=0;d0<4;++d0){s16x4 lo[4],hi[4];
    #pragma unroll
    for(int ks=0;ks<4;++ks){
      asm volatile("ds_read_b64_tr_b16 %0,%1 offset:%c2":"=&v"(lo[ks]):"v"(vb),"i"(d0*4096+ks*1024):"memory");
      asm volatile("ds_read_b64_tr_b16 %0,%1 offset:%c2":"=&v"(hi[ks]):"v"(vb),"i"(d0*4096+ks*1024+512):"memory");}
    asm volatile("s_waitcnt lgkmcnt(0)":::"memory");SBAR();
    #define PK(k) (bf16x8){lo[k][0],lo[k][1],lo[k][2],lo[k][3],hi[k][0],hi[k][1],hi[k][2],hi[k][3]}
    o[d0]=__builtin_amdgcn_mfma_f32_32x32x16_bf16(pa0,PK(0),o[d0],0,0,0);
    o[d0]=__builtin_amdgcn_mfma_f32_32x32x16_bf16(pa1,PK(1),o[d0],0,0,0);
    o[d0]=__builtin_amdgcn_mfma_f32_32x32x16_bf16(pa2,PK(2),o[d0],0,0,0);
    o[d0]=__builtin_amdgcn_mfma_f32_32x32x16_bf16(pa3,PK(3),o[d0],0,0,0);
    #undef PK
  }
}

#ifndef ATTN_STORE16
#define ATTN_STORE16(p,v) (*(u32x4*)(p)=(v))
#endif
template<int THRL> __device__ __forceinline__ void attn_unit(int qb,int st,float lam,const float*sgp,const bf16*Qb,const bf16*__restrict__ Kb,const bf16*__restrict__ Vb,bf16*Ob,char*shm){
  int tid_=threadIdx.x; asm volatile("":"+v"(tid_));
  const int tid=tid_,lane=tid&63,r32=lane&31,hi=lane>>5; const int wid=__builtin_amdgcn_readfirstlane(tid>>6);
  const int q0=qb*QB;
  const bf16*Qw=Qb+(long)(q0+wid*QBLK)*PQ;
  const bf16*Kh=Kb,*Vh=Vb;
  const unsigned lds0=(unsigned)(uintptr_t)shm;
  float*wsf=(float*)(shm+LDS_WS)+wid*64;
  const bf16*ksrc=Kh+(long)lane*PQ+wid*8;
  const bf16*vsrc=Vh+(long)(16*(wid&3)+(lane>>2))*PQ+(wid>>2)*32+(lane&3)*8;
  const unsigned kdst=lds0+LDS_K+wid*1024, vdst=lds0+LDS_V+wid*1024;
  #define DMA_K(t,slot) glds16(ksrc+(long)(t)*KVBLK*PQ,(unsigned)__builtin_amdgcn_readfirstlane(kdst+(slot)))
  #define DMA_V(t,slot) do{ glds16(vsrc+(long)(t)*KVBLK*PQ,(unsigned)__builtin_amdgcn_readfirstlane(vdst+2*(slot))); glds16(vsrc+(long)(t)*KVBLK*PQ+64,(unsigned)__builtin_amdgcn_readfirstlane(vdst+2*(slot)+8192)); }while(0)
  const int vb0=(int)(lds0+LDS_V)+((lane>>4)&1)*32+(lane&3)*8+(4*hi+((lane&15)>>2))*64;
  const char*Kbase=shm+LDS_K; bf16x8 kf[8];
  const lds_cptr shm3=(lds_cptr)shm; const lds_cptr kp0=shm3+LDS_K+hi*1024+r32*16; const lds_cptr vp0=shm3+LDS_V+((lane>>4)&1)*32+(lane&3)*8+(4*hi+((lane&15)>>2))*64;
  const int NT=(q0+QB)/KVBLK;
  DMA_K(0,0);DMA_V(0,0);DMA_K(1,SLOTB);
  bf16x8 qr[4];
  #pragma unroll
  for(int d0=0;d0<4;++d0)qr[d0]=*reinterpret_cast<const bf16x8*>(&Qw[(long)r32*PQ+d0*16+hi*8]);
  float mhat=0.f,l_reg=0.f;f32x16 o[4];o[0]=f32x16{};o[1]=f32x16{};o[2]=f32x16{};o[3]=f32x16{};
  const int qrel=wid*QBLK+r32;
  #define CMASK(P0,P1,t) do{int jb_=(t)-(NT-4); if(jb_>=0)cmask(P0,P1,jb_,qrel,hi);}while(0)
  bool resc=false;
  #define START(P0,P1) do{ const float rm=rowmax(P0,P1); resc=false; mhat=rm; \
    _Pragma("unroll") for(int r=0;r<16;++r)P0[r]=__builtin_amdgcn_exp2f(P0[r]-mhat); }while(0)
  #define RESC() do{ if(resc){ asm volatile("s_waitcnt lgkmcnt(0)":::"memory"); \
      _Pragma("unroll") for(int d_=0;d_<4;++d_) _Pragma("unroll") for(int r=0;r<16;++r)o[d_][r]*=wsf[crow(r,hi)]; } }while(0)
  f32x16 pA0,pA1,pB0,pB1;
  int sl_prev=0,sl_cur=0,sl_next=SLOTB;
  #define ROT() do{sl_prev=sl_cur;sl_cur=sl_next;sl_next=(sl_next==(NSLOT-1)*SLOTB)?0:sl_next+SLOTB;}while(0)
  DMA_K(2,2*SLOTB);
  WAIT_BAR(4);
  qkt(pA0,pA1,Kbase,qr,r32,hi);asm volatile("s_nop 15\n\ts_nop 7":"+v"(pA0),"+v"(pA1));CMASK(pA0,pA1,0);
  START(pA0,pA1);
  _Pragma("unroll") for(int r=0;r<16;++r)pA1[r]=__builtin_amdgcn_exp2f(pA1[r]-mhat);
  WAIT_BAR(0);
  DMA_K(3,0);DMA_V(1,SLOTB);
  ROT();
  kload8(kf,kp0+sl_cur);
  WAIT_BAR(3);
  s16x4 vlo[4],vhi[4]; u32x4 pw0,pw1,pw2,pw3;
  #define PKW(P,B) cvtpk_s(P[B],P[B+1])
  #define PAF(k) __builtin_bit_cast(bf16x8,pw##k)
  #define PAFJ(j) __builtin_bit_cast(bf16x8,((j)<4?pw0:(j)<8?pw1:(j)<12?pw2:pw3))
  #define VFR(i) (bf16x8){vlo[i][0],vlo[i][1],vlo[i][2],vlo[i][3],vhi[i][0],vhi[i][1],vhi[i][2],vhi[i][3]}
  #define PIN(x) asm volatile("":"+v"(x))
  #define MX3(a,b,c) __builtin_fmaxf(__builtin_fmaxf((a),(b)),(c))
  #define GAPA(MF,A0,A1,A2,A3,W0,W1,PW) do{ MF; sacc+=A0; sacc+=A1; sacc+=A2; sacc+=A3; PIN(sacc); W0; W1; PIN(PW); SBAR(); }while(0)
  #define EX(v) __builtin_amdgcn_exp2f(v)
  #define GAPB(MF,X,B) do{ MF; X[B]=EX(X[B]-mhat); X[B+1]=EX(X[B+1]-mhat); PIN(X); SBAR(); }while(0)
  #define VRD(S,ks,d0) do{ vlo[S]=vtr(vp_+((d0)*4096+(ks)*1024)); vhi[S]=vtr(vp_+((d0)*4096+(ks)*1024+512)); }while(0)
  #define KRD(G,j) do{ if(G){ kload2(kf,kp0+sl_next,j); SBAR(); } }while(0)
  #define PVG(j,X,B) GAPB(o[(j)&3]=__builtin_amdgcn_mfma_f32_32x32x16_bf16(PAFJ(j),VFR((j)&3),o[(j)&3],0,0,0), X,B)
  #define STEP(C0,C1,P0,P1,t,GK,GV,GL) do{ SBAR(); \
    const lds_cptr vp_=vp0+2*sl_prev; \
    float sacc=(P0[0]+P0[1]); \
    GAPA(C0=__builtin_amdgcn_mfma_f32_32x32x16_bf16(kf[0],qr[0],f32x16{},0,0,0), P0[2],P0[3],P0[4],P0[5],     pw0[0]=PKW(P0,0), pw0[1]=PKW(P0,2), pw0); \
    GAPA(C1=__builtin_amdgcn_mfma_f32_32x32x16_bf16(kf[1],qr[0],f32x16{},0,0,0), P0[6],P0[7],P0[8],P0[9],     pw0[2]=PKW(P0,4), pw0[3]=PKW(P0,6), pw0); \
    GAPA(C0=__builtin_amdgcn_mfma_f32_32x32x16_bf16(kf[2],qr[1],C0,0,0,0),   P0[10],P0[11],P0[12],P0[13], pw1[0]=PKW(P0,8), pw1[1]=PKW(P0,10), pw1); \
    GAPA(C1=__builtin_amdgcn_mfma_f32_32x32x16_bf16(kf[3],qr[1],C1,0,0,0),   P0[14],P0[15],P1[0],P1[1],   pw1[2]=PKW(P0,12),pw1[3]=PKW(P0,14), pw1); \
    VRD(0,0,0); SBAR(); GAPA(C0=__builtin_amdgcn_mfma_f32_32x32x16_bf16(kf[4],qr[2],C0,0,0,0),   P1[2],P1[3],P1[4],P1[5],     pw2[0]=PKW(P1,0), pw2[1]=PKW(P1,2), pw2); \
    VRD(1,0,1); SBAR(); GAPA(C1=__builtin_amdgcn_mfma_f32_32x32x16_bf16(kf[5],qr[2],C1,0,0,0),   P1[6],P1[7],P1[8],P1[9],     pw2[2]=PKW(P1,4), pw2[3]=PKW(P1,6), pw2); \
    VRD(2,0,2); SBAR(); GAPA(C0=__builtin_amdgcn_mfma_f32_32x32x16_bf16(kf[6],qr[3],C0,0,0,0),   P1[10],P1[11],P1[12],P1[13], pw3[0]=PKW(P1,8), pw3[1]=PKW(P1,10), pw3); \
    VRD(3,0,3); SBAR(); GAPA(C1=__builtin_amdgcn_mfma_f32_32x32x16_bf16(kf[7],qr[3],C1,0,0,0),   P1[14],P1[15],0.f,0.f,       pw3[2]=PKW(P1,12),pw3[3]=PKW(P1,14), pw3); \
    l_reg+=sacc; \
    if(GK){DMA_K((t)+3,sl_cur);} if(GV){DMA_V((t)+1,sl_next);} \
    CMASK(C0,C1,t); \
    { float a=MX3(C0[0],C0[1],C1[0]),b=MX3(C0[2],C0[3],C1[1]); a=MX3(a,C1[2],C1[3]); \
      _Pragma("unroll") for(int r=4;r<16;r+=4){a=MX3(a,C0[r],C0[r+1]);b=MX3(b,C0[r+2],C0[r+3]);a=MX3(a,C1[r],C1[r+1]);b=MX3(b,C1[r+2],C1[r+3]);} \
      float rm=__builtin_fmaxf(a,b); { auto rr=__builtin_amdgcn_permlane32_swap(__float_as_uint(rm),__float_as_uint(rm),false,false); rm=__builtin_fmaxf(__uint_as_float(rr[0]),__uint_as_float(rr[1])); } \
      resc=false; rm-=mhat;                                   \
      if(__builtin_expect(__any(rm>(float)THRL),0)){ const float dl=__builtin_fmaxf(rm,0.f); mhat+=dl; \
        const float f=__builtin_amdgcn_exp2f(-dl); l_reg*=f; if(hi==0)wsf[r32]=f; resc=true; } } \
    SBAR(); \
      \
    PVG(0,C0,0);  VRD(0,1,0); SBAR(); \
    PVG(1,C0,2);  VRD(1,1,1); SBAR(); \
    PVG(2,C0,4);  VRD(2,1,2); SBAR(); \
    PVG(3,C0,6);  VRD(3,1,3); SBAR(); \
    PVG(4,C0,8);  VRD(0,2,0); SBAR(); \
    PVG(5,C0,10); VRD(1,2,1); SBAR(); \
    PVG(6,C0,12); VRD(2,2,2); SBAR(); \
    PVG(7,C0,14); VRD(3,2,3); SBAR(); \
    KRD(GL,0); PVG(8,C1,0);   VRD(0,3,0); SBAR(); \
    KRD(GL,1); PVG(9,C1,2);   VRD(1,3,1); SBAR(); \
    KRD(GL,2); PVG(10,C1,4);  VRD(2,3,2); SBAR(); \
    KRD(GL,3); PVG(11,C1,6);  VRD(3,3,3); SBAR(); \
    PVG(12,C1,8); PVG(13,C1,10); PVG(14,C1,12); PVG(15,C1,14); \
    }while(0)
  int t=1;
  #undef CMASK
  #define CMASK(P0,P1,t) do{}while(0)
  for(;t+5<NT;t+=2){
    STEP(pB0,pB1,pA0,pA1,t,true,true,true);     WAIT_BAR(3); RESC(); ROT();
    STEP(pA0,pA1,pB0,pB1,t+1,true,true,true);   WAIT_BAR(3); RESC(); ROT();
  }
  #undef CMASK
  #define CMASK(P0,P1,t) do{int jb_=(t)-(NT-4); if(jb_>=0)cmask(P0,P1,jb_,qrel,hi);}while(0)
  #define ENDW(tt) do{ if((tt)+3<NT){WAIT_BAR(3);} else if((tt)+2<NT){WAIT_BAR(2);} else {WAIT_BAR(0);} }while(0)
  for(;t+1<NT;t+=2){
    STEP(pB0,pB1,pA0,pA1,t,(t+3<NT),(t+1<NT),(t+1<NT));       ENDW(t);   RESC(); ROT();
    STEP(pA0,pA1,pB0,pB1,t+1,(t+4<NT),(t+2<NT),(t+2<NT));     ENDW(t+1); RESC(); ROT();
  }
  STEP(pB0,pB1,pA0,pA1,NT-1,false,false,false); RESC();
  { float sacc=pB0[0]+pB0[1]; _Pragma("unroll") for(int r=2;r<16;++r)sacc+=pB0[r]; _Pragma("unroll") for(int r=0;r<16;++r)sacc+=pB1[r]; l_reg+=sacc;
    pw0=(u32x4){PKW(pB0,0),PKW(pB0,2),PKW(pB0,4),PKW(pB0,6)};pw1=(u32x4){PKW(pB0,8),PKW(pB0,10),PKW(pB0,12),PKW(pB0,14)};pw2=(u32x4){PKW(pB1,0),PKW(pB1,2),PKW(pB1,4),PKW(pB1,6)};pw3=(u32x4){PKW(pB1,8),PKW(pB1,10),PKW(pB1,12),PKW(pB1,14)};
    SBAR(); pv(o,vb0+2*sl_cur,PAF(0),PAF(1),PAF(2),PAF(3)); }
  #undef PKW
  #undef PAF
  #undef PAFJ
  #undef PVG
  #undef VFR
  #undef PIN
  #undef MX3
  #undef GAPA
  #undef GAPB
  #undef EX
  #undef VRD
  #undef KRD
  #undef STEP
  #undef ENDW
  {auto rr=__builtin_amdgcn_permlane32_swap(__float_as_uint(l_reg),__float_as_uint(l_reg),false,false);l_reg=__uint_as_float(rr[0])+__uint_as_float(rr[1]);}
  if(hi==0)wsf[32+r32]=l_reg;asm volatile("s_waitcnt lgkmcnt(0)":::"memory");
  float rli[16];
  #pragma unroll
  for(int r=0;r<16;++r)rli[r]=__builtin_amdgcn_rcpf(wsf[32+crow(r,hi)]);
  bf16*stash=(bf16*)(shm+LDS_STASH)+wid*4096;
  if(st==0){
    #pragma unroll
    for(int r=0;r<16;++r){const int orow=crow(r,hi);
      #pragma unroll
      for(int d0=0;d0<4;++d0)stash[orow*128+d0*32+r32]=__float2bfloat16(o[d0][r]*rli[r]);}
  } else {
    asm volatile("s_waitcnt lgkmcnt(0)\n\ts_barrier":::"memory");
    bf16*stg=(bf16*)(shm+LDS_K)+wid*4096;
    #pragma unroll
    for(int r=0;r<16;++r){const int orow=crow(r,hi);
      #pragma unroll
      for(int d0=0;d0<4;++d0)stg[orow*128+d0*32+r32]=__float2bfloat16(o[d0][r]*rli[r]);}
    asm volatile("s_waitcnt lgkmcnt(0)":::"memory");
    bf16*Ow=Ob+(long)(q0+wid*QBLK)*PO;
    const int ch=lane&15; float sgv[8];
    #pragma unroll
    for(int i=0;i<8;++i)sgv[i]=sgp[ch*8+i]*(1.0f-LAMBDA_INIT);
    #pragma unroll
    for(int i=0;i<8;++i){const int row=i*4+(lane>>4);
      const u32x4 a4=*(const u32x4*)(stash+row*128+ch*8), b4=*(const u32x4*)(stg+row*128+ch*8);
      const unsigned aw[4]={a4.x,a4.y,a4.z,a4.w}, bw[4]={b4.x,b4.y,b4.z,b4.w}; float d[8]; float ss=0.f;
      #pragma unroll
      for(int c=0;c<4;++c){ d[2*c]=__uint_as_float(aw[c]<<16)-lam*__uint_as_float(bw[c]<<16); d[2*c+1]=__uint_as_float(aw[c]&0xffff0000u)-lam*__uint_as_float(bw[c]&0xffff0000u); ss+=d[2*c]*d[2*c]+d[2*c+1]*d[2*c+1]; }
      ss+=__shfl_xor(ss,1); ss+=__shfl_xor(ss,2); ss+=__shfl_xor(ss,4); ss+=__shfl_xor(ss,8);
      const float rn=rsqrtf(ss*(1.0f/128.0f)+LN_EPS);
#if OUTPROJ_FP8
      { unsigned char*Ow8=(unsigned char*)Ob+(long)(q0+wid*QBLK+row)*PO+ch*8;
        typedef unsigned u32x2_ __attribute__((ext_vector_type(2))); u32x2_ o8; o8.x=pg8::pk4_fp8(d[0]*rn*sgv[0],d[1]*rn*sgv[1],d[2]*rn*sgv[2],d[3]*rn*sgv[3]); o8.y=pg8::pk4_fp8(d[4]*rn*sgv[4],d[5]*rn*sgv[5],d[6]*rn*sgv[6],d[7]*rn*sgv[7]);
        *(u32x2_*)Ow8=o8; } }
#else
      u32x4 ov; ov.x=cvtpk_s(d[0]*rn*sgv[0],d[1]*rn*sgv[1]); ov.y=cvtpk_s(d[2]*rn*sgv[2],d[3]*rn*sgv[3]); ov.z=cvtpk_s(d[4]*rn*sgv[4],d[5]*rn*sgv[5]); ov.w=cvtpk_s(d[6]*rn*sgv[6],d[7]*rn*sgv[7]);
      ATTN_STORE16(Ow+(long)row*PO+ch*8,ov); }
#endif
  }
  asm volatile("s_waitcnt lgkmcnt(0)\n\ts_barrier":::"memory");
  #undef DMA_K
  #undef DMA_V
  #undef CMASK
  #undef START
  #undef RESC
  #undef ROT
}
constexpr int ATTN_LDS_BYTES=LDS_BYTES;
template<int THRL=8> __device__ __forceinline__ void attn_phase(char*lds,const bf16_t*proj,bf16_t*mix,int vcu,float lam,const float*sgp){
  const int bh=vcu>>3,s8=vcu&7,b=bh>>2,h=bh&3;
  const bf16*P0=(const bf16*)proj+(long)b*SEQ*PQ; bf16*O0=(bf16*)mix+(long)b*SEQ*PO+h*128;
  for(int i=0;i<4;++i){ const int qb=(i<2)?(15-s8):s8, st=i&1;
    attn_unit<THRL>(qb,st,lam,sgp,P0+C_Q+st*256+h*64,P0+C_K+st*256+h*64,P0+C_V+h*128,O0,lds); }
}
#undef SBAR
#undef WAIT_BAR
}

constexpr int NWAVES = 8;
constexpr int RING_OFF = 0, RING_BYTES = 131072;
constexpr int LDSCTL_OFF = 155648, MISC_OFF = LDSCTL_OFF + 320;
constexpr int TAB_OFF = LDSCTL_OFF + 1024;
constexpr int REC_OFF = LDSCTL_OFF + 2048;
constexpr int LDS_BYTES = 163840;
static_assert(pg8::PG8_META_OFF == LDSCTL_OFF + 2048 && pg8::PG8_META_OFF + 3 * pg8::PG8_META_SLOT <= LDS_BYTES && RING_OFF == 0, "GEMM unit-meta ring (overlays the router phase's REC area: different phases)");
static_assert(REC_OFF + (64 + 512) * 4 <= LDS_BYTES && attn_body::ATTN_LDS_BYTES <= LDSCTL_OFF && RING_BYTES <= LDSCTL_OFF, "LDS map");

#define GAS __attribute__((address_space(1)))
#define LAS __attribute__((address_space(3)))
typedef unsigned v4u __attribute__((ext_vector_type(4)));
typedef unsigned v2u __attribute__((ext_vector_type(2)));
typedef float f32x4 __attribute__((ext_vector_type(4)));
typedef float f32x2 __attribute__((ext_vector_type(2)));
typedef short bf16x8 __attribute__((ext_vector_type(8)));
typedef GAS unsigned gu32;
#define RLX_AGENT __ATOMIC_RELAXED, __HIP_MEMORY_SCOPE_AGENT
#define LDS_WAIT() asm volatile("s_waitcnt lgkmcnt(0)" ::: "memory")
#define VM_WAIT() asm volatile("s_waitcnt vmcnt(0)" ::: "memory")

#define XB_TMO      128
#define XB_XCNT(j)  (256  + 64 * (j))
#define XB_XSUB(j)  (1280 + 64 * (j))
#define XB_XGEN(j)  (2304 + 64 * (j))
#define XB_TOP      3328
#define XB_TOPGEN   3392
#define XCD_BAR_WORDS 3456
#define XB_SPIN_CAP (1u << 18)
__device__ __forceinline__ unsigned xb_ld(unsigned* p)              { return __hip_atomic_load(p, __ATOMIC_RELAXED, __HIP_MEMORY_SCOPE_AGENT); }
__device__ __forceinline__ unsigned xb_add(unsigned* p, unsigned v) { return __hip_atomic_fetch_add(p, v, __ATOMIC_RELAXED, __HIP_MEMORY_SCOPE_AGENT); }
__device__ __forceinline__ unsigned xb_xcc_id() { return (unsigned)__builtin_amdgcn_s_getreg((3 << 11) | 20) & 0xFu; }
#define XB_SPIN(cond, bar) do { unsigned _sp = 0; while (cond) { __builtin_amdgcn_s_sleep(1); \
    if ((++_sp & 255u) == 0u) { if (xb_ld(&(bar)[XB_TMO])) break; if (_sp > XB_SPIN_CAP) { atomicAdd(&(bar)[XB_TMO], 1u); break; } } } } while (0)
struct XcdBarrier { unsigned* bar; unsigned x; volatile LAS unsigned* st; };
__device__ __forceinline__ XcdBarrier xcd_barrier_post(unsigned* bar, volatile LAS unsigned* st) {
    XcdBarrier b; b.bar = bar; b.x = xb_xcc_id(); b.st = st;
    if (threadIdx.x == 0) (void)xb_add(&bar[XB_XCNT(b.x)], 1u);
    return b;
}
__device__ __forceinline__ void xcd_barrier_complete(unsigned* bar, unsigned x, unsigned& nloc, unsigned& nx) {
    const unsigned G = gridDim.x * gridDim.y * gridDim.z;
    unsigned sum, cnt, mine, sp = 0u;
    for (;;) {
        sum = 0u; cnt = 0u; mine = 0u;
#pragma unroll
        for (unsigned j = 0; j < 16; ++j) { const unsigned c = xb_ld(&bar[XB_XCNT(j)]); sum += c; cnt += (c > 0u) ? 1u : 0u; mine = (j == x) ? c : mine; }
        if (sum == G) break;
        __builtin_amdgcn_s_sleep(1);
        if ((++sp & 255u) == 0u) { if (xb_ld(&bar[XB_TMO])) break; if (sp > XB_SPIN_CAP) { atomicAdd(&bar[XB_TMO], 1u); break; } }
    }
    nloc = mine > 0u ? mine : 1u; nx = cnt > 0u ? cnt : 1u;
}
__device__ __forceinline__ void xcd_barrier(const XcdBarrier& b) {
    asm volatile("s_waitcnt vmcnt(0)" ::: "memory");
    __syncthreads();
    if (threadIdx.x == 0) {
        unsigned* bar = b.bar;
        __builtin_amdgcn_s_waitcnt(0);
#define XB_INV() asm volatile("buffer_inv sc1" ::: "memory")
        unsigned nloc = b.st[0], nx = b.st[1];
        if (nloc == 0u) { xcd_barrier_complete(bar, b.x, nloc, nx); b.st[0] = nloc; b.st[1] = nx; }
        const unsigned old = xb_add(&bar[XB_XSUB(b.x)], 1u);
        const unsigned gen = old / nloc;
        if (old + 1u == (gen + 1u) * nloc) {
            __builtin_amdgcn_fence(__ATOMIC_RELEASE, "agent");
            asm volatile("s_waitcnt vmcnt(0)" ::: "memory");
            const unsigned og = xb_add(&bar[XB_TOP], 1u);
            const unsigned tg = og / nx;
            const bool lastx = (og + 1u == (tg + 1u) * nx);
            XB_INV();
            if (lastx) xb_add(&bar[XB_TOPGEN], 1u);
            else XB_SPIN(xb_ld(&bar[XB_TOPGEN]) == tg, bar);
            xb_add(&bar[XB_XGEN(b.x)], 1u);
            asm volatile("s_waitcnt vmcnt(0)" ::: "memory");
        } else {
            XB_INV();
            XB_SPIN(xb_ld(&bar[XB_XGEN(b.x)]) == gen, bar);
            asm volatile("s_waitcnt vmcnt(0)" ::: "memory");
        }
    }
    __syncthreads();
#undef XB_INV
}

struct Args { const float* in[22]; float* out; unsigned char* ws; int ph_lo, ph_hi, pad0, pad1; };
struct Frame {
    LAS unsigned char* lds; volatile LAS unsigned* MISC; gu32* ctl;
    int tid, lane, wave, vcu, G;
};

typedef const __attribute__((address_space(4))) Args* kargs_t;
__device__ __forceinline__ Args fetch_args() {
    kargs_t kp = (kargs_t)__builtin_amdgcn_kernarg_segment_ptr();
    asm volatile("" : "+s"(kp));
    Args a;
#pragma unroll
    for (int i = 0; i < 22; ++i) a.in[i] = kp->in[i];
    a.out = kp->out; a.ws = kp->ws; a.ph_lo = kp->ph_lo; a.ph_hi = kp->ph_hi; a.pad0 = kp->pad0; a.pad1 = kp->pad1;
    return a;
}
__device__ __forceinline__ void refresh_frame(Frame& F) { int t = threadIdx.x; asm volatile("" : "+v"(t)); F.tid = t; F.lane = t & 63; F.wave = __builtin_amdgcn_readfirstlane(t >> 6); }

template <int CTRL> __device__ __forceinline__ float dppf(float v) { return __builtin_bit_cast(float, __builtin_amdgcn_update_dpp(0, __builtin_bit_cast(int, v), CTRL, 0xF, 0xF, true)); }
template <int CTRL> __device__ __forceinline__ int dppi(int v) { return __builtin_amdgcn_update_dpp(0, v, CTRL, 0xF, 0xF, true); }
__device__ __forceinline__ float rlf(float v, int l) { return __builtin_bit_cast(float, __builtin_amdgcn_readlane(__builtin_bit_cast(int, v), l)); }
__device__ __forceinline__ float wsum_dpp(float v) {
    v += dppf<0xB1>(v); v += dppf<0x4E>(v); v += dppf<0x141>(v); v += dppf<0x140>(v);
    return (rlf(v, 0) + rlf(v, 16)) + (rlf(v, 32) + rlf(v, 48));
}
__device__ __forceinline__ float wmax_dpp(float v) {
    v = fmaxf(v, dppf<0xB1>(v)); v = fmaxf(v, dppf<0x4E>(v)); v = fmaxf(v, dppf<0x141>(v)); v = fmaxf(v, dppf<0x140>(v));
    return fmaxf(fmaxf(rlf(v, 0), rlf(v, 16)), fmaxf(rlf(v, 32), rlf(v, 48)));
}
__device__ __forceinline__ int wmin_dpp(int v) {
    v = min(v, dppi<0xB1>(v)); v = min(v, dppi<0x4E>(v)); v = min(v, dppi<0x141>(v)); v = min(v, dppi<0x140>(v));
    return min(min(__builtin_amdgcn_readlane(v, 0), __builtin_amdgcn_readlane(v, 16)), min(__builtin_amdgcn_readlane(v, 32), __builtin_amdgcn_readlane(v, 48)));
}

__device__ __forceinline__ void p0_transpose_item(const float* W, int K, int N, bf16_t* WT, long row_off, LAS float* scr, int item, int lane) {
    const int nblk = N / 32, kb = item / nblk, nb = item % nblk, k0 = 64 * kb, n0 = 32 * nb;
#pragma unroll 8
    for (int i = 0; i < 32; ++i) { const int kk = 2 * i + (lane >> 5); scr[kk * 33 + (lane & 31)] = W[(size_t)(k0 + kk) * N + n0 + (lane & 31)]; }
    LDS_WAIT(); asm volatile("" ::: "memory");
    const int c = lane & 7;
#pragma unroll
    for (int j = 0; j < 4; ++j) { const int n = (lane >> 3) + 8 * j; const LAS float* s = scr + (8 * c) * 33 + n;
        v4u o; o.x = pk2(s[0 * 33], s[1 * 33]); o.y = pk2(s[2 * 33], s[3 * 33]); o.z = pk2(s[4 * 33], s[5 * 33]); o.w = pk2(s[6 * 33], s[7 * 33]);
        *(GAS v4u*)(WT + (size_t)(row_off + n0 + n) * K + k0 + 8 * c) = o; }
    LDS_WAIT(); asm volatile("" ::: "memory");
}
__device__ __forceinline__ void p0_transpose_item8(const float* W, int K, int N, unsigned char* WT, long row_off, LAS float* scr, int item, int lane) {
    const int nblk = N / 32, kb = item / nblk, nb = item % nblk, k0 = 64 * kb, n0 = 32 * nb;
#pragma unroll 8
    for (int i = 0; i < 32; ++i) { const int kk = 2 * i + (lane >> 5); scr[kk * 33 + (lane & 31)] = W[(size_t)(k0 + kk) * N + n0 + (lane & 31)]; }
    LDS_WAIT(); asm volatile("" ::: "memory");
    const int c = lane & 3; constexpr float SC = (float)(1 << pg8::WSHIFT);
#pragma unroll
    for (int j = 0; j < 2; ++j) { const int n = (lane >> 2) + 16 * j; const LAS float* s = scr + (16 * c) * 33 + n;
        v4u o; o.x = pg8::pk4_fp8(s[0 * 33] * SC, s[1 * 33] * SC, s[2 * 33] * SC, s[3 * 33] * SC); o.y = pg8::pk4_fp8(s[4 * 33] * SC, s[5 * 33] * SC, s[6 * 33] * SC, s[7 * 33] * SC);
        o.z = pg8::pk4_fp8(s[8 * 33] * SC, s[9 * 33] * SC, s[10 * 33] * SC, s[11 * 33] * SC); o.w = pg8::pk4_fp8(s[12 * 33] * SC, s[13 * 33] * SC, s[14 * 33] * SC, s[15 * 33] * SC);
        *(GAS v4u*)(WT + (size_t)(row_off + n0 + n) * K + k0 + 16 * c) = o; }
    LDS_WAIT(); asm volatile("" ::: "memory");
}
__device__ __forceinline__ void p0_prologue(Frame& F, const Args& a) {
    LAS float* scr = (LAS float*)(F.lds + RING_OFF + F.wave * 16384);
    const int gw = F.vcu * NWAVES + F.wave, NGW = F.G * NWAVES;
    unsigned char* ws = a.ws;
    constexpr int I_IN = (DM / 64) * (INW / 32), I_O = (DM / 64) * (DM / 32), I_UP1 = (DM / 64) * (2 * DFF / 32), I_DN1 = (DFF / 64) * (DM / 32);
    constexpr int NITEMS = I_IN + I_O + NE * I_UP1 + NE * I_DN1;
#if CONV_IN_ATTN
    constexpr int NITEMS_P0 = I_IN + I_O;
#else
    constexpr int NITEMS_P0 = NITEMS;
#endif
    for (int it = gw; it < NITEMS_P0; it += NGW) {
        int r = it;
        if (r < I_IN) { p0_transpose_item(a.in[1], DM, INW, (bf16_t*)(ws + WS_WIN), 0, scr, r, F.lane); continue; } r -= I_IN;
#if OUTPROJ_FP8
        if (r < I_O) { p0_transpose_item8(a.in[11], DM, DM, (unsigned char*)(ws + WS_WO), 0, scr, r, F.lane); continue; } r -= I_O;
#else
        if (r < I_O) { p0_transpose_item(a.in[11], DM, DM, (bf16_t*)(ws + WS_WO), 0, scr, r, F.lane); continue; } r -= I_O;
#endif
        if (r < NE * I_UP1) { const int e = r / I_UP1, ii = r % I_UP1; const int n0 = 32 * (ii % (2 * DFF / 32));
            const int bj = n0 / DFF, f = n0 % DFF, rho0 = 256 * (f / 128) + 128 * bj + (f % 128);
#if MOE_FP8
            p0_transpose_item8(a.in[16] + (size_t)e * DM * 2 * DFF, DM, 2 * DFF, (unsigned char*)(ws + WS_WUP) + (size_t)e * 2 * DFF * DM, (long)rho0 - n0, scr, ii, F.lane); continue; }
#else
            p0_transpose_item(a.in[16] + (size_t)e * DM * 2 * DFF, DM, 2 * DFF, (bf16_t*)(ws + WS_WUP) + (size_t)e * 2 * DFF * DM, (long)rho0 - n0, scr, ii, F.lane); continue; }
#endif
        r -= NE * I_UP1;
        { const int e = r / I_DN1, ii = r % I_DN1;
#if MOE_FP8
            p0_transpose_item8(a.in[18] + (size_t)e * DFF * DM, DFF, DM, (unsigned char*)(ws + WS_WDN) + (size_t)e * DM * DFF, 0, scr, ii, F.lane); }
#else
            p0_transpose_item(a.in[18] + (size_t)e * DFF * DM, DFF, DM, (bf16_t*)(ws + WS_WDN) + (size_t)e * DM * DFF, 0, scr, ii, F.lane); }
#endif
    }
    const float* x = a.in[0]; bf16_t* xb = (bf16_t*)(ws + WS_XB);
    for (int m = gw; m < NTOK; m += NGW) {
        const GAS f32x4* xr = (const GAS f32x4*)(x + (size_t)m * DM) + F.lane; GAS v2u* o8 = (GAS v2u*)(xb + (size_t)m * DM) + F.lane;
        f32x4 v[4];
#pragma unroll
        for (int j = 0; j < 4; ++j) v[j] = __builtin_nontemporal_load((const f32x4*)(xr + 64 * j));
#pragma unroll
        for (int j = 0; j < 4; ++j) { v2u o; o.x = pk2(v[j].x, v[j].y); o.y = pk2(v[j].z, v[j].w); __builtin_nontemporal_store(o, (v2u*)(o8 + 64 * j)); }
    }
}

struct CItem { const float* W; unsigned char* WT; int N, k0, n0, rowbase; };
__device__ __forceinline__ CItem conv_decode(int r, const Args& a) {
    constexpr int I_UP1 = (DM / 64) * (2 * DFF / 32), I_DN1 = (DFF / 64) * (DM / 32);
    CItem it;
    if (r < NE * I_UP1) { const int e = r / I_UP1, ii = r % I_UP1, nblk = 2 * DFF / 32; it.k0 = 64 * (ii / nblk); it.n0 = 32 * (ii % nblk);
        const int bj = it.n0 / DFF, f = it.n0 % DFF; it.rowbase = 256 * (f / 128) + 128 * bj + (f % 128);
        it.W = a.in[16] + (size_t)e * DM * 2 * DFF; it.WT = a.ws + WS_WUP + (size_t)e * 2 * DFF * DM; it.N = 2 * DFF; return it; }
    r -= NE * I_UP1;
    { const int e = r / I_DN1, ii = r % I_DN1, nblk = DM / 32; it.k0 = 64 * (ii / nblk); it.n0 = 32 * (ii % nblk); it.rowbase = it.n0;
        it.W = a.in[18] + (size_t)e * DFF * DM; it.WT = a.ws + WS_WDN + (size_t)e * DM * DFF; it.N = DM; return it; }
}
__device__ __forceinline__ void conv_load(const CItem& it, int lane, f32x4 (&t)[8]) {
    const int kr = lane >> 3, n4 = (lane & 7) * 4;
#pragma unroll
    for (int i = 0; i < 8; ++i) t[i] = __builtin_nontemporal_load((const f32x4*)(it.W + (size_t)(it.k0 + 8 * i + kr) * it.N + it.n0 + n4));
}
__device__ __forceinline__ void conv_finish(const CItem& it, int lane, const f32x4 (&t)[8], LAS float* scr, v4u (&outv)[2]) {
    const int kr = lane >> 3, n4 = (lane & 7) * 4;
#pragma unroll
    for (int i = 0; i < 8; ++i) { LAS float* d = scr + (8 * i + kr) * 33 + n4; d[0] = t[i].x; d[1] = t[i].y; d[2] = t[i].z; d[3] = t[i].w; }
    LDS_WAIT(); asm volatile("" ::: "memory");
    const int c = lane & 3; constexpr float SC = (float)(1 << pg8::WSHIFT);
#pragma unroll
    for (int j = 0; j < 2; ++j) { const int n = (lane >> 2) + 16 * j; const LAS float* sp = scr + (16 * c) * 33 + n;
        v4u o; o.x = pg8::pk4_fp8(sp[0 * 33] * SC, sp[1 * 33] * SC, sp[2 * 33] * SC, sp[3 * 33] * SC); o.y = pg8::pk4_fp8(sp[4 * 33] * SC, sp[5 * 33] * SC, sp[6 * 33] * SC, sp[7 * 33] * SC);
        o.z = pg8::pk4_fp8(sp[8 * 33] * SC, sp[9 * 33] * SC, sp[10 * 33] * SC, sp[11 * 33] * SC); o.w = pg8::pk4_fp8(sp[12 * 33] * SC, sp[13 * 33] * SC, sp[14 * 33] * SC, sp[15 * 33] * SC);
        outv[j] = o; }
    LDS_WAIT(); asm volatile("" ::: "memory");
}
__device__ __forceinline__ void conv_store(const CItem& it, int lane, const v4u (&outv)[2]) {
    const int c = lane & 3;
#pragma unroll
    for (int j = 0; j < 2; ++j) { const int n = (lane >> 2) + 16 * j; __builtin_nontemporal_store(outv[j], (v4u*)(it.WT + (size_t)(it.rowbase + n) * DM + it.k0 + 16 * c)); }
}
__device__ __forceinline__ void moe_weight_items(Frame& F, const Args& a, int first) {
    LAS float* scr = (LAS float*)(F.lds + RING_OFF + F.wave * 8448);
    const int gw = F.vcu * NWAVES + F.wave, NGW = F.G * NWAVES, lane = F.lane;
    const CItem i0 = conv_decode(gw + (first + 0) * NGW, a), i1 = conv_decode(gw + (first + 1) * NGW, a), i2 = conv_decode(gw + (first + 2) * NGW, a), i3 = conv_decode(gw + (first + 3) * NGW, a);
    const CItem i4 = conv_decode(gw + (first + 4) * NGW, a), i5 = conv_decode(gw + (first + 5) * NGW, a), i6 = conv_decode(gw + (first + 6) * NGW, a), i7 = conv_decode(gw + (first + 7) * NGW, a);
    f32x4 t0[8], t1[8], t2[8], t3[8], t4[8], t5[8];
    conv_load(i0, lane, t0); conv_load(i1, lane, t1); conv_load(i2, lane, t2); conv_load(i3, lane, t3); conv_load(i4, lane, t4); conv_load(i5, lane, t5);
    v4u o0[2], o1[2], o2[2], o3[2], o4[2], o5[2], o6[2], o7[2];
    conv_finish(i0, lane, t0, scr, o0); conv_load(i6, lane, t0);
    conv_finish(i1, lane, t1, scr, o1); conv_load(i7, lane, t1);
    conv_finish(i2, lane, t2, scr, o2); conv_finish(i3, lane, t3, scr, o3); conv_finish(i4, lane, t4, scr, o4); conv_finish(i5, lane, t5, scr, o5);
    conv_finish(i6, lane, t0, scr, o6); conv_finish(i7, lane, t1, scr, o7);
    conv_store(i0, lane, o0); conv_store(i1, lane, o1); conv_store(i2, lane, o2); conv_store(i3, lane, o3); conv_store(i4, lane, o4); conv_store(i5, lane, o5); conv_store(i6, lane, o6); conv_store(i7, lane, o7);
}

__device__ __forceinline__ void gmlp_phase(Frame& F, const Args& a) {
    const bf16_t* proj = (const bf16_t*)(a.ws + WS_PROJ); bf16_t* mix = (bf16_t*)(a.ws + WS_MIX);
    const float *lng = a.in[7], *lnb = a.in[8], *wsp = a.in[9], *bsp = a.in[10];
    LAS f32x2* st = (LAS f32x2*)(F.lds + RING_OFF);
    LAS bf16_t* Vg = (LAS bf16_t*)(F.lds + RING_OFF + 1024);
    LAS bf16_t* Wg = (LAS bf16_t*)(F.lds + RING_OFF + 19456);
    LAS float* Zg = (LAS float*)(F.lds + RING_OFF + 54272);
    const int tid = F.tid, lane = F.lane, w = F.wave;
    const int row = tid >> 2, cq = (tid & 3) * 16;
    for (int c = blockIdx.x; c < NTOK / CHUNK; c += F.G) {
        const size_t row0 = (size_t)c * CHUNK;
        v4u pgv[2], pgu[2]; f32x4 pwv[8], plg[4], plb[4]; float pbb;
#define GMLP_LOAD(g_) do { const int col_ = (g_) * GD + cq; \
            pgv[0] = *(const GAS v4u*)(proj + (row0 + row) * INW + C_GV + col_); pgv[1] = *(const GAS v4u*)(proj + (row0 + row) * INW + C_GV + col_ + 8); \
            pgu[0] = *(const GAS v4u*)(proj + (row0 + row) * INW + C_GU + col_); pgu[1] = *(const GAS v4u*)(proj + (row0 + row) * INW + C_GU + col_ + 8); \
            _Pragma("unroll") for (int k = 0; k < 8; ++k) { const int i_ = tid + 512 * k; pwv[k] = *(const GAS f32x4*)(wsp + ((size_t)(g_) * CHUNK + (i_ >> 5)) * CHUNK + (i_ & 31) * 4); } \
            _Pragma("unroll") for (int k = 0; k < 4; ++k) { plg[k] = *(const GAS f32x4*)(lng + col_ + 4 * k); plb[k] = *(const GAS f32x4*)(lnb + col_ + 4 * k); } \
            pbb = bsp[(g_) * CHUNK + row]; } while (0)
        GMLP_LOAD(0);
        {
            v4u raw[16];
#pragma unroll
            for (int i = 0; i < 16; ++i) raw[i] = *(const GAS v4u*)(proj + (row0 + 16 * w + i) * INW + C_GV + lane * 8);
#pragma unroll
            for (int i = 0; i < 16; ++i) {
                const unsigned rw[4] = {raw[i].x, raw[i].y, raw[i].z, raw[i].w}; float v[8]; float sum = 0.f;
#pragma unroll
                for (int k = 0; k < 4; ++k) { const f32x2 gg = (f32x2){bf2f((bf16_t)(rw[k] & 0xffff)), bf2f((bf16_t)(rw[k] >> 16))}; v[2 * k] = gg.x; v[2 * k + 1] = gg.y; sum += gg.x + gg.y; }
                const float mean = wsum_dpp(sum) * (1.0f / GW); float q = 0.f;
#pragma unroll
                for (int k = 0; k < 8; ++k) { const float d = v[k] - mean; q += d * d; }
                const float var = wsum_dpp(q) * (1.0f / GW);
                if (lane == 0) st[16 * w + i] = (f32x2){mean, rsqrtf(var + LN_EPS)};
            }
        }
        __syncthreads();
        for (int g = 0; g < NG; ++g) {
            const int col = g * GD + cq;
            const v4u cgu0 = pgu[0], cgu1 = pgu[1]; const float bb = pbb;
            {
                const f32x2 ms = st[row]; unsigned ow[8];
#pragma unroll
                for (int hh = 0; hh < 2; ++hh) { const unsigned rw[4] = {pgv[hh].x, pgv[hh].y, pgv[hh].z, pgv[hh].w};
#pragma unroll
                    for (int i = 0; i < 4; ++i) { const f32x2 gg = (f32x2){bf2f((bf16_t)(rw[i] & 0xffff)), bf2f((bf16_t)(rw[i] >> 16))};
                        const int e = hh * 8 + 2 * i; const f32x4 lg = plg[e >> 2], lb = plb[e >> 2];
                        const float g0 = (e & 2) ? lg.z : lg.x, g1 = (e & 2) ? lg.w : lg.y, b0 = (e & 2) ? lb.z : lb.x, b1 = (e & 2) ? lb.w : lb.y;
                        ow[hh * 4 + i] = pk2((gg.x - ms.x) * ms.y * g0 + b0, (gg.y - ms.x) * ms.y * g1 + b1); } }
                { const int sx = row ^ ((cq >> 4) << 4);
#pragma unroll
                  for (int e = 0; e < 8; ++e) { Vg[(cq + 2 * e) * 136 + sx] = (bf16_t)(ow[e] & 0xffffu); Vg[(cq + 2 * e + 1) * 136 + sx] = (bf16_t)(ow[e] >> 16); } }
#pragma unroll
                for (int k = 0; k < 8; ++k) { const int i = tid + 512 * k, t = i >> 5, s4 = (i & 31) * 4; const f32x4 wv = pwv[k];
                    v2u o; o.x = pk2(s4 <= t ? wv.x : 0.f, s4 + 1 <= t ? wv.y : 0.f); o.y = pk2(s4 + 2 <= t ? wv.z : 0.f, s4 + 3 <= t ? wv.w : 0.f);
                    *(LAS v2u*)(Wg + t * 136 + s4) = o; }
            }
            if (g + 1 < NG) GMLP_LOAD(g + 1);
            __syncthreads();
            {
                f32x4 acc[4];
#pragma unroll
                for (int n = 0; n < 4; ++n) acc[n] = (f32x4){0.f, 0.f, 0.f, 0.f};
                const int t0 = 16 * w, fr = lane & 15, fq = lane >> 4;
                for (int ks = 0; ks * 32 <= t0 + 15; ++ks) {
                    const bf16x8 af = *(const LAS bf16x8*)(Wg + (t0 + fr) * 136 + ks * 32 + fq * 8);
#pragma unroll
                    for (int n = 0; n < 4; ++n) { const bf16x8 bfv = *(const LAS bf16x8*)(Vg + (n * 16 + fr) * 136 + ((ks * 32 + fq * 8) ^ (n << 4)));
                        acc[n] = __builtin_amdgcn_mfma_f32_16x16x32_bf16(af, bfv, acc[n], 0, 0, 0); }
                }
#pragma unroll
                for (int n = 0; n < 4; ++n)
#pragma unroll
                    for (int r = 0; r < 4; ++r) Zg[(t0 + fq * 4 + r) * 68 + n * 16 + fr] = acc[n][r];
            }
            __syncthreads();
            {
#if OUTPROJ_FP8
                float ov_[16];
#pragma unroll
                for (int hh = 0; hh < 2; ++hh) { const v4u rawu = hh ? cgu1 : cgu0; const unsigned rw[4] = {rawu.x, rawu.y, rawu.z, rawu.w};
#pragma unroll
                    for (int i = 0; i < 4; ++i) { const f32x2 uu = (f32x2){bf2f((bf16_t)(rw[i] & 0xffff)), bf2f((bf16_t)(rw[i] >> 16))};
                        const f32x2 zz = *(const LAS f32x2*)(Zg + row * 68 + cq + hh * 8 + 2 * i);
                        ov_[hh * 8 + 2 * i] = uu.x * (zz.x + bb); ov_[hh * 8 + 2 * i + 1] = uu.y * (zz.y + bb); } }
                *(GAS v4u*)((unsigned char*)mix + (size_t)(row0 + row) * DM + GW + col) = (v4u){pg8::pk4_fp8(ov_[0], ov_[1], ov_[2], ov_[3]), pg8::pk4_fp8(ov_[4], ov_[5], ov_[6], ov_[7]),
                                                                                              pg8::pk4_fp8(ov_[8], ov_[9], ov_[10], ov_[11]), pg8::pk4_fp8(ov_[12], ov_[13], ov_[14], ov_[15])};
#else
                unsigned ow[8];
#pragma unroll
                for (int hh = 0; hh < 2; ++hh) { const v4u rawu = hh ? cgu1 : cgu0; const unsigned rw[4] = {rawu.x, rawu.y, rawu.z, rawu.w};
#pragma unroll
                    for (int i = 0; i < 4; ++i) { const f32x2 uu = (f32x2){bf2f((bf16_t)(rw[i] & 0xffff)), bf2f((bf16_t)(rw[i] >> 16))};
                        const f32x2 zz = *(const LAS f32x2*)(Zg + row * 68 + cq + hh * 8 + 2 * i);
                        ow[hh * 4 + i] = pk2(uu.x * (zz.x + bb), uu.y * (zz.y + bb)); } }
                GAS v4u* dst = (GAS v4u*)(mix + (row0 + row) * DM + GW + col);
                dst[0] = (v4u){ow[0], ow[1], ow[2], ow[3]}; dst[1] = (v4u){ow[4], ow[5], ow[6], ow[7]};
#endif
            }
        }
        __syncthreads();
#undef GMLP_LOAD
    }
}

__device__ __forceinline__ void attn_combine_phase(Frame& F, const Args& a) {
    const bf16_t* atto = (const bf16_t*)(a.ws + WS_ATTO); bf16_t* mix = (bf16_t*)(a.ws + WS_MIX);
    const int lane = F.lane, gw = F.vcu * NWAVES + F.wave, NGW = F.G * NWAVES;
    const float lam = expf(wave_sum(a.in[2][lane] * a.in[3][lane])) - expf(wave_sum(a.in[4][lane] * a.in[5][lane])) + LAMBDA_INIT;
    const int h = lane >> 4, e0 = (lane & 15) * 8;
    float sg[8];
#pragma unroll
    for (int i = 0; i < 8; ++i) sg[i] = a.in[6][e0 + i] * (1.0f - LAMBDA_INIT);
    for (int t = gw; t < NTOK; t += NGW) {
        const v4u r1 = *(const GAS v4u*)(atto + (size_t)t * DM + h * 256 + e0), r2 = *(const GAS v4u*)(atto + (size_t)t * DM + h * 256 + 128 + e0);
        const unsigned w1[4] = {r1.x, r1.y, r1.z, r1.w}, w2[4] = {r2.x, r2.y, r2.z, r2.w};
        float d[8]; float ss = 0.f;
#pragma unroll
        for (int i = 0; i < 4; ++i) { d[2 * i] = bf2f((bf16_t)(w1[i] & 0xffff)) - lam * bf2f((bf16_t)(w2[i] & 0xffff)); d[2 * i + 1] = bf2f((bf16_t)(w1[i] >> 16)) - lam * bf2f((bf16_t)(w2[i] >> 16)); ss += d[2 * i] * d[2 * i] + d[2 * i + 1] * d[2 * i + 1]; }
        ss += __shfl_xor(ss, 1); ss += __shfl_xor(ss, 2); ss += __shfl_xor(ss, 4); ss += __shfl_xor(ss, 8);
        const float r = rsqrtf(ss * (1.0f / DV) + LN_EPS);
        v4u o; o.x = pk2(d[0] * r * sg[0], d[1] * r * sg[1]); o.y = pk2(d[2] * r * sg[2], d[3] * r * sg[3]); o.z = pk2(d[4] * r * sg[4], d[5] * r * sg[5]); o.w = pk2(d[6] * r * sg[6], d[7] * r * sg[7]);
        *(GAS v4u*)(mix + (size_t)t * DM + h * DV + e0) = o;
    }
}

__device__ __forceinline__ void route_phase(Frame& F, const Args& a) {
    const bf16_t* h1 = (const bf16_t*)(a.ws + WS_H1); bf16_t* xb = (bf16_t*)(a.ws + WS_XB); bf16_t* x1b = (bf16_t*)(a.ws + WS_X1B);
    int* list = (int*)(a.ws + WS_LIST); int* re = (int*)(a.ws + WS_RE); int* rr = (int*)(a.ws + WS_RR); float* rg = (float*)(a.ws + WS_RG);
    const float *g1 = a.in[12], *b1 = a.in[13], *wr = a.in[14], *br = a.in[15];
    constexpr int XS = 1028;
    LAS float* XT = (LAS float*)(F.lds + RING_OFF);
    LAS float* PT = (LAS float*)(F.lds + RING_OFF + 16 * XS * 4);
    LAS float* LT = (LAS float*)(F.lds + RING_OFF + 16 * XS * 4 + 8 * 16 * 32 * 4);
    LAS int* lcnt = (LAS int*)(F.lds + REC_OFF); LAS int* lbase = lcnt + 32; LAS int* rec = lcnt + 64;
    const int tid = F.tid, lane = F.lane, w = F.wave, fr = lane & 15, fq = lane >> 4;
    if (tid < 32) lcnt[tid] = 0;
    constexpr int RPB = NTOK / 256;
    const int tblk = blockIdx.x * RPB;
    v2u praw[2][4];
#define ROUTE_LOAD(ch_) do { _Pragma("unroll") for (int q = 0; q < 2; ++q) _Pragma("unroll") for (int j = 0; j < 4; ++j) \
        praw[q][j] = *(const GAS v2u*)(h1 + (size_t)(tblk + (ch_) * 16 + 2 * w + q) * DM + j * 256 + lane * 4); } while (0)
    ROUTE_LOAD(0);
    bf16x8 bwh[4][2], bwl[4][2];
#pragma unroll
    for (int ks = 0; ks < 4; ++ks)
#pragma unroll
        for (int n = 0; n < 2; ++n) { float wv[8];
#pragma unroll
            for (int j = 0; j < 8; ++j) wv[j] = wr[(size_t)(128 * w + 32 * ks + 8 * fq + j) * NE + 16 * n + fr];
            unsigned hh[4], ll[4];
#pragma unroll
            for (int j = 0; j < 4; ++j) { hh[j] = pk2(wv[2 * j], wv[2 * j + 1]);
                ll[j] = pk2(wv[2 * j] - __uint_as_float(hh[j] << 16), wv[2 * j + 1] - __uint_as_float(hh[j] & 0xffff0000u)); }
            bwh[ks][n] = __builtin_bit_cast(bf16x8, (v4u){hh[0], hh[1], hh[2], hh[3]}); bwl[ks][n] = __builtin_bit_cast(bf16x8, (v4u){ll[0], ll[1], ll[2], ll[3]}); }
    const int myexp = lane & 31; const float mybr = br[myexp];
    f32x4 g1v[4], b1v[4];
#pragma unroll
    for (int j = 0; j < 4; ++j) { g1v[j] = *(const GAS f32x4*)(g1 + j * 256 + lane * 4); b1v[j] = *(const GAS f32x4*)(b1 + j * 256 + lane * 4); }
    for (int ch = 0; ch < 8; ++ch) {
        const int t0 = tblk + ch * 16;
        {
            f32x4 pv[2][4];
#pragma unroll
            for (int q = 0; q < 2; ++q)
#pragma unroll
                for (int j = 0; j < 4; ++j) { const v2u hw_ = praw[q][j]; pv[q][j] = (f32x4){__uint_as_float(hw_.x << 16), __uint_as_float(hw_.x & 0xffff0000u), __uint_as_float(hw_.y << 16), __uint_as_float(hw_.y & 0xffff0000u)}; }
            float mean[2], rstd[2];
#pragma unroll
            for (int q = 0; q < 2; ++q) { float s = 0.f;
#pragma unroll
                for (int j = 0; j < 4; ++j) s += (pv[q][j].x + pv[q][j].y) + (pv[q][j].z + pv[q][j].w);
                mean[q] = wsum_dpp(s) * (1.0f / DM); }
#pragma unroll
            for (int q = 0; q < 2; ++q) { float q2 = 0.f;
#pragma unroll
                for (int j = 0; j < 4; ++j) { pv[q][j] = pv[q][j] - mean[q]; q2 += (pv[q][j].x * pv[q][j].x + pv[q][j].y * pv[q][j].y) + (pv[q][j].z * pv[q][j].z + pv[q][j].w * pv[q][j].w); }
                rstd[q] = rsqrtf(wsum_dpp(q2) * (1.0f / DM) + LN_EPS); }
#pragma unroll
            for (int j = 0; j < 4; ++j) {
                const int col = j * 256 + lane * 4;
                const f32x4 gq = g1v[j], bq = b1v[j];
#pragma unroll
                for (int q = 0; q < 2; ++q) {
                    const int rl = 2 * w + q, t = t0 + rl;
                    const f32x4 o = pv[q][j] * rstd[q] * gq + bq;
                    { v2u pk1; pk1.x = pk2(o.x, o.y); pk1.y = pk2(o.z, o.w); *(GAS v2u*)(x1b + (size_t)t * DM + col) = pk1; }
                    *(LAS f32x4*)(XT + rl * XS + col) = o;
#if MOE_FP8
                    *(GAS unsigned*)((unsigned char*)xb + (size_t)t * DM + col) = pg8::pk4_fp8(o.x, o.y, o.z, o.w);
#else
                    v2u pk; pk.x = pk2(o.x, o.y); pk.y = pk2(o.z, o.w);
                    *(GAS v2u*)(xb + (size_t)t * DM + col) = pk;
#endif
                }
            }
        }
        if (ch < 7) ROUTE_LOAD(ch + 1);
        __syncthreads();
        {
            f32x4 acc0 = (f32x4){0.f, 0.f, 0.f, 0.f}, acc1 = (f32x4){0.f, 0.f, 0.f, 0.f};
            const LAS float* xp = XT + fr * XS + 128 * w + 8 * fq;
#pragma unroll
            for (int ks = 0; ks < 4; ++ks) { const f32x4 x0 = *(const LAS f32x4*)(xp + 32 * ks), x1 = *(const LAS f32x4*)(xp + 32 * ks + 4);
                unsigned hh[4], ll[4];
                hh[0] = pk2(x0.x, x0.y); hh[1] = pk2(x0.z, x0.w); hh[2] = pk2(x1.x, x1.y); hh[3] = pk2(x1.z, x1.w);
                ll[0] = pk2(x0.x - __uint_as_float(hh[0] << 16), x0.y - __uint_as_float(hh[0] & 0xffff0000u)); ll[1] = pk2(x0.z - __uint_as_float(hh[1] << 16), x0.w - __uint_as_float(hh[1] & 0xffff0000u));
                ll[2] = pk2(x1.x - __uint_as_float(hh[2] << 16), x1.y - __uint_as_float(hh[2] & 0xffff0000u)); ll[3] = pk2(x1.z - __uint_as_float(hh[3] << 16), x1.w - __uint_as_float(hh[3] & 0xffff0000u));
                const bf16x8 ah = __builtin_bit_cast(bf16x8, (v4u){hh[0], hh[1], hh[2], hh[3]}), al = __builtin_bit_cast(bf16x8, (v4u){ll[0], ll[1], ll[2], ll[3]});
                acc0 = __builtin_amdgcn_mfma_f32_16x16x32_bf16(ah, bwh[ks][0], acc0, 0, 0, 0); acc1 = __builtin_amdgcn_mfma_f32_16x16x32_bf16(ah, bwh[ks][1], acc1, 0, 0, 0);
                acc0 = __builtin_amdgcn_mfma_f32_16x16x32_bf16(ah, bwl[ks][0], acc0, 0, 0, 0); acc1 = __builtin_amdgcn_mfma_f32_16x16x32_bf16(ah, bwl[ks][1], acc1, 0, 0, 0);
                acc0 = __builtin_amdgcn_mfma_f32_16x16x32_bf16(al, bwh[ks][0], acc0, 0, 0, 0); acc1 = __builtin_amdgcn_mfma_f32_16x16x32_bf16(al, bwh[ks][1], acc1, 0, 0, 0); }
#pragma unroll
            for (int r = 0; r < 4; ++r) { PT[(w * 16 + fq * 4 + r) * 32 + fr] = acc0[r]; PT[(w * 16 + fq * 4 + r) * 32 + 16 + fr] = acc1[r]; }
        }
        __syncthreads();
        {
            float cur[2];
#pragma unroll
            for (int q = 0; q < 2; ++q) { cur[q] = mybr;
#pragma unroll
                for (int ww = 0; ww < 8; ++ww) cur[q] += PT[(ww * 16 + 2 * w + q) * 32 + myexp]; }
            if (lane < 32) {
#pragma unroll
                for (int q = 0; q < 2; ++q) LT[(ch * 16 + 2 * w + q) * 33 + myexp] = cur[q]; }
        }
    }
#undef ROUTE_LOAD
    __syncthreads();
    if (lane < 16) {
        const int rl = 16 * w + lane, t = tblk + rl; const LAS float* lr_ = LT + rl * 33;
        float lv[32];
#pragma unroll
        for (int e = 0; e < 32; ++e) lv[e] = lr_[e];
        int idx[4]; float val[4];
#pragma unroll
        for (int k = 0; k < 4; ++k) { float m = lv[0]; int bi = 0;
#pragma unroll
            for (int e = 1; e < 32; ++e) { const bool gt = lv[e] > m; m = gt ? lv[e] : m; bi = gt ? e : bi; }
            idx[k] = bi; val[k] = m;
#pragma unroll
            for (int e = 0; e < 32; ++e) lv[e] = (e == bi) ? -INFINITY : lv[e]; }
        float ex[4], se = 0.f;
#pragma unroll
        for (int k = 0; k < 4; ++k) { ex[k] = expf(val[k] - val[0]); se += ex[k]; }
#pragma unroll
        for (int k = 0; k < 4; ++k) {
            const int lrk = __hip_atomic_fetch_add(lcnt + idx[k], 1, __ATOMIC_RELAXED, __HIP_MEMORY_SCOPE_WORKGROUP);
            rec[rl * 4 + k] = idx[k] | (lrk << 8);
            re[t * 4 + k] = idx[k]; rg[t * 4 + k] = ex[k] / se; }
    }
    __syncthreads();
    if (tid < 32) lbase[tid] = (int)__hip_atomic_fetch_add((unsigned*)(F.ctl + CW_CNT + tid), (unsigned)lcnt[tid], RLX_AGENT);
    __syncthreads();
    { const int rw = tid >> 2, k = tid & 3; const int t = tblk + rw; const int rc = rec[tid]; const int e_ = rc & 255, r_ = lbase[e_] + (rc >> 8);
      rr[t * 4 + k] = r_; list[e_ * NTOK + r_] = t; }
}
__device__ __forceinline__ void build_tab(Frame& F) {
    LAS int* tab = (LAS int*)(F.lds + TAB_OFF);
    if (F.tid < 32) tab[40 + F.tid] = (int)__hip_atomic_load(F.ctl + CW_CNT + F.tid, RLX_AGENT);
    __syncthreads();
    if (F.tid == 0) { int p = 0; for (int e = 0; e < NE; ++e) { tab[e] = p; p += (tab[40 + e] + 255) >> 8; } tab[NE] = p; }
    __syncthreads();
}
__device__ __forceinline__ void combine_phase(Frame& F, const Args& a) {
    const bf16_t* x1 = (const bf16_t*)(a.ws + WS_X1B); const unsigned char* y = (const unsigned char*)(a.ws + WS_Y);
    const int* re = (const int*)(a.ws + WS_RE); const int* rr = (const int*)(a.ws + WS_RR); const float* rg = (const float*)(a.ws + WS_RG);
    float* out = a.out;
    const LAS int* tab = (const LAS int*)(F.lds + TAB_OFF);
    const int lane = F.lane, gw = F.vcu * NWAVES + F.wave, NGW = F.G * NWAVES, c0 = lane * 16;
    f32x4 g2v[4], b2v[4];
#pragma unroll
    for (int j = 0; j < 4; ++j) { g2v[j] = *(const GAS f32x4*)(a.in[20] + c0 + 4 * j); b2v[j] = *(const GAS f32x4*)(a.in[21] + c0 + 4 * j); }
    for (int tt = gw; tt < NTOK; tt += 2 * NGW) {
        float v[2][16];
#pragma unroll
        for (int q = 0; q < 2; ++q) {
            const int t = tt + q * NGW;
            const v4u xa = *(const GAS v4u*)(x1 + (size_t)t * DM + c0), xb_ = *(const GAS v4u*)(x1 + (size_t)t * DM + c0 + 8);
            const unsigned xw[8] = {xa.x, xa.y, xa.z, xa.w, xb_.x, xb_.y, xb_.z, xb_.w};
#pragma unroll
            for (int i = 0; i < 8; ++i) { v[q][2 * i] = ALPHA * bf2f((bf16_t)(xw[i] & 0xffff)); v[q][2 * i + 1] = ALPHA * bf2f((bf16_t)(xw[i] >> 16)); }
#pragma unroll
            for (int k = 0; k < 4; ++k) {
                const int e = re[t * 4 + k], slot = tab[e] * 256 + rr[t * 4 + k]; const float g = rg[t * 4 + k];
#if MOE_FP8
                const v4u yw = *(const GAS v4u*)(y + (size_t)slot * DM + c0); const unsigned yy[4] = {yw.x, yw.y, yw.z, yw.w};
#pragma unroll
                for (int i = 0; i < 4; ++i) { const f32x2 lo = __builtin_amdgcn_cvt_pk_f32_fp8((int)yy[i], false), hi = __builtin_amdgcn_cvt_pk_f32_fp8((int)yy[i], true);
                    v[q][4 * i] = fmaf(g, lo.x, v[q][4 * i]); v[q][4 * i + 1] = fmaf(g, lo.y, v[q][4 * i + 1]); v[q][4 * i + 2] = fmaf(g, hi.x, v[q][4 * i + 2]); v[q][4 * i + 3] = fmaf(g, hi.y, v[q][4 * i + 3]); }
#else
                const v4u ya = *(const GAS v4u*)((const bf16_t*)y + (size_t)slot * DM + c0), yb = *(const GAS v4u*)((const bf16_t*)y + (size_t)slot * DM + c0 + 8);
                const unsigned yy[8] = {ya.x, ya.y, ya.z, ya.w, yb.x, yb.y, yb.z, yb.w};
#pragma unroll
                for (int i = 0; i < 8; ++i) { v[q][2 * i] = fmaf(g, bf2f((bf16_t)(yy[i] & 0xffff)), v[q][2 * i]); v[q][2 * i + 1] = fmaf(g, bf2f((bf16_t)(yy[i] >> 16)), v[q][2 * i + 1]); }
#endif
            }
        }
#pragma unroll
        for (int q = 0; q < 2; ++q) {
            const int t = tt + q * NGW;
            float s = 0.f;
#pragma unroll
            for (int i = 0; i < 16; ++i) s += v[q][i];
            const float mean = wsum_dpp(s) * (1.0f / DM); float q2 = 0.f;
#pragma unroll
            for (int i = 0; i < 16; ++i) { v[q][i] -= mean; q2 += v[q][i] * v[q][i]; }
            const float rstd = rsqrtf(wsum_dpp(q2) * (1.0f / DM) + LN_EPS);
#pragma unroll
            for (int j = 0; j < 4; ++j)
                *(GAS f32x4*)(out + (size_t)t * DM + c0 + 4 * j) = (f32x4){v[q][4 * j] * rstd * g2v[j].x + b2v[j].x, v[q][4 * j + 1] * rstd * g2v[j].y + b2v[j].y, v[q][4 * j + 2] * rstd * g2v[j].z + b2v[j].z, v[q][4 * j + 3] * rstd * g2v[j].w + b2v[j].w};
        }
    }
}

#ifndef ALIGN_H1
#define ALIGN_H1 true
#endif
#ifndef ALIGN_UP
#define ALIGN_UP true
#endif
#ifndef META_UP
#define META_UP false
#endif
#ifndef META_DN
#define META_DN false
#endif
constexpr int N_PHASES = 9;
__global__ void __launch_bounds__(NWAVES * 64, 2) mega_fwd(Args args) {
    extern __shared__ __attribute__((aligned(16))) unsigned char lds[];
    Frame F;
    F.lds = (LAS unsigned char*)lds;
    F.MISC = (volatile LAS unsigned*)(F.lds + MISC_OFF);
    F.tid = threadIdx.x; F.lane = F.tid & 63; F.wave = __builtin_amdgcn_readfirstlane(F.tid >> 6);
    F.G = gridDim.x; { const int bx = blockIdx.x; F.vcu = (F.G % 8 == 0) ? (bx % 8) * (F.G / 8) + bx / 8 : bx; }
    F.ctl = (gu32*)(args.ws + WS_CTL);
    for (int u = F.tid; u < (LDS_BYTES - LDSCTL_OFF) / 4; u += NWAVES * 64) ((LAS unsigned*)(F.lds + LDSCTL_OFF))[u] = 0u;
    __syncthreads();
    const int lo = args.ph_lo, hi = args.ph_hi;
    const bool multi = (hi - lo) > 1;
    XcdBarrier bar; bar.bar = (unsigned*)(F.ctl + CW_BAR); bar.x = 0; bar.st = nullptr;
    if (multi) bar = xcd_barrier_post((unsigned*)(F.ctl + CW_BAR), F.MISC + 8);
#ifndef PH_MASK
#define PH_MASK 0x1FF
#endif
#define IN(k) ((((PH_MASK) >> (k)) & 1) && lo <= (k) && (k) < hi)
#define SEAM(k) do { if (IN(k) && IN((k) + 1)) xcd_barrier(bar); } while (0)
#ifndef DOUBLE_MASK
#define DOUBLE_MASK 0
#endif
#define REP(k) for (int rep_ = 0; rep_ < ((((DOUBLE_MASK) >> (k)) & 1) + 1); ++rep_)
#if defined(PROBE_M0)
    if (IN(0) && blockIdx.x == 0 && F.wave == 0) {
        const Args A = fetch_args();
        LAS unsigned* hi = (LAS unsigned*)(F.lds + 0x26800); LAS unsigned* lo = (LAS unsigned*)(F.lds + 0x6800);
        for (int i = F.lane; i < 256; i += 64) { hi[i] = 0u; lo[i] = 0u; }
        asm volatile("s_waitcnt lgkmcnt(0)" ::: "memory");
        { unsigned keep_; const char* sb = (const char*)A.in[0]; unsigned vo = F.lane * 16u, dst = 0x26800u;
          asm volatile("s_mov_b32 %0, m0\n\ts_mov_b32 m0, %3\n\ts_nop 0\n\tglobal_load_lds_dwordx4 %1, %2\n\ts_mov_b32 m0, %0" : "=&s"(keep_) : "v"(vo), "s"(sb), "s"(dst) : "memory"); }
        asm volatile("s_waitcnt vmcnt(0)" ::: "memory");
        unsigned nzh = 0u, nzl = 0u;
        for (int i = F.lane; i < 256; i += 64) { nzh |= ((volatile LAS unsigned*)hi)[i]; nzl |= ((volatile LAS unsigned*)lo)[i]; }
        const bool landed_high = __any(nzh != 0u);
#if PROBE_M0 == 2
        const bool delay = landed_high;
#else
        const bool delay = !landed_high;
#endif
        if (delay) { const unsigned long long t0 = __builtin_amdgcn_s_memrealtime(); while (__builtin_amdgcn_s_memrealtime() - t0 < 30000ull) __builtin_amdgcn_s_sleep(8); }
        for (int i = F.lane; i < 256; i += 64) { hi[i] = 0u; lo[i] = 0u; }
        asm volatile("s_waitcnt lgkmcnt(0)" ::: "memory");
    }
    __syncthreads();
#endif
    if (IN(0)) { REP(0) { refresh_frame(F); const Args A = fetch_args(); p0_prologue(F, A); } SEAM(0); }
    if (IN(1)) { REP(1) {
        refresh_frame(F); const Args A = fetch_args(); unsigned char* ws = A.ws;
        pg8::Gemm g{(const bf16_t*)(ws + WS_XB), (const bf16_t*)(ws + WS_WIN), NTOK, INW, DM, 0}; pg8::StaticOrder S; S.init(NTOK, INW, F.G, (int)blockIdx.x);
        pg8::EpiProj E{(bf16_t*)(ws + WS_PROJ)};
        pg8::gemm_phase<pg8::EpiProj, pg8::StaticOrder, false>(F.lds + RING_OFF, g, S, E);
        } SEAM(1);
    }
    if (IN(2)) { REP(2) {
        refresh_frame(F); const Args A = fetch_args(); unsigned char* ws = A.ws;
#ifndef P2_REP_SUB
#define P2_REP_SUB 3
#endif
        const int sub_ = (rep_ == 0) ? A.pad0 : (A.pad0 & P2_REP_SUB);
        if (sub_ & 1) { const float lam = expf(wave_sum(A.in[2][F.lane] * A.in[3][F.lane])) - expf(wave_sum(A.in[4][F.lane] * A.in[5][F.lane])) + LAMBDA_INIT;
#if CONV_IN_ATTN
            {
                const int vcu = F.vcu, bh = vcu >> 3, s8 = vcu & 7, b = bh >> 2, h = bh & 3;
                const attn_body::bf16* P0 = (const attn_body::bf16*)(ws + WS_PROJ) + (long)b * SEQ * INW;
#if OUTPROJ_FP8
                attn_body::bf16* O0 = (attn_body::bf16*)(ws + WS_MIX + (size_t)b * SEQ * DM + h * 128);
#else
                attn_body::bf16* O0 = (attn_body::bf16*)(ws + WS_MIX) + (long)b * SEQ * DM + h * 128;
#endif

                for (int i = 0; i < 4; ++i) { const int qb = (i < 2) ? (15 - s8) : s8, st = i & 1;
                    attn_body::attn_unit<8>(qb, st, lam, A.in[6], P0 + C_Q + st * 256 + h * 64, P0 + C_K + st * 256 + h * 64, P0 + C_V + h * 128, O0, (char*)lds + RING_OFF);
                    if (rep_ == 0 && i < 3) { moe_weight_items(F, A, 8 * i); __syncthreads(); } }
            }
#else
            attn_body::attn_phase<8>((char*)lds + RING_OFF, (const bf16_t*)(ws + WS_PROJ), (bf16_t*)(ws + WS_MIX), F.vcu, lam, A.in[6]);
#endif
            }
        if (sub_ & 2) gmlp_phase(F, A);
        }
    }
    if (IN(3)) { SEAM(3); }
    if (IN(4)) { REP(4) {
        refresh_frame(F); const Args A = fetch_args(); unsigned char* ws = A.ws;
        pg8::Gemm g{(const bf16_t*)(ws + WS_MIX), (const bf16_t*)(ws + WS_WO), NTOK, DM, DM, 0}; pg8::StaticOrder S; S.init(NTOK, DM, F.G, (int)blockIdx.x);
#if OUTPROJ_FP8
        pg8::EpiH1 E{(const bf16_t*)(ws + WS_XB), (bf16_t*)(ws + WS_H1), pg8::WUNSCALE};
        pg8::gemm_phase<pg8::EpiH1, pg8::StaticOrder, false, true, false, ALIGN_H1>(F.lds + RING_OFF, g, S, E);
#else
        pg8::EpiH1 E{(const bf16_t*)(ws + WS_XB), (bf16_t*)(ws + WS_H1), 1.0f};
        pg8::gemm_phase<pg8::EpiH1, pg8::StaticOrder, false, false, false, ALIGN_H1>(F.lds + RING_OFF, g, S, E);
#endif
        } SEAM(4);
    }
    if (IN(5)) { REP(5) { refresh_frame(F); const Args A = fetch_args(); route_phase(F, A); } SEAM(5); }
    if (IN(6)) { REP(6) {
        refresh_frame(F); const Args A = fetch_args(); unsigned char* ws = A.ws;
        build_tab(F);
        pg8::MoeOrder S; S.init((const LAS int*)(F.lds + TAB_OFF), (const int*)(ws + WS_LIST), 8, (int)blockIdx.x);
#if MOE_FP8
        pg8::Gemm g{(const bf16_t*)(ws + WS_XB), (const bf16_t*)(ws + WS_WUP), PADROWS, 2 * DFF, DM, (size_t)2 * DFF * DM / 2};
        pg8::EpiSwiglu8 E{(unsigned char*)(ws + WS_ACT), A.in[17]};
        pg8::gemm_phase<pg8::EpiSwiglu8, pg8::MoeOrder, true, true, META_UP, ALIGN_UP>(F.lds + RING_OFF, g, S, E);
#else
        pg8::Gemm g{(const bf16_t*)(ws + WS_XB), (const bf16_t*)(ws + WS_WUP), PADROWS, 2 * DFF, DM, (size_t)2 * DFF * DM};
        pg8::EpiSwiglu E{(bf16_t*)(ws + WS_ACT), A.in[17]};
        pg8::gemm_phase<pg8::EpiSwiglu, pg8::MoeOrder, true>(F.lds + RING_OFF, g, S, E);
#endif
        } SEAM(6);
    }
    if (IN(7)) { REP(7) {
        refresh_frame(F); const Args A = fetch_args(); unsigned char* ws = A.ws;
        build_tab(F);
        pg8::MoeOrder S; S.init((const LAS int*)(F.lds + TAB_OFF), (const int*)(ws + WS_LIST), 4, (int)blockIdx.x);
#if MOE_FP8
        pg8::EpiDown8 E{(unsigned char*)(ws + WS_Y), A.in[19]};
        pg8::Gemm g{(const bf16_t*)(ws + WS_ACT), (const bf16_t*)(ws + WS_WDN), PADROWS, DM, DFF, (size_t)DM * DFF / 2};
        pg8::gemm_phase<pg8::EpiDown8, pg8::MoeOrder, false, true, META_DN>(F.lds + RING_OFF, g, S, E);
#else
        pg8::EpiDown E{(bf16_t*)(ws + WS_Y), A.in[19]};
        pg8::Gemm g{(const bf16_t*)(ws + WS_ACT), (const bf16_t*)(ws + WS_WDN), PADROWS, DM, DFF, (size_t)DM * DFF};
        pg8::gemm_phase<pg8::EpiDown, pg8::MoeOrder, false>(F.lds + RING_OFF, g, S, E);
#endif
        } SEAM(7);
    }
    if (IN(8)) { REP(8) { refresh_frame(F); const Args A = fetch_args(); build_tab(F); combine_phase(F, A); } }
#undef IN
#undef SEAM
}

struct NArgs {
    const float* x; const float* B; const float* bias; const float* bias2;
    const bf16_t* Ab; bf16_t* Ob; float* Of; const int* ctl; const int* list;
};
template <int MODE> __global__ void __launch_bounds__(256) ngemm(NArgs a) {
    constexpr int K = 1024;
    constexpr int LDB = (MODE == 0) ? INW : (MODE == 2 ? 2048 : 1024);
    constexpr bool DUAL = (MODE == 2);
    __shared__ float As[16][68];
    __shared__ float Bs[16][64];
    __shared__ float Bs2[DUAL ? 16 : 1][64];
    const int tid = threadIdx.x, ty = tid >> 4, tx = tid & 15;
    const int row0 = blockIdx.y * 64, col0 = blockIdx.x * 64;
    const float* B = a.B; int e = 0, pst = 0, cnt = 0;
    if (MODE >= 2) {
        const int* ps = a.ctl + CW_PSTART;
        while (e < NE && row0 >= ps[e + 1]) ++e;
        if (e >= NE) return;
        pst = ps[e]; cnt = a.ctl[CW_CNT + e];
        B += (size_t)e * K * LDB;
    }
    const int ar = tid >> 2, ak = (tid & 3) * 4;
    const float* arow_f = nullptr; const bf16_t* arow_b = nullptr;
    if (MODE == 0) arow_f = a.x + (size_t)(row0 + ar) * K;
    else if (MODE == 1 || MODE == 3) arow_b = a.Ab + (size_t)(row0 + ar) * K;
    else { const int r = row0 + ar - pst; const int tok = (r < cnt) ? a.list[e * NTOK + r] : 0; arow_b = a.Ab + (size_t)tok * K; }
    const int bk = tid >> 4, bn = (tid & 15) * 4;
    float acc[4][4], acc2[4][4];
#pragma unroll
    for (int i = 0; i < 4; ++i)
#pragma unroll
        for (int j = 0; j < 4; ++j) { acc[i][j] = 0.f; acc2[i][j] = 0.f; }
    for (int k0 = 0; k0 < K; k0 += 16) {
        float av[4];
        if (MODE == 0) { const float4 t = *(const float4*)(arow_f + k0 + ak); av[0] = t.x; av[1] = t.y; av[2] = t.z; av[3] = t.w; }
        else { const uint2 t = *(const uint2*)(arow_b + k0 + ak); av[0] = bf2f((bf16_t)(t.x & 0xffff)); av[1] = bf2f((bf16_t)(t.x >> 16)); av[2] = bf2f((bf16_t)(t.y & 0xffff)); av[3] = bf2f((bf16_t)(t.y >> 16)); }
        const float4 bv = *(const float4*)(B + (size_t)(k0 + bk) * LDB + col0 + bn);
        float4 bv2 = bv;
        if (DUAL) bv2 = *(const float4*)(B + (size_t)(k0 + bk) * LDB + 1024 + col0 + bn);
        __syncthreads();
#pragma unroll
        for (int c = 0; c < 4; ++c) As[ak + c][ar] = av[c];
        *(float4*)&Bs[bk][bn] = bv;
        if (DUAL) *(float4*)&Bs2[bk][bn] = bv2;
        __syncthreads();
#pragma unroll
        for (int k = 0; k < 16; ++k) {
            const float4 a4 = *(const float4*)&As[k][ty * 4];
            const float4 b4 = *(const float4*)&Bs[k][tx * 4];
            const float aa[4] = {a4.x, a4.y, a4.z, a4.w}, bb[4] = {b4.x, b4.y, b4.z, b4.w};
#pragma unroll
            for (int i = 0; i < 4; ++i)
#pragma unroll
                for (int j = 0; j < 4; ++j) acc[i][j] = fmaf(aa[i], bb[j], acc[i][j]);
            if (DUAL) {
                const float4 c4 = *(const float4*)&Bs2[k][tx * 4];
                const float cc[4] = {c4.x, c4.y, c4.z, c4.w};
#pragma unroll
                for (int i = 0; i < 4; ++i)
#pragma unroll
                    for (int j = 0; j < 4; ++j) acc2[i][j] = fmaf(aa[i], cc[j], acc2[i][j]);
            }
        }
    }
#pragma unroll
    for (int i = 0; i < 4; ++i) {
        const int row = row0 + ty * 4 + i;
#pragma unroll
        for (int j = 0; j < 4; ++j) {
            const int col = col0 + tx * 4 + j;
            if (MODE == 0) { float v = acc[i][j]; if (col < C_K) v *= QSCALE; a.Ob[(size_t)row * INW + col] = f2bf(v); }
            else if (MODE == 1) { a.Of[(size_t)row * DM + col] = ALPHA * a.x[(size_t)row * DM + col] + acc[i][j]; }
            else if (MODE == 2) {
                float g = acc[i][j] + a.bias[e * 2048 + col], l = acc2[i][j] + a.bias[e * 2048 + 1024 + col];
                g = fminf(g, 7.0f); l = fminf(fmaxf(l, -7.0f), 7.0f);
                const float act = (l + 1.0f) * g * (1.0f / (1.0f + expf(-1.702f * g)));
                a.Ob[(size_t)row * DFF + col] = f2bf(act);
            } else { a.Ob[(size_t)row * DM + col] = f2bf(acc[i][j] + a.bias[e * DM + col]); }
        }
    }
}

__global__ void __launch_bounds__(128) nattn(const bf16_t* __restrict__ proj, bf16_t* __restrict__ mix, const float* lq1, const float* lk1, const float* lq2, const float* lk2, const float* subg) {
    __shared__ float sc[2][SEQ];
    const int w = threadIdx.x >> 6, lane = threadIdx.x & 63;
    const int task = blockIdx.x * 2 + w, t = task >> 2, h = task & 3, b = t / SEQ, qpos = t % SEQ;
    const float lam = expf(wave_sum(lq1[lane] * lk1[lane])) - expf(wave_sum(lq2[lane] * lk2[lane])) + LAMBDA_INIT;
    const bf16_t* pb = proj + (size_t)b * SEQ * INW;
    float o[2][2];
    for (int s = 0; s < 2; ++s) {
        float q[DH];
        const bf16_t* qp = proj + (size_t)t * INW + C_Q + s * 256 + h * DH;
#pragma unroll
        for (int d = 0; d < DH; ++d) q[d] = bf2f(qp[d]);
        float m = -INFINITY;
        for (int j = lane; j <= qpos; j += 64) {
            const uint4* kp = (const uint4*)(pb + (size_t)j * INW + C_K + s * 256 + h * DH);
            float acc = 0.f;
#pragma unroll
            for (int c = 0; c < 8; ++c) {
                const uint4 kk = kp[c];
                const uint32_t ww[4] = {kk.x, kk.y, kk.z, kk.w};
#pragma unroll
                for (int z = 0; z < 4; ++z) { acc = fmaf(q[c * 8 + 2 * z], bf2f((bf16_t)(ww[z] & 0xffff)), acc); acc = fmaf(q[c * 8 + 2 * z + 1], bf2f((bf16_t)(ww[z] >> 16)), acc); }
            }
            sc[w][j] = acc; m = fmaxf(m, acc);
        }
        m = wave_max(m);
        float l = 0.f;
        for (int j = lane; j <= qpos; j += 64) { const float p = exp2f(sc[w][j] - m); sc[w][j] = p; l += p; }
        l = wave_sum(l);
        __syncthreads();
        float o0 = 0.f, o1 = 0.f;
        const bf16_t* vp = pb + C_V + h * DV + lane * 2;
        for (int j = 0; j <= qpos; ++j) {
            const float p = sc[w][j];
            const uint32_t vv = *(const uint32_t*)(vp + (size_t)j * INW);
            o0 = fmaf(p, bf2f((bf16_t)(vv & 0xffff)), o0); o1 = fmaf(p, bf2f((bf16_t)(vv >> 16)), o1);
        }
        o[s][0] = o0 / l; o[s][1] = o1 / l;
        __syncthreads();
    }
    const float d0 = o[0][0] - lam * o[1][0], d1 = o[0][1] - lam * o[1][1];
    const float ss = wave_sum(d0 * d0 + d1 * d1);
    const float r = rsqrtf(ss * (1.0f / DV) + LN_EPS) * (1.0f - LAMBDA_INIT);
    const uint32_t pk = (uint32_t)f2bf(d0 * r * subg[lane * 2]) | ((uint32_t)f2bf(d1 * r * subg[lane * 2 + 1]) << 16);
    *(uint32_t*)(mix + (size_t)t * DM + h * DV + lane * 2) = pk;
}

__global__ void __launch_bounds__(256) ngmlp(const bf16_t* __restrict__ proj, bf16_t* __restrict__ mix, const float* lng, const float* lnb, const float* wsp, const float* bsp) {
    __shared__ float mu[CHUNK], rs[CHUNK];
    __shared__ float vn[CHUNK][GD];
    const int c = blockIdx.x, g = blockIdx.y, tid = threadIdx.x, w = tid >> 6, lane = tid & 63;
    const size_t row0 = (size_t)c * CHUNK;
    for (int s = w; s < CHUNK; s += 4) {
        const bf16_t* p = proj + (row0 + s) * INW + C_GV;
        float v[8]; float sum = 0.f;
#pragma unroll
        for (int i = 0; i < 8; ++i) { v[i] = gelu_exact(bf2f(p[lane + 64 * i])); sum += v[i]; }
        const float mean = wave_sum(sum) * (1.0f / GW); float q = 0.f;
#pragma unroll
        for (int i = 0; i < 8; ++i) { const float d = v[i] - mean; q += d * d; }
        const float var = wave_sum(q) * (1.0f / GW);
        if (lane == 0) { mu[s] = mean; rs[s] = rsqrtf(var + LN_EPS); }
    }
    __syncthreads();
    for (int i = tid; i < CHUNK * GD; i += 256) {
        const int s = i >> 6, d = i & 63, col = g * GD + d;
        const float v = gelu_exact(bf2f(proj[(row0 + s) * INW + C_GV + col]));
        vn[s][d] = (v - mu[s]) * rs[s] * lng[col] + lnb[col];
    }
    __syncthreads();
    const int t = tid >> 1, dh = (tid & 1) * 32;
    float z[32];
#pragma unroll
    for (int d = 0; d < 32; ++d) z[d] = 0.f;
    const float* wr = wsp + ((size_t)g * CHUNK + t) * CHUNK;
    for (int s = 0; s <= t; ++s) {
        const float wv = wr[s];
#pragma unroll
        for (int d = 0; d < 32; ++d) z[d] = fmaf(wv, vn[s][dh + d], z[d]);
    }
    const float bb = bsp[g * CHUNK + t];
#pragma unroll
    for (int d = 0; d < 32; ++d) {
        const int col = g * GD + dh + d;
        const float u = gelu_exact(bf2f(proj[(row0 + t) * INW + C_GU + col]));
        mix[(row0 + t) * DM + GW + col] = f2bf(u * (z[d] + bb));
    }
}

__global__ void __launch_bounds__(256) nroute(float* __restrict__ h1, bf16_t* __restrict__ xb, const float* g1, const float* b1, const float* wr, const float* br, int* ctl, int* list, int* re, int* rr, float* rg) {
    const int w = threadIdx.x >> 6, lane = threadIdx.x & 63, t = blockIdx.x * 4 + w;
    float* row = h1 + (size_t)t * DM;
    float v[16]; float s = 0.f;
#pragma unroll
    for (int j = 0; j < 4; ++j) { const float4 q = *(const float4*)(row + j * 256 + lane * 4); v[4 * j] = q.x; v[4 * j + 1] = q.y; v[4 * j + 2] = q.z; v[4 * j + 3] = q.w; s += (q.x + q.y) + (q.z + q.w); }
    const float mean = wave_sum(s) * (1.0f / DM); float q2 = 0.f;
#pragma unroll
    for (int i = 0; i < 16; ++i) { v[i] -= mean; q2 += v[i] * v[i]; }
    const float rstd = rsqrtf(wave_sum(q2) * (1.0f / DM) + LN_EPS);
#pragma unroll
    for (int j = 0; j < 4; ++j) {
        const int col = j * 256 + lane * 4;
#pragma unroll
        for (int c = 0; c < 4; ++c) v[4 * j + c] = v[4 * j + c] * rstd * g1[col + c] + b1[col + c];
        *(float4*)(row + col) = make_float4(v[4 * j], v[4 * j + 1], v[4 * j + 2], v[4 * j + 3]);
        uint2 pk; pk.x = (uint32_t)f2bf(v[4 * j]) | ((uint32_t)f2bf(v[4 * j + 1]) << 16); pk.y = (uint32_t)f2bf(v[4 * j + 2]) | ((uint32_t)f2bf(v[4 * j + 3]) << 16);
        *(uint2*)(xb + (size_t)t * DM + col) = pk;
    }
    float lg[NE];
#pragma unroll
    for (int e = 0; e < NE; ++e) lg[e] = 0.f;
#pragma unroll
    for (int j = 0; j < 4; ++j)
#pragma unroll
        for (int c = 0; c < 4; ++c) {
            const float xv = v[4 * j + c]; const float4* wp = (const float4*)(wr + (size_t)(j * 256 + lane * 4 + c) * NE);
#pragma unroll
            for (int e4 = 0; e4 < 8; ++e4) { const float4 ww = wp[e4]; lg[4 * e4] = fmaf(xv, ww.x, lg[4 * e4]); lg[4 * e4 + 1] = fmaf(xv, ww.y, lg[4 * e4 + 1]); lg[4 * e4 + 2] = fmaf(xv, ww.z, lg[4 * e4 + 2]); lg[4 * e4 + 3] = fmaf(xv, ww.w, lg[4 * e4 + 3]); }
        }
#pragma unroll
    for (int e = 0; e < NE; ++e) lg[e] = wave_sum(lg[e]) + br[e];
    int idx[4]; float val[4]; unsigned taken = 0u;
#pragma unroll
    for (int k = 0; k < 4; ++k) {
        float best = -INFINITY; int bi = 0;
#pragma unroll
        for (int e = 0; e < NE; ++e) { const bool ok = !((taken >> e) & 1u) && lg[e] > best; best = ok ? lg[e] : best; bi = ok ? e : bi; }
        idx[k] = bi; val[k] = best; taken |= 1u << bi;
    }
    float ex[4], se = 0.f;
#pragma unroll
    for (int k = 0; k < 4; ++k) { ex[k] = expf(val[k] - val[0]); se += ex[k]; }
    if (lane == 0) {
#pragma unroll
        for (int k = 0; k < 4; ++k) {
            const int r = atomicAdd(ctl + CW_CNT + idx[k], 1);
            list[idx[k] * NTOK + r] = t;
            re[t * 4 + k] = idx[k]; rr[t * 4 + k] = r; rg[t * 4 + k] = ex[k] / se;
        }
    }
}
__global__ void npstart(int* ctl) {
    if (threadIdx.x == 0 && blockIdx.x == 0) { int p = 0; for (int e = 0; e < NE; ++e) { ctl[CW_PSTART + e] = p; p += ((ctl[CW_CNT + e] + 255) / 256) * 256; } ctl[CW_PSTART + NE] = p; }
}
__global__ void __launch_bounds__(256) ncombine(const float* __restrict__ x1, const bf16_t* __restrict__ y, const int* ctl, const int* re, const int* rr, const float* rg, const float* g2, const float* b2, float* __restrict__ out) {
    const int w = threadIdx.x >> 6, lane = threadIdx.x & 63, t = blockIdx.x * 4 + w;
    float v[16];
#pragma unroll
    for (int j = 0; j < 4; ++j) { const float4 q = *(const float4*)(x1 + (size_t)t * DM + j * 256 + lane * 4); v[4 * j] = ALPHA * q.x; v[4 * j + 1] = ALPHA * q.y; v[4 * j + 2] = ALPHA * q.z; v[4 * j + 3] = ALPHA * q.w; }
#pragma unroll
    for (int k = 0; k < 4; ++k) {
        const int e = re[t * 4 + k], slot = ctl[CW_PSTART + e] + rr[t * 4 + k]; const float g = rg[t * 4 + k];
        const bf16_t* yr = y + (size_t)slot * DM;
#pragma unroll
        for (int j = 0; j < 4; ++j) { const uint2 pk = *(const uint2*)(yr + j * 256 + lane * 4);
            v[4 * j] = fmaf(g, bf2f((bf16_t)(pk.x & 0xffff)), v[4 * j]); v[4 * j + 1] = fmaf(g, bf2f((bf16_t)(pk.x >> 16)), v[4 * j + 1]);
            v[4 * j + 2] = fmaf(g, bf2f((bf16_t)(pk.y & 0xffff)), v[4 * j + 2]); v[4 * j + 3] = fmaf(g, bf2f((bf16_t)(pk.y >> 16)), v[4 * j + 3]); }
    }
    float s = 0.f;
#pragma unroll
    for (int i = 0; i < 16; ++i) s += v[i];
    const float mean = wave_sum(s) * (1.0f / DM); float q2 = 0.f;
#pragma unroll
    for (int i = 0; i < 16; ++i) { v[i] -= mean; q2 += v[i] * v[i]; }
    const float rstd = rsqrtf(wave_sum(q2) * (1.0f / DM) + LN_EPS);
#pragma unroll
    for (int j = 0; j < 4; ++j) { const int col = j * 256 + lane * 4;
        *(float4*)(out + (size_t)t * DM + col) = make_float4(v[4 * j] * rstd * g2[col] + b2[col], v[4 * j + 1] * rstd * g2[col + 1] + b2[col + 1], v[4 * j + 2] * rstd * g2[col + 2] + b2[col + 2], v[4 * j + 3] * rstd * g2[col + 3] + b2[col + 3]); }
}

#ifndef OPT_MASK
#define OPT_MASK 0x1FF
#endif
#ifndef FUSED
#define FUSED 0
#endif
static void launch_mega(const Args& base, int lo, int hi, int sub, hipStream_t stream) {
    Args a = base; a.ph_lo = lo; a.ph_hi = hi; a.pad0 = sub; a.pad1 = 0;
    hipLaunchKernelGGL(mega_fwd, dim3(256), dim3(NWAVES * 64), LDS_BYTES, stream, a);
}
extern "C" void kernel_launch(void* const* d_in, const int* in_sizes, int n_in, void* d_out, int out_size, void* d_ws, size_t ws_size, hipStream_t stream) {
    static int ready = 0;
    if (ready == 0) {
        if (n_in != 22 || in_sizes[0] != NTOK * DM || out_size != NTOK * DM || ws_size < WS_END) { fprintf(stderr, "kernel_launch: unexpected shapes (n_in %d, in0 %d, out %d, ws %zu)\n", n_in, n_in > 0 ? in_sizes[0] : -1, out_size, ws_size); ready = -1; return; }
        if (hipFuncSetAttribute((const void*)mega_fwd, hipFuncAttributeMaxDynamicSharedMemorySize, LDS_BYTES) != hipSuccess) { fprintf(stderr, "kernel_launch: hipFuncSetAttribute failed\n"); ready = -1; return; }
        ready = 1;
    }
    if (ready < 0) return;
    const float* x = (const float*)d_in[0]; const float* w_in = (const float*)d_in[1];
    const float *lq1 = (const float*)d_in[2], *lk1 = (const float*)d_in[3], *lq2 = (const float*)d_in[4], *lk2 = (const float*)d_in[5];
    const float *subg = (const float*)d_in[6], *glng = (const float*)d_in[7], *glnb = (const float*)d_in[8], *wsp = (const float*)d_in[9], *bsp = (const float*)d_in[10];
    const float *w_o = (const float*)d_in[11], *ln1g = (const float*)d_in[12], *ln1b = (const float*)d_in[13], *w_r = (const float*)d_in[14], *b_r = (const float*)d_in[15];
    const float *w_up = (const float*)d_in[16], *b_up = (const float*)d_in[17], *w_dn = (const float*)d_in[18], *b_dn = (const float*)d_in[19], *ln2g = (const float*)d_in[20], *ln2b = (const float*)d_in[21];
    unsigned char* ws = (unsigned char*)d_ws;
    int* ctl = (int*)(ws + WS_CTL); int* list = (int*)(ws + WS_LIST); int* re = (int*)(ws + WS_RE); int* rr = (int*)(ws + WS_RR); float* rg = (float*)(ws + WS_RG);
    bf16_t* xb = (bf16_t*)(ws + WS_XB); bf16_t* proj = (bf16_t*)(ws + WS_PROJ); bf16_t* mix = (bf16_t*)(ws + WS_MIX); bf16_t* yb = (bf16_t*)(ws + WS_Y);
    float* h1 = (float*)(ws + WS_H1); bf16_t* act = (bf16_t*)(ws + WS_ACT);
    (void)hipMemsetAsync(ws + WS_CTL, 0, CTL_BYTES, stream);
    Args base{};
    for (int i = 0; i < 22; ++i) base.in[i] = (const float*)d_in[i];
    base.out = (float*)d_out; base.ws = ws;
    constexpr unsigned OM = OPT_MASK;
#if FUSED
    static_assert(OM == 0x1FFu, "FUSED needs every stage in the persistent kernel");
    launch_mega(base, 0, N_PHASES, 3, stream);
#else
    if (OM & 0xD3u) launch_mega(base, 0, 1, 0, stream);
    if (OM & 2u) launch_mega(base, 1, 2, 0, stream);
    else { NArgs a{}; a.x = x; a.B = w_in; a.Ob = proj; ngemm<0><<<dim3(INW / 64, NTOK / 64), 256, 0, stream>>>(a); }
    if ((OM & 4u) || (OM & 8u)) launch_mega(base, 2, 3, ((OM & 4u) ? 1 : 0) | ((OM & 8u) ? 2 : 0), stream);
    if (OM & 4u) launch_mega(base, 3, 4, 0, stream);
    else nattn<<<NTOK * NH / 2, 128, 0, stream>>>(proj, mix, lq1, lk1, lq2, lk2, subg);
    if (!(OM & 8u)) ngmlp<<<dim3(NTOK / CHUNK, NG), 256, 0, stream>>>(proj, mix, glng, glnb, wsp, bsp);
    if (OM & 16u) launch_mega(base, 4, 5, 0, stream);
    else { NArgs a{}; a.x = x; a.B = w_o; a.Ab = mix; a.Of = h1; ngemm<1><<<dim3(DM / 64, NTOK / 64), 256, 0, stream>>>(a); }
    if (OM & 32u) launch_mega(base, 5, 6, 0, stream);
    else nroute<<<NTOK / 4, 256, 0, stream>>>(h1, xb, ln1g, ln1b, w_r, b_r, ctl, list, re, rr, rg);
    if ((OM & 0x1C0u) != 0x1C0u) npstart<<<1, 64, 0, stream>>>(ctl);
    if (OM & 64u) launch_mega(base, 6, 7, 0, stream);
    else { NArgs a{}; a.B = w_up; a.bias = b_up; a.Ab = xb; a.Ob = act; a.ctl = ctl; a.list = list; ngemm<2><<<dim3(DFF / 64, PADROWS / 64), 256, 0, stream>>>(a); }
    if (OM & 128u) launch_mega(base, 7, 8, 0, stream);
    else { NArgs a{}; a.B = w_dn; a.bias = b_dn; a.Ab = act; a.Ob = yb; a.ctl = ctl; a.list = list; ngemm<3><<<dim3(DM / 64, PADROWS / 64), 256, 0, stream>>>(a); }
    if (OM & 256u) launch_mega(base, 8, 9, 0, stream);
    else ncombine<<<NTOK / 4, 256, 0, stream>>>(h1, yb, ctl, re, rr, rg, ln2g, ln2b, (float*)d_out);
#endif
}
```

```cpp
#include <hip/hip_runtime.h>
#include <hip/hip_bf16.h>
#include <cstdint>
#include <cstdio>
#include <cmath>

#ifndef MOE_FP8
#define MOE_FP8 1
#endif
#ifndef CONV_IN_ATTN
#define CONV_IN_ATTN 1
#endif
#ifndef OUTPROJ_FP8
#define OUTPROJ_FP8 1
#endif
namespace cfg {
constexpr int BATCH = 8, SEQ = 4096, NTOK = BATCH * SEQ, DM = 1024;
constexpr int INW = 2560, NH = 4, DH = 64, DV = 128;
constexpr int C_Q = 0, C_K = 512, C_V = 1024, C_GU = 1536, C_GV = 2048;
constexpr int GW = 512, NG = 8, GD = 64, CHUNK = 128;
constexpr int NE = 32, TOPK = 4, DFF = 1024;
constexpr int PADROWS = 139264;
constexpr float LN_EPS = 1e-5f;
constexpr float ALPHA = 1.189207115002721f;
constexpr float LAMBDA_INIT = 0.2f;
constexpr float QSCALE = 0.125f * 1.4426950408889634f;
constexpr size_t MiB = 1u << 20;
constexpr size_t WS_CTL = 0, CTL_BYTES = 1 * MiB;
constexpr size_t WS_LIST = 1 * MiB;
constexpr size_t WS_RE = 5 * MiB, WS_RR = 5 * MiB + 512 * 1024, WS_RG = 6 * MiB;
constexpr size_t WS_WIN = 8 * MiB;
constexpr size_t WS_WO = 13 * MiB;
constexpr size_t WS_WUP = 16 * MiB;
constexpr size_t WS_WDN = 144 * MiB;
constexpr size_t WS_X1B = 80 * MiB;
constexpr size_t WS_XB = 208 * MiB;
constexpr size_t WS_PROJ = 272 * MiB;
constexpr size_t WS_MIX = 432 * MiB;
constexpr size_t WS_ATTO = 496 * MiB;
constexpr size_t WS_Y = 272 * MiB;
constexpr size_t WS_H1 = 560 * MiB;
constexpr size_t WS_ACT = 688 * MiB;
constexpr size_t WS_END = 960 * MiB;
constexpr int CW_CNT = 0;
constexpr int CW_PSTART = 64;
constexpr int CW_BAR = 4096;
}
using namespace cfg;
typedef uint16_t bf16_t;

__device__ __forceinline__ float bf2f(bf16_t b) { return __uint_as_float((uint32_t)b << 16); }
__device__ __forceinline__ bf16_t f2bf(float f) { uint32_t u = __float_as_uint(f); u += 0x7fffu + ((u >> 16) & 1u); return (bf16_t)(u >> 16); }
typedef float pk2_f32x2_t __attribute__((ext_vector_type(2))); typedef __bf16 pk2_bf16x2_t __attribute__((ext_vector_type(2)));
__device__ __forceinline__ uint32_t pk2(float lo, float hi) { pk2_f32x2_t v = {lo, hi}; pk2_bf16x2_t b = __builtin_convertvector(v, pk2_bf16x2_t); return __builtin_bit_cast(uint32_t, b); }
__device__ __forceinline__ float wave_sum(float v) {
#pragma unroll
    for (int o = 1; o < 64; o <<= 1) v += __shfl_xor(v, o);
    return v;
}
__device__ __forceinline__ float wave_max(float v) {
#pragma unroll
    for (int o = 1; o < 64; o <<= 1) v = fmaxf(v, __shfl_xor(v, o));
    return v;
}
__device__ __forceinline__ float gelu_exact(float x) { return 0.5f * x * (1.0f + erff(x * 0.70710678118654752f)); }

#define OPT_MASK 0x1FF
#define FUSED 1
#define DOUBLE_MASK 0
#define P2_REP_SUB 3
namespace pg8 {
#define PG8_LAS __attribute__((address_space(3)))
typedef short bf16x8 __attribute__((ext_vector_type(8)));
typedef float f32x4 __attribute__((ext_vector_type(4)));
typedef float f32x2 __attribute__((ext_vector_type(2)));
typedef unsigned u32x4 __attribute__((ext_vector_type(4)));
typedef int v4i_t __attribute__((ext_vector_type(4)));
typedef int v8i_t __attribute__((ext_vector_type(8)));
constexpr int WSHIFT = 6;
#if defined(PROBE_DOUBLE_MFMA)
constexpr float WUNSCALE = 0.5f / (float)(1 << WSHIFT);
#else
constexpr float WUNSCALE = 1.0f / (float)(1 << WSHIFT);
#endif
constexpr int BM = 256, BK = 64, HALF = 128, HTB = HALF * BK * 2  , STAGE_BYTES = 8 * HTB, NXCD = 8, WGM = 8;

__host__ __device__ __forceinline__ int lds_byte(int r, int c) { const int st = (r >> 4) * 2 + (c >> 5), rr = r & 15, cc = c & 31, ob = rr * 64 + cc * 2; return st * 1024 + (ob ^ (((ob >> 9) & 1) << 5)); }
__host__ __device__ __forceinline__ void stage_rc(int b, int& R, int& C) { const int st = b / 1024, sb = b % 1024, swz = sb ^ (((sb >> 9) & 1) << 5); R = (st >> 1) * 16 + swz / 64; C = (st & 1) * 32 + (swz % 64) / 2; }
__host__ __device__ __forceinline__ int perm32(int rho) { const int n = rho >> 4, i = rho & 15; return 8 * (i >> 2) + 4 * n + (i & 3); }

struct Unit { int pm, pn, e; };
struct Gemm { const bf16_t* A; const bf16_t* Bt; int M, N, K; size_t strideB; };

struct StaticOrder {
    int nM, nN, nwg, G, c;
    __host__ __device__ void init(int M, int N, int G_, int c_) { nM = M / BM; nN = N / BM; nwg = nM * nN; G = G_; c = c_; }
    __host__ __device__ bool next(int i, Unit& u) const {
        const long L = (long)i * G + c; if (L >= nwg) return false;
        int wgid = (int)L; { const int q = nwg / NXCD, r = nwg % NXCD, xcd = wgid % NXCD, off = wgid / NXCD; wgid = (xcd < r ? xcd * (q + 1) : r * (q + 1) + (xcd - r) * q) + off; }
        const int nig = WGM * nN, gid = wgid / nig, fm = gid * WGM, gsz = (nM - fm) < WGM ? (nM - fm) : WGM;
        u.pm = fm + ((wgid % nig) % gsz); u.pn = (wgid % nig) / gsz; u.e = 0; return true;
    }
    __device__ __forceinline__ void gather(const Unit&, const int (&)[2], const int (&)[2], unsigned (&)[2][2], unsigned) const {}
    __device__ __forceinline__ void gather_issue(const Unit&, const int (&)[2], unsigned (&)[4]) const {}
    __device__ __forceinline__ void gather_finish(const Unit&, const int (&)[2], const int (&)[2], const unsigned (&)[4], unsigned (&)[2][2], unsigned) const {}
};
struct MoeOrder {
    const PG8_LAS int* tab; const int* list; int NC, RG, chunk0, nrt, j0;
    __device__ __forceinline__ void init(const PG8_LAS int* tab_, const int* list_, int NC_, int bid) {
        tab = tab_; list = list_; NC = NC_; RG = 32 / NC_; const int x = bid & 7; j0 = bid >> 3;
        const int T = __builtin_amdgcn_readfirstlane(tab_[32]); chunk0 = (T * x) / 8; nrt = (T * (x + 1)) / 8 - chunk0;
    }
    __device__ __forceinline__ bool next(int i, Unit& u) const {
        const int pml = i * RG + (j0 % RG); if (pml >= nrt) return false;
        u.pm = chunk0 + pml; u.pn = j0 / RG;
        const int ln = (int)(threadIdx.x & 63u); const int tv = tab[(ln & 31) + 1];
        u.e = __builtin_amdgcn_readfirstlane(__popcll(__ballot(ln < NE - 1 && u.pm >= tv))); return true;
    }
    __device__ __forceinline__ void tok_src(const Unit& u, int lane, const char*& sbase, unsigned& voff) const {
        const int r0 = (u.pm - __builtin_amdgcn_readfirstlane(tab[u.e])) * BM; sbase = (const char*)(list + (size_t)u.e * NTOK); voff = (unsigned)(r0 + 4 * lane) * 4u; }
    __device__ __forceinline__ void gather_lds(const Unit& u, const int (&RA)[2], const int (&CA2)[2], unsigned (&go)[2][2], unsigned rowbytes, const PG8_LAS int* tokl) const {
        const int r0 = (u.pm - __builtin_amdgcn_readfirstlane(tab[u.e])) * BM, cnt = __builtin_amdgcn_readfirstlane(tab[40 + u.e]);
#pragma unroll
        for (int h = 0; h < 2; ++h)
#pragma unroll
            for (int i = 0; i < 2; ++i) { const int rr_ = h * HALF + RA[i]; const int tk = ((const volatile PG8_LAS int*)tokl)[rr_];     const int tok = (r0 + rr_ < cnt) ? tk : 0; go[h][i] = (unsigned)tok * rowbytes + (unsigned)CA2[i]; }
    }
    __device__ __forceinline__ void gather_issue(const Unit& u, const int (&RA)[2], unsigned (&tk)[4]) const {
        const int r0 = (u.pm - __builtin_amdgcn_readfirstlane(tab[u.e])) * BM; const char* sb = (const char*)(list + (size_t)u.e * NTOK);
#pragma unroll
        for (int h = 0; h < 2; ++h)
#pragma unroll
            for (int i = 0; i < 2; ++i) { const unsigned vo = (unsigned)(r0 + h * HALF + RA[i]) * 4u; asm volatile("global_load_dword %0, %1, %2" : "=v"(tk[h * 2 + i]) : "v"(vo), "s"(sb) : "memory"); }
    }
    __device__ __forceinline__ void gather_finish(const Unit& u, const int (&RA)[2], const int (&CA2)[2], const unsigned (&tk)[4], unsigned (&go)[2][2], unsigned rowbytes) const {
        const int r0 = (u.pm - __builtin_amdgcn_readfirstlane(tab[u.e])) * BM, cnt = __builtin_amdgcn_readfirstlane(tab[40 + u.e]);
#pragma unroll
        for (int h = 0; h < 2; ++h)
#pragma unroll
            for (int i = 0; i < 2; ++i) { const unsigned tok = (r0 + h * HALF + RA[i] < cnt) ? tk[h * 2 + i] : 0u; go[h][i] = tok * rowbytes + (unsigned)CA2[i]; }
    }
    __device__ __forceinline__ void gather(const Unit& u, const int (&RA)[2], const int (&CA2)[2], unsigned (&go)[2][2], unsigned rowbytes) const {
        const int r0 = (u.pm - __builtin_amdgcn_readfirstlane(tab[u.e])) * BM, cnt = __builtin_amdgcn_readfirstlane(tab[40 + u.e]);
#pragma unroll
        for (int h = 0; h < 2; ++h)
#pragma unroll
            for (int i = 0; i < 2; ++i) { const int r = r0 + h * HALF + RA[i]; const int tl = list[u.e * NTOK + r]; const int tok = (r < cnt) ? tl : 0; go[h][i] = (unsigned)tok * rowbytes + (unsigned)CA2[i]; }
    }
};

__device__ __forceinline__ unsigned cvt_pk_bf16(float lo, float hi) { unsigned r; asm volatile("v_cvt_pk_bf16_f32 %0, %1, %2" : "=v"(r) : "v"(lo), "v"(hi)); return r; }
__device__ __forceinline__ f32x2 gelu_pk(f32x2 v) {
    const f32x2 av = __builtin_elementwise_abs(v), d = av * 0.2316418882f + 1.0f;
    f32x2 t; t.x = __builtin_amdgcn_rcpf(d.x); t.y = __builtin_amdgcn_rcpf(d.y);
    f32x2 q = t * 0.5307027145f + (-0.7265760135f); q = q * t + 0.7107068705f; q = q * t + (-0.142248368f); q = q * t + 0.127414796f; q = q * t;
    const f32x2 s = (v * v) * (-0.72134752044f);
    f32x2 e; e.x = __builtin_amdgcn_exp2f(s.x); e.y = __builtin_amdgcn_exp2f(s.y);
    const f32x2 m = v * (q * e), r = v - m;
    f32x2 o; o.x = v.x < 0.f ? m.x : r.x; o.y = v.y < 0.f ? m.y : r.y; return o;
}
__device__ __forceinline__ float gelu1(float v) { return gelu_pk((f32x2){v, v}).x; }

struct EpiProj {
    static constexpr bool PERM = true; static constexpr bool BIAS = false;
    bf16_t* O;
    __device__ __forceinline__ void operator()(const f32x4 (&acc)[2][2][4][2], const Unit& u, int wr, int wc, int fr, int fq) const {
        const int row0 = u.pm * BM + wr * 64 + fr, col0 = u.pn * BM + wc * 32 + 8 * fq; const float sc = (u.pn < 2) ? QSCALE : 1.0f;
        const bool act = (u.pn >= C_GU / BM);
#pragma unroll
        for (int ai = 0; ai < 2; ++ai)
#pragma unroll
            for (int m = 0; m < 4; ++m) { bf16_t* rowp = O + (size_t)(row0 + ai * HALF + m * 16) * INW + col0;
#pragma unroll
                for (int bj = 0; bj < 2; ++bj) { f32x4 v0 = acc[ai][bj][m][0] * sc, v1 = acc[ai][bj][m][1] * sc;
                    if (act) { const f32x2 a = gelu_pk((f32x2){v0[0], v0[1]}), b = gelu_pk((f32x2){v0[2], v0[3]}), c = gelu_pk((f32x2){v1[0], v1[1]}), d = gelu_pk((f32x2){v1[2], v1[3]});
                        v0 = (f32x4){a.x, a.y, b.x, b.y}; v1 = (f32x4){c.x, c.y, d.x, d.y}; }
                    u32x4 w; w.x = cvt_pk_bf16(v0[0], v0[1]); w.y = cvt_pk_bf16(v0[2], v0[3]); w.z = cvt_pk_bf16(v1[0], v1[1]); w.w = cvt_pk_bf16(v1[2], v1[3]);
                    *(u32x4*)(rowp + bj * HALF) = w; } }
    }
};
struct EpiH1 {
    static constexpr bool PERM = true; static constexpr bool BIAS = false;
    const bf16_t* X; bf16_t* C; float sc;
    __device__ __forceinline__ void operator()(const f32x4 (&acc)[2][2][4][2], const Unit& u, int wr, int wc, int fr, int fq) const {
        const int row0 = u.pm * BM + wr * 64 + fr, col0 = u.pn * BM + wc * 32 + 8 * fq;
        u32x4 xv[2][4][2];
#pragma unroll
        for (int ai = 0; ai < 2; ++ai)
#pragma unroll
            for (int m = 0; m < 4; ++m)
#pragma unroll
                for (int bj = 0; bj < 2; ++bj) xv[ai][m][bj] = *(const u32x4*)(X + (size_t)(row0 + ai * HALF + m * 16) * DM + col0 + bj * HALF);
#pragma unroll
        for (int ai = 0; ai < 2; ++ai)
#pragma unroll
            for (int m = 0; m < 4; ++m) { const size_t off = (size_t)(row0 + ai * HALF + m * 16) * DM + col0;
#pragma unroll
                for (int bj = 0; bj < 2; ++bj) { const u32x4 xw = xv[ai][m][bj];
                    const f32x4 a0 = acc[ai][bj][m][0] * sc, a1 = acc[ai][bj][m][1] * sc;
                    u32x4 w;
                    w.x = cvt_pk_bf16(__uint_as_float(xw.x << 16) * ALPHA + a0[0], __uint_as_float(xw.x & 0xffff0000u) * ALPHA + a0[1]);
                    w.y = cvt_pk_bf16(__uint_as_float(xw.y << 16) * ALPHA + a0[2], __uint_as_float(xw.y & 0xffff0000u) * ALPHA + a0[3]);
                    w.z = cvt_pk_bf16(__uint_as_float(xw.z << 16) * ALPHA + a1[0], __uint_as_float(xw.z & 0xffff0000u) * ALPHA + a1[1]);
                    w.w = cvt_pk_bf16(__uint_as_float(xw.w << 16) * ALPHA + a1[2], __uint_as_float(xw.w & 0xffff0000u) * ALPHA + a1[3]);
                    *(u32x4*)(C + off + bj * HALF) = w; } }
    }
};
struct EpiSwiglu {
    static constexpr bool PERM = true; static constexpr bool BIAS = false;
    bf16_t* O; const float* bias;
    __device__ __forceinline__ void operator()(const f32x4 (&acc)[2][2][4][2], const Unit& u, int wr, int wc, int fr, int fq) const {
        const int row0 = u.pm * BM + wr * 64 + fr, col0 = u.pn * HALF + wc * 32 + 8 * fq;
        const float* bp = bias + (size_t)u.e * (2 * DFF) + col0;
        f32x4 bg[2], bl[2];
#pragma unroll
        for (int n = 0; n < 2; ++n) { bg[n] = *(const f32x4*)(bp + 4 * n); bl[n] = *(const f32x4*)(bp + DFF + 4 * n); }
#pragma unroll
        for (int ai = 0; ai < 2; ++ai)
#pragma unroll
            for (int m = 0; m < 4; ++m) { float a8[8];
#pragma unroll
                for (int n = 0; n < 2; ++n) { const f32x4 g4 = acc[ai][0][m][n] + bg[n], l4 = acc[ai][1][m][n] + bl[n];
#pragma unroll
                    for (int j = 0; j < 4; ++j) { const float g = fminf(g4[j], 7.0f), l = fminf(fmaxf(l4[j], -7.0f), 7.0f);
                        const float sg = __builtin_amdgcn_rcpf(1.0f + __builtin_amdgcn_exp2f(g * (-1.702f * 1.4426950408889634f)));
                        a8[4 * n + j] = (l + 1.0f) * g * sg; } }
                u32x4 w; w.x = cvt_pk_bf16(a8[0], a8[1]); w.y = cvt_pk_bf16(a8[2], a8[3]); w.z = cvt_pk_bf16(a8[4], a8[5]); w.w = cvt_pk_bf16(a8[6], a8[7]);
                *(u32x4*)(O + (size_t)(row0 + ai * HALF + m * 16) * DFF + col0) = w; }
    }
};
struct EpiDown {
    static constexpr bool PERM = true; static constexpr bool BIAS = false;
    bf16_t* O; const float* bias;
    __device__ __forceinline__ void operator()(const f32x4 (&acc)[2][2][4][2], const Unit& u, int wr, int wc, int fr, int fq) const {
        const int row0 = u.pm * BM + wr * 64 + fr, col0 = u.pn * BM + wc * 32 + 8 * fq;
        const float* bp = bias + (size_t)u.e * DM + col0;
        f32x4 bv[2][2];
#pragma unroll
        for (int bj = 0; bj < 2; ++bj)
#pragma unroll
            for (int n = 0; n < 2; ++n) bv[bj][n] = *(const f32x4*)(bp + bj * HALF + 4 * n);
#pragma unroll
        for (int ai = 0; ai < 2; ++ai)
#pragma unroll
            for (int m = 0; m < 4; ++m) { bf16_t* rowp = O + (size_t)(row0 + ai * HALF + m * 16) * DM + col0;
#pragma unroll
                for (int bj = 0; bj < 2; ++bj) { const f32x4 v0 = acc[ai][bj][m][0] + bv[bj][0], v1 = acc[ai][bj][m][1] + bv[bj][1];
                    u32x4 w; w.x = cvt_pk_bf16(v0[0], v0[1]); w.y = cvt_pk_bf16(v0[2], v0[3]); w.z = cvt_pk_bf16(v1[0], v1[1]); w.w = cvt_pk_bf16(v1[2], v1[3]);
                    *(u32x4*)(rowp + bj * HALF) = w; } }
    }
};

__device__ __forceinline__ unsigned pk4_fp8(float a, float b, float c, float d) { int w = 0; w = __builtin_amdgcn_cvt_pk_fp8_f32(a, b, w, false); w = __builtin_amdgcn_cvt_pk_fp8_f32(c, d, w, true); return (unsigned)w; }
typedef unsigned u32x2 __attribute__((ext_vector_type(2)));
__device__ __forceinline__ u32x4 widen16(u32x2 w0, u32x2 w1) {
    const auto sx = __builtin_amdgcn_permlane16_swap(w0.x, w1.x, false, false); const auto sy = __builtin_amdgcn_permlane16_swap(w0.y, w1.y, false, false);
    return (u32x4){sx[0], sy[0], sx[1], sy[1]}; }
struct EpiSwiglu8 {
    static constexpr bool PERM = true; static constexpr bool BIAS = true;
    unsigned char* O; const float* bias;
    __device__ __forceinline__ size_t bias_idx(const Unit& u, int j) const { return (size_t)u.e * (2 * DFF) + (j < HALF ? 0 : DFF - HALF) + u.pn * HALF + j; }
    __device__ __forceinline__ void bias_src(const Unit& u, int lane, const char*& sbase, unsigned& voff) const {
        sbase = (const char*)(bias + (size_t)u.e * (2 * DFF)); voff = (unsigned)((lane < 32 ? 0 : DFF - 128) + u.pn * HALF + 4 * lane) * 4u; }
    __device__ __forceinline__ void operator()(const f32x4 (&acc)[2][2][4][2], const Unit& u, int wr, int wc, int fr, int fq, const PG8_LAS float* brec) const {
        const int row0 = u.pm * BM + wr * 64 + fr, col0 = u.pn * HALF + wc * 32 + 8 * fq;
        f32x4 bg[2], bl[2];
#pragma unroll
        for (int n = 0; n < 2; ++n) {
            bg[n] = *(const PG8_LAS f32x4*)(brec + wc * 32 + 8 * fq + 4 * n); bl[n] = *(const PG8_LAS f32x4*)(brec + HALF + wc * 32 + 8 * fq + 4 * n); }
        u32x2 wq[2];
#pragma unroll
        for (int ai = 0; ai < 2; ++ai)
#pragma unroll
            for (int m = 0; m < 4; ++m) { float a8[8];
#pragma unroll
                for (int n = 0; n < 2; ++n) { const f32x4 g4 = acc[ai][0][m][n] * WUNSCALE + bg[n], l4 = acc[ai][1][m][n] * WUNSCALE + bl[n];
#pragma unroll
                    for (int pr = 0; pr < 2; ++pr) {
                        const f32x2 g = (f32x2){__builtin_amdgcn_fmed3f(g4[2 * pr], -3.0e38f, 7.0f), __builtin_amdgcn_fmed3f(g4[2 * pr + 1], -3.0e38f, 7.0f)};
                        const f32x2 l = (f32x2){__builtin_amdgcn_fmed3f(l4[2 * pr], -7.0f, 7.0f), __builtin_amdgcn_fmed3f(l4[2 * pr + 1], -7.0f, 7.0f)};
                        f32x2 e = g * (-1.702f * 1.4426950408889634f); e.x = __builtin_amdgcn_exp2f(e.x); e.y = __builtin_amdgcn_exp2f(e.y);
                        f32x2 d = e + 1.0f; d.x = __builtin_amdgcn_rcpf(d.x); d.y = __builtin_amdgcn_rcpf(d.y);
                        const f32x2 av = (l * g + g) * d;
                        a8[4 * n + 2 * pr] = av.x; a8[4 * n + 2 * pr + 1] = av.y; } }
                wq[m & 1].x = pk4_fp8(a8[0], a8[1], a8[2], a8[3]); wq[m & 1].y = pk4_fp8(a8[4], a8[5], a8[6], a8[7]);
                if (m & 1) { const u32x4 w16 = widen16(wq[0], wq[1]);
                    *(u32x4*)(O + (size_t)(row0 + ai * HALF + (m - 1 + (fq & 1)) * 16) * DFF + (col0 - 8 * (fq & 1))) = w16; } }
    }
};

struct EpiDown8 {
    static constexpr bool PERM = true; static constexpr bool BIAS = true;
    unsigned char* O; const float* bias;
    __device__ __forceinline__ size_t bias_idx(const Unit& u, int j) const { return (size_t)u.e * DM + u.pn * BM + j; }
    __device__ __forceinline__ void bias_src(const Unit& u, int lane, const char*& sbase, unsigned& voff) const {
        sbase = (const char*)(bias + (size_t)u.e * DM); voff = (unsigned)(u.pn * BM + 4 * lane) * 4u; }
    __device__ __forceinline__ void operator()(const f32x4 (&acc)[2][2][4][2], const Unit& u, int wr, int wc, int fr, int fq, const PG8_LAS float* brec) const {
        const int row0 = u.pm * BM + wr * 64 + fr, col0 = u.pn * BM + wc * 32 + 8 * fq;
        f32x4 bv[2][2];
#pragma unroll
        for (int bj = 0; bj < 2; ++bj)
#pragma unroll
            for (int n = 0; n < 2; ++n) bv[bj][n] = *(const PG8_LAS f32x4*)(brec + bj * HALF + wc * 32 + 8 * fq + 4 * n);
#pragma unroll
        for (int ai = 0; ai < 2; ++ai)
#pragma unroll
            for (int mp = 0; mp < 4; mp += 2) { unsigned char* rowp = O + (size_t)(row0 + ai * HALF + (mp + (fq & 1)) * 16) * DM + (col0 - 8 * (fq & 1));
#pragma unroll
                for (int bj = 0; bj < 2; ++bj) { u32x2 wq[2];
#pragma unroll
                    for (int q = 0; q < 2; ++q) { const f32x4 v0 = acc[ai][bj][mp + q][0] * WUNSCALE + bv[bj][0], v1 = acc[ai][bj][mp + q][1] * WUNSCALE + bv[bj][1];
                        wq[q].x = pk4_fp8(v0[0], v0[1], v0[2], v0[3]); wq[q].y = pk4_fp8(v1[0], v1[1], v1[2], v1[3]); }
                    *(u32x4*)(rowp + bj * HALF) = widen16(wq[0], wq[1]); } }
    }
};

constexpr int PG8_META_OFF = 157696, PG8_META_SLOT = 2048;
constexpr int PG8_BIAS_OFF = 131072, PG8_BIAS_MAX = 24;
template <class Epi, class Sched, bool GATHER, bool FP8 = false, bool META = false, bool ALIGN_EPI = true>
__device__ __forceinline__ void gemm_phase(PG8_LAS unsigned char* lds, const Gemm g, const Sched& S, const Epi& E) {
    int tid_ = threadIdx.x; asm volatile("" : "+v"(tid_));
    const int tid = tid_, wid = __builtin_amdgcn_readfirstlane(tid >> 6), lane = tid & 63, wr = wid >> 2, wc = wid & 3, fr = lane & 15, fq = lane >> 4;
    const int K = FP8 ? g.K / 2 : g.K, nt = K / BK;
    unsigned voffB[2]; int RA[2], CA2[2]; unsigned voffA[2];
#pragma unroll
    for (int i = 0; i < 2; ++i) { int R, C; stage_rc(tid * 16 + i * 8192, R, C); const int Rb = Epi::PERM ? ((R & ~31) + perm32(R & 31)) : R;
        voffA[i] = (unsigned)(R * K + C) * 2u; voffB[i] = (unsigned)(Rb * K + C) * 2u; RA[i] = R; CA2[i] = C * 2; }
    const size_t kstep = (size_t)(BK * 2);
    const size_t hstep = (size_t)HALF * K * 2;
    const size_t tstep = 2 * hstep;
    const unsigned ldsw = (unsigned)wid * 1024u;
    const int aoff = lds_byte(wr * 64 + fr, fq * 8), boff = lds_byte(wc * 32 + fr, fq * 8);
    const unsigned lds0 = (unsigned)(uintptr_t)lds;
#define PG8_SA(b, h) (((b) * 2 + (h)) * HTB)
#define PG8_SB(b, h) ((4 + (b) * 2 + (h)) * HTB)
#define PG8_GLDS(sbase, voff, ldsoff) do { unsigned keep_; asm volatile("s_mov_b32 %0, m0\n\ts_mov_b32 m0, %3\n\ts_nop 0\n\tglobal_load_lds_dwordx4 %1, %2\n\ts_mov_b32 m0, %0" \
        : "=&s"(keep_) : "v"(voff), "s"(sbase), "s"((unsigned)__builtin_amdgcn_readfirstlane((int)(lds0 + (unsigned)(ldsoff)))) : "memory"); } while (0)
#define PG8_STAGE_B(bufoff, gbase) do { PG8_GLDS((const char*)(gbase), voffB[0], (bufoff) + ldsw); PG8_GLDS((const char*)(gbase), voffB[1], (bufoff) + ldsw + 8192); } while (0)
#define PG8_STAGE_A(bufoff, gbase, o0, o1) do { PG8_GLDS((const char*)(gbase), (o0), (bufoff) + ldsw); PG8_GLDS((const char*)(gbase), (o1), (bufoff) + ldsw + 8192); } while (0)
#define PG8_LDA(dst, b, h) do { _Pragma("unroll") for (int m = 0; m < 4; ++m) _Pragma("unroll") for (int k = 0; k < 2; ++k) dst[m][k] = *(const PG8_LAS bf16x8*)(lds + PG8_SA(b, h) + aoff + m * 2048 + k * 1024); } while (0)
#define PG8_LDB(dst, b, h) do { _Pragma("unroll") for (int n = 0; n < 2; ++n) _Pragma("unroll") for (int k = 0; k < 2; ++k) dst[n][k] = *(const PG8_LAS bf16x8*)(lds + PG8_SB(b, h) + boff + n * 2048 + k * 1024); } while (0)
#define PG8_LD8(p) __builtin_shufflevector(*(const PG8_LAS v4i_t*)(p), *(const PG8_LAS v4i_t*)((p) + 1024), 0, 1, 2, 3, 4, 5, 6, 7)
#define PG8_LDA8(dst, b, h) do { _Pragma("unroll") for (int m = 0; m < 4; ++m) dst[m] = PG8_LD8(lds + PG8_SA(b, h) + aoff + m * 2048); } while (0)
#define PG8_LDB8(dst, b, h) do { _Pragma("unroll") for (int n = 0; n < 2; ++n) dst[n] = PG8_LD8(lds + PG8_SB(b, h) + boff + n * 2048); } while (0)
#if defined(PROBE_DOUBLE_MFMA)
#define PG8_MFMA_TWICE(ai, bj, m, n, At, Bt) acc[ai][bj][m][n] = __builtin_amdgcn_mfma_scale_f32_16x16x128_f8f6f4(Bt##8[n], At##8[m], acc[ai][bj][m][n], 0, 0, 0, 0, 0, 0);
#else
#define PG8_MFMA_TWICE(ai, bj, m, n, At, Bt)
#endif
#define PG8_MMA(ai, bj, At, Bt) do { __builtin_amdgcn_s_setprio(1); \
        if constexpr (FP8) { _Pragma("unroll") for (int m = 0; m < 4; ++m) _Pragma("unroll") for (int n = 0; n < 2; ++n) \
            { acc[ai][bj][m][n] = __builtin_amdgcn_mfma_scale_f32_16x16x128_f8f6f4(Bt##8[n], At##8[m], acc[ai][bj][m][n], 0, 0, 0, 0, 0, 0); PG8_MFMA_TWICE(ai, bj, m, n, At, Bt) }     \
              \
            _Pragma("unroll") for (int m = 0; m < 4; ++m) _Pragma("unroll") for (int n = 0; n < 2; ++n) asm volatile("" : "+v"(acc[ai][bj][m][n])); } \
        else { _Pragma("unroll") for (int m = 0; m < 4; ++m) _Pragma("unroll") for (int n = 0; n < 2; ++n) _Pragma("unroll") for (int k = 0; k < 2; ++k) \
            acc[ai][bj][m][n] = __builtin_amdgcn_mfma_f32_16x16x32_bf16(Bt[n][k], At[m][k], acc[ai][bj][m][n], 0, 0, 0); } \
        __builtin_amdgcn_s_setprio(0); } while (0)
#define PG8_XLDA(dst, b, h) do { if constexpr (FP8) PG8_LDA8(dst##8, b, h); else PG8_LDA(dst, b, h); } while (0)
#define PG8_XLDB(dst, b, h) do { if constexpr (FP8) PG8_LDB8(dst##8, b, h); else PG8_LDB(dst, b, h); } while (0)
#define PG8_WAIT_V(n) asm volatile("s_waitcnt vmcnt(" #n ")" ::: "memory")
#define PG8_WAIT_L(n) asm volatile("s_waitcnt lgkmcnt(" #n ")" ::: "memory")
#define PG8_BAR __builtin_amdgcn_s_barrier()
#define PG8_SCHED __builtin_amdgcn_sched_barrier(0)
    Unit cur, nxt; int ui = 0;
#if defined(PROBE_DOUBLE_K)
    constexpr bool DKSEL = (PROBE_DOUBLE_K == 1) ? GATHER : (PROBE_DOUBLE_K == 2) ? (FP8 && !GATHER) : (!FP8 && !GATHER && Epi::PERM);
#define PG8_UIDX(i) (DKSEL ? ((i) >> 1) : (i))
#else
#define PG8_UIDX(i) (i)
#endif
    if (!S.next(PG8_UIDX(0), cur)) return;
    if constexpr (FP8 && !META && Epi::BIAS) {
        f32x4 bv_[3]; bool ok_[3];
#pragma unroll
        for (int k = 0; k < 3; ++k) { Unit bu; ok_[k] = S.next(wid + 8 * k, bu); if (ok_[k]) bv_[k] = *(const f32x4*)&E.bias[E.bias_idx(bu, 4 * lane)]; }
#pragma unroll
        for (int k = 0; k < 3; ++k) if (ok_[k]) *(PG8_LAS f32x4*)(lds + PG8_BIAS_OFF + (wid + 8 * k) * 1024 + lane * 16) = bv_[k];
        PG8_WAIT_L(0); PG8_BAR; }
    f32x4 acc[2][2][4][2];
#pragma unroll
    for (int a = 0; a < 2; ++a)
#pragma unroll
        for (int b = 0; b < 2; ++b)
#pragma unroll
            for (int m = 0; m < 4; ++m)
#pragma unroll
                for (int n = 0; n < 2; ++n) acc[a][b][m][n] = (f32x4){0.f, 0.f, 0.f, 0.f};
    bf16x8 At[4][2], B0[2][2], B1[2][2]; v8i_t At8[4], B08[2], B18[2];
    const char* cA = GATHER ? (const char*)g.A : (const char*)g.A + (size_t)cur.pm * tstep;
    const char* cB = (const char*)g.Bt + ((size_t)cur.e * g.strideB) * 2 + (size_t)cur.pn * tstep;
    unsigned gc[2][2], gn[2][2];
    unsigned tkn[4] = {0u, 0u, 0u, 0u};
#define PG8_META_ISSUE(u_, slot_) do { const char* sb_; unsigned vo_; \
        if (GATHER && wid == 0) { S.tok_src(u_, lane, sb_, vo_); PG8_GLDS(sb_, vo_, PG8_META_OFF + (slot_) * PG8_META_SLOT); } \
        if (wid == 1) { E.bias_src(u_, lane, sb_, vo_); PG8_GLDS(sb_, vo_, PG8_META_OFF + (slot_) * PG8_META_SLOT + 1024); } } while (0)
    if constexpr (META) { PG8_META_ISSUE(cur, 0); PG8_WAIT_V(0); PG8_BAR; asm volatile("" ::: "memory");
        if constexpr (GATHER) S.gather_lds(cur, RA, CA2, gc, (unsigned)(K * 2), (const PG8_LAS int*)(lds + PG8_META_OFF)); }
    else if constexpr (GATHER) { S.gather(cur, RA, CA2, gc, (unsigned)(K * 2)); }
    else {
#pragma unroll
        for (int h = 0; h < 2; ++h)
#pragma unroll
            for (int i = 0; i < 2; ++i) gc[h][i] = (unsigned)(h * hstep) + voffA[i]; }
#pragma unroll
    for (int h = 0; h < 2; ++h)
#pragma unroll
        for (int i = 0; i < 2; ++i) gn[h][i] = gc[h][i];
    PG8_STAGE_B(PG8_SB(0, 0), cB); PG8_STAGE_B(PG8_SB(0, 1), cB + hstep); PG8_STAGE_A(PG8_SA(0, 0), cA, gc[0][0], gc[0][1]); PG8_STAGE_A(PG8_SA(0, 1), cA, gc[1][0], gc[1][1]);
    if (wr == 1) PG8_BAR;
    PG8_WAIT_V(2); PG8_BAR;
    PG8_STAGE_B(PG8_SB(1, 0), cB + kstep); PG8_STAGE_A(PG8_SA(1, 0), cA + kstep, gc[0][0], gc[0][1]); PG8_STAGE_B(PG8_SB(1, 1), cB + hstep + kstep);
    PG8_WAIT_V(6); PG8_BAR;
    for (;;) {
        const bool has_next = S.next(PG8_UIDX(ui + 1), nxt);
        const char* nA = GATHER ? cA : (has_next ? (const char*)g.A + (size_t)nxt.pm * tstep : cA);
        const char* nB = has_next ? (const char*)g.Bt + ((size_t)nxt.e * g.strideB) * 2 + (size_t)nxt.pn * tstep : cB;
        if constexpr (META) { if (has_next) PG8_META_ISSUE(nxt, (ui + 1) % 3); }
        else if constexpr (GATHER) { if (has_next) S.gather_issue(nxt, RA, tkn); }
        for (int t = 0; t < nt; t += 2) {
            const bool last = (t == nt - 2);
            const char* a1 = cA + (size_t)(t + 1) * kstep;
            const char* a2 = last ? nA : cA + (size_t)(t + 2) * kstep; const char* b2 = last ? nB : cB + (size_t)(t + 2) * kstep;
            const char* a3 = a2 + kstep; const char* b3 = b2 + kstep;
            if constexpr (GATHER && META) { if (last && has_next) S.gather_lds(nxt, RA, CA2, gn, (unsigned)(K * 2), (const PG8_LAS int*)(lds + PG8_META_OFF + ((ui + 1) % 3) * PG8_META_SLOT)); }
            if constexpr (GATHER && !META) { if (last && has_next) {
                asm volatile("s_waitcnt vmcnt(8)" : "+v"(tkn[0]), "+v"(tkn[1]), "+v"(tkn[2]), "+v"(tkn[3]) :: "memory");
                S.gather_finish(nxt, RA, CA2, tkn, gn, (unsigned)(K * 2)); } }
            unsigned o00 = gc[0][0], o01 = gc[0][1], o10 = gc[1][0], o11 = gc[1][1];
            if constexpr (GATHER) { if (last) { o00 = gn[0][0]; o01 = gn[0][1]; o10 = gn[1][0]; o11 = gn[1][1]; } }
            PG8_XLDB(B0, 0, 0); PG8_XLDB(B1, 0, 1); PG8_SCHED; PG8_XLDA(At, 0, 0); PG8_STAGE_A(PG8_SA(1, 1), a1, gc[1][0], gc[1][1]);
            PG8_WAIT_V(8); PG8_WAIT_L(0); PG8_BAR; PG8_MMA(0, 0, At, B0); PG8_MMA(0, 1, At, B1); PG8_BAR; PG8_SCHED;
            PG8_XLDA(At, 0, 1); PG8_STAGE_B(PG8_SB(0, 0), b2); PG8_STAGE_B(PG8_SB(0, 1), b2 + hstep); PG8_STAGE_A(PG8_SA(0, 0), a2, o00, o01);
            PG8_WAIT_V(8); PG8_WAIT_L(0); PG8_BAR; PG8_MMA(1, 0, At, B0); PG8_MMA(1, 1, At, B1); PG8_BAR; PG8_SCHED;
            PG8_XLDB(B0, 1, 0); PG8_XLDB(B1, 1, 1); PG8_SCHED; PG8_XLDA(At, 1, 0); PG8_STAGE_A(PG8_SA(0, 1), a2, o10, o11);
            PG8_WAIT_V(8); PG8_WAIT_L(0); PG8_BAR; PG8_MMA(0, 0, At, B0); PG8_MMA(0, 1, At, B1); PG8_BAR; PG8_SCHED;
            PG8_XLDA(At, 1, 1); PG8_STAGE_B(PG8_SB(1, 0), b3); PG8_STAGE_B(PG8_SB(1, 1), b3 + hstep); PG8_STAGE_A(PG8_SA(1, 0), a3, o00, o01);
            PG8_WAIT_V(8); PG8_WAIT_L(0); PG8_BAR; PG8_MMA(1, 0, At, B0); PG8_MMA(1, 1, At, B1); PG8_BAR; PG8_SCHED;
        }
        if constexpr (ALIGN_EPI) { if (wr == 0) PG8_BAR; }
#if defined(PROBE_DOUBLE_K)
        const bool dk_first = DKSEL && ((ui & 1) == 0);
        if (DKSEL && !dk_first) { _Pragma("unroll") for (int a = 0; a < 2; ++a) _Pragma("unroll") for (int b = 0; b < 2; ++b) _Pragma("unroll") for (int m = 0; m < 4; ++m) _Pragma("unroll") for (int n = 0; n < 2; ++n) acc[a][b][m][n] *= 0.5f; }
#else
        constexpr bool dk_first = false;
#endif
        if (!dk_first)
        { int fr_ = fr, fq_ = fq; asm volatile("" : "+v"(fr_), "+v"(fq_));
          if constexpr (META) PG8_WAIT_V(0);
          asm volatile("" ::: "memory");
          if constexpr (META) E(acc, cur, wr, wc, fr_, fq_, (const PG8_LAS float*)(lds + PG8_META_OFF + (ui % 3) * PG8_META_SLOT + 1024));
          else if constexpr (FP8 && Epi::BIAS) E(acc, cur, wr, wc, fr_, fq_, (const PG8_LAS float*)(lds + PG8_BIAS_OFF) + ui * 256);
          else E(acc, cur, wr, wc, fr_, fq_);
#if defined(PROBE_DOUBLE_EPI_OFF)
          if constexpr (GATHER) { asm volatile("" : "+v"(fr_), "+v"(fq_)); E(acc, cur, wr, wc, fr_, fq_); }
#endif
          }
        if (!has_next) break;
        if (!dk_first) {
#pragma unroll
        for (int a = 0; a < 2; ++a)
#pragma unroll
            for (int b = 0; b < 2; ++b)
#pragma unroll
                for (int m = 0; m < 4; ++m)
#pragma unroll
                    for (int n = 0; n < 2; ++n) acc[a][b][m][n] = (f32x4){0.f, 0.f, 0.f, 0.f};
        }
        cur = nxt; cA = nA; cB = nB; ++ui;
#pragma unroll
        for (int h = 0; h < 2; ++h)
#pragma unroll
            for (int i = 0; i < 2; ++i) gc[h][i] = gn[h][i];
        if constexpr (ALIGN_EPI) { if (wr == 1) PG8_BAR; }
    }
    PG8_WAIT_V(0);
    if constexpr (!ALIGN_EPI) { if (wr == 0) PG8_BAR; }
    PG8_BAR;
#undef PG8_UIDX
#undef PG8_META_ISSUE
#undef PG8_SA
#undef PG8_SB
#undef PG8_GLDS
#undef PG8_STAGE_A
#undef PG8_STAGE_B
#undef PG8_LDA
#undef PG8_LDB
#undef PG8_MMA
#undef PG8_LD8
#undef PG8_LDA8
#undef PG8_LDB8
#undef PG8_XLDA
#undef PG8_XLDB
#undef PG8_WAIT_V
#undef PG8_WAIT_L
#undef PG8_BAR
#undef PG8_SCHED
}
}

namespace attn_body {
using bf16=__hip_bfloat16;
using bf16x8=__attribute__((ext_vector_type(8)))short;
using s16x4=__attribute__((ext_vector_type(4)))short;
using f32x16=__attribute__((ext_vector_type(16)))float;
using u32x4=__attribute__((ext_vector_type(4)))unsigned;
constexpr int D=64,PQ=INW,PO=DM;
constexpr int NW=8,QBLK=32,QB=QBLK*NW,KVBLK=64,NQB=SEQ/QB;
constexpr int ATTN_UNIT_ROWS=QB;
__device__ __forceinline__ int crow(int r,int hi){return (r&3)+8*(r>>2)+4*hi;}
#define SBAR() __builtin_amdgcn_sched_barrier(0)
__device__ __forceinline__ void cmask(f32x16&p0,f32x16&p1,int jb,int qrel,int hi){
  const float NEG=-INFINITY; int kb=64*jb+4*hi;
  #pragma unroll
  for(int r=0;r<16;++r){int kv=kb+(r&3)+8*(r>>2); if(kv>qrel)p0[r]=NEG; if(kv+32>qrel)p1[r]=NEG;}
}

constexpr int NSLOT=3, SLOTB=8192;
constexpr int LDS_K=0, LDS_V=NSLOT*SLOTB, LDS_WS=3*NSLOT*SLOTB, LDS_STASH=LDS_WS+NW*64*4, LDS_BYTES=LDS_STASH+NW*8192;
constexpr float C2=0.125f*1.4426950408889634f;
__device__ __forceinline__ void glds16(const void*gsrc,unsigned lds_dst){unsigned keep;
  asm volatile("s_mov_b32 %0, m0\n\ts_mov_b32 m0, %2\n\ts_nop 0\n\tglobal_load_lds_dwordx4 %1, off\n\ts_mov_b32 m0, %0":"=&s"(keep):"v"(gsrc),"s"(lds_dst):"memory");}
__device__ __forceinline__ float max3f(float a,float b,float c){float r;asm("v_max3_f32 %0, %1, %2, %3":"=v"(r):"v"(a),"v"(b),"v"(c));return r;}
__device__ __forceinline__ float max2f(float a,float b){float r;asm("v_max_f32_e32 %0, %1, %2":"=v"(r):"v"(a),"v"(b));return r;}
__device__ __forceinline__ float fadd_s(float a,float b){float r;asm("v_add_f32_e32 %0, %1, %2":"=v"(r):"v"(a),"v"(b));return r;}
__device__ __forceinline__ float fsub_s(float a,float b){float r;asm("v_sub_f32_e32 %0, %1, %2":"=v"(r):"v"(a),"v"(b));return r;}
typedef float f32x2_t __attribute__((ext_vector_type(2))); typedef __bf16 bf16x2_t __attribute__((ext_vector_type(2)));
__device__ __forceinline__ unsigned cvtpk_s(float lo,float hi){f32x2_t v={lo,hi};bf16x2_t b=__builtin_convertvector(v,bf16x2_t);return __builtin_bit_cast(unsigned,b);}
#define WAIT_BAR(N) asm volatile("s_waitcnt vmcnt(" #N ") lgkmcnt(0)\n\ts_barrier":::"memory")

__device__ __forceinline__ void qkt(f32x16&p0,f32x16&p1,const char*Kslot,const bf16x8*qr,int r32,int hi){ const f32x16 negm=f32x16{};
  const char*kb=Kslot+hi*1024+r32*16;
  #pragma unroll
  for(int d0=0;d0<4;++d0){
    const bf16x8 b0=*reinterpret_cast<const bf16x8*>(kb+d0*2048);
    const bf16x8 b1=*reinterpret_cast<const bf16x8*>(kb+d0*2048+512);
    if(d0==0){p0=__builtin_amdgcn_mfma_f32_32x32x16_bf16(b0,qr[0],negm,0,0,0);p1=__builtin_amdgcn_mfma_f32_32x32x16_bf16(b1,qr[0],negm,0,0,0);}
    else{p0=__builtin_amdgcn_mfma_f32_32x32x16_bf16(b0,qr[d0],p0,0,0,0);p1=__builtin_amdgcn_mfma_f32_32x32x16_bf16(b1,qr[d0],p1,0,0,0);}}
}
typedef __attribute__((address_space(3))) const char* lds_cptr;
typedef short v4i16_t __attribute__((ext_vector_type(4)));
__device__ __forceinline__ void kload8(bf16x8*kf,lds_cptr kp){
  kf[0]=*(const __attribute__((address_space(3))) bf16x8*)(kp);      kf[1]=*(const __attribute__((address_space(3))) bf16x8*)(kp+512);
  kf[2]=*(const __attribute__((address_space(3))) bf16x8*)(kp+2048); kf[3]=*(const __attribute__((address_space(3))) bf16x8*)(kp+2560);
  kf[4]=*(const __attribute__((address_space(3))) bf16x8*)(kp+4096); kf[5]=*(const __attribute__((address_space(3))) bf16x8*)(kp+4608);
  kf[6]=*(const __attribute__((address_space(3))) bf16x8*)(kp+6144); kf[7]=*(const __attribute__((address_space(3))) bf16x8*)(kp+6656);
}
__device__ __forceinline__ void kload2(bf16x8*kf,lds_cptr kp,int j){ kf[2*j]=*(const __attribute__((address_space(3))) bf16x8*)(kp+j*2048); kf[2*j+1]=*(const __attribute__((address_space(3))) bf16x8*)(kp+j*2048+512); }
__device__ __forceinline__ s16x4 vtr(lds_cptr p){ return __builtin_bit_cast(s16x4,__builtin_amdgcn_ds_read_tr16_b64_v4i16((__attribute__((address_space(3))) v4i16_t*)p)); }
__device__ __forceinline__ float rowmax(const f32x16&p0,const f32x16&p1){
  float a=max3f(p0[0],p0[1],p1[0]),b=max3f(p0[2],p0[3],p1[1]);a=max3f(a,p1[2],p1[3]);
  #pragma unroll
  for(int r=4;r<16;r+=4){a=max3f(a,p0[r],p0[r+1]);b=max3f(b,p0[r+2],p0[r+3]);a=max3f(a,p1[r],p1[r+1]);b=max3f(b,p1[r+2],p1[r+3]);}
  const float m=max2f(a,b);
  auto rr=__builtin_amdgcn_permlane32_swap(__float_as_uint(m),__float_as_uint(m),false,false);
  return max2f(__uint_as_float(rr[0]),__uint_as_float(rr[1]));
}
__device__ __forceinline__ void pv(f32x16*o,int vb,bf16x8 pa0,bf16x8 pa1,bf16x8 pa2,bf16x8 pa3){
  #pragma unroll
  for(int d0=0;d0<4;++d0){s16x4 lo[4],hi[4];
    #pragma unroll
    for(int ks=0;ks<4;++ks){
      asm volatile("ds_read_b64_tr_b16 %0,%1 offset:%c2":"=&v"(lo[ks]):"v"(vb),"i"(d0*4096+ks*1024):"memory");
      asm volatile("ds_read_b64_tr_b16 %0,%1 offset:%c2":"=&v"(hi[ks]):"v"(vb),"i"(d0*4096+ks*1024+512):"memory");}
    asm volatile("s_waitcnt lgkmcnt(0)":::"memory");SBAR();
    #define PK(k) (bf16x8){lo[k][0],lo[k][1],lo[k][2],lo[k][3],hi[k][0],hi[k][1],hi[k][2],hi[k][3]}
    o[d0]=__builtin_amdgcn_mfma_f32_32x32x16_bf16(pa0,PK(0),o[d0],0,0,0);
    o[d0]=__builtin_amdgcn_mfma_f32_32x32x16_bf16(pa1,PK(1),o[d0],0,0,0);
    o[d0]=__builtin_amdgcn_mfma_f32_32x32x16_bf16(pa2,PK(2),o[d0],0,0,0);
    o[d0]=__builtin_amdgcn_mfma_f32_32x32x16_bf16(pa3,PK(3),o[d0],0,0,0);
    #undef PK
  }
}

#ifndef ATTN_STORE16
#define ATTN_STORE16(p,v) (*(u32x4*)(p)=(v))
#endif
template<int THRL> __device__ __forceinline__ void attn_unit(int qb,int st,float lam,const float*sgp,const bf16*Qb,const bf16*__restrict__ Kb,const bf16*__restrict__ Vb,bf16*Ob,char*shm){
  int tid_=threadIdx.x; asm volatile("":"+v"(tid_));
  const int tid=tid_,lane=tid&63,r32=lane&31,hi=lane>>5; const int wid=__builtin_amdgcn_readfirstlane(tid>>6);
  const int q0=qb*QB;
  const bf16*Qw=Qb+(long)(q0+wid*QBLK)*PQ;
  const bf16*Kh=Kb,*Vh=Vb;
  const unsigned lds0=(unsigned)(uintptr_t)shm;
  float*wsf=(float*)(shm+LDS_WS)+wid*64;
  const bf16*ksrc=Kh+(long)lane*PQ+wid*8;
  const bf16*vsrc=Vh+(long)(16*(wid&3)+(lane>>2))*PQ+(wid>>2)*32+(lane&3)*8;
  const unsigned kdst=lds0+LDS_K+wid*1024, vdst=lds0+LDS_V+wid*1024;
  #define DMA_K(t,slot) glds16(ksrc+(long)(t)*KVBLK*PQ,(unsigned)__builtin_amdgcn_readfirstlane(kdst+(slot)))
  #define DMA_V(t,slot) do{ glds16(vsrc+(long)(t)*KVBLK*PQ,(unsigned)__builtin_amdgcn_readfirstlane(vdst+2*(slot))); glds16(vsrc+(long)(t)*KVBLK*PQ+64,(unsigned)__builtin_amdgcn_readfirstlane(vdst+2*(slot)+8192)); }while(0)
  const int vb0=(int)(lds0+LDS_V)+((lane>>4)&1)*32+(lane&3)*8+(4*hi+((lane&15)>>2))*64;
  const char*Kbase=shm+LDS_K; bf16x8 kf[8];
  const lds_cptr shm3=(lds_cptr)shm; const lds_cptr kp0=shm3+LDS_K+hi*1024+r32*16; const lds_cptr vp0=shm3+LDS_V+((lane>>4)&1)*32+(lane&3)*8+(4*hi+((lane&15)>>2))*64;
  const int NT=(q0+QB)/KVBLK;
  DMA_K(0,0);DMA_V(0,0);DMA_K(1,SLOTB);
  bf16x8 qr[4];
  #pragma unroll
  for(int d0=0;d0<4;++d0)qr[d0]=*reinterpret_cast<const bf16x8*>(&Qw[(long)r32*PQ+d0*16+hi*8]);
  float mhat=0.f,l_reg=0.f;f32x16 o[4];o[0]=f32x16{};o[1]=f32x16{};o[2]=f32x16{};o[3]=f32x16{};
  const int qrel=wid*QBLK+r32;
  #define CMASK(P0,P1,t) do{int jb_=(t)-(NT-4); if(jb_>=0)cmask(P0,P1,jb_,qrel,hi);}while(0)
  bool resc=false;
  #define START(P0,P1) do{ const float rm=rowmax(P0,P1); resc=false; mhat=rm; \
    _Pragma("unroll") for(int r=0;r<16;++r)P0[r]=__builtin_amdgcn_exp2f(P0[r]-mhat); }while(0)
  #define RESC() do{ if(resc){ asm volatile("s_waitcnt lgkmcnt(0)":::"memory"); \
      _Pragma("unroll") for(int d_=0;d_<4;++d_) _Pragma("unroll") for(int r=0;r<16;++r)o[d_][r]*=wsf[crow(r,hi)]; } }while(0)
  f32x16 pA0,pA1,pB0,pB1;
  int sl_prev=0,sl_cur=0,sl_next=SLOTB;
  #define ROT() do{sl_prev=sl_cur;sl_cur=sl_next;sl_next=(sl_next==(NSLOT-1)*SLOTB)?0:sl_next+SLOTB;}while(0)
  DMA_K(2,2*SLOTB);
  WAIT_BAR(4);
  qkt(pA0,pA1,Kbase,qr,r32,hi);asm volatile("s_nop 15\n\ts_nop 7":"+v"(pA0),"+v"(pA1));CMASK(pA0,pA1,0);
  START(pA0,pA1);
  _Pragma("unroll") for(int r=0;r<16;++r)pA1[r]=__builtin_amdgcn_exp2f(pA1[r]-mhat);
  WAIT_BAR(0);
  DMA_K(3,0);DMA_V(1,SLOTB);
  ROT();
  kload8(kf,kp0+sl_cur);
  WAIT_BAR(3);
  s16x4 vlo[4],vhi[4]; u32x4 pw0,pw1,pw2,pw3;
  #define PKW(P,B) cvtpk_s(P[B],P[B+1])
  #define PAF(k) __builtin_bit_cast(bf16x8,pw##k)
  #define PAFJ(j) __builtin_bit_cast(bf16x8,((j)<4?pw0:(j)<8?pw1:(j)<12?pw2:pw3))
  #define VFR(i) (bf16x8){vlo[i][0],vlo[i][1],vlo[i][2],vlo[i][3],vhi[i][0],vhi[i][1],vhi[i][2],vhi[i][3]}
  #define PIN(x) asm volatile("":"+v"(x))
  #define MX3(a,b,c) __builtin_fmaxf(__builtin_fmaxf((a),(b)),(c))
  #define GAPA(MF,A0,A1,A2,A3,W0,W1,PW) do{ MF; sacc+=A0; sacc+=A1; sacc+=A2; sacc+=A3; PIN(sacc); W0; W1; PIN(PW); SBAR(); }while(0)
  #define EX(v) __builtin_amdgcn_exp2f(v)
  #define GAPB(MF,X,B) do{ MF; X[B]=EX(X[B]-mhat); X[B+1]=EX(X[B+1]-mhat); PIN(X); SBAR(); }while(0)
  #define VRD(S,ks,d0) do{ vlo[S]=vtr(vp_+((d0)*4096+(ks)*1024)); vhi[S]=vtr(vp_+((d0)*4096+(ks)*1024+512)); }while(0)
  #define KRD(G,j) do{ if(G){ kload2(kf,kp0+sl_next,j); SBAR(); } }while(0)
  #define PVG(j,X,B) GAPB(o[(j)&3]=__builtin_amdgcn_mfma_f32_32x32x16_bf16(PAFJ(j),VFR((j)&3),o[(j)&3],0,0,0), X,B)
  #define STEP(C0,C1,P0,P1,t,GK,GV,GL) do{ SBAR(); \
    const lds_cptr vp_=vp0+2*sl_prev; \
    float sacc=(P0[0]+P0[1]); \
    GAPA(C0=__builtin_amdgcn_mfma_f32_32x32x16_bf16(kf[0],qr[0],f32x16{},0,0,0), P0[2],P0[3],P0[4],P0[5],     pw0[0]=PKW(P0,0), pw0[1]=PKW(P0,2), pw0); \
    GAPA(C1=__builtin_amdgcn_mfma_f32_32x32x16_bf16(kf[1],qr[0],f32x16{},0,0,0), P0[6],P0[7],P0[8],P0[9],     pw0[2]=PKW(P0,4), pw0[3]=PKW(P0,6), pw0); \
    GAPA(C0=__builtin_amdgcn_mfma_f32_32x32x16_bf16(kf[2],qr[1],C0,0,0,0),   P0[10],P0[11],P0[12],P0[13], pw1[0]=PKW(P0,8), pw1[1]=PKW(P0,10), pw1); \
    GAPA(C1=__builtin_amdgcn_mfma_f32_32x32x16_bf16(kf[3],qr[1],C1,0,0,0),   P0[14],P0[15],P1[0],P1[1],   pw1[2]=PKW(P0,12),pw1[3]=PKW(P0,14), pw1); \
    VRD(0,0,0); SBAR(); GAPA(C0=__builtin_amdgcn_mfma_f32_32x32x16_bf16(kf[4],qr[2],C0,0,0,0),   P1[2],P1[3],P1[4],P1[5],     pw2[0]=PKW(P1,0), pw2[1]=PKW(P1,2), pw2); \
    VRD(1,0,1); SBAR(); GAPA(C1=__builtin_amdgcn_mfma_f32_32x32x16_bf16(kf[5],qr[2],C1,0,0,0),   P1[6],P1[7],P1[8],P1[9],     pw2[2]=PKW(P1,4), pw2[3]=PKW(P1,6), pw2); \
    VRD(2,0,2); SBAR(); GAPA(C0=__builtin_amdgcn_mfma_f32_32x32x16_bf16(kf[6],qr[3],C0,0,0,0),   P1[10],P1[11],P1[12],P1[13], pw3[0]=PKW(P1,8), pw3[1]=PKW(P1,10), pw3); \
    VRD(3,0,3); SBAR(); GAPA(C1=__builtin_amdgcn_mfma_f32_32x32x16_bf16(kf[7],qr[3],C1,0,0,0),   P1[14],P1[15],0.f,0.f,       pw3[2]=PKW(P1,12),pw3[3]=PKW(P1,14), pw3); \
    l_reg+=sacc; \
    if(GK){DMA_K((t)+3,sl_cur);} if(GV){DMA_V((t)+1,sl_next);} \
    CMASK(C0,C1,t); \
    { float a=MX3(C0[0],C0[1],C1[0]),b=MX3(C0[2],C0[3],C1[1]); a=MX3(a,C1[2],C1[3]); \
      _Pragma("unroll") for(int r=4;r<16;r+=4){a=MX3(a,C0[r],C0[r+1]);b=MX3(b,C0[r+2],C0[r+3]);a=MX3(a,C1[r],C1[r+1]);b=MX3(b,C1[r+2],C1[r+3]);} \
      float rm=__builtin_fmaxf(a,b); { auto rr=__builtin_amdgcn_permlane32_swap(__float_as_uint(rm),__float_as_uint(rm),false,false); rm=__builtin_fmaxf(__uint_as_float(rr[0]),__uint_as_float(rr[1])); } \
      resc=false; rm-=mhat;                                   \
      if(__builtin_expect(__any(rm>(float)THRL),0)){ const float dl=__builtin_fmaxf(rm,0.f); mhat+=dl; \
        const float f=__builtin_amdgcn_exp2f(-dl); l_reg*=f; if(hi==0)wsf[r32]=f; resc=true; } } \
    SBAR(); \
      \
    PVG(0,C0,0);  VRD(0,1,0); SBAR(); \
    PVG(1,C0,2);  VRD(1,1,1); SBAR(); \
    PVG(2,C0,4);  VRD(2,1,2); SBAR(); \
    PVG(3,C0,6);  VRD(3,1,3); SBAR(); \
    PVG(4,C0,8);  VRD(0,2,0); SBAR(); \
    PVG(5,C0,10); VRD(1,2,1); SBAR(); \
    PVG(6,C0,12); VRD(2,2,2); SBAR(); \
    PVG(7,C0,14); VRD(3,2,3); SBAR(); \
    KRD(GL,0); PVG(8,C1,0);   VRD(0,3,0); SBAR(); \
    KRD(GL,1); PVG(9,C1,2);   VRD(1,3,1); SBAR(); \
    KRD(GL,2); PVG(10,C1,4);  VRD(2,3,2); SBAR(); \
    KRD(GL,3); PVG(11,C1,6);  VRD(3,3,3); SBAR(); \
    PVG(12,C1,8); PVG(13,C1,10); PVG(14,C1,12); PVG(15,C1,14); \
    }while(0)
  int t=1;
  #undef CMASK
  #define CMASK(P0,P1,t) do{}while(0)
  for(;t+5<NT;t+=2){
    STEP(pB0,pB1,pA0,pA1,t,true,true,true);     WAIT_BAR(3); RESC(); ROT();
    STEP(pA0,pA1,pB0,pB1,t+1,true,true,true);   WAIT_BAR(3); RESC(); ROT();
  }
  #undef CMASK
  #define CMASK(P0,P1,t) do{int jb_=(t)-(NT-4); if(jb_>=0)cmask(P0,P1,jb_,qrel,hi);}while(0)
  #define ENDW(tt) do{ if((tt)+3<NT){WAIT_BAR(3);} else if((tt)+2<NT){WAIT_BAR(2);} else {WAIT_BAR(0);} }while(0)
  for(;t+1<NT;t+=2){
    STEP(pB0,pB1,pA0,pA1,t,(t+3<NT),(t+1<NT),(t+1<NT));       ENDW(t);   RESC(); ROT();
    STEP(pA0,pA1,pB0,pB1,t+1,(t+4<NT),(t+2<NT),(t+2<NT));     ENDW(t+1); RESC(); ROT();
  }
  STEP(pB0,pB1,pA0,pA1,NT-1,false,false,false); RESC();
  { float sacc=pB0[0]+pB0[1]; _Pragma("unroll") for(int r=2;r<16;++r)sacc+=pB0[r]; _Pragma("unroll") for(int r=0;r<16;++r)sacc+=pB1[r]; l_reg+=sacc;
    pw0=(u32x4){PKW(pB0,0),PKW(pB0,2),PKW(pB0,4),PKW(pB0,6)};pw1=(u32x4){PKW(pB0,8),PKW(pB0,10),PKW(pB0,12),PKW(pB0,14)};pw2=(u32x4){PKW(pB1,0),PKW(pB1,2),PKW(pB1,4),PKW(pB1,6)};pw3=(u32x4){PKW(pB1,8),PKW(pB1,10),PKW(pB1,12),PKW(pB1,14)};
    SBAR(); pv(o,vb0+2*sl_cur,PAF(0),PAF(1),PAF(2),PAF(3)); }
  #undef PKW
  #undef PAF
  #undef PAFJ
  #undef PVG
  #undef VFR
  #undef PIN
  #undef MX3
  #undef GAPA
  #undef GAPB
  #undef EX
  #undef VRD
  #undef KRD
  #undef STEP
  #undef ENDW
  {auto rr=__builtin_amdgcn_permlane32_swap(__float_as_uint(l_reg),__float_as_uint(l_reg),false,false);l_reg=__uint_as_float(rr[0])+__uint_as_float(rr[1]);}
  if(hi==0)wsf[32+r32]=l_reg;asm volatile("s_waitcnt lgkmcnt(0)":::"memory");
  float rli[16];
  #pragma unroll
  for(int r=0;r<16;++r)rli[r]=__builtin_amdgcn_rcpf(wsf[32+crow(r,hi)]);
  bf16*stash=(bf16*)(shm+LDS_STASH)+wid*4096;
  if(st==0){
    #pragma unroll
    for(int r=0;r<16;++r){const int orow=crow(r,hi);
      #pragma unroll
      for(int d0=0;d0<4;++d0)stash[orow*128+d0*32+r32]=__float2bfloat16(o[d0][r]*rli[r]);}
  } else {
    asm volatile("s_waitcnt lgkmcnt(0)\n\ts_barrier":::"memory");
    bf16*stg=(bf16*)(shm+LDS_K)+wid*4096;
    #pragma unroll
    for(int r=0;r<16;++r){const int orow=crow(r,hi);
      #pragma unroll
      for(int d0=0;d0<4;++d0)stg[orow*128+d0*32+r32]=__float2bfloat16(o[d0][r]*rli[r]);}
    asm volatile("s_waitcnt lgkmcnt(0)":::"memory");
    bf16*Ow=Ob+(long)(q0+wid*QBLK)*PO;
    const int ch=lane&15; float sgv[8];
    #pragma unroll
    for(int i=0;i<8;++i)sgv[i]=sgp[ch*8+i]*(1.0f-LAMBDA_INIT);
    #pragma unroll
    for(int i=0;i<8;++i){const int row=i*4+(lane>>4);
      const u32x4 a4=*(const u32x4*)(stash+row*128+ch*8), b4=*(const u32x4*)(stg+row*128+ch*8);
      const unsigned aw[4]={a4.x,a4.y,a4.z,a4.w}, bw[4]={b4.x,b4.y,b4.z,b4.w}; float d[8]; float ss=0.f;
      #pragma unroll
      for(int c=0;c<4;++c){ d[2*c]=__uint_as_float(aw[c]<<16)-lam*__uint_as_float(bw[c]<<16); d[2*c+1]=__uint_as_float(aw[c]&0xffff0000u)-lam*__uint_as_float(bw[c]&0xffff0000u); ss+=d[2*c]*d[2*c]+d[2*c+1]*d[2*c+1]; }
      ss+=__shfl_xor(ss,1); ss+=__shfl_xor(ss,2); ss+=__shfl_xor(ss,4); ss+=__shfl_xor(ss,8);
      const float rn=rsqrtf(ss*(1.0f/128.0f)+LN_EPS);
#if OUTPROJ_FP8
      { unsigned char*Ow8=(unsigned char*)Ob+(long)(q0+wid*QBLK+row)*PO+ch*8;
        typedef unsigned u32x2_ __attribute__((ext_vector_type(2))); u32x2_ o8; o8.x=pg8::pk4_fp8(d[0]*rn*sgv[0],d[1]*rn*sgv[1],d[2]*rn*sgv[2],d[3]*rn*sgv[3]); o8.y=pg8::pk4_fp8(d[4]*rn*sgv[4],d[5]*rn*sgv[5],d[6]*rn*sgv[6],d[7]*rn*sgv[7]);
        *(u32x2_*)Ow8=o8; } }
#else
      u32x4 ov; ov.x=cvtpk_s(d[0]*rn*sgv[0],d[1]*rn*sgv[1]); ov.y=cvtpk_s(d[2]*rn*sgv[2],d[3]*rn*sgv[3]); ov.z=cvtpk_s(d[4]*rn*sgv[4],d[5]*rn*sgv[5]); ov.w=cvtpk_s(d[6]*rn*sgv[6],d[7]*rn*sgv[7]);
      ATTN_STORE16(Ow+(long)row*PO+ch*8,ov); }
#endif
  }
  asm volatile("s_waitcnt lgkmcnt(0)\n\ts_barrier":::"memory");
  #undef DMA_K
  #undef DMA_V
  #undef CMASK
  #undef START
  #undef RESC
  #undef ROT
}
constexpr int ATTN_LDS_BYTES=LDS_BYTES;
template<int THRL=8> __device__ __forceinline__ void attn_phase(char*lds,const bf16_t*proj,bf16_t*mix,int vcu,float lam,const float*sgp){
  const int bh=vcu>>3,s8=vcu&7,b=bh>>2,h=bh&3;
  const bf16*P0=(const bf16*)proj+(long)b*SEQ*PQ; bf16*O0=(bf16*)mix+(long)b*SEQ*PO+h*128;
  for(int i=0;i<4;++i){ const int qb=(i<2)?(15-s8):s8, st=i&1;
    attn_unit<THRL>(qb,st,lam,sgp,P0+C_Q+st*256+h*64,P0+C_K+st*256+h*64,P0+C_V+h*128,O0,lds); }
}
#undef SBAR
#undef WAIT_BAR
}

constexpr int NWAVES = 8;
constexpr int RING_OFF = 0, RING_BYTES = 131072;
constexpr int LDSCTL_OFF = 155648, MISC_OFF = LDSCTL_OFF + 320;
constexpr int TAB_OFF = LDSCTL_OFF + 1024;
constexpr int REC_OFF = LDSCTL_OFF + 2048;
constexpr int LDS_BYTES = 163840;
static_assert(pg8::PG8_META_OFF == LDSCTL_OFF + 2048 && pg8::PG8_META_OFF + 3 * pg8::PG8_META_SLOT <= LDS_BYTES && RING_OFF == 0, "GEMM unit-meta ring (overlays the router phase's REC area: different phases)");
static_assert(REC_OFF + (64 + 512) * 4 <= LDS_BYTES && attn_body::ATTN_LDS_BYTES <= LDSCTL_OFF && RING_BYTES <= LDSCTL_OFF, "LDS map");

#define GAS __attribute__((address_space(1)))
#define LAS __attribute__((address_space(3)))
typedef unsigned v4u __attribute__((ext_vector_type(4)));
typedef unsigned v2u __attribute__((ext_vector_type(2)));
typedef float f32x4 __attribute__((ext_vector_type(4)));
typedef float f32x2 __attribute__((ext_vector_type(2)));
typedef short bf16x8 __attribute__((ext_vector_type(8)));
typedef GAS unsigned gu32;
#define RLX_AGENT __ATOMIC_RELAXED, __HIP_MEMORY_SCOPE_AGENT
#define LDS_WAIT() asm volatile("s_waitcnt lgkmcnt(0)" ::: "memory")
#define VM_WAIT() asm volatile("s_waitcnt vmcnt(0)" ::: "memory")

#define XB_TMO      128
#define XB_XCNT(j)  (256  + 64 * (j))
#define XB_XSUB(j)  (1280 + 64 * (j))
#define XB_XGEN(j)  (2304 + 64 * (j))
#define XB_TOP      3328
#define XB_TOPGEN   3392
#define XCD_BAR_WORDS 3456
#define XB_SPIN_CAP (1u << 18)
__device__ __forceinline__ unsigned xb_ld(unsigned* p)              { return __hip_atomic_load(p, __ATOMIC_RELAXED, __HIP_MEMORY_SCOPE_AGENT); }
__device__ __forceinline__ unsigned xb_add(unsigned* p, unsigned v) { return __hip_atomic_fetch_add(p, v, __ATOMIC_RELAXED, __HIP_MEMORY_SCOPE_AGENT); }
__device__ __forceinline__ unsigned xb_xcc_id() { return (unsigned)__builtin_amdgcn_s_getreg((3 << 11) | 20) & 0xFu; }
#define XB_SPIN(cond, bar) do { unsigned _sp = 0; while (cond) { __builtin_amdgcn_s_sleep(1); \
    if ((++_sp & 255u) == 0u) { if (xb_ld(&(bar)[XB_TMO])) break; if (_sp > XB_SPIN_CAP) { atomicAdd(&(bar)[XB_TMO], 1u); break; } } } } while (0)
struct XcdBarrier { unsigned* bar; unsigned x; volatile LAS unsigned* st; };
__device__ __forceinline__ XcdBarrier xcd_barrier_post(unsigned* bar, volatile LAS unsigned* st) {
    XcdBarrier b; b.bar = bar; b.x = xb_xcc_id(); b.st = st;
    if (threadIdx.x == 0) (void)xb_add(&bar[XB_XCNT(b.x)], 1u);
    return b;
}
__device__ __forceinline__ void xcd_barrier_complete(unsigned* bar, unsigned x, unsigned& nloc, unsigned& nx) {
    const unsigned G = gridDim.x * gridDim.y * gridDim.z;
    unsigned sum, cnt, mine, sp = 0u;
    for (;;) {
        sum = 0u; cnt = 0u; mine = 0u;
#pragma unroll
        for (unsigned j = 0; j < 16; ++j) { const unsigned c = xb_ld(&bar[XB_XCNT(j)]); sum += c; cnt += (c > 0u) ? 1u : 0u; mine = (j == x) ? c : mine; }
        if (sum == G) break;
        __builtin_amdgcn_s_sleep(1);
        if ((++sp & 255u) == 0u) { if (xb_ld(&bar[XB_TMO])) break; if (sp > XB_SPIN_CAP) { atomicAdd(&bar[XB_TMO], 1u); break; } }
    }
    nloc = mine > 0u ? mine : 1u; nx = cnt > 0u ? cnt : 1u;
}
__device__ __forceinline__ void xcd_barrier(const XcdBarrier& b) {
    asm volatile("s_waitcnt vmcnt(0)" ::: "memory");
    __syncthreads();
    if (threadIdx.x == 0) {
        unsigned* bar = b.bar;
        __builtin_amdgcn_s_waitcnt(0);
#define XB_INV() asm volatile("buffer_inv sc1" ::: "memory")
        unsigned nloc = b.st[0], nx = b.st[1];
        if (nloc == 0u) { xcd_barrier_complete(bar, b.x, nloc, nx); b.st[0] = nloc; b.st[1] = nx; }
        const unsigned old = xb_add(&bar[XB_XSUB(b.x)], 1u);
        const unsigned gen = old / nloc;
        if (old + 1u == (gen + 1u) * nloc) {
            __builtin_amdgcn_fence(__ATOMIC_RELEASE, "agent");
            asm volatile("s_waitcnt vmcnt(0)" ::: "memory");
            const unsigned og = xb_add(&bar[XB_TOP], 1u);
            const unsigned tg = og / nx;
            const bool lastx = (og + 1u == (tg + 1u) * nx);
            XB_INV();
            if (lastx) xb_add(&bar[XB_TOPGEN], 1u);
            else XB_SPIN(xb_ld(&bar[XB_TOPGEN]) == tg, bar);
            xb_add(&bar[XB_XGEN(b.x)], 1u);
            asm volatile("s_waitcnt vmcnt(0)" ::: "memory");
        } else {
            XB_INV();
            XB_SPIN(xb_ld(&bar[XB_XGEN(b.x)]) == gen, bar);
            asm volatile("s_waitcnt vmcnt(0)" ::: "memory");
        }
    }
    __syncthreads();
#undef XB_INV
}

struct Args { const float* in[22]; float* out; unsigned char* ws; int ph_lo, ph_hi, pad0, pad1; };
struct Frame {
    LAS unsigned char* lds; volatile LAS unsigned* MISC; gu32* ctl;
    int tid, lane, wave, vcu, G;
};

typedef const __attribute__((address_space(4))) Args* kargs_t;
__device__ __forceinline__ Args fetch_args() {
    kargs_t kp = (kargs_t)__builtin_amdgcn_kernarg_segment_ptr();
    asm volatile("" : "+s"(kp));
    Args a;
#pragma unroll
    for (int i = 0; i < 22; ++i) a.in[i] = kp->in[i];
    a.out = kp->out; a.ws = kp->ws; a.ph_lo = kp->ph_lo; a.ph_hi = kp->ph_hi; a.pad0 = kp->pad0; a.pad1 = kp->pad1;
    return a;
}
__device__ __forceinline__ void refresh_frame(Frame& F) { int t = threadIdx.x; asm volatile("" : "+v"(t)); F.tid = t; F.lane = t & 63; F.wave = __builtin_amdgcn_readfirstlane(t >> 6); }

template <int CTRL> __device__ __forceinline__ float dppf(float v) { return __builtin_bit_cast(float, __builtin_amdgcn_update_dpp(0, __builtin_bit_cast(int, v), CTRL, 0xF, 0xF, true)); }
template <int CTRL> __device__ __forceinline__ int dppi(int v) { return __builtin_amdgcn_update_dpp(0, v, CTRL, 0xF, 0xF, true); }
__device__ __forceinline__ float rlf(float v, int l) { return __builtin_bit_cast(float, __builtin_amdgcn_readlane(__builtin_bit_cast(int, v), l)); }
__device__ __forceinline__ float wsum_dpp(float v) {
    v += dppf<0xB1>(v); v += dppf<0x4E>(v); v += dppf<0x141>(v); v += dppf<0x140>(v);
    return (rlf(v, 0) + rlf(v, 16)) + (rlf(v, 32) + rlf(v, 48));
}
__device__ __forceinline__ float wmax_dpp(float v) {
    v = fmaxf(v, dppf<0xB1>(v)); v = fmaxf(v, dppf<0x4E>(v)); v = fmaxf(v, dppf<0x141>(v)); v = fmaxf(v, dppf<0x140>(v));
    return fmaxf(fmaxf(rlf(v, 0), rlf(v, 16)), fmaxf(rlf(v, 32), rlf(v, 48)));
}
__device__ __forceinline__ int wmin_dpp(int v) {
    v = min(v, dppi<0xB1>(v)); v = min(v, dppi<0x4E>(v)); v = min(v, dppi<0x141>(v)); v = min(v, dppi<0x140>(v));
    return min(min(__builtin_amdgcn_readlane(v, 0), __builtin_amdgcn_readlane(v, 16)), min(__builtin_amdgcn_readlane(v, 32), __builtin_amdgcn_readlane(v, 48)));
}

__device__ __forceinline__ void p0_transpose_item(const float* W, int K, int N, bf16_t* WT, long row_off, LAS float* scr, int item, int lane) {
    const int nblk = N / 32, kb = item / nblk, nb = item % nblk, k0 = 64 * kb, n0 = 32 * nb;
    {
        const int kr = lane >> 3, n4 = (lane & 7) * 4; f32x4 t[8];
#pragma unroll
        for (int i = 0; i < 8; ++i) t[i] = __builtin_nontemporal_load((const f32x4*)(W + (size_t)(k0 + 8 * i + kr) * N + n0 + n4));
#pragma unroll
        for (int i = 0; i < 8; ++i) { LAS float* d = scr + (8 * i + kr) * 33 + n4; d[0] = t[i].x; d[1] = t[i].y; d[2] = t[i].z; d[3] = t[i].w; }
    }
    LDS_WAIT(); asm volatile("" ::: "memory");
    const int c = lane & 7;
#pragma unroll
    for (int j = 0; j < 4; ++j) { const int n = (lane >> 3) + 8 * j; const LAS float* s = scr + (8 * c) * 33 + n;
        v4u o; o.x = pk2(s[0 * 33], s[1 * 33]); o.y = pk2(s[2 * 33], s[3 * 33]); o.z = pk2(s[4 * 33], s[5 * 33]); o.w = pk2(s[6 * 33], s[7 * 33]);
        *(GAS v4u*)(WT + (size_t)(row_off + n0 + n) * K + k0 + 8 * c) = o; }
    LDS_WAIT(); asm volatile("" ::: "memory");
}
__device__ __forceinline__ void p0_transpose_item8(const float* W, int K, int N, unsigned char* WT, long row_off, LAS float* scr, int item, int lane) {
    const int nblk = N / 32, kb = item / nblk, nb = item % nblk, k0 = 64 * kb, n0 = 32 * nb;
    {
        const int kr = lane >> 3, n4 = (lane & 7) * 4; f32x4 t[8];
#pragma unroll
        for (int i = 0; i < 8; ++i) t[i] = __builtin_nontemporal_load((const f32x4*)(W + (size_t)(k0 + 8 * i + kr) * N + n0 + n4));
#pragma unroll
        for (int i = 0; i < 8; ++i) { LAS float* d = scr + (8 * i + kr) * 33 + n4; d[0] = t[i].x; d[1] = t[i].y; d[2] = t[i].z; d[3] = t[i].w; }
    }
    LDS_WAIT(); asm volatile("" ::: "memory");
    const int c = lane & 3; constexpr float SC = (float)(1 << pg8::WSHIFT);
#pragma unroll
    for (int j = 0; j < 2; ++j) { const int n = (lane >> 2) + 16 * j; const LAS float* s = scr + (16 * c) * 33 + n;
        v4u o; o.x = pg8::pk4_fp8(s[0 * 33] * SC, s[1 * 33] * SC, s[2 * 33] * SC, s[3 * 33] * SC); o.y = pg8::pk4_fp8(s[4 * 33] * SC, s[5 * 33] * SC, s[6 * 33] * SC, s[7 * 33] * SC);
        o.z = pg8::pk4_fp8(s[8 * 33] * SC, s[9 * 33] * SC, s[10 * 33] * SC, s[11 * 33] * SC); o.w = pg8::pk4_fp8(s[12 * 33] * SC, s[13 * 33] * SC, s[14 * 33] * SC, s[15 * 33] * SC);
        *(GAS v4u*)(WT + (size_t)(row_off + n0 + n) * K + k0 + 16 * c) = o; }
    LDS_WAIT(); asm volatile("" ::: "memory");
}
__device__ __forceinline__ void p0_prologue(Frame& F, const Args& a) {
    LAS float* scr = (LAS float*)(F.lds + RING_OFF + F.wave * 16384);
    const int gw = F.vcu * NWAVES + F.wave, NGW = F.G * NWAVES;
    unsigned char* ws = a.ws;
    constexpr int I_IN = (DM / 64) * (INW / 32), I_O = (DM / 64) * (DM / 32), I_UP1 = (DM / 64) * (2 * DFF / 32), I_DN1 = (DFF / 64) * (DM / 32);
    constexpr int NITEMS = I_IN + I_O + NE * I_UP1 + NE * I_DN1;
#if CONV_IN_ATTN
    constexpr int NITEMS_P0 = I_IN + I_O;
#else
    constexpr int NITEMS_P0 = NITEMS;
#endif
    for (int it = gw; it < NITEMS_P0; it += NGW) {
        int r = it;
        if (r < I_IN) { p0_transpose_item(a.in[1], DM, INW, (bf16_t*)(ws + WS_WIN), 0, scr, r, F.lane); continue; } r -= I_IN;
#if OUTPROJ_FP8
        if (r < I_O) { p0_transpose_item8(a.in[11], DM, DM, (unsigned char*)(ws + WS_WO), 0, scr, r, F.lane); continue; } r -= I_O;
#else
        if (r < I_O) { p0_transpose_item(a.in[11], DM, DM, (bf16_t*)(ws + WS_WO), 0, scr, r, F.lane); continue; } r -= I_O;
#endif
        if (r < NE * I_UP1) { const int e = r / I_UP1, ii = r % I_UP1; const int n0 = 32 * (ii % (2 * DFF / 32));
            const int bj = n0 / DFF, f = n0 % DFF, rho0 = 256 * (f / 128) + 128 * bj + (f % 128);
#if MOE_FP8
            p0_transpose_item8(a.in[16] + (size_t)e * DM * 2 * DFF, DM, 2 * DFF, (unsigned char*)(ws + WS_WUP) + (size_t)e * 2 * DFF * DM, (long)rho0 - n0, scr, ii, F.lane); continue; }
#else
            p0_transpose_item(a.in[16] + (size_t)e * DM * 2 * DFF, DM, 2 * DFF, (bf16_t*)(ws + WS_WUP) + (size_t)e * 2 * DFF * DM, (long)rho0 - n0, scr, ii, F.lane); continue; }
#endif
        r -= NE * I_UP1;
        { const int e = r / I_DN1, ii = r % I_DN1;
#if MOE_FP8
            p0_transpose_item8(a.in[18] + (size_t)e * DFF * DM, DFF, DM, (unsigned char*)(ws + WS_WDN) + (size_t)e * DM * DFF, 0, scr, ii, F.lane); }
#else
            p0_transpose_item(a.in[18] + (size_t)e * DFF * DM, DFF, DM, (bf16_t*)(ws + WS_WDN) + (size_t)e * DM * DFF, 0, scr, ii, F.lane); }
#endif
    }
    const float* x = a.in[0]; bf16_t* xb = (bf16_t*)(ws + WS_XB);
    for (int m = gw; m < NTOK; m += NGW) {
        const GAS f32x4* xr = (const GAS f32x4*)(x + (size_t)m * DM) + F.lane; GAS v2u* o8 = (GAS v2u*)(xb + (size_t)m * DM) + F.lane;
        f32x4 v[4];
#pragma unroll
        for (int j = 0; j < 4; ++j) v[j] = __builtin_nontemporal_load((const f32x4*)(xr + 64 * j));
#pragma unroll
        for (int j = 0; j < 4; ++j) { v2u o; o.x = pk2(v[j].x, v[j].y); o.y = pk2(v[j].z, v[j].w); o8[64 * j] = o; }
    }
}

struct CItem { const float* W; unsigned char* WT; int N, k0, n0, rowbase; };
__device__ __forceinline__ CItem conv_decode(int r, const Args& a) {
    constexpr int I_UP1 = (DM / 64) * (2 * DFF / 32), I_DN1 = (DFF / 64) * (DM / 32);
    CItem it;
    if (r < NE * I_UP1) { const int e = r / I_UP1, ii = r % I_UP1, nblk = 2 * DFF / 32; it.k0 = 64 * (ii / nblk); it.n0 = 32 * (ii % nblk);
        const int bj = it.n0 / DFF, f = it.n0 % DFF; it.rowbase = 256 * (f / 128) + 128 * bj + (f % 128);
        it.W = a.in[16] + (size_t)e * DM * 2 * DFF; it.WT = a.ws + WS_WUP + (size_t)e * 2 * DFF * DM; it.N = 2 * DFF; return it; }
    r -= NE * I_UP1;
    { const int e = r / I_DN1, ii = r % I_DN1, nblk = DM / 32; it.k0 = 64 * (ii / nblk); it.n0 = 32 * (ii % nblk); it.rowbase = it.n0;
        it.W = a.in[18] + (size_t)e * DFF * DM; it.WT = a.ws + WS_WDN + (size_t)e * DM * DFF; it.N = DM; return it; }
}
__device__ __forceinline__ void conv_load(const CItem& it, int lane, f32x4 (&t)[8]) {
    const int kr = lane >> 3, n4 = (lane & 7) * 4;
#pragma unroll
    for (int i = 0; i < 8; ++i) t[i] = __builtin_nontemporal_load((const f32x4*)(it.W + (size_t)(it.k0 + 8 * i + kr) * it.N + it.n0 + n4));
}
__device__ __forceinline__ void conv_finish(const CItem& it, int lane, const f32x4 (&t)[8], LAS float* scr, v4u (&outv)[2]) {
    const int kr = lane >> 3, n4 = (lane & 7) * 4;
#pragma unroll
    for (int i = 0; i < 8; ++i) { LAS float* d = scr + (8 * i + kr) * 33 + n4; d[0] = t[i].x; d[1] = t[i].y; d[2] = t[i].z; d[3] = t[i].w; }
    LDS_WAIT(); asm volatile("" ::: "memory");
    const int c = lane & 3; constexpr float SC = (float)(1 << pg8::WSHIFT);
#pragma unroll
    for (int j = 0; j < 2; ++j) { const int n = (lane >> 2) + 16 * j; const LAS float* sp = scr + (16 * c) * 33 + n;
        v4u o; o.x = pg8::pk4_fp8(sp[0 * 33] * SC, sp[1 * 33] * SC, sp[2 * 33] * SC, sp[3 * 33] * SC); o.y = pg8::pk4_fp8(sp[4 * 33] * SC, sp[5 * 33] * SC, sp[6 * 33] * SC, sp[7 * 33] * SC);
        o.z = pg8::pk4_fp8(sp[8 * 33] * SC, sp[9 * 33] * SC, sp[10 * 33] * SC, sp[11 * 33] * SC); o.w = pg8::pk4_fp8(sp[12 * 33] * SC, sp[13 * 33] * SC, sp[14 * 33] * SC, sp[15 * 33] * SC);
        outv[j] = o; }
    LDS_WAIT(); asm volatile("" ::: "memory");
}
__device__ __forceinline__ void conv_store(const CItem& it, int lane, const v4u (&outv)[2]) {
    const int c = lane & 3;
#pragma unroll
    for (int j = 0; j < 2; ++j) { const int n = (lane >> 2) + 16 * j; __builtin_nontemporal_store(outv[j], (v4u*)(it.WT + (size_t)(it.rowbase + n) * DM + it.k0 + 16 * c)); }
}
__device__ __forceinline__ void moe_weight_items(Frame& F, const Args& a, int first) {
    LAS float* scr = (LAS float*)(F.lds + RING_OFF + F.wave * 8448);
    const int gw = F.vcu * NWAVES + F.wave, NGW = F.G * NWAVES, lane = F.lane;
    const CItem i0 = conv_decode(gw + (first + 0) * NGW, a), i1 = conv_decode(gw + (first + 1) * NGW, a), i2 = conv_decode(gw + (first + 2) * NGW, a), i3 = conv_decode(gw + (first + 3) * NGW, a);
    const CItem i4 = conv_decode(gw + (first + 4) * NGW, a), i5 = conv_decode(gw + (first + 5) * NGW, a), i6 = conv_decode(gw + (first + 6) * NGW, a), i7 = conv_decode(gw + (first + 7) * NGW, a);
    f32x4 t0[8], t1[8], t2[8], t3[8], t4[8], t5[8];
    conv_load(i0, lane, t0); conv_load(i1, lane, t1); conv_load(i2, lane, t2); conv_load(i3, lane, t3); conv_load(i4, lane, t4); conv_load(i5, lane, t5);
    v4u o0[2], o1[2], o2[2], o3[2], o4[2], o5[2], o6[2], o7[2];
    conv_finish(i0, lane, t0, scr, o0); conv_load(i6, lane, t0);
    conv_finish(i1, lane, t1, scr, o1); conv_load(i7, lane, t1);
    conv_finish(i2, lane, t2, scr, o2); conv_finish(i3, lane, t3, scr, o3); conv_finish(i4, lane, t4, scr, o4); conv_finish(i5, lane, t5, scr, o5);
    conv_finish(i6, lane, t0, scr, o6); conv_finish(i7, lane, t1, scr, o7);
    conv_store(i0, lane, o0); conv_store(i1, lane, o1); conv_store(i2, lane, o2); conv_store(i3, lane, o3); conv_store(i4, lane, o4); conv_store(i5, lane, o5); conv_store(i6, lane, o6); conv_store(i7, lane, o7);
}

__device__ __forceinline__ void gmlp_phase(Frame& F, const Args& a) {
    const bf16_t* proj = (const bf16_t*)(a.ws + WS_PROJ); bf16_t* mix = (bf16_t*)(a.ws + WS_MIX);
    const float *lng = a.in[7], *lnb = a.in[8], *wsp = a.in[9], *bsp = a.in[10];
    LAS f32x2* st = (LAS f32x2*)(F.lds + RING_OFF);
    LAS bf16_t* Vg = (LAS bf16_t*)(F.lds + RING_OFF + 1024);
    LAS bf16_t* Wg = (LAS bf16_t*)(F.lds + RING_OFF + 19456);
    LAS float* Zg = (LAS float*)(F.lds + RING_OFF + 54272);
    const int tid = F.tid, lane = F.lane, w = F.wave;
    const int row = tid >> 2, cq = (tid & 3) * 16;
    for (int c = blockIdx.x; c < NTOK / CHUNK; c += F.G) {
        const size_t row0 = (size_t)c * CHUNK;
        v4u pgv[2], pgu[2]; f32x4 pwv[8], plg[4], plb[4]; float pbb;
#define GMLP_LOAD(g_) do { const int col_ = (g_) * GD + cq; \
            pgv[0] = *(const GAS v4u*)(proj + (row0 + row) * INW + C_GV + col_); pgv[1] = *(const GAS v4u*)(proj + (row0 + row) * INW + C_GV + col_ + 8); \
            pgu[0] = *(const GAS v4u*)(proj + (row0 + row) * INW + C_GU + col_); pgu[1] = *(const GAS v4u*)(proj + (row0 + row) * INW + C_GU + col_ + 8); \
            _Pragma("unroll") for (int k = 0; k < 8; ++k) { const int i_ = tid + 512 * k; pwv[k] = *(const GAS f32x4*)(wsp + ((size_t)(g_) * CHUNK + (i_ >> 5)) * CHUNK + (i_ & 31) * 4); } \
            _Pragma("unroll") for (int k = 0; k < 4; ++k) { plg[k] = *(const GAS f32x4*)(lng + col_ + 4 * k); plb[k] = *(const GAS f32x4*)(lnb + col_ + 4 * k); } \
            pbb = bsp[(g_) * CHUNK + row]; } while (0)
        GMLP_LOAD(0);
        {
            v4u raw[16];
#pragma unroll
            for (int i = 0; i < 16; ++i) raw[i] = *(const GAS v4u*)(proj + (row0 + 16 * w + i) * INW + C_GV + lane * 8);
#pragma unroll
            for (int i = 0; i < 16; ++i) {
                const unsigned rw[4] = {raw[i].x, raw[i].y, raw[i].z, raw[i].w}; float v[8]; float sum = 0.f;
#pragma unroll
                for (int k = 0; k < 4; ++k) { const f32x2 gg = (f32x2){bf2f((bf16_t)(rw[k] & 0xffff)), bf2f((bf16_t)(rw[k] >> 16))}; v[2 * k] = gg.x; v[2 * k + 1] = gg.y; sum += gg.x + gg.y; }
                const float mean = wsum_dpp(sum) * (1.0f / GW); float q = 0.f;
#pragma unroll
                for (int k = 0; k < 8; ++k) { const float d = v[k] - mean; q += d * d; }
                const float var = wsum_dpp(q) * (1.0f / GW);
                if (lane == 0) st[16 * w + i] = (f32x2){mean, rsqrtf(var + LN_EPS)};
            }
        }
        __syncthreads();
        for (int g = 0; g < NG; ++g) {
            const int col = g * GD + cq;
            const v4u cgu0 = pgu[0], cgu1 = pgu[1]; const float bb = pbb;
            {
                const f32x2 ms = st[row]; unsigned ow[8];
#pragma unroll
                for (int hh = 0; hh < 2; ++hh) { const unsigned rw[4] = {pgv[hh].x, pgv[hh].y, pgv[hh].z, pgv[hh].w};
#pragma unroll
                    for (int i = 0; i < 4; ++i) { const f32x2 gg = (f32x2){bf2f((bf16_t)(rw[i] & 0xffff)), bf2f((bf16_t)(rw[i] >> 16))};
                        const int e = hh * 8 + 2 * i; const f32x4 lg = plg[e >> 2], lb = plb[e >> 2];
                        const float g0 = (e & 2) ? lg.z : lg.x, g1 = (e & 2) ? lg.w : lg.y, b0 = (e & 2) ? lb.z : lb.x, b1 = (e & 2) ? lb.w : lb.y;
                        ow[hh * 4 + i] = pk2((gg.x - ms.x) * ms.y * g0 + b0, (gg.y - ms.x) * ms.y * g1 + b1); } }
                { const int sx = row ^ ((cq >> 4) << 4);
#pragma unroll
                  for (int e = 0; e < 8; ++e) { Vg[(cq + 2 * e) * 136 + sx] = (bf16_t)(ow[e] & 0xffffu); Vg[(cq + 2 * e + 1) * 136 + sx] = (bf16_t)(ow[e] >> 16); } }
#pragma unroll
                for (int k = 0; k < 8; ++k) { const int i = tid + 512 * k, t = i >> 5, s4 = (i & 31) * 4; const f32x4 wv = pwv[k];
                    v2u o; o.x = pk2(s4 <= t ? wv.x : 0.f, s4 + 1 <= t ? wv.y : 0.f); o.y = pk2(s4 + 2 <= t ? wv.z : 0.f, s4 + 3 <= t ? wv.w : 0.f);
                    *(LAS v2u*)(Wg + t * 136 + s4) = o; }
            }
            if (g + 1 < NG) GMLP_LOAD(g + 1);
            __syncthreads();
            {
                f32x4 acc[4];
#pragma unroll
                for (int n = 0; n < 4; ++n) acc[n] = (f32x4){0.f, 0.f, 0.f, 0.f};
                const int t0 = 16 * w, fr = lane & 15, fq = lane >> 4;
                for (int ks = 0; ks * 32 <= t0 + 15; ++ks) {
                    const bf16x8 af = *(const LAS bf16x8*)(Wg + (t0 + fr) * 136 + ks * 32 + fq * 8);
#pragma unroll
                    for (int n = 0; n < 4; ++n) { const bf16x8 bfv = *(const LAS bf16x8*)(Vg + (n * 16 + fr) * 136 + ((ks * 32 + fq * 8) ^ (n << 4)));
                        acc[n] = __builtin_amdgcn_mfma_f32_16x16x32_bf16(af, bfv, acc[n], 0, 0, 0); }
                }
#pragma unroll
                for (int n = 0; n < 4; ++n)
#pragma unroll
                    for (int r = 0; r < 4; ++r) Zg[(t0 + fq * 4 + r) * 68 + n * 16 + fr] = acc[n][r];
            }
            __syncthreads();
            {
#if OUTPROJ_FP8
                float ov_[16];
#pragma unroll
                for (int hh = 0; hh < 2; ++hh) { const v4u rawu = hh ? cgu1 : cgu0; const unsigned rw[4] = {rawu.x, rawu.y, rawu.z, rawu.w};
#pragma unroll
                    for (int i = 0; i < 4; ++i) { const f32x2 uu = (f32x2){bf2f((bf16_t)(rw[i] & 0xffff)), bf2f((bf16_t)(rw[i] >> 16))};
                        const f32x2 zz = *(const LAS f32x2*)(Zg + row * 68 + cq + hh * 8 + 2 * i);
                        ov_[hh * 8 + 2 * i] = uu.x * (zz.x + bb); ov_[hh * 8 + 2 * i + 1] = uu.y * (zz.y + bb); } }
                *(GAS v4u*)((unsigned char*)mix + (size_t)(row0 + row) * DM + GW + col) = (v4u){pg8::pk4_fp8(ov_[0], ov_[1], ov_[2], ov_[3]), pg8::pk4_fp8(ov_[4], ov_[5], ov_[6], ov_[7]),
                                                                                              pg8::pk4_fp8(ov_[8], ov_[9], ov_[10], ov_[11]), pg8::pk4_fp8(ov_[12], ov_[13], ov_[14], ov_[15])};
#else
                unsigned ow[8];
#pragma unroll
                for (int hh = 0; hh < 2; ++hh) { const v4u rawu = hh ? cgu1 : cgu0; const unsigned rw[4] = {rawu.x, rawu.y, rawu.z, rawu.w};
#pragma unroll
                    for (int i = 0; i < 4; ++i) { const f32x2 uu = (f32x2){bf2f((bf16_t)(rw[i] & 0xffff)), bf2f((bf16_t)(rw[i] >> 16))};
                        const f32x2 zz = *(const LAS f32x2*)(Zg + row * 68 + cq + hh * 8 + 2 * i);
                        ow[hh * 4 + i] = pk2(uu.x * (zz.x + bb), uu.y * (zz.y + bb)); } }
                GAS v4u* dst = (GAS v4u*)(mix + (row0 + row) * DM + GW + col);
                dst[0] = (v4u){ow[0], ow[1], ow[2], ow[3]}; dst[1] = (v4u){ow[4], ow[5], ow[6], ow[7]};
#endif
            }
        }
        __syncthreads();
#undef GMLP_LOAD
    }
}

__device__ __forceinline__ void attn_combine_phase(Frame& F, const Args& a) {
    const bf16_t* atto = (const bf16_t*)(a.ws + WS_ATTO); bf16_t* mix = (bf16_t*)(a.ws + WS_MIX);
    const int lane = F.lane, gw = F.vcu * NWAVES + F.wave, NGW = F.G * NWAVES;
    const float lam = expf(wave_sum(a.in[2][lane] * a.in[3][lane])) - expf(wave_sum(a.in[4][lane] * a.in[5][lane])) + LAMBDA_INIT;
    const int h = lane >> 4, e0 = (lane & 15) * 8;
    float sg[8];
#pragma unroll
    for (int i = 0; i < 8; ++i) sg[i] = a.in[6][e0 + i] * (1.0f - LAMBDA_INIT);
    for (int t = gw; t < NTOK; t += NGW) {
        const v4u r1 = *(const GAS v4u*)(atto + (size_t)t * DM + h * 256 + e0), r2 = *(const GAS v4u*)(atto + (size_t)t * DM + h * 256 + 128 + e0);
        const unsigned w1[4] = {r1.x, r1.y, r1.z, r1.w}, w2[4] = {r2.x, r2.y, r2.z, r2.w};
        float d[8]; float ss = 0.f;
#pragma unroll
        for (int i = 0; i < 4; ++i) { d[2 * i] = bf2f((bf16_t)(w1[i] & 0xffff)) - lam * bf2f((bf16_t)(w2[i] & 0xffff)); d[2 * i + 1] = bf2f((bf16_t)(w1[i] >> 16)) - lam * bf2f((bf16_t)(w2[i] >> 16)); ss += d[2 * i] * d[2 * i] + d[2 * i + 1] * d[2 * i + 1]; }
        ss += __shfl_xor(ss, 1); ss += __shfl_xor(ss, 2); ss += __shfl_xor(ss, 4); ss += __shfl_xor(ss, 8);
        const float r = rsqrtf(ss * (1.0f / DV) + LN_EPS);
        v4u o; o.x = pk2(d[0] * r * sg[0], d[1] * r * sg[1]); o.y = pk2(d[2] * r * sg[2], d[3] * r * sg[3]); o.z = pk2(d[4] * r * sg[4], d[5] * r * sg[5]); o.w = pk2(d[6] * r * sg[6], d[7] * r * sg[7]);
        *(GAS v4u*)(mix + (size_t)t * DM + h * DV + e0) = o;
    }
}

__device__ __forceinline__ void route_phase(Frame& F, const Args& a) {
    const bf16_t* h1 = (const bf16_t*)(a.ws + WS_H1); bf16_t* xb = (bf16_t*)(a.ws + WS_XB); bf16_t* x1b = (bf16_t*)(a.ws + WS_X1B);
    int* list = (int*)(a.ws + WS_LIST); int* re = (int*)(a.ws + WS_RE); int* rr = (int*)(a.ws + WS_RR); float* rg = (float*)(a.ws + WS_RG);
    const float *g1 = a.in[12], *b1 = a.in[13], *wr = a.in[14], *br = a.in[15];
    constexpr int XS = 1028;
    LAS float* XT = (LAS float*)(F.lds + RING_OFF);
    LAS float* PT = (LAS float*)(F.lds + RING_OFF + 16 * XS * 4);
    LAS float* LT = (LAS float*)(F.lds + RING_OFF + 16 * XS * 4 + 8 * 16 * 32 * 4);
    LAS int* lcnt = (LAS int*)(F.lds + REC_OFF); LAS int* lbase = lcnt + 32; LAS int* rec = lcnt + 64;
    const int tid = F.tid, lane = F.lane, w = F.wave, fr = lane & 15, fq = lane >> 4;
    if (tid < 32) lcnt[tid] = 0;
    constexpr int RPB = NTOK / 256;
    const int tblk = blockIdx.x * RPB;
    v2u praw[2][4];
#define ROUTE_LOAD(ch_) do { _Pragma("unroll") for (int q = 0; q < 2; ++q) _Pragma("unroll") for (int j = 0; j < 4; ++j) \
        praw[q][j] = *(const GAS v2u*)(h1 + (size_t)(tblk + (ch_) * 16 + 2 * w + q) * DM + j * 256 + lane * 4); } while (0)
    ROUTE_LOAD(0);
    bf16x8 bwh[4][2], bwl[4][2];
#pragma unroll
    for (int ks = 0; ks < 4; ++ks)
#pragma unroll
        for (int n = 0; n < 2; ++n) { float wv[8];
#pragma unroll
            for (int j = 0; j < 8; ++j) wv[j] = wr[(size_t)(128 * w + 32 * ks + 8 * fq + j) * NE + 16 * n + fr];
            unsigned hh[4], ll[4];
#pragma unroll
            for (int j = 0; j < 4; ++j) { hh[j] = pk2(wv[2 * j], wv[2 * j + 1]);
                ll[j] = pk2(wv[2 * j] - __uint_as_float(hh[j] << 16), wv[2 * j + 1] - __uint_as_float(hh[j] & 0xffff0000u)); }
            bwh[ks][n] = __builtin_bit_cast(bf16x8, (v4u){hh[0], hh[1], hh[2], hh[3]}); bwl[ks][n] = __builtin_bit_cast(bf16x8, (v4u){ll[0], ll[1], ll[2], ll[3]}); }
    const int myexp = lane & 31; const float mybr = br[myexp];
    f32x4 g1v[4], b1v[4];
#pragma unroll
    for (int j = 0; j < 4; ++j) { g1v[j] = *(const GAS f32x4*)(g1 + j * 256 + lane * 4); b1v[j] = *(const GAS f32x4*)(b1 + j * 256 + lane * 4); }
    for (int ch = 0; ch < 8; ++ch) {
        const int t0 = tblk + ch * 16;
        {
            f32x4 pv[2][4];
#pragma unroll
            for (int q = 0; q < 2; ++q)
#pragma unroll
                for (int j = 0; j < 4; ++j) { const v2u hw_ = praw[q][j]; pv[q][j] = (f32x4){__uint_as_float(hw_.x << 16), __uint_as_float(hw_.x & 0xffff0000u), __uint_as_float(hw_.y << 16), __uint_as_float(hw_.y & 0xffff0000u)}; }
            float mean[2], rstd[2];
#pragma unroll
            for (int q = 0; q < 2; ++q) { float s = 0.f;
#pragma unroll
                for (int j = 0; j < 4; ++j) s += (pv[q][j].x + pv[q][j].y) + (pv[q][j].z + pv[q][j].w);
                mean[q] = wsum_dpp(s) * (1.0f / DM); }
#pragma unroll
            for (int q = 0; q < 2; ++q) { float q2 = 0.f;
#pragma unroll
                for (int j = 0; j < 4; ++j) { pv[q][j] = pv[q][j] - mean[q]; q2 += (pv[q][j].x * pv[q][j].x + pv[q][j].y * pv[q][j].y) + (pv[q][j].z * pv[q][j].z + pv[q][j].w * pv[q][j].w); }
                rstd[q] = rsqrtf(wsum_dpp(q2) * (1.0f / DM) + LN_EPS); }
#pragma unroll
            for (int j = 0; j < 4; ++j) {
                const int col = j * 256 + lane * 4;
                const f32x4 gq = g1v[j], bq = b1v[j];
#pragma unroll
                for (int q = 0; q < 2; ++q) {
                    const int rl = 2 * w + q, t = t0 + rl;
                    const f32x4 o = pv[q][j] * rstd[q] * gq + bq;
                    { v2u pk1; pk1.x = pk2(o.x, o.y); pk1.y = pk2(o.z, o.w); *(GAS v2u*)(x1b + (size_t)t * DM + col) = pk1; }
                    *(LAS f32x4*)(XT + rl * XS + col) = o;
#if MOE_FP8
                    *(GAS unsigned*)((unsigned char*)xb + (size_t)t * DM + col) = pg8::pk4_fp8(o.x, o.y, o.z, o.w);
#else
                    v2u pk; pk.x = pk2(o.x, o.y); pk.y = pk2(o.z, o.w);
                    *(GAS v2u*)(xb + (size_t)t * DM + col) = pk;
#endif
                }
            }
        }
        if (ch < 7) ROUTE_LOAD(ch + 1);
        __syncthreads();
        {
            f32x4 acc0 = (f32x4){0.f, 0.f, 0.f, 0.f}, acc1 = (f32x4){0.f, 0.f, 0.f, 0.f};
            const LAS float* xp = XT + fr * XS + 128 * w + 8 * fq;
#pragma unroll
            for (int ks = 0; ks < 4; ++ks) { const f32x4 x0 = *(const LAS f32x4*)(xp + 32 * ks), x1 = *(const LAS f32x4*)(xp + 32 * ks + 4);
                unsigned hh[4], ll[4];
                hh[0] = pk2(x0.x, x0.y); hh[1] = pk2(x0.z, x0.w); hh[2] = pk2(x1.x, x1.y); hh[3] = pk2(x1.z, x1.w);
                ll[0] = pk2(x0.x - __uint_as_float(hh[0] << 16), x0.y - __uint_as_float(hh[0] & 0xffff0000u)); ll[1] = pk2(x0.z - __uint_as_float(hh[1] << 16), x0.w - __uint_as_float(hh[1] & 0xffff0000u));
                ll[2] = pk2(x1.x - __uint_as_float(hh[2] << 16), x1.y - __uint_as_float(hh[2] & 0xffff0000u)); ll[3] = pk2(x1.z - __uint_as_float(hh[3] << 16), x1.w - __uint_as_float(hh[3] & 0xffff0000u));
                const bf16x8 ah = __builtin_bit_cast(bf16x8, (v4u){hh[0], hh[1], hh[2], hh[3]}), al = __builtin_bit_cast(bf16x8, (v4u){ll[0], ll[1], ll[2], ll[3]});
                acc0 = __builtin_amdgcn_mfma_f32_16x16x32_bf16(ah, bwh[ks][0], acc0, 0, 0, 0); acc1 = __builtin_amdgcn_mfma_f32_16x16x32_bf16(ah, bwh[ks][1], acc1, 0, 0, 0);
                acc0 = __builtin_amdgcn_mfma_f32_16x16x32_bf16(ah, bwl[ks][0], acc0, 0, 0, 0); acc1 = __builtin_amdgcn_mfma_f32_16x16x32_bf16(ah, bwl[ks][1], acc1, 0, 0, 0);
                acc0 = __builtin_amdgcn_mfma_f32_16x16x32_bf16(al, bwh[ks][0], acc0, 0, 0, 0); acc1 = __builtin_amdgcn_mfma_f32_16x16x32_bf16(al, bwh[ks][1], acc1, 0, 0, 0); }
#pragma unroll
            for (int r = 0; r < 4; ++r) { PT[(w * 16 + fq * 4 + r) * 32 + fr] = acc0[r]; PT[(w * 16 + fq * 4 + r) * 32 + 16 + fr] = acc1[r]; }
        }
        __syncthreads();
        {
            float cur[2];
#pragma unroll
            for (int q = 0; q < 2; ++q) { cur[q] = mybr;
#pragma unroll
                for (int ww = 0; ww < 8; ++ww) cur[q] += PT[(ww * 16 + 2 * w + q) * 32 + myexp]; }
            if (lane < 32) {
#pragma unroll
                for (int q = 0; q < 2; ++q) LT[(ch * 16 + 2 * w + q) * 33 + myexp] = cur[q]; }
        }
    }
#undef ROUTE_LOAD
    __syncthreads();
    if (lane < 16) {
        const int rl = 16 * w + lane, t = tblk + rl; const LAS float* lr_ = LT + rl * 33;
        float lv[32];
#pragma unroll
        for (int e = 0; e < 32; ++e) lv[e] = lr_[e];
        int idx[4]; float val[4];
#pragma unroll
        for (int k = 0; k < 4; ++k) { float m = lv[0]; int bi = 0;
#pragma unroll
            for (int e = 1; e < 32; ++e) { const bool gt = lv[e] > m; m = gt ? lv[e] : m; bi = gt ? e : bi; }
            idx[k] = bi; val[k] = m;
#pragma unroll
            for (int e = 0; e < 32; ++e) lv[e] = (e == bi) ? -INFINITY : lv[e]; }
        float ex[4], se = 0.f;
#pragma unroll
        for (int k = 0; k < 4; ++k) { ex[k] = expf(val[k] - val[0]); se += ex[k]; }
#pragma unroll
        for (int k = 0; k < 4; ++k) {
            const int lrk = __hip_atomic_fetch_add(lcnt + idx[k], 1, __ATOMIC_RELAXED, __HIP_MEMORY_SCOPE_WORKGROUP);
            rec[rl * 4 + k] = idx[k] | (lrk << 8);
            re[t * 4 + k] = idx[k]; rg[t * 4 + k] = ex[k] / se; }
    }
    __syncthreads();
    if (tid < 32) lbase[tid] = (int)__hip_atomic_fetch_add((unsigned*)(F.ctl + CW_CNT + tid), (unsigned)lcnt[tid], RLX_AGENT);
    __syncthreads();
    { const int rw = tid >> 2, k = tid & 3; const int t = tblk + rw; const int rc = rec[tid]; const int e_ = rc & 255, r_ = lbase[e_] + (rc >> 8);
      rr[t * 4 + k] = r_; list[e_ * NTOK + r_] = t; }
}
__device__ __forceinline__ void build_tab(Frame& F) {
    LAS int* tab = (LAS int*)(F.lds + TAB_OFF);
    if (F.tid < 32) tab[40 + F.tid] = (int)__hip_atomic_load(F.ctl + CW_CNT + F.tid, RLX_AGENT);
    __syncthreads();
    if (F.tid == 0) { int p = 0; for (int e = 0; e < NE; ++e) { tab[e] = p; p += (tab[40 + e] + 255) >> 8; } tab[NE] = p; }
    __syncthreads();
}
__device__ __forceinline__ void combine_phase(Frame& F, const Args& a) {
    const bf16_t* x1 = (const bf16_t*)(a.ws + WS_X1B); const unsigned char* y = (const unsigned char*)(a.ws + WS_Y);
    const int* re = (const int*)(a.ws + WS_RE); const int* rr = (const int*)(a.ws + WS_RR); const float* rg = (const float*)(a.ws + WS_RG);
    float* out = a.out;
    const LAS int* tab = (const LAS int*)(F.lds + TAB_OFF);
    const int lane = F.lane, gw = F.vcu * NWAVES + F.wave, NGW = F.G * NWAVES, c0 = lane * 16;
    f32x4 g2v[4], b2v[4];
#pragma unroll
    for (int j = 0; j < 4; ++j) { g2v[j] = *(const GAS f32x4*)(a.in[20] + c0 + 4 * j); b2v[j] = *(const GAS f32x4*)(a.in[21] + c0 + 4 * j); }
    for (int tt = gw; tt < NTOK; tt += 2 * NGW) {
        float v[2][16];
#pragma unroll
        for (int q = 0; q < 2; ++q) {
            const int t = tt + q * NGW;
            const v4u xa = *(const GAS v4u*)(x1 + (size_t)t * DM + c0), xb_ = *(const GAS v4u*)(x1 + (size_t)t * DM + c0 + 8);
            const unsigned xw[8] = {xa.x, xa.y, xa.z, xa.w, xb_.x, xb_.y, xb_.z, xb_.w};
#pragma unroll
            for (int i = 0; i < 8; ++i) { v[q][2 * i] = ALPHA * bf2f((bf16_t)(xw[i] & 0xffff)); v[q][2 * i + 1] = ALPHA * bf2f((bf16_t)(xw[i] >> 16)); }
#pragma unroll
            for (int k = 0; k < 4; ++k) {
                const int e = re[t * 4 + k], slot = tab[e] * 256 + rr[t * 4 + k]; const float g = rg[t * 4 + k];
#if MOE_FP8
                const v4u yw = *(const GAS v4u*)(y + (size_t)slot * DM + c0); const unsigned yy[4] = {yw.x, yw.y, yw.z, yw.w};
#pragma unroll
                for (int i = 0; i < 4; ++i) { const f32x2 lo = __builtin_amdgcn_cvt_pk_f32_fp8((int)yy[i], false), hi = __builtin_amdgcn_cvt_pk_f32_fp8((int)yy[i], true);
                    v[q][4 * i] = fmaf(g, lo.x, v[q][4 * i]); v[q][4 * i + 1] = fmaf(g, lo.y, v[q][4 * i + 1]); v[q][4 * i + 2] = fmaf(g, hi.x, v[q][4 * i + 2]); v[q][4 * i + 3] = fmaf(g, hi.y, v[q][4 * i + 3]); }
#else
                const v4u ya = *(const GAS v4u*)((const bf16_t*)y + (size_t)slot * DM + c0), yb = *(const GAS v4u*)((const bf16_t*)y + (size_t)slot * DM + c0 + 8);
                const unsigned yy[8] = {ya.x, ya.y, ya.z, ya.w, yb.x, yb.y, yb.z, yb.w};
#pragma unroll
                for (int i = 0; i < 8; ++i) { v[q][2 * i] = fmaf(g, bf2f((bf16_t)(yy[i] & 0xffff)), v[q][2 * i]); v[q][2 * i + 1] = fmaf(g, bf2f((bf16_t)(yy[i] >> 16)), v[q][2 * i + 1]); }
#endif
            }
        }
#pragma unroll
        for (int q = 0; q < 2; ++q) {
            const int t = tt + q * NGW;
            float s = 0.f;
#pragma unroll
            for (int i = 0; i < 16; ++i) s += v[q][i];
            const float mean = wsum_dpp(s) * (1.0f / DM); float q2 = 0.f;
#pragma unroll
            for (int i = 0; i < 16; ++i) { v[q][i] -= mean; q2 += v[q][i] * v[q][i]; }
            const float rstd = rsqrtf(wsum_dpp(q2) * (1.0f / DM) + LN_EPS);
#pragma unroll
            for (int j = 0; j < 4; ++j)
                *(GAS f32x4*)(out + (size_t)t * DM + c0 + 4 * j) = (f32x4){v[q][4 * j] * rstd * g2v[j].x + b2v[j].x, v[q][4 * j + 1] * rstd * g2v[j].y + b2v[j].y, v[q][4 * j + 2] * rstd * g2v[j].z + b2v[j].z, v[q][4 * j + 3] * rstd * g2v[j].w + b2v[j].w};
        }
    }
}

#ifndef ALIGN_H1
#define ALIGN_H1 true
#endif
#ifndef ALIGN_UP
#define ALIGN_UP true
#endif
#ifndef META_UP
#define META_UP false
#endif
#ifndef META_DN
#define META_DN false
#endif
constexpr int N_PHASES = 9;
__global__ void __launch_bounds__(NWAVES * 64, 2) mega_fwd(Args args) {
    extern __shared__ __attribute__((aligned(16))) unsigned char lds[];
    Frame F;
    F.lds = (LAS unsigned char*)lds;
    F.MISC = (volatile LAS unsigned*)(F.lds + MISC_OFF);
    F.tid = threadIdx.x; F.lane = F.tid & 63; F.wave = __builtin_amdgcn_readfirstlane(F.tid >> 6);
    F.G = gridDim.x; { const int bx = blockIdx.x; F.vcu = (F.G % 8 == 0) ? (bx % 8) * (F.G / 8) + bx / 8 : bx; }
    F.ctl = (gu32*)(args.ws + WS_CTL);
    for (int u = F.tid; u < (LDS_BYTES - LDSCTL_OFF) / 4; u += NWAVES * 64) ((LAS unsigned*)(F.lds + LDSCTL_OFF))[u] = 0u;
    __syncthreads();
    const int lo = args.ph_lo, hi = args.ph_hi;
    const bool multi = (hi - lo) > 1;
    XcdBarrier bar; bar.bar = (unsigned*)(F.ctl + CW_BAR); bar.x = 0; bar.st = nullptr;
    if (multi) bar = xcd_barrier_post((unsigned*)(F.ctl + CW_BAR), F.MISC + 8);
#ifndef PH_MASK
#define PH_MASK 0x1FF
#endif
#define IN(k) ((((PH_MASK) >> (k)) & 1) && lo <= (k) && (k) < hi)
#define SEAM(k) do { if (IN(k) && IN((k) + 1)) xcd_barrier(bar); } while (0)
#ifndef DOUBLE_MASK
#define DOUBLE_MASK 0
#endif
#define REP(k) for (int rep_ = 0; rep_ < ((((DOUBLE_MASK) >> (k)) & 1) + 1); ++rep_)
#if defined(PROBE_M0)
    if (IN(0) && blockIdx.x == 0 && F.wave == 0) {
        const Args A = fetch_args();
        LAS unsigned* hi = (LAS unsigned*)(F.lds + 0x26800); LAS unsigned* lo = (LAS unsigned*)(F.lds + 0x6800);
        for (int i = F.lane; i < 256; i += 64) { hi[i] = 0u; lo[i] = 0u; }
        asm volatile("s_waitcnt lgkmcnt(0)" ::: "memory");
        { unsigned keep_; const char* sb = (const char*)A.in[0]; unsigned vo = F.lane * 16u, dst = 0x26800u;
          asm volatile("s_mov_b32 %0, m0\n\ts_mov_b32 m0, %3\n\ts_nop 0\n\tglobal_load_lds_dwordx4 %1, %2\n\ts_mov_b32 m0, %0" : "=&s"(keep_) : "v"(vo), "s"(sb), "s"(dst) : "memory"); }
        asm volatile("s_waitcnt vmcnt(0)" ::: "memory");
        unsigned nzh = 0u, nzl = 0u;
        for (int i = F.lane; i < 256; i += 64) { nzh |= ((volatile LAS unsigned*)hi)[i]; nzl |= ((volatile LAS unsigned*)lo)[i]; }
        const bool landed_high = __any(nzh != 0u);
#if PROBE_M0 == 2
        const bool delay = landed_high;
#else
        const bool delay = !landed_high;
#endif
        if (delay) { const unsigned long long t0 = __builtin_amdgcn_s_memrealtime(); while (__builtin_amdgcn_s_memrealtime() - t0 < 30000ull) __builtin_amdgcn_s_sleep(8); }
        for (int i = F.lane; i < 256; i += 64) { hi[i] = 0u; lo[i] = 0u; }
        asm volatile("s_waitcnt lgkmcnt(0)" ::: "memory");
    }
    __syncthreads();
#endif
    if (IN(0)) { REP(0) { refresh_frame(F); const Args A = fetch_args(); p0_prologue(F, A); } SEAM(0); }
    if (IN(1)) { REP(1) {
        refresh_frame(F); const Args A = fetch_args(); unsigned char* ws = A.ws;
        pg8::Gemm g{(const bf16_t*)(ws + WS_XB), (const bf16_t*)(ws + WS_WIN), NTOK, INW, DM, 0}; pg8::StaticOrder S; S.init(NTOK, INW, F.G, (int)blockIdx.x);
        pg8::EpiProj E{(bf16_t*)(ws + WS_PROJ)};
        pg8::gemm_phase<pg8::EpiProj, pg8::StaticOrder, false>(F.lds + RING_OFF, g, S, E);
        } SEAM(1);
    }
    if (IN(2)) { REP(2) {
        refresh_frame(F); const Args A = fetch_args(); unsigned char* ws = A.ws;
#ifndef P2_REP_SUB
#define P2_REP_SUB 3
#endif
        const int sub_ = (rep_ == 0) ? A.pad0 : (A.pad0 & P2_REP_SUB);
        if (sub_ & 1) { const float lam = expf(wave_sum(A.in[2][F.lane] * A.in[3][F.lane])) - expf(wave_sum(A.in[4][F.lane] * A.in[5][F.lane])) + LAMBDA_INIT;
#if CONV_IN_ATTN
            {
                const int vcu = F.vcu, bh = vcu >> 3, s8 = vcu & 7, b = bh >> 2, h = bh & 3;
                const attn_body::bf16* P0 = (const attn_body::bf16*)(ws + WS_PROJ) + (long)b * SEQ * INW;
#if OUTPROJ_FP8
                attn_body::bf16* O0 = (attn_body::bf16*)(ws + WS_MIX + (size_t)b * SEQ * DM + h * 128);
#else
                attn_body::bf16* O0 = (attn_body::bf16*)(ws + WS_MIX) + (long)b * SEQ * DM + h * 128;
#endif

                for (int i = 0; i < 4; ++i) { const int qb = (i < 2) ? (15 - s8) : s8, st = i & 1;
                    attn_body::attn_unit<8>(qb, st, lam, A.in[6], P0 + C_Q + st * 256 + h * 64, P0 + C_K + st * 256 + h * 64, P0 + C_V + h * 128, O0, (char*)lds + RING_OFF);
                    if (rep_ == 0 && i < 3) { moe_weight_items(F, A, 8 * i); __syncthreads(); } }
            }
#else
            attn_body::attn_phase<8>((char*)lds + RING_OFF, (const bf16_t*)(ws + WS_PROJ), (bf16_t*)(ws + WS_MIX), F.vcu, lam, A.in[6]);
#endif
            }
        if (sub_ & 2) gmlp_phase(F, A);
        }
    }
    if (IN(3)) { SEAM(3); }
    if (IN(4)) { REP(4) {
        refresh_frame(F); const Args A = fetch_args(); unsigned char* ws = A.ws;
        pg8::Gemm g{(const bf16_t*)(ws + WS_MIX), (const bf16_t*)(ws + WS_WO), NTOK, DM, DM, 0}; pg8::StaticOrder S; S.init(NTOK, DM, F.G, (int)blockIdx.x);
#if OUTPROJ_FP8
        pg8::EpiH1 E{(const bf16_t*)(ws + WS_XB), (bf16_t*)(ws + WS_H1), pg8::WUNSCALE};
        pg8::gemm_phase<pg8::EpiH1, pg8::StaticOrder, false, true, false, ALIGN_H1>(F.lds + RING_OFF, g, S, E);
#else
        pg8::EpiH1 E{(const bf16_t*)(ws + WS_XB), (bf16_t*)(ws + WS_H1), 1.0f};
        pg8::gemm_phase<pg8::EpiH1, pg8::StaticOrder, false, false, false, ALIGN_H1>(F.lds + RING_OFF, g, S, E);
#endif
        } SEAM(4);
    }
    if (IN(5)) { REP(5) { refresh_frame(F); const Args A = fetch_args(); route_phase(F, A); } SEAM(5); }
    if (IN(6)) { REP(6) {
        refresh_frame(F); const Args A = fetch_args(); unsigned char* ws = A.ws;
        build_tab(F);
        pg8::MoeOrder S; S.init((const LAS int*)(F.lds + TAB_OFF), (const int*)(ws + WS_LIST), 8, (int)blockIdx.x);
#if MOE_FP8
        pg8::Gemm g{(const bf16_t*)(ws + WS_XB), (const bf16_t*)(ws + WS_WUP), PADROWS, 2 * DFF, DM, (size_t)2 * DFF * DM / 2};
        pg8::EpiSwiglu8 E{(unsigned char*)(ws + WS_ACT), A.in[17]};
        pg8::gemm_phase<pg8::EpiSwiglu8, pg8::MoeOrder, true, true, META_UP, ALIGN_UP>(F.lds + RING_OFF, g, S, E);
#else
        pg8::Gemm g{(const bf16_t*)(ws + WS_XB), (const bf16_t*)(ws + WS_WUP), PADROWS, 2 * DFF, DM, (size_t)2 * DFF * DM};
        pg8::EpiSwiglu E{(bf16_t*)(ws + WS_ACT), A.in[17]};
        pg8::gemm_phase<pg8::EpiSwiglu, pg8::MoeOrder, true>(F.lds + RING_OFF, g, S, E);
#endif
        } SEAM(6);
    }
    if (IN(7)) { REP(7) {
        refresh_frame(F); const Args A = fetch_args(); unsigned char* ws = A.ws;
        build_tab(F);
        pg8::MoeOrder S; S.init((const LAS int*)(F.lds + TAB_OFF), (const int*)(ws + WS_LIST), 4, (int)blockIdx.x);
#if MOE_FP8
        pg8::EpiDown8 E{(unsigned char*)(ws + WS_Y), A.in[19]};
        pg8::Gemm g{(const bf16_t*)(ws + WS_ACT), (const bf16_t*)(ws + WS_WDN), PADROWS, DM, DFF, (size_t)DM * DFF / 2};
        pg8::gemm_phase<pg8::EpiDown8, pg8::MoeOrder, false, true, META_DN>(F.lds + RING_OFF, g, S, E);
#else
        pg8::EpiDown E{(bf16_t*)(ws + WS_Y), A.in[19]};
        pg8::Gemm g{(const bf16_t*)(ws + WS_ACT), (const bf16_t*)(ws + WS_WDN), PADROWS, DM, DFF, (size_t)DM * DFF};
        pg8::gemm_phase<pg8::EpiDown, pg8::MoeOrder, false>(F.lds + RING_OFF, g, S, E);
#endif
        } SEAM(7);
    }
    if (IN(8)) { REP(8) { refresh_frame(F); const Args A = fetch_args(); build_tab(F); combine_phase(F, A); } }
#undef IN
#undef SEAM
}

struct NArgs {
    const float* x; const float* B; const float* bias; const float* bias2;
    const bf16_t* Ab; bf16_t* Ob; float* Of; const int* ctl; const int* list;
};
template <int MODE> __global__ void __launch_bounds__(256) ngemm(NArgs a) {
    constexpr int K = 1024;
    constexpr int LDB = (MODE == 0) ? INW : (MODE == 2 ? 2048 : 1024);
    constexpr bool DUAL = (MODE == 2);
    __shared__ float As[16][68];
    __shared__ float Bs[16][64];
    __shared__ float Bs2[DUAL ? 16 : 1][64];
    const int tid = threadIdx.x, ty = tid >> 4, tx = tid & 15;
    const int row0 = blockIdx.y * 64, col0 = blockIdx.x * 64;
    const float* B = a.B; int e = 0, pst = 0, cnt = 0;
    if (MODE >= 2) {
        const int* ps = a.ctl + CW_PSTART;
        while (e < NE && row0 >= ps[e + 1]) ++e;
        if (e >= NE) return;
        pst = ps[e]; cnt = a.ctl[CW_CNT + e];
        B += (size_t)e * K * LDB;
    }
    const int ar = tid >> 2, ak = (tid & 3) * 4;
    const float* arow_f = nullptr; const bf16_t* arow_b = nullptr;
    if (MODE == 0) arow_f = a.x + (size_t)(row0 + ar) * K;
    else if (MODE == 1 || MODE == 3) arow_b = a.Ab + (size_t)(row0 + ar) * K;
    else { const int r = row0 + ar - pst; const int tok = (r < cnt) ? a.list[e * NTOK + r] : 0; arow_b = a.Ab + (size_t)tok * K; }
    const int bk = tid >> 4, bn = (tid & 15) * 4;
    float acc[4][4], acc2[4][4];
#pragma unroll
    for (int i = 0; i < 4; ++i)
#pragma unroll
        for (int j = 0; j < 4; ++j) { acc[i][j] = 0.f; acc2[i][j] = 0.f; }
    for (int k0 = 0; k0 < K; k0 += 16) {
        float av[4];
        if (MODE == 0) { const float4 t = *(const float4*)(arow_f + k0 + ak); av[0] = t.x; av[1] = t.y; av[2] = t.z; av[3] = t.w; }
        else { const uint2 t = *(const uint2*)(arow_b + k0 + ak); av[0] = bf2f((bf16_t)(t.x & 0xffff)); av[1] = bf2f((bf16_t)(t.x >> 16)); av[2] = bf2f((bf16_t)(t.y & 0xffff)); av[3] = bf2f((bf16_t)(t.y >> 16)); }
        const float4 bv = *(const float4*)(B + (size_t)(k0 + bk) * LDB + col0 + bn);
        float4 bv2 = bv;
        if (DUAL) bv2 = *(const float4*)(B + (size_t)(k0 + bk) * LDB + 1024 + col0 + bn);
        __syncthreads();
#pragma unroll
        for (int c = 0; c < 4; ++c) As[ak + c][ar] = av[c];
        *(float4*)&Bs[bk][bn] = bv;
        if (DUAL) *(float4*)&Bs2[bk][bn] = bv2;
        __syncthreads();
#pragma unroll
        for (int k = 0; k < 16; ++k) {
            const float4 a4 = *(const float4*)&As[k][ty * 4];
            const float4 b4 = *(const float4*)&Bs[k][tx * 4];
            const float aa[4] = {a4.x, a4.y, a4.z, a4.w}, bb[4] = {b4.x, b4.y, b4.z, b4.w};
#pragma unroll
            for (int i = 0; i < 4; ++i)
#pragma unroll
                for (int j = 0; j < 4; ++j) acc[i][j] = fmaf(aa[i], bb[j], acc[i][j]);
            if (DUAL) {
                const float4 c4 = *(const float4*)&Bs2[k][tx * 4];
                const float cc[4] = {c4.x, c4.y, c4.z, c4.w};
#pragma unroll
                for (int i = 0; i < 4; ++i)
#pragma unroll
                    for (int j = 0; j < 4; ++j) acc2[i][j] = fmaf(aa[i], cc[j], acc2[i][j]);
            }
        }
    }
#pragma unroll
    for (int i = 0; i < 4; ++i) {
        const int row = row0 + ty * 4 + i;
#pragma unroll
        for (int j = 0; j < 4; ++j) {
            const int col = col0 + tx * 4 + j;
            if (MODE == 0) { float v = acc[i][j]; if (col < C_K) v *= QSCALE; a.Ob[(size_t)row * INW + col] = f2bf(v); }
            else if (MODE == 1) { a.Of[(size_t)row * DM + col] = ALPHA * a.x[(size_t)row * DM + col] + acc[i][j]; }
            else if (MODE == 2) {
                float g = acc[i][j] + a.bias[e * 2048 + col], l = acc2[i][j] + a.bias[e * 2048 + 1024 + col];
                g = fminf(g, 7.0f); l = fminf(fmaxf(l, -7.0f), 7.0f);
                const float act = (l + 1.0f) * g * (1.0f / (1.0f + expf(-1.702f * g)));
                a.Ob[(size_t)row * DFF + col] = f2bf(act);
            } else { a.Ob[(size_t)row * DM + col] = f2bf(acc[i][j] + a.bias[e * DM + col]); }
        }
    }
}

__global__ void __launch_bounds__(128) nattn(const bf16_t* __restrict__ proj, bf16_t* __restrict__ mix, const float* lq1, const float* lk1, const float* lq2, const float* lk2, const float* subg) {
    __shared__ float sc[2][SEQ];
    const int w = threadIdx.x >> 6, lane = threadIdx.x & 63;
    const int task = blockIdx.x * 2 + w, t = task >> 2, h = task & 3, b = t / SEQ, qpos = t % SEQ;
    const float lam = expf(wave_sum(lq1[lane] * lk1[lane])) - expf(wave_sum(lq2[lane] * lk2[lane])) + LAMBDA_INIT;
    const bf16_t* pb = proj + (size_t)b * SEQ * INW;
    float o[2][2];
    for (int s = 0; s < 2; ++s) {
        float q[DH];
        const bf16_t* qp = proj + (size_t)t * INW + C_Q + s * 256 + h * DH;
#pragma unroll
        for (int d = 0; d < DH; ++d) q[d] = bf2f(qp[d]);
        float m = -INFINITY;
        for (int j = lane; j <= qpos; j += 64) {
            const uint4* kp = (const uint4*)(pb + (size_t)j * INW + C_K + s * 256 + h * DH);
            float acc = 0.f;
#pragma unroll
            for (int c = 0; c < 8; ++c) {
                const uint4 kk = kp[c];
                const uint32_t ww[4] = {kk.x, kk.y, kk.z, kk.w};
#pragma unroll
                for (int z = 0; z < 4; ++z) { acc = fmaf(q[c * 8 + 2 * z], bf2f((bf16_t)(ww[z] & 0xffff)), acc); acc = fmaf(q[c * 8 + 2 * z + 1], bf2f((bf16_t)(ww[z] >> 16)), acc); }
            }
            sc[w][j] = acc; m = fmaxf(m, acc);
        }
        m = wave_max(m);
        float l = 0.f;
        for (int j = lane; j <= qpos; j += 64) { const float p = exp2f(sc[w][j] - m); sc[w][j] = p; l += p; }
        l = wave_sum(l);
        __syncthreads();
        float o0 = 0.f, o1 = 0.f;
        const bf16_t* vp = pb + C_V + h * DV + lane * 2;
        for (int j = 0; j <= qpos; ++j) {
            const float p = sc[w][j];
            const uint32_t vv = *(const uint32_t*)(vp + (size_t)j * INW);
            o0 = fmaf(p, bf2f((bf16_t)(vv & 0xffff)), o0); o1 = fmaf(p, bf2f((bf16_t)(vv >> 16)), o1);
        }
        o[s][0] = o0 / l; o[s][1] = o1 / l;
        __syncthreads();
    }
    const float d0 = o[0][0] - lam * o[1][0], d1 = o[0][1] - lam * o[1][1];
    const float ss = wave_sum(d0 * d0 + d1 * d1);
    const float r = rsqrtf(ss * (1.0f / DV) + LN_EPS) * (1.0f - LAMBDA_INIT);
    const uint32_t pk = (uint32_t)f2bf(d0 * r * subg[lane * 2]) | ((uint32_t)f2bf(d1 * r * subg[lane * 2 + 1]) << 16);
    *(uint32_t*)(mix + (size_t)t * DM + h * DV + lane * 2) = pk;
}

__global__ void __launch_bounds__(256) ngmlp(const bf16_t* __restrict__ proj, bf16_t* __restrict__ mix, const float* lng, const float* lnb, const float* wsp, const float* bsp) {
    __shared__ float mu[CHUNK], rs[CHUNK];
    __shared__ float vn[CHUNK][GD];
    const int c = blockIdx.x, g = blockIdx.y, tid = threadIdx.x, w = tid >> 6, lane = tid & 63;
    const size_t row0 = (size_t)c * CHUNK;
    for (int s = w; s < CHUNK; s += 4) {
        const bf16_t* p = proj + (row0 + s) * INW + C_GV;
        float v[8]; float sum = 0.f;
#pragma unroll
        for (int i = 0; i < 8; ++i) { v[i] = gelu_exact(bf2f(p[lane + 64 * i])); sum += v[i]; }
        const float mean = wave_sum(sum) * (1.0f / GW); float q = 0.f;
#pragma unroll
        for (int i = 0; i < 8; ++i) { const float d = v[i] - mean; q += d * d; }
        const float var = wave_sum(q) * (1.0f / GW);
        if (lane == 0) { mu[s] = mean; rs[s] = rsqrtf(var + LN_EPS); }
    }
    __syncthreads();
    for (int i = tid; i < CHUNK * GD; i += 256) {
        const int s = i >> 6, d = i & 63, col = g * GD + d;
        const float v = gelu_exact(bf2f(proj[(row0 + s) * INW + C_GV + col]));
        vn[s][d] = (v - mu[s]) * rs[s] * lng[col] + lnb[col];
    }
    __syncthreads();
    const int t = tid >> 1, dh = (tid & 1) * 32;
    float z[32];
#pragma unroll
    for (int d = 0; d < 32; ++d) z[d] = 0.f;
    const float* wr = wsp + ((size_t)g * CHUNK + t) * CHUNK;
    for (int s = 0; s <= t; ++s) {
        const float wv = wr[s];
#pragma unroll
        for (int d = 0; d < 32; ++d) z[d] = fmaf(wv, vn[s][dh + d], z[d]);
    }
    const float bb = bsp[g * CHUNK + t];
#pragma unroll
    for (int d = 0; d < 32; ++d) {
        const int col = g * GD + dh + d;
        const float u = gelu_exact(bf2f(proj[(row0 + t) * INW + C_GU + col]));
        mix[(row0 + t) * DM + GW + col] = f2bf(u * (z[d] + bb));
    }
}

__global__ void __launch_bounds__(256) nroute(float* __restrict__ h1, bf16_t* __restrict__ xb, const float* g1, const float* b1, const float* wr, const float* br, int* ctl, int* list, int* re, int* rr, float* rg) {
    const int w = threadIdx.x >> 6, lane = threadIdx.x & 63, t = blockIdx.x * 4 + w;
    float* row = h1 + (size_t)t * DM;
    float v[16]; float s = 0.f;
#pragma unroll
    for (int j = 0; j < 4; ++j) { const float4 q = *(const float4*)(row + j * 256 + lane * 4); v[4 * j] = q.x; v[4 * j + 1] = q.y; v[4 * j + 2] = q.z; v[4 * j + 3] = q.w; s += (q.x + q.y) + (q.z + q.w); }
    const float mean = wave_sum(s) * (1.0f / DM); float q2 = 0.f;
#pragma unroll
    for (int i = 0; i < 16; ++i) { v[i] -= mean; q2 += v[i] * v[i]; }
    const float rstd = rsqrtf(wave_sum(q2) * (1.0f / DM) + LN_EPS);
#pragma unroll
    for (int j = 0; j < 4; ++j) {
        const int col = j * 256 + lane * 4;
#pragma unroll
        for (int c = 0; c < 4; ++c) v[4 * j + c] = v[4 * j + c] * rstd * g1[col + c] + b1[col + c];
        *(float4*)(row + col) = make_float4(v[4 * j], v[4 * j + 1], v[4 * j + 2], v[4 * j + 3]);
        uint2 pk; pk.x = (uint32_t)f2bf(v[4 * j]) | ((uint32_t)f2bf(v[4 * j + 1]) << 16); pk.y = (uint32_t)f2bf(v[4 * j + 2]) | ((uint32_t)f2bf(v[4 * j + 3]) << 16);
        *(uint2*)(xb + (size_t)t * DM + col) = pk;
    }
    float lg[NE];
#pragma unroll
    for (int e = 0; e < NE; ++e) lg[e] = 0.f;
#pragma unroll
    for (int j = 0; j < 4; ++j)
#pragma unroll
        for (int c = 0; c < 4; ++c) {
            const float xv = v[4 * j + c]; const float4* wp = (const float4*)(wr + (size_t)(j * 256 + lane * 4 + c) * NE);
#pragma unroll
            for (int e4 = 0; e4 < 8; ++e4) { const float4 ww = wp[e4]; lg[4 * e4] = fmaf(xv, ww.x, lg[4 * e4]); lg[4 * e4 + 1] = fmaf(xv, ww.y, lg[4 * e4 + 1]); lg[4 * e4 + 2] = fmaf(xv, ww.z, lg[4 * e4 + 2]); lg[4 * e4 + 3] = fmaf(xv, ww.w, lg[4 * e4 + 3]); }
        }
#pragma unroll
    for (int e = 0; e < NE; ++e) lg[e] = wave_sum(lg[e]) + br[e];
    int idx[4]; float val[4]; unsigned taken = 0u;
#pragma unroll
    for (int k = 0; k < 4; ++k) {
        float best = -INFINITY; int bi = 0;
#pragma unroll
        for (int e = 0; e < NE; ++e) { const bool ok = !((taken >> e) & 1u) && lg[e] > best; best = ok ? lg[e] : best; bi = ok ? e : bi; }
        idx[k] = bi; val[k] = best; taken |= 1u << bi;
    }
    float ex[4], se = 0.f;
#pragma unroll
    for (int k = 0; k < 4; ++k) { ex[k] = expf(val[k] - val[0]); se += ex[k]; }
    if (lane == 0) {
#pragma unroll
        for (int k = 0; k < 4; ++k) {
            const int r = atomicAdd(ctl + CW_CNT + idx[k], 1);
            list[idx[k] * NTOK + r] = t;
            re[t * 4 + k] = idx[k]; rr[t * 4 + k] = r; rg[t * 4 + k] = ex[k] / se;
        }
    }
}
__global__ void npstart(int* ctl) {
    if (threadIdx.x == 0 && blockIdx.x == 0) { int p = 0; for (int e = 0; e < NE; ++e) { ctl[CW_PSTART + e] = p; p += ((ctl[CW_CNT + e] + 255) / 256) * 256; } ctl[CW_PSTART + NE] = p; }
}
__global__ void __launch_bounds__(256) ncombine(const float* __restrict__ x1, const bf16_t* __restrict__ y, const int* ctl, const int* re, const int* rr, const float* rg, const float* g2, const float* b2, float* __restrict__ out) {
    const int w = threadIdx.x >> 6, lane = threadIdx.x & 63, t = blockIdx.x * 4 + w;
    float v[16];
#pragma unroll
    for (int j = 0; j < 4; ++j) { const float4 q = *(const float4*)(x1 + (size_t)t * DM + j * 256 + lane * 4); v[4 * j] = ALPHA * q.x; v[4 * j + 1] = ALPHA * q.y; v[4 * j + 2] = ALPHA * q.z; v[4 * j + 3] = ALPHA * q.w; }
#pragma unroll
    for (int k = 0; k < 4; ++k) {
        const int e = re[t * 4 + k], slot = ctl[CW_PSTART + e] + rr[t * 4 + k]; const float g = rg[t * 4 + k];
        const bf16_t* yr = y + (size_t)slot * DM;
#pragma unroll
        for (int j = 0; j < 4; ++j) { const uint2 pk = *(const uint2*)(yr + j * 256 + lane * 4);
            v[4 * j] = fmaf(g, bf2f((bf16_t)(pk.x & 0xffff)), v[4 * j]); v[4 * j + 1] = fmaf(g, bf2f((bf16_t)(pk.x >> 16)), v[4 * j + 1]);
            v[4 * j + 2] = fmaf(g, bf2f((bf16_t)(pk.y & 0xffff)), v[4 * j + 2]); v[4 * j + 3] = fmaf(g, bf2f((bf16_t)(pk.y >> 16)), v[4 * j + 3]); }
    }
    float s = 0.f;
#pragma unroll
    for (int i = 0; i < 16; ++i) s += v[i];
    const float mean = wave_sum(s) * (1.0f / DM); float q2 = 0.f;
#pragma unroll
    for (int i = 0; i < 16; ++i) { v[i] -= mean; q2 += v[i] * v[i]; }
    const float rstd = rsqrtf(wave_sum(q2) * (1.0f / DM) + LN_EPS);
#pragma unroll
    for (int j = 0; j < 4; ++j) { const int col = j * 256 + lane * 4;
        *(float4*)(out + (size_t)t * DM + col) = make_float4(v[4 * j] * rstd * g2[col] + b2[col], v[4 * j + 1] * rstd * g2[col + 1] + b2[col + 1], v[4 * j + 2] * rstd * g2[col + 2] + b2[col + 2], v[4 * j + 3] * rstd * g2[col + 3] + b2[col + 3]); }
}

#ifndef OPT_MASK
#define OPT_MASK 0x1FF
#endif
#ifndef FUSED
#define FUSED 0
#endif
static void launch_mega(const Args& base, int lo, int hi, int sub, hipStream_t stream) {
    Args a = base; a.ph_lo = lo; a.ph_hi = hi; a.pad0 = sub; a.pad1 = 0;
    hipLaunchKernelGGL(mega_fwd, dim3(256), dim3(NWAVES * 64), LDS_BYTES, stream, a);
}
extern "C" void kernel_launch(void* const* d_in, const int* in_sizes, int n_in, void* d_out, int out_size, void* d_ws, size_t ws_size, hipStream_t stream) {
    static int ready = 0;
    if (ready == 0) {
        if (n_in != 22 || in_sizes[0] != NTOK * DM || out_size != NTOK * DM || ws_size < WS_END) { fprintf(stderr, "kernel_launch: unexpected shapes (n_in %d, in0 %d, out %d, ws %zu)\n", n_in, n_in > 0 ? in_sizes[0] : -1, out_size, ws_size); ready = -1; return; }
        if (hipFuncSetAttribute((const void*)mega_fwd, hipFuncAttributeMaxDynamicSharedMemorySize, LDS_BYTES) != hipSuccess) { fprintf(stderr, "kernel_launch: hipFuncSetAttribute failed\n"); ready = -1; return; }
        ready = 1;
    }
    if (ready < 0) return;
    const float* x = (const float*)d_in[0]; const float* w_in = (const float*)d_in[1];
    const float *lq1 = (const float*)d_in[2], *lk1 = (const float*)d_in[3], *lq2 = (const float*)d_in[4], *lk2 = (const float*)d_in[5];
    const float *subg = (const float*)d_in[6], *glng = (const float*)d_in[7], *glnb = (const float*)d_in[8], *wsp = (const float*)d_in[9], *bsp = (const float*)d_in[10];
    const float *w_o = (const float*)d_in[11], *ln1g = (const float*)d_in[12], *ln1b = (const float*)d_in[13], *w_r = (const float*)d_in[14], *b_r = (const float*)d_in[15];
    const float *w_up = (const float*)d_in[16], *b_up = (const float*)d_in[17], *w_dn = (const float*)d_in[18], *b_dn = (const float*)d_in[19], *ln2g = (const float*)d_in[20], *ln2b = (const float*)d_in[21];
    unsigned char* ws = (unsigned char*)d_ws;
    int* ctl = (int*)(ws + WS_CTL); int* list = (int*)(ws + WS_LIST); int* re = (int*)(ws + WS_RE); int* rr = (int*)(ws + WS_RR); float* rg = (float*)(ws + WS_RG);
    bf16_t* xb = (bf16_t*)(ws + WS_XB); bf16_t* proj = (bf16_t*)(ws + WS_PROJ); bf16_t* mix = (bf16_t*)(ws + WS_MIX); bf16_t* yb = (bf16_t*)(ws + WS_Y);
    float* h1 = (float*)(ws + WS_H1); bf16_t* act = (bf16_t*)(ws + WS_ACT);
    (void)hipMemsetAsync(ws + WS_CTL, 0, CTL_BYTES, stream);
    Args base{};
    for (int i = 0; i < 22; ++i) base.in[i] = (const float*)d_in[i];
    base.out = (float*)d_out; base.ws = ws;
    constexpr unsigned OM = OPT_MASK;
#if FUSED
    static_assert(OM == 0x1FFu, "FUSED needs every stage in the persistent kernel");
    launch_mega(base, 0, N_PHASES, 3, stream);
#else
    if (OM & 0xD3u) launch_mega(base, 0, 1, 0, stream);
    if (OM & 2u) launch_mega(base, 1, 2, 0, stream);
    else { NArgs a{}; a.x = x; a.B = w_in; a.Ob = proj; ngemm<0><<<dim3(INW / 64, NTOK / 64), 256, 0, stream>>>(a); }
    if ((OM & 4u) || (OM & 8u)) launch_mega(base, 2, 3, ((OM & 4u) ? 1 : 0) | ((OM & 8u) ? 2 : 0), stream);
    if (OM & 4u) launch_mega(base, 3, 4, 0, stream);
    else nattn<<<NTOK * NH / 2, 128, 0, stream>>>(proj, mix, lq1, lk1, lq2, lk2, subg);
    if (!(OM & 8u)) ngmlp<<<dim3(NTOK / CHUNK, NG), 256, 0, stream>>>(proj, mix, glng, glnb, wsp, bsp);
    if (OM & 16u) launch_mega(base, 4, 5, 0, stream);
    else { NArgs a{}; a.x = x; a.B = w_o; a.Ab = mix; a.Of = h1; ngemm<1><<<dim3(DM / 64, NTOK / 64), 256, 0, stream>>>(a); }
    if (OM & 32u) launch_mega(base, 5, 6, 0, stream);
    else nroute<<<NTOK / 4, 256, 0, stream>>>(h1, xb, ln1g, ln1b, w_r, b_r, ctl, list, re, rr, rg);
    if ((OM & 0x1C0u) != 0x1C0u) npstart<<<1, 64, 0, stream>>>(ctl);
    if (OM & 64u) launch_mega(base, 6, 7, 0, stream);
    else { NArgs a{}; a.B = w_up; a.bias = b_up; a.Ab = xb; a.Ob = act; a.ctl = ctl; a.list = list; ngemm<2><<<dim3(DFF / 64, PADROWS / 64), 256, 0, stream>>>(a); }
    if (OM & 128u) launch_mega(base, 7, 8, 0, stream);
    else { NArgs a{}; a.B = w_dn; a.bias = b_dn; a.Ab = act; a.Ob = yb; a.ctl = ctl; a.list = list; ngemm<3><<<dim3(DM / 64, PADROWS / 64), 256, 0, stream>>>(a); }
    if (OM & 256u) launch_mega(base, 8, 9, 0, stream);
    else ncombine<<<NTOK / 4, 256, 0, stream>>>(h1, yb, ctl, re, rr, rg, ln2g, ln2b, (float*)d_out);
#endif
}
```

```cpp
#include <hip/hip_runtime.h>
#include <hip/hip_bf16.h>
#include <cstdint>
#include <cstdio>
#include <cmath>

#ifndef MOE_FP8
#define MOE_FP8 1
#endif
#ifndef CONV_IN_ATTN
#define CONV_IN_ATTN 1
#endif
#ifndef OUTPROJ_FP8
#define OUTPROJ_FP8 1
#endif
namespace cfg {
constexpr int BATCH = 8, SEQ = 4096, NTOK = BATCH * SEQ, DM = 1024;
constexpr int INW = 2560, NH = 4, DH = 64, DV = 128;
constexpr int C_Q = 0, C_K = 512, C_V = 1024, C_GU = 1536, C_GV = 2048;
constexpr int GW = 512, NG = 8, GD = 64, CHUNK = 128;
constexpr int NE = 32, TOPK = 4, DFF = 1024;
constexpr int PADROWS = 139264;
constexpr float LN_EPS = 1e-5f;
constexpr float ALPHA = 1.189207115002721f;
constexpr float LAMBDA_INIT = 0.2f;
constexpr float QSCALE = 0.125f * 1.4426950408889634f;
constexpr size_t MiB = 1u << 20;
constexpr size_t WS_CTL = 0, CTL_BYTES = 1 * MiB;
constexpr size_t WS_LIST = 1 * MiB;
constexpr size_t WS_RE = 5 * MiB, WS_RR = 5 * MiB + 512 * 1024, WS_RG = 6 * MiB;
constexpr size_t WS_ST = 7 * MiB;
constexpr size_t WS_WIN = 8 * MiB;
constexpr size_t WS_WO = 13 * MiB;
constexpr size_t WS_WUP = 16 * MiB;
constexpr size_t WS_WDN = 144 * MiB;
constexpr size_t WS_X1B = 272 * MiB;
constexpr size_t WS_XB = 208 * MiB;
constexpr size_t WS_PROJ = 272 * MiB;
constexpr size_t WS_MIX = 432 * MiB;
constexpr size_t WS_ATTO = 496 * MiB;
constexpr size_t WS_Y = 336 * MiB;
constexpr size_t WS_H1 = 272 * MiB;
constexpr size_t WS_ACT = 688 * MiB;
constexpr size_t WS_END = 960 * MiB;
constexpr int CW_CNT = 0;
constexpr int CW_PSTART = 64;
constexpr int CW_BAR = 4096;
}
using namespace cfg;
typedef uint16_t bf16_t;

__device__ __forceinline__ float bf2f(bf16_t b) { return __uint_as_float((uint32_t)b << 16); }
__device__ __forceinline__ bf16_t f2bf(float f) { uint32_t u = __float_as_uint(f); u += 0x7fffu + ((u >> 16) & 1u); return (bf16_t)(u >> 16); }
typedef float pk2_f32x2_t __attribute__((ext_vector_type(2))); typedef __bf16 pk2_bf16x2_t __attribute__((ext_vector_type(2)));
__device__ __forceinline__ uint32_t pk2(float lo, float hi) { pk2_f32x2_t v = {lo, hi}; pk2_bf16x2_t b = __builtin_convertvector(v, pk2_bf16x2_t); return __builtin_bit_cast(uint32_t, b); }
__device__ __forceinline__ float wave_sum(float v) {
#pragma unroll
    for (int o = 1; o < 64; o <<= 1) v += __shfl_xor(v, o);
    return v;
}
__device__ __forceinline__ float wave_max(float v) {
#pragma unroll
    for (int o = 1; o < 64; o <<= 1) v = fmaxf(v, __shfl_xor(v, o));
    return v;
}
__device__ __forceinline__ float gelu_exact(float x) { return 0.5f * x * (1.0f + erff(x * 0.70710678118654752f)); }

#define OPT_MASK 0x1FF
#define FUSED 1
#define DOUBLE_MASK 0
#define P2_REP_SUB 3
namespace pg8 {
#define PG8_LAS __attribute__((address_space(3)))
typedef short bf16x8 __attribute__((ext_vector_type(8)));
typedef float f32x4 __attribute__((ext_vector_type(4)));
typedef float f32x2 __attribute__((ext_vector_type(2)));
typedef unsigned u32x4 __attribute__((ext_vector_type(4)));
typedef int v4i_t __attribute__((ext_vector_type(4)));
typedef int v8i_t __attribute__((ext_vector_type(8)));
constexpr int WSHIFT = 6;
#if defined(PROBE_DOUBLE_MFMA)
constexpr float WUNSCALE = 0.5f / (float)(1 << WSHIFT);
#else
constexpr float WUNSCALE = 1.0f / (float)(1 << WSHIFT);
#endif
constexpr int BM = 256, BK = 64, HALF = 128, HTB = HALF * BK * 2  , STAGE_BYTES = 8 * HTB, NXCD = 8, WGM = 8;

__host__ __device__ __forceinline__ int lds_byte(int r, int c) { const int st = (r >> 4) * 2 + (c >> 5), rr = r & 15, cc = c & 31, ob = rr * 64 + cc * 2; return st * 1024 + (ob ^ (((ob >> 9) & 1) << 5)); }
__host__ __device__ __forceinline__ void stage_rc(int b, int& R, int& C) { const int st = b / 1024, sb = b % 1024, swz = sb ^ (((sb >> 9) & 1) << 5); R = (st >> 1) * 16 + swz / 64; C = (st & 1) * 32 + (swz % 64) / 2; }
__host__ __device__ __forceinline__ int perm32(int rho) { const int n = rho >> 4, i = rho & 15; return 8 * (i >> 2) + 4 * n + (i & 3); }

struct Unit { int pm, pn, e; };
struct Gemm { const bf16_t* A; const bf16_t* Bt; int M, N, K; size_t strideB; };

struct StaticOrder {
    int nM, nN, nwg, G, c;
    __host__ __device__ void init(int M, int N, int G_, int c_) { nM = M / BM; nN = N / BM; nwg = nM * nN; G = G_; c = c_; }
    __host__ __device__ bool next(int i, Unit& u) const {
        const long L = (long)i * G + c; if (L >= nwg) return false;
        int wgid = (int)L; { const int q = nwg / NXCD, r = nwg % NXCD, xcd = wgid % NXCD, off = wgid / NXCD; wgid = (xcd < r ? xcd * (q + 1) : r * (q + 1) + (xcd - r) * q) + off; }
        const int nig = WGM * nN, gid = wgid / nig, fm = gid * WGM, gsz = (nM - fm) < WGM ? (nM - fm) : WGM;
        u.pm = fm + ((wgid % nig) % gsz); u.pn = (wgid % nig) / gsz; u.e = 0; return true;
    }
    __device__ __forceinline__ void gather(const Unit&, const int (&)[2], const int (&)[2], unsigned (&)[2][2], unsigned) const {}
    __device__ __forceinline__ void gather_issue(const Unit&, const int (&)[2], unsigned (&)[4]) const {}
    __device__ __forceinline__ void gather_finish(const Unit&, const int (&)[2], const int (&)[2], const unsigned (&)[4], unsigned (&)[2][2], unsigned) const {}
};
struct MoeOrder {
    const PG8_LAS int* tab; const int* list; int NC, RG, chunk0, nrt, j0;
    __device__ __forceinline__ void init(const PG8_LAS int* tab_, const int* list_, int NC_, int bid) {
        tab = tab_; list = list_; NC = NC_; RG = 32 / NC_; const int x = bid & 7; j0 = bid >> 3;
        const int T = __builtin_amdgcn_readfirstlane(tab_[32]); chunk0 = (T * x) / 8; nrt = (T * (x + 1)) / 8 - chunk0;
    }
    __device__ __forceinline__ bool next(int i, Unit& u) const {
        const int pml = i * RG + (j0 % RG); if (pml >= nrt) return false;
        u.pm = chunk0 + pml; u.pn = j0 / RG;
        const int ln = (int)(threadIdx.x & 63u); const int tv = tab[(ln & 31) + 1];
        u.e = __builtin_amdgcn_readfirstlane(__popcll(__ballot(ln < NE - 1 && u.pm >= tv))); return true;
    }
    __device__ __forceinline__ void tok_src(const Unit& u, int lane, const char*& sbase, unsigned& voff) const {
        const int r0 = (u.pm - __builtin_amdgcn_readfirstlane(tab[u.e])) * BM; sbase = (const char*)(list + (size_t)u.e * NTOK); voff = (unsigned)(r0 + 4 * lane) * 4u; }
    __device__ __forceinline__ void gather_lds(const Unit& u, const int (&RA)[2], const int (&CA2)[2], unsigned (&go)[2][2], unsigned rowbytes, const PG8_LAS int* tokl) const {
        const int r0 = (u.pm - __builtin_amdgcn_readfirstlane(tab[u.e])) * BM, cnt = __builtin_amdgcn_readfirstlane(tab[40 + u.e]);
#pragma unroll
        for (int h = 0; h < 2; ++h)
#pragma unroll
            for (int i = 0; i < 2; ++i) { const int rr_ = h * HALF + RA[i]; const int tk = ((const volatile PG8_LAS int*)tokl)[rr_];     const int tok = (r0 + rr_ < cnt) ? tk : 0; go[h][i] = (unsigned)tok * rowbytes + (unsigned)CA2[i]; }
    }
    __device__ __forceinline__ void gather_issue(const Unit& u, const int (&RA)[2], unsigned (&tk)[4]) const {
        const int r0 = (u.pm - __builtin_amdgcn_readfirstlane(tab[u.e])) * BM; const char* sb = (const char*)(list + (size_t)u.e * NTOK);
#pragma unroll
        for (int h = 0; h < 2; ++h)
#pragma unroll
            for (int i = 0; i < 2; ++i) { const unsigned vo = (unsigned)(r0 + h * HALF + RA[i]) * 4u; asm volatile("global_load_dword %0, %1, %2" : "=v"(tk[h * 2 + i]) : "v"(vo), "s"(sb) : "memory"); }
    }
    __device__ __forceinline__ void gather_finish(const Unit& u, const int (&RA)[2], const int (&CA2)[2], const unsigned (&tk)[4], unsigned (&go)[2][2], unsigned rowbytes) const {
        const int r0 = (u.pm - __builtin_amdgcn_readfirstlane(tab[u.e])) * BM, cnt = __builtin_amdgcn_readfirstlane(tab[40 + u.e]);
#pragma unroll
        for (int h = 0; h < 2; ++h)
#pragma unroll
            for (int i = 0; i < 2; ++i) { const unsigned tok = (r0 + h * HALF + RA[i] < cnt) ? tk[h * 2 + i] : 0u; go[h][i] = tok * rowbytes + (unsigned)CA2[i]; }
    }
    __device__ __forceinline__ void gather(const Unit& u, const int (&RA)[2], const int (&CA2)[2], unsigned (&go)[2][2], unsigned rowbytes) const {
        const int r0 = (u.pm - __builtin_amdgcn_readfirstlane(tab[u.e])) * BM, cnt = __builtin_amdgcn_readfirstlane(tab[40 + u.e]);
#pragma unroll
        for (int h = 0; h < 2; ++h)
#pragma unroll
            for (int i = 0; i < 2; ++i) { const int r = r0 + h * HALF + RA[i]; const int tl = list[u.e * NTOK + r]; const int tok = (r < cnt) ? tl : 0; go[h][i] = (unsigned)tok * rowbytes + (unsigned)CA2[i]; }
    }
};

__device__ __forceinline__ unsigned cvt_pk_bf16(float lo, float hi) { unsigned r; asm volatile("v_cvt_pk_bf16_f32 %0, %1, %2" : "=v"(r) : "v"(lo), "v"(hi)); return r; }
__device__ __forceinline__ f32x2 gelu_pk(f32x2 v) {
    const f32x2 av = __builtin_elementwise_abs(v);
    f32x2 p = av * 5.621299663962208e-06f + 5.105520900865984e-05f; p = p * av + 3.96861370110139e-05f; p = p * av + 0.0034227392389008246f;
    p = p * av + 0.022076998456581717f; p = p * av + 0.052075163036630574f; p = p * av + 1.0442737824274138f;
    f32x2 r; r.x = __builtin_amdgcn_rcpf(p.x); r.y = __builtin_amdgcn_rcpf(p.y);
    r = r * r; r = r * r; r = r * r; r = r * r;
    f32x2 mx; mx.x = __builtin_fmaxf(v.x, 0.f); mx.y = __builtin_fmaxf(v.y, 0.f);
    return mx - av * r;
}
__device__ __forceinline__ float gelu1(float v) { return gelu_pk((f32x2){v, v}).x; }

struct EpiProj {
    static constexpr bool PERM = true; static constexpr bool BIAS = false; static constexpr bool ACCBIAS = false;
    bf16_t* O;
    __device__ __forceinline__ void operator()(const f32x4 (&acc)[2][2][4][2], const Unit& u, int wr, int wc, int fr, int fq) const {
        const int row0 = u.pm * BM + wr * 64 + fr, col0 = u.pn * BM + wc * 32 + 8 * fq;
        const bool act = (u.pn >= C_GU / BM);
#pragma unroll
        for (int ai = 0; ai < 2; ++ai)
#pragma unroll
            for (int m = 0; m < 4; ++m) { bf16_t* rowp = O + (size_t)(row0 + ai * HALF + m * 16) * INW + col0;
#pragma unroll
                for (int bj = 0; bj < 2; ++bj) { f32x4 v0 = acc[ai][bj][m][0], v1 = acc[ai][bj][m][1];
                    if (act) { const f32x2 a = gelu_pk((f32x2){v0[0], v0[1]}), b = gelu_pk((f32x2){v0[2], v0[3]}), c = gelu_pk((f32x2){v1[0], v1[1]}), d = gelu_pk((f32x2){v1[2], v1[3]});
                        v0 = (f32x4){a.x, a.y, b.x, b.y}; v1 = (f32x4){c.x, c.y, d.x, d.y}; }
                    u32x4 w; w.x = cvt_pk_bf16(v0[0], v0[1]); w.y = cvt_pk_bf16(v0[2], v0[3]); w.z = cvt_pk_bf16(v1[0], v1[1]); w.w = cvt_pk_bf16(v1[2], v1[3]);
                    *(u32x4*)(rowp + bj * HALF) = w; } }
    }
};
struct EpiH1 {
    static constexpr bool PERM = true; static constexpr bool BIAS = false; static constexpr bool ACCBIAS = false;
    const bf16_t* X; bf16_t* C; float sc;
    __device__ __forceinline__ void operator()(const f32x4 (&acc)[2][2][4][2], const Unit& u, int wr, int wc, int fr, int fq) const {
        const int row0 = u.pm * BM + wr * 64 + fr, col0 = u.pn * BM + wc * 32 + 8 * fq;
        u32x4 xv[2][4][2];
#pragma unroll
        for (int ai = 0; ai < 2; ++ai)
#pragma unroll
            for (int m = 0; m < 4; ++m)
#pragma unroll
                for (int bj = 0; bj < 2; ++bj) xv[ai][m][bj] = *(const u32x4*)(X + (size_t)(row0 + ai * HALF + m * 16) * DM + col0 + bj * HALF);
#pragma unroll
        for (int ai = 0; ai < 2; ++ai)
#pragma unroll
            for (int m = 0; m < 4; ++m) { const size_t off = (size_t)(row0 + ai * HALF + m * 16) * DM + col0;
#pragma unroll
                for (int bj = 0; bj < 2; ++bj) { const u32x4 xw = xv[ai][m][bj];
                    const f32x4 a0 = acc[ai][bj][m][0] * sc, a1 = acc[ai][bj][m][1] * sc;
                    u32x4 w;
                    w.x = cvt_pk_bf16(__uint_as_float(xw.x << 16) * ALPHA + a0[0], __uint_as_float(xw.x & 0xffff0000u) * ALPHA + a0[1]);
                    w.y = cvt_pk_bf16(__uint_as_float(xw.y << 16) * ALPHA + a0[2], __uint_as_float(xw.y & 0xffff0000u) * ALPHA + a0[3]);
                    w.z = cvt_pk_bf16(__uint_as_float(xw.z << 16) * ALPHA + a1[0], __uint_as_float(xw.z & 0xffff0000u) * ALPHA + a1[1]);
                    w.w = cvt_pk_bf16(__uint_as_float(xw.w << 16) * ALPHA + a1[2], __uint_as_float(xw.w & 0xffff0000u) * ALPHA + a1[3]);
                    *(u32x4*)(C + off + bj * HALF) = w; } }
    }
};
struct EpiSwiglu {
    static constexpr bool PERM = true; static constexpr bool BIAS = false; static constexpr bool ACCBIAS = false;
    bf16_t* O; const float* bias;
    __device__ __forceinline__ void operator()(const f32x4 (&acc)[2][2][4][2], const Unit& u, int wr, int wc, int fr, int fq) const {
        const int row0 = u.pm * BM + wr * 64 + fr, col0 = u.pn * HALF + wc * 32 + 8 * fq;
        const float* bp = bias + (size_t)u.e * (2 * DFF) + col0;
        f32x4 bg[2], bl[2];
#pragma unroll
        for (int n = 0; n < 2; ++n) { bg[n] = *(const f32x4*)(bp + 4 * n); bl[n] = *(const f32x4*)(bp + DFF + 4 * n); }
#pragma unroll
        for (int ai = 0; ai < 2; ++ai)
#pragma unroll
            for (int m = 0; m < 4; ++m) { float a8[8];
#pragma unroll
                for (int n = 0; n < 2; ++n) { const f32x4 g4 = acc[ai][0][m][n] + bg[n], l4 = acc[ai][1][m][n] + bl[n];
#pragma unroll
                    for (int j = 0; j < 4; ++j) { const float g = fminf(g4[j], 7.0f), l = fminf(fmaxf(l4[j], -7.0f), 7.0f);
                        const float sg = __builtin_amdgcn_rcpf(1.0f + __builtin_amdgcn_exp2f(g * (-1.702f * 1.4426950408889634f)));
                        a8[4 * n + j] = (l + 1.0f) * g * sg; } }
                u32x4 w; w.x = cvt_pk_bf16(a8[0], a8[1]); w.y = cvt_pk_bf16(a8[2], a8[3]); w.z = cvt_pk_bf16(a8[4], a8[5]); w.w = cvt_pk_bf16(a8[6], a8[7]);
                *(u32x4*)(O + (size_t)(row0 + ai * HALF + m * 16) * DFF + col0) = w; }
    }
};
struct EpiDown {
    static constexpr bool PERM = true; static constexpr bool BIAS = false; static constexpr bool ACCBIAS = false;
    bf16_t* O; const float* bias;
    __device__ __forceinline__ void operator()(const f32x4 (&acc)[2][2][4][2], const Unit& u, int wr, int wc, int fr, int fq) const {
        const int row0 = u.pm * BM + wr * 64 + fr, col0 = u.pn * BM + wc * 32 + 8 * fq;
        const float* bp = bias + (size_t)u.e * DM + col0;
        f32x4 bv[2][2];
#pragma unroll
        for (int bj = 0; bj < 2; ++bj)
#pragma unroll
            for (int n = 0; n < 2; ++n) bv[bj][n] = *(const f32x4*)(bp + bj * HALF + 4 * n);
#pragma unroll
        for (int ai = 0; ai < 2; ++ai)
#pragma unroll
            for (int m = 0; m < 4; ++m) { bf16_t* rowp = O + (size_t)(row0 + ai * HALF + m * 16) * DM + col0;
#pragma unroll
                for (int bj = 0; bj < 2; ++bj) { const f32x4 v0 = acc[ai][bj][m][0] + bv[bj][0], v1 = acc[ai][bj][m][1] + bv[bj][1];
                    u32x4 w; w.x = cvt_pk_bf16(v0[0], v0[1]); w.y = cvt_pk_bf16(v0[2], v0[3]); w.z = cvt_pk_bf16(v1[0], v1[1]); w.w = cvt_pk_bf16(v1[2], v1[3]);
                    *(u32x4*)(rowp + bj * HALF) = w; } }
    }
};

__device__ __forceinline__ unsigned pk4_fp8(float a, float b, float c, float d) { int w = 0; w = __builtin_amdgcn_cvt_pk_fp8_f32(a, b, w, false); w = __builtin_amdgcn_cvt_pk_fp8_f32(c, d, w, true); return (unsigned)w; }
typedef unsigned u32x2 __attribute__((ext_vector_type(2)));
__device__ __forceinline__ u32x4 widen16(u32x2 w0, u32x2 w1) {
    const auto sx = __builtin_amdgcn_permlane16_swap(w0.x, w1.x, false, false); const auto sy = __builtin_amdgcn_permlane16_swap(w0.y, w1.y, false, false);
    return (u32x4){sx[0], sy[0], sx[1], sy[1]}; }
struct EpiSwiglu8 {
    static constexpr bool PERM = true; static constexpr bool BIAS = true; static constexpr bool ACCBIAS = true;
    unsigned char* O; const float* bias;
    __device__ __forceinline__ size_t bias_idx(const Unit& u, int j) const { return (size_t)u.e * (2 * DFF) + (j < HALF ? 0 : DFF - HALF) + u.pn * HALF + j; }
    __device__ __forceinline__ void bias_src(const Unit& u, int lane, const char*& sbase, unsigned& voff) const {
        sbase = (const char*)(bias + (size_t)u.e * (2 * DFF)); voff = (unsigned)((lane < 32 ? 0 : DFF - 128) + u.pn * HALF + 4 * lane) * 4u; }
    __device__ __forceinline__ void operator()(const f32x4 (&acc)[2][2][4][2], const Unit& u, int wr, int wc, int fr, int fq, const PG8_LAS float* brec) const {
        const int row0 = u.pm * BM + wr * 64 + fr, col0 = u.pn * HALF + wc * 32 + 8 * fq;
        constexpr float S = (float)(1 << WSHIFT), IS = 1.0f / S;
        u32x2 wq[2];
#pragma unroll
        for (int ai = 0; ai < 2; ++ai)
#pragma unroll
            for (int m = 0; m < 4; ++m) { float a8[8];
#pragma unroll
                for (int n = 0; n < 2; ++n) { const f32x4 g4 = acc[ai][0][m][n], l4 = acc[ai][1][m][n];
#pragma unroll
                    for (int pr = 0; pr < 2; ++pr) {
                        const f32x2 g = (f32x2){__builtin_amdgcn_fmed3f(g4[2 * pr], -3.0e38f, 7.0f * S), __builtin_amdgcn_fmed3f(g4[2 * pr + 1], -3.0e38f, 7.0f * S)};
                        const f32x2 l = (f32x2){__builtin_amdgcn_fmed3f(l4[2 * pr], -7.0f * S, 7.0f * S), __builtin_amdgcn_fmed3f(l4[2 * pr + 1], -7.0f * S, 7.0f * S)};
                        f32x2 e = g * (-1.702f * 1.4426950408889634f * IS); e.x = __builtin_amdgcn_exp2f(e.x); e.y = __builtin_amdgcn_exp2f(e.y);
                        f32x2 d = e + 1.0f; d.x = __builtin_amdgcn_rcpf(d.x); d.y = __builtin_amdgcn_rcpf(d.y);
                        const f32x2 av = (g * (l * (IS * IS) + IS)) * d;
                        a8[4 * n + 2 * pr] = av.x; a8[4 * n + 2 * pr + 1] = av.y; } }
                wq[m & 1].x = pk4_fp8(a8[0], a8[1], a8[2], a8[3]); wq[m & 1].y = pk4_fp8(a8[4], a8[5], a8[6], a8[7]);
                if (m & 1) { const u32x4 w16 = widen16(wq[0], wq[1]);
                    *(u32x4*)(O + (size_t)(row0 + ai * HALF + (m - 1 + (fq & 1)) * 16) * DFF + (col0 - 8 * (fq & 1))) = w16; } }
    }
};

struct EpiDown8 {
    static constexpr bool PERM = true; static constexpr bool BIAS = true; static constexpr bool ACCBIAS = false;
    unsigned char* O; const float* bias;
    __device__ __forceinline__ size_t bias_idx(const Unit& u, int j) const { return (size_t)u.e * DM + u.pn * BM + j; }
    __device__ __forceinline__ void bias_src(const Unit& u, int lane, const char*& sbase, unsigned& voff) const {
        sbase = (const char*)(bias + (size_t)u.e * DM); voff = (unsigned)(u.pn * BM + 4 * lane) * 4u; }
    __device__ __forceinline__ void operator()(const f32x4 (&acc)[2][2][4][2], const Unit& u, int wr, int wc, int fr, int fq, const PG8_LAS float* brec) const {
        const int row0 = u.pm * BM + wr * 64 + fr, col0 = u.pn * BM + wc * 32 + 8 * fq;
        f32x4 bv[2][2];
#pragma unroll
        for (int bj = 0; bj < 2; ++bj)
#pragma unroll
            for (int n = 0; n < 2; ++n) bv[bj][n] = *(const PG8_LAS f32x4*)(brec + bj * HALF + wc * 32 + 8 * fq + 4 * n);
#pragma unroll
        for (int ai = 0; ai < 2; ++ai)
#pragma unroll
            for (int mp = 0; mp < 4; mp += 2) { unsigned char* rowp = O + (size_t)(row0 + ai * HALF + (mp + (fq & 1)) * 16) * DM + (col0 - 8 * (fq & 1));
#pragma unroll
                for (int bj = 0; bj < 2; ++bj) { u32x2 wq[2];
#pragma unroll
                    for (int q = 0; q < 2; ++q) { const f32x4 v0 = acc[ai][bj][mp + q][0] * WUNSCALE + bv[bj][0], v1 = acc[ai][bj][mp + q][1] * WUNSCALE + bv[bj][1];
                        wq[q].x = pk4_fp8(v0[0], v0[1], v0[2], v0[3]); wq[q].y = pk4_fp8(v1[0], v1[1], v1[2], v1[3]); }
                    *(u32x4*)(rowp + bj * HALF) = widen16(wq[0], wq[1]); } }
    }
};

constexpr int PG8_META_OFF = 157696, PG8_META_SLOT = 2048;
constexpr int PG8_BIAS_OFF = 131072, PG8_BIAS_MAX = 24;
template <class Epi, class Sched, bool GATHER, bool FP8 = false, bool META = false, bool ALIGN_EPI = true>
__device__ __forceinline__ void gemm_phase(PG8_LAS unsigned char* lds, const Gemm g, const Sched& S, const Epi& E) {
    int tid_ = threadIdx.x; asm volatile("" : "+v"(tid_));
    const int tid = tid_, wid = __builtin_amdgcn_readfirstlane(tid >> 6), lane = tid & 63, wr = wid >> 2, wc = wid & 3, fr = lane & 15, fq = lane >> 4;
    const int K = FP8 ? g.K / 2 : g.K, nt = K / BK;
    unsigned voffB[2]; int RA[2], CA2[2]; unsigned voffA[2];
#pragma unroll
    for (int i = 0; i < 2; ++i) { int R, C; stage_rc(tid * 16 + i * 8192, R, C); const int Rb = Epi::PERM ? ((R & ~31) + perm32(R & 31)) : R;
        voffA[i] = (unsigned)(R * K + C) * 2u; voffB[i] = (unsigned)(Rb * K + C) * 2u; RA[i] = R; CA2[i] = C * 2; }
    const size_t kstep = (size_t)(BK * 2);
    const size_t hstep = (size_t)HALF * K * 2;
    const size_t tstep = 2 * hstep;
    const unsigned ldsw = (unsigned)wid * 1024u;
    const int aoff = lds_byte(wr * 64 + fr, fq * 8), boff = lds_byte(wc * 32 + fr, fq * 8);
    const unsigned lds0 = (unsigned)(uintptr_t)lds;
#define PG8_SA(b, h) (((b) * 2 + (h)) * HTB)
#define PG8_SB(b, h) ((4 + (b) * 2 + (h)) * HTB)
#define PG8_GLDS(sbase, voff, ldsoff) do { unsigned keep_; asm volatile("s_mov_b32 %0, m0\n\ts_mov_b32 m0, %3\n\ts_nop 0\n\tglobal_load_lds_dwordx4 %1, %2\n\ts_mov_b32 m0, %0" \
        : "=&s"(keep_) : "v"(voff), "s"(sbase), "s"((unsigned)__builtin_amdgcn_readfirstlane((int)(lds0 + (unsigned)(ldsoff)))) : "memory"); } while (0)
#define PG8_STAGE_B(bufoff, gbase) do { PG8_GLDS((const char*)(gbase), voffB[0], (bufoff) + ldsw); PG8_GLDS((const char*)(gbase), voffB[1], (bufoff) + ldsw + 8192); } while (0)
#define PG8_STAGE_A(bufoff, gbase, o0, o1) do { PG8_GLDS((const char*)(gbase), (o0), (bufoff) + ldsw); PG8_GLDS((const char*)(gbase), (o1), (bufoff) + ldsw + 8192); } while (0)
#define PG8_LDA(dst, b, h) do { _Pragma("unroll") for (int m = 0; m < 4; ++m) _Pragma("unroll") for (int k = 0; k < 2; ++k) dst[m][k] = *(const PG8_LAS bf16x8*)(lds + PG8_SA(b, h) + aoff + m * 2048 + k * 1024); } while (0)
#define PG8_LDB(dst, b, h) do { _Pragma("unroll") for (int n = 0; n < 2; ++n) _Pragma("unroll") for (int k = 0; k < 2; ++k) dst[n][k] = *(const PG8_LAS bf16x8*)(lds + PG8_SB(b, h) + boff + n * 2048 + k * 1024); } while (0)
#define PG8_LD8(p) __builtin_shufflevector(*(const PG8_LAS v4i_t*)(p), *(const PG8_LAS v4i_t*)((p) + 1024), 0, 1, 2, 3, 4, 5, 6, 7)
#define PG8_LDA8(dst, b, h) do { _Pragma("unroll") for (int m = 0; m < 4; ++m) dst[m] = PG8_LD8(lds + PG8_SA(b, h) + aoff + m * 2048); } while (0)
#define PG8_LDB8(dst, b, h) do { _Pragma("unroll") for (int n = 0; n < 2; ++n) dst[n] = PG8_LD8(lds + PG8_SB(b, h) + boff + n * 2048); } while (0)
#if defined(PROBE_DOUBLE_MFMA)
#define PG8_MFMA_TWICE(ai, bj, m, n, At, Bt) acc[ai][bj][m][n] = __builtin_amdgcn_mfma_scale_f32_16x16x128_f8f6f4(Bt##8[n], At##8[m], acc[ai][bj][m][n], 0, 0, 0, 0, 0, 0);
#else
#define PG8_MFMA_TWICE(ai, bj, m, n, At, Bt)
#endif
#define PG8_MMA(ai, bj, At, Bt) do { __builtin_amdgcn_s_setprio(1); \
        if constexpr (FP8) { _Pragma("unroll") for (int m = 0; m < 4; ++m) _Pragma("unroll") for (int n = 0; n < 2; ++n) \
            { acc[ai][bj][m][n] = __builtin_amdgcn_mfma_scale_f32_16x16x128_f8f6f4(Bt##8[n], At##8[m], acc[ai][bj][m][n], 0, 0, 0, 0, 0, 0); PG8_MFMA_TWICE(ai, bj, m, n, At, Bt) }     \
              \
            _Pragma("unroll") for (int m = 0; m < 4; ++m) _Pragma("unroll") for (int n = 0; n < 2; ++n) asm volatile("" : "+v"(acc[ai][bj][m][n])); } \
        else { _Pragma("unroll") for (int m = 0; m < 4; ++m) _Pragma("unroll") for (int n = 0; n < 2; ++n) _Pragma("unroll") for (int k = 0; k < 2; ++k) \
            acc[ai][bj][m][n] = __builtin_amdgcn_mfma_f32_16x16x32_bf16(Bt[n][k], At[m][k], acc[ai][bj][m][n], 0, 0, 0); } \
        __builtin_amdgcn_s_setprio(0); } while (0)
#define PG8_XLDA(dst, b, h) do { if constexpr (FP8) PG8_LDA8(dst##8, b, h); else PG8_LDA(dst, b, h); } while (0)
#define PG8_XLDB(dst, b, h) do { if constexpr (FP8) PG8_LDB8(dst##8, b, h); else PG8_LDB(dst, b, h); } while (0)
#define PG8_WAIT_V(n) asm volatile("s_waitcnt vmcnt(" #n ")" ::: "memory")
#define PG8_WAIT_L(n) asm volatile("s_waitcnt lgkmcnt(" #n ")" ::: "memory")
#define PG8_BAR __builtin_amdgcn_s_barrier()
#define PG8_SCHED __builtin_amdgcn_sched_barrier(0)
    Unit cur, nxt; int ui = 0;
#if defined(PROBE_DOUBLE_K)
    constexpr bool DKSEL = (PROBE_DOUBLE_K == 1) ? GATHER : (PROBE_DOUBLE_K == 2) ? (FP8 && !GATHER) : (!FP8 && !GATHER && Epi::PERM);
#define PG8_UIDX(i) (DKSEL ? ((i) >> 1) : (i))
#else
#define PG8_UIDX(i) (i)
#endif
    if (!S.next(PG8_UIDX(0), cur)) return;
    if constexpr (FP8 && !META && Epi::BIAS) {
        f32x4 bv_[3]; bool ok_[3];
#pragma unroll
        for (int k = 0; k < 3; ++k) { Unit bu; ok_[k] = S.next(wid + 8 * k, bu); if (ok_[k]) bv_[k] = *(const f32x4*)&E.bias[E.bias_idx(bu, 4 * lane)]; }
#pragma unroll
        for (int k = 0; k < 3; ++k) if (ok_[k]) *(PG8_LAS f32x4*)(lds + PG8_BIAS_OFF + (wid + 8 * k) * 1024 + lane * 16) = bv_[k];
        PG8_WAIT_L(0); PG8_BAR; }
    f32x4 acc[2][2][4][2];
#pragma unroll
    for (int a = 0; a < 2; ++a)
#pragma unroll
        for (int b = 0; b < 2; ++b)
#pragma unroll
            for (int m = 0; m < 4; ++m)
#pragma unroll
                for (int n = 0; n < 2; ++n) acc[a][b][m][n] = (f32x4){0.f, 0.f, 0.f, 0.f};
#define PG8_ACC_BIAS(idx_) do { if constexpr (FP8 && !META && Epi::BIAS && Epi::ACCBIAS) { const PG8_LAS float* br_ = (const PG8_LAS float*)(lds + PG8_BIAS_OFF) + (idx_) * 256; \
        _Pragma("unroll") for (int b = 0; b < 2; ++b) _Pragma("unroll") for (int n = 0; n < 2; ++n) { const f32x4 v_ = *(const PG8_LAS f32x4*)(br_ + b * HALF + wc * 32 + 8 * fq + 4 * n) * (float)(1 << WSHIFT); \
            _Pragma("unroll") for (int a = 0; a < 2; ++a) _Pragma("unroll") for (int m = 0; m < 4; ++m) acc[a][b][m][n] = v_; } } } while (0)
    PG8_ACC_BIAS(0);
    bf16x8 At[4][2], B0[2][2], B1[2][2]; v8i_t At8[4], B08[2], B18[2];
    const char* cA = GATHER ? (const char*)g.A : (const char*)g.A + (size_t)cur.pm * tstep;
    const char* cB = (const char*)g.Bt + ((size_t)cur.e * g.strideB) * 2 + (size_t)cur.pn * tstep;
    unsigned gc[2][2], gn[2][2];
    unsigned tkn[4] = {0u, 0u, 0u, 0u};
#define PG8_META_ISSUE(u_, slot_) do { const char* sb_; unsigned vo_; \
        if (GATHER && wid == 0) { S.tok_src(u_, lane, sb_, vo_); PG8_GLDS(sb_, vo_, PG8_META_OFF + (slot_) * PG8_META_SLOT); } \
        if (wid == 1) { E.bias_src(u_, lane, sb_, vo_); PG8_GLDS(sb_, vo_, PG8_META_OFF + (slot_) * PG8_META_SLOT + 1024); } } while (0)
    if constexpr (META) { PG8_META_ISSUE(cur, 0); PG8_WAIT_V(0); PG8_BAR; asm volatile("" ::: "memory");
        if constexpr (GATHER) S.gather_lds(cur, RA, CA2, gc, (unsigned)(K * 2), (const PG8_LAS int*)(lds + PG8_META_OFF)); }
    else if constexpr (GATHER) { S.gather(cur, RA, CA2, gc, (unsigned)(K * 2)); }
    else {
#pragma unroll
        for (int h = 0; h < 2; ++h)
#pragma unroll
            for (int i = 0; i < 2; ++i) gc[h][i] = (unsigned)(h * hstep) + voffA[i]; }
#pragma unroll
    for (int h = 0; h < 2; ++h)
#pragma unroll
        for (int i = 0; i < 2; ++i) gn[h][i] = gc[h][i];
    PG8_STAGE_B(PG8_SB(0, 0), cB); PG8_STAGE_B(PG8_SB(0, 1), cB + hstep); PG8_STAGE_A(PG8_SA(0, 0), cA, gc[0][0], gc[0][1]); PG8_STAGE_A(PG8_SA(0, 1), cA, gc[1][0], gc[1][1]);
    if (wr == 1) PG8_BAR;
    PG8_WAIT_V(2); PG8_BAR;
    PG8_STAGE_B(PG8_SB(1, 0), cB + kstep); PG8_STAGE_A(PG8_SA(1, 0), cA + kstep, gc[0][0], gc[0][1]); PG8_STAGE_B(PG8_SB(1, 1), cB + hstep + kstep);
    PG8_WAIT_V(6); PG8_BAR;
    for (;;) {
        const bool has_next = S.next(PG8_UIDX(ui + 1), nxt);
        const char* nA = GATHER ? cA : (has_next ? (const char*)g.A + (size_t)nxt.pm * tstep : cA);
        const char* nB = has_next ? (const char*)g.Bt + ((size_t)nxt.e * g.strideB) * 2 + (size_t)nxt.pn * tstep : cB;
        if constexpr (META) { if (has_next) PG8_META_ISSUE(nxt, (ui + 1) % 3); }
        else if constexpr (GATHER) { if (has_next) S.gather_issue(nxt, RA, tkn); }
        for (int t = 0; t < nt; t += 2) {
            const bool last = (t == nt - 2);
            const char* a1 = cA + (size_t)(t + 1) * kstep;
            const char* a2 = last ? nA : cA + (size_t)(t + 2) * kstep; const char* b2 = last ? nB : cB + (size_t)(t + 2) * kstep;
            const char* a3 = a2 + kstep; const char* b3 = b2 + kstep;
            if constexpr (GATHER && META) { if (last && has_next) S.gather_lds(nxt, RA, CA2, gn, (unsigned)(K * 2), (const PG8_LAS int*)(lds + PG8_META_OFF + ((ui + 1) % 3) * PG8_META_SLOT)); }
            if constexpr (GATHER && !META) { if (last && has_next) {
                asm volatile("s_waitcnt vmcnt(8)" : "+v"(tkn[0]), "+v"(tkn[1]), "+v"(tkn[2]), "+v"(tkn[3]) :: "memory");
                S.gather_finish(nxt, RA, CA2, tkn, gn, (unsigned)(K * 2)); } }
            unsigned o00 = gc[0][0], o01 = gc[0][1], o10 = gc[1][0], o11 = gc[1][1];
            if constexpr (GATHER) { if (last) { o00 = gn[0][0]; o01 = gn[0][1]; o10 = gn[1][0]; o11 = gn[1][1]; } }
            PG8_XLDB(B0, 0, 0); PG8_XLDB(B1, 0, 1); PG8_SCHED; PG8_XLDA(At, 0, 0); PG8_STAGE_A(PG8_SA(1, 1), a1, gc[1][0], gc[1][1]);
            PG8_WAIT_V(8); PG8_WAIT_L(0); PG8_BAR; PG8_MMA(0, 0, At, B0); PG8_MMA(0, 1, At, B1); PG8_BAR; PG8_SCHED;
            PG8_XLDA(At, 0, 1); PG8_STAGE_B(PG8_SB(0, 0), b2); PG8_STAGE_B(PG8_SB(0, 1), b2 + hstep); PG8_STAGE_A(PG8_SA(0, 0), a2, o00, o01);
            PG8_WAIT_V(8); PG8_WAIT_L(0); PG8_BAR; PG8_MMA(1, 0, At, B0); PG8_MMA(1, 1, At, B1); PG8_BAR; PG8_SCHED;
            PG8_XLDB(B0, 1, 0); PG8_XLDB(B1, 1, 1); PG8_SCHED; PG8_XLDA(At, 1, 0); PG8_STAGE_A(PG8_SA(0, 1), a2, o10, o11);
            PG8_WAIT_V(8); PG8_WAIT_L(0); PG8_BAR; PG8_MMA(0, 0, At, B0); PG8_MMA(0, 1, At, B1); PG8_BAR; PG8_SCHED;
            PG8_XLDA(At, 1, 1); PG8_STAGE_B(PG8_SB(1, 0), b3); PG8_STAGE_B(PG8_SB(1, 1), b3 + hstep); PG8_STAGE_A(PG8_SA(1, 0), a3, o00, o01);
            PG8_WAIT_V(8); PG8_WAIT_L(0); PG8_BAR; PG8_MMA(1, 0, At, B0); PG8_MMA(1, 1, At, B1); PG8_BAR; PG8_SCHED;
        }
        if constexpr (ALIGN_EPI) { if (wr == 0) PG8_BAR; }
#if defined(PROBE_DOUBLE_K)
        const bool dk_first = DKSEL && ((ui & 1) == 0);
        if (DKSEL && !dk_first) { _Pragma("unroll") for (int a = 0; a < 2; ++a) _Pragma("unroll") for (int b = 0; b < 2; ++b) _Pragma("unroll") for (int m = 0; m < 4; ++m) _Pragma("unroll") for (int n = 0; n < 2; ++n) acc[a][b][m][n] *= 0.5f; }
#else
        constexpr bool dk_first = false;
#endif
        if (!dk_first)
        { int fr_ = fr, fq_ = fq; asm volatile("" : "+v"(fr_), "+v"(fq_));
          if constexpr (META) PG8_WAIT_V(0);
          asm volatile("" ::: "memory");
          if constexpr (META) E(acc, cur, wr, wc, fr_, fq_, (const PG8_LAS float*)(lds + PG8_META_OFF + (ui % 3) * PG8_META_SLOT + 1024));
          else if constexpr (FP8 && Epi::BIAS) E(acc, cur, wr, wc, fr_, fq_, (const PG8_LAS float*)(lds + PG8_BIAS_OFF) + ui * 256);
          else E(acc, cur, wr, wc, fr_, fq_);
#if defined(PROBE_DOUBLE_EPI_OFF)
          if constexpr (GATHER) { asm volatile("" : "+v"(fr_), "+v"(fq_)); E(acc, cur, wr, wc, fr_, fq_); }
#endif
          }
        if (!has_next) break;
        if (!dk_first) {
#pragma unroll
        for (int a = 0; a < 2; ++a)
#pragma unroll
            for (int b = 0; b < 2; ++b)
#pragma unroll
                for (int m = 0; m < 4; ++m)
#pragma unroll
                    for (int n = 0; n < 2; ++n) acc[a][b][m][n] = (f32x4){0.f, 0.f, 0.f, 0.f};
        PG8_ACC_BIAS(ui + 1);
        }
        cur = nxt; cA = nA; cB = nB; ++ui;
#pragma unroll
        for (int h = 0; h < 2; ++h)
#pragma unroll
            for (int i = 0; i < 2; ++i) gc[h][i] = gn[h][i];
        if constexpr (ALIGN_EPI) { if (wr == 1) PG8_BAR; }
    }
    PG8_WAIT_V(0);
    if constexpr (!ALIGN_EPI) { if (wr == 0) PG8_BAR; }
    PG8_BAR;
#undef PG8_UIDX
#undef PG8_ACC_BIAS
#undef PG8_META_ISSUE
#undef PG8_SA
#undef PG8_SB
#undef PG8_GLDS
#undef PG8_STAGE_A
#undef PG8_STAGE_B
#undef PG8_LDA
#undef PG8_LDB
#undef PG8_MMA
#undef PG8_LD8
#undef PG8_LDA8
#undef PG8_LDB8
#undef PG8_XLDA
#undef PG8_XLDB
#undef PG8_WAIT_V
#undef PG8_WAIT_L
#undef PG8_BAR
#undef PG8_SCHED
}
}

namespace attn_body {
using bf16=__hip_bfloat16;
using bf16x8=__attribute__((ext_vector_type(8)))short;
using s16x4=__attribute__((ext_vector_type(4)))short;
using f32x16=__attribute__((ext_vector_type(16)))float;
using u32x4=__attribute__((ext_vector_type(4)))unsigned;
constexpr int D=64,PQ=INW,PO=DM;
constexpr int NW=8,QBLK=32,QB=QBLK*NW,KVBLK=64,NQB=SEQ/QB;
constexpr int ATTN_UNIT_ROWS=QB;
__device__ __forceinline__ int crow(int r,int hi){return (r&3)+8*(r>>2)+4*hi;}
#define SBAR() __builtin_amdgcn_sched_barrier(0)
__device__ __forceinline__ void cmask(f32x16&p0,f32x16&p1,int jb,int qrel,int hi){
  const float NEG=-INFINITY; int kb=64*jb+4*hi;
  #pragma unroll
  for(int r=0;r<16;++r){int kv=kb+(r&3)+8*(r>>2); if(kv>qrel)p0[r]=NEG; if(kv+32>qrel)p1[r]=NEG;}
}

constexpr int NSLOT=3, SLOTB=8192;
constexpr int LDS_K=0, LDS_V=NSLOT*SLOTB, LDS_WS=3*NSLOT*SLOTB, LDS_STASH=LDS_WS+NW*64*4, LDS_BYTES=LDS_STASH+NW*8192;
constexpr float C2=0.125f*1.4426950408889634f;
__device__ __forceinline__ void glds16(const void*gsrc,unsigned lds_dst){unsigned keep;
  asm volatile("s_mov_b32 %0, m0\n\ts_mov_b32 m0, %2\n\ts_nop 0\n\tglobal_load_lds_dwordx4 %1, off\n\ts_mov_b32 m0, %0":"=&s"(keep):"v"(gsrc),"s"(lds_dst):"memory");}
__device__ __forceinline__ void glds16s(unsigned long sbase,unsigned voff,unsigned lds_dst){unsigned keep;
  asm volatile("s_mov_b32 %0, m0\n\ts_mov_b32 m0, %3\n\ts_nop 0\n\tglobal_load_lds_dwordx4 %1, %2\n\ts_mov_b32 m0, %0":"=&s"(keep):"v"(voff),"s"(sbase),"s"(lds_dst):"memory");}
__device__ __forceinline__ unsigned long uni64(const void*p){const unsigned long a=(unsigned long)p; return ((unsigned long)(unsigned)__builtin_amdgcn_readfirstlane((int)(a>>32))<<32)|(unsigned)__builtin_amdgcn_readfirstlane((int)a);}
__device__ __forceinline__ float max3f(float a,float b,float c){float r;asm("v_max3_f32 %0, %1, %2, %3":"=v"(r):"v"(a),"v"(b),"v"(c));return r;}
__device__ __forceinline__ float max2f(float a,float b){float r;asm("v_max_f32_e32 %0, %1, %2":"=v"(r):"v"(a),"v"(b));return r;}
__device__ __forceinline__ float fadd_s(float a,float b){float r;asm("v_add_f32_e32 %0, %1, %2":"=v"(r):"v"(a),"v"(b));return r;}
__device__ __forceinline__ float fsub_s(float a,float b){float r;asm("v_sub_f32_e32 %0, %1, %2":"=v"(r):"v"(a),"v"(b));return r;}
typedef float f32x2_t __attribute__((ext_vector_type(2))); typedef __bf16 bf16x2_t __attribute__((ext_vector_type(2)));
__device__ __forceinline__ unsigned cvtpk_s(float lo,float hi){f32x2_t v={lo,hi};bf16x2_t b=__builtin_convertvector(v,bf16x2_t);return __builtin_bit_cast(unsigned,b);}
#define WAIT_BAR(N) asm volatile("s_waitcnt vmcnt(" #N ") lgkmcnt(0)\n\ts_barrier":::"memory")

__device__ __forceinline__ void qkt(f32x16&p0,f32x16&p1,const char*Kslot,const bf16x8*qr,int r32,int hi){ const f32x16 negm=f32x16{};
  const char*kb=Kslot+hi*1024+r32*16;
  #pragma unroll
  for(int d0=0;d0<4;++d0){
    const bf16x8 b0=*reinterpret_cast<const bf16x8*>(kb+d0*2048);
    const bf16x8 b1=*reinterpret_cast<const bf16x8*>(kb+d0*2048+512);
    if(d0==0){p0=__builtin_amdgcn_mfma_f32_32x32x16_bf16(b0,qr[0],negm,0,0,0);p1=__builtin_amdgcn_mfma_f32_32x32x16_bf16(b1,qr[0],negm,0,0,0);}
    else{p0=__builtin_amdgcn_mfma_f32_32x32x16_bf16(b0,qr[d0],p0,0,0,0);p1=__builtin_amdgcn_mfma_f32_32x32x16_bf16(b1,qr[d0],p1,0,0,0);}}
}
typedef __attribute__((address_space(3))) const char* lds_cptr;
typedef short v4i16_t __attribute__((ext_vector_type(4)));
__device__ __forceinline__ void kload8(bf16x8*kf,lds_cptr kp){
  kf[0]=*(const __attribute__((address_space(3))) bf16x8*)(kp);      kf[1]=*(const __attribute__((address_space(3))) bf16x8*)(kp+512);
  kf[2]=*(const __attribute__((address_space(3))) bf16x8*)(kp+2048); kf[3]=*(const __attribute__((address_space(3))) bf16x8*)(kp+2560);
  kf[4]=*(const __attribute__((address_space(3))) bf16x8*)(kp+4096); kf[5]=*(const __attribute__((address_space(3))) bf16x8*)(kp+4608);
  kf[6]=*(const __attribute__((address_space(3))) bf16x8*)(kp+6144); kf[7]=*(const __attribute__((address_space(3))) bf16x8*)(kp+6656);
}
__device__ __forceinline__ void kload2(bf16x8*kf,lds_cptr kp,int j){ kf[2*j]=*(const __attribute__((address_space(3))) bf16x8*)(kp+j*2048); kf[2*j+1]=*(const __attribute__((address_space(3))) bf16x8*)(kp+j*2048+512); }
__device__ __forceinline__ s16x4 vtr(lds_cptr p){ return __builtin_bit_cast(s16x4,__builtin_amdgcn_ds_read_tr16_b64_v4i16((__attribute__((address_space(3))) v4i16_t*)p)); }
__device__ __forceinline__ float rowmax(const f32x16&p0,const f32x16&p1){
  float a=max3f(p0[0],p0[1],p1[0]),b=max3f(p0[2],p0[3],p1[1]);a=max3f(a,p1[2],p1[3]);
  #pragma unroll
  for(int r=4;r<16;r+=4){a=max3f(a,p0[r],p0[r+1]);b=max3f(b,p0[r+2],p0[r+3]);a=max3f(a,p1[r],p1[r+1]);b=max3f(b,p1[r+2],p1[r+3]);}
  const float m=max2f(a,b);
  auto rr=__builtin_amdgcn_permlane32_swap(__float_as_uint(m),__float_as_uint(m),false,false);
  return max2f(__uint_as_float(rr[0]),__uint_as_float(rr[1]));
}
__device__ __forceinline__ void pv(f32x16*o,int vb,bf16x8 pa0,bf16x8 pa1,bf16x8 pa2,bf16x8 pa3){
  #pragma unroll
  for(int d0=0;d0<4;++d0){s16x4 lo[4],hi[4];
    #pragma unroll
    for(int ks=0;ks<4;++ks){
      asm volatile("ds_read_b64_tr_b16 %0,%1 offset:%c2":"=&v"(lo[ks]):"v"(vb),"i"(d0*4096+ks*1024):"memory");
      asm volatile("ds_read_b64_tr_b16 %0,%1 offset:%c2":"=&v"(hi[ks]):"v"(vb),"i"(d0*4096+ks*1024+512):"memory");}
    asm volatile("s_waitcnt lgkmcnt(0)":::"memory");SBAR();
    #define PK(k) (bf16x8){lo[k][0],lo[k][1],lo[k][2],lo[k][3],hi[k][0],hi[k][1],hi[k][2],hi[k][3]}
    o[d0]=__builtin_amdgcn_mfma_f32_32x32x16_bf16(pa0,PK(0),o[d0],0,0,0);
    o[d0]=__builtin_amdgcn_mfma_f32_32x32x16_bf16(pa1,PK(1),o[d0],0,0,0);
    o[d0]=__builtin_amdgcn_mfma_f32_32x32x16_bf16(pa2,PK(2),o[d0],0,0,0);
    o[d0]=__builtin_amdgcn_mfma_f32_32x32x16_bf16(pa3,PK(3),o[d0],0,0,0);
    #undef PK
  }
}

#ifndef ATTN_STORE16
#define ATTN_STORE16(p,v) (*(u32x4*)(p)=(v))
#endif
template<int THRL> __device__ __forceinline__ void attn_unit(int qb,int st,float lam,const float*sgp,const bf16*Qb,const bf16*__restrict__ Kb,const bf16*__restrict__ Vb,bf16*Ob,char*shm){
  int tid_=threadIdx.x; asm volatile("":"+v"(tid_));
  const int tid=tid_,lane=tid&63,r32=lane&31,hi=lane>>5; const int wid=__builtin_amdgcn_readfirstlane(tid>>6);
  const int q0=qb*QB;
  const bf16*Qw=Qb+(long)(q0+wid*QBLK)*PQ;
  const bf16*Kh=Kb,*Vh=Vb;
  const unsigned lds0=(unsigned)(uintptr_t)shm;
  float*wsf=(float*)(shm+LDS_WS)+wid*64;
  const unsigned long kbase=uni64(Kh), vbase=uni64(Vh);
  const unsigned koff=(unsigned)(lane*PQ+wid*8)*2u, voff=(unsigned)((16*(wid&3)+(lane>>2))*PQ+(wid>>2)*32+(lane&3)*8)*2u;
  const unsigned kdst=lds0+LDS_K+wid*1024, vdst=lds0+LDS_V+wid*1024;
  #define DMA_K(t,slot) glds16s(kbase+(unsigned long)(t)*(KVBLK*PQ*2),koff,(unsigned)__builtin_amdgcn_readfirstlane(kdst+(slot)))
  #define DMA_V(t,slot) do{ glds16s(vbase+(unsigned long)(t)*(KVBLK*PQ*2),voff,(unsigned)__builtin_amdgcn_readfirstlane(vdst+2*(slot))); glds16s(vbase+(unsigned long)(t)*(KVBLK*PQ*2)+128,voff,(unsigned)__builtin_amdgcn_readfirstlane(vdst+2*(slot)+8192)); }while(0)
  #define DMA_V0(t,slot) glds16s(vbase+(unsigned long)(t)*(KVBLK*PQ*2),voff,(unsigned)__builtin_amdgcn_readfirstlane(vdst+2*(slot)))
  #define DMA_V1(t,slot) glds16s(vbase+(unsigned long)(t)*(KVBLK*PQ*2)+128,voff,(unsigned)__builtin_amdgcn_readfirstlane(vdst+2*(slot)+8192))
  const int vb0=(int)(lds0+LDS_V)+((lane>>4)&1)*32+(lane&3)*8+(4*hi+((lane&15)>>2))*64;
  const char*Kbase=shm+LDS_K; bf16x8 kf[8];
  const lds_cptr shm3=(lds_cptr)shm; const lds_cptr kp0=shm3+LDS_K+hi*1024+r32*16; const lds_cptr vp0=shm3+LDS_V+((lane>>4)&1)*32+(lane&3)*8+(4*hi+((lane&15)>>2))*64;
  const int NT=(q0+QB)/KVBLK;
  DMA_K(0,0);DMA_V(0,0);DMA_K(1,SLOTB);
  bf16x8 qr[4];
  #pragma unroll
  for(int d0=0;d0<4;++d0)qr[d0]=*reinterpret_cast<const bf16x8*>(&Qw[(long)r32*PQ+d0*16+hi*8]);
  float mhat=0.f,l_reg=0.f;f32x16 o[4];o[0]=f32x16{};o[1]=f32x16{};o[2]=f32x16{};o[3]=f32x16{};
  const int qrel=wid*QBLK+r32;
  #define CMASK(P0,P1,t) do{int jb_=(t)-(NT-4); if(jb_>=0)cmask(P0,P1,jb_,qrel,hi);}while(0)
  bool resc=false;
  #define START(P0,P1) do{ const float rm=rowmax(P0,P1); resc=false; mhat=rm; \
    _Pragma("unroll") for(int r=0;r<16;++r)P0[r]=__builtin_amdgcn_exp2f(P0[r]-mhat); }while(0)
  #define RESC() do{ if(resc){ asm volatile("s_waitcnt lgkmcnt(0)":::"memory"); \
      _Pragma("unroll") for(int d_=0;d_<4;++d_) _Pragma("unroll") for(int r=0;r<16;++r)o[d_][r]*=wsf[crow(r,hi)]; } }while(0)
  f32x16 pA0,pA1,pB0,pB1;
  int sl_prev=0,sl_cur=0,sl_next=SLOTB;
  #define ROT() do{sl_prev=sl_cur;sl_cur=sl_next;sl_next=(sl_next==(NSLOT-1)*SLOTB)?0:sl_next+SLOTB;}while(0)
  DMA_K(2,2*SLOTB);
  WAIT_BAR(4);
  qkt(pA0,pA1,Kbase,qr,r32,hi);asm volatile("s_nop 15\n\ts_nop 7":"+v"(pA0),"+v"(pA1));CMASK(pA0,pA1,0);
  START(pA0,pA1);
  _Pragma("unroll") for(int r=0;r<16;++r)pA1[r]=__builtin_amdgcn_exp2f(pA1[r]-mhat);
  f32x16 nm; _Pragma("unroll") for(int r=0;r<16;++r)nm[r]=-mhat;
  WAIT_BAR(0);
  DMA_K(3,0);DMA_V(1,SLOTB);
  ROT();
  kload8(kf,kp0+sl_cur);
  WAIT_BAR(3);
  s16x4 vlo[4],vhi[4]; u32x4 pw0,pw1,pw2,pw3;
  #define PKW(P,B) cvtpk_s(P[B],P[B+1])
  #define PAF(k) __builtin_bit_cast(bf16x8,pw##k)
  #define PAFJ(j) __builtin_bit_cast(bf16x8,((j)<4?pw0:(j)<8?pw1:(j)<12?pw2:pw3))
  #define VFR(i) (bf16x8){vlo[i][0],vlo[i][1],vlo[i][2],vlo[i][3],vhi[i][0],vhi[i][1],vhi[i][2],vhi[i][3]}
  #define PIN(x) asm volatile("":"+v"(x))
  #define MX3(a,b,c) __builtin_fmaxf(__builtin_fmaxf((a),(b)),(c))
  #define GAPA(MF,A0,A1,A2,A3,W0,W1,PW) do{ MF; l_reg+=A0; l_reg+=A1; l_reg+=A2; l_reg+=A3; PIN(l_reg); W0; W1; PIN(PW); SBAR(); }while(0)
  #define EX(v) __builtin_amdgcn_exp2f(v)
  #define GAPB(MF,X,B) do{ MF; X[B]=EX(X[B]); X[B+1]=EX(X[B+1]); PIN(X); SBAR(); }while(0)
  #define VRD(S,ks,d0) do{ vlo[S]=vtr(vp_+((d0)*4096+(ks)*1024)); vhi[S]=vtr(vp_+((d0)*4096+(ks)*1024+512)); }while(0)
  #define KRD(G,j) do{ if(G){ kload2(kf,kp0+sl_next,j); SBAR(); } }while(0)
  #define PVG(j,X,B) GAPB(o[(j)&3]=__builtin_amdgcn_mfma_f32_32x32x16_bf16(PAFJ(j),VFR((j)&3),o[(j)&3],0,0,0), X,B)
  #define PVGD(j,X,B,D) do{ o[(j)&3]=__builtin_amdgcn_mfma_f32_32x32x16_bf16(PAFJ(j),VFR((j)&3),o[(j)&3],0,0,0); SBAR(); D; SBAR(); X[B]=EX(X[B]); X[B+1]=EX(X[B+1]); PIN(X); SBAR(); }while(0)
  #define STEP(C0,C1,P0,P1,t,GK,GV,GL) do{ SBAR(); \
    const lds_cptr vp_=vp0+2*sl_prev; \
    l_reg+=P0[0]; l_reg+=P0[1];                                 \
    GAPA(C0=__builtin_amdgcn_mfma_f32_32x32x16_bf16(kf[0],qr[0],nm,0,0,0), P0[2],P0[3],P0[4],P0[5],     pw0[0]=PKW(P0,0), pw0[1]=PKW(P0,2), pw0); \
    GAPA(C1=__builtin_amdgcn_mfma_f32_32x32x16_bf16(kf[1],qr[0],nm,0,0,0), P0[6],P0[7],P0[8],P0[9],     pw0[2]=PKW(P0,4), pw0[3]=PKW(P0,6), pw0); \
    GAPA(C0=__builtin_amdgcn_mfma_f32_32x32x16_bf16(kf[2],qr[1],C0,0,0,0),   P0[10],P0[11],P0[12],P0[13], pw1[0]=PKW(P0,8), pw1[1]=PKW(P0,10), pw1); \
    GAPA(C1=__builtin_amdgcn_mfma_f32_32x32x16_bf16(kf[3],qr[1],C1,0,0,0),   P0[14],P0[15],P1[0],P1[1],   pw1[2]=PKW(P0,12),pw1[3]=PKW(P0,14), pw1); \
    VRD(0,0,0); SBAR(); GAPA(C0=__builtin_amdgcn_mfma_f32_32x32x16_bf16(kf[4],qr[2],C0,0,0,0),   P1[2],P1[3],P1[4],P1[5],     pw2[0]=PKW(P1,0), pw2[1]=PKW(P1,2), pw2); \
    VRD(1,0,1); SBAR(); GAPA(C1=__builtin_amdgcn_mfma_f32_32x32x16_bf16(kf[5],qr[2],C1,0,0,0),   P1[6],P1[7],P1[8],P1[9],     pw2[2]=PKW(P1,4), pw2[3]=PKW(P1,6), pw2); \
    VRD(2,0,2); SBAR(); GAPA(C0=__builtin_amdgcn_mfma_f32_32x32x16_bf16(kf[6],qr[3],C0,0,0,0),   P1[10],P1[11],P1[12],P1[13], pw3[0]=PKW(P1,8), pw3[1]=PKW(P1,10), pw3); \
    VRD(3,0,3); SBAR(); GAPA(C1=__builtin_amdgcn_mfma_f32_32x32x16_bf16(kf[7],qr[3],C1,0,0,0),   P1[14],P1[15],0.f,0.f,       pw3[2]=PKW(P1,12),pw3[3]=PKW(P1,14), pw3); \
    CMASK(C0,C1,t); \
    { float a=MX3(C0[0],C0[1],C1[0]),b=MX3(C0[2],C0[3],C1[1]); a=MX3(a,C1[2],C1[3]); \
      _Pragma("unroll") for(int r=4;r<16;r+=4){a=MX3(a,C0[r],C0[r+1]);b=MX3(b,C0[r+2],C0[r+3]);a=MX3(a,C1[r],C1[r+1]);b=MX3(b,C1[r+2],C1[r+3]);} \
      float rm=__builtin_fmaxf(a,b); { auto rr=__builtin_amdgcn_permlane32_swap(__float_as_uint(rm),__float_as_uint(rm),false,false); rm=__builtin_fmaxf(__uint_as_float(rr[0]),__uint_as_float(rr[1])); } \
      resc=false;                                             \
      if(__builtin_expect(__any(rm>(float)THRL),0)){ const float dl=__builtin_fmaxf(rm,0.f);     \
        _Pragma("unroll") for(int r=0;r<16;++r){ C0[r]-=dl; C1[r]-=dl; nm[r]-=dl; } \
        const float f=__builtin_amdgcn_exp2f(-dl); l_reg*=f; if(hi==0)wsf[r32]=f; resc=true; } } \
    SBAR(); \
      \
    PVG(0,C0,0);  VRD(0,1,0); SBAR(); \
    PVG(1,C0,2);  VRD(1,1,1); SBAR(); \
    PVG(2,C0,4);  VRD(2,1,2); SBAR(); \
    PVG(3,C0,6);  VRD(3,1,3); SBAR(); \
    PVG(4,C0,8);  VRD(0,2,0); SBAR(); \
    PVG(5,C0,10); VRD(1,2,1); SBAR(); \
    PVG(6,C0,12); VRD(2,2,2); SBAR(); \
    PVG(7,C0,14); VRD(3,2,3); SBAR(); \
    KRD(GL,0); PVG(8,C1,0);   VRD(0,3,0); SBAR(); \
    KRD(GL,1); PVG(9,C1,2);   VRD(1,3,1); SBAR(); \
    KRD(GL,2); PVG(10,C1,4);  VRD(2,3,2); SBAR(); \
    KRD(GL,3); PVG(11,C1,6);  VRD(3,3,3); SBAR(); \
      \
    PVGD(12,C1,8,if(GK){DMA_K((t)+3,sl_cur);}); PVGD(13,C1,10,if(GV){DMA_V0((t)+1,sl_next);}); PVGD(14,C1,12,if(GV){DMA_V1((t)+1,sl_next);}); PVG(15,C1,14); \
    }while(0)
  int t=1;
  #undef CMASK
  #define CMASK(P0,P1,t) do{}while(0)
  for(;t+5<NT;t+=2){
    STEP(pB0,pB1,pA0,pA1,t,true,true,true);     WAIT_BAR(3); RESC(); ROT();
    STEP(pA0,pA1,pB0,pB1,t+1,true,true,true);   WAIT_BAR(3); RESC(); ROT();
  }
  #undef CMASK
  #define CMASK(P0,P1,t) do{int jb_=(t)-(NT-4); if(jb_>=0)cmask(P0,P1,jb_,qrel,hi);}while(0)
  #define ENDW(tt) do{ if((tt)+3<NT){WAIT_BAR(3);} else if((tt)+2<NT){WAIT_BAR(2);} else {WAIT_BAR(0);} }while(0)
  for(;t+1<NT;t+=2){
    STEP(pB0,pB1,pA0,pA1,t,(t+3<NT),(t+1<NT),(t+1<NT));       ENDW(t);   RESC(); ROT();
    STEP(pA0,pA1,pB0,pB1,t+1,(t+4<NT),(t+2<NT),(t+2<NT));     ENDW(t+1); RESC(); ROT();
  }
  STEP(pB0,pB1,pA0,pA1,NT-1,false,false,false); RESC();
  { float sacc=pB0[0]+pB0[1]; _Pragma("unroll") for(int r=2;r<16;++r)sacc+=pB0[r]; _Pragma("unroll") for(int r=0;r<16;++r)sacc+=pB1[r]; l_reg+=sacc;
    pw0=(u32x4){PKW(pB0,0),PKW(pB0,2),PKW(pB0,4),PKW(pB0,6)};pw1=(u32x4){PKW(pB0,8),PKW(pB0,10),PKW(pB0,12),PKW(pB0,14)};pw2=(u32x4){PKW(pB1,0),PKW(pB1,2),PKW(pB1,4),PKW(pB1,6)};pw3=(u32x4){PKW(pB1,8),PKW(pB1,10),PKW(pB1,12),PKW(pB1,14)};
    SBAR(); pv(o,vb0+2*sl_cur,PAF(0),PAF(1),PAF(2),PAF(3)); }
  #undef PKW
  #undef PAF
  #undef PAFJ
  #undef PVG
  #undef VFR
  #undef PIN
  #undef MX3
  #undef GAPA
  #undef GAPB
  #undef EX
  #undef VRD
  #undef KRD
  #undef STEP
  #undef ENDW
  {auto rr=__builtin_amdgcn_permlane32_swap(__float_as_uint(l_reg),__float_as_uint(l_reg),false,false);l_reg=__uint_as_float(rr[0])+__uint_as_float(rr[1]);}
  if(hi==0)wsf[32+r32]=l_reg;asm volatile("s_waitcnt lgkmcnt(0)":::"memory");
  float rli[16];
  #pragma unroll
  for(int r=0;r<16;++r)rli[r]=__builtin_amdgcn_rcpf(wsf[32+crow(r,hi)]);
  bf16*stash=(bf16*)(shm+LDS_STASH)+wid*4096;
  if(st==0){
    #pragma unroll
    for(int r=0;r<16;++r){const int orow=crow(r,hi);
      #pragma unroll
      for(int d0=0;d0<4;++d0)stash[orow*128+d0*32+r32]=__float2bfloat16(o[d0][r]*rli[r]);}
  } else {
    asm volatile("s_waitcnt lgkmcnt(0)\n\ts_barrier":::"memory");
    bf16*stg=(bf16*)(shm+LDS_K)+wid*4096;
    #pragma unroll
    for(int r=0;r<16;++r){const int orow=crow(r,hi);
      #pragma unroll
      for(int d0=0;d0<4;++d0)stg[orow*128+d0*32+r32]=__float2bfloat16(o[d0][r]*rli[r]);}
    asm volatile("s_waitcnt lgkmcnt(0)":::"memory");
    bf16*Ow=Ob+(long)(q0+wid*QBLK)*PO;
    const int ch=lane&15; float sgv[8];
    #pragma unroll
    for(int i=0;i<8;++i)sgv[i]=sgp[ch*8+i]*(1.0f-LAMBDA_INIT);
    #pragma unroll
    for(int i=0;i<8;++i){const int row=i*4+(lane>>4);
      const u32x4 a4=*(const u32x4*)(stash+row*128+ch*8), b4=*(const u32x4*)(stg+row*128+ch*8);
      const unsigned aw[4]={a4.x,a4.y,a4.z,a4.w}, bw[4]={b4.x,b4.y,b4.z,b4.w}; float d[8]; float ss=0.f;
      #pragma unroll
      for(int c=0;c<4;++c){ d[2*c]=__uint_as_float(aw[c]<<16)-lam*__uint_as_float(bw[c]<<16); d[2*c+1]=__uint_as_float(aw[c]&0xffff0000u)-lam*__uint_as_float(bw[c]&0xffff0000u); ss+=d[2*c]*d[2*c]+d[2*c+1]*d[2*c+1]; }
      ss+=__shfl_xor(ss,1); ss+=__shfl_xor(ss,2); ss+=__shfl_xor(ss,4); ss+=__shfl_xor(ss,8);
      const float rn=rsqrtf(ss*(1.0f/128.0f)+LN_EPS);
#if OUTPROJ_FP8
      { unsigned char*Ow8=(unsigned char*)Ob+(long)(q0+wid*QBLK+row)*PO+ch*8;
        typedef unsigned u32x2_ __attribute__((ext_vector_type(2))); u32x2_ o8; o8.x=pg8::pk4_fp8(d[0]*rn*sgv[0],d[1]*rn*sgv[1],d[2]*rn*sgv[2],d[3]*rn*sgv[3]); o8.y=pg8::pk4_fp8(d[4]*rn*sgv[4],d[5]*rn*sgv[5],d[6]*rn*sgv[6],d[7]*rn*sgv[7]);
        *(u32x2_*)Ow8=o8; } }
#else
      u32x4 ov; ov.x=cvtpk_s(d[0]*rn*sgv[0],d[1]*rn*sgv[1]); ov.y=cvtpk_s(d[2]*rn*sgv[2],d[3]*rn*sgv[3]); ov.z=cvtpk_s(d[4]*rn*sgv[4],d[5]*rn*sgv[5]); ov.w=cvtpk_s(d[6]*rn*sgv[6],d[7]*rn*sgv[7]);
      ATTN_STORE16(Ow+(long)row*PO+ch*8,ov); }
#endif
  }
  asm volatile("s_waitcnt lgkmcnt(0)\n\ts_barrier":::"memory");
  #undef DMA_K
  #undef DMA_V
  #undef CMASK
  #undef START
  #undef RESC
  #undef ROT
}
constexpr int ATTN_LDS_BYTES=LDS_BYTES;
template<int THRL=8> __device__ __forceinline__ void attn_phase(char*lds,const bf16_t*proj,bf16_t*mix,int vcu,float lam,const float*sgp){
  const int bh=vcu>>3,s8=vcu&7,b=bh>>2,h=bh&3;
  const bf16*P0=(const bf16*)proj+(long)b*SEQ*PQ; bf16*O0=(bf16*)mix+(long)b*SEQ*PO+h*128;
  for(int i=0;i<4;++i){ const int qb=(i<2)?(15-s8):s8, st=i&1;
    attn_unit<THRL>(qb,st,lam,sgp,P0+C_Q+st*256+h*64,P0+C_K+st*256+h*64,P0+C_V+h*128,O0,lds); }
}
#undef SBAR
#undef WAIT_BAR
}

constexpr int NWAVES = 8;
constexpr int RING_OFF = 0, RING_BYTES = 131072;
constexpr int LDSCTL_OFF = 155648, MISC_OFF = LDSCTL_OFF + 320;
constexpr int TAB_OFF = LDSCTL_OFF + 1024;
constexpr int REC_OFF = LDSCTL_OFF + 2048;
constexpr int LDS_BYTES = 163840;
static_assert(pg8::PG8_META_OFF == LDSCTL_OFF + 2048 && pg8::PG8_META_OFF + 3 * pg8::PG8_META_SLOT <= LDS_BYTES && RING_OFF == 0, "GEMM unit-meta ring (overlays the router phase's REC area: different phases)");
static_assert(REC_OFF + (64 + 512) * 4 <= LDS_BYTES && attn_body::ATTN_LDS_BYTES <= LDSCTL_OFF && RING_BYTES <= LDSCTL_OFF, "LDS map");

#define GAS __attribute__((address_space(1)))
#define LAS __attribute__((address_space(3)))
typedef unsigned v4u __attribute__((ext_vector_type(4)));
typedef unsigned v2u __attribute__((ext_vector_type(2)));
typedef float f32x4 __attribute__((ext_vector_type(4)));
typedef float f32x2 __attribute__((ext_vector_type(2)));
typedef short bf16x8 __attribute__((ext_vector_type(8)));
typedef GAS unsigned gu32;
#define RLX_AGENT __ATOMIC_RELAXED, __HIP_MEMORY_SCOPE_AGENT
#define LDS_WAIT() asm volatile("s_waitcnt lgkmcnt(0)" ::: "memory")
#define VM_WAIT() asm volatile("s_waitcnt vmcnt(0)" ::: "memory")

#define XB_TMO      128
#define XB_XCNT(j)  (256  + 64 * (j))
#define XB_XSUB(j)  (1280 + 64 * (j))
#define XB_XGEN(j)  (2304 + 64 * (j))
#define XB_TOP      3328
#define XB_TOPGEN   3392
#define XCD_BAR_WORDS 3456
#define XB_SPIN_CAP (1u << 18)
__device__ __forceinline__ unsigned xb_ld(unsigned* p)              { return __hip_atomic_load(p, __ATOMIC_RELAXED, __HIP_MEMORY_SCOPE_AGENT); }
__device__ __forceinline__ unsigned xb_add(unsigned* p, unsigned v) { return __hip_atomic_fetch_add(p, v, __ATOMIC_RELAXED, __HIP_MEMORY_SCOPE_AGENT); }
__device__ __forceinline__ unsigned xb_xcc_id() { return (unsigned)__builtin_amdgcn_s_getreg((3 << 11) | 20) & 0xFu; }
#define XB_SPIN(cond, bar) do { unsigned _sp = 0; while (cond) { __builtin_amdgcn_s_sleep(1); \
    if ((++_sp & 255u) == 0u) { if (xb_ld(&(bar)[XB_TMO])) break; if (_sp > XB_SPIN_CAP) { atomicAdd(&(bar)[XB_TMO], 1u); break; } } } } while (0)
struct XcdBarrier { unsigned* bar; unsigned x; volatile LAS unsigned* st; };
__device__ __forceinline__ XcdBarrier xcd_barrier_post(unsigned* bar, volatile LAS unsigned* st) {
    XcdBarrier b; b.bar = bar; b.x = xb_xcc_id(); b.st = st;
    if (threadIdx.x == 0) (void)xb_add(&bar[XB_XCNT(b.x)], 1u);
    return b;
}
__device__ __forceinline__ void xcd_barrier_complete(unsigned* bar, unsigned x, unsigned& nloc, unsigned& nx) {
    const unsigned G = gridDim.x * gridDim.y * gridDim.z;
    unsigned sum, cnt, mine, sp = 0u;
    for (;;) {
        sum = 0u; cnt = 0u; mine = 0u;
#pragma unroll
        for (unsigned j = 0; j < 16; ++j) { const unsigned c = xb_ld(&bar[XB_XCNT(j)]); sum += c; cnt += (c > 0u) ? 1u : 0u; mine = (j == x) ? c : mine; }
        if (sum == G) break;
        __builtin_amdgcn_s_sleep(1);
        if ((++sp & 255u) == 0u) { if (xb_ld(&bar[XB_TMO])) break; if (sp > XB_SPIN_CAP) { atomicAdd(&bar[XB_TMO], 1u); break; } }
    }
    nloc = mine > 0u ? mine : 1u; nx = cnt > 0u ? cnt : 1u;
}
__device__ __forceinline__ void xcd_barrier(const XcdBarrier& b) {
    asm volatile("s_waitcnt vmcnt(0)" ::: "memory");
    __syncthreads();
    if (threadIdx.x == 0) {
        unsigned* bar = b.bar;
        __builtin_amdgcn_s_waitcnt(0);
#define XB_INV() asm volatile("buffer_inv sc1" ::: "memory")
        unsigned nloc = b.st[0], nx = b.st[1];
        if (nloc == 0u) { xcd_barrier_complete(bar, b.x, nloc, nx); b.st[0] = nloc; b.st[1] = nx; }
        const unsigned old = xb_add(&bar[XB_XSUB(b.x)], 1u);
        const unsigned gen = old / nloc;
        if (old + 1u == (gen + 1u) * nloc) {
            __builtin_amdgcn_fence(__ATOMIC_RELEASE, "agent");
            asm volatile("s_waitcnt vmcnt(0)" ::: "memory");
            const unsigned og = xb_add(&bar[XB_TOP], 1u);
            const unsigned tg = og / nx;
            const bool lastx = (og + 1u == (tg + 1u) * nx);
            XB_INV();
            if (lastx) xb_add(&bar[XB_TOPGEN], 1u);
            else XB_SPIN(xb_ld(&bar[XB_TOPGEN]) == tg, bar);
            xb_add(&bar[XB_XGEN(b.x)], 1u);
            asm volatile("s_waitcnt vmcnt(0)" ::: "memory");
        } else {
            XB_INV();
            XB_SPIN(xb_ld(&bar[XB_XGEN(b.x)]) == gen, bar);
            asm volatile("s_waitcnt vmcnt(0)" ::: "memory");
        }
    }
    __syncthreads();
#undef XB_INV
}

struct Args { const float* in[22]; float* out; unsigned char* ws; int ph_lo, ph_hi, pad0, pad1; };
struct Frame {
    LAS unsigned char* lds; volatile LAS unsigned* MISC; gu32* ctl;
    int tid, lane, wave, vcu, G;
};

typedef const __attribute__((address_space(4))) Args* kargs_t;
__device__ __forceinline__ Args fetch_args() {
    kargs_t kp = (kargs_t)__builtin_amdgcn_kernarg_segment_ptr();
    asm volatile("" : "+s"(kp));
    Args a;
#pragma unroll
    for (int i = 0; i < 22; ++i) a.in[i] = kp->in[i];
    a.out = kp->out; a.ws = kp->ws; a.ph_lo = kp->ph_lo; a.ph_hi = kp->ph_hi; a.pad0 = kp->pad0; a.pad1 = kp->pad1;
    return a;
}
__device__ __forceinline__ void refresh_frame(Frame& F) { int t = threadIdx.x; asm volatile("" : "+v"(t)); F.tid = t; F.lane = t & 63; F.wave = __builtin_amdgcn_readfirstlane(t >> 6); }

template <int CTRL> __device__ __forceinline__ float dppf(float v) { return __builtin_bit_cast(float, __builtin_amdgcn_update_dpp(0, __builtin_bit_cast(int, v), CTRL, 0xF, 0xF, true)); }
template <int CTRL> __device__ __forceinline__ int dppi(int v) { return __builtin_amdgcn_update_dpp(0, v, CTRL, 0xF, 0xF, true); }
__device__ __forceinline__ float rlf(float v, int l) { return __builtin_bit_cast(float, __builtin_amdgcn_readlane(__builtin_bit_cast(int, v), l)); }
__device__ __forceinline__ float wsum_dpp(float v) {
    v += dppf<0xB1>(v); v += dppf<0x4E>(v); v += dppf<0x141>(v); v += dppf<0x140>(v);
    return (rlf(v, 0) + rlf(v, 16)) + (rlf(v, 32) + rlf(v, 48));
}
__device__ __forceinline__ float wmax_dpp(float v) {
    v = fmaxf(v, dppf<0xB1>(v)); v = fmaxf(v, dppf<0x4E>(v)); v = fmaxf(v, dppf<0x141>(v)); v = fmaxf(v, dppf<0x140>(v));
    return fmaxf(fmaxf(rlf(v, 0), rlf(v, 16)), fmaxf(rlf(v, 32), rlf(v, 48)));
}
__device__ __forceinline__ int wmin_dpp(int v) {
    v = min(v, dppi<0xB1>(v)); v = min(v, dppi<0x4E>(v)); v = min(v, dppi<0x141>(v)); v = min(v, dppi<0x140>(v));
    return min(min(__builtin_amdgcn_readlane(v, 0), __builtin_amdgcn_readlane(v, 16)), min(__builtin_amdgcn_readlane(v, 32), __builtin_amdgcn_readlane(v, 48)));
}

__device__ __forceinline__ void p0_transpose_item(const float* W, int K, int N, bf16_t* WT, long row_off, LAS float* scr, int item, int lane, int nscale = 0) {
    const int nblk = N / 32, kb = item / nblk, nb = item % nblk, k0 = 64 * kb, n0 = 32 * nb; const float sc = (n0 < nscale) ? QSCALE : 1.0f;
#pragma unroll 8
    for (int i = 0; i < 32; ++i) { const int kk = 2 * i + (lane >> 5); scr[kk * 33 + (lane & 31)] = W[(size_t)(k0 + kk) * N + n0 + (lane & 31)]; }
    LDS_WAIT(); asm volatile("" ::: "memory");
    const int c = lane & 7;
#pragma unroll
    for (int j = 0; j < 4; ++j) { const int n = (lane >> 3) + 8 * j; const LAS float* s = scr + (8 * c) * 33 + n;
        v4u o; o.x = pk2(s[0 * 33] * sc, s[1 * 33] * sc); o.y = pk2(s[2 * 33] * sc, s[3 * 33] * sc); o.z = pk2(s[4 * 33] * sc, s[5 * 33] * sc); o.w = pk2(s[6 * 33] * sc, s[7 * 33] * sc);
        *(GAS v4u*)(WT + (size_t)(row_off + n0 + n) * K + k0 + 8 * c) = o; }
    LDS_WAIT(); asm volatile("" ::: "memory");
}
__device__ __forceinline__ void p0_transpose_item8(const float* W, int K, int N, unsigned char* WT, long row_off, LAS float* scr, int item, int lane) {
    const int nblk = N / 32, kb = item / nblk, nb = item % nblk, k0 = 64 * kb, n0 = 32 * nb;
#pragma unroll 8
    for (int i = 0; i < 32; ++i) { const int kk = 2 * i + (lane >> 5); scr[kk * 33 + (lane & 31)] = W[(size_t)(k0 + kk) * N + n0 + (lane & 31)]; }
    LDS_WAIT(); asm volatile("" ::: "memory");
    const int c = lane & 3; constexpr float SC = (float)(1 << pg8::WSHIFT);
#pragma unroll
    for (int j = 0; j < 2; ++j) { const int n = (lane >> 2) + 16 * j; const LAS float* s = scr + (16 * c) * 33 + n;
        v4u o; o.x = pg8::pk4_fp8(s[0 * 33] * SC, s[1 * 33] * SC, s[2 * 33] * SC, s[3 * 33] * SC); o.y = pg8::pk4_fp8(s[4 * 33] * SC, s[5 * 33] * SC, s[6 * 33] * SC, s[7 * 33] * SC);
        o.z = pg8::pk4_fp8(s[8 * 33] * SC, s[9 * 33] * SC, s[10 * 33] * SC, s[11 * 33] * SC); o.w = pg8::pk4_fp8(s[12 * 33] * SC, s[13 * 33] * SC, s[14 * 33] * SC, s[15 * 33] * SC);
        *(GAS v4u*)(WT + (size_t)(row_off + n0 + n) * K + k0 + 16 * c) = o; }
    LDS_WAIT(); asm volatile("" ::: "memory");
}
__device__ __forceinline__ void p0_prologue(Frame& F, const Args& a) {
    LAS float* scr = (LAS float*)(F.lds + RING_OFF + F.wave * 16384);
    const int gw = F.vcu * NWAVES + F.wave, NGW = F.G * NWAVES;
    unsigned char* ws = a.ws;
    constexpr int I_IN = (DM / 64) * (INW / 32), I_O = (DM / 64) * (DM / 32), I_UP1 = (DM / 64) * (2 * DFF / 32), I_DN1 = (DFF / 64) * (DM / 32);
    constexpr int NITEMS = I_IN + I_O + NE * I_UP1 + NE * I_DN1;
#if CONV_IN_ATTN
    constexpr int NITEMS_P0 = I_IN + I_O;
#else
    constexpr int NITEMS_P0 = NITEMS;
#endif
    for (int it = gw; it < NITEMS_P0; it += NGW) {
        int r = it;
        if (r < I_IN) { p0_transpose_item(a.in[1], DM, INW, (bf16_t*)(ws + WS_WIN), 0, scr, r, F.lane, C_K); continue; } r -= I_IN;
#if OUTPROJ_FP8
        if (r < I_O) { p0_transpose_item8(a.in[11], DM, DM, (unsigned char*)(ws + WS_WO), 0, scr, r, F.lane); continue; } r -= I_O;
#else
        if (r < I_O) { p0_transpose_item(a.in[11], DM, DM, (bf16_t*)(ws + WS_WO), 0, scr, r, F.lane); continue; } r -= I_O;
#endif
        if (r < NE * I_UP1) { const int e = r / I_UP1, ii = r % I_UP1; const int n0 = 32 * (ii % (2 * DFF / 32));
            const int bj = n0 / DFF, f = n0 % DFF, rho0 = 256 * (f / 128) + 128 * bj + (f % 128);
#if MOE_FP8
            p0_transpose_item8(a.in[16] + (size_t)e * DM * 2 * DFF, DM, 2 * DFF, (unsigned char*)(ws + WS_WUP) + (size_t)e * 2 * DFF * DM, (long)rho0 - n0, scr, ii, F.lane); continue; }
#else
            p0_transpose_item(a.in[16] + (size_t)e * DM * 2 * DFF, DM, 2 * DFF, (bf16_t*)(ws + WS_WUP) + (size_t)e * 2 * DFF * DM, (long)rho0 - n0, scr, ii, F.lane); continue; }
#endif
        r -= NE * I_UP1;
        { const int e = r / I_DN1, ii = r % I_DN1;
#if MOE_FP8
            p0_transpose_item8(a.in[18] + (size_t)e * DFF * DM, DFF, DM, (unsigned char*)(ws + WS_WDN) + (size_t)e * DM * DFF, 0, scr, ii, F.lane); }
#else
            p0_transpose_item(a.in[18] + (size_t)e * DFF * DM, DFF, DM, (bf16_t*)(ws + WS_WDN) + (size_t)e * DM * DFF, 0, scr, ii, F.lane); }
#endif
    }
    const float* x = a.in[0]; bf16_t* xb = (bf16_t*)(ws + WS_XB);
    for (int m = gw; m < NTOK; m += NGW) {
        const GAS f32x4* xr = (const GAS f32x4*)(x + (size_t)m * DM) + F.lane; GAS v2u* o8 = (GAS v2u*)(xb + (size_t)m * DM) + F.lane;
        f32x4 v[4];
#pragma unroll
        for (int j = 0; j < 4; ++j) v[j] = __builtin_nontemporal_load((const f32x4*)(xr + 64 * j));
#pragma unroll
        for (int j = 0; j < 4; ++j) { v2u o; o.x = pk2(v[j].x, v[j].y); o.y = pk2(v[j].z, v[j].w); o8[64 * j] = o; }
    }
}

struct CItem { const float* W; unsigned char* WT; int N, k0, n0, rowbase; };
__device__ __forceinline__ CItem conv_decode(int r, const Args& a) {
    constexpr int I_UP1 = (DM / 64) * (2 * DFF / 32), I_DN1 = (DFF / 64) * (DM / 32);
    CItem it;
    if (r < NE * I_UP1) { const int e = r / I_UP1, ii = r % I_UP1, nblk = 2 * DFF / 32; it.k0 = 64 * (ii / nblk); it.n0 = 32 * (ii % nblk);
        const int bj = it.n0 / DFF, f = it.n0 % DFF; it.rowbase = 256 * (f / 128) + 128 * bj + (f % 128);
        it.W = a.in[16] + (size_t)e * DM * 2 * DFF; it.WT = a.ws + WS_WUP + (size_t)e * 2 * DFF * DM; it.N = 2 * DFF; return it; }
    r -= NE * I_UP1;
    { const int e = r / I_DN1, ii = r % I_DN1, nblk = DM / 32; it.k0 = 64 * (ii / nblk); it.n0 = 32 * (ii % nblk); it.rowbase = it.n0;
        it.W = a.in[18] + (size_t)e * DFF * DM; it.WT = a.ws + WS_WDN + (size_t)e * DM * DFF; it.N = DM; return it; }
}
__device__ __forceinline__ void conv_load(const CItem& it, int lane, f32x4 (&t)[8]) {
    const int kr = lane >> 3, n4 = (lane & 7) * 4;
#pragma unroll
    for (int i = 0; i < 8; ++i) t[i] = __builtin_nontemporal_load((const f32x4*)(it.W + (size_t)(it.k0 + 8 * i + kr) * it.N + it.n0 + n4));
}
__device__ __forceinline__ void conv_finish(const CItem& it, int lane, const f32x4 (&t)[8], LAS float* scr, v4u (&outv)[2]) {
    const int kr = lane >> 3, n4 = (lane & 7) * 4;
#pragma unroll
    for (int i = 0; i < 8; ++i) { LAS float* d = scr + (8 * i + kr) * 33 + n4; d[0] = t[i].x; d[1] = t[i].y; d[2] = t[i].z; d[3] = t[i].w; }
    LDS_WAIT(); asm volatile("" ::: "memory");
    const int c = lane & 3; constexpr float SC = (float)(1 << pg8::WSHIFT);
#pragma unroll
    for (int j = 0; j < 2; ++j) { const int n = (lane >> 2) + 16 * j; const LAS float* sp = scr + (16 * c) * 33 + n;
        v4u o; o.x = pg8::pk4_fp8(sp[0 * 33] * SC, sp[1 * 33] * SC, sp[2 * 33] * SC, sp[3 * 33] * SC); o.y = pg8::pk4_fp8(sp[4 * 33] * SC, sp[5 * 33] * SC, sp[6 * 33] * SC, sp[7 * 33] * SC);
        o.z = pg8::pk4_fp8(sp[8 * 33] * SC, sp[9 * 33] * SC, sp[10 * 33] * SC, sp[11 * 33] * SC); o.w = pg8::pk4_fp8(sp[12 * 33] * SC, sp[13 * 33] * SC, sp[14 * 33] * SC, sp[15 * 33] * SC);
        outv[j] = o; }
    LDS_WAIT(); asm volatile("" ::: "memory");
}
__device__ __forceinline__ void conv_store(const CItem& it, int lane, const v4u (&outv)[2]) {
    const int c = lane & 3;
#pragma unroll
    for (int j = 0; j < 2; ++j) { const int n = (lane >> 2) + 16 * j; __builtin_nontemporal_store(outv[j], (v4u*)(it.WT + (size_t)(it.rowbase + n) * DM + it.k0 + 16 * c)); }
}
__device__ __forceinline__ void moe_weight_items(Frame& F, const Args& a, int first) {
    LAS float* scr = (LAS float*)(F.lds + RING_OFF + F.wave * 8448);
    const int gw = F.vcu * NWAVES + F.wave, NGW = F.G * NWAVES, lane = F.lane;
    const CItem i0 = conv_decode(gw + (first + 0) * NGW, a), i1 = conv_decode(gw + (first + 1) * NGW, a), i2 = conv_decode(gw + (first + 2) * NGW, a), i3 = conv_decode(gw + (first + 3) * NGW, a);
    const CItem i4 = conv_decode(gw + (first + 4) * NGW, a), i5 = conv_decode(gw + (first + 5) * NGW, a), i6 = conv_decode(gw + (first + 6) * NGW, a), i7 = conv_decode(gw + (first + 7) * NGW, a);
    f32x4 t0[8], t1[8], t2[8], t3[8], t4[8], t5[8];
    conv_load(i0, lane, t0); conv_load(i1, lane, t1); conv_load(i2, lane, t2); conv_load(i3, lane, t3); conv_load(i4, lane, t4); conv_load(i5, lane, t5);
    v4u o0[2], o1[2], o2[2], o3[2], o4[2], o5[2], o6[2], o7[2];
    conv_finish(i0, lane, t0, scr, o0); conv_load(i6, lane, t0);
    conv_finish(i1, lane, t1, scr, o1); conv_load(i7, lane, t1);
    conv_finish(i2, lane, t2, scr, o2); conv_finish(i3, lane, t3, scr, o3); conv_finish(i4, lane, t4, scr, o4); conv_finish(i5, lane, t5, scr, o5);
    conv_finish(i6, lane, t0, scr, o6); conv_finish(i7, lane, t1, scr, o7);
    conv_store(i0, lane, o0); conv_store(i1, lane, o1); conv_store(i2, lane, o2); conv_store(i3, lane, o3); conv_store(i4, lane, o4); conv_store(i5, lane, o5); conv_store(i6, lane, o6); conv_store(i7, lane, o7);
}

__device__ __forceinline__ void gmlp_phase(Frame& F, const Args& a) {
    const bf16_t* proj = (const bf16_t*)(a.ws + WS_PROJ); bf16_t* mix = (bf16_t*)(a.ws + WS_MIX);
    const float *lng = a.in[7], *lnb = a.in[8], *wsp = a.in[9], *bsp = a.in[10];
    LAS f32x2* st = (LAS f32x2*)(F.lds + RING_OFF);
    LAS bf16_t* Vg = (LAS bf16_t*)(F.lds + RING_OFF + 1024);
    LAS bf16_t* Wg = (LAS bf16_t*)(F.lds + RING_OFF + 19456);
    LAS float* Zg = (LAS float*)(F.lds + RING_OFF + 54272);
    const int tid = F.tid, lane = F.lane, w = F.wave;
    const int row = tid >> 2, cq = (tid & 3) * 16;
    for (int c = blockIdx.x; c < NTOK / CHUNK; c += F.G) {
        const size_t row0 = (size_t)c * CHUNK;
        v4u pgv[2], pgu[2]; f32x4 pwv[8], plg[4], plb[4]; float pbb;
#define GMLP_LOAD(g_) do { const int col_ = (g_) * GD + cq; \
            pgv[0] = *(const GAS v4u*)(proj + (row0 + row) * INW + C_GV + col_); pgv[1] = *(const GAS v4u*)(proj + (row0 + row) * INW + C_GV + col_ + 8); \
            pgu[0] = *(const GAS v4u*)(proj + (row0 + row) * INW + C_GU + col_); pgu[1] = *(const GAS v4u*)(proj + (row0 + row) * INW + C_GU + col_ + 8); \
            _Pragma("unroll") for (int k = 0; k < 8; ++k) { const int i_ = tid + 512 * k; pwv[k] = *(const GAS f32x4*)(wsp + ((size_t)(g_) * CHUNK + (i_ >> 5)) * CHUNK + (i_ & 31) * 4); } \
            _Pragma("unroll") for (int k = 0; k < 4; ++k) { plg[k] = *(const GAS f32x4*)(lng + col_ + 4 * k); plb[k] = *(const GAS f32x4*)(lnb + col_ + 4 * k); } \
            pbb = bsp[(g_) * CHUNK + row]; } while (0)
        GMLP_LOAD(0);
        {
            v4u raw[16];
#pragma unroll
            for (int i = 0; i < 16; ++i) raw[i] = *(const GAS v4u*)(proj + (row0 + 16 * w + i) * INW + C_GV + lane * 8);
#pragma unroll
            for (int i = 0; i < 16; ++i) {
                const unsigned rw[4] = {raw[i].x, raw[i].y, raw[i].z, raw[i].w}; float v[8]; float sum = 0.f;
#pragma unroll
                for (int k = 0; k < 4; ++k) { const f32x2 gg = (f32x2){bf2f((bf16_t)(rw[k] & 0xffff)), bf2f((bf16_t)(rw[k] >> 16))}; v[2 * k] = gg.x; v[2 * k + 1] = gg.y; sum += gg.x + gg.y; }
                const float mean = wsum_dpp(sum) * (1.0f / GW); float q = 0.f;
#pragma unroll
                for (int k = 0; k < 8; ++k) { const float d = v[k] - mean; q += d * d; }
                const float var = wsum_dpp(q) * (1.0f / GW);
                if (lane == 0) st[16 * w + i] = (f32x2){mean, rsqrtf(var + LN_EPS)};
            }
        }
        __syncthreads();
        for (int g = 0; g < NG; ++g) {
            const int col = g * GD + cq;
            const v4u cgu0 = pgu[0], cgu1 = pgu[1]; const float bb = pbb;
            {
                const f32x2 ms = st[row]; unsigned ow[8];
#pragma unroll
                for (int hh = 0; hh < 2; ++hh) { const unsigned rw[4] = {pgv[hh].x, pgv[hh].y, pgv[hh].z, pgv[hh].w};
#pragma unroll
                    for (int i = 0; i < 4; ++i) { const f32x2 gg = (f32x2){bf2f((bf16_t)(rw[i] & 0xffff)), bf2f((bf16_t)(rw[i] >> 16))};
                        const int e = hh * 8 + 2 * i; const f32x4 lg = plg[e >> 2], lb = plb[e >> 2];
                        const float g0 = (e & 2) ? lg.z : lg.x, g1 = (e & 2) ? lg.w : lg.y, b0 = (e & 2) ? lb.z : lb.x, b1 = (e & 2) ? lb.w : lb.y;
                        ow[hh * 4 + i] = pk2((gg.x - ms.x) * ms.y * g0 + b0, (gg.y - ms.x) * ms.y * g1 + b1); } }
                { const int sx = row ^ ((cq >> 4) << 4);
#pragma unroll
                  for (int e = 0; e < 8; ++e) { Vg[(cq + 2 * e) * 136 + sx] = (bf16_t)(ow[e] & 0xffffu); Vg[(cq + 2 * e + 1) * 136 + sx] = (bf16_t)(ow[e] >> 16); } }
#pragma unroll
                for (int k = 0; k < 8; ++k) { const int i = tid + 512 * k, t = i >> 5, s4 = (i & 31) * 4; const f32x4 wv = pwv[k];
                    v2u o; o.x = pk2(s4 <= t ? wv.x : 0.f, s4 + 1 <= t ? wv.y : 0.f); o.y = pk2(s4 + 2 <= t ? wv.z : 0.f, s4 + 3 <= t ? wv.w : 0.f);
                    *(LAS v2u*)(Wg + t * 136 + s4) = o; }
            }
            if (g + 1 < NG) GMLP_LOAD(g + 1);
            __syncthreads();
            {
                f32x4 acc[4];
#pragma unroll
                for (int n = 0; n < 4; ++n) acc[n] = (f32x4){0.f, 0.f, 0.f, 0.f};
                const int t0 = 16 * w, fr = lane & 15, fq = lane >> 4;
                for (int ks = 0; ks * 32 <= t0 + 15; ++ks) {
                    const bf16x8 af = *(const LAS bf16x8*)(Wg + (t0 + fr) * 136 + ks * 32 + fq * 8);
#pragma unroll
                    for (int n = 0; n < 4; ++n) { const bf16x8 bfv = *(const LAS bf16x8*)(Vg + (n * 16 + fr) * 136 + ((ks * 32 + fq * 8) ^ (n << 4)));
                        acc[n] = __builtin_amdgcn_mfma_f32_16x16x32_bf16(af, bfv, acc[n], 0, 0, 0); }
                }
#pragma unroll
                for (int n = 0; n < 4; ++n)
#pragma unroll
                    for (int r = 0; r < 4; ++r) Zg[(t0 + fq * 4 + r) * 68 + n * 16 + fr] = acc[n][r];
            }
            __syncthreads();
            {
#if OUTPROJ_FP8
                float ov_[16];
#pragma unroll
                for (int hh = 0; hh < 2; ++hh) { const v4u rawu = hh ? cgu1 : cgu0; const unsigned rw[4] = {rawu.x, rawu.y, rawu.z, rawu.w};
#pragma unroll
                    for (int i = 0; i < 4; ++i) { const f32x2 uu = (f32x2){bf2f((bf16_t)(rw[i] & 0xffff)), bf2f((bf16_t)(rw[i] >> 16))};
                        const f32x2 zz = *(const LAS f32x2*)(Zg + row * 68 + cq + hh * 8 + 2 * i);
                        ov_[hh * 8 + 2 * i] = uu.x * (zz.x + bb); ov_[hh * 8 + 2 * i + 1] = uu.y * (zz.y + bb); } }
                *(GAS v4u*)((unsigned char*)mix + (size_t)(row0 + row) * DM + GW + col) = (v4u){pg8::pk4_fp8(ov_[0], ov_[1], ov_[2], ov_[3]), pg8::pk4_fp8(ov_[4], ov_[5], ov_[6], ov_[7]),
                                                                                              pg8::pk4_fp8(ov_[8], ov_[9], ov_[10], ov_[11]), pg8::pk4_fp8(ov_[12], ov_[13], ov_[14], ov_[15])};
#else
                unsigned ow[8];
#pragma unroll
                for (int hh = 0; hh < 2; ++hh) { const v4u rawu = hh ? cgu1 : cgu0; const unsigned rw[4] = {rawu.x, rawu.y, rawu.z, rawu.w};
#pragma unroll
                    for (int i = 0; i < 4; ++i) { const f32x2 uu = (f32x2){bf2f((bf16_t)(rw[i] & 0xffff)), bf2f((bf16_t)(rw[i] >> 16))};
                        const f32x2 zz = *(const LAS f32x2*)(Zg + row * 68 + cq + hh * 8 + 2 * i);
                        ow[hh * 4 + i] = pk2(uu.x * (zz.x + bb), uu.y * (zz.y + bb)); } }
                GAS v4u* dst = (GAS v4u*)(mix + (row0 + row) * DM + GW + col);
                dst[0] = (v4u){ow[0], ow[1], ow[2], ow[3]}; dst[1] = (v4u){ow[4], ow[5], ow[6], ow[7]};
#endif
            }
        }
        __syncthreads();
#undef GMLP_LOAD
    }
}

__device__ __forceinline__ void attn_combine_phase(Frame& F, const Args& a) {
    const bf16_t* atto = (const bf16_t*)(a.ws + WS_ATTO); bf16_t* mix = (bf16_t*)(a.ws + WS_MIX);
    const int lane = F.lane, gw = F.vcu * NWAVES + F.wave, NGW = F.G * NWAVES;
    const float lam = expf(wave_sum(a.in[2][lane] * a.in[3][lane])) - expf(wave_sum(a.in[4][lane] * a.in[5][lane])) + LAMBDA_INIT;
    const int h = lane >> 4, e0 = (lane & 15) * 8;
    float sg[8];
#pragma unroll
    for (int i = 0; i < 8; ++i) sg[i] = a.in[6][e0 + i] * (1.0f - LAMBDA_INIT);
    for (int t = gw; t < NTOK; t += NGW) {
        const v4u r1 = *(const GAS v4u*)(atto + (size_t)t * DM + h * 256 + e0), r2 = *(const GAS v4u*)(atto + (size_t)t * DM + h * 256 + 128 + e0);
        const unsigned w1[4] = {r1.x, r1.y, r1.z, r1.w}, w2[4] = {r2.x, r2.y, r2.z, r2.w};
        float d[8]; float ss = 0.f;
#pragma unroll
        for (int i = 0; i < 4; ++i) { d[2 * i] = bf2f((bf16_t)(w1[i] & 0xffff)) - lam * bf2f((bf16_t)(w2[i] & 0xffff)); d[2 * i + 1] = bf2f((bf16_t)(w1[i] >> 16)) - lam * bf2f((bf16_t)(w2[i] >> 16)); ss += d[2 * i] * d[2 * i] + d[2 * i + 1] * d[2 * i + 1]; }
        ss += __shfl_xor(ss, 1); ss += __shfl_xor(ss, 2); ss += __shfl_xor(ss, 4); ss += __shfl_xor(ss, 8);
        const float r = rsqrtf(ss * (1.0f / DV) + LN_EPS);
        v4u o; o.x = pk2(d[0] * r * sg[0], d[1] * r * sg[1]); o.y = pk2(d[2] * r * sg[2], d[3] * r * sg[3]); o.z = pk2(d[4] * r * sg[4], d[5] * r * sg[5]); o.w = pk2(d[6] * r * sg[6], d[7] * r * sg[7]);
        *(GAS v4u*)(mix + (size_t)t * DM + h * DV + e0) = o;
    }
}

__device__ __forceinline__ void route_phase(Frame& F, const Args& a) {
    const bf16_t* h1 = (const bf16_t*)(a.ws + WS_H1); bf16_t* xb = (bf16_t*)(a.ws + WS_XB); bf16_t* x1b = (bf16_t*)(a.ws + WS_X1B);
    int* list = (int*)(a.ws + WS_LIST); int* re = (int*)(a.ws + WS_RE); int* rr = (int*)(a.ws + WS_RR); float* rg = (float*)(a.ws + WS_RG);
    const float *g1 = a.in[12], *b1 = a.in[13], *wr = a.in[14], *br = a.in[15];
    constexpr int XS = 1028;
    LAS float* XT = (LAS float*)(F.lds + RING_OFF);
    LAS float* PT = (LAS float*)(F.lds + RING_OFF + 16 * XS * 4);
    LAS float* LT = (LAS float*)(F.lds + RING_OFF + 16 * XS * 4 + 8 * 16 * 32 * 4);
    LAS int* lcnt = (LAS int*)(F.lds + REC_OFF); LAS int* lbase = lcnt + 32; LAS int* rec = lcnt + 64;
    const int tid = F.tid, lane = F.lane, w = F.wave, fr = lane & 15, fq = lane >> 4;
    if (tid < 32) lcnt[tid] = 0;
    constexpr int RPB = NTOK / 256;
    const int tblk = blockIdx.x * RPB;
    v2u praw[2][4];
#define ROUTE_LOAD(ch_) do { _Pragma("unroll") for (int q = 0; q < 2; ++q) _Pragma("unroll") for (int j = 0; j < 4; ++j) \
        praw[q][j] = *(const GAS v2u*)(h1 + (size_t)(tblk + (ch_) * 16 + 2 * w + q) * DM + j * 256 + lane * 4); } while (0)
    ROUTE_LOAD(0);
    bf16x8 bwh[4][2], bwl[4][2];
#pragma unroll
    for (int ks = 0; ks < 4; ++ks)
#pragma unroll
        for (int n = 0; n < 2; ++n) { float wv[8];
#pragma unroll
            for (int j = 0; j < 8; ++j) wv[j] = wr[(size_t)(128 * w + 32 * ks + 8 * fq + j) * NE + 16 * n + fr];
            unsigned hh[4], ll[4];
#pragma unroll
            for (int j = 0; j < 4; ++j) { hh[j] = pk2(wv[2 * j], wv[2 * j + 1]);
                ll[j] = pk2(wv[2 * j] - __uint_as_float(hh[j] << 16), wv[2 * j + 1] - __uint_as_float(hh[j] & 0xffff0000u)); }
            bwh[ks][n] = __builtin_bit_cast(bf16x8, (v4u){hh[0], hh[1], hh[2], hh[3]}); bwl[ks][n] = __builtin_bit_cast(bf16x8, (v4u){ll[0], ll[1], ll[2], ll[3]}); }
    const int myexp = lane & 31; const float mybr = br[myexp];
    f32x4 g1v[4], b1v[4];
#pragma unroll
    for (int j = 0; j < 4; ++j) { g1v[j] = *(const GAS f32x4*)(g1 + j * 256 + lane * 4); b1v[j] = *(const GAS f32x4*)(b1 + j * 256 + lane * 4); }
    for (int ch = 0; ch < 8; ++ch) {
        const int t0 = tblk + ch * 16;
        {
            f32x4 pv[2][4];
#pragma unroll
            for (int q = 0; q < 2; ++q)
#pragma unroll
                for (int j = 0; j < 4; ++j) { const v2u hw_ = praw[q][j]; pv[q][j] = (f32x4){__uint_as_float(hw_.x << 16), __uint_as_float(hw_.x & 0xffff0000u), __uint_as_float(hw_.y << 16), __uint_as_float(hw_.y & 0xffff0000u)}; }
            float mean[2], rstd[2];
#pragma unroll
            for (int q = 0; q < 2; ++q) { float s = 0.f;
#pragma unroll
                for (int j = 0; j < 4; ++j) s += (pv[q][j].x + pv[q][j].y) + (pv[q][j].z + pv[q][j].w);
                mean[q] = wsum_dpp(s) * (1.0f / DM); }
#pragma unroll
            for (int q = 0; q < 2; ++q) { float q2 = 0.f;
#pragma unroll
                for (int j = 0; j < 4; ++j) { pv[q][j] = pv[q][j] - mean[q]; q2 += (pv[q][j].x * pv[q][j].x + pv[q][j].y * pv[q][j].y) + (pv[q][j].z * pv[q][j].z + pv[q][j].w * pv[q][j].w); }
                rstd[q] = rsqrtf(wsum_dpp(q2) * (1.0f / DM) + LN_EPS); }
            if (lane == 0) {
#pragma unroll
                for (int q = 0; q < 2; ++q) *(GAS f32x2*)((float*)(a.ws + WS_ST) + 2 * (t0 + 2 * w + q)) = (f32x2){mean[q], rstd[q]}; }
#pragma unroll
            for (int j = 0; j < 4; ++j) {
                const int col = j * 256 + lane * 4;
                const f32x4 gq = g1v[j], bq = b1v[j];
#pragma unroll
                for (int q = 0; q < 2; ++q) {
                    const int rl = 2 * w + q, t = t0 + rl;
                    const f32x4 o = pv[q][j] * rstd[q] * gq + bq;
                    *(LAS f32x4*)(XT + rl * XS + col) = o;
#if MOE_FP8
                    *(GAS unsigned*)((unsigned char*)xb + (size_t)t * DM + col) = pg8::pk4_fp8(o.x, o.y, o.z, o.w);
#else
                    v2u pk; pk.x = pk2(o.x, o.y); pk.y = pk2(o.z, o.w);
                    *(GAS v2u*)(xb + (size_t)t * DM + col) = pk;
#endif
                }
            }
        }
        if (ch < 7) ROUTE_LOAD(ch + 1);
        __syncthreads();
        {
            f32x4 acc0 = (f32x4){0.f, 0.f, 0.f, 0.f}, acc1 = (f32x4){0.f, 0.f, 0.f, 0.f};
            const LAS float* xp = XT + fr * XS + 128 * w + 8 * fq;
#pragma unroll
            for (int ks = 0; ks < 4; ++ks) { const f32x4 x0 = *(const LAS f32x4*)(xp + 32 * ks), x1 = *(const LAS f32x4*)(xp + 32 * ks + 4);
                unsigned hh[4], ll[4];
                hh[0] = pk2(x0.x, x0.y); hh[1] = pk2(x0.z, x0.w); hh[2] = pk2(x1.x, x1.y); hh[3] = pk2(x1.z, x1.w);
                ll[0] = pk2(x0.x - __uint_as_float(hh[0] << 16), x0.y - __uint_as_float(hh[0] & 0xffff0000u)); ll[1] = pk2(x0.z - __uint_as_float(hh[1] << 16), x0.w - __uint_as_float(hh[1] & 0xffff0000u));
                ll[2] = pk2(x1.x - __uint_as_float(hh[2] << 16), x1.y - __uint_as_float(hh[2] & 0xffff0000u)); ll[3] = pk2(x1.z - __uint_as_float(hh[3] << 16), x1.w - __uint_as_float(hh[3] & 0xffff0000u));
                const bf16x8 ah = __builtin_bit_cast(bf16x8, (v4u){hh[0], hh[1], hh[2], hh[3]}), al = __builtin_bit_cast(bf16x8, (v4u){ll[0], ll[1], ll[2], ll[3]});
                acc0 = __builtin_amdgcn_mfma_f32_16x16x32_bf16(ah, bwh[ks][0], acc0, 0, 0, 0); acc1 = __builtin_amdgcn_mfma_f32_16x16x32_bf16(ah, bwh[ks][1], acc1, 0, 0, 0);
                acc0 = __builtin_amdgcn_mfma_f32_16x16x32_bf16(ah, bwl[ks][0], acc0, 0, 0, 0); acc1 = __builtin_amdgcn_mfma_f32_16x16x32_bf16(ah, bwl[ks][1], acc1, 0, 0, 0);
                acc0 = __builtin_amdgcn_mfma_f32_16x16x32_bf16(al, bwh[ks][0], acc0, 0, 0, 0); acc1 = __builtin_amdgcn_mfma_f32_16x16x32_bf16(al, bwh[ks][1], acc1, 0, 0, 0); }
#pragma unroll
            for (int r = 0; r < 4; ++r) { PT[(w * 16 + fq * 4 + r) * 32 + fr] = acc0[r]; PT[(w * 16 + fq * 4 + r) * 32 + 16 + fr] = acc1[r]; }
        }
        __syncthreads();
        {
            float cur[2];
#pragma unroll
            for (int q = 0; q < 2; ++q) { cur[q] = mybr;
#pragma unroll
                for (int ww = 0; ww < 8; ++ww) cur[q] += PT[(ww * 16 + 2 * w + q) * 32 + myexp]; }
            if (lane < 32) {
#pragma unroll
                for (int q = 0; q < 2; ++q) LT[(ch * 16 + 2 * w + q) * 33 + myexp] = cur[q]; }
        }
    }
#undef ROUTE_LOAD
    __syncthreads();
    if (lane < 16) {
        const int rl = 16 * w + lane, t = tblk + rl; const LAS float* lr_ = LT + rl * 33;
        float lv[32];
#pragma unroll
        for (int e = 0; e < 32; ++e) lv[e] = lr_[e];
        int idx[4]; float val[4];
#pragma unroll
        for (int k = 0; k < 4; ++k) { float m = lv[0]; int bi = 0;
#pragma unroll
            for (int e = 1; e < 32; ++e) { const bool gt = lv[e] > m; m = gt ? lv[e] : m; bi = gt ? e : bi; }
            idx[k] = bi; val[k] = m;
#pragma unroll
            for (int e = 0; e < 32; ++e) lv[e] = (e == bi) ? -INFINITY : lv[e]; }
        float ex[4], se = 0.f;
#pragma unroll
        for (int k = 0; k < 4; ++k) { ex[k] = expf(val[k] - val[0]); se += ex[k]; }
#pragma unroll
        for (int k = 0; k < 4; ++k) {
            const int lrk = __hip_atomic_fetch_add(lcnt + idx[k], 1, __ATOMIC_RELAXED, __HIP_MEMORY_SCOPE_WORKGROUP);
            rec[rl * 4 + k] = idx[k] | (lrk << 8);
            re[t * 4 + k] = idx[k]; rg[t * 4 + k] = ex[k] / se; }
    }
    __syncthreads();
    if (tid < 32) lbase[tid] = (int)__hip_atomic_fetch_add((unsigned*)(F.ctl + CW_CNT + tid), (unsigned)lcnt[tid], RLX_AGENT);
    __syncthreads();
    { const int rw = tid >> 2, k = tid & 3; const int t = tblk + rw; const int rc = rec[tid]; const int e_ = rc & 255, r_ = lbase[e_] + (rc >> 8);
      rr[t * 4 + k] = r_; list[e_ * NTOK + r_] = t; }
}
__device__ __forceinline__ void build_tab(Frame& F) {
    LAS int* tab = (LAS int*)(F.lds + TAB_OFF);
    if (F.tid < 32) tab[40 + F.tid] = (int)__hip_atomic_load(F.ctl + CW_CNT + F.tid, RLX_AGENT);
    __syncthreads();
    if (F.tid == 0) { int p = 0; for (int e = 0; e < NE; ++e) { tab[e] = p; p += (tab[40 + e] + 255) >> 8; } tab[NE] = p; }
    __syncthreads();
}
__device__ __forceinline__ void combine_phase(Frame& F, const Args& a) {
    const bf16_t* x1 = (const bf16_t*)(a.ws + WS_H1); const unsigned char* y = (const unsigned char*)(a.ws + WS_Y);
    const float* stv = (const float*)(a.ws + WS_ST);
    const int* re = (const int*)(a.ws + WS_RE); const int* rr = (const int*)(a.ws + WS_RR); const float* rg = (const float*)(a.ws + WS_RG);
    float* out = a.out;
    const LAS int* tab = (const LAS int*)(F.lds + TAB_OFF);
    const int lane = F.lane, gw = F.vcu * NWAVES + F.wave, NGW = F.G * NWAVES, c0 = lane * 16;
    f32x4 g2v[4], b2v[4];
#pragma unroll
    for (int j = 0; j < 4; ++j) { g2v[j] = *(const GAS f32x4*)(a.in[20] + c0 + 4 * j); b2v[j] = *(const GAS f32x4*)(a.in[21] + c0 + 4 * j); }
    float g1c[16], b1c[16];
#pragma unroll
    for (int j = 0; j < 4; ++j) { const f32x4 gq = *(const GAS f32x4*)(a.in[12] + c0 + 4 * j), bq = *(const GAS f32x4*)(a.in[13] + c0 + 4 * j);
        g1c[4 * j] = gq.x; g1c[4 * j + 1] = gq.y; g1c[4 * j + 2] = gq.z; g1c[4 * j + 3] = gq.w; b1c[4 * j] = bq.x; b1c[4 * j + 1] = bq.y; b1c[4 * j + 2] = bq.z; b1c[4 * j + 3] = bq.w; }
    for (int tt = gw; tt < NTOK; tt += 2 * NGW) {
        float v[2][16];
#pragma unroll
        for (int q = 0; q < 2; ++q) {
            const int t = tt + q * NGW;
            const v4u xa = *(const GAS v4u*)(x1 + (size_t)t * DM + c0), xb_ = *(const GAS v4u*)(x1 + (size_t)t * DM + c0 + 8);
            const unsigned xw[8] = {xa.x, xa.y, xa.z, xa.w, xb_.x, xb_.y, xb_.z, xb_.w};
            const f32x2 st_ = *(const GAS f32x2*)(stv + 2 * t);
#pragma unroll
            for (int i = 0; i < 8; ++i) { v[q][2 * i] = ALPHA * ((bf2f((bf16_t)(xw[i] & 0xffff)) - st_.x) * st_.y * g1c[2 * i] + b1c[2 * i]); v[q][2 * i + 1] = ALPHA * ((bf2f((bf16_t)(xw[i] >> 16)) - st_.x) * st_.y * g1c[2 * i + 1] + b1c[2 * i + 1]); }
#pragma unroll
            for (int k = 0; k < 4; ++k) {
                const int e = re[t * 4 + k], slot = tab[e] * 256 + rr[t * 4 + k]; const float g = rg[t * 4 + k];
#if MOE_FP8
                const v4u yw = *(const GAS v4u*)(y + (size_t)slot * DM + c0); const unsigned yy[4] = {yw.x, yw.y, yw.z, yw.w};
#pragma unroll
                for (int i = 0; i < 4; ++i) { const f32x2 lo = __builtin_amdgcn_cvt_pk_f32_fp8((int)yy[i], false), hi = __builtin_amdgcn_cvt_pk_f32_fp8((int)yy[i], true);
                    v[q][4 * i] = fmaf(g, lo.x, v[q][4 * i]); v[q][4 * i + 1] = fmaf(g, lo.y, v[q][4 * i + 1]); v[q][4 * i + 2] = fmaf(g, hi.x, v[q][4 * i + 2]); v[q][4 * i + 3] = fmaf(g, hi.y, v[q][4 * i + 3]); }
#else
                const v4u ya = *(const GAS v4u*)((const bf16_t*)y + (size_t)slot * DM + c0), yb = *(const GAS v4u*)((const bf16_t*)y + (size_t)slot * DM + c0 + 8);
                const unsigned yy[8] = {ya.x, ya.y, ya.z, ya.w, yb.x, yb.y, yb.z, yb.w};
#pragma unroll
                for (int i = 0; i < 8; ++i) { v[q][2 * i] = fmaf(g, bf2f((bf16_t)(yy[i] & 0xffff)), v[q][2 * i]); v[q][2 * i + 1] = fmaf(g, bf2f((bf16_t)(yy[i] >> 16)), v[q][2 * i + 1]); }
#endif
            }
        }
#pragma unroll
        for (int q = 0; q < 2; ++q) {
            const int t = tt + q * NGW;
            float s = 0.f;
#pragma unroll
            for (int i = 0; i < 16; ++i) s += v[q][i];
            const float mean = wsum_dpp(s) * (1.0f / DM); float q2 = 0.f;
#pragma unroll
            for (int i = 0; i < 16; ++i) { v[q][i] -= mean; q2 += v[q][i] * v[q][i]; }
            const float rstd = rsqrtf(wsum_dpp(q2) * (1.0f / DM) + LN_EPS);
#pragma unroll
            for (int j = 0; j < 4; ++j)
                *(GAS f32x4*)(out + (size_t)t * DM + c0 + 4 * j) = (f32x4){v[q][4 * j] * rstd * g2v[j].x + b2v[j].x, v[q][4 * j + 1] * rstd * g2v[j].y + b2v[j].y, v[q][4 * j + 2] * rstd * g2v[j].z + b2v[j].z, v[q][4 * j + 3] * rstd * g2v[j].w + b2v[j].w};
        }
    }
}

#ifndef ALIGN_H1
#define ALIGN_H1 true
#endif
#ifndef ALIGN_UP
#define ALIGN_UP true
#endif
#ifndef META_UP
#define META_UP false
#endif
#ifndef META_DN
#define META_DN false
#endif
constexpr int N_PHASES = 9;
__global__ void __launch_bounds__(NWAVES * 64, 2) mega_fwd(Args args) {
    extern __shared__ __attribute__((aligned(16))) unsigned char lds[];
    Frame F;
    F.lds = (LAS unsigned char*)lds;
    F.MISC = (volatile LAS unsigned*)(F.lds + MISC_OFF);
    F.tid = threadIdx.x; F.lane = F.tid & 63; F.wave = __builtin_amdgcn_readfirstlane(F.tid >> 6);
    F.G = gridDim.x; { const int bx = blockIdx.x; F.vcu = (F.G % 8 == 0) ? (bx % 8) * (F.G / 8) + bx / 8 : bx; }
    F.ctl = (gu32*)(args.ws + WS_CTL);
    for (int u = F.tid; u < (LDS_BYTES - LDSCTL_OFF) / 4; u += NWAVES * 64) ((LAS unsigned*)(F.lds + LDSCTL_OFF))[u] = 0u;
    __syncthreads();
    const int lo = args.ph_lo, hi = args.ph_hi;
    const bool multi = (hi - lo) > 1;
    XcdBarrier bar; bar.bar = (unsigned*)(F.ctl + CW_BAR); bar.x = 0; bar.st = nullptr;
    if (multi) bar = xcd_barrier_post((unsigned*)(F.ctl + CW_BAR), F.MISC + 8);
#ifndef PH_MASK
#define PH_MASK 0x1FF
#endif
#define IN(k) ((((PH_MASK) >> (k)) & 1) && lo <= (k) && (k) < hi)
#define SEAM(k) do { if (IN(k) && IN((k) + 1)) xcd_barrier(bar); } while (0)
#ifndef DOUBLE_MASK
#define DOUBLE_MASK 0
#endif
#define REP(k) for (int rep_ = 0; rep_ < ((((DOUBLE_MASK) >> (k)) & 1) + 1); ++rep_)
#if defined(PROBE_M0)
    if (IN(0) && blockIdx.x == 0 && F.wave == 0) {
        const Args A = fetch_args();
        LAS unsigned* hi = (LAS unsigned*)(F.lds + 0x26800); LAS unsigned* lo = (LAS unsigned*)(F.lds + 0x6800);
        for (int i = F.lane; i < 256; i += 64) { hi[i] = 0u; lo[i] = 0u; }
        asm volatile("s_waitcnt lgkmcnt(0)" ::: "memory");
        { unsigned keep_; const char* sb = (const char*)A.in[0]; unsigned vo = F.lane * 16u, dst = 0x26800u;
          asm volatile("s_mov_b32 %0, m0\n\ts_mov_b32 m0, %3\n\ts_nop 0\n\tglobal_load_lds_dwordx4 %1, %2\n\ts_mov_b32 m0, %0" : "=&s"(keep_) : "v"(vo), "s"(sb), "s"(dst) : "memory"); }
        asm volatile("s_waitcnt vmcnt(0)" ::: "memory");
        unsigned nzh = 0u, nzl = 0u;
        for (int i = F.lane; i < 256; i += 64) { nzh |= ((volatile LAS unsigned*)hi)[i]; nzl |= ((volatile LAS unsigned*)lo)[i]; }
        const bool landed_high = __any(nzh != 0u);
#if PROBE_M0 == 2
        const bool delay = landed_high;
#else
        const bool delay = !landed_high;
#endif
        if (delay) { const unsigned long long t0 = __builtin_amdgcn_s_memrealtime(); while (__builtin_amdgcn_s_memrealtime() - t0 < 30000ull) __builtin_amdgcn_s_sleep(8); }
        for (int i = F.lane; i < 256; i += 64) { hi[i] = 0u; lo[i] = 0u; }
        asm volatile("s_waitcnt lgkmcnt(0)" ::: "memory");
    }
    __syncthreads();
#endif
    if (IN(0)) { REP(0) { refresh_frame(F); const Args A = fetch_args(); p0_prologue(F, A); } SEAM(0); }
    if (IN(1)) { REP(1) {
        refresh_frame(F); const Args A = fetch_args(); unsigned char* ws = A.ws;
        pg8::Gemm g{(const bf16_t*)(ws + WS_XB), (const bf16_t*)(ws + WS_WIN), NTOK, INW, DM, 0}; pg8::StaticOrder S; S.init(NTOK, INW, F.G, (int)blockIdx.x);
        pg8::EpiProj E{(bf16_t*)(ws + WS_PROJ)};
        pg8::gemm_phase<pg8::EpiProj, pg8::StaticOrder, false>(F.lds + RING_OFF, g, S, E);
        } SEAM(1);
    }
    if (IN(2)) { REP(2) {
        refresh_frame(F); const Args A = fetch_args(); unsigned char* ws = A.ws;
#ifndef P2_REP_SUB
#define P2_REP_SUB 3
#endif
        const int sub_ = (rep_ == 0) ? A.pad0 : (A.pad0 & P2_REP_SUB);
        if (sub_ & 1) { const float lam = expf(wave_sum(A.in[2][F.lane] * A.in[3][F.lane])) - expf(wave_sum(A.in[4][F.lane] * A.in[5][F.lane])) + LAMBDA_INIT;
#if CONV_IN_ATTN
            {
                const int vcu = F.vcu, bh = vcu >> 3, s8 = vcu & 7, b = bh >> 2, h = bh & 3;
                const attn_body::bf16* P0 = (const attn_body::bf16*)(ws + WS_PROJ) + (long)b * SEQ * INW;
#if OUTPROJ_FP8
                attn_body::bf16* O0 = (attn_body::bf16*)(ws + WS_MIX + (size_t)b * SEQ * DM + h * 128);
#else
                attn_body::bf16* O0 = (attn_body::bf16*)(ws + WS_MIX) + (long)b * SEQ * DM + h * 128;
#endif

                for (int i = 0; i < 4; ++i) { const int qb = (i < 2) ? (15 - s8) : s8, st = i & 1;
                    attn_body::attn_unit<8>(qb, st, lam, A.in[6], P0 + C_Q + st * 256 + h * 64, P0 + C_K + st * 256 + h * 64, P0 + C_V + h * 128, O0, (char*)lds + RING_OFF);
                    if (rep_ == 0 && i < 3) { moe_weight_items(F, A, 8 * i); __syncthreads(); } }
            }
#else
            attn_body::attn_phase<8>((char*)lds + RING_OFF, (const bf16_t*)(ws + WS_PROJ), (bf16_t*)(ws + WS_MIX), F.vcu, lam, A.in[6]);
#endif
            }
        if (sub_ & 2) gmlp_phase(F, A);
        }
    }
    if (IN(3)) { SEAM(3); }
    if (IN(4)) { REP(4) {
        refresh_frame(F); const Args A = fetch_args(); unsigned char* ws = A.ws;
        pg8::Gemm g{(const bf16_t*)(ws + WS_MIX), (const bf16_t*)(ws + WS_WO), NTOK, DM, DM, 0}; pg8::StaticOrder S; S.init(NTOK, DM, F.G, (int)blockIdx.x);
#if OUTPROJ_FP8
        pg8::EpiH1 E{(const bf16_t*)(ws + WS_XB), (bf16_t*)(ws + WS_H1), pg8::WUNSCALE};
        pg8::gemm_phase<pg8::EpiH1, pg8::StaticOrder, false, true, false, ALIGN_H1>(F.lds + RING_OFF, g, S, E);
#else
        pg8::EpiH1 E{(const bf16_t*)(ws + WS_XB), (bf16_t*)(ws + WS_H1), 1.0f};
        pg8::gemm_phase<pg8::EpiH1, pg8::StaticOrder, false, false, false, ALIGN_H1>(F.lds + RING_OFF, g, S, E);
#endif
        } SEAM(4);
    }
    if (IN(5)) { REP(5) { refresh_frame(F); const Args A = fetch_args(); route_phase(F, A); } SEAM(5); }
    if (IN(6)) { REP(6) {
        refresh_frame(F); const Args A = fetch_args(); unsigned char* ws = A.ws;
        build_tab(F);
        pg8::MoeOrder S; S.init((const LAS int*)(F.lds + TAB_OFF), (const int*)(ws + WS_LIST), 8, (int)blockIdx.x);
#if MOE_FP8
        pg8::Gemm g{(const bf16_t*)(ws + WS_XB), (const bf16_t*)(ws + WS_WUP), PADROWS, 2 * DFF, DM, (size_t)2 * DFF * DM / 2};
        pg8::EpiSwiglu8 E{(unsigned char*)(ws + WS_ACT), A.in[17]};
        pg8::gemm_phase<pg8::EpiSwiglu8, pg8::MoeOrder, true, true, META_UP, ALIGN_UP>(F.lds + RING_OFF, g, S, E);
#else
        pg8::Gemm g{(const bf16_t*)(ws + WS_XB), (const bf16_t*)(ws + WS_WUP), PADROWS, 2 * DFF, DM, (size_t)2 * DFF * DM};
        pg8::EpiSwiglu E{(bf16_t*)(ws + WS_ACT), A.in[17]};
        pg8::gemm_phase<pg8::EpiSwiglu, pg8::MoeOrder, true>(F.lds + RING_OFF, g, S, E);
#endif
        } SEAM(6);
    }
    if (IN(7)) { REP(7) {
        refresh_frame(F); const Args A = fetch_args(); unsigned char* ws = A.ws;
        if (!IN(6)) build_tab(F);
        pg8::MoeOrder S; S.init((const LAS int*)(F.lds + TAB_OFF), (const int*)(ws + WS_LIST), 4, (int)blockIdx.x);
#if MOE_FP8
        pg8::EpiDown8 E{(unsigned char*)(ws + WS_Y), A.in[19]};
        pg8::Gemm g{(const bf16_t*)(ws + WS_ACT), (const bf16_t*)(ws + WS_WDN), PADROWS, DM, DFF, (size_t)DM * DFF / 2};
        pg8::gemm_phase<pg8::EpiDown8, pg8::MoeOrder, false, true, META_DN>(F.lds + RING_OFF, g, S, E);
#else
        pg8::EpiDown E{(bf16_t*)(ws + WS_Y), A.in[19]};
        pg8::Gemm g{(const bf16_t*)(ws + WS_ACT), (const bf16_t*)(ws + WS_WDN), PADROWS, DM, DFF, (size_t)DM * DFF};
        pg8::gemm_phase<pg8::EpiDown, pg8::MoeOrder, false>(F.lds + RING_OFF, g, S, E);
#endif
        } SEAM(7);
    }
    if (IN(8)) { REP(8) { refresh_frame(F); const Args A = fetch_args(); if (!IN(6)) build_tab(F); combine_phase(F, A); } }
#undef IN
#undef SEAM
}

struct NArgs {
    const float* x; const float* B; const float* bias; const float* bias2;
    const bf16_t* Ab; bf16_t* Ob; float* Of; const int* ctl; const int* list;
};
template <int MODE> __global__ void __launch_bounds__(256) ngemm(NArgs a) {
    constexpr int K = 1024;
    constexpr int LDB = (MODE == 0) ? INW : (MODE == 2 ? 2048 : 1024);
    constexpr bool DUAL = (MODE == 2);
    __shared__ float As[16][68];
    __shared__ float Bs[16][64];
    __shared__ float Bs2[DUAL ? 16 : 1][64];
    const int tid = threadIdx.x, ty = tid >> 4, tx = tid & 15;
    const int row0 = blockIdx.y * 64, col0 = blockIdx.x * 64;
    const float* B = a.B; int e = 0, pst = 0, cnt = 0;
    if (MODE >= 2) {
        const int* ps = a.ctl + CW_PSTART;
        while (e < NE && row0 >= ps[e + 1]) ++e;
        if (e >= NE) return;
        pst = ps[e]; cnt = a.ctl[CW_CNT + e];
        B += (size_t)e * K * LDB;
    }
    const int ar = tid >> 2, ak = (tid & 3) * 4;
    const float* arow_f = nullptr; const bf16_t* arow_b = nullptr;
    if (MODE == 0) arow_f = a.x + (size_t)(row0 + ar) * K;
    else if (MODE == 1 || MODE == 3) arow_b = a.Ab + (size_t)(row0 + ar) * K;
    else { const int r = row0 + ar - pst; const int tok = (r < cnt) ? a.list[e * NTOK + r] : 0; arow_b = a.Ab + (size_t)tok * K; }
    const int bk = tid >> 4, bn = (tid & 15) * 4;
    float acc[4][4], acc2[4][4];
#pragma unroll
    for (int i = 0; i < 4; ++i)
#pragma unroll
        for (int j = 0; j < 4; ++j) { acc[i][j] = 0.f; acc2[i][j] = 0.f; }
    for (int k0 = 0; k0 < K; k0 += 16) {
        float av[4];
        if (MODE == 0) { const float4 t = *(const float4*)(arow_f + k0 + ak); av[0] = t.x; av[1] = t.y; av[2] = t.z; av[3] = t.w; }
        else { const uint2 t = *(const uint2*)(arow_b + k0 + ak); av[0] = bf2f((bf16_t)(t.x & 0xffff)); av[1] = bf2f((bf16_t)(t.x >> 16)); av[2] = bf2f((bf16_t)(t.y & 0xffff)); av[3] = bf2f((bf16_t)(t.y >> 16)); }
        const float4 bv = *(const float4*)(B + (size_t)(k0 + bk) * LDB + col0 + bn);
        float4 bv2 = bv;
        if (DUAL) bv2 = *(const float4*)(B + (size_t)(k0 + bk) * LDB + 1024 + col0 + bn);
        __syncthreads();
#pragma unroll
        for (int c = 0; c < 4; ++c) As[ak + c][ar] = av[c];
        *(float4*)&Bs[bk][bn] = bv;
        if (DUAL) *(float4*)&Bs2[bk][bn] = bv2;
        __syncthreads();
#pragma unroll
        for (int k = 0; k < 16; ++k) {
            const float4 a4 = *(const float4*)&As[k][ty * 4];
            const float4 b4 = *(const float4*)&Bs[k][tx * 4];
            const float aa[4] = {a4.x, a4.y, a4.z, a4.w}, bb[4] = {b4.x, b4.y, b4.z, b4.w};
#pragma unroll
            for (int i = 0; i < 4; ++i)
#pragma unroll
                for (int j = 0; j < 4; ++j) acc[i][j] = fmaf(aa[i], bb[j], acc[i][j]);
            if (DUAL) {
                const float4 c4 = *(const float4*)&Bs2[k][tx * 4];
                const float cc[4] = {c4.x, c4.y, c4.z, c4.w};
#pragma unroll
                for (int i = 0; i < 4; ++i)
#pragma unroll
                    for (int j = 0; j < 4; ++j) acc2[i][j] = fmaf(aa[i], cc[j], acc2[i][j]);
            }
        }
    }
#pragma unroll
    for (int i = 0; i < 4; ++i) {
        const int row = row0 + ty * 4 + i;
#pragma unroll
        for (int j = 0; j < 4; ++j) {
            const int col = col0 + tx * 4 + j;
            if (MODE == 0) { float v = acc[i][j]; if (col < C_K) v *= QSCALE; a.Ob[(size_t)row * INW + col] = f2bf(v); }
            else if (MODE == 1) { a.Of[(size_t)row * DM + col] = ALPHA * a.x[(size_t)row * DM + col] + acc[i][j]; }
            else if (MODE == 2) {
                float g = acc[i][j] + a.bias[e * 2048 + col], l = acc2[i][j] + a.bias[e * 2048 + 1024 + col];
                g = fminf(g, 7.0f); l = fminf(fmaxf(l, -7.0f), 7.0f);
                const float act = (l + 1.0f) * g * (1.0f / (1.0f + expf(-1.702f * g)));
                a.Ob[(size_t)row * DFF + col] = f2bf(act);
            } else { a.Ob[(size_t)row * DM + col] = f2bf(acc[i][j] + a.bias[e * DM + col]); }
        }
    }
}

__global__ void __launch_bounds__(128) nattn(const bf16_t* __restrict__ proj, bf16_t* __restrict__ mix, const float* lq1, const float* lk1, const float* lq2, const float* lk2, const float* subg) {
    __shared__ float sc[2][SEQ];
    const int w = threadIdx.x >> 6, lane = threadIdx.x & 63;
    const int task = blockIdx.x * 2 + w, t = task >> 2, h = task & 3, b = t / SEQ, qpos = t % SEQ;
    const float lam = expf(wave_sum(lq1[lane] * lk1[lane])) - expf(wave_sum(lq2[lane] * lk2[lane])) + LAMBDA_INIT;
    const bf16_t* pb = proj + (size_t)b * SEQ * INW;
    float o[2][2];
    for (int s = 0; s < 2; ++s) {
        float q[DH];
        const bf16_t* qp = proj + (size_t)t * INW + C_Q + s * 256 + h * DH;
#pragma unroll
        for (int d = 0; d < DH; ++d) q[d] = bf2f(qp[d]);
        float m = -INFINITY;
        for (int j = lane; j <= qpos; j += 64) {
            const uint4* kp = (const uint4*)(pb + (size_t)j * INW + C_K + s * 256 + h * DH);
            float acc = 0.f;
#pragma unroll
            for (int c = 0; c < 8; ++c) {
                const uint4 kk = kp[c];
                const uint32_t ww[4] = {kk.x, kk.y, kk.z, kk.w};
#pragma unroll
                for (int z = 0; z < 4; ++z) { acc = fmaf(q[c * 8 + 2 * z], bf2f((bf16_t)(ww[z] & 0xffff)), acc); acc = fmaf(q[c * 8 + 2 * z + 1], bf2f((bf16_t)(ww[z] >> 16)), acc); }
            }
            sc[w][j] = acc; m = fmaxf(m, acc);
        }
        m = wave_max(m);
        float l = 0.f;
        for (int j = lane; j <= qpos; j += 64) { const float p = exp2f(sc[w][j] - m); sc[w][j] = p; l += p; }
        l = wave_sum(l);
        __syncthreads();
        float o0 = 0.f, o1 = 0.f;
        const bf16_t* vp = pb + C_V + h * DV + lane * 2;
        for (int j = 0; j <= qpos; ++j) {
            const float p = sc[w][j];
            const uint32_t vv = *(const uint32_t*)(vp + (size_t)j * INW);
            o0 = fmaf(p, bf2f((bf16_t)(vv & 0xffff)), o0); o1 = fmaf(p, bf2f((bf16_t)(vv >> 16)), o1);
        }
        o[s][0] = o0 / l; o[s][1] = o1 / l;
        __syncthreads();
    }
    const float d0 = o[0][0] - lam * o[1][0], d1 = o[0][1] - lam * o[1][1];
    const float ss = wave_sum(d0 * d0 + d1 * d1);
    const float r = rsqrtf(ss * (1.0f / DV) + LN_EPS) * (1.0f - LAMBDA_INIT);
    const uint32_t pk = (uint32_t)f2bf(d0 * r * subg[lane * 2]) | ((uint32_t)f2bf(d1 * r * subg[lane * 2 + 1]) << 16);
    *(uint32_t*)(mix + (size_t)t * DM + h * DV + lane * 2) = pk;
}

__global__ void __launch_bounds__(256) ngmlp(const bf16_t* __restrict__ proj, bf16_t* __restrict__ mix, const float* lng, const float* lnb, const float* wsp, const float* bsp) {
    __shared__ float mu[CHUNK], rs[CHUNK];
    __shared__ float vn[CHUNK][GD];
    const int c = blockIdx.x, g = blockIdx.y, tid = threadIdx.x, w = tid >> 6, lane = tid & 63;
    const size_t row0 = (size_t)c * CHUNK;
    for (int s = w; s < CHUNK; s += 4) {
        const bf16_t* p = proj + (row0 + s) * INW + C_GV;
        float v[8]; float sum = 0.f;
#pragma unroll
        for (int i = 0; i < 8; ++i) { v[i] = gelu_exact(bf2f(p[lane + 64 * i])); sum += v[i]; }
        const float mean = wave_sum(sum) * (1.0f / GW); float q = 0.f;
#pragma unroll
        for (int i = 0; i < 8; ++i) { const float d = v[i] - mean; q += d * d; }
        const float var = wave_sum(q) * (1.0f / GW);
        if (lane == 0) { mu[s] = mean; rs[s] = rsqrtf(var + LN_EPS); }
    }
    __syncthreads();
    for (int i = tid; i < CHUNK * GD; i += 256) {
        const int s = i >> 6, d = i & 63, col = g * GD + d;
        const float v = gelu_exact(bf2f(proj[(row0 + s) * INW + C_GV + col]));
        vn[s][d] = (v - mu[s]) * rs[s] * lng[col] + lnb[col];
    }
    __syncthreads();
    const int t = tid >> 1, dh = (tid & 1) * 32;
    float z[32];
#pragma unroll
    for (int d = 0; d < 32; ++d) z[d] = 0.f;
    const float* wr = wsp + ((size_t)g * CHUNK + t) * CHUNK;
    for (int s = 0; s <= t; ++s) {
        const float wv = wr[s];
#pragma unroll
        for (int d = 0; d < 32; ++d) z[d] = fmaf(wv, vn[s][dh + d], z[d]);
    }
    const float bb = bsp[g * CHUNK + t];
#pragma unroll
    for (int d = 0; d < 32; ++d) {
        const int col = g * GD + dh + d;
        const float u = gelu_exact(bf2f(proj[(row0 + t) * INW + C_GU + col]));
        mix[(row0 + t) * DM + GW + col] = f2bf(u * (z[d] + bb));
    }
}

__global__ void __launch_bounds__(256) nroute(float* __restrict__ h1, bf16_t* __restrict__ xb, const float* g1, const float* b1, const float* wr, const float* br, int* ctl, int* list, int* re, int* rr, float* rg) {
    const int w = threadIdx.x >> 6, lane = threadIdx.x & 63, t = blockIdx.x * 4 + w;
    float* row = h1 + (size_t)t * DM;
    float v[16]; float s = 0.f;
#pragma unroll
    for (int j = 0; j < 4; ++j) { const float4 q = *(const float4*)(row + j * 256 + lane * 4); v[4 * j] = q.x; v[4 * j + 1] = q.y; v[4 * j + 2] = q.z; v[4 * j + 3] = q.w; s += (q.x + q.y) + (q.z + q.w); }
    const float mean = wave_sum(s) * (1.0f / DM); float q2 = 0.f;
#pragma unroll
    for (int i = 0; i < 16; ++i) { v[i] -= mean; q2 += v[i] * v[i]; }
    const float rstd = rsqrtf(wave_sum(q2) * (1.0f / DM) + LN_EPS);
#pragma unroll
    for (int j = 0; j < 4; ++j) {
        const int col = j * 256 + lane * 4;
#pragma unroll
        for (int c = 0; c < 4; ++c) v[4 * j + c] = v[4 * j + c] * rstd * g1[col + c] + b1[col + c];
        *(float4*)(row + col) = make_float4(v[4 * j], v[4 * j + 1], v[4 * j + 2], v[4 * j + 3]);
        uint2 pk; pk.x = (uint32_t)f2bf(v[4 * j]) | ((uint32_t)f2bf(v[4 * j + 1]) << 16); pk.y = (uint32_t)f2bf(v[4 * j + 2]) | ((uint32_t)f2bf(v[4 * j + 3]) << 16);
        *(uint2*)(xb + (size_t)t * DM + col) = pk;
    }
    float lg[NE];
#pragma unroll
    for (int e = 0; e < NE; ++e) lg[e] = 0.f;
#pragma unroll
    for (int j = 0; j < 4; ++j)
#pragma unroll
        for (int c = 0; c < 4; ++c) {
            const float xv = v[4 * j + c]; const float4* wp = (const float4*)(wr + (size_t)(j * 256 + lane * 4 + c) * NE);
#pragma unroll
            for (int e4 = 0; e4 < 8; ++e4) { const float4 ww = wp[e4]; lg[4 * e4] = fmaf(xv, ww.x, lg[4 * e4]); lg[4 * e4 + 1] = fmaf(xv, ww.y, lg[4 * e4 + 1]); lg[4 * e4 + 2] = fmaf(xv, ww.z, lg[4 * e4 + 2]); lg[4 * e4 + 3] = fmaf(xv, ww.w, lg[4 * e4 + 3]); }
        }
#pragma unroll
    for (int e = 0; e < NE; ++e) lg[e] = wave_sum(lg[e]) + br[e];
    int idx[4]; float val[4]; unsigned taken = 0u;
#pragma unroll
    for (int k = 0; k < 4; ++k) {
        float best = -INFINITY; int bi = 0;
#pragma unroll
        for (int e = 0; e < NE; ++e) { const bool ok = !((taken >> e) & 1u) && lg[e] > best; best = ok ? lg[e] : best; bi = ok ? e : bi; }
        idx[k] = bi; val[k] = best; taken |= 1u << bi;
    }
    float ex[4], se = 0.f;
#pragma unroll
    for (int k = 0; k < 4; ++k) { ex[k] = expf(val[k] - val[0]); se += ex[k]; }
    if (lane == 0) {
#pragma unroll
        for (int k = 0; k < 4; ++k) {
            const int r = atomicAdd(ctl + CW_CNT + idx[k], 1);
            list[idx[k] * NTOK + r] = t;
            re[t * 4 + k] = idx[k]; rr[t * 4 + k] = r; rg[t * 4 + k] = ex[k] / se;
        }
    }
}
__global__ void npstart(int* ctl) {
    if (threadIdx.x == 0 && blockIdx.x == 0) { int p = 0; for (int e = 0; e < NE; ++e) { ctl[CW_PSTART + e] = p; p += ((ctl[CW_CNT + e] + 255) / 256) * 256; } ctl[CW_PSTART + NE] = p; }
}
__global__ void __launch_bounds__(256) ncombine(const float* __restrict__ x1, const bf16_t* __restrict__ y, const int* ctl, const int* re, const int* rr, const float* rg, const float* g2, const float* b2, float* __restrict__ out) {
    const int w = threadIdx.x >> 6, lane = threadIdx.x & 63, t = blockIdx.x * 4 + w;
    float v[16];
#pragma unroll
    for (int j = 0; j < 4; ++j) { const float4 q = *(const float4*)(x1 + (size_t)t * DM + j * 256 + lane * 4); v[4 * j] = ALPHA * q.x; v[4 * j + 1] = ALPHA * q.y; v[4 * j + 2] = ALPHA * q.z; v[4 * j + 3] = ALPHA * q.w; }
#pragma unroll
    for (int k = 0; k < 4; ++k) {
        const int e = re[t * 4 + k], slot = ctl[CW_PSTART + e] + rr[t * 4 + k]; const float g = rg[t * 4 + k];
        const bf16_t* yr = y + (size_t)slot * DM;
#pragma unroll
        for (int j = 0; j < 4; ++j) { const uint2 pk = *(const uint2*)(yr + j * 256 + lane * 4);
            v[4 * j] = fmaf(g, bf2f((bf16_t)(pk.x & 0xffff)), v[4 * j]); v[4 * j + 1] = fmaf(g, bf2f((bf16_t)(pk.x >> 16)), v[4 * j + 1]);
            v[4 * j + 2] = fmaf(g, bf2f((bf16_t)(pk.y & 0xffff)), v[4 * j + 2]); v[4 * j + 3] = fmaf(g, bf2f((bf16_t)(pk.y >> 16)), v[4 * j + 3]); }
    }
    float s = 0.f;
#pragma unroll
    for (int i = 0; i < 16; ++i) s += v[i];
    const float mean = wave_sum(s) * (1.0f / DM); float q2 = 0.f;
#pragma unroll
    for (int i = 0; i < 16; ++i) { v[i] -= mean; q2 += v[i] * v[i]; }
    const float rstd = rsqrtf(wave_sum(q2) * (1.0f / DM) + LN_EPS);
#pragma unroll
    for (int j = 0; j < 4; ++j) { const int col = j * 256 + lane * 4;
        *(float4*)(out + (size_t)t * DM + col) = make_float4(v[4 * j] * rstd * g2[col] + b2[col], v[4 * j + 1] * rstd * g2[col + 1] + b2[col + 1], v[4 * j + 2] * rstd * g2[col + 2] + b2[col + 2], v[4 * j + 3] * rstd * g2[col + 3] + b2[col + 3]); }
}

#ifndef OPT_MASK
#define OPT_MASK 0x1FF
#endif
#ifndef FUSED
#define FUSED 0
#endif
static void launch_mega(const Args& base, int lo, int hi, int sub, hipStream_t stream) {
    Args a = base; a.ph_lo = lo; a.ph_hi = hi; a.pad0 = sub; a.pad1 = 0;
    hipLaunchKernelGGL(mega_fwd, dim3(256), dim3(NWAVES * 64), LDS_BYTES, stream, a);
}
extern "C" void kernel_launch(void* const* d_in, const int* in_sizes, int n_in, void* d_out, int out_size, void* d_ws, size_t ws_size, hipStream_t stream) {
    static int ready = 0;
    if (ready == 0) {
        if (n_in != 22 || in_sizes[0] != NTOK * DM || out_size != NTOK * DM || ws_size < WS_END) { fprintf(stderr, "kernel_launch: unexpected shapes (n_in %d, in0 %d, out %d, ws %zu)\n", n_in, n_in > 0 ? in_sizes[0] : -1, out_size, ws_size); ready = -1; return; }
        if (hipFuncSetAttribute((const void*)mega_fwd, hipFuncAttributeMaxDynamicSharedMemorySize, LDS_BYTES) != hipSuccess) { fprintf(stderr, "kernel_launch: hipFuncSetAttribute failed\n"); ready = -1; return; }
        ready = 1;
    }
    if (ready < 0) return;
    const float* x = (const float*)d_in[0]; const float* w_in = (const float*)d_in[1];
    const float *lq1 = (const float*)d_in[2], *lk1 = (const float*)d_in[3], *lq2 = (const float*)d_in[4], *lk2 = (const float*)d_in[5];
    const float *subg = (const float*)d_in[6], *glng = (const float*)d_in[7], *glnb = (const float*)d_in[8], *wsp = (const float*)d_in[9], *bsp = (const float*)d_in[10];
    const float *w_o = (const float*)d_in[11], *ln1g = (const float*)d_in[12], *ln1b = (const float*)d_in[13], *w_r = (const float*)d_in[14], *b_r = (const float*)d_in[15];
    const float *w_up = (const float*)d_in[16], *b_up = (const float*)d_in[17], *w_dn = (const float*)d_in[18], *b_dn = (const float*)d_in[19], *ln2g = (const float*)d_in[20], *ln2b = (const float*)d_in[21];
    unsigned char* ws = (unsigned char*)d_ws;
    int* ctl = (int*)(ws + WS_CTL); int* list = (int*)(ws + WS_LIST); int* re = (int*)(ws + WS_RE); int* rr = (int*)(ws + WS_RR); float* rg = (float*)(ws + WS_RG);
    bf16_t* xb = (bf16_t*)(ws + WS_XB); bf16_t* proj = (bf16_t*)(ws + WS_PROJ); bf16_t* mix = (bf16_t*)(ws + WS_MIX); bf16_t* yb = (bf16_t*)(ws + WS_Y);
    float* h1 = (float*)(ws + WS_H1); bf16_t* act = (bf16_t*)(ws + WS_ACT);
    (void)hipMemsetAsync(ws + WS_CTL, 0, CTL_BYTES, stream);
    Args base{};
    for (int i = 0; i < 22; ++i) base.in[i] = (const float*)d_in[i];
    base.out = (float*)d_out; base.ws = ws;
    constexpr unsigned OM = OPT_MASK;
#if FUSED
    static_assert(OM == 0x1FFu, "FUSED needs every stage in the persistent kernel");
    launch_mega(base, 0, N_PHASES, 3, stream);
#else
    if (OM & 0xD3u) launch_mega(base, 0, 1, 0, stream);
    if (OM & 2u) launch_mega(base, 1, 2, 0, stream);
    else { NArgs a{}; a.x = x; a.B = w_in; a.Ob = proj; ngemm<0><<<dim3(INW / 64, NTOK / 64), 256, 0, stream>>>(a); }
    if ((OM & 4u) || (OM & 8u)) launch_mega(base, 2, 3, ((OM & 4u) ? 1 : 0) | ((OM & 8u) ? 2 : 0), stream);
    if (OM & 4u) launch_mega(base, 3, 4, 0, stream);
    else nattn<<<NTOK * NH / 2, 128, 0, stream>>>(proj, mix, lq1, lk1, lq2, lk2, subg);
    if (!(OM & 8u)) ngmlp<<<dim3(NTOK / CHUNK, NG), 256, 0, stream>>>(proj, mix, glng, glnb, wsp, bsp);
    if (OM & 16u) launch_mega(base, 4, 5, 0, stream);
    else { NArgs a{}; a.x = x; a.B = w_o; a.Ab = mix; a.Of = h1; ngemm<1><<<dim3(DM / 64, NTOK / 64), 256, 0, stream>>>(a); }
    if (OM & 32u) launch_mega(base, 5, 6, 0, stream);
    else nroute<<<NTOK / 4, 256, 0, stream>>>(h1, xb, ln1g, ln1b, w_r, b_r, ctl, list, re, rr, rg);
    if ((OM & 0x1C0u) != 0x1C0u) npstart<<<1, 64, 0, stream>>>(ctl);
    if (OM & 64u) launch_mega(base, 6, 7, 0, stream);
    else { NArgs a{}; a.B = w_up; a.bias = b_up; a.Ab = xb; a.Ob = act; a.ctl = ctl; a.list = list; ngemm<2><<<dim3(DFF / 64, PADROWS / 64), 256, 0, stream>>>(a); }
    if (OM & 128u) launch_mega(base, 7, 8, 0, stream);
    else { NArgs a{}; a.B = w_dn; a.bias = b_dn; a.Ab = act; a.Ob = yb; a.ctl = ctl; a.list = list; ngemm<3><<<dim3(DM / 64, PADROWS / 64), 256, 0, stream>>>(a); }
    if (OM & 256u) launch_mega(base, 8, 9, 0, stream);
    else ncombine<<<NTOK / 4, 256, 0, stream>>>(h1, yb, ctl, re, rr, rg, ln2g, ln2b, (float*)d_out);
#endif
}
```
